# Optimizing an MI355X kernel written in HIP

```python
import math
import jax
import jax.numpy as jnp
from jax import lax
import numpy as np

D_MODEL = 1024
BATCH = 4
SEQ = 4096
DEPTH = 2

CTX_LEN = 256
GRID_W = 64
HEAD_DIM = 64
D_MIX = D_MODEL
SSD_WIDTH = 3 * D_MIX // 8
SSD_HEADS = SSD_WIDTH // HEAD_DIM
SSD_GROUPS = 2
SSD_STATE = 64
SSD_CHUNK = 128
HYENA_WIDTH = D_MIX // 4
HYENA_ORDER = 2
HYENA_BANDS = 16
HYENA_POS_DIM = 1 + 2 * HYENA_BANDS
HYENA_FILTER_HIDDEN = 64
MLSTM_WIDTH = D_MIX - SSD_WIDTH - HYENA_WIDTH
MLSTM_HEADS = MLSTM_WIDTH // HEAD_DIM
MLSTM_CHUNK = 128
SHORT_CONV = 3
N_GROUPS = 4
EXPERTS_PER_GROUP = 8
N_EXPERTS = N_GROUPS * EXPERTS_PER_GROUP
TOP_K_IN_GROUP = 2
EXPERT_HIDDEN = 256
N_MOD = 6
EPS = 1e-6
SSD_CONV_CH = SSD_WIDTH + 2 * SSD_GROUPS * SSD_STATE
IN_SIZES = (SSD_WIDTH, SSD_CONV_CH, 2 * SSD_HEADS, (HYENA_ORDER + 1) * HYENA_WIDTH,
            2 * MLSTM_WIDTH, MLSTM_WIDTH, MLSTM_WIDTH, 4 * MLSTM_HEADS)
IN_COLS = sum(IN_SIZES)

kernel_name = 'hybrid_ssd_hyena_mlstm_hmoe_dit'


def split_sizes(u, sizes):
    cuts, s = [], 0
    for n in sizes[:-1]:
        s += n
        cuts.append(s)
    return jnp.split(u, cuts, axis=-1)


def rmsnorm(x, w):
    xf = x.astype(jnp.float32)
    y = xf * lax.rsqrt(jnp.mean(xf * xf, axis=-1, keepdims=True) + EPS)
    return (y * w.astype(jnp.float32)).astype(x.dtype)


def modulated_norm(x, w, shift, scale):
    return rmsnorm(x, w) * (1 + scale[:, None, :]) + shift[:, None, :]


def short_conv(x, w, b):
    L = x.shape[1]
    pad = w.shape[0] // 2
    xp = jnp.pad(x, ((0, 0), (pad, pad), (0, 0)))
    return sum(xp[:, k:k + L] * w[k] for k in range(w.shape[0])) + b


def flip(t):
    return t[:, ::-1]


def to_col_major(u):
    b, L, ch = u.shape
    rows = L // GRID_W
    return u.reshape(b, rows, GRID_W, ch).transpose(0, 2, 1, 3).reshape(b, L, ch)


def to_row_major(u):
    b, L, ch = u.shape
    rows = L // GRID_W
    return u.reshape(b, GRID_W, rows, ch).transpose(0, 2, 1, 3).reshape(b, L, ch)


def zero_states(b):
    f32 = jnp.float32
    ssd0 = jnp.zeros((b, SSD_HEADS, HEAD_DIM, SSD_STATE), f32)
    ml0 = (jnp.zeros((b, MLSTM_HEADS, HEAD_DIM, HEAD_DIM), f32),
           jnp.zeros((b, MLSTM_HEADS, HEAD_DIM), f32),
           jnp.zeros((b, MLSTM_HEADS), f32))
    return (ssd0, ssd0), (ml0, ml0)


def ssd_scan(xh, dt, a, bh, ch, init, want_y):
    b, L, h, pd = xh.shape
    n = bh.shape[-1]
    q = SSD_CHUNK
    nc = L // q
    cum = jnp.cumsum((dt * a).reshape(b, nc, q, h).transpose(0, 1, 3, 2), axis=-1)
    xdt = (xh * dt[..., None]).reshape(b, nc, q, h, pd)
    bc = bh.reshape(b, nc, q, h, n)
    cc = ch.reshape(b, nc, q, h, n)
    to_end = jnp.exp(cum[..., -1:] - cum)
    chunk_states = jnp.einsum('bcqhn,bchq,bcqhp->bchpn', bc, to_end, xdt)
    chunk_decay = jnp.exp(cum[..., -1])

    def step(state, inp):
        s_c, d_c = inp
        return state * d_c[..., None, None] + s_c, state

    final, entering = lax.scan(step, init, (jnp.moveaxis(chunk_states, 1, 0), jnp.moveaxis(chunk_decay, 1, 0)))
    if not want_y:
        return None, final
    entering = jnp.moveaxis(entering, 0, 1)
    causal = jnp.tril(jnp.ones((q, q), dtype=bool))
    seg = jnp.exp(jnp.where(causal, cum[..., :, None] - cum[..., None, :], -jnp.inf))
    scores = jnp.einsum('bclhn,bcshn->bchls', cc, bc) * seg
    y = jnp.einsum('bchls,bcshp->bclhp', scores, xdt)
    y = y + jnp.einsum('bclhn,bchpn->bclhp', cc, entering) * jnp.exp(cum).transpose(0, 1, 3, 2)[..., None]
    return y.reshape(b, L, h, pd), final


def ssd_mixer(z, xbc, dt_raw, p, init, want_y):
    b, L, _ = z.shape
    f32 = jnp.float32
    xbc = jax.nn.silu(short_conv(xbc, p['ssd_conv_w'], p['ssd_conv_b']))
    xs, bs, cs = split_sizes(xbc, (SSD_WIDTH, SSD_GROUPS * SSD_STATE, SSD_GROUPS * SSD_STATE))
    rep = SSD_HEADS // SSD_GROUPS
    xh = xs.reshape(b, L, SSD_HEADS, HEAD_DIM).astype(f32)
    bh = jnp.repeat(bs.reshape(b, L, SSD_GROUPS, SSD_STATE), rep, axis=2).astype(f32)
    chh = jnp.repeat(cs.reshape(b, L, SSD_GROUPS, SSD_STATE), rep, axis=2).astype(f32)
    dt = jax.nn.softplus(dt_raw.reshape(b, L, 2, SSD_HEADS).astype(f32) + p['ssd_dt_bias'])
    a = -jnp.exp(p['ssd_a_log'].astype(f32))
    y_f, s_f = ssd_scan(xh, dt[:, :, 0], a[0], bh, chh, init[0], want_y)
    y_b, s_b = ssd_scan(flip(xh), flip(dt[:, :, 1]), a[1], flip(bh), flip(chh), init[1], want_y)
    if not want_y:
        return None, (s_f, s_b)
    y = y_f + flip(y_b) + xh * p['ssd_d'][:, None]
    y = y.reshape(b, L, SSD_WIDTH).astype(z.dtype)
    return rmsnorm(y * jax.nn.silu(z), p['ssd_norm_w']), (s_f, s_b)


def mlstm_scan(q, k, v, i_pre, f_pre, init, want_y):
    b, L, h, d = q.shape
    qn = MLSTM_CHUNK
    nc = L // qn
    chunk = lambda t: t.reshape(b, nc, qn, h, d).transpose(0, 1, 3, 2, 4)
    gate = lambda t: t.reshape(b, nc, qn, h).transpose(0, 1, 3, 2)
    qc, kc, vc = chunk(q), chunk(k) * (d ** -0.5), chunk(v)
    ig = gate(i_pre)
    cum_f = jnp.cumsum(gate(jax.nn.log_sigmoid(f_pre)), axis=-1)
    tot_f = cum_f[..., -1]
    w_end = tot_f[..., None] - cum_f + ig
    m_loc = jnp.max(w_end, axis=-1)
    e_end = jnp.exp(w_end - m_loc[..., None])
    c_loc = jnp.einsum('bchq,bchqv,bchqk->bchvk', e_end, vc, kc)
    n_loc = jnp.einsum('bchq,bchqk->bchk', e_end, kc)

    def step(carry, inp):
        c_prev, n_prev, m_prev = carry
        c_l, n_l, m_l, g_l = inp
        m_new = jnp.maximum(g_l + m_prev, m_l)
        a_prev = jnp.exp(g_l + m_prev - m_new)
        a_loc = jnp.exp(m_l - m_new)
        new = (a_prev[..., None, None] * c_prev + a_loc[..., None, None] * c_l,
               a_prev[..., None] * n_prev + a_loc[..., None] * n_l,
               m_new)
        return new, (c_prev, n_prev, m_prev)

    mv = lambda t: jnp.moveaxis(t, 1, 0)
    final, (c_in, n_in, m_in) = lax.scan(step, init, (mv(c_loc), mv(n_loc), mv(m_loc), mv(tot_f)))
    if not want_y:
        return None, final
    c_in, n_in, m_in = mv(c_in), mv(n_in), mv(m_in)
    causal = jnp.tril(jnp.ones((qn, qn), dtype=bool))
    log_w = jnp.where(causal, cum_f[..., :, None] - cum_f[..., None, :] + ig[..., None, :], -jnp.inf)
    inter = cum_f + m_in[..., None]
    m_t = jnp.maximum(inter, jnp.max(log_w, axis=-1))
    s = jnp.einsum('bchld,bchsd->bchls', qc, kc) * jnp.exp(log_w - m_t[..., None])
    a_inter = jnp.exp(inter - m_t)
    num = jnp.einsum('bchls,bchsv->bchlv', s, vc) + a_inter[..., None] * jnp.einsum('bchld,bchvd->bchlv', qc, c_in)
    den = jnp.sum(s, axis=-1) + a_inter * jnp.einsum('bchld,bchd->bchl', qc, n_in)
    hid = num / jnp.maximum(jnp.abs(den), jnp.exp(-m_t))[..., None]
    return hid.transpose(0, 1, 3, 2, 4).reshape(b, L, h, d), final


def head_layernorm(h, w):
    mu = jnp.mean(h, axis=-1, keepdims=True)
    hc = h - mu
    return hc * lax.rsqrt(jnp.mean(hc * hc, axis=-1, keepdims=True) + EPS) * w


def mlstm_mixer(qk, v, o, g, p, init, want_y):
    b, L, _ = v.shape
    f32 = jnp.float32
    qk = jax.nn.silu(short_conv(qk, p['ml_conv_w'], p['ml_conv_b']))
    q, k = jnp.split(qk, 2, axis=-1)
    heads = lambda t: t.reshape(b, L, MLSTM_HEADS, HEAD_DIM).astype(f32)
    q, k, vh = heads(q), heads(k), heads(v)
    gates = g.reshape(b, L, 2, 2, MLSTM_HEADS).astype(f32) + p['ml_gate_b']
    h_f, s_f = mlstm_scan(q, k, vh, gates[:, :, 0, 0], gates[:, :, 0, 1], init[0], want_y)
    h_b, s_b = mlstm_scan(flip(q), flip(k), flip(vh), flip(gates[:, :, 1, 0]), flip(gates[:, :, 1, 1]), init[1], want_y)
    if not want_y:
        return None, (s_f, s_b)
    h = head_layernorm(h_f + flip(h_b), p['ml_norm_w'].reshape(MLSTM_HEADS, HEAD_DIM))
    out = jax.nn.sigmoid(o.astype(f32)) * h.reshape(b, L, MLSTM_WIDTH)
    return out.astype(v.dtype), (s_f, s_b)


def hyena_filters(L, p):
    t = jnp.arange(L, dtype=jnp.float32)
    t_unit = t / float(max(L - 1, 1))
    bands = jnp.linspace(1e-4, HYENA_BANDS - 1, HYENA_BANDS, dtype=jnp.float32)
    ang = (2 * math.pi / L) * t[:, None] * bands[None, :]
    feats = jnp.concatenate([t_unit[:, None], jnp.cos(ang), -jnp.sin(ang)], axis=-1)
    freq = p['hy_freq']
    hdn = jnp.sin(freq * (feats @ p['hy_pos_w1'] + p['hy_pos_b1']))
    hdn = jnp.sin(freq * (hdn @ p['hy_pos_w2'] + p['hy_pos_b2']))
    filt = (hdn @ p['hy_pos_w3']).reshape(L, 2, HYENA_ORDER, HYENA_WIDTH)
    window = jnp.exp(-t_unit[:, None, None, None] * jnp.abs(p['hy_decay']))
    return (filt * window).astype(jnp.float32)


def bidir_long_conv(z, h_fwd, h_bwd):
    L, ch = h_fwd.shape
    two_sided = jnp.concatenate([h_fwd, jnp.zeros((1, ch), h_fwd.dtype), h_bwd[1:][::-1]], axis=0)
    two_sided = two_sided / jnp.sum(jnp.abs(two_sided), axis=0, keepdims=True)
    zf = jnp.fft.rfft(z.astype(jnp.float32), n=2 * L, axis=1)
    hf = jnp.fft.rfft(two_sided, n=2 * L, axis=0)
    return jnp.fft.irfft(zf * hf[None], n=2 * L, axis=1)[:, :L]


def hyena_mixer(u, p):
    uc = short_conv(u, p['hy_conv_w'], p['hy_conv_b'])
    v, *gates = jnp.split(uc.astype(jnp.float32), HYENA_ORDER + 1, axis=-1)
    filt = hyena_filters(u.shape[1], p)
    z = v
    for order, gate in enumerate(gates):
        z = gate * (bidir_long_conv(z, filt[:, 0, order], filt[:, 1, order]) + p['hy_skip'][order] * z)
    return z.astype(u.dtype)


def token_mixers(u, p, ssd_init, ml_init, want_out):
    z, xbc, dt_raw, hy_u, ml_qk, ml_v, ml_o, ml_g = split_sizes(u, IN_SIZES)
    y_ssd, ssd_fin = ssd_mixer(z, xbc, dt_raw, p, ssd_init, want_out)
    y_ml, ml_fin = mlstm_mixer(ml_qk, ml_v, ml_o, ml_g, p, ml_init, want_out)
    if not want_out:
        return None, ssd_fin, ml_fin
    y_hy = hyena_mixer(hy_u, p)
    return jnp.concatenate([y_ssd, y_hy, y_ml], axis=-1), ssd_fin, ml_fin


def hier_moe(h, p):
    b, L, dm = h.shape
    t = h.reshape(b * L, dm)
    grp_prob = jax.nn.softmax((t @ p['grp_router_w'] + p['grp_router_b']).astype(jnp.float32), axis=-1)
    grp_p, grp_idx = lax.top_k(grp_prob, 1)
    exp_logits = (t @ p['exp_router_w'] + p['exp_router_b']).astype(jnp.float32)
    exp_logits = exp_logits.reshape(-1, N_GROUPS, EXPERTS_PER_GROUP)
    in_grp = jnp.take_along_axis(exp_logits, grp_idx[:, :, None], axis=1)[:, 0]
    top_p, top_idx = lax.top_k(jax.nn.softmax(in_grp, axis=-1), TOP_K_IN_GROUP)
    top_w = grp_p * top_p / jnp.sum(top_p, axis=-1, keepdims=True)
    expert_w = jnp.sum(jax.nn.one_hot(top_idx, EXPERTS_PER_GROUP) * top_w[..., None], axis=1)
    group_mask = jax.nn.one_hot(grp_idx[:, 0], N_GROUPS)
    out = jnp.zeros_like(t)
    for g in range(N_GROUPS):
        gate_w = (group_mask[:, g:g + 1] * expert_w).astype(t.dtype)
        hid = jax.nn.silu(jnp.einsum('td,edf->tef', t, p['moe_w_gate'][g])) * jnp.einsum('td,edf->tef', t, p['moe_w_up'][g])
        out = out + jnp.einsum('tef,efd->td', hid * gate_w[..., None], p['moe_w_down'][g])
    return out.reshape(b, L, dm)


def setup_inputs(seed: int = 0) -> dict:
    key = jax.random.key(seed)
    keys = list(jax.random.split(key, 48))
    f32 = jnp.float32

    def nrm(shape, scale):
        return jax.random.normal(keys.pop(), shape, f32) * scale

    def gain(shape):
        return 1.0 + nrm(shape, 0.02)

    def unif(shape, lo, hi):
        return jax.random.uniform(keys.pop(), shape, f32, minval=lo, maxval=hi)

    D, FH, HW = D_MODEL, HYENA_FILTER_HIDDEN, HYENA_WIDTH
    dt0 = jnp.exp(unif((DEPTH, 2, SSD_HEADS), math.log(1e-3), math.log(1e-1)))
    decay_lo, decay_hi = -math.log(1e-2) / 1.5, -math.log(1e-2) / 0.3
    decay = jnp.broadcast_to(jnp.linspace(decay_lo, decay_hi, HW, dtype=f32), (DEPTH, 2, HYENA_ORDER, HW))
    f_bias = jnp.linspace(3.0, 6.0, MLSTM_HEADS, dtype=f32) + nrm((DEPTH, 2, MLSTM_HEADS), 0.02)
    i_bias = nrm((DEPTH, 2, MLSTM_HEADS), 0.1)
    return {
        'x': nrm((BATCH, SEQ, D), 1.0),
        'c': nrm((BATCH, D), 1.0),
        'ctx': nrm((BATCH, CTX_LEN, D), 1.0),
        'c_ctx': nrm((D,), 1.0),
        'w_mod': nrm((DEPTH, D, N_MOD * D), 0.5 * D ** -0.5),
        'b_mod': nrm((DEPTH, N_MOD * D), 0.02),
        'norm1_w': gain((DEPTH, D)),
        'norm2_w': gain((DEPTH, D)),
        'w_in': nrm((DEPTH, D, IN_COLS), D ** -0.5),
        'w_out': nrm((DEPTH, D_MIX, D), D_MIX ** -0.5),
        'ssd_conv_w': nrm((DEPTH, SHORT_CONV, SSD_CONV_CH), SHORT_CONV ** -0.5),
        'ssd_conv_b': nrm((DEPTH, SSD_CONV_CH), 0.02),
        'ssd_dt_bias': dt0 + jnp.log(-jnp.expm1(-dt0)),
        'ssd_a_log': jnp.log(unif((DEPTH, 2, SSD_HEADS), 1.0, 16.0)),
        'ssd_d': gain((DEPTH, SSD_HEADS)),
        'ssd_norm_w': gain((DEPTH, SSD_WIDTH)),
        'hy_conv_w': nrm((DEPTH, SHORT_CONV, (HYENA_ORDER + 1) * HW), SHORT_CONV ** -0.5),
        'hy_conv_b': nrm((DEPTH, (HYENA_ORDER + 1) * HW), 0.02),
        'hy_pos_w1': nrm((DEPTH, HYENA_POS_DIM, FH), HYENA_POS_DIM ** -0.5),
        'hy_pos_b1': nrm((DEPTH, FH), 0.02),
        'hy_pos_w2': nrm((DEPTH, FH, FH), FH ** -0.5),
        'hy_pos_b2': nrm((DEPTH, FH), 0.02),
        'hy_pos_w3': nrm((DEPTH, FH, 2 * HYENA_ORDER * HW), FH ** -0.5),
        'hy_freq': gain((DEPTH, FH)),
        'hy_decay': decay + nrm((DEPTH, 2, HYENA_ORDER, HW), 0.02),
        'hy_skip': nrm((DEPTH, HYENA_ORDER, HW), 1.0),
        'ml_conv_w': nrm((DEPTH, SHORT_CONV, 2 * MLSTM_WIDTH), SHORT_CONV ** -0.5),
        'ml_conv_b': nrm((DEPTH, 2 * MLSTM_WIDTH), 0.02),
        'ml_gate_b': jnp.stack([i_bias, f_bias], axis=2),
        'ml_norm_w': gain((DEPTH, MLSTM_WIDTH)),
        'grp_router_w': nrm((DEPTH, D, N_GROUPS), D ** -0.5),
        'grp_router_b': nrm((DEPTH, N_GROUPS), 0.01),
        'exp_router_w': nrm((DEPTH, D, N_EXPERTS), D ** -0.5),
        'exp_router_b': nrm((DEPTH, N_EXPERTS), 0.01),
        'moe_w_gate': nrm((DEPTH, N_GROUPS, EXPERTS_PER_GROUP, D, EXPERT_HIDDEN), D ** -0.5),
        'moe_w_up': nrm((DEPTH, N_GROUPS, EXPERTS_PER_GROUP, D, EXPERT_HIDDEN), D ** -0.5),
        'moe_w_down': nrm((DEPTH, N_GROUPS, EXPERTS_PER_GROUP, EXPERT_HIDDEN, D), EXPERT_HIDDEN ** -0.5),
        'final_norm_w': gain((D,)),
    }


def reference(x, c, ctx, c_ctx, w_mod, b_mod, norm1_w, norm2_w, w_in, w_out,
              ssd_conv_w, ssd_conv_b, ssd_dt_bias, ssd_a_log, ssd_d, ssd_norm_w,
              hy_conv_w, hy_conv_b, hy_pos_w1, hy_pos_b1, hy_pos_w2, hy_pos_b2, hy_pos_w3,
              hy_freq, hy_decay, hy_skip, ml_conv_w, ml_conv_b, ml_gate_b, ml_norm_w,
              grp_router_w, grp_router_b, exp_router_w, exp_router_b,
              moe_w_gate, moe_w_up, moe_w_down, final_norm_w):
    layer_params = (
        ('ssd_conv_w', ssd_conv_w), ('ssd_conv_b', ssd_conv_b), ('ssd_dt_bias', ssd_dt_bias),
        ('ssd_a_log', ssd_a_log), ('ssd_d', ssd_d), ('ssd_norm_w', ssd_norm_w),
        ('hy_conv_w', hy_conv_w), ('hy_conv_b', hy_conv_b), ('hy_pos_w1', hy_pos_w1),
        ('hy_pos_b1', hy_pos_b1), ('hy_pos_w2', hy_pos_w2), ('hy_pos_b2', hy_pos_b2),
        ('hy_pos_w3', hy_pos_w3), ('hy_freq', hy_freq), ('hy_decay', hy_decay), ('hy_skip', hy_skip),
        ('ml_conv_w', ml_conv_w), ('ml_conv_b', ml_conv_b), ('ml_gate_b', ml_gate_b), ('ml_norm_w', ml_norm_w),
        ('grp_router_w', grp_router_w), ('grp_router_b', grp_router_b),
        ('exp_router_w', exp_router_w), ('exp_router_b', exp_router_b),
        ('moe_w_gate', moe_w_gate), ('moe_w_up', moe_w_up), ('moe_w_down', moe_w_down),
    )
    xl, xc = x, ctx
    ssd_zero, ml_zero = zero_states(ctx.shape[0])
    for i in range(DEPTH):
        last = i == DEPTH - 1
        p = {name: arr[i] for name, arr in layer_params}
        mod_l = jnp.split(jax.nn.silu(c) @ w_mod[i] + b_mod[i], N_MOD, axis=-1)
        mod_c = jnp.split(jax.nn.silu(c_ctx)[None, :] @ w_mod[i] + b_mod[i], N_MOD, axis=-1)
        uc = modulated_norm(xc, norm1_w[i], mod_c[0], mod_c[1]) @ w_in[i]
        yc, ssd_ctx, ml_ctx = token_mixers(uc, p, ssd_zero, ml_zero, not last)
        ul = modulated_norm(xl, norm1_w[i], mod_l[0], mod_l[1]) @ w_in[i]
        col_major = i % 2 == 1
        if col_major:
            ul = to_col_major(ul)
        yl, _, _ = token_mixers(ul, p, ssd_ctx, ml_ctx, True)
        if col_major:
            yl = to_row_major(yl)
        xl = xl + mod_l[2][:, None, :] * (yl @ w_out[i])
        xl = xl + mod_l[5][:, None, :] * hier_moe(modulated_norm(xl, norm2_w[i], mod_l[3], mod_l[4]), p)
        if not last:
            xc = xc + mod_c[2][:, None, :] * (yc @ w_out[i])
            xc = xc + mod_c[5][:, None, :] * hier_moe(modulated_norm(xc, norm2_w[i], mod_c[3], mod_c[4]), p)
    return rmsnorm(xl, final_norm_w)
```

```cpp
#ifdef EMU
#include "gpuemu.h"
#else
#include <hip/hip_runtime.h>
#include <hip/hip_cooperative_groups.h>
#include <cstdio>
namespace cg = cooperative_groups;
#endif
#include <stdint.h>

#ifndef CFG_B
#define CFG_B 4
#endif
#ifndef CFG_SEQ
#define CFG_SEQ 4096
#endif
#ifndef CFG_CTX
#define CFG_CTX 256
#endif

typedef _Float16 half_t;
typedef _Float16 half8 __attribute__((ext_vector_type(8)));
typedef _Float16 half4 __attribute__((ext_vector_type(4)));
typedef float f32x4 __attribute__((ext_vector_type(4)));
struct cplx { float x, y; };

constexpr int D = 1024, NB = CFG_B, SEQ = CFG_SEQ, CTXL = CFG_CTX, GW = 64, GROWS = SEQ / GW;
constexpr int TL = NB * SEQ, TC = NB * CTXL, TT = TL + TC;
constexpr int NIN = 3364, NINP = 3456;
constexpr int UW = 2560;
constexpr int UGW = 36;
constexpr int NT = 512;
constexpr int TWN = 2 * SEQ > 2 * CTXL ? 2 * SEQ : 2 * CTXL;
constexpr int NMOD = 6 * D;
constexpr int LCAP = TT;
constexpr float EPSF = 1e-6f;

constexpr size_t al256(size_t x) { return (x + 255) / 256 * 256; }
constexpr size_t WS_CTL    = 0;
constexpr size_t WS_MOD    = 4096;
constexpr size_t WS_TW     = WS_MOD + al256(sizeof(float) * 2 * 5 * NMOD);
constexpr size_t WS_WIN    = WS_TW + al256(sizeof(cplx) * TWN);
constexpr size_t WS_WOUT   = WS_WIN + al256(2ull * 2 * NINP * D);
constexpr size_t WS_WMOE   = WS_WOUT + al256(2ull * 2 * D * D);
constexpr size_t WS_XC     = WS_WMOE + al256(2ull * 32 * 3 * 262144);
constexpr size_t WS_XN     = WS_XC + al256(4ull * TC * D);
constexpr size_t WS_U16    = WS_XN + al256(2ull * TT * D);
constexpr size_t WS_UG     = WS_U16 + al256(2ull * TT * UW);
constexpr size_t WS_HYT    = WS_UG + al256(4ull * TT * UGW);
constexpr size_t WS_YF     = WS_HYT + al256(2ull * NB * 768 * (SEQ + CTXL));
constexpr size_t WS_YHT    = WS_YF + al256(2ull * 4 * TT * 384);
constexpr size_t WS_FT     = WS_YHT + al256(4ull * NB * 256 * (SEQ + CTXL));
constexpr size_t WS_LIST   = WS_FT + al256(4ull * (2 * 256 * 4 * SEQ + 256 * 4 * CTXL));
constexpr size_t WS_PW     = WS_LIST + al256(4ull * 64 * LCAP);
constexpr size_t WS_END    = WS_PW + al256(4ull * TT * 2);
static_assert(4ull * NB * 256 * (SEQ + CTXL) <= 2ull * TT * D, "Z1 scratch must fit in the XN region");
static_assert(2ull * TT * 2 * 256 <= 2ull * TT * UW, "HID must fit in the U16 region");

constexpr int CW_CNT = 0;

constexpr int LDS_BYTES = 156 * 1024;

struct Params {
    const float* in[38];
    float* out;
    unsigned char* ws;
    int ph_lo, ph_hi;
};

enum { I_X = 0, I_C, I_CTX, I_CCTX, I_WMOD, I_BMOD, I_N1W, I_N2W, I_WIN, I_WOUT, I_SCW, I_SCB, I_DTB, I_ALOG, I_SD, I_SNW,
       I_HCW, I_HCB, I_HW1, I_HB1, I_HW2, I_HB2, I_HW3, I_HFREQ, I_HDEC, I_HSKIP, I_MCW, I_MCB, I_MGB, I_MNW,
       I_GRW, I_GRB, I_ERW, I_ERB, I_MG, I_MU, I_MD, I_FNW };

__device__ __forceinline__ float siluf(float x) { return x / (1.0f + expf(-x)); }
__device__ __forceinline__ float sigmoidf_(float x) { return 1.0f / (1.0f + expf(-x)); }
__device__ __forceinline__ float softplusf_(float x) { return x > 20.f ? x : log1pf(expf(x)); }
__device__ __forceinline__ float logsigmoidf_(float x) { return fminf(x, 0.f) - log1pf(expf(-fabsf(x))); }

__device__ __forceinline__ float wave_sum(float v) {
#pragma unroll
    for (int m = 32; m >= 1; m >>= 1) v += __shfl_xor(v, m);
    return v;
}
__device__ __forceinline__ float wave_max(float v) {
#pragma unroll
    for (int m = 32; m >= 1; m >>= 1) v = fmaxf(v, __shfl_xor(v, m));
    return v;
}
__device__ __forceinline__ float wave_scan_sum(float v, int lane) {
#pragma unroll
    for (int d = 1; d < 64; d <<= 1) { float o = __shfl_up(v, d); if (lane >= d) v += o; }
    return v;
}
__device__ __forceinline__ float wave_scan_max(float v, int lane) {
#pragma unroll
    for (int d = 1; d < 64; d <<= 1) { float o = __shfl_up(v, d); if (lane >= d) v = fmaxf(v, o); }
    return v;
}

template <int MT, int NTL>
__device__ __forceinline__ void mma_lds(f32x4 (&acc)[MT][NTL], const half_t* A, int lda, const half_t* B, int ldb, int ksteps, int lane) {
#ifndef EMU
    const int r = lane & 15, kq = (lane >> 4) * 8;
    for (int ks = 0; ks < ksteps; ++ks) {
        half8 a[MT], b[NTL];
#pragma unroll
        for (int mt = 0; mt < MT; ++mt) a[mt] = *(const half8*)(A + (mt * 16 + r) * lda + ks * 32 + kq);
#pragma unroll
        for (int nt = 0; nt < NTL; ++nt) b[nt] = *(const half8*)(B + (nt * 16 + r) * ldb + ks * 32 + kq);
#pragma unroll
        for (int mt = 0; mt < MT; ++mt)
#pragma unroll
            for (int nt = 0; nt < NTL; ++nt) acc[mt][nt] = __builtin_amdgcn_mfma_f32_16x16x32_f16(a[mt], b[nt], acc[mt][nt], 0, 0, 0);
    }
#else
    for (int mt = 0; mt < MT; ++mt) for (int nt = 0; nt < NTL; ++nt) for (int i = 0; i < 4; ++i) {
        const int row = mt * 16 + (lane >> 4) * 4 + i, col = nt * 16 + (lane & 15);
        float s = acc[mt][nt][i];
        for (int k = 0; k < ksteps * 32; ++k) s += (float)A[row * lda + k] * (float)B[col * ldb + k];
        acc[mt][nt][i] = s;
    }
#endif
}

template <int MT, int NTL> __device__ __forceinline__ void zero_acc(f32x4 (&acc)[MT][NTL]) {
#pragma unroll
    for (int mt = 0; mt < MT; ++mt)
#pragma unroll
        for (int nt = 0; nt < NTL; ++nt) acc[mt][nt] = (f32x4){0.f, 0.f, 0.f, 0.f};
}

constexpr int GLD = 40;
__device__ __forceinline__ void gemm128(const half_t* __restrict__ ap, const half_t* __restrict__ bp, int K, f32x4 (&acc)[2][4], half_t* lds, int tid) {
    half_t* As = lds;
    half_t* Bs = lds + 2 * 128 * GLD;
    const int lane = tid & 63, wave = tid >> 6, wm = wave >> 1, wn = wave & 1;
    const int lr = tid >> 2, lc = (tid & 3) * 8;
    const int nk = K / 32;
    half8 ra = *(const half8*)ap, rb = *(const half8*)bp;
    *(half8*)(As + lr * GLD + lc) = ra; *(half8*)(Bs + lr * GLD + lc) = rb;
    __syncthreads();
    for (int kt = 0; kt < nk; ++kt) {
        const int cur = kt & 1;
        if (kt + 1 < nk) { ra = *(const half8*)(ap + (kt + 1) * 32); rb = *(const half8*)(bp + (kt + 1) * 32); }
        mma_lds<2, 4>(acc, As + cur * 128 * GLD + wm * 32 * GLD, GLD, Bs + cur * 128 * GLD + wn * 64 * GLD, GLD, 1, lane);
        if (kt + 1 < nk) { *(half8*)(As + (cur ^ 1) * 128 * GLD + lr * GLD + lc) = ra; *(half8*)(Bs + (cur ^ 1) * 128 * GLD + lr * GLD + lc) = rb; }
        __syncthreads();
    }
}

struct Frame {
    Params P; unsigned char* ws; unsigned char* smem; int tid, lane, wave;
    __device__ __forceinline__ const float* in(int i) const { return P.in[i]; }
    __device__ __forceinline__ float* xrow(int row) const { return row < TL ? P.out + (size_t)row * D : (float*)(ws + WS_XC) + (size_t)(row - TL) * D; }
    __device__ __forceinline__ const float* xrow_in(int layer, int row) const {
        if (layer == 0) return row < TL ? in(I_X) + (size_t)row * D : in(I_CTX) + (size_t)(row - TL) * D;
        return xrow(row);
    }
};
__device__ __forceinline__ int row_mod(int row) { return row < TL ? row / SEQ : NB; }
__device__ __forceinline__ const float* modp(const Frame& F, int layer, int m, int chunk) { return (const float*)(F.ws + WS_MOD) + ((size_t)(layer * 5 + m) * 6 + chunk) * D; }

__device__ __forceinline__ void item_twiddle(const Frame& F, int it) {
    cplx* tw = (cplx*)(F.ws + WS_TW);
    const int k = it * NT + F.tid;
    if (k < TWN) { float s, c; const float a = -6.283185307179586f * (float)k / (float)TWN; s = sinf(a); c = cosf(a); tw[k].x = c; tw[k].y = s; }
}
__device__ __forceinline__ void item_mod(const Frame& F, int it) {
    const int layer = it / (NMOD / 64), n0 = (it % (NMOD / 64)) * 64;
    float* sc = (float*)F.smem;
    float* red = sc + 5 * D;
    for (int i = F.tid; i < 5 * D; i += NT) { const int m = i / D, k = i % D; const float v = m < NB ? F.in(I_C)[m * D + k] : F.in(I_CCTX)[k]; sc[i] = siluf(v); }
    __syncthreads();
    const int j = F.tid & 63, ks = F.tid >> 6;
    const float* w = F.in(I_WMOD) + (size_t)layer * D * NMOD + n0 + j;
    float a[5] = {0, 0, 0, 0, 0};
    for (int k = ks * 128; k < ks * 128 + 128; ++k) { const float wv = w[(size_t)k * NMOD];
#pragma unroll
        for (int m = 0; m < 5; ++m) a[m] += sc[m * D + k] * wv; }
#pragma unroll
    for (int m = 0; m < 5; ++m) red[(ks * 5 + m) * 64 + j] = a[m];
    __syncthreads();
    if (F.tid < 5 * 64) { const int m = F.tid / 64, jj = F.tid % 64; float s = 0; for (int q = 0; q < 8; ++q) s += red[(q * 5 + m) * 64 + jj];
        ((float*)(F.ws + WS_MOD))[(size_t)(layer * 5 + m) * NMOD + n0 + jj] = s + F.in(I_BMOD)[layer * NMOD + n0 + jj]; }
    __syncthreads();
}
__device__ __forceinline__ void item_filter(const Frame& F, int layer, int isctx, int tb) {
    const int L = isctx ? CTXL : SEQ;
    float* feats = (float*)F.smem;
    float* h1 = feats + 32 * 33;
    float* h2 = h1 + 32 * 64;
    const int t0 = tb * 32;
    for (int i = F.tid; i < 32 * 33; i += NT) {
        const int tt = i / 33, f = i % 33; const float t = (float)(t0 + tt);
        float v;
        if (f == 0) v = t / (float)(L - 1 > 1 ? L - 1 : 1);
        else { const int bi = (f - 1) & 15; const float band = 1e-4f + (float)bi * ((15.0f - 1e-4f) / 15.0f);
               const float ang = (6.283185307179586f / (float)L) * t * band; v = (f <= 16) ? cosf(ang) : -sinf(ang); }
        feats[i] = v;
    }
    __syncthreads();
    const float* w1 = F.in(I_HW1) + layer * 33 * 64; const float* b1 = F.in(I_HB1) + layer * 64;
    const float* w2 = F.in(I_HW2) + layer * 64 * 64; const float* b2 = F.in(I_HB2) + layer * 64;
    const float* fr = F.in(I_HFREQ) + layer * 64;
    for (int i = F.tid; i < 32 * 64; i += NT) { const int tt = i >> 6, j = i & 63; float s = b1[j]; for (int k = 0; k < 33; ++k) s += feats[tt * 33 + k] * w1[k * 64 + j]; h1[i] = sinf(fr[j] * s); }
    __syncthreads();
    for (int i = F.tid; i < 32 * 64; i += NT) { const int tt = i >> 6, j = i & 63; float s = b2[j]; for (int k = 0; k < 64; ++k) s += h1[tt * 64 + k] * w2[k * 64 + j]; h2[i] = sinf(fr[j] * s); }
    __syncthreads();
    const float* w3 = F.in(I_HW3) + (size_t)layer * 64 * 1024;
    const int c0 = F.tid * 2;
    float* ft = (float*)(F.ws + WS_FT) + (isctx ? (size_t)2 * 256 * 4 * SEQ : (size_t)layer * 256 * 4 * SEQ);
    for (int hf = 0; hf < 2; ++hf) {
        float acc[16][2];
        for (int tt = 0; tt < 16; ++tt) { acc[tt][0] = 0.f; acc[tt][1] = 0.f; }
        for (int k = 0; k < 64; ++k) { const float wa = w3[k * 1024 + c0], wb = w3[k * 1024 + c0 + 1];
#pragma unroll
            for (int tt = 0; tt < 16; ++tt) { const float hv = h2[(hf * 16 + tt) * 64 + k]; acc[tt][0] += hv * wa; acc[tt][1] += hv * wb; } }
#pragma unroll
        for (int q = 0; q < 2; ++q) {
            const int col = c0 + q, dir = col >> 9, order = (col >> 8) & 1, c = col & 255;
            const float dec = fabsf(F.in(I_HDEC)[((layer * 2 + dir) * 2 + order) * 256 + c]);
            float* dst = ft + ((size_t)(c * 2 + order) * 2 + dir) * L + t0 + hf * 16;
#pragma unroll
            for (int tt = 0; tt < 16; ++tt) { const float tu = (float)(t0 + hf * 16 + tt) / (float)(L - 1 > 1 ? L - 1 : 1); dst[tt] = acc[tt][q] * expf(-tu * dec); }
        }
    }
    __syncthreads();
}
__device__ __forceinline__ void item_transpose(const Frame& F, const float* src, int ldn, int nvalid, half_t* dst, int K, int k0, int n0) {
    float* tile = (float*)F.smem;
    for (int i = F.tid; i < 64 * 16; i += NT) {
        const int r = i >> 4, c4 = (i & 15) * 4;
        float v[4];
#pragma unroll
        for (int q = 0; q < 4; ++q) v[q] = (n0 + c4 + q < nvalid) ? src[(size_t)(k0 + r) * ldn + n0 + c4 + q] : 0.f;
#pragma unroll
        for (int q = 0; q < 4; ++q) tile[r * 65 + c4 + q] = v[q];
    }
    __syncthreads();
    { const int n = F.tid >> 3, kc = (F.tid & 7) * 8; half8 h;
#pragma unroll
      for (int q = 0; q < 8; ++q) h[q] = (half_t)tile[(kc + q) * 65 + n];
      *(half8*)(dst + (size_t)(n0 + n) * K + k0 + kc) = h; }
    __syncthreads();
}
constexpr int IT_TW = (TWN + NT - 1) / NT;
constexpr int IT_MOD = 2 * (NMOD / 64);
constexpr int IT_FILT = 2 * (SEQ / 32) + (CTXL / 32);
constexpr int IT_TWIN = 2 * 16 * (NINP / 64);
constexpr int IT_TWOUT = 2 * 16 * 16;
constexpr int IT_TMOE = 32 * 192;
__device__ __forceinline__ void moe_transpose_item(const Frame& F, int layer, int it) {
    const int e = it / 192, r = it % 192, which = r / 64, t = r % 64;
    half_t* base = (half_t*)(F.ws + WS_WMOE) + (size_t)e * 3 * 262144;
    if (which < 2) {
        const float* src = F.in(which == 0 ? I_MG : I_MU) + ((size_t)layer * 32 + e) * 262144;
        item_transpose(F, src, 256, 256, base + which * 262144, 1024, (t >> 2) * 64, (t & 3) * 64);
    } else {
        const float* src = F.in(I_MD) + ((size_t)layer * 32 + e) * 262144;
        item_transpose(F, src, 1024, 1024, base + 2 * 262144, 256, (t >> 4) * 64, (t & 15) * 64);
    }
}
__device__ __forceinline__ void phase_setup(const Frame& F) {
    if (blockIdx.x == 0 && F.tid < 128) ((unsigned*)(F.ws + WS_CTL))[CW_CNT + F.tid] = 0u;
    const int total = IT_TW + IT_MOD + IT_FILT + IT_TWIN + IT_TWOUT + IT_TMOE;
    for (int it = blockIdx.x; it < total; it += gridDim.x) {
        int i = it;
        if (i < IT_MOD) { item_mod(F, i); continue; } i -= IT_MOD;
        if (i < IT_FILT) { if (i < 2 * (SEQ / 32)) item_filter(F, i / (SEQ / 32), 0, i % (SEQ / 32)); else item_filter(F, 0, 1, i - 2 * (SEQ / 32)); continue; } i -= IT_FILT;
        if (i < IT_TW) { item_twiddle(F, i); continue; } i -= IT_TW;
        if (i < IT_TWIN) { const int layer = i / (16 * (NINP / 64)), r = i % (16 * (NINP / 64));
            item_transpose(F, F.in(I_WIN) + (size_t)layer * D * NIN, NIN, NIN, (half_t*)(F.ws + WS_WIN) + (size_t)layer * NINP * D, D, (r / (NINP / 64)) * 64, (r % (NINP / 64)) * 64); continue; } i -= IT_TWIN;
        if (i < IT_TWOUT) { const int layer = i / 256, r = i % 256;
            item_transpose(F, F.in(I_WOUT) + (size_t)layer * D * D, D, D, (half_t*)(F.ws + WS_WOUT) + (size_t)layer * D * D, D, (r >> 4) * 64, (r & 15) * 64); continue; } i -= IT_TWOUT;
        moe_transpose_item(F, 0, i);
    }
}

__device__ __forceinline__ void norm_rows16(const Frame& F, int layer, int row0, int which  ) {
    half_t* xn = (half_t*)(F.ws + WS_XN);
    for (int rr = F.wave; rr < 16; rr += NT / 64) {
        const int row = row0 + rr; const int m = row_mod(row);
        const float* x = F.xrow_in(layer, row);
        float v[16]; float ss = 0.f;
#pragma unroll
        for (int q = 0; q < 4; ++q) { const f32x4 t = *(const f32x4*)(x + q * 256 + F.lane * 4); v[q * 4 + 0] = t[0]; v[q * 4 + 1] = t[1]; v[q * 4 + 2] = t[2]; v[q * 4 + 3] = t[3]; ss += t[0] * t[0] + t[1] * t[1] + t[2] * t[2] + t[3] * t[3]; }
        ss = wave_sum(ss);
        const float rs = 1.0f / sqrtf(ss * (1.0f / D) + EPSF);
        const float* nw = F.in(I_N1W) + layer * D; const float* sh = modp(F, layer, m, 0); const float* scl = modp(F, layer, m, 1);
        int srow = row;
        if (layer == 1 && row < TL) { const int b = row / SEQ, l = row % SEQ; srow = b * SEQ + (l % GW) * GROWS + l / GW; }
#pragma unroll
        for (int q = 0; q < 4; ++q) { const int k = q * 256 + F.lane * 4; half4 h;
#pragma unroll
            for (int e = 0; e < 4; ++e) h[e] = (half_t)(v[q * 4 + e] * rs * nw[k + e] * (1.0f + scl[k + e]) + sh[k + e]);
            *(half4*)(xn + (size_t)srow * D + k) = h; }
    }
}
__device__ __forceinline__ void phase_norm1(const Frame& F, int layer) {
    const int nrow_items = TT / 16;
    const int total = nrow_items + (layer == 1 ? IT_TMOE : 0);
    for (int it = blockIdx.x; it < total; it += gridDim.x) {
        if (it < nrow_items) norm_rows16(F, layer, it * 16, 0); else moe_transpose_item(F, 1, it - nrow_items);
    }
}

__device__ __forceinline__ void phase_inproj(const Frame& F, int layer) {
    const half_t* xn = (const half_t*)(F.ws + WS_XN);
    const half_t* wt = (const half_t*)(F.ws + WS_WIN) + (size_t)layer * NINP * D;
    half_t* u16 = (half_t*)(F.ws + WS_U16); float* ug = (float*)(F.ws + WS_UG); half_t* hyt = (half_t*)(F.ws + WS_HYT);
    const int ntn = NINP / 128, total = (TT / 128) * ntn;
    const int lr = F.tid >> 2, lc = (F.tid & 3) * 8, wm = F.wave >> 1, wn = F.wave & 1;
    for (int it = blockIdx.x; it < total; it += gridDim.x) {
        const int mt_ = it / ntn, nt_ = it % ntn, m0 = mt_ * 128, n0 = nt_ * 128;
        f32x4 acc[2][4]; zero_acc(acc);
        gemm128(xn + (size_t)(m0 + lr) * D + lc, wt + (size_t)(n0 + lr) * D + lc, D, acc, (half_t*)F.smem, F.tid);
#pragma unroll
        for (int a = 0; a < 2; ++a)
#pragma unroll
            for (int b = 0; b < 4; ++b) {
                const int r0 = m0 + wm * 32 + a * 16 + (F.lane >> 4) * 4, n = n0 + wn * 64 + b * 16 + (F.lane & 15);
                const f32x4 v = acc[a][b];
                if (n < 1024) { for (int i = 0; i < 4; ++i) u16[(size_t)(r0 + i) * UW + n] = (half_t)v[i]; }
                else if (n < 1036) { for (int i = 0; i < 4; ++i) ug[(size_t)(r0 + i) * UGW + (n - 1024)] = v[i]; }
                else if (n < 1804) { const int ch = n - 1036; half4 h = {(half_t)v[0], (half_t)v[1], (half_t)v[2], (half_t)v[3]};
                    if (r0 < TL) { const int b_ = r0 / SEQ, s = r0 % SEQ; *(half4*)(hyt + ((size_t)b_ * 768 + ch) * SEQ + s) = h; }
                    else { const int rc = r0 - TL, b_ = rc / CTXL, s = rc % CTXL; *(half4*)(hyt + (size_t)NB * 768 * SEQ + ((size_t)b_ * 768 + ch) * CTXL + s) = h; } }
                else if (n < 3340) { for (int i = 0; i < 4; ++i) u16[(size_t)(r0 + i) * UW + (n - 1804 + 1024)] = (half_t)v[i]; }
                else if (n < NIN) { for (int i = 0; i < 4; ++i) ug[(size_t)(r0 + i) * UGW + 12 + (n - 3340)] = v[i]; }
            }
    }
}

__device__ __forceinline__ void conv8(const half_t* u16, int rowbase, int pos, int Lseq, int ucol, const float* cw, const float* cb, int ccol, int C, float (&o)[8]) {
    half8 z8; for (int i = 0; i < 8; ++i) z8[i] = (half_t)0.f;
    const half8 m = *(const half8*)(u16 + (size_t)(rowbase + pos) * UW + ucol);
    const half8 l = pos > 0 ? *(const half8*)(u16 + (size_t)(rowbase + pos - 1) * UW + ucol) : z8;
    const half8 r = pos + 1 < Lseq ? *(const half8*)(u16 + (size_t)(rowbase + pos + 1) * UW + ucol) : z8;
#pragma unroll
    for (int i = 0; i < 8; ++i) o[i] = cw[ccol + i] * (float)l[i] + cw[C + ccol + i] * (float)m[i] + cw[2 * C + ccol + i] * (float)r[i] + cb[ccol + i];
}

constexpr int SA = 72, SB = 136;
__device__ __forceinline__ void ssd_block(const Frame& F, int layer, int b, int h, int dir) {
    half_t* Cs = (half_t*)F.smem;
    half_t* Bs = Cs + 128 * SA;
    half_t* Xs = Bs + 128 * SA;
    half_t* BT = Xs + 128 * SA;
    half_t* XT = BT + 64 * SB;
    half_t* XW = XT + 64 * SB;
    half_t* SC = XW + 64 * SB;
    half_t* ST = SC + 128 * SB;
    float* cum = (float*)(ST + 64 * SA);
    float* dtv = cum + 128;
    float* wtot = dtv + 128;
    const half_t* u16 = (const half_t*)(F.ws + WS_U16); const float* ug = (const float*)(F.ws + WS_UG);
    half_t* yout = (half_t*)(F.ws + WS_YF) + (size_t)dir * TT * 384;
    const float* cw = F.in(I_SCW) + layer * 3 * 640; const float* cb = F.in(I_SCB) + layer * 640;
    const float dtb = F.in(I_DTB)[(layer * 2 + dir) * 6 + h];
    const float Aneg = -expf(F.in(I_ALOG)[(layer * 2 + dir) * 6 + h]);
    const float Dh = F.in(I_SD)[layer * 6 + h];
    const int g = h / 3, tid = F.tid, lane = F.lane, wave = F.wave;
    f32x4 accS[1][2]; zero_acc(accS);
    for (int i = tid; i < 64 * SA; i += NT) ST[i] = (half_t)0.f;
    __syncthreads();
    for (int seg = 0; seg < 2; ++seg) {
        const int Lseq = seg == 0 ? CTXL : SEQ, rowbase = seg == 0 ? TL + b * CTXL : b * SEQ;
        const bool want_y = (seg == 1) || (layer == 0);
        for (int c = 0; c < Lseq / 128; ++c) {
            if (tid < 128) {
                const int j = tid, pi = c * 128 + j, pos = dir == 0 ? pi : Lseq - 1 - pi;
                const float dt = softplusf_(ug[(size_t)(rowbase + pos) * UGW + dir * 6 + h] + dtb);
                const float cs = wave_scan_sum(dt * Aneg, lane);
                dtv[j] = dt; cum[j] = cs;
                if (lane == 63) wtot[wave] = cs;
            }
            __syncthreads();
            if (tid >= 64 && tid < 128) cum[tid] += wtot[0];
            __syncthreads();
            const float cl = cum[127];
            for (int item = tid; item < 128 * 24; item += NT) {
                const int j = item / 24, grp = item % 24, pi = c * 128 + j, pos = dir == 0 ? pi : Lseq - 1 - pi;
                float o[8];
                if (grp < 8) {
                    const int p0 = grp * 8;
                    conv8(u16, rowbase, pos, Lseq, 384 + h * 64 + p0, cw, cb, h * 64 + p0, 640, o);
                    const float dt = dtv[j], we = expf(cl - cum[j]); half8 hx;
#pragma unroll
                    for (int i = 0; i < 8; ++i) { const float xv = siluf(o[i]); hx[i] = (half_t)xv; XT[(p0 + i) * SB + j] = (half_t)(xv * dt); XW[(p0 + i) * SB + j] = (half_t)(xv * dt * we); }
                    *(half8*)(Xs + j * SA + p0) = hx;
                } else if (grp < 16) {
                    const int n0 = (grp - 8) * 8;
                    conv8(u16, rowbase, pos, Lseq, 384 + 384 + g * 64 + n0, cw, cb, 384 + g * 64 + n0, 640, o);
                    half8 hb;
#pragma unroll
                    for (int i = 0; i < 8; ++i) { const float v = siluf(o[i]); hb[i] = (half_t)v; BT[(n0 + i) * SB + j] = (half_t)v; }
                    *(half8*)(Bs + j * SA + n0) = hb;
                } else {
                    const int n0 = (grp - 16) * 8;
                    conv8(u16, rowbase, pos, Lseq, 384 + 512 + g * 64 + n0, cw, cb, 512 + g * 64 + n0, 640, o);
                    half8 hc;
#pragma unroll
                    for (int i = 0; i < 8; ++i) hc[i] = (half_t)siluf(o[i]);
                    *(half8*)(Cs + j * SA + n0) = hc;
                }
            }
            __syncthreads();
            if (want_y) {
                { const int wm = wave >> 1, wn = wave & 1;
                  if (!(wn == 1 && wm < 2)) {
                    f32x4 g_[2][4]; zero_acc(g_);
                    mma_lds<2, 4>(g_, Cs + wm * 32 * SA, SA, Bs + wn * 64 * SA, SA, 2, lane);
#pragma unroll
                    for (int a = 0; a < 2; ++a)
#pragma unroll
                        for (int q = 0; q < 4; ++q)
#pragma unroll
                            for (int i = 0; i < 4; ++i) {
                                const int l = wm * 32 + a * 16 + (lane >> 4) * 4 + i, s = wn * 64 + q * 16 + (lane & 15);
                                const float v = s <= l ? g_[a][q][i] * expf(cum[l] - cum[s]) : 0.f;
                                SC[l * SB + s] = (half_t)v;
                            }
                  } }
                f32x4 y1[1][4]; zero_acc(y1);
                mma_lds<1, 4>(y1, Cs + wave * 16 * SA, SA, ST, SA, 2, lane);
                __syncthreads();
                f32x4 y2[1][4]; zero_acc(y2);
                mma_lds<1, 4>(y2, SC + wave * 16 * SB, SB, XT, SB, wave / 2 + 1, lane);
#pragma unroll
                for (int q = 0; q < 4; ++q)
#pragma unroll
                    for (int i = 0; i < 4; ++i) {
                        const int l = wave * 16 + (lane >> 4) * 4 + i, p = q * 16 + (lane & 15);
                        float y = y1[0][q][i] * expf(cum[l]) + y2[0][q][i];
                        if (dir == 0) y += Dh * (float)Xs[l * SA + p];
                        const int pi = c * 128 + l, pos = dir == 0 ? pi : Lseq - 1 - pi;
                        yout[(size_t)(rowbase + pos) * 384 + h * 64 + p] = (half_t)y;
                    }
            }
            { const float dec = expf(cl);
#pragma unroll
              for (int q = 0; q < 2; ++q) accS[0][q] *= dec;
              mma_lds<1, 2>(accS, XW + (wave >> 1) * 16 * SB, SB, BT + (wave & 1) * 32 * SB, SB, 4, lane); }
            __syncthreads();
#pragma unroll
            for (int q = 0; q < 2; ++q)
#pragma unroll
                for (int i = 0; i < 4; ++i) { const int p = (wave >> 1) * 16 + (lane >> 4) * 4 + i, n = (wave & 1) * 32 + q * 16 + (lane & 15); ST[p * SA + n] = (half_t)accS[0][q][i]; }
            __syncthreads();
        }
    }
}

__device__ __forceinline__ void mlstm_block(const Frame& F, int layer, int b, int h, int dir) {
    half_t* Qs = (half_t*)F.smem;
    half_t* Ks = Qs + 128 * SA;
    half_t* KT = Ks + 128 * SA;
    half_t* VT = KT + 64 * SB;
    half_t* VW = VT + 64 * SB;
    half_t* SC = VW + 64 * SB;
    half_t* CS = SC + 128 * SB;
    float* ig = (float*)(CS + 64 * SA);
    float* cumf = ig + 128; float* pmx = cumf + 128; float* mtv = pmx + 128; float* ee = mtv + 128; float* dn = ee + 128;
    float* nvec = dn + 128;
    float* wtot = nvec + 64;
    const half_t* u16 = (const half_t*)(F.ws + WS_U16); const float* ug = (const float*)(F.ws + WS_UG);
    half_t* hout = (half_t*)(F.ws + WS_YF) + (size_t)(2 + dir) * TT * 384;
    const float* cw = F.in(I_MCW) + layer * 3 * 768; const float* cb = F.in(I_MCB) + layer * 768;
    const float bi = F.in(I_MGB)[((layer * 2 + dir) * 2 + 0) * 6 + h], bf = F.in(I_MGB)[((layer * 2 + dir) * 2 + 1) * 6 + h];
    const int tid = F.tid, lane = F.lane, wave = F.wave;
    f32x4 accC[1][2]; zero_acc(accC);
    float m_in = 0.f;
    for (int i = tid; i < 64 * SA; i += NT) CS[i] = (half_t)0.f;
    if (tid < 64) nvec[tid] = 0.f;
    __syncthreads();
    for (int seg = 0; seg < 2; ++seg) {
        const int Lseq = seg == 0 ? CTXL : SEQ, rowbase = seg == 0 ? TL + b * CTXL : b * SEQ;
        const bool want_y = (seg == 1) || (layer == 0);
        for (int c = 0; c < Lseq / 128; ++c) {
            if (tid < 128) {
                const int j = tid, pi = c * 128 + j, pos = dir == 0 ? pi : Lseq - 1 - pi;
                const float* gp = ug + (size_t)(rowbase + pos) * UGW + 12 + dir * 12;
                const float ip = gp[h] + bi, fp = gp[6 + h] + bf;
                const float cs = wave_scan_sum(logsigmoidf_(fp), lane);
                ig[j] = ip; cumf[j] = cs;
                if (lane == 63) wtot[wave] = cs;
            }
            __syncthreads();
            if (tid >= 64 && tid < 128) cumf[tid] += wtot[0];
            __syncthreads();
            if (tid < 128) {
                const float r = ig[tid] - cumf[tid];
                const float pm = wave_scan_max(r, lane);
                pmx[tid] = pm;
                if (lane == 63) wtot[4 + wave] = pm;
            }
            __syncthreads();
            if (tid >= 64 && tid < 128) pmx[tid] = fmaxf(pmx[tid], wtot[4]);
            __syncthreads();
            const float tot = cumf[127];
            const float m_new = fmaxf(tot + m_in, tot + pmx[127]);
            if (tid < 128) { mtv[tid] = fmaxf(cumf[tid] + m_in, cumf[tid] + pmx[tid]); ee[tid] = expf(ig[tid] + tot - cumf[tid] - m_new); }
            __syncthreads();
            for (int item = tid; item < 128 * 24; item += NT) {
                const int j = item / 24, grp = item % 24, pi = c * 128 + j, pos = dir == 0 ? pi : Lseq - 1 - pi;
                float o[8];
                if (grp < 8) {
                    const int d0 = grp * 8;
                    conv8(u16, rowbase, pos, Lseq, 1024 + h * 64 + d0, cw, cb, h * 64 + d0, 768, o);
                    half8 hq;
#pragma unroll
                    for (int i = 0; i < 8; ++i) hq[i] = (half_t)siluf(o[i]);
                    *(half8*)(Qs + j * SA + d0) = hq;
                } else if (grp < 16) {
                    const int d0 = (grp - 8) * 8;
                    conv8(u16, rowbase, pos, Lseq, 1024 + 384 + h * 64 + d0, cw, cb, 384 + h * 64 + d0, 768, o);
                    half8 hk;
#pragma unroll
                    for (int i = 0; i < 8; ++i) { const float v = siluf(o[i]) * 0.125f; hk[i] = (half_t)v; KT[(d0 + i) * SB + j] = (half_t)v; }
                    *(half8*)(Ks + j * SA + d0) = hk;
                } else {
                    const int v0 = (grp - 16) * 8;
                    const half8 hv = *(const half8*)(u16 + (size_t)(rowbase + pos) * UW + 1792 + h * 64 + v0);
                    const float e = ee[j];
#pragma unroll
                    for (int i = 0; i < 8; ++i) { VT[(v0 + i) * SB + j] = hv[i]; VW[(v0 + i) * SB + j] = (half_t)((float)hv[i] * e); }
                }
            }
            __syncthreads();
            if (want_y) {
                { const int wm = wave >> 1, wn = wave & 1;
                  if (!(wn == 1 && wm < 2)) {
                    f32x4 g_[2][4]; zero_acc(g_);
                    mma_lds<2, 4>(g_, Qs + wm * 32 * SA, SA, Ks + wn * 64 * SA, SA, 2, lane);
#pragma unroll
                    for (int a = 0; a < 2; ++a)
#pragma unroll
                        for (int q = 0; q < 4; ++q)
#pragma unroll
                            for (int i = 0; i < 4; ++i) {
                                const int l = wm * 32 + a * 16 + (lane >> 4) * 4 + i, s = wn * 64 + q * 16 + (lane & 15);
                                const float v = s <= l ? g_[a][q][i] * expf(cumf[l] - cumf[s] + ig[s] - mtv[l]) : 0.f;
                                SC[l * SB + s] = (half_t)v;
                            }
                  } }
                f32x4 h1[1][4]; zero_acc(h1);
                mma_lds<1, 4>(h1, Qs + wave * 16 * SA, SA, CS, SA, 2, lane);
                if (tid < 128) { float s = 0.f; for (int d = 0; d < 64; ++d) s += (float)Qs[tid * SA + d] * nvec[d]; dn[tid] = s * expf(cumf[tid] + m_in - mtv[tid]); }
                __syncthreads();
                f32x4 h2[1][4]; zero_acc(h2);
                mma_lds<1, 4>(h2, SC + wave * 16 * SB, SB, VT, SB, wave / 2 + 1, lane);
                if (tid < 128) { float s = 0.f; for (int k = 0; k <= tid; ++k) s += (float)SC[tid * SB + k]; dn[tid] += s; }
                __syncthreads();
#pragma unroll
                for (int q = 0; q < 4; ++q)
#pragma unroll
                    for (int i = 0; i < 4; ++i) {
                        const int l = wave * 16 + (lane >> 4) * 4 + i, v = q * 16 + (lane & 15);
                        const float num = h1[0][q][i] * expf(cumf[l] + m_in - mtv[l]) + h2[0][q][i];
                        const float den = fmaxf(fabsf(dn[l]), expf(-mtv[l]));
                        const int pi = c * 128 + l, pos = dir == 0 ? pi : Lseq - 1 - pi;
                        hout[(size_t)(rowbase + pos) * 384 + h * 64 + v] = (half_t)(num / den);
                    }
            }
            { const float sc = expf(tot + m_in - m_new);
#pragma unroll
              for (int q = 0; q < 2; ++q) accC[0][q] *= sc;
              mma_lds<1, 2>(accC, VW + (wave >> 1) * 16 * SB, SB, KT + (wave & 1) * 32 * SB, SB, 4, lane);
              if (tid < 64) { float s = 0.f; for (int k = 0; k < 128; ++k) s += ee[k] * (float)KT[tid * SB + k]; nvec[tid] = sc * nvec[tid] + s; } }
            m_in = m_new;
            __syncthreads();
#pragma unroll
            for (int q = 0; q < 2; ++q)
#pragma unroll
                for (int i = 0; i < 4; ++i) { const int v = (wave >> 1) * 16 + (lane >> 4) * 4 + i, d = (wave & 1) * 32 + q * 16 + (lane & 15); CS[v * SA + d] = (half_t)accC[0][q][i]; }
            __syncthreads();
        }
    }
}

__device__ __forceinline__ cplx cmul(cplx a, cplx b) { return cplx{a.x * b.x - a.y * b.y, a.x * b.y + a.y * b.x}; }
__device__ __forceinline__ cplx cmulc(cplx a, cplx b) { return cplx{a.x * b.x + a.y * b.y, a.y * b.x - a.x * b.y}; }
__device__ __forceinline__ void fft_fwd(cplx* buf, int N, const cplx* tw, int tid) {
    int n = N;
    int lg = 0; while ((1 << lg) < N) ++lg;
    if (lg & 1) { const int hf = n >> 1, st = TWN / n;
        for (int i = tid; i < hf; i += NT) { const cplx a = buf[i], b = buf[i + hf]; buf[i] = cplx{a.x + b.x, a.y + b.y}; buf[i + hf] = cmul(cplx{a.x - b.x, a.y - b.y}, tw[i * st]); }
        __syncthreads(); n = hf; }
    for (; n >= 4; n >>= 2) { const int q = n >> 2, st = TWN / n;
        for (int i = tid; i < N / 4; i += NT) {
            const int blk = i / q, j = i - blk * q, base = blk * n + j;
            const cplx a0 = buf[base], a1 = buf[base + q], a2 = buf[base + 2 * q], a3 = buf[base + 3 * q];
            const cplx t0{a0.x + a2.x, a0.y + a2.y}, t1{a0.x - a2.x, a0.y - a2.y}, t2{a1.x + a3.x, a1.y + a3.y}, t3{a1.x - a3.x, a1.y - a3.y};
            buf[base] = cplx{t0.x + t2.x, t0.y + t2.y};
            buf[base + q] = cmul(cplx{t1.x + t3.y, t1.y - t3.x}, tw[j * st]);
            buf[base + 2 * q] = cmul(cplx{t0.x - t2.x, t0.y - t2.y}, tw[2 * j * st]);
            buf[base + 3 * q] = cmul(cplx{t1.x - t3.y, t1.y + t3.x}, tw[3 * j * st]);
        }
        __syncthreads(); }
}
__device__ __forceinline__ void fft_inv(cplx* buf, int N, const cplx* tw, int tid) {
    int lg = 0; while ((1 << lg) < N) ++lg;
    const int nmax = (lg & 1) ? N / 2 : N;
    for (int n = 4; n <= nmax; n <<= 2) { const int q = n >> 2, st = TWN / n;
        for (int i = tid; i < N / 4; i += NT) {
            const int blk = i / q, j = i - blk * q, base = blk * n + j;
            const cplx u0 = buf[base], u1 = cmulc(buf[base + q], tw[j * st]), u2 = cmulc(buf[base + 2 * q], tw[2 * j * st]), u3 = cmulc(buf[base + 3 * q], tw[3 * j * st]);
            const cplx t0{u0.x + u2.x, u0.y + u2.y}, t1{u0.x - u2.x, u0.y - u2.y}, t2{u1.x + u3.x, u1.y + u3.y}, t3{u1.x - u3.x, u1.y - u3.y};
            buf[base] = cplx{t0.x + t2.x, t0.y + t2.y};
            buf[base + q] = cplx{t1.x - t3.y, t1.y + t3.x};
            buf[base + 2 * q] = cplx{t0.x - t2.x, t0.y - t2.y};
            buf[base + 3 * q] = cplx{t1.x + t3.y, t1.y - t3.x};
        }
        __syncthreads(); }
    if (lg & 1) { const int hf = N >> 1, st = TWN / N;
        for (int i = tid; i < hf; i += NT) { const cplx a = buf[i], b = cmulc(buf[i + hf], tw[i * st]); buf[i] = cplx{a.x + b.x, a.y + b.y}; buf[i + hf] = cplx{a.x - b.x, a.y - b.y}; }
        __syncthreads(); }
}
__device__ __forceinline__ float hy_conv1(const half_t* p, int t, int L, float w0, float w1, float w2, float bsv) {
    const float m = (float)p[t], l = t > 0 ? (float)p[t - 1] : 0.f, r = t + 1 < L ? (float)p[t + 1] : 0.f;
    return w0 * l + w1 * m + w2 * r + bsv;
}
__device__ __forceinline__ void hyena_channel(const Frame& F, int layer, int c) {
    cplx* bufA = (cplx*)F.smem;
    cplx* bufH = bufA + 2 * SEQ;
    float* red = (float*)(bufH + 2 * SEQ);
    const cplx* tw = (const cplx*)(F.ws + WS_TW);
    const int tid = F.tid;
    const float* cwp = F.in(I_HCW) + layer * 3 * 768; const float* cbp = F.in(I_HCB) + layer * 768;
    for (int seg = 0; seg < (layer == 0 ? 2 : 1); ++seg) {
        const int L = seg == 0 ? SEQ : CTXL, N = 2 * L;
        const half_t* hyt = (const half_t*)(F.ws + WS_HYT) + (seg == 0 ? 0 : (size_t)NB * 768 * SEQ);
        float* z1 = (float*)(F.ws + WS_XN) + (seg == 0 ? 0 : (size_t)NB * 256 * SEQ);
        float* yht = (float*)(F.ws + WS_YHT) + (seg == 0 ? 0 : (size_t)NB * 256 * SEQ);
        const float* ft = (const float*)(F.ws + WS_FT) + (seg == 0 ? (size_t)layer * 256 * 4 * SEQ : (size_t)2 * 256 * 4 * SEQ);
        for (int order = 0; order < 2; ++order) {
            const float* hfw = ft + ((size_t)(c * 2 + order) * 2 + 0) * L; const float* hbw = ft + ((size_t)(c * 2 + order) * 2 + 1) * L;
            float asum = 0.f;
            for (int i = tid; i < N; i += NT) { const float v = i < L ? hfw[i] : (i == L ? 0.f : hbw[N - i]); bufH[i] = cplx{v, 0.f}; asum += fabsf(v); }
            asum = wave_sum(asum);
            if (F.lane == 0) red[F.wave] = asum;
            __syncthreads();
            float tot = 0.f; for (int w = 0; w < NT / 64; ++w) tot += red[w];
            const float scale = 1.0f / (tot * (float)N);
            fft_fwd(bufH, N, tw, tid);
            const int gch = 256 * (order + 1) + c;
            const float gw0 = cwp[gch], gw1 = cwp[768 + gch], gw2 = cwp[1536 + gch], gb = cbp[gch];
            const float vw0 = cwp[c], vw1 = cwp[768 + c], vw2 = cwp[1536 + c], vb = cbp[c];
            const float skip = F.in(I_HSKIP)[(layer * 2 + order) * 256 + c];
            for (int pr = 0; pr < NB / 2; ++pr) {
                const int b0 = 2 * pr, b1 = b0 + 1;
                const half_t* v0p = hyt + ((size_t)b0 * 768 + c) * L; const half_t* v1p = hyt + ((size_t)b1 * 768 + c) * L;
                for (int i = tid; i < N; i += NT) {
                    cplx z{0.f, 0.f};
                    if (i < L) { if (order == 0) { z.x = hy_conv1(v0p, i, L, vw0, vw1, vw2, vb); z.y = hy_conv1(v1p, i, L, vw0, vw1, vw2, vb); }
                                 else { z.x = z1[((size_t)b0 * 256 + c) * L + i]; z.y = z1[((size_t)b1 * 256 + c) * L + i]; } }
                    bufA[i] = z;
                }
                __syncthreads();
                fft_fwd(bufA, N, tw, tid);
                for (int i = tid; i < N; i += NT) { cplx p = cmul(bufA[i], bufH[i]); bufA[i] = cplx{p.x * scale, p.y * scale}; }
                __syncthreads();
                fft_inv(bufA, N, tw, tid);
                const half_t* g0p = hyt + ((size_t)b0 * 768 + gch) * L; const half_t* g1p = hyt + ((size_t)b1 * 768 + gch) * L;
                for (int i = tid; i < L; i += NT) {
                    float za, zb;
                    if (order == 0) { za = hy_conv1(v0p, i, L, vw0, vw1, vw2, vb); zb = hy_conv1(v1p, i, L, vw0, vw1, vw2, vb); }
                    else { za = z1[((size_t)b0 * 256 + c) * L + i]; zb = z1[((size_t)b1 * 256 + c) * L + i]; }
                    const float ga = hy_conv1(g0p, i, L, gw0, gw1, gw2, gb), gb_ = hy_conv1(g1p, i, L, gw0, gw1, gw2, gb);
                    const cplx y = bufA[i];
                    const float oa = ga * (y.x + skip * za), ob = gb_ * (y.y + skip * zb);
                    float* dst = order == 0 ? z1 : yht;
                    dst[((size_t)b0 * 256 + c) * L + i] = oa; dst[((size_t)b1 * 256 + c) * L + i] = ob;
                }
                __syncthreads();
            }
        }
    }
}
#ifndef MIX
#define MIX -1
#endif
#define MIXEN(x) (MIX < 0 || MIX == (x))
__device__ __forceinline__ void phase_mixers(const Frame& F, int layer) {
    const int G = gridDim.x, bid = blockIdx.x;
    constexpr int NSCAN = 2 * NB * 6 * 2;
    if (bid < NSCAN) {
        const int k = bid >> 1, kind = bid & 1, dir = k % 2, h = (k / 2) % 6, b = k / 12;
        if (kind == 0) { if (MIXEN(1)) ssd_block(F, layer, b, h, dir); } else { if (MIXEN(2)) mlstm_block(F, layer, b, h, dir); }
    } else {
        for (int c = bid - NSCAN; c < 256; c += G - NSCAN) if (MIXEN(3)) hyena_channel(F, layer, c);
    }
}

__device__ __forceinline__ void phase_combine(const Frame& F, int layer) {
    const int nrows = layer == 0 ? TT : TL, total = nrows / 32;
    const half_t* u16 = (const half_t*)(F.ws + WS_U16);
    const half_t* yf = (const half_t*)(F.ws + WS_YF); const half_t* yb = yf + (size_t)TT * 384; const half_t* hf = yb + (size_t)TT * 384; const half_t* hb = hf + (size_t)TT * 384;
    half_t* yl = (half_t*)(F.ws + WS_XN);
    const float* snw = F.in(I_SNW) + layer * 384; const float* mnw = F.in(I_MNW) + layer * 384;
    for (int it = blockIdx.x; it < total; it += gridDim.x) {
        const int row0 = it * 32;
        for (int rr = F.wave; rr < 32; rr += NT / 64) {
            const int row = row0 + rr;
            float g[6]; float ss = 0.f;
#pragma unroll
            for (int i = 0; i < 6; ++i) { const int k = i * 64 + F.lane; const float y = (float)yf[(size_t)row * 384 + k] + (float)yb[(size_t)row * 384 + k];
                g[i] = y * siluf((float)u16[(size_t)row * UW + k]); ss += g[i] * g[i]; }
            ss = wave_sum(ss);
            const float rs = 1.0f / sqrtf(ss * (1.0f / 384.f) + EPSF);
#pragma unroll
            for (int i = 0; i < 6; ++i) { const int k = i * 64 + F.lane; yl[(size_t)row * D + k] = (half_t)(g[i] * rs * snw[k]); }
#pragma unroll
            for (int i = 0; i < 6; ++i) { const int k = i * 64 + F.lane; const float hv = (float)hf[(size_t)row * 384 + k] + (float)hb[(size_t)row * 384 + k];
                const float mu = wave_sum(hv) * (1.0f / 64.f); const float hc = hv - mu; const float var = wave_sum(hc * hc) * (1.0f / 64.f);
                const float hn = hc * (1.0f / sqrtf(var + EPSF)) * mnw[k];
                yl[(size_t)row * D + 640 + k] = (half_t)(sigmoidf_((float)u16[(size_t)row * UW + 2176 + k]) * hn); }
        }
        { const bool isl = row0 < TL; const int L = isl ? SEQ : CTXL; const int rc = isl ? row0 : row0 - TL; const int b = rc / L, t0 = rc % L;
          const float* yht = (const float*)(F.ws + WS_YHT) + (isl ? 0 : (size_t)NB * 256 * SEQ);
          if (F.tid < 256) { const int c = F.tid; const float* src = yht + ((size_t)b * 256 + c) * L + t0;
              for (int i = 0; i < 32; ++i) yl[(size_t)(row0 + i) * D + 384 + c] = (half_t)src[i]; } }
    }
}

__device__ __forceinline__ void phase_outproj(const Frame& F, int layer) {
    const half_t* yl = (const half_t*)(F.ws + WS_XN);
    const half_t* wt = (const half_t*)(F.ws + WS_WOUT) + (size_t)layer * D * D;
    const int nrows = layer == 0 ? TT : TL, total = (nrows / 128) * 8;
    const int lr = F.tid >> 2, lc = (F.tid & 3) * 8, wm = F.wave >> 1, wn = F.wave & 1;
    for (int it = blockIdx.x; it < total; it += gridDim.x) {
        const int m0 = (it / 8) * 128, n0 = (it % 8) * 128;
        f32x4 acc[2][4]; zero_acc(acc);
        gemm128(yl + (size_t)(m0 + lr) * D + lc, wt + (size_t)(n0 + lr) * D + lc, D, acc, (half_t*)F.smem, F.tid);
#pragma unroll
        for (int a = 0; a < 2; ++a)
#pragma unroll
            for (int i = 0; i < 4; ++i) {
                const int srow = m0 + wm * 32 + a * 16 + (F.lane >> 4) * 4 + i;
                int row = srow;
                if (layer == 1 && srow < TL) { const int b = srow / SEQ, s = srow % SEQ; row = b * SEQ + (s % GROWS) * GW + s / GROWS; }
                const float* g1 = modp(F, layer, row_mod(row), 2);
                const float* xi = F.xrow_in(layer, row); float* xo = F.xrow(row);
#pragma unroll
                for (int b = 0; b < 4; ++b) { const int n = n0 + wn * 64 + b * 16 + (F.lane & 15); xo[n] = xi[n] + g1[n] * acc[a][b][i]; }
            }
    }
}

__device__ __forceinline__ void phase_router(const Frame& F, int layer) {
    const int nrows = layer == 0 ? TT : TL, total = nrows / 16;
    float* T = (float*)F.smem;
    float* LG = T + 16 * D;
    half_t* tb = (half_t*)(F.ws + WS_XN);
    unsigned* cnt = (unsigned*)(F.ws + WS_CTL) + CW_CNT + layer * 64;
    int* list = (int*)(F.ws + WS_LIST); float* pw = (float*)(F.ws + WS_PW);
    const float* nw = F.in(I_N2W) + layer * D;
    const float* gw = F.in(I_GRW) + (size_t)layer * D * 4; const float* ew = F.in(I_ERW) + (size_t)layer * D * 32;
    for (int it = blockIdx.x; it < total; it += gridDim.x) {
        const int row0 = it * 16;
        for (int rr = F.wave; rr < 16; rr += NT / 64) {
            const int row = row0 + rr, m = row_mod(row);
            const float* x = F.xrow(row);
            float v[16]; float ss = 0.f;
#pragma unroll
            for (int q = 0; q < 4; ++q) { const f32x4 t = *(const f32x4*)(x + q * 256 + F.lane * 4); v[q * 4 + 0] = t[0]; v[q * 4 + 1] = t[1]; v[q * 4 + 2] = t[2]; v[q * 4 + 3] = t[3]; ss += t[0] * t[0] + t[1] * t[1] + t[2] * t[2] + t[3] * t[3]; }
            ss = wave_sum(ss);
            const float rs = 1.0f / sqrtf(ss * (1.0f / D) + EPSF);
            const float* sh = modp(F, layer, m, 3); const float* scl = modp(F, layer, m, 4);
#pragma unroll
            for (int q = 0; q < 4; ++q) { const int k = q * 256 + F.lane * 4; half4 h;
#pragma unroll
                for (int e = 0; e < 4; ++e) { const float tv = v[q * 4 + e] * rs * nw[k + e] * (1.0f + scl[k + e]) + sh[k + e]; T[rr * D + k + e] = tv; h[e] = (half_t)tv; }
                *(half4*)(tb + (size_t)row * D + k) = h; }
        }
        __syncthreads();
        for (int o = F.tid; o < 16 * 36; o += NT) {
            const int r = o / 36, col = o % 36;
            float s = 0.f;
            if (col < 4) { for (int k = 0; k < D; ++k) s += T[r * D + k] * gw[k * 4 + col]; s += F.in(I_GRB)[layer * 4 + col]; }
            else { const int e = col - 4; for (int k = 0; k < D; ++k) s += T[r * D + k] * ew[k * 32 + e]; s += F.in(I_ERB)[layer * 32 + e]; }
            LG[o] = s;
        }
        __syncthreads();
        if (F.tid < 16) {
            const int row = row0 + F.tid; const float* lg = LG + F.tid * 36;
            int gi = 0; float gm = lg[0];
            for (int q = 1; q < 4; ++q) if (lg[q] > gm) { gm = lg[q]; gi = q; }
            float gs = 0.f; for (int q = 0; q < 4; ++q) gs += expf(lg[q] - gm);
            const float grp_p = 1.0f / gs;
            const float* el = lg + 4 + gi * 8;
            int i0 = 0; float e0 = el[0];
            for (int q = 1; q < 8; ++q) if (el[q] > e0) { e0 = el[q]; i0 = q; }
            int i1 = -1; float e1 = -3.0e38f;
            for (int q = 0; q < 8; ++q) if (q != i0 && el[q] > e1) { e1 = el[q]; i1 = q; }
            const float p1 = expf(e1 - e0);
            const float w0 = grp_p * (1.0f / (1.0f + p1)), w1 = grp_p * (p1 / (1.0f + p1));
            const int ea = gi * 8 + i0, eb = gi * 8 + i1;
            const unsigned pa = atomicAdd(&cnt[ea * 2 + 0], 1u), pb = atomicAdd(&cnt[eb * 2 + 1], 1u);
            list[(size_t)(ea * 2 + 0) * LCAP + pa] = row * 2 + 0; list[(size_t)(eb * 2 + 1) * LCAP + pb] = row * 2 + 1;
            pw[row * 2 + 0] = w0; pw[row * 2 + 1] = w1;
        }
        __syncthreads();
    }
}

__device__ __forceinline__ int find_list(const int* pre, int t) { int l = 0; while (t >= pre[l + 1]) ++l; return l; }
__device__ __forceinline__ void phase_moe_a(const Frame& F, int layer) {
    half_t* gl = (half_t*)F.smem;
    int* pre = (int*)(F.smem + 40960);
    int* rows = pre + 66;
    const unsigned* cnt = (const unsigned*)(F.ws + WS_CTL) + CW_CNT + layer * 64;
    const int* list = (const int*)(F.ws + WS_LIST); const float* pw = (const float*)(F.ws + WS_PW);
    const half_t* tb = (const half_t*)(F.ws + WS_XN); half_t* hid = (half_t*)(F.ws + WS_U16);
    const half_t* wmoe = (const half_t*)(F.ws + WS_WMOE);
    if (F.tid == 0) { int s = 0; for (int l = 0; l < 64; ++l) { pre[l] = s; s += ((int)cnt[l] + 127) / 128; } pre[64] = s; }
    __syncthreads();
    const int total = pre[64] * 4;
    const int lr = F.tid >> 2, lc = (F.tid & 3) * 8, wm = F.wave >> 1, wn = F.wave & 1;
    for (int it = blockIdx.x; it < total; it += gridDim.x) {
        const int tile = it >> 2, fc = it & 3, l = find_list(pre, tile), e = l >> 1, r0 = (tile - pre[l]) * 128, n = (int)cnt[l];
        if (F.tid < 128) { const int r = r0 + F.tid; rows[F.tid] = list[(size_t)l * LCAP + (r < n ? r : r0)]; }
        __syncthreads();
        const int prow = rows[lr] >> 1;
        const int f = fc * 64 + (lr >> 6) * 32 + (((lr >> 4) & 3) & 1) * 16 + (lr & 15), isup = ((lr >> 4) & 3) >> 1;
        f32x4 acc[2][4]; zero_acc(acc);
        gemm128(tb + (size_t)prow * D + lc, wmoe + (size_t)e * 3 * 262144 + (size_t)isup * 262144 + (size_t)f * D + lc, D, acc, gl, F.tid);
#pragma unroll
        for (int a = 0; a < 2; ++a)
#pragma unroll
            for (int i = 0; i < 4; ++i) {
                const int rt = wm * 32 + a * 16 + (F.lane >> 4) * 4 + i;
                if (r0 + rt < n) { const int pid = rows[rt]; const float w = pw[pid];
#pragma unroll
                    for (int q = 0; q < 2; ++q) { const int ff = fc * 64 + wn * 32 + q * 16 + (F.lane & 15);
                        hid[(size_t)pid * 256 + ff] = (half_t)(siluf(acc[a][q][i]) * acc[a][q + 2][i] * w); } }
            }
        __syncthreads();
    }
}
__device__ __forceinline__ void phase_moe_b(const Frame& F, int layer, int slot) {
    half_t* gl = (half_t*)F.smem;
    int* pre = (int*)(F.smem + 40960);
    int* rows = pre + 34;
    const unsigned* cnt = (const unsigned*)(F.ws + WS_CTL) + CW_CNT + layer * 64;
    const int* list = (const int*)(F.ws + WS_LIST);
    const half_t* hid = (const half_t*)(F.ws + WS_U16);
    const half_t* wmoe = (const half_t*)(F.ws + WS_WMOE);
    if (F.tid == 0) { int s = 0; for (int e = 0; e < 32; ++e) { pre[e] = s; s += ((int)cnt[e * 2 + slot] + 127) / 128; } pre[32] = s; }
    __syncthreads();
    const int total = pre[32] * 8;
    const int lr = F.tid >> 2, lc = (F.tid & 3) * 8, wm = F.wave >> 1, wn = F.wave & 1;
    for (int it = blockIdx.x; it < total; it += gridDim.x) {
        const int tile = it >> 3, dc = it & 7, e = find_list(pre, tile), l = e * 2 + slot, r0 = (tile - pre[e]) * 128, n = (int)cnt[l];
        if (F.tid < 128) { const int r = r0 + F.tid; rows[F.tid] = list[(size_t)l * LCAP + (r < n ? r : r0)]; }
        __syncthreads();
        const int pid_l = rows[lr];
        f32x4 acc[2][4]; zero_acc(acc);
        gemm128(hid + (size_t)pid_l * 256 + lc, wmoe + (size_t)e * 3 * 262144 + 2 * 262144 + (size_t)(dc * 128 + lr) * 256 + lc, 256, acc, gl, F.tid);
#pragma unroll
        for (int a = 0; a < 2; ++a)
#pragma unroll
            for (int i = 0; i < 4; ++i) {
                const int rt = wm * 32 + a * 16 + (F.lane >> 4) * 4 + i;
                if (r0 + rt < n) { const int row = rows[rt] >> 1; float* xo = F.xrow(row); const float* g5 = modp(F, layer, row_mod(row), 5);
#pragma unroll
                    for (int q = 0; q < 4; ++q) { const int d = dc * 128 + wn * 64 + q * 16 + (F.lane & 15); xo[d] += g5[d] * acc[a][q][i]; } }
            }
        __syncthreads();
    }
}

__device__ __forceinline__ void phase_final(const Frame& F) {
    const float* fw = F.in(I_FNW);
    for (int it = blockIdx.x; it < TL / 16; it += gridDim.x) {
        for (int rr = F.wave; rr < 16; rr += NT / 64) {
            float* x = F.P.out + (size_t)(it * 16 + rr) * D;
            f32x4 v[4]; float ss = 0.f;
#pragma unroll
            for (int q = 0; q < 4; ++q) { v[q] = *(const f32x4*)(x + q * 256 + F.lane * 4); ss += v[q][0] * v[q][0] + v[q][1] * v[q][1] + v[q][2] * v[q][2] + v[q][3] * v[q][3]; }
            ss = wave_sum(ss);
            const float rs = 1.0f / sqrtf(ss * (1.0f / D) + EPSF);
#pragma unroll
            for (int q = 0; q < 4; ++q) { const int k = q * 256 + F.lane * 4; f32x4 o;
#pragma unroll
                for (int e = 0; e < 4; ++e) o[e] = v[q][e] * rs * fw[k + e];
                *(f32x4*)(x + k) = o; }
        }
    }
}

constexpr int NPHASE = 1 + 2 * 9 + 1;
#ifndef ONLY
#define ONLY -1
#endif
#define EN(x) (ONLY < 0 || ONLY == (x))
__device__ __forceinline__ void run_phase(const Frame& F, int ph) {
    if (ph == 0) { if (EN(0)) phase_setup(F); return; }
    if (ph == NPHASE - 1) { if (EN(10)) phase_final(F); return; }
    const int layer = (ph - 1) / 9, k = (ph - 1) % 9;
    switch (k) {
        case 0: if (EN(1)) phase_norm1(F, layer); break;
        case 1: if (EN(2)) phase_inproj(F, layer); break;
        case 2: if (EN(3)) phase_mixers(F, layer); break;
        case 3: if (EN(4)) phase_combine(F, layer); break;
        case 4: if (EN(5)) phase_outproj(F, layer); break;
        case 5: if (EN(6)) phase_router(F, layer); break;
        case 6: if (EN(7)) phase_moe_a(F, layer); break;
        case 7: if (EN(8)) phase_moe_b(F, layer, 0); break;
        default: if (EN(9)) phase_moe_b(F, layer, 1); break;
    }
}

#ifdef EMU
void mega(const Params* Pp) {
    Frame F; F.P = *Pp; F.ws = Pp->ws; F.smem = emu_blk->smem; F.tid = threadIdx.x; F.lane = F.tid & 63; F.wave = F.tid >> 6;
    for (int ph = Pp->ph_lo; ph < Pp->ph_hi; ++ph) { run_phase(F, ph); __syncthreads(); }
}
#else
__global__ void __launch_bounds__(NT) mega(Params P) {
    extern __shared__ __attribute__((aligned(16))) unsigned char smem_dyn[];
    cg::grid_group grid = cg::this_grid();
    Frame F; F.P = P; F.ws = P.ws; F.smem = smem_dyn; F.tid = threadIdx.x; F.lane = F.tid & 63; F.wave = F.tid >> 6;
#define PHASE_STEP(i) if (P.ph_lo <= (i) && (i) < P.ph_hi) { run_phase(F, (i)); if ((i) + 1 < P.ph_hi) grid.sync(); }
    PHASE_STEP(0) PHASE_STEP(1) PHASE_STEP(2) PHASE_STEP(3) PHASE_STEP(4) PHASE_STEP(5) PHASE_STEP(6) PHASE_STEP(7) PHASE_STEP(8) PHASE_STEP(9)
    PHASE_STEP(10) PHASE_STEP(11) PHASE_STEP(12) PHASE_STEP(13) PHASE_STEP(14) PHASE_STEP(15) PHASE_STEP(16) PHASE_STEP(17) PHASE_STEP(18) PHASE_STEP(19)
    static_assert(NPHASE == 20, "phase list");
}

extern "C" void kernel_launch(void* const* d_in, const int* in_sizes, int n_in, void* d_out, int out_size, void* d_ws, size_t ws_size, hipStream_t stream) {
    static int grid_blocks = 0;
    if (grid_blocks == 0) {
        if (n_in != 38 || out_size != TL * D || ws_size < WS_END) { fprintf(stderr, "kernel_launch: unexpected shapes (n_in %d out %d ws %zu need %zu)\n", n_in, out_size, ws_size, (size_t)WS_END); grid_blocks = -1; return; }
        int dev = 0, cus = 0, per_cu = 0;
        hipGetDevice(&dev);
        hipDeviceGetAttribute(&cus, hipDeviceAttributeMultiprocessorCount, dev);
        hipFuncSetAttribute((const void*)mega, hipFuncAttributeMaxDynamicSharedMemorySize, LDS_BYTES);
        hipOccupancyMaxActiveBlocksPerMultiprocessor(&per_cu, (const void*)mega, NT, LDS_BYTES);
        if (per_cu < 1) { fprintf(stderr, "kernel_launch: occupancy query says 0 blocks per CU\n"); grid_blocks = -1; return; }
        grid_blocks = cus;
    }
    if (grid_blocks < 0) return;
    Params p{};
    for (int i = 0; i < 38; ++i) p.in[i] = (const float*)d_in[i];
    p.out = (float*)d_out; p.ws = (unsigned char*)d_ws; p.ph_lo = 0; p.ph_hi = NPHASE;
    void* args[] = {&p};
    hipError_t e = hipLaunchCooperativeKernel((const void*)mega, dim3(grid_blocks), dim3(NT), args, LDS_BYTES, stream);
    if (e != hipSuccess) fprintf(stderr, "cooperative launch failed: %s (grid %d)\n", hipGetErrorString(e), grid_blocks);
}
#endif
```

```cpp
#ifdef EMU
#include "gpuemu.h"
#else
#include <hip/hip_runtime.h>
#include <hip/hip_cooperative_groups.h>
#include <cstdio>
namespace cg = cooperative_groups;
#endif
#include <stdint.h>

#ifndef CFG_B
#define CFG_B 4
#endif
#ifndef CFG_SEQ
#define CFG_SEQ 4096
#endif
#ifndef CFG_CTX
#define CFG_CTX 256
#endif

typedef _Float16 half_t;
typedef _Float16 half8 __attribute__((ext_vector_type(8)));
typedef _Float16 half4 __attribute__((ext_vector_type(4)));
typedef float f32x4 __attribute__((ext_vector_type(4)));
struct cplx { float x, y; };

constexpr int D = 1024, NB = CFG_B, SEQ = CFG_SEQ, CTXL = CFG_CTX, GW = 64, GROWS = SEQ / GW;
constexpr int TL = NB * SEQ, TC = NB * CTXL, TT = TL + TC;
constexpr int NIN = 3364, NINP = 3584;
constexpr int UW = 2560;
constexpr int UGW = 36;
constexpr int NT = 512;
constexpr int TWN = 2 * SEQ > 2 * CTXL ? 2 * SEQ : 2 * CTXL;
constexpr int NMOD = 6 * D;
constexpr int LCAP = TT;
constexpr float EPSF = 1e-6f;

constexpr size_t al256(size_t x) { return (x + 255) / 256 * 256; }
constexpr size_t WS_CTL    = 0;
constexpr size_t WS_MOD    = 32768;
constexpr size_t WS_TW     = WS_MOD + al256(sizeof(float) * 2 * 5 * NMOD);
constexpr size_t WS_WIN    = WS_TW + al256(sizeof(cplx) * TWN);
constexpr size_t WS_WOUT   = WS_WIN + al256(2ull * 2 * NINP * D);
constexpr size_t WS_WMOE   = WS_WOUT + al256(2ull * 2 * D * D);
constexpr size_t WS_XC     = WS_WMOE + al256(2ull * 32 * 3 * 262144);
constexpr size_t WS_XN     = WS_XC + al256(4ull * TC * D);
constexpr size_t WS_U16    = WS_XN + al256(2ull * TT * D);
constexpr size_t WS_UG     = WS_U16 + al256(2ull * TT * UW);
constexpr size_t WS_HYT    = WS_UG + al256(4ull * TT * UGW);
constexpr size_t WS_YF     = WS_HYT + al256(2ull * NB * 768 * (SEQ + CTXL));
constexpr size_t WS_YHT    = WS_YF + al256(2ull * 4 * TT * 384);
constexpr size_t WS_FT     = WS_YHT + al256(4ull * NB * 256 * (SEQ + CTXL));
constexpr size_t WS_LIST   = WS_FT + al256(4ull * (2 * 256 * 4 * SEQ + 256 * 4 * CTXL));
constexpr size_t WS_PW     = WS_LIST + al256(4ull * 64 * LCAP);
constexpr size_t WS_WR     = WS_PW + al256(4ull * TT * 2);
constexpr size_t WS_END    = WS_WR + al256(2ull * 2 * 2 * 48 * D);
static_assert(4ull * NB * 256 * (SEQ + CTXL) <= 2ull * TT * D, "Z1 scratch must fit in the XN region");
static_assert(2ull * TT * 2 * 256 <= 2ull * TT * UW, "HID must fit in the U16 region");

constexpr int CW_CNT = 0;
constexpr int CW_BAR = 1024;
constexpr size_t CTL_BYTES = 32768;

constexpr int LDS_BYTES = 156 * 1024;

struct Params {
    const float* in[38];
    float* out;
    unsigned char* ws;
    int ph_lo, ph_hi;
};

enum { I_X = 0, I_C, I_CTX, I_CCTX, I_WMOD, I_BMOD, I_N1W, I_N2W, I_WIN, I_WOUT, I_SCW, I_SCB, I_DTB, I_ALOG, I_SD, I_SNW,
       I_HCW, I_HCB, I_HW1, I_HB1, I_HW2, I_HB2, I_HW3, I_HFREQ, I_HDEC, I_HSKIP, I_MCW, I_MCB, I_MGB, I_MNW,
       I_GRW, I_GRB, I_ERW, I_ERB, I_MG, I_MU, I_MD, I_FNW };

__device__ __forceinline__ float siluf(float x) { return x / (1.0f + expf(-x)); }
__device__ __forceinline__ float sigmoidf_(float x) { return 1.0f / (1.0f + expf(-x)); }
__device__ __forceinline__ float softplusf_(float x) { return x > 20.f ? x : log1pf(expf(x)); }
__device__ __forceinline__ float logsigmoidf_(float x) { return fminf(x, 0.f) - log1pf(expf(-fabsf(x))); }

__device__ __forceinline__ float wave_sum(float v) {
#pragma unroll
    for (int m = 32; m >= 1; m >>= 1) v += __shfl_xor(v, m);
    return v;
}
__device__ __forceinline__ float wave_max(float v) {
#pragma unroll
    for (int m = 32; m >= 1; m >>= 1) v = fmaxf(v, __shfl_xor(v, m));
    return v;
}
__device__ __forceinline__ float wave_scan_sum(float v, int lane) {
#pragma unroll
    for (int d = 1; d < 64; d <<= 1) { float o = __shfl_up(v, d); if (lane >= d) v += o; }
    return v;
}
__device__ __forceinline__ float wave_scan_max(float v, int lane) {
#pragma unroll
    for (int d = 1; d < 64; d <<= 1) { float o = __shfl_up(v, d); if (lane >= d) v = fmaxf(v, o); }
    return v;
}

template <int MT, int NTL>
__device__ __forceinline__ void mma_lds(f32x4 (&acc)[MT][NTL], const half_t* A, int lda, const half_t* B, int ldb, int ksteps, int lane) {
#ifndef EMU
    const int r = lane & 15, kq = (lane >> 4) * 8;
    for (int ks = 0; ks < ksteps; ++ks) {
        half8 a[MT], b[NTL];
#pragma unroll
        for (int mt = 0; mt < MT; ++mt) a[mt] = *(const half8*)(A + (mt * 16 + r) * lda + ks * 32 + kq);
#pragma unroll
        for (int nt = 0; nt < NTL; ++nt) b[nt] = *(const half8*)(B + (nt * 16 + r) * ldb + ks * 32 + kq);
#pragma unroll
        for (int mt = 0; mt < MT; ++mt)
#pragma unroll
            for (int nt = 0; nt < NTL; ++nt) acc[mt][nt] = __builtin_amdgcn_mfma_f32_16x16x32_f16(a[mt], b[nt], acc[mt][nt], 0, 0, 0);
    }
#else
    for (int mt = 0; mt < MT; ++mt) for (int nt = 0; nt < NTL; ++nt) for (int i = 0; i < 4; ++i) {
        const int row = mt * 16 + (lane >> 4) * 4 + i, col = nt * 16 + (lane & 15);
        float s = acc[mt][nt][i];
        for (int k = 0; k < ksteps * 32; ++k) s += (float)A[row * lda + k] * (float)B[col * ldb + k];
        acc[mt][nt][i] = s;
    }
#endif
}

__device__ __forceinline__ f32x4 mfma16(half8 a, half8 b, f32x4 c) {
#ifdef EMU
    return emu_mfma16(a, b, c);
#else
    return __builtin_amdgcn_mfma_f32_16x16x32_f16(a, b, c, 0, 0, 0);
#endif
}
template <int MT, int NTL> __device__ __forceinline__ void zero_acc(f32x4 (&acc)[MT][NTL]) {
#pragma unroll
    for (int mt = 0; mt < MT; ++mt)
#pragma unroll
        for (int nt = 0; nt < NTL; ++nt) acc[mt][nt] = (f32x4){0.f, 0.f, 0.f, 0.f};
}

__device__ __forceinline__ half4 to_half4(const f32x4 v) { half4 h; h[0] = (half_t)v[0]; h[1] = (half_t)v[1]; h[2] = (half_t)v[2]; h[3] = (half_t)v[3]; return h; }
namespace g8 {
constexpr int BM = 256, BK = 64, HALF = 128, HTB = HALF * BK * 2, STAGE_BYTES = 8 * HTB;
__device__ __forceinline__ int lds_byte(int r, int c) { const int st = (r >> 4) * 2 + (c >> 5), rr = r & 15, cc = c & 31, ob = rr * 64 + cc * 2; return st * 1024 + (ob ^ (((ob >> 9) & 1) << 5)); }
__device__ __forceinline__ void stage_rc(int b, int& R, int& C) { const int st = b / 1024, sb = b % 1024, swz = sb ^ (((sb >> 9) & 1) << 5); R = (st >> 1) * 16 + swz / 64; C = (st & 1) * 32 + (swz % 64) / 2; }
struct Unit { int pm, pn, e, n; };

struct DenseSched {
    const char* abase; const char* bbase; int K, nM, nN, G, c;
    __device__ __forceinline__ bool next(int i, Unit& u) const {
        const int nwg = nM * nN; const long L = (long)i * G + c; if (L >= nwg) return false;
        int wgid = (int)L; { const int q = nwg / 8, r = nwg % 8, xcd = wgid % 8, off = wgid / 8; wgid = (xcd < r ? xcd * (q + 1) : r * (q + 1) + (xcd - r) * q) + off; }
        const int nig = 8 * nN, gid = wgid / nig, fm = gid * 8, gsz = (nM - fm) < 8 ? (nM - fm) : 8;
        u.pm = fm + ((wgid % nig) % gsz); u.pn = (wgid % nig) / gsz; u.e = 0; u.n = 0; return true;
    }
    __device__ __forceinline__ unsigned a_off(const Unit& u, int r) const { return (unsigned)((size_t)(u.pm * 256 + r) * K * 2); }
    __device__ __forceinline__ const char* b_half(const Unit& u, int h) const { return bbase + (size_t)(u.pn * 256 + h * 128) * K * 2; }
};

template <class Epi, class Sched>
__device__ __forceinline__ void gemm_phase(unsigned char* smem, const int K, const Sched& S, const Epi& E) {
    const int tid = threadIdx.x, lane = tid & 63;
#ifdef EMU
    const int wid = tid >> 6, wr = wid >> 2, wc = wid & 3, fr = lane & 15, fq = lane >> 4;
    half_t* As = (half_t*)smem; half_t* Bs = As + 256 * 72;
    Unit cur;
    for (int ui = 0; S.next(ui, cur); ++ui) {
        f32x4 acc[2][2][4][2];
        for (int a = 0; a < 2; ++a) for (int b = 0; b < 2; ++b) for (int m = 0; m < 4; ++m) for (int n = 0; n < 2; ++n) acc[a][b][m][n] = (f32x4){0.f, 0.f, 0.f, 0.f};
        for (int kt = 0; kt < K / 64; ++kt) {
            { const int row = tid >> 1, c0 = (tid & 1) * 32;
              const half_t* sa = (const half_t*)(S.abase + S.a_off(cur, row)) + kt * 64 + c0;
              const half_t* sb = (const half_t*)(S.b_half(cur, row >> 7)) + (size_t)(row & 127) * K + kt * 64 + c0;
              for (int q = 0; q < 32; ++q) { As[row * 72 + c0 + q] = sa[q]; Bs[row * 72 + c0 + q] = sb[q]; } }
            __syncthreads();
            for (int a = 0; a < 2; ++a) for (int b = 0; b < 2; ++b) for (int m = 0; m < 4; ++m) for (int n = 0; n < 2; ++n) for (int i = 0; i < 4; ++i) {
                const int row = 128 * a + 64 * wr + 16 * m + fr, col = 128 * b + 32 * wc + 16 * n + 4 * fq + i; float s = acc[a][b][m][n][i];
                for (int k = 0; k < 64; ++k) s += (float)As[row * 72 + k] * (float)Bs[col * 72 + k];
                acc[a][b][m][n][i] = s; }
            __syncthreads();
        }
        E(acc, cur, wr, wc, fr, fq);
    }
#else
    typedef __attribute__((address_space(3))) unsigned char* ldsp_t;
    const ldsp_t lds = (ldsp_t)smem;
    const int wid = __builtin_amdgcn_readfirstlane(tid >> 6), wr = wid >> 2, wc = wid & 3, fr = lane & 15, fq = lane >> 4;
    const int nt = K / BK;
    int Rr[2], Cc[2]; unsigned voffB[2];
#pragma unroll
    for (int i = 0; i < 2; ++i) { stage_rc(tid * 16 + i * 8192, Rr[i], Cc[i]); voffB[i] = (unsigned)(Rr[i] * K + Cc[i]) * 2u; }
    const size_t kstep = (size_t)(BK * 2);
    const unsigned ldsw = (unsigned)wid * 1024u;
    const int aoffl = lds_byte(wr * 64 + fr, fq * 8), boffl = lds_byte(wc * 32 + fr, fq * 8);
#define G8_SA(b, h) (((b) * 2 + (h)) * HTB)
#define G8_SB(b, h) ((4 + (b) * 2 + (h)) * HTB)
#define G8_STAGE(bufoff, gbase, voff) do { _Pragma("unroll") for (int _i = 0; _i < 2; ++_i) \
        __builtin_amdgcn_global_load_lds((const unsigned*)((const char*)(gbase) + (voff)[_i]), (__attribute__((address_space(3))) unsigned*)(lds + (bufoff) + ldsw + _i * 8192), 16, 0, 0); } while (0)
#define G8_LDA(dst, b, h) do { _Pragma("unroll") for (int m = 0; m < 4; ++m) _Pragma("unroll") for (int k = 0; k < 2; ++k) dst[m][k] = *(const __attribute__((address_space(3))) half8*)(lds + G8_SA(b, h) + aoffl + m * 2048 + k * 1024); } while (0)
#define G8_LDB(dst, b, h) do { _Pragma("unroll") for (int n = 0; n < 2; ++n) _Pragma("unroll") for (int k = 0; k < 2; ++k) dst[n][k] = *(const __attribute__((address_space(3))) half8*)(lds + G8_SB(b, h) + boffl + n * 2048 + k * 1024); } while (0)
#define G8_MMA(ai, bj, At, Bt) do { __builtin_amdgcn_s_setprio(1); _Pragma("unroll") for (int m = 0; m < 4; ++m) _Pragma("unroll") for (int n = 0; n < 2; ++n) _Pragma("unroll") for (int k = 0; k < 2; ++k) \
        acc[ai][bj][m][n] = __builtin_amdgcn_mfma_f32_16x16x32_f16(Bt[n][k], At[m][k], acc[ai][bj][m][n], 0, 0, 0); __builtin_amdgcn_s_setprio(0); } while (0)
#define G8_WAIT_V(n) asm volatile("s_waitcnt vmcnt(" #n ")" ::: "memory")
#define G8_WAIT_L(n) asm volatile("s_waitcnt lgkmcnt(" #n ")" ::: "memory")
#define G8_BAR __builtin_amdgcn_s_barrier()
#define G8_SCHED __builtin_amdgcn_sched_barrier(0)
#define G8_AOFF(dst, u) do { _Pragma("unroll") for (int _h = 0; _h < 2; ++_h) _Pragma("unroll") for (int _i = 0; _i < 2; ++_i) dst[_h][_i] = S.a_off(u, _h * 128 + Rr[_i]) + (unsigned)Cc[_i] * 2u; } while (0)
    Unit cur, nxt; int ui = 0;
    if (!S.next(0, cur)) return;
    f32x4 acc[2][2][4][2];
#pragma unroll
    for (int a = 0; a < 2; ++a)
#pragma unroll
        for (int b = 0; b < 2; ++b)
#pragma unroll
            for (int m = 0; m < 4; ++m)
#pragma unroll
                for (int n = 0; n < 2; ++n) acc[a][b][m][n] = (f32x4){0.f, 0.f, 0.f, 0.f};
    half8 At[4][2], B0[2][2], B1[2][2];
    unsigned caoff[2][2], naoff[2][2];
    G8_AOFF(caoff, cur);
    const char* cA = S.abase; const char* cB0 = S.b_half(cur, 0); const char* cB1 = S.b_half(cur, 1);
    G8_STAGE(G8_SB(0, 0), cB0, voffB); G8_STAGE(G8_SA(0, 0), cA, caoff[0]); G8_STAGE(G8_SB(0, 1), cB1, voffB); G8_STAGE(G8_SA(0, 1), cA, caoff[1]);
    if (wr == 1) G8_BAR;
    G8_WAIT_V(4); G8_BAR;
    G8_STAGE(G8_SB(1, 0), cB0 + kstep, voffB); G8_STAGE(G8_SA(1, 0), cA + kstep, caoff[0]); G8_STAGE(G8_SB(1, 1), cB1 + kstep, voffB);
    G8_WAIT_V(6); G8_BAR;
    for (;;) {
        const bool has_next = S.next(ui + 1, nxt);
        if (!has_next) nxt = cur;
        G8_AOFF(naoff, nxt);
        const char* nB0 = S.b_half(nxt, 0); const char* nB1 = S.b_half(nxt, 1);
#pragma unroll 1
        for (int t = 0; t < nt; t += 2) {
            const bool last = (t == nt - 2);
            const char* a1 = cA + (size_t)(t + 1) * kstep;
            const char* a2 = last ? cA : cA + (size_t)(t + 2) * kstep;
            const char* b20 = last ? nB0 : cB0 + (size_t)(t + 2) * kstep; const char* b21 = last ? nB1 : cB1 + (size_t)(t + 2) * kstep;
            const char* a3 = a2 + kstep; const char* b30 = b20 + kstep; const char* b31 = b21 + kstep;
            unsigned xoff[2][2];
#pragma unroll
            for (int h = 0; h < 2; ++h)
#pragma unroll
                for (int i = 0; i < 2; ++i) xoff[h][i] = last ? naoff[h][i] : caoff[h][i];
            G8_LDB(B0, 0, 0); G8_SCHED; G8_LDA(At, 0, 0); G8_STAGE(G8_SA(1, 1), a1, caoff[1]);
            G8_WAIT_L(8); G8_BAR; G8_WAIT_L(0); G8_MMA(0, 0, At, B0); G8_BAR; G8_SCHED;
            G8_LDB(B1, 0, 1); G8_STAGE(G8_SB(0, 0), b20, voffB);
            G8_BAR; G8_WAIT_L(0); G8_MMA(0, 1, At, B1); G8_BAR;
            G8_LDA(At, 0, 1); G8_STAGE(G8_SA(0, 0), a2, xoff[0]);
            G8_BAR; G8_WAIT_L(0); G8_MMA(1, 0, At, B0); G8_BAR; G8_SCHED;
            G8_STAGE(G8_SB(0, 1), b21, voffB);
            G8_WAIT_V(6); G8_BAR; G8_MMA(1, 1, At, B1); G8_BAR;
            G8_LDB(B0, 1, 0); G8_SCHED; G8_LDA(At, 1, 0); G8_STAGE(G8_SA(0, 1), a2, xoff[1]);
            G8_WAIT_L(8); G8_BAR; G8_WAIT_L(0); G8_MMA(0, 0, At, B0); G8_BAR; G8_SCHED;
            G8_LDB(B1, 1, 1); G8_STAGE(G8_SB(1, 0), b30, voffB);
            G8_BAR; G8_WAIT_L(0); G8_MMA(0, 1, At, B1); G8_BAR;
            G8_LDA(At, 1, 1); G8_STAGE(G8_SA(1, 0), a3, xoff[0]);
            G8_BAR; G8_WAIT_L(0); G8_MMA(1, 0, At, B0); G8_BAR; G8_SCHED;
            G8_STAGE(G8_SB(1, 1), b31, voffB);
            G8_WAIT_V(6); G8_BAR; G8_MMA(1, 1, At, B1); G8_BAR;
        }
        E(acc, cur, wr, wc, fr, fq);
        if (!has_next) break;
#pragma unroll
        for (int a = 0; a < 2; ++a)
#pragma unroll
            for (int b = 0; b < 2; ++b)
#pragma unroll
                for (int m = 0; m < 4; ++m)
#pragma unroll
                    for (int n = 0; n < 2; ++n) acc[a][b][m][n] = (f32x4){0.f, 0.f, 0.f, 0.f};
        cur = nxt; cB0 = nB0; cB1 = nB1; ++ui;
#pragma unroll
        for (int h = 0; h < 2; ++h)
#pragma unroll
            for (int i = 0; i < 2; ++i) caoff[h][i] = naoff[h][i];
    }
    G8_WAIT_V(0);
    if (wr == 0) G8_BAR;
    G8_BAR;
#undef G8_SA
#undef G8_SB
#undef G8_STAGE
#undef G8_LDA
#undef G8_LDB
#undef G8_MMA
#undef G8_WAIT_V
#undef G8_WAIT_L
#undef G8_BAR
#undef G8_SCHED
#undef G8_AOFF
#endif
}
}

#ifdef EMU
typedef const Params* ParamsPtr;
#else
typedef const __attribute__((address_space(4))) Params* ParamsPtr;
#endif
struct Frame {
    ParamsPtr P; unsigned char* ws; unsigned char* smem; int tid, lane, wave;
    __device__ __forceinline__ const float* in(int i) const { return P->in[i]; }
    __device__ __forceinline__ float* xrow(int row) const { return row < TL ? P->out + (size_t)row * D : (float*)(ws + WS_XC) + (size_t)(row - TL) * D; }
    __device__ __forceinline__ const float* xrow_in(int layer, int row) const {
        if (layer == 0) return row < TL ? in(I_X) + (size_t)row * D : in(I_CTX) + (size_t)(row - TL) * D;
        return xrow(row);
    }
};
__device__ __forceinline__ int row_mod(int row) { return row < TL ? row / SEQ : NB; }
__device__ __forceinline__ const float* modp(const Frame& F, int layer, int m, int chunk) { return (const float*)(F.ws + WS_MOD) + ((size_t)(layer * 5 + m) * 6 + chunk) * D; }


#ifndef EMU
#define XB_TMO      128
#define XB_XCNT(j)  (256  + 64 * (j))
#define XB_XSUB(j)  (1280 + 64 * (j))
#define XB_XGEN(j)  (2304 + 64 * (j))
#define XB_TOP      3328
#define XB_TOPGEN   3392
#define XCD_BAR_WORDS 3456
#define XB_SPIN_CAP (1u << 26)
#define LAS __attribute__((address_space(3)))
static_assert((CW_BAR + XCD_BAR_WORDS) * 4 <= CTL_BYTES, "control region");
__device__ __forceinline__ unsigned xb_ld(unsigned* p)              { return __hip_atomic_load(p, __ATOMIC_RELAXED, __HIP_MEMORY_SCOPE_AGENT); }
__device__ __forceinline__ unsigned xb_add(unsigned* p, unsigned v) { return __hip_atomic_fetch_add(p, v, __ATOMIC_RELAXED, __HIP_MEMORY_SCOPE_AGENT); }
__device__ __forceinline__ unsigned xb_xcc_id() { return (unsigned)__builtin_amdgcn_s_getreg((3 << 11) | 20) & 0xFu; }
#define XB_SPIN(cond, bar) do { unsigned _sp = 0; while (cond) { __builtin_amdgcn_s_sleep(1); \
    if ((++_sp & 255u) == 0u) { if (xb_ld(&(bar)[XB_TMO])) break; if (_sp > XB_SPIN_CAP) { atomicAdd(&(bar)[XB_TMO], 1u); break; } } } } while (0)
struct XcdBarrier { unsigned* bar; unsigned x; volatile LAS unsigned* st; };
__device__ __forceinline__ XcdBarrier xcd_barrier_post(unsigned* bar, volatile LAS unsigned* st) {
    XcdBarrier b; b.bar = bar; b.x = xb_xcc_id(); b.st = st;
    if (threadIdx.x == 0) (void)xb_add(&bar[XB_XCNT(b.x)], 1u);
    return b;
}
__device__ __forceinline__ void xcd_barrier_complete(unsigned* bar, unsigned x, unsigned& nloc, unsigned& nx) {
    const unsigned G = gridDim.x * gridDim.y * gridDim.z;
    unsigned sum, cnt, mine, sp = 0u;
    for (;;) {
        sum = 0u; cnt = 0u; mine = 0u;
#pragma unroll
        for (unsigned j = 0; j < 16; ++j) { const unsigned c = xb_ld(&bar[XB_XCNT(j)]); sum += c; cnt += (c > 0u) ? 1u : 0u; mine = (j == x) ? c : mine; }
        if (sum == G) break;
        __builtin_amdgcn_s_sleep(1);
        if ((++sp & 255u) == 0u) { if (xb_ld(&bar[XB_TMO])) break; if (sp > XB_SPIN_CAP) { atomicAdd(&bar[XB_TMO], 1u); break; } }
    }
    nloc = mine > 0u ? mine : 1u; nx = cnt > 0u ? cnt : 1u;
}
__device__ __forceinline__ void xcd_barrier(const XcdBarrier& b) {
    asm volatile("s_waitcnt vmcnt(0)" ::: "memory");
    __syncthreads();
    if (threadIdx.x == 0) {
        unsigned* bar = b.bar;
        __builtin_amdgcn_s_waitcnt(0);
        unsigned nloc = b.st[0], nx = b.st[1];
        if (nloc == 0u) { xcd_barrier_complete(bar, b.x, nloc, nx); b.st[0] = nloc; b.st[1] = nx; }
        const unsigned old = xb_add(&bar[XB_XSUB(b.x)], 1u);
        const unsigned gen = old / nloc;
        if (old + 1u == (gen + 1u) * nloc) {
            __builtin_amdgcn_fence(__ATOMIC_RELEASE, "agent");
            asm volatile("s_waitcnt vmcnt(0)" ::: "memory");
            const unsigned og = xb_add(&bar[XB_TOP], 1u);
            const unsigned tg = og / nx;
            if (og + 1u == (tg + 1u) * nx) xb_add(&bar[XB_TOPGEN], 1u);
            else XB_SPIN(xb_ld(&bar[XB_TOPGEN]) == tg, bar);
            __builtin_amdgcn_fence(__ATOMIC_ACQUIRE, "agent");
            xb_add(&bar[XB_XGEN(b.x)], 1u);
            asm volatile("s_waitcnt vmcnt(0)" ::: "memory");
        } else {
            XB_SPIN(xb_ld(&bar[XB_XGEN(b.x)]) == gen, bar);
            __builtin_amdgcn_fence(__ATOMIC_ACQUIRE, "agent");
            asm volatile("s_waitcnt vmcnt(0)" ::: "memory");
        }
    }
    __syncthreads();
}
#endif

__device__ __forceinline__ void item_twiddle(const Frame& F, int it) {
    cplx* tw = (cplx*)(F.ws + WS_TW);
    const int k = it * NT + F.tid;
    if (k < TWN) { float s, c; const float a = -6.283185307179586f * (float)k / (float)TWN; s = sinf(a); c = cosf(a); tw[k].x = c; tw[k].y = s; }
}
__device__ __forceinline__ void item_mod(const Frame& F, int it) {
    const int layer = it / (NMOD / 64), n0 = (it % (NMOD / 64)) * 64;
    float* sc = (float*)F.smem;
    float* red = sc + 5 * D;
    for (int i = F.tid; i < 5 * D; i += NT) { const int m = i / D, k = i % D; const float v = m < NB ? F.in(I_C)[m * D + k] : F.in(I_CCTX)[k]; sc[i] = siluf(v); }
    __syncthreads();
    const int j = F.tid & 63, ks = F.tid >> 6;
    const float* w = F.in(I_WMOD) + (size_t)layer * D * NMOD + n0 + j;
    float a[5] = {0, 0, 0, 0, 0};
    for (int k = ks * 128; k < ks * 128 + 128; ++k) { const float wv = w[(size_t)k * NMOD];
#pragma unroll
        for (int m = 0; m < 5; ++m) a[m] += sc[m * D + k] * wv; }
#pragma unroll
    for (int m = 0; m < 5; ++m) red[(ks * 5 + m) * 64 + j] = a[m];
    __syncthreads();
    if (F.tid < 5 * 64) { const int m = F.tid / 64, jj = F.tid % 64; float s = 0; for (int q = 0; q < 8; ++q) s += red[(q * 5 + m) * 64 + jj];
        ((float*)(F.ws + WS_MOD))[(size_t)(layer * 5 + m) * NMOD + n0 + jj] = s + F.in(I_BMOD)[layer * NMOD + n0 + jj]; }
    __syncthreads();
}
__device__ __forceinline__ void item_filter(const Frame& F, int layer, int isctx, int tb) {
    const int L = isctx ? CTXL : SEQ;
    float* feats = (float*)F.smem;
    float* h1 = feats + 32 * 33;
    float* h2 = h1 + 32 * 64;
    const int t0 = tb * 32;
    for (int i = F.tid; i < 32 * 33; i += NT) {
        const int tt = i / 33, f = i % 33; const float t = (float)(t0 + tt);
        float v;
        if (f == 0) v = t / (float)(L - 1 > 1 ? L - 1 : 1);
        else { const int bi = (f - 1) & 15; const float band = 1e-4f + (float)bi * ((15.0f - 1e-4f) / 15.0f);
               const float ang = (6.283185307179586f / (float)L) * t * band; v = (f <= 16) ? cosf(ang) : -sinf(ang); }
        feats[i] = v;
    }
    __syncthreads();
    const float* w1 = F.in(I_HW1) + layer * 33 * 64; const float* b1 = F.in(I_HB1) + layer * 64;
    const float* w2 = F.in(I_HW2) + layer * 64 * 64; const float* b2 = F.in(I_HB2) + layer * 64;
    const float* fr = F.in(I_HFREQ) + layer * 64;
    for (int i = F.tid; i < 32 * 64; i += NT) { const int tt = i >> 6, j = i & 63; float s = b1[j]; for (int k = 0; k < 33; ++k) s += feats[tt * 33 + k] * w1[k * 64 + j]; h1[i] = sinf(fr[j] * s); }
    __syncthreads();
    for (int i = F.tid; i < 32 * 64; i += NT) { const int tt = i >> 6, j = i & 63; float s = b2[j]; for (int k = 0; k < 64; ++k) s += h1[tt * 64 + k] * w2[k * 64 + j]; h2[i] = sinf(fr[j] * s); }
    __syncthreads();
    const float* w3 = F.in(I_HW3) + (size_t)layer * 64 * 1024;
    const int c0 = F.tid * 2;
    float* ft = (float*)(F.ws + WS_FT) + (isctx ? (size_t)2 * 256 * 4 * SEQ : (size_t)layer * 256 * 4 * SEQ);
    for (int hf = 0; hf < 2; ++hf) {
        float acc[16][2];
        for (int tt = 0; tt < 16; ++tt) { acc[tt][0] = 0.f; acc[tt][1] = 0.f; }
        for (int k = 0; k < 64; ++k) { const float wa = w3[k * 1024 + c0], wb = w3[k * 1024 + c0 + 1];
#pragma unroll
            for (int tt = 0; tt < 16; ++tt) { const float hv = h2[(hf * 16 + tt) * 64 + k]; acc[tt][0] += hv * wa; acc[tt][1] += hv * wb; } }
#pragma unroll
        for (int q = 0; q < 2; ++q) {
            const int col = c0 + q, dir = col >> 9, order = (col >> 8) & 1, c = col & 255;
            const float dec = fabsf(F.in(I_HDEC)[((layer * 2 + dir) * 2 + order) * 256 + c]);
            float* dst = ft + ((size_t)(c * 2 + order) * 2 + dir) * L + t0 + hf * 16;
#pragma unroll
            for (int tt = 0; tt < 16; ++tt) { const float tu = (float)(t0 + hf * 16 + tt) / (float)(L - 1 > 1 ? L - 1 : 1); dst[tt] = acc[tt][q] * expf(-tu * dec); }
        }
    }
    __syncthreads();
}
__device__ __forceinline__ void item_transpose(const Frame& F, const float* src, int ldn, int nvalid, half_t* dst, int K, int k0, int n0) {
    float* tile = (float*)F.smem;
    for (int i = F.tid; i < 64 * 16; i += NT) {
        const int r = i >> 4, c4 = (i & 15) * 4;
        float v[4];
#pragma unroll
        for (int q = 0; q < 4; ++q) v[q] = (n0 + c4 + q < nvalid) ? src[(size_t)(k0 + r) * ldn + n0 + c4 + q] : 0.f;
#pragma unroll
        for (int q = 0; q < 4; ++q) tile[r * 65 + c4 + q] = v[q];
    }
    __syncthreads();
    { const int n = F.tid >> 3, kc = (F.tid & 7) * 8; half8 h;
#pragma unroll
      for (int q = 0; q < 8; ++q) h[q] = (half_t)tile[(kc + q) * 65 + n];
      *(half8*)(dst + (size_t)(n0 + n) * K + k0 + kc) = h; }
    __syncthreads();
}
__device__ __forceinline__ void item_router_w(const Frame& F, int layer) {
    half_t* dst = (half_t*)(F.ws + WS_WR) + (size_t)layer * 2 * 48 * D;
    for (int i = F.tid; i < 48 * D; i += NT) {
        const int col = i / D, k = i % D;
        float w = 0.f;
        if (col < 4) w = F.in(I_GRW)[((size_t)layer * D + k) * 4 + col]; else if (col < 36) w = F.in(I_ERW)[((size_t)layer * D + k) * 32 + (col - 4)];
        const half_t hi = (half_t)w; const half_t lo = (half_t)((w - (float)hi) * 2048.f);
        dst[i] = hi; dst[48 * D + i] = lo;
    }
}
constexpr int IT_TW = (TWN + NT - 1) / NT;
constexpr int IT_MOD = 2 * (NMOD / 64);
constexpr int IT_FILT = 2 * (SEQ / 32) + (CTXL / 32);
constexpr int IT_TWIN = 2 * 16 * (NINP / 64);
constexpr int IT_TWOUT = 2 * 16 * 16;
constexpr int IT_TMOE = 32 * 192;
__device__ __forceinline__ void moe_transpose_item(const Frame& F, int layer, int it) {
    const int e = it / 192, r = it % 192, which = r / 64, t = r % 64;
    half_t* base = (half_t*)(F.ws + WS_WMOE) + (size_t)e * 3 * 262144;
    if (which < 2) {
        const float* src = F.in(which == 0 ? I_MG : I_MU) + ((size_t)layer * 32 + e) * 262144;
        item_transpose(F, src, 256, 256, base + which * 262144, 1024, (t >> 2) * 64, (t & 3) * 64);
    } else {
        const float* src = F.in(I_MD) + ((size_t)layer * 32 + e) * 262144;
        item_transpose(F, src, 1024, 1024, base + 2 * 262144, 256, (t >> 4) * 64, (t & 15) * 64);
    }
}
__device__ __forceinline__ void phase_setup(const Frame& F) {
    if (blockIdx.x == 0 && F.tid < 128) ((unsigned*)(F.ws + WS_CTL))[CW_CNT + F.tid] = 0u;
    const int total = IT_TW + IT_MOD + IT_FILT + IT_TWIN + IT_TWOUT + IT_TMOE + 2;
    for (int it = blockIdx.x; it < total; it += gridDim.x) {
        int i = it;
        if (i < 2) { item_router_w(F, i); continue; } i -= 2;
        if (i < IT_MOD) { item_mod(F, i); continue; } i -= IT_MOD;
        if (i < IT_FILT) { if (i < 2 * (SEQ / 32)) item_filter(F, i / (SEQ / 32), 0, i % (SEQ / 32)); else item_filter(F, 0, 1, i - 2 * (SEQ / 32)); continue; } i -= IT_FILT;
        if (i < IT_TW) { item_twiddle(F, i); continue; } i -= IT_TW;
        if (i < IT_TWIN) { const int layer = i / (16 * (NINP / 64)), r = i % (16 * (NINP / 64));
            item_transpose(F, F.in(I_WIN) + (size_t)layer * D * NIN, NIN, NIN, (half_t*)(F.ws + WS_WIN) + (size_t)layer * NINP * D, D, (r / (NINP / 64)) * 64, (r % (NINP / 64)) * 64); continue; } i -= IT_TWIN;
        if (i < IT_TWOUT) { const int layer = i / 256, r = i % 256;
            item_transpose(F, F.in(I_WOUT) + (size_t)layer * D * D, D, D, (half_t*)(F.ws + WS_WOUT) + (size_t)layer * D * D, D, (r >> 4) * 64, (r & 15) * 64); continue; } i -= IT_TWOUT;
        moe_transpose_item(F, 0, i);
    }
}

__device__ __forceinline__ void norm_rows16(const Frame& F, int layer, int row0, int which  ) {
    half_t* xn = (half_t*)(F.ws + WS_XN);
    for (int rr = F.wave; rr < 16; rr += NT / 64) {
        const int row = row0 + rr; const int m = row_mod(row);
        const float* x = F.xrow_in(layer, row);
        float v[16]; float ss = 0.f;
#pragma unroll
        for (int q = 0; q < 4; ++q) { const f32x4 t = *(const f32x4*)(x + q * 256 + F.lane * 4); v[q * 4 + 0] = t[0]; v[q * 4 + 1] = t[1]; v[q * 4 + 2] = t[2]; v[q * 4 + 3] = t[3]; ss += t[0] * t[0] + t[1] * t[1] + t[2] * t[2] + t[3] * t[3]; }
        ss = wave_sum(ss);
        const float rs = 1.0f / sqrtf(ss * (1.0f / D) + EPSF);
        const float* nw = F.in(I_N1W) + layer * D; const float* sh = modp(F, layer, m, 0); const float* scl = modp(F, layer, m, 1);
        int srow = row;
        if (layer == 1 && row < TL) { const int b = row / SEQ, l = row % SEQ; srow = b * SEQ + (l % GW) * GROWS + l / GW; }
#pragma unroll
        for (int q = 0; q < 4; ++q) { const int k = q * 256 + F.lane * 4; half4 h;
#pragma unroll
            for (int e = 0; e < 4; ++e) h[e] = (half_t)(v[q * 4 + e] * rs * nw[k + e] * (1.0f + scl[k + e]) + sh[k + e]);
            *(half4*)(xn + (size_t)srow * D + k) = h; }
    }
}
__device__ __forceinline__ void phase_norm1(const Frame& F, int layer) {
    const int nrow_items = TT / 16;
    const int total = nrow_items + (layer == 1 ? IT_TMOE : 0);
    for (int it = blockIdx.x; it < total; it += gridDim.x) {
        if (it < nrow_items) norm_rows16(F, layer, it * 16, 0); else moe_transpose_item(F, 1, it - nrow_items);
    }
}

struct EpiInproj {
    half_t* u16; float* ug; half_t* hyt;
    __device__ __forceinline__ void operator()(const f32x4 (&acc)[2][2][4][2], const g8::Unit& u, int wr, int wc, int fr, int fq) const {
#pragma unroll
        for (int ai = 0; ai < 2; ++ai)
#pragma unroll
            for (int m = 0; m < 4; ++m) {
                const int row = u.pm * 256 + ai * 128 + wr * 64 + m * 16 + fr;
#pragma unroll
                for (int bj = 0; bj < 2; ++bj)
#pragma unroll
                    for (int n = 0; n < 2; ++n) {
                        const int c0 = u.pn * 256 + bj * 128 + wc * 32 + n * 16 + 4 * fq; const f32x4 v = acc[ai][bj][m][n];
                        if (c0 < 1024) *(half4*)(u16 + (size_t)row * UW + c0) = to_half4(v);
                        else if (c0 < 1036) *(f32x4*)(ug + (size_t)row * UGW + (c0 - 1024)) = v;
                        else if (c0 < 1804) { const int ch = c0 - 1036;
                            half_t* dst = row < TL ? hyt + ((size_t)(row / SEQ) * 768 + ch) * SEQ + row % SEQ : hyt + (size_t)NB * 768 * SEQ + ((size_t)((row - TL) / CTXL) * 768 + ch) * CTXL + (row - TL) % CTXL;
                            const size_t st = row < TL ? SEQ : CTXL;
#pragma unroll
                            for (int i = 0; i < 4; ++i) dst[i * st] = (half_t)v[i]; }
                        else if (c0 < 3340) *(half4*)(u16 + (size_t)row * UW + (c0 - 1804 + 1024)) = to_half4(v);
                        else if (c0 < NIN) *(f32x4*)(ug + (size_t)row * UGW + 12 + (c0 - 3340)) = v;
                    }
            }
    }
};
__device__ __forceinline__ void phase_inproj(const Frame& F, int layer) {
    g8::DenseSched S; S.abase = (const char*)(F.ws + WS_XN); S.bbase = (const char*)((const half_t*)(F.ws + WS_WIN) + (size_t)layer * NINP * D); S.K = D; S.nM = TT / 256; S.nN = NINP / 256; S.G = gridDim.x; S.c = blockIdx.x;
    EpiInproj E{(half_t*)(F.ws + WS_U16), (float*)(F.ws + WS_UG), (half_t*)(F.ws + WS_HYT)};
    g8::gemm_phase(F.smem, D, S, E);
}


constexpr int SA = 72, SB = 136;

__device__ __forceinline__ void load_rows10(const half_t* u16, int rowbase, int Lseq, int dir, int jj0, int ucol, half8 (&rr)[10]) {
#pragma unroll
    for (int t = 0; t < 10; ++t) {
        const int jj = jj0 - 1 + t;
        half8 v;
        if (jj >= 0 && jj < Lseq) { const int pos = dir == 0 ? jj : Lseq - 1 - jj; v = *(const half8*)(u16 + (size_t)(rowbase + pos) * UW + ucol); }
        else {
#pragma unroll
            for (int i = 0; i < 8; ++i) v[i] = (half_t)0.f; }
        rr[t] = v;
    }
}
__device__ __forceinline__ void load_taps(const float* cw, const float* cb, int C, int ch, int dir, float (&w0)[8], float (&w1)[8], float (&w2)[8], float (&wb)[8]) {
#pragma unroll
    for (int q = 0; q < 2; ++q) {
        const f32x4 a = *(const f32x4*)(cw + (dir ? 2 : 0) * C + ch + q * 4), b = *(const f32x4*)(cw + C + ch + q * 4), c = *(const f32x4*)(cw + (dir ? 0 : 2) * C + ch + q * 4), d = *(const f32x4*)(cb + ch + q * 4);
#pragma unroll
        for (int i = 0; i < 4; ++i) { w0[q * 4 + i] = a[i]; w1[q * 4 + i] = b[i]; w2[q * 4 + i] = c[i]; wb[q * 4 + i] = d[i]; }
    }
}

__device__ __forceinline__ void ssd_block(const Frame& F, int layer, int b, int h, int dir) {
    half_t* Cs = (half_t*)F.smem;
    half_t* Bs = Cs + 128 * SA;
    half_t* Xs = Bs + 128 * SA;
    half_t* BT = Xs + 128 * SA;
    half_t* XT = BT + 64 * SB;
    half_t* XW = XT + 64 * SB;
    half_t* SC = XW + 64 * SB;
    half_t* ST = SC + 128 * SB;
    float* cum = (float*)(ST + 64 * SA);
    float* dtv = cum + 128;
    float* wtot = dtv + 128;
    const half_t* u16 = (const half_t*)(F.ws + WS_U16); const float* ug = (const float*)(F.ws + WS_UG);
    half_t* yout = (half_t*)(F.ws + WS_YF) + (size_t)dir * TT * 384;
    const float* cw = F.in(I_SCW) + layer * 3 * 640; const float* cb = F.in(I_SCB) + layer * 640;
    const float dtb = F.in(I_DTB)[(layer * 2 + dir) * 6 + h];
    const float Aneg = -expf(F.in(I_ALOG)[(layer * 2 + dir) * 6 + h]);
    const float Dh = F.in(I_SD)[layer * 6 + h];
    const int g = h / 3, tid = F.tid, lane = F.lane, wave = F.wave;
    const int kind = tid >> 7, c8 = (tid & 7) * 8, j0 = ((tid >> 3) & 15) * 8;
    const int ch = kind == 0 ? h * 64 + c8 : (kind == 1 ? 384 + g * 64 + c8 : 512 + g * 64 + c8);
    f32x4 accS[1][2]; zero_acc(accS);
    for (int i = tid; i < 64 * SA; i += NT) ST[i] = (half_t)0.f;
    __syncthreads();
    for (int seg = 0; seg < 2; ++seg) {
        const int Lseq = seg == 0 ? CTXL : SEQ, rowbase = seg == 0 ? TL + b * CTXL : b * SEQ;
        const bool want_y = (seg == 1) || (layer == 0);
        for (int c = 0; c < Lseq / 128; ++c) {
            if (tid < 128) {
                const int j = tid, pi = c * 128 + j, pos = dir == 0 ? pi : Lseq - 1 - pi;
                const float dt = softplusf_(ug[(size_t)(rowbase + pos) * UGW + dir * 6 + h] + dtb);
                const float cs = wave_scan_sum(dt * Aneg, lane);
                dtv[j] = dt; cum[j] = cs;
                if (lane == 63) wtot[wave] = cs;
            }
            __syncthreads();
            if (tid >= 64 && tid < 128) cum[tid] += wtot[0];
            __syncthreads();
            const float cl = cum[127];
            if (kind < 3) {
                float w0[8], w1[8], w2[8], wb[8]; load_taps(cw, cb, 640, ch, dir, w0, w1, w2, wb);
                half8 rr[10]; load_rows10(u16, rowbase, Lseq, dir, c * 128 + j0, 384 + ch, rr);
                if (kind == 0) {
                    half8 xt[8], xw[8];
#pragma unroll
                    for (int k = 0; k < 8; ++k) { const float dt = dtv[j0 + k], we = dt * expf(cl - cum[j0 + k]); half8 hx;
#pragma unroll
                        for (int i = 0; i < 8; ++i) { const float xv = siluf(w0[i] * (float)rr[k][i] + w1[i] * (float)rr[k + 1][i] + w2[i] * (float)rr[k + 2][i] + wb[i]);
                            hx[i] = (half_t)xv; xt[i][k] = (half_t)(xv * dt); xw[i][k] = (half_t)(xv * we); }
                        *(half8*)(Xs + (j0 + k) * SA + c8) = hx; }
#pragma unroll
                    for (int i = 0; i < 8; ++i) { *(half8*)(XT + (c8 + i) * SB + j0) = xt[i]; *(half8*)(XW + (c8 + i) * SB + j0) = xw[i]; }
                } else if (kind == 1) {
                    half8 bt[8];
#pragma unroll
                    for (int k = 0; k < 8; ++k) { half8 hb;
#pragma unroll
                        for (int i = 0; i < 8; ++i) { const half_t v = (half_t)siluf(w0[i] * (float)rr[k][i] + w1[i] * (float)rr[k + 1][i] + w2[i] * (float)rr[k + 2][i] + wb[i]); hb[i] = v; bt[i][k] = v; }
                        *(half8*)(Bs + (j0 + k) * SA + c8) = hb; }
#pragma unroll
                    for (int i = 0; i < 8; ++i) *(half8*)(BT + (c8 + i) * SB + j0) = bt[i];
                } else {
#pragma unroll
                    for (int k = 0; k < 8; ++k) { half8 hc;
#pragma unroll
                        for (int i = 0; i < 8; ++i) hc[i] = (half_t)siluf(w0[i] * (float)rr[k][i] + w1[i] * (float)rr[k + 1][i] + w2[i] * (float)rr[k + 2][i] + wb[i]);
                        *(half8*)(Cs + (j0 + k) * SA + c8) = hc; }
                }
            }
            __syncthreads();
            if (want_y) {
                { const int ws_ = wave & 1, wl = wave >> 1;
                  if (!(ws_ == 1 && wl < 2)) {
                    f32x4 g_[4][2]; zero_acc(g_);
                    mma_lds<4, 2>(g_, Bs + ws_ * 64 * SA, SA, Cs + wl * 32 * SA, SA, 2, lane);
#pragma unroll
                    for (int a = 0; a < 4; ++a)
#pragma unroll
                        for (int q = 0; q < 2; ++q) {
                            const int s0 = ws_ * 64 + a * 16 + (lane >> 4) * 4, l = wl * 32 + q * 16 + (lane & 15); const float cl_ = cum[l]; half4 hv;
#pragma unroll
                            for (int i = 0; i < 4; ++i) hv[i] = (half_t)((s0 + i) <= l ? g_[a][q][i] * expf(cl_ - cum[s0 + i]) : 0.f);
                            *(half4*)(SC + l * SB + s0) = hv;
                        }
                  } }
                f32x4 y1[4][1]; zero_acc(y1);
                mma_lds<4, 1>(y1, ST, SA, Cs + wave * 16 * SA, SA, 2, lane);
                __syncthreads();
                f32x4 y2[4][1]; zero_acc(y2);
                mma_lds<4, 1>(y2, XT, SB, SC + wave * 16 * SB, SB, wave / 2 + 1, lane);
                { const int l = wave * 16 + (lane & 15); const float el = expf(cum[l]);
                  const int pi = c * 128 + l, pos = dir == 0 ? pi : Lseq - 1 - pi;
#pragma unroll
                  for (int a = 0; a < 4; ++a) { const int p0 = a * 16 + (lane >> 4) * 4; f32x4 y;
#pragma unroll
                      for (int i = 0; i < 4; ++i) y[i] = y1[a][0][i] * el + y2[a][0][i];
                      if (dir == 0) { const half4 xv = *(const half4*)(Xs + l * SA + p0);
#pragma unroll
                          for (int i = 0; i < 4; ++i) y[i] += Dh * (float)xv[i]; }
                      *(half4*)(yout + (size_t)(rowbase + pos) * 384 + h * 64 + p0) = to_half4(y); } }
            }
            { const float dec = expf(cl);
#pragma unroll
              for (int q = 0; q < 2; ++q) accS[0][q] *= dec;
              mma_lds<1, 2>(accS, BT + (wave >> 1) * 16 * SB, SB, XW + (wave & 1) * 32 * SB, SB, 4, lane); }
            __syncthreads();
#pragma unroll
            for (int q = 0; q < 2; ++q) { const int p = (wave & 1) * 32 + q * 16 + (lane & 15), n0 = (wave >> 1) * 16 + (lane >> 4) * 4; *(half4*)(ST + p * SA + n0) = to_half4(accS[0][q]); }
            __syncthreads();
        }
    }
}

__device__ __forceinline__ void mlstm_block(const Frame& F, int layer, int b, int h, int dir) {
    half_t* Qs = (half_t*)F.smem;
    half_t* Ks = Qs + 128 * SA;
    half_t* KT = Ks + 128 * SA;
    half_t* VT = KT + 64 * SB;
    half_t* VW = VT + 64 * SB;
    half_t* SC = VW + 64 * SB;
    half_t* CS = SC + 128 * SB;
    float* ig = (float*)(CS + 64 * SA);
    float* cumf = ig + 128; float* pmx = cumf + 128; float* mtv = pmx + 128; float* ee = mtv + 128; float* dn = ee + 128;
    float* nvec = dn + 128;
    float* wtot = nvec + 64;
    const half_t* u16 = (const half_t*)(F.ws + WS_U16); const float* ug = (const float*)(F.ws + WS_UG);
    half_t* hout = (half_t*)(F.ws + WS_YF) + (size_t)(2 + dir) * TT * 384;
    const float* cw = F.in(I_MCW) + layer * 3 * 768; const float* cb = F.in(I_MCB) + layer * 768;
    const float bi = F.in(I_MGB)[((layer * 2 + dir) * 2 + 0) * 6 + h], bf = F.in(I_MGB)[((layer * 2 + dir) * 2 + 1) * 6 + h];
    const int tid = F.tid, lane = F.lane, wave = F.wave;
    const int kind = tid >> 7, c8 = (tid & 7) * 8, j0 = ((tid >> 3) & 15) * 8;
    const int ch = kind == 0 ? h * 64 + c8 : 384 + h * 64 + c8;
    f32x4 accC[1][2]; zero_acc(accC);
    float m_in = 0.f;
    for (int i = tid; i < 64 * SA; i += NT) CS[i] = (half_t)0.f;
    if (tid < 64) nvec[tid] = 0.f;
    __syncthreads();
    for (int seg = 0; seg < 2; ++seg) {
        const int Lseq = seg == 0 ? CTXL : SEQ, rowbase = seg == 0 ? TL + b * CTXL : b * SEQ;
        const bool want_y = (seg == 1) || (layer == 0);
        for (int c = 0; c < Lseq / 128; ++c) {
            if (tid < 128) {
                const int j = tid, pi = c * 128 + j, pos = dir == 0 ? pi : Lseq - 1 - pi;
                const float* gp = ug + (size_t)(rowbase + pos) * UGW + 12 + dir * 12;
                const float ip = gp[h] + bi, fp = gp[6 + h] + bf;
                const float cs = wave_scan_sum(logsigmoidf_(fp), lane);
                ig[j] = ip; cumf[j] = cs;
                if (lane == 63) wtot[wave] = cs;
            }
            __syncthreads();
            if (tid >= 64 && tid < 128) cumf[tid] += wtot[0];
            __syncthreads();
            if (tid < 128) {
                const float r = ig[tid] - cumf[tid];
                const float pm = wave_scan_max(r, lane);
                pmx[tid] = pm;
                if (lane == 63) wtot[4 + wave] = pm;
            }
            __syncthreads();
            if (tid >= 64 && tid < 128) pmx[tid] = fmaxf(pmx[tid], wtot[4]);
            __syncthreads();
            const float tot = cumf[127];
            const float m_new = fmaxf(tot + m_in, tot + pmx[127]);
            if (tid < 128) { mtv[tid] = fmaxf(cumf[tid] + m_in, cumf[tid] + pmx[tid]); ee[tid] = expf(ig[tid] + tot - cumf[tid] - m_new); }
            __syncthreads();
            if (kind < 2) {
                float w0[8], w1[8], w2[8], wb[8]; load_taps(cw, cb, 768, ch, dir, w0, w1, w2, wb);
                half8 rr[10]; load_rows10(u16, rowbase, Lseq, dir, c * 128 + j0, 1024 + ch, rr);
                if (kind == 0) {
#pragma unroll
                    for (int k = 0; k < 8; ++k) { half8 hq;
#pragma unroll
                        for (int i = 0; i < 8; ++i) hq[i] = (half_t)siluf(w0[i] * (float)rr[k][i] + w1[i] * (float)rr[k + 1][i] + w2[i] * (float)rr[k + 2][i] + wb[i]);
                        *(half8*)(Qs + (j0 + k) * SA + c8) = hq; }
                } else {
                    half8 kt[8];
#pragma unroll
                    for (int k = 0; k < 8; ++k) { half8 hk;
#pragma unroll
                        for (int i = 0; i < 8; ++i) { const half_t v = (half_t)(0.125f * siluf(w0[i] * (float)rr[k][i] + w1[i] * (float)rr[k + 1][i] + w2[i] * (float)rr[k + 2][i] + wb[i])); hk[i] = v; kt[i][k] = v; }
                        *(half8*)(Ks + (j0 + k) * SA + c8) = hk; }
#pragma unroll
                    for (int i = 0; i < 8; ++i) *(half8*)(KT + (c8 + i) * SB + j0) = kt[i];
                }
            } else if (kind == 2) {
                half8 vt[8], vw[8];
#pragma unroll
                for (int k = 0; k < 8; ++k) { const int jj = c * 128 + j0 + k, pos = dir == 0 ? jj : Lseq - 1 - jj; const float e = ee[j0 + k];
                    const half8 hv = *(const half8*)(u16 + (size_t)(rowbase + pos) * UW + 1792 + h * 64 + c8);
#pragma unroll
                    for (int i = 0; i < 8; ++i) { vt[i][k] = hv[i]; vw[i][k] = (half_t)((float)hv[i] * e); } }
#pragma unroll
                for (int i = 0; i < 8; ++i) { *(half8*)(VT + (c8 + i) * SB + j0) = vt[i]; *(half8*)(VW + (c8 + i) * SB + j0) = vw[i]; }
            }
            __syncthreads();
            if (want_y) {
                { const int ws_ = wave & 1, wl = wave >> 1;
                  if (!(ws_ == 1 && wl < 2)) {
                    f32x4 g_[4][2]; zero_acc(g_);
                    mma_lds<4, 2>(g_, Ks + ws_ * 64 * SA, SA, Qs + wl * 32 * SA, SA, 2, lane);
#pragma unroll
                    for (int a = 0; a < 4; ++a)
#pragma unroll
                        for (int q = 0; q < 2; ++q) {
                            const int s0 = ws_ * 64 + a * 16 + (lane >> 4) * 4, l = wl * 32 + q * 16 + (lane & 15); const float cm = cumf[l] - mtv[l]; half4 hv;
#pragma unroll
                            for (int i = 0; i < 4; ++i) hv[i] = (half_t)((s0 + i) <= l ? g_[a][q][i] * expf(cm - cumf[s0 + i] + ig[s0 + i]) : 0.f);
                            *(half4*)(SC + l * SB + s0) = hv;
                        }
                  } }
                f32x4 h1[4][1]; zero_acc(h1);
                mma_lds<4, 1>(h1, CS, SA, Qs + wave * 16 * SA, SA, 2, lane);
                if (tid < 128) { float s = 0.f; for (int d = 0; d < 64; ++d) s += (float)Qs[tid * SA + d] * nvec[d]; dn[tid] = s * expf(cumf[tid] + m_in - mtv[tid]); }
                __syncthreads();
                f32x4 h2[4][1]; zero_acc(h2);
                mma_lds<4, 1>(h2, VT, SB, SC + wave * 16 * SB, SB, wave / 2 + 1, lane);
                if (tid < 128) { float s = 0.f; for (int k = 0; k <= tid; ++k) s += (float)SC[tid * SB + k]; dn[tid] += s; }
                __syncthreads();
                { const int l = wave * 16 + (lane & 15); const float ai = expf(cumf[l] + m_in - mtv[l]); const float rden = 1.0f / fmaxf(fabsf(dn[l]), expf(-mtv[l]));
                  const int pi = c * 128 + l, pos = dir == 0 ? pi : Lseq - 1 - pi;
#pragma unroll
                  for (int a = 0; a < 4; ++a) { const int v0 = a * 16 + (lane >> 4) * 4; f32x4 y;
#pragma unroll
                      for (int i = 0; i < 4; ++i) y[i] = (h1[a][0][i] * ai + h2[a][0][i]) * rden;
                      *(half4*)(hout + (size_t)(rowbase + pos) * 384 + h * 64 + v0) = to_half4(y); } }
            }
            { const float sc = expf(tot + m_in - m_new);
#pragma unroll
              for (int q = 0; q < 2; ++q) accC[0][q] *= sc;
              mma_lds<1, 2>(accC, KT + (wave >> 1) * 16 * SB, SB, VW + (wave & 1) * 32 * SB, SB, 4, lane);
              if (tid < 64) { float s = 0.f; for (int k = 0; k < 128; ++k) s += ee[k] * (float)KT[tid * SB + k]; nvec[tid] = sc * nvec[tid] + s; } }
            m_in = m_new;
            __syncthreads();
#pragma unroll
            for (int q = 0; q < 2; ++q) { const int v = (wave & 1) * 32 + q * 16 + (lane & 15), d0 = (wave >> 1) * 16 + (lane >> 4) * 4; *(half4*)(CS + v * SA + d0) = to_half4(accC[0][q]); }
            __syncthreads();
        }
    }
}

__device__ __forceinline__ cplx cmul(cplx a, cplx b) { return cplx{a.x * b.x - a.y * b.y, a.x * b.y + a.y * b.x}; }
__device__ __forceinline__ cplx cadd(cplx a, cplx b) { return cplx{a.x + b.x, a.y + b.y}; }
__device__ __forceinline__ cplx csub(cplx a, cplx b) { return cplx{a.x - b.x, a.y - b.y}; }
__device__ __forceinline__ void sincos_turns(float x, float& s, float& c) {
#ifdef EMU
    s = sinf(6.283185307179586f * x); c = cosf(6.283185307179586f * x);
#else
    s = __builtin_amdgcn_sinf(x); c = __builtin_amdgcn_cosf(x);
#endif
}
#define PADI(i) ((i) + ((i) >> 5))
template <bool INV> __device__ __forceinline__ void r4(cplx& a0, cplx& a1, cplx& a2, cplx& a3) {
    const cplx t0 = cadd(a0, a2), t1 = csub(a0, a2), t2 = cadd(a1, a3), t3 = csub(a1, a3);
    a0 = cadd(t0, t2); a2 = csub(t0, t2);
    if (!INV) { a1 = cplx{t1.x + t3.y, t1.y - t3.x}; a3 = cplx{t1.x - t3.y, t1.y + t3.x}; }
    else      { a1 = cplx{t1.x - t3.y, t1.y + t3.x}; a3 = cplx{t1.x + t3.y, t1.y - t3.x}; }
}
template <bool INV> __device__ __forceinline__ void fft16(cplx (&v)[16]) {
#pragma unroll
    for (int l0 = 0; l0 < 4; ++l0) r4<INV>(v[l0], v[l0 + 4], v[l0 + 8], v[l0 + 12]);
    const float C1 = 0.9238795325112867f, S1 = 0.3826834323650898f, C2 = 0.7071067811865476f;
    const float sg = INV ? 1.f : -1.f;
#define TWM(idx, cr, ci) v[idx] = cmul(v[idx], cplx{(cr), sg * (ci)})
    TWM(1 + 4 * 1, C1, S1); TWM(2 + 4 * 1, C2, C2); TWM(3 + 4 * 1, S1, C1);
    TWM(1 + 4 * 2, C2, C2); TWM(2 + 4 * 2, 0.f, 1.f); TWM(3 + 4 * 2, -C2, C2);
    TWM(1 + 4 * 3, S1, C1); TWM(2 + 4 * 3, -C2, C2); TWM(3 + 4 * 3, -C1, -S1);
#undef TWM
    cplx o[16];
#pragma unroll
    for (int m0 = 0; m0 < 4; ++m0) { cplx a0 = v[4 * m0], a1 = v[4 * m0 + 1], a2 = v[4 * m0 + 2], a3 = v[4 * m0 + 3]; r4<INV>(a0, a1, a2, a3);
        o[m0] = a0; o[m0 + 4] = a1; o[m0 + 8] = a2; o[m0 + 12] = a3; }
#pragma unroll
    for (int i = 0; i < 16; ++i) v[i] = o[i];
}
__device__ __forceinline__ void twpow(cplx w1, cplx (&w)[16]) {
    w[1] = w1; w[2] = cmul(w1, w1); w[3] = cmul(w[2], w1); w[4] = cmul(w[2], w[2]); w[5] = cmul(w[4], w1); w[6] = cmul(w[4], w[2]); w[7] = cmul(w[4], w[3]); w[8] = cmul(w[4], w[4]);
#pragma unroll
    for (int m = 9; m < 16; ++m) w[m] = cmul(w[8], w[m - 8]);
}
__device__ __forceinline__ void fft_fwd16(cplx* buf, int N, int tid) {
    for (int n = N; n >= 32; n >>= 4) { const int q = n >> 4;
        for (int i = tid; i < N / 16; i += NT) {
            const int blk = i / q, j = i - blk * q, base = blk * n + j;
            cplx v[16];
#pragma unroll
            for (int l = 0; l < 16; ++l) v[l] = buf[PADI(base + l * q)];
            fft16<false>(v);
            float s, c; sincos_turns(-(float)j / (float)n, s, c);
            cplx w[16]; twpow(cplx{c, s}, w);
            buf[PADI(base)] = v[0];
#pragma unroll
            for (int m = 1; m < 16; ++m) buf[PADI(base + m * q)] = cmul(v[m], w[m]);
        }
        __syncthreads(); }
}
__device__ __forceinline__ void fft_inv16(cplx* buf, int N, int tid) {
    for (int n = 32; n <= N; n <<= 4) { const int q = n >> 4;
        for (int i = tid; i < N / 16; i += NT) {
            const int blk = i / q, j = i - blk * q, base = blk * n + j;
            float s, c; sincos_turns((float)j / (float)n, s, c);
            cplx w[16]; twpow(cplx{c, s}, w);
            cplx v[16];
            v[0] = buf[PADI(base)];
#pragma unroll
            for (int m = 1; m < 16; ++m) v[m] = cmul(buf[PADI(base + m * q)], w[m]);
            fft16<true>(v);
#pragma unroll
            for (int l = 0; l < 16; ++l) buf[PADI(base + l * q)] = v[l];
        }
        __syncthreads(); }
}
static_assert(2 * SEQ == 512 || 2 * SEQ == 8192 || 2 * SEQ == 131072, "FFT size must be 2*16^k");
static_assert(2 * CTXL == 512 || 2 * CTXL == 8192, "FFT size must be 2*16^k");
constexpr int HBUF = (2 * SEQ + (2 * SEQ) / 32 + 8);
__device__ __forceinline__ void hy_conv8(const half_t* p, int t0, int L, float w0, float w1, float w2, float bsv, float (&o)[8]) {
    const half8 m = *(const half8*)(p + t0);
    float e[10]; e[0] = t0 > 0 ? (float)p[t0 - 1] : 0.f; e[9] = t0 + 8 < L ? (float)p[t0 + 8] : 0.f;
#pragma unroll
    for (int i = 0; i < 8; ++i) e[i + 1] = (float)m[i];
#pragma unroll
    for (int i = 0; i < 8; ++i) o[i] = w0 * e[i] + w1 * e[i + 1] + w2 * e[i + 2] + bsv;
}
__device__ __forceinline__ void hyena_channel(const Frame& F, int layer, int c) {
    cplx* bufA = (cplx*)F.smem;
    cplx* bufH = bufA + HBUF;
    float* red = (float*)(bufH + HBUF);
    const int tid = F.tid;
    const float* cwp = F.in(I_HCW) + layer * 3 * 768; const float* cbp = F.in(I_HCB) + layer * 768;
    for (int seg = 0; seg < (layer == 0 ? 2 : 1); ++seg) {
        const int L = seg == 0 ? SEQ : CTXL, N = 2 * L;
        const half_t* hyt = (const half_t*)(F.ws + WS_HYT) + (seg == 0 ? 0 : (size_t)NB * 768 * SEQ);
        float* z1 = (float*)(F.ws + WS_XN) + (seg == 0 ? 0 : (size_t)NB * 256 * SEQ);
        float* yht = (float*)(F.ws + WS_YHT) + (seg == 0 ? 0 : (size_t)NB * 256 * SEQ);
        const float* ft = (const float*)(F.ws + WS_FT) + (seg == 0 ? (size_t)layer * 256 * 4 * SEQ : (size_t)2 * 256 * 4 * SEQ);
        for (int order = 0; order < 2; ++order) {
            const float* hfw = ft + ((size_t)(c * 2 + order) * 2 + 0) * L; const float* hbw = ft + ((size_t)(c * 2 + order) * 2 + 1) * L;
            float asum = 0.f;
            for (int i = tid; i < N; i += NT) { const float v = i < L ? hfw[i] : (i == L ? 0.f : hbw[N - i]); bufH[PADI(i)] = cplx{v, 0.f}; asum += fabsf(v); }
            asum = wave_sum(asum);
            if (F.lane == 0) red[F.wave] = asum;
            __syncthreads();
            float tot = 0.f; for (int w = 0; w < NT / 64; ++w) tot += red[w];
            const float scale = 1.0f / (tot * (float)N);
            fft_fwd16(bufH, N, tid);
            for (int i = tid; i < N / 2; i += NT) { const cplx a = bufH[PADI(2 * i)], b_ = bufH[PADI(2 * i + 1)]; const cplx s = cadd(a, b_), d = csub(a, b_);
                bufH[PADI(2 * i)] = cplx{s.x * scale, s.y * scale}; bufH[PADI(2 * i + 1)] = cplx{d.x * scale, d.y * scale}; }
            __syncthreads();
            const int gch = 256 * (order + 1) + c;
            const float gw0 = cwp[gch], gw1 = cwp[768 + gch], gw2 = cwp[1536 + gch], gb = cbp[gch];
            const float vw0 = cwp[c], vw1 = cwp[768 + c], vw2 = cwp[1536 + c], vb = cbp[c];
            const float skip = F.in(I_HSKIP)[(layer * 2 + order) * 256 + c];
            for (int pr = 0; pr < NB / 2; ++pr) {
                const int b0 = 2 * pr, b1 = b0 + 1;
                const half_t* v0p = hyt + ((size_t)b0 * 768 + c) * L; const half_t* v1p = hyt + ((size_t)b1 * 768 + c) * L;
                const float* z0q = z1 + ((size_t)b0 * 256 + c) * L; const float* z1q = z1 + ((size_t)b1 * 256 + c) * L;
                for (int t0 = tid * 8; t0 < N; t0 += NT * 8) {
                    if (t0 < L) { float za[8], zb[8];
                        if (order == 0) { hy_conv8(v0p, t0, L, vw0, vw1, vw2, vb, za); hy_conv8(v1p, t0, L, vw0, vw1, vw2, vb, zb); }
                        else {
#pragma unroll
                            for (int i = 0; i < 8; ++i) { za[i] = z0q[t0 + i]; zb[i] = z1q[t0 + i]; } }
#pragma unroll
                        for (int i = 0; i < 8; ++i) bufA[PADI(t0 + i)] = cplx{za[i], zb[i]}; }
                    else {
#pragma unroll
                        for (int i = 0; i < 8; ++i) bufA[PADI(t0 + i)] = cplx{0.f, 0.f}; }
                }
                __syncthreads();
                fft_fwd16(bufA, N, tid);
                for (int i = tid; i < N / 2; i += NT) { const cplx a = bufA[PADI(2 * i)], b_ = bufA[PADI(2 * i + 1)];
                    const cplx s = cmul(cadd(a, b_), bufH[PADI(2 * i)]), d = cmul(csub(a, b_), bufH[PADI(2 * i + 1)]);
                    bufA[PADI(2 * i)] = cadd(s, d); bufA[PADI(2 * i + 1)] = csub(s, d); }
                __syncthreads();
                fft_inv16(bufA, N, tid);
                const half_t* g0p = hyt + ((size_t)b0 * 768 + gch) * L; const half_t* g1p = hyt + ((size_t)b1 * 768 + gch) * L;
                float* d0 = (order == 0 ? z1 : yht) + ((size_t)b0 * 256 + c) * L; float* d1 = (order == 0 ? z1 : yht) + ((size_t)b1 * 256 + c) * L;
                for (int t0 = tid * 8; t0 < L; t0 += NT * 8) {
                    float za[8], zb[8], ga[8], gb_[8];
                    if (order == 0) { hy_conv8(v0p, t0, L, vw0, vw1, vw2, vb, za); hy_conv8(v1p, t0, L, vw0, vw1, vw2, vb, zb); }
                    else {
#pragma unroll
                        for (int i = 0; i < 8; ++i) { za[i] = z0q[t0 + i]; zb[i] = z1q[t0 + i]; } }
                    hy_conv8(g0p, t0, L, gw0, gw1, gw2, gb, ga); hy_conv8(g1p, t0, L, gw0, gw1, gw2, gb, gb_);
                    f32x4 oa[2], ob[2];
#pragma unroll
                    for (int i = 0; i < 8; ++i) { const cplx y = bufA[PADI(t0 + i)]; oa[i >> 2][i & 3] = ga[i] * (y.x + skip * za[i]); ob[i >> 2][i & 3] = gb_[i] * (y.y + skip * zb[i]); }
                    *(f32x4*)(d0 + t0) = oa[0]; *(f32x4*)(d0 + t0 + 4) = oa[1]; *(f32x4*)(d1 + t0) = ob[0]; *(f32x4*)(d1 + t0 + 4) = ob[1];
                }
                __syncthreads();
            }
        }
    }
}
__device__ __forceinline__ void phase_mixers(const Frame& F, int layer) {
    const int G = gridDim.x, bid = blockIdx.x;
    constexpr int NSCAN = 2 * NB * 6 * 2;
    if (bid < NSCAN) {
        const int k = bid >> 1, kind = bid & 1, dir = k % 2, h = (k / 2) % 6, b = k / 12;
#ifndef MIXMASK
#define MIXMASK 7
#endif
        if (kind == 0) { if (MIXMASK & 1) ssd_block(F, layer, b, h, dir); } else { if (MIXMASK & 2) mlstm_block(F, layer, b, h, dir); }
    } else {
        for (int c = bid - NSCAN; c < 256; c += G - NSCAN) if (MIXMASK & 4) hyena_channel(F, layer, c);
    }
}

__device__ __forceinline__ void phase_combine(const Frame& F, int layer) {
    const int nrows = layer == 0 ? TT : TL, total = nrows / 32;
    const half_t* u16 = (const half_t*)(F.ws + WS_U16);
    const half_t* yf = (const half_t*)(F.ws + WS_YF); const half_t* yb = yf + (size_t)TT * 384; const half_t* hf = yb + (size_t)TT * 384; const half_t* hb = hf + (size_t)TT * 384;
    half_t* yl = (half_t*)(F.ws + WS_XN);
    const float* snw = F.in(I_SNW) + layer * 384; const float* mnw = F.in(I_MNW) + layer * 384;
    for (int it = blockIdx.x; it < total; it += gridDim.x) {
        const int row0 = it * 32;
        for (int rr = F.wave; rr < 32; rr += NT / 64) {
            const int row = row0 + rr;
            float g[6]; float ss = 0.f;
#pragma unroll
            for (int i = 0; i < 6; ++i) { const int k = i * 64 + F.lane; const float y = (float)yf[(size_t)row * 384 + k] + (float)yb[(size_t)row * 384 + k];
                g[i] = y * siluf((float)u16[(size_t)row * UW + k]); ss += g[i] * g[i]; }
            ss = wave_sum(ss);
            const float rs = 1.0f / sqrtf(ss * (1.0f / 384.f) + EPSF);
#pragma unroll
            for (int i = 0; i < 6; ++i) { const int k = i * 64 + F.lane; yl[(size_t)row * D + k] = (half_t)(g[i] * rs * snw[k]); }
#pragma unroll
            for (int i = 0; i < 6; ++i) { const int k = i * 64 + F.lane; const float hv = (float)hf[(size_t)row * 384 + k] + (float)hb[(size_t)row * 384 + k];
                const float mu = wave_sum(hv) * (1.0f / 64.f); const float hc = hv - mu; const float var = wave_sum(hc * hc) * (1.0f / 64.f);
                const float hn = hc * (1.0f / sqrtf(var + EPSF)) * mnw[k];
                yl[(size_t)row * D + 640 + k] = (half_t)(sigmoidf_((float)u16[(size_t)row * UW + 2176 + k]) * hn); }
        }
        { const bool isl = row0 < TL; const int L = isl ? SEQ : CTXL; const int rc = isl ? row0 : row0 - TL; const int b = rc / L, t0 = rc % L;
          const float* yht = (const float*)(F.ws + WS_YHT) + (isl ? 0 : (size_t)NB * 256 * SEQ);
          if (F.tid < 256) { const int c = F.tid; const float* src = yht + ((size_t)b * 256 + c) * L + t0;
              for (int i = 0; i < 32; ++i) yl[(size_t)(row0 + i) * D + 384 + c] = (half_t)src[i]; } }
    }
}

struct EpiOutproj {
    Frame F; int layer;
    __device__ __forceinline__ void operator()(const f32x4 (&acc)[2][2][4][2], const g8::Unit& u, int wr, int wc, int fr, int fq) const {
#pragma unroll
        for (int ai = 0; ai < 2; ++ai)
#pragma unroll
            for (int m = 0; m < 4; ++m) {
                const int srow = u.pm * 256 + ai * 128 + wr * 64 + m * 16 + fr;
                int row = srow;
                if (layer == 1 && srow < TL) { const int b = srow / SEQ, s = srow % SEQ; row = b * SEQ + (s % GROWS) * GW + s / GROWS; }
                const float* g1 = modp(F, layer, row_mod(row), 2);
                const float* xi = F.xrow_in(layer, row); float* xo = F.xrow(row);
#pragma unroll
                for (int bj = 0; bj < 2; ++bj)
#pragma unroll
                    for (int n = 0; n < 2; ++n) { const int c0 = u.pn * 256 + bj * 128 + wc * 32 + n * 16 + 4 * fq;
                        const f32x4 xv = *(const f32x4*)(xi + c0), gv = *(const f32x4*)(g1 + c0);
                        *(f32x4*)(xo + c0) = xv + gv * acc[ai][bj][m][n]; }
#ifndef EMU
                asm volatile("" ::: "memory");
#endif
            }
    }
};
__device__ __forceinline__ void phase_outproj(const Frame& F, int layer) {
    const int nrows = layer == 0 ? TT : TL;
    g8::DenseSched S; S.abase = (const char*)(F.ws + WS_XN); S.bbase = (const char*)((const half_t*)(F.ws + WS_WOUT) + (size_t)layer * D * D); S.K = D; S.nM = nrows / 256; S.nN = D / 256; S.G = gridDim.x; S.c = blockIdx.x;
    EpiOutproj E{F, layer};
    g8::gemm_phase(F.smem, D, S, E);
}

constexpr int RLD = D + 8;
__device__ __forceinline__ void phase_router(const Frame& F, int layer) {
    const int nrows = layer == 0 ? TT : TL, total = nrows / 32;
    half_t* Th = (half_t*)F.smem;
    half_t* Tl = Th + 32 * RLD;
    float* LG = (float*)(Tl + 32 * RLD);
    half_t* tb = (half_t*)(F.ws + WS_XN);
    unsigned* cnt = (unsigned*)(F.ws + WS_CTL) + CW_CNT + layer * 64;
    int* list = (int*)(F.ws + WS_LIST); float* pw = (float*)(F.ws + WS_PW);
    const float* nw = F.in(I_N2W) + layer * D;
    const half_t* wr = (const half_t*)(F.ws + WS_WR) + (size_t)layer * 2 * 48 * D;
    for (int it = blockIdx.x; it < total; it += gridDim.x) {
        const int row0 = it * 32;
        for (int rr = F.wave; rr < 32; rr += NT / 64) {
            const int row = row0 + rr, m = row_mod(row);
            const float* x = F.xrow(row);
            float v[16]; float ss = 0.f;
#pragma unroll
            for (int q = 0; q < 4; ++q) { const f32x4 t = *(const f32x4*)(x + q * 256 + F.lane * 4); v[q * 4 + 0] = t[0]; v[q * 4 + 1] = t[1]; v[q * 4 + 2] = t[2]; v[q * 4 + 3] = t[3]; ss += t[0] * t[0] + t[1] * t[1] + t[2] * t[2] + t[3] * t[3]; }
            ss = wave_sum(ss);
            const float rs = 1.0f / sqrtf(ss * (1.0f / D) + EPSF);
            const float* sh = modp(F, layer, m, 3); const float* scl = modp(F, layer, m, 4);
#pragma unroll
            for (int q = 0; q < 4; ++q) { const int k = q * 256 + F.lane * 4; half4 h, l;
#pragma unroll
                for (int e = 0; e < 4; ++e) { const float tv = v[q * 4 + e] * rs * nw[k + e] * (1.0f + scl[k + e]) + sh[k + e]; h[e] = (half_t)tv; l[e] = (half_t)((tv - (float)h[e]) * 2048.f); }
                *(half4*)(tb + (size_t)row * D + k) = h; *(half4*)(Th + rr * RLD + k) = h; *(half4*)(Tl + rr * RLD + k) = l; }
        }
        __syncthreads();
        {
            const int kb = F.wave * 128, r = F.lane & 15, kq = (F.lane >> 4) * 8;
            f32x4 ah[2][3], al[2][3]; zero_acc(ah); zero_acc(al);
#pragma unroll
            for (int hf = 0; hf < 2; ++hf) {
                half8 bh[3][2], bl[3][2];
#pragma unroll
                for (int nt = 0; nt < 3; ++nt)
#pragma unroll
                    for (int ks = 0; ks < 2; ++ks) { const size_t o = (size_t)(nt * 16 + r) * D + kb + (hf * 2 + ks) * 32 + kq; bh[nt][ks] = *(const half8*)(wr + o); bl[nt][ks] = *(const half8*)(wr + (size_t)48 * D + o); }
#pragma unroll
                for (int ks = 0; ks < 2; ++ks)
#pragma unroll
                    for (int mt = 0; mt < 2; ++mt) {
                        const half8 a_h = *(const half8*)(Th + (mt * 16 + r) * RLD + kb + (hf * 2 + ks) * 32 + kq), a_l = *(const half8*)(Tl + (mt * 16 + r) * RLD + kb + (hf * 2 + ks) * 32 + kq);
#pragma unroll
                        for (int nt = 0; nt < 3; ++nt) { ah[mt][nt] = mfma16(a_h, bh[nt][ks], ah[mt][nt]); al[mt][nt] = mfma16(a_l, bh[nt][ks], al[mt][nt]); al[mt][nt] = mfma16(a_h, bl[nt][ks], al[mt][nt]); }
                    }
            }
            __syncthreads();
            float* PART = (float*)Th;
#pragma unroll
            for (int mt = 0; mt < 2; ++mt)
#pragma unroll
                for (int nt = 0; nt < 3; ++nt)
#pragma unroll
                    for (int i = 0; i < 4; ++i) PART[(F.wave * 32 + mt * 16 + (F.lane >> 4) * 4 + i) * 48 + nt * 16 + r] = ah[mt][nt][i] + al[mt][nt][i] * (1.0f / 2048.f);
            __syncthreads();
            for (int o = F.tid; o < 32 * 48; o += NT) { const int col = o % 48; float sum = 0.f;
#pragma unroll
                for (int w = 0; w < 8; ++w) sum += PART[w * 32 * 48 + o];
                float bias = 0.f; if (col < 4) bias = F.in(I_GRB)[layer * 4 + col]; else if (col < 36) bias = F.in(I_ERB)[layer * 32 + col - 4];
                LG[o] = sum + bias; }
        }
        __syncthreads();
        if (F.tid < 32) {
            const int row = row0 + F.tid; const float* lg = LG + F.tid * 48;
            int gi = 0; float gm = lg[0];
            for (int q = 1; q < 4; ++q) if (lg[q] > gm) { gm = lg[q]; gi = q; }
            float gs = 0.f; for (int q = 0; q < 4; ++q) gs += expf(lg[q] - gm);
            const float grp_p = 1.0f / gs;
            const float* el = lg + 4 + gi * 8;
            int i0 = 0; float e0 = el[0];
            for (int q = 1; q < 8; ++q) if (el[q] > e0) { e0 = el[q]; i0 = q; }
            int i1 = -1; float e1 = -3.0e38f;
            for (int q = 0; q < 8; ++q) if (q != i0 && el[q] > e1) { e1 = el[q]; i1 = q; }
            const float p1 = expf(e1 - e0);
            const float w0 = grp_p * (1.0f / (1.0f + p1)), w1 = grp_p * (p1 / (1.0f + p1));
            const int ea = gi * 8 + i0, eb = gi * 8 + i1;
            const unsigned pa = atomicAdd(&cnt[ea * 2 + 0], 1u), pb = atomicAdd(&cnt[eb * 2 + 1], 1u);
            list[(size_t)(ea * 2 + 0) * LCAP + pa] = row * 2 + 0; list[(size_t)(eb * 2 + 1) * LCAP + pb] = row * 2 + 1;
            pw[row * 2 + 0] = w0; pw[row * 2 + 1] = w1;
        }
        __syncthreads();
    }
}

constexpr int MOE_PRE_OFF = g8::STAGE_BYTES;
struct MoeSchedA {
    const char* abase; const char* wbase; const int* pre; const unsigned* cnt; const int* list; int G, c;
    __device__ __forceinline__ int entry(int e, int r) const { const int c0 = (int)cnt[e * 2]; return r < c0 ? list[(size_t)(e * 2) * LCAP + r] : list[(size_t)(e * 2 + 1) * LCAP + (r - c0)]; }
    __device__ __forceinline__ bool next(int i, g8::Unit& u) const {
        const int L = i * G + c; if (L >= pre[32]) return false;
        int e = 0; while (L >= pre[e + 1]) ++e;
        const int loc = L - pre[e]; u.e = e; u.n = (int)(cnt[e * 2] + cnt[e * 2 + 1]); u.pm = loc >> 1; u.pn = loc & 1; return true;
    }
    __device__ __forceinline__ unsigned a_off(const g8::Unit& u, int r) const { const int rr = u.pm * 256 + r; const int pid = entry(u.e, rr < u.n ? rr : 0); return (unsigned)(pid >> 1) * (unsigned)(D * 2); }
    __device__ __forceinline__ const char* b_half(const g8::Unit& u, int h) const { return wbase + ((size_t)u.e * 3 * 262144 + (size_t)h * 262144 + (size_t)u.pn * 128 * D) * 2; }
};
struct EpiMoeA {
    MoeSchedA S; const float* pw; half_t* hid;
    __device__ __forceinline__ void operator()(const f32x4 (&acc)[2][2][4][2], const g8::Unit& u, int wr, int wc, int fr, int fq) const {
#pragma unroll
        for (int ai = 0; ai < 2; ++ai)
#pragma unroll
            for (int m = 0; m < 4; ++m) {
                const int rr = u.pm * 256 + ai * 128 + wr * 64 + m * 16 + fr;
                if (rr < u.n) { const int pid = S.entry(u.e, rr); const float w = pw[pid];
#pragma unroll
                    for (int n = 0; n < 2; ++n) { const int f = u.pn * 128 + wc * 32 + n * 16 + 4 * fq; const f32x4 g = acc[ai][0][m][n], up = acc[ai][1][m][n]; f32x4 o;
#pragma unroll
                        for (int i = 0; i < 4; ++i) o[i] = siluf(g[i]) * up[i] * w;
                        *(half4*)(hid + (size_t)pid * 256 + f) = to_half4(o); } }
            }
    }
};
__device__ __forceinline__ void phase_moe_a(const Frame& F, int layer) {
    int* pre = (int*)(F.smem + MOE_PRE_OFF);
    const unsigned* cnt = (const unsigned*)(F.ws + WS_CTL) + CW_CNT + layer * 64;
    if (F.tid == 0) { int s = 0; for (int e = 0; e < 32; ++e) { pre[e] = s; s += (((int)(cnt[e * 2] + cnt[e * 2 + 1]) + 255) / 256) * 2; } pre[32] = s; }
    __syncthreads();
    MoeSchedA S; S.abase = (const char*)(F.ws + WS_XN); S.wbase = (const char*)(F.ws + WS_WMOE); S.pre = pre; S.cnt = cnt; S.list = (const int*)(F.ws + WS_LIST); S.G = gridDim.x; S.c = blockIdx.x;
    EpiMoeA E{S, (const float*)(F.ws + WS_PW), (half_t*)(F.ws + WS_U16)};
    g8::gemm_phase(F.smem, D, S, E);
    __syncthreads();
}
struct MoeSchedB {
    const char* abase; const char* wbase; const int* pre; const unsigned* cnt; const int* list; int slot, G, c;
    __device__ __forceinline__ bool next(int i, g8::Unit& u) const {
        const int L = i * G + c; if (L >= pre[32]) return false;
        int e = 0; while (L >= pre[e + 1]) ++e;
        const int loc = L - pre[e]; u.e = e; u.n = (int)cnt[e * 2 + slot]; u.pm = loc >> 2; u.pn = loc & 3; return true;
    }
    __device__ __forceinline__ int entry(const g8::Unit& u, int rr) const { return list[(size_t)(u.e * 2 + slot) * LCAP + (rr < u.n ? rr : 0)]; }
    __device__ __forceinline__ unsigned a_off(const g8::Unit& u, int r) const { return (unsigned)entry(u, u.pm * 256 + r) * 512u; }
    __device__ __forceinline__ const char* b_half(const g8::Unit& u, int h) const { return wbase + ((size_t)u.e * 3 * 262144 + 2 * 262144 + (size_t)(u.pn * 256 + h * 128) * 256) * 2; }
};
struct EpiMoeB {
    MoeSchedB S; Frame F; int layer;
    __device__ __forceinline__ void operator()(const f32x4 (&acc)[2][2][4][2], const g8::Unit& u, int wr, int wc, int fr, int fq) const {
#pragma unroll
        for (int ai = 0; ai < 2; ++ai)
#pragma unroll
            for (int m = 0; m < 4; ++m) {
                const int rr = u.pm * 256 + ai * 128 + wr * 64 + m * 16 + fr;
                if (rr < u.n) { const int row = S.entry(u, rr) >> 1; float* xo = F.xrow(row); const float* g5 = modp(F, layer, row_mod(row), 5);
#pragma unroll
                    for (int bj = 0; bj < 2; ++bj) {
#pragma unroll
                        for (int n = 0; n < 2; ++n) { const int d = u.pn * 256 + bj * 128 + wc * 32 + n * 16 + 4 * fq;
                            const f32x4 xv = *(const f32x4*)(xo + d), gv = *(const f32x4*)(g5 + d); *(f32x4*)(xo + d) = xv + gv * acc[ai][bj][m][n]; }
#ifndef EMU
                        asm volatile("" ::: "memory");
#endif
                    } }
            }
    }
};
__device__ __forceinline__ void phase_moe_b(const Frame& F, int layer, int slot) {
    int* pre = (int*)(F.smem + MOE_PRE_OFF);
    const unsigned* cnt = (const unsigned*)(F.ws + WS_CTL) + CW_CNT + layer * 64;
    if (F.tid == 0) { int s = 0; for (int e = 0; e < 32; ++e) { pre[e] = s; s += (((int)cnt[e * 2 + slot] + 255) / 256) * 4; } pre[32] = s; }
    __syncthreads();
    MoeSchedB S; S.abase = (const char*)(F.ws + WS_U16); S.wbase = (const char*)(F.ws + WS_WMOE); S.pre = pre; S.cnt = cnt; S.list = (const int*)(F.ws + WS_LIST); S.slot = slot; S.G = gridDim.x; S.c = blockIdx.x;
    EpiMoeB E{S, F, layer};
    g8::gemm_phase(F.smem, 256, S, E);
    __syncthreads();
}

__device__ __forceinline__ void phase_final(const Frame& F) {
    const float* fw = F.in(I_FNW);
    for (int it = blockIdx.x; it < TL / 16; it += gridDim.x) {
        for (int rr = F.wave; rr < 16; rr += NT / 64) {
            float* x = F.P->out + (size_t)(it * 16 + rr) * D;
            f32x4 v[4]; float ss = 0.f;
#pragma unroll
            for (int q = 0; q < 4; ++q) { v[q] = *(const f32x4*)(x + q * 256 + F.lane * 4); ss += v[q][0] * v[q][0] + v[q][1] * v[q][1] + v[q][2] * v[q][2] + v[q][3] * v[q][3]; }
            ss = wave_sum(ss);
            const float rs = 1.0f / sqrtf(ss * (1.0f / D) + EPSF);
#pragma unroll
            for (int q = 0; q < 4; ++q) { const int k = q * 256 + F.lane * 4; f32x4 o;
#pragma unroll
                for (int e = 0; e < 4; ++e) o[e] = v[q][e] * rs * fw[k + e];
                *(f32x4*)(x + k) = o; }
        }
    }
}

constexpr int NPHASE = 1 + 2 * 9 + 1;
#ifndef ONLY
#define ONLY -1
#endif
#define EN(x) (ONLY < 0 || ONLY == (x))
__device__ __forceinline__ void run_phase(const Frame& F, int ph) {
    if (ph == 0) { if (EN(0)) phase_setup(F); return; }
    if (ph == NPHASE - 1) { if (EN(10)) phase_final(F); return; }
    const int layer = (ph - 1) / 9, k = (ph - 1) % 9;
    switch (k) {
        case 0: if (EN(1)) phase_norm1(F, layer); break;
        case 1: if (EN(2)) phase_inproj(F, layer); break;
        case 2: if (EN(3)) phase_mixers(F, layer); break;
        case 3: if (EN(4)) phase_combine(F, layer); break;
        case 4: if (EN(5)) phase_outproj(F, layer); break;
        case 5: if (EN(6)) phase_router(F, layer); break;
        case 6: if (EN(7)) phase_moe_a(F, layer); break;
        case 7: if (EN(8)) phase_moe_b(F, layer, 0); break;
        default: if (EN(9)) phase_moe_b(F, layer, 1); break;
    }
}

#ifdef EMU
void mega(const Params* Pp) {
    Frame F; F.P = Pp; F.ws = Pp->ws; F.smem = emu_blk->smem; F.tid = threadIdx.x; F.lane = F.tid & 63; F.wave = F.tid >> 6;
    for (int ph = Pp->ph_lo; ph < Pp->ph_hi; ++ph) { run_phase(F, ph); __syncthreads(); }
}
#else
__global__ void __launch_bounds__(NT) mega(Params P) {
    extern __shared__ __attribute__((aligned(16))) unsigned char smem_dyn[];
    cg::grid_group grid = cg::this_grid();
    Frame F; F.P = (ParamsPtr)__builtin_amdgcn_kernarg_segment_ptr(); F.ws = P.ws; F.smem = smem_dyn; F.tid = threadIdx.x; F.lane = F.tid & 63; F.wave = F.tid >> 6;
    volatile LAS unsigned* bst = (volatile LAS unsigned*)(smem_dyn + LDS_BYTES - 16);
    if (F.tid < 4) bst[F.tid] = 0u;
    __syncthreads();
    XcdBarrier xb = xcd_barrier_post((unsigned*)(P.ws + WS_CTL) + CW_BAR, bst);
    if (P.ph_lo < 0) grid.sync();
#define PHASE_STEP(i) if (P.ph_lo <= (i) && (i) < P.ph_hi) { run_phase(F, (i)); if ((i) + 1 < P.ph_hi) xcd_barrier(xb); }
    PHASE_STEP(0) PHASE_STEP(1) PHASE_STEP(2) PHASE_STEP(3) PHASE_STEP(4) PHASE_STEP(5) PHASE_STEP(6) PHASE_STEP(7) PHASE_STEP(8) PHASE_STEP(9)
    PHASE_STEP(10) PHASE_STEP(11) PHASE_STEP(12) PHASE_STEP(13) PHASE_STEP(14) PHASE_STEP(15) PHASE_STEP(16) PHASE_STEP(17) PHASE_STEP(18) PHASE_STEP(19)
    static_assert(NPHASE == 20, "phase list");
}

extern "C" void kernel_launch(void* const* d_in, const int* in_sizes, int n_in, void* d_out, int out_size, void* d_ws, size_t ws_size, hipStream_t stream) {
    static int grid_blocks = 0;
    if (grid_blocks == 0) {
        if (n_in != 38 || out_size != TL * D || ws_size < WS_END) { fprintf(stderr, "kernel_launch: unexpected shapes (n_in %d out %d ws %zu need %zu)\n", n_in, out_size, ws_size, (size_t)WS_END); grid_blocks = -1; return; }
        int dev = 0, cus = 0, per_cu = 0;
        hipGetDevice(&dev);
        hipDeviceGetAttribute(&cus, hipDeviceAttributeMultiprocessorCount, dev);
        hipFuncSetAttribute((const void*)mega, hipFuncAttributeMaxDynamicSharedMemorySize, LDS_BYTES);
        hipOccupancyMaxActiveBlocksPerMultiprocessor(&per_cu, (const void*)mega, NT, LDS_BYTES);
        if (per_cu < 1) { fprintf(stderr, "kernel_launch: occupancy query says 0 blocks per CU\n"); grid_blocks = -1; return; }
        grid_blocks = cus;
    }
    if (grid_blocks < 0) return;
    if (hipMemsetAsync((char*)d_ws + WS_CTL, 0, CTL_BYTES, stream) != hipSuccess) { fprintf(stderr, "kernel_launch: memset failed\n"); return; }
    Params p{};
    for (int i = 0; i < 38; ++i) p.in[i] = (const float*)d_in[i];
    p.out = (float*)d_out; p.ws = (unsigned char*)d_ws; p.ph_lo = 0; p.ph_hi = NPHASE;
    void* args[] = {&p};
    hipError_t e = hipLaunchCooperativeKernel((const void*)mega, dim3(grid_blocks), dim3(NT), args, LDS_BYTES, stream);
    if (e != hipSuccess) fprintf(stderr, "cooperative launch failed: %s (grid %d)\n", hipGetErrorString(e), grid_blocks);
}
#endif
```

```cpp
#ifdef EMU
#include "gpuemu.h"
#else
#include <hip/hip_runtime.h>
#include <hip/hip_cooperative_groups.h>
#include <cstdio>
namespace cg = cooperative_groups;
#endif
#include <stdint.h>

#ifndef CFG_B
#define CFG_B 4
#endif
#ifndef CFG_SEQ
#define CFG_SEQ 4096
#endif
#ifndef CFG_CTX
#define CFG_CTX 256
#endif

typedef _Float16 half_t;
typedef _Float16 half8 __attribute__((ext_vector_type(8)));
typedef _Float16 half4 __attribute__((ext_vector_type(4)));
typedef float f32x4 __attribute__((ext_vector_type(4)));
struct cplx { float x, y; };

constexpr int D = 1024, NB = CFG_B, SEQ = CFG_SEQ, CTXL = CFG_CTX, GW = 64, GROWS = SEQ / GW;
constexpr int TL = NB * SEQ, TC = NB * CTXL, TT = TL + TC;
constexpr int NIN = 3364, NINP = 3584;
constexpr int UW = 2560;
constexpr int UGW = 36;
constexpr int NT = 512;
constexpr int TWN = 2 * SEQ > 2 * CTXL ? 2 * SEQ : 2 * CTXL;
constexpr int NMOD = 6 * D;
constexpr int LCAP = TT;
constexpr float EPSF = 1e-6f;

constexpr size_t al256(size_t x) { return (x + 255) / 256 * 256; }
constexpr size_t WS_CTL    = 0;
constexpr size_t WS_MOD    = 32768;
constexpr size_t WS_TW     = WS_MOD + al256(sizeof(float) * 2 * 5 * NMOD);
constexpr size_t WS_WIN    = WS_TW + al256(sizeof(cplx) * TWN);
constexpr size_t WS_WOUT   = WS_WIN + al256(2ull * 2 * NINP * D);
constexpr size_t WS_WMOE   = WS_WOUT + al256(2ull * 2 * D * D);
constexpr size_t WS_XC     = WS_WMOE + al256(2ull * 32 * 3 * 262144);
constexpr size_t WS_XN     = WS_XC + al256(4ull * TC * D);
constexpr size_t WS_U16    = WS_XN + al256(2ull * TT * D);
constexpr size_t WS_UG     = WS_U16 + al256(2ull * TT * UW);
constexpr size_t WS_HYT    = WS_UG + al256(4ull * TT * UGW);
constexpr size_t WS_YF     = WS_HYT + al256(2ull * NB * 768 * (SEQ + CTXL));
constexpr size_t WS_YHT    = WS_YF + al256(2ull * 4 * TT * 384);
constexpr size_t WS_FT     = WS_YHT + al256(4ull * NB * 256 * (SEQ + CTXL));
constexpr size_t WS_LIST   = WS_FT + al256(4ull * (2 * 256 * 4 * SEQ + 256 * 4 * CTXL));
constexpr size_t WS_PW     = WS_LIST + al256(4ull * 64 * LCAP);
constexpr size_t WS_WR     = WS_PW + al256(4ull * TT * 2);
constexpr size_t WS_END    = WS_WR + al256(2ull * 2 * 2 * 48 * D);
static_assert(4ull * NB * 256 * (SEQ + CTXL) <= 2ull * TT * D, "Z1 scratch must fit in the XN region");
static_assert(2ull * TT * 2 * 256 <= 2ull * TT * UW, "HID must fit in the U16 region");

constexpr int CW_CNT = 0;
constexpr int CW_BAR = 1024;
constexpr size_t CTL_BYTES = 32768;

constexpr int LDS_BYTES = 156 * 1024;

struct Params {
    const float* in[38];
    float* out;
    unsigned char* ws;
    int ph_lo, ph_hi;
};

enum { I_X = 0, I_C, I_CTX, I_CCTX, I_WMOD, I_BMOD, I_N1W, I_N2W, I_WIN, I_WOUT, I_SCW, I_SCB, I_DTB, I_ALOG, I_SD, I_SNW,
       I_HCW, I_HCB, I_HW1, I_HB1, I_HW2, I_HB2, I_HW3, I_HFREQ, I_HDEC, I_HSKIP, I_MCW, I_MCB, I_MGB, I_MNW,
       I_GRW, I_GRB, I_ERW, I_ERB, I_MG, I_MU, I_MD, I_FNW };

__device__ __forceinline__ float siluf(float x) { return x / (1.0f + expf(-x)); }
__device__ __forceinline__ float sigmoidf_(float x) { return 1.0f / (1.0f + expf(-x)); }
__device__ __forceinline__ float softplusf_(float x) { return x > 20.f ? x : log1pf(expf(x)); }
__device__ __forceinline__ float logsigmoidf_(float x) { return fminf(x, 0.f) - log1pf(expf(-fabsf(x))); }

__device__ __forceinline__ float fexp(float x) {
#ifdef EMU
    return expf(x);
#else
    return __expf(x);
#endif
}
__device__ __forceinline__ float fsilu(float x) {
#ifdef EMU
    return x / (1.0f + expf(-x));
#else
    return __fdividef(x, 1.0f + __expf(-x));
#endif
}
__device__ __forceinline__ float wave_sum(float v) {
#pragma unroll
    for (int m = 32; m >= 1; m >>= 1) v += __shfl_xor(v, m);
    return v;
}
__device__ __forceinline__ float wave_max(float v) {
#pragma unroll
    for (int m = 32; m >= 1; m >>= 1) v = fmaxf(v, __shfl_xor(v, m));
    return v;
}
__device__ __forceinline__ float wave_scan_sum(float v, int lane) {
#pragma unroll
    for (int d = 1; d < 64; d <<= 1) { float o = __shfl_up(v, d); if (lane >= d) v += o; }
    return v;
}
__device__ __forceinline__ float wave_scan_max(float v, int lane) {
#pragma unroll
    for (int d = 1; d < 64; d <<= 1) { float o = __shfl_up(v, d); if (lane >= d) v = fmaxf(v, o); }
    return v;
}

template <int MT, int NTL>
__device__ __forceinline__ void mma_lds(f32x4 (&acc)[MT][NTL], const half_t* A, int lda, const half_t* B, int ldb, int ksteps, int lane) {
#ifndef EMU
    const int r = lane & 15, kq = (lane >> 4) * 8;
    for (int ks = 0; ks < ksteps; ++ks) {
        half8 a[MT], b[NTL];
#pragma unroll
        for (int mt = 0; mt < MT; ++mt) a[mt] = *(const half8*)(A + (mt * 16 + r) * lda + ks * 32 + kq);
#pragma unroll
        for (int nt = 0; nt < NTL; ++nt) b[nt] = *(const half8*)(B + (nt * 16 + r) * ldb + ks * 32 + kq);
#pragma unroll
        for (int mt = 0; mt < MT; ++mt)
#pragma unroll
            for (int nt = 0; nt < NTL; ++nt) acc[mt][nt] = __builtin_amdgcn_mfma_f32_16x16x32_f16(a[mt], b[nt], acc[mt][nt], 0, 0, 0);
    }
#else
    for (int mt = 0; mt < MT; ++mt) for (int nt = 0; nt < NTL; ++nt) for (int i = 0; i < 4; ++i) {
        const int row = mt * 16 + (lane >> 4) * 4 + i, col = nt * 16 + (lane & 15);
        float s = acc[mt][nt][i];
        for (int k = 0; k < ksteps * 32; ++k) s += (float)A[row * lda + k] * (float)B[col * ldb + k];
        acc[mt][nt][i] = s;
    }
#endif
}

__device__ __forceinline__ f32x4 mfma16(half8 a, half8 b, f32x4 c) {
#ifdef EMU
    return emu_mfma16(a, b, c);
#else
    return __builtin_amdgcn_mfma_f32_16x16x32_f16(a, b, c, 0, 0, 0);
#endif
}
template <int MT, int NTL> __device__ __forceinline__ void zero_acc(f32x4 (&acc)[MT][NTL]) {
#pragma unroll
    for (int mt = 0; mt < MT; ++mt)
#pragma unroll
        for (int nt = 0; nt < NTL; ++nt) acc[mt][nt] = (f32x4){0.f, 0.f, 0.f, 0.f};
}

__device__ __forceinline__ void load_taps4(const float* cw, const float* cb, int C, int ch, int dir, f32x4& w0, f32x4& w1, f32x4& w2, f32x4& wb) {
    w0 = *(const f32x4*)(cw + (dir ? 2 : 0) * C + ch); w1 = *(const f32x4*)(cw + C + ch); w2 = *(const f32x4*)(cw + (dir ? 0 : 2) * C + ch); wb = *(const f32x4*)(cb + ch);
}
#ifdef EMU
#define LOADER_FENCE()
#else
#define LOADER_FENCE() asm volatile("" ::: "memory")
#endif
#define CONV4(k, i) (w0[i] * (float)rr[k][hh * 4 + i] + w1[i] * (float)rr[(k) + 1][hh * 4 + i] + w2[i] * (float)rr[(k) + 2][hh * 4 + i] + wb[i])
__device__ __forceinline__ half4 to_half4(const f32x4 v) { half4 h; h[0] = (half_t)v[0]; h[1] = (half_t)v[1]; h[2] = (half_t)v[2]; h[3] = (half_t)v[3]; return h; }
namespace g8 {
constexpr int BM = 256, BK = 64, HALF = 128, HTB = HALF * BK * 2, STAGE_BYTES = 8 * HTB;
__device__ __forceinline__ int lds_byte(int r, int c) { const int st = (r >> 4) * 2 + (c >> 5), rr = r & 15, cc = c & 31, ob = rr * 64 + cc * 2; return st * 1024 + (ob ^ (((ob >> 9) & 1) << 5)); }
__device__ __forceinline__ void stage_rc(int b, int& R, int& C) { const int st = b / 1024, sb = b % 1024, swz = sb ^ (((sb >> 9) & 1) << 5); R = (st >> 1) * 16 + swz / 64; C = (st & 1) * 32 + (swz % 64) / 2; }
struct Unit { int pm, pn, e, n; };

struct DenseSched {
    const char* abase; const char* bbase; int K, nM, nN, G, c;
    __device__ __forceinline__ bool next(int i, Unit& u) const {
        const int nwg = nM * nN; const long L = (long)i * G + c; if (L >= nwg) return false;
        int wgid = (int)L; { const int q = nwg / 8, r = nwg % 8, xcd = wgid % 8, off = wgid / 8; wgid = (xcd < r ? xcd * (q + 1) : r * (q + 1) + (xcd - r) * q) + off; }
        const int nig = 8 * nN, gid = wgid / nig, fm = gid * 8, gsz = (nM - fm) < 8 ? (nM - fm) : 8;
        u.pm = fm + ((wgid % nig) % gsz); u.pn = (wgid % nig) / gsz; u.e = 0; u.n = 0; return true;
    }
    __device__ __forceinline__ unsigned a_off(const Unit& u, int r) const { return (unsigned)((size_t)(u.pm * 256 + r) * K * 2); }
    __device__ __forceinline__ const char* b_half(const Unit& u, int h) const { return bbase + (size_t)(u.pn * 256 + h * 128) * K * 2; }
};

template <class Epi, class Sched>
__device__ __forceinline__ void gemm_phase(unsigned char* smem, const int K, const Sched& S, const Epi& E) {
    const int tid = threadIdx.x, lane = tid & 63;
#ifdef EMU
    const int wid = tid >> 6, wr = wid >> 2, wc = wid & 3, fr = lane & 15, fq = lane >> 4;
    half_t* As = (half_t*)smem; half_t* Bs = As + 256 * 72;
    Unit cur;
    for (int ui = 0; S.next(ui, cur); ++ui) {
        f32x4 acc[2][2][4][2];
        for (int a = 0; a < 2; ++a) for (int b = 0; b < 2; ++b) for (int m = 0; m < 4; ++m) for (int n = 0; n < 2; ++n) acc[a][b][m][n] = (f32x4){0.f, 0.f, 0.f, 0.f};
        for (int kt = 0; kt < K / 64; ++kt) {
            { const int row = tid >> 1, c0 = (tid & 1) * 32;
              const half_t* sa = (const half_t*)(S.abase + S.a_off(cur, row)) + kt * 64 + c0;
              const half_t* sb = (const half_t*)(S.b_half(cur, row >> 7)) + (size_t)(row & 127) * K + kt * 64 + c0;
              for (int q = 0; q < 32; ++q) { As[row * 72 + c0 + q] = sa[q]; Bs[row * 72 + c0 + q] = sb[q]; } }
            __syncthreads();
            for (int a = 0; a < 2; ++a) for (int b = 0; b < 2; ++b) for (int m = 0; m < 4; ++m) for (int n = 0; n < 2; ++n) for (int i = 0; i < 4; ++i) {
                const int row = 128 * a + 64 * wr + 16 * m + fr, col = 128 * b + 32 * wc + 16 * n + 4 * fq + i; float s = acc[a][b][m][n][i];
                for (int k = 0; k < 64; ++k) s += (float)As[row * 72 + k] * (float)Bs[col * 72 + k];
                acc[a][b][m][n][i] = s; }
            __syncthreads();
        }
        E(acc, cur, wr, wc, fr, fq);
    }
#else
    typedef __attribute__((address_space(3))) unsigned char* ldsp_t;
    const ldsp_t lds = (ldsp_t)smem;
    const int wid = __builtin_amdgcn_readfirstlane(tid >> 6), wr = wid >> 2, wc = wid & 3, fr = lane & 15, fq = lane >> 4;
    const int nt = K / BK;
    int Rr[2], Cc[2]; unsigned voffB[2];
#pragma unroll
    for (int i = 0; i < 2; ++i) { stage_rc(tid * 16 + i * 8192, Rr[i], Cc[i]); voffB[i] = (unsigned)(Rr[i] * K + Cc[i]) * 2u; }
    const size_t kstep = (size_t)(BK * 2);
    const unsigned ldsw = (unsigned)wid * 1024u;
    const int aoffl = lds_byte(wr * 64 + fr, fq * 8), boffl = lds_byte(wc * 32 + fr, fq * 8);
#define G8_SA(b, h) (((b) * 2 + (h)) * HTB)
#define G8_SB(b, h) ((4 + (b) * 2 + (h)) * HTB)
#define G8_STAGE(bufoff, gbase, voff) do { _Pragma("unroll") for (int _i = 0; _i < 2; ++_i) \
        __builtin_amdgcn_global_load_lds((const unsigned*)((const char*)(gbase) + (voff)[_i]), (__attribute__((address_space(3))) unsigned*)(lds + (bufoff) + ldsw + _i * 8192), 16, 0, 0); } while (0)
#define G8_LDA(dst, b, h) do { _Pragma("unroll") for (int m = 0; m < 4; ++m) _Pragma("unroll") for (int k = 0; k < 2; ++k) dst[m][k] = *(const __attribute__((address_space(3))) half8*)(lds + G8_SA(b, h) + aoffl + m * 2048 + k * 1024); } while (0)
#define G8_LDB(dst, b, h) do { _Pragma("unroll") for (int n = 0; n < 2; ++n) _Pragma("unroll") for (int k = 0; k < 2; ++k) dst[n][k] = *(const __attribute__((address_space(3))) half8*)(lds + G8_SB(b, h) + boffl + n * 2048 + k * 1024); } while (0)
#define G8_MMA(ai, bj, At, Bt) do { __builtin_amdgcn_s_setprio(1); _Pragma("unroll") for (int m = 0; m < 4; ++m) _Pragma("unroll") for (int n = 0; n < 2; ++n) _Pragma("unroll") for (int k = 0; k < 2; ++k) \
        acc[ai][bj][m][n] = __builtin_amdgcn_mfma_f32_16x16x32_f16(Bt[n][k], At[m][k], acc[ai][bj][m][n], 0, 0, 0); __builtin_amdgcn_s_setprio(0); } while (0)
#define G8_WAIT_V(n) asm volatile("s_waitcnt vmcnt(" #n ")" ::: "memory")
#define G8_WAIT_L(n) asm volatile("s_waitcnt lgkmcnt(" #n ")" ::: "memory")
#define G8_BAR __builtin_amdgcn_s_barrier()
#define G8_SCHED __builtin_amdgcn_sched_barrier(0)
#define G8_AOFF(dst, u) do { _Pragma("unroll") for (int _h = 0; _h < 2; ++_h) _Pragma("unroll") for (int _i = 0; _i < 2; ++_i) dst[_h][_i] = S.a_off(u, _h * 128 + Rr[_i]) + (unsigned)Cc[_i] * 2u; } while (0)
    Unit cur, nxt; int ui = 0;
    if (!S.next(0, cur)) return;
    f32x4 acc[2][2][4][2];
#pragma unroll
    for (int a = 0; a < 2; ++a)
#pragma unroll
        for (int b = 0; b < 2; ++b)
#pragma unroll
            for (int m = 0; m < 4; ++m)
#pragma unroll
                for (int n = 0; n < 2; ++n) acc[a][b][m][n] = (f32x4){0.f, 0.f, 0.f, 0.f};
    half8 At[4][2], B0[2][2], B1[2][2];
    unsigned caoff[2][2], naoff[2][2];
    G8_AOFF(caoff, cur);
    const char* cA = S.abase; const char* cB0 = S.b_half(cur, 0); const char* cB1 = S.b_half(cur, 1);
    G8_STAGE(G8_SB(0, 0), cB0, voffB); G8_STAGE(G8_SA(0, 0), cA, caoff[0]); G8_STAGE(G8_SB(0, 1), cB1, voffB); G8_STAGE(G8_SA(0, 1), cA, caoff[1]);
    if (wr == 1) G8_BAR;
    G8_WAIT_V(4); G8_BAR;
    G8_STAGE(G8_SB(1, 0), cB0 + kstep, voffB); G8_STAGE(G8_SA(1, 0), cA + kstep, caoff[0]); G8_STAGE(G8_SB(1, 1), cB1 + kstep, voffB);
    G8_WAIT_V(6); G8_BAR;
    for (;;) {
        const bool has_next = S.next(ui + 1, nxt);
        if (!has_next) nxt = cur;
        G8_AOFF(naoff, nxt);
        const char* nB0 = S.b_half(nxt, 0); const char* nB1 = S.b_half(nxt, 1);
#pragma unroll 1
        for (int t = 0; t < nt; t += 2) {
            const bool last = (t == nt - 2);
            const char* a1 = cA + (size_t)(t + 1) * kstep;
            const char* a2 = last ? cA : cA + (size_t)(t + 2) * kstep;
            const char* b20 = last ? nB0 : cB0 + (size_t)(t + 2) * kstep; const char* b21 = last ? nB1 : cB1 + (size_t)(t + 2) * kstep;
            const char* a3 = a2 + kstep; const char* b30 = b20 + kstep; const char* b31 = b21 + kstep;
            unsigned xoff[2][2];
#pragma unroll
            for (int h = 0; h < 2; ++h)
#pragma unroll
                for (int i = 0; i < 2; ++i) xoff[h][i] = last ? naoff[h][i] : caoff[h][i];
            G8_LDB(B0, 0, 0); G8_SCHED; G8_LDA(At, 0, 0); G8_STAGE(G8_SA(1, 1), a1, caoff[1]);
            G8_WAIT_L(8); G8_BAR; G8_WAIT_L(0); G8_MMA(0, 0, At, B0); G8_BAR; G8_SCHED;
            G8_LDB(B1, 0, 1); G8_STAGE(G8_SB(0, 0), b20, voffB);
            G8_BAR; G8_WAIT_L(0); G8_MMA(0, 1, At, B1); G8_BAR;
            G8_LDA(At, 0, 1); G8_STAGE(G8_SA(0, 0), a2, xoff[0]);
            G8_BAR; G8_WAIT_L(0); G8_MMA(1, 0, At, B0); G8_BAR; G8_SCHED;
            G8_STAGE(G8_SB(0, 1), b21, voffB);
            G8_WAIT_V(6); G8_BAR; G8_MMA(1, 1, At, B1); G8_BAR;
            G8_LDB(B0, 1, 0); G8_SCHED; G8_LDA(At, 1, 0); G8_STAGE(G8_SA(0, 1), a2, xoff[1]);
            G8_WAIT_L(8); G8_BAR; G8_WAIT_L(0); G8_MMA(0, 0, At, B0); G8_BAR; G8_SCHED;
            G8_LDB(B1, 1, 1); G8_STAGE(G8_SB(1, 0), b30, voffB);
            G8_BAR; G8_WAIT_L(0); G8_MMA(0, 1, At, B1); G8_BAR;
            G8_LDA(At, 1, 1); G8_STAGE(G8_SA(1, 0), a3, xoff[0]);
            G8_BAR; G8_WAIT_L(0); G8_MMA(1, 0, At, B0); G8_BAR; G8_SCHED;
            G8_STAGE(G8_SB(1, 1), b31, voffB);
            G8_WAIT_V(6); G8_BAR; G8_MMA(1, 1, At, B1); G8_BAR;
        }
        E(acc, cur, wr, wc, fr, fq);
        if (!has_next) break;
#pragma unroll
        for (int a = 0; a < 2; ++a)
#pragma unroll
            for (int b = 0; b < 2; ++b)
#pragma unroll
                for (int m = 0; m < 4; ++m)
#pragma unroll
                    for (int n = 0; n < 2; ++n) acc[a][b][m][n] = (f32x4){0.f, 0.f, 0.f, 0.f};
        cur = nxt; cB0 = nB0; cB1 = nB1; ++ui;
#pragma unroll
        for (int h = 0; h < 2; ++h)
#pragma unroll
            for (int i = 0; i < 2; ++i) caoff[h][i] = naoff[h][i];
    }
    G8_WAIT_V(0);
    if (wr == 0) G8_BAR;
    G8_BAR;
#undef G8_SA
#undef G8_SB
#undef G8_STAGE
#undef G8_LDA
#undef G8_LDB
#undef G8_MMA
#undef G8_WAIT_V
#undef G8_WAIT_L
#undef G8_BAR
#undef G8_SCHED
#undef G8_AOFF
#endif
}
}

#ifdef EMU
typedef const Params* ParamsPtr;
#else
typedef const __attribute__((address_space(4))) Params* ParamsPtr;
#endif
struct Frame {
    ParamsPtr P; unsigned char* ws; unsigned char* smem; int tid, lane, wave;
    __device__ __forceinline__ const float* in(int i) const { return P->in[i]; }
    __device__ __forceinline__ float* xrow(int row) const { return row < TL ? P->out + (size_t)row * D : (float*)(ws + WS_XC) + (size_t)(row - TL) * D; }
    __device__ __forceinline__ const float* xrow_in(int layer, int row) const {
        if (layer == 0) return row < TL ? in(I_X) + (size_t)row * D : in(I_CTX) + (size_t)(row - TL) * D;
        return xrow(row);
    }
};
__device__ __forceinline__ int row_mod(int row) { return row < TL ? row / SEQ : NB; }
__device__ __forceinline__ const float* modp(const Frame& F, int layer, int m, int chunk) { return (const float*)(F.ws + WS_MOD) + ((size_t)(layer * 5 + m) * 6 + chunk) * D; }


#ifndef EMU
#define XB_TMO      128
#define XB_XCNT(j)  (256  + 64 * (j))
#define XB_XSUB(j)  (1280 + 64 * (j))
#define XB_XGEN(j)  (2304 + 64 * (j))
#define XB_TOP      3328
#define XB_TOPGEN   3392
#define XCD_BAR_WORDS 3456
#define XB_SPIN_CAP (1u << 26)
#define LAS __attribute__((address_space(3)))
static_assert((CW_BAR + XCD_BAR_WORDS) * 4 <= CTL_BYTES, "control region");
__device__ __forceinline__ unsigned xb_ld(unsigned* p)              { return __hip_atomic_load(p, __ATOMIC_RELAXED, __HIP_MEMORY_SCOPE_AGENT); }
__device__ __forceinline__ unsigned xb_add(unsigned* p, unsigned v) { return __hip_atomic_fetch_add(p, v, __ATOMIC_RELAXED, __HIP_MEMORY_SCOPE_AGENT); }
__device__ __forceinline__ unsigned xb_xcc_id() { return (unsigned)__builtin_amdgcn_s_getreg((3 << 11) | 20) & 0xFu; }
#define XB_SPIN(cond, bar) do { unsigned _sp = 0; while (cond) { __builtin_amdgcn_s_sleep(1); \
    if ((++_sp & 255u) == 0u) { if (xb_ld(&(bar)[XB_TMO])) break; if (_sp > XB_SPIN_CAP) { atomicAdd(&(bar)[XB_TMO], 1u); break; } } } } while (0)
struct XcdBarrier { unsigned* bar; unsigned x; volatile LAS unsigned* st; };
__device__ __forceinline__ XcdBarrier xcd_barrier_post(unsigned* bar, volatile LAS unsigned* st) {
    XcdBarrier b; b.bar = bar; b.x = xb_xcc_id(); b.st = st;
    if (threadIdx.x == 0) (void)xb_add(&bar[XB_XCNT(b.x)], 1u);
    return b;
}
__device__ __forceinline__ void xcd_barrier_complete(unsigned* bar, unsigned x, unsigned& nloc, unsigned& nx) {
    const unsigned G = gridDim.x * gridDim.y * gridDim.z;
    unsigned sum, cnt, mine, sp = 0u;
    for (;;) {
        sum = 0u; cnt = 0u; mine = 0u;
#pragma unroll
        for (unsigned j = 0; j < 16; ++j) { const unsigned c = xb_ld(&bar[XB_XCNT(j)]); sum += c; cnt += (c > 0u) ? 1u : 0u; mine = (j == x) ? c : mine; }
        if (sum == G) break;
        __builtin_amdgcn_s_sleep(1);
        if ((++sp & 255u) == 0u) { if (xb_ld(&bar[XB_TMO])) break; if (sp > XB_SPIN_CAP) { atomicAdd(&bar[XB_TMO], 1u); break; } }
    }
    nloc = mine > 0u ? mine : 1u; nx = cnt > 0u ? cnt : 1u;
}
__device__ __forceinline__ void xcd_barrier(const XcdBarrier& b) {
    asm volatile("s_waitcnt vmcnt(0)" ::: "memory");
    __syncthreads();
    if (threadIdx.x == 0) {
        unsigned* bar = b.bar;
        __builtin_amdgcn_s_waitcnt(0);
        unsigned nloc = b.st[0], nx = b.st[1];
        if (nloc == 0u) { xcd_barrier_complete(bar, b.x, nloc, nx); b.st[0] = nloc; b.st[1] = nx; }
        const unsigned old = xb_add(&bar[XB_XSUB(b.x)], 1u);
        const unsigned gen = old / nloc;
        if (old + 1u == (gen + 1u) * nloc) {
            __builtin_amdgcn_fence(__ATOMIC_RELEASE, "agent");
            asm volatile("s_waitcnt vmcnt(0)" ::: "memory");
            const unsigned og = xb_add(&bar[XB_TOP], 1u);
            const unsigned tg = og / nx;
            if (og + 1u == (tg + 1u) * nx) xb_add(&bar[XB_TOPGEN], 1u);
            else XB_SPIN(xb_ld(&bar[XB_TOPGEN]) == tg, bar);
            __builtin_amdgcn_fence(__ATOMIC_ACQUIRE, "agent");
            xb_add(&bar[XB_XGEN(b.x)], 1u);
            asm volatile("s_waitcnt vmcnt(0)" ::: "memory");
        } else {
            XB_SPIN(xb_ld(&bar[XB_XGEN(b.x)]) == gen, bar);
            __builtin_amdgcn_fence(__ATOMIC_ACQUIRE, "agent");
            asm volatile("s_waitcnt vmcnt(0)" ::: "memory");
        }
    }
    __syncthreads();
}
#endif

__device__ __forceinline__ void item_twiddle(const Frame& F, int it) {
    cplx* tw = (cplx*)(F.ws + WS_TW);
    const int k = it * NT + F.tid;
    if (k < TWN) { float s, c; const float a = -6.283185307179586f * (float)k / (float)TWN; s = sinf(a); c = cosf(a); tw[k].x = c; tw[k].y = s; }
}
__device__ __forceinline__ void item_mod(const Frame& F, int it) {
    const int layer = it / (NMOD / 64), n0 = (it % (NMOD / 64)) * 64;
    float* sc = (float*)F.smem;
    float* red = sc + 5 * D;
    for (int i = F.tid; i < 5 * D; i += NT) { const int m = i / D, k = i % D; const float v = m < NB ? F.in(I_C)[m * D + k] : F.in(I_CCTX)[k]; sc[i] = siluf(v); }
    __syncthreads();
    const int j = F.tid & 63, ks = F.tid >> 6;
    const float* w = F.in(I_WMOD) + (size_t)layer * D * NMOD + n0 + j;
    float a[5] = {0, 0, 0, 0, 0};
    for (int k = ks * 128; k < ks * 128 + 128; ++k) { const float wv = w[(size_t)k * NMOD];
#pragma unroll
        for (int m = 0; m < 5; ++m) a[m] += sc[m * D + k] * wv; }
#pragma unroll
    for (int m = 0; m < 5; ++m) red[(ks * 5 + m) * 64 + j] = a[m];
    __syncthreads();
    if (F.tid < 5 * 64) { const int m = F.tid / 64, jj = F.tid % 64; float s = 0; for (int q = 0; q < 8; ++q) s += red[(q * 5 + m) * 64 + jj];
        ((float*)(F.ws + WS_MOD))[(size_t)(layer * 5 + m) * NMOD + n0 + jj] = s + F.in(I_BMOD)[layer * NMOD + n0 + jj]; }
    __syncthreads();
}
__device__ __forceinline__ void item_filter(const Frame& F, int layer, int isctx, int tb) {
    const int L = isctx ? CTXL : SEQ;
    float* feats = (float*)F.smem;
    float* h1 = feats + 32 * 33;
    float* h2 = h1 + 32 * 64;
    const int t0 = tb * 32;
    for (int i = F.tid; i < 32 * 33; i += NT) {
        const int tt = i / 33, f = i % 33; const float t = (float)(t0 + tt);
        float v;
        if (f == 0) v = t / (float)(L - 1 > 1 ? L - 1 : 1);
        else { const int bi = (f - 1) & 15; const float band = 1e-4f + (float)bi * ((15.0f - 1e-4f) / 15.0f);
               const float ang = (6.283185307179586f / (float)L) * t * band; v = (f <= 16) ? cosf(ang) : -sinf(ang); }
        feats[i] = v;
    }
    __syncthreads();
    const float* w1 = F.in(I_HW1) + layer * 33 * 64; const float* b1 = F.in(I_HB1) + layer * 64;
    const float* w2 = F.in(I_HW2) + layer * 64 * 64; const float* b2 = F.in(I_HB2) + layer * 64;
    const float* fr = F.in(I_HFREQ) + layer * 64;
    for (int i = F.tid; i < 32 * 64; i += NT) { const int tt = i >> 6, j = i & 63; float s = b1[j]; for (int k = 0; k < 33; ++k) s += feats[tt * 33 + k] * w1[k * 64 + j]; h1[i] = sinf(fr[j] * s); }
    __syncthreads();
    for (int i = F.tid; i < 32 * 64; i += NT) { const int tt = i >> 6, j = i & 63; float s = b2[j]; for (int k = 0; k < 64; ++k) s += h1[tt * 64 + k] * w2[k * 64 + j]; h2[i] = sinf(fr[j] * s); }
    __syncthreads();
    const float* w3 = F.in(I_HW3) + (size_t)layer * 64 * 1024;
    const int c0 = F.tid * 2;
    float* ft = (float*)(F.ws + WS_FT) + (isctx ? (size_t)2 * 256 * 4 * SEQ : (size_t)layer * 256 * 4 * SEQ);
    for (int hf = 0; hf < 2; ++hf) {
        float acc[16][2];
        for (int tt = 0; tt < 16; ++tt) { acc[tt][0] = 0.f; acc[tt][1] = 0.f; }
        for (int k = 0; k < 64; ++k) { const float wa = w3[k * 1024 + c0], wb = w3[k * 1024 + c0 + 1];
#pragma unroll
            for (int tt = 0; tt < 16; ++tt) { const float hv = h2[(hf * 16 + tt) * 64 + k]; acc[tt][0] += hv * wa; acc[tt][1] += hv * wb; } }
#pragma unroll
        for (int q = 0; q < 2; ++q) {
            const int col = c0 + q, dir = col >> 9, order = (col >> 8) & 1, c = col & 255;
            const float dec = fabsf(F.in(I_HDEC)[((layer * 2 + dir) * 2 + order) * 256 + c]);
            float* dst = ft + ((size_t)(c * 2 + order) * 2 + dir) * L + t0 + hf * 16;
#pragma unroll
            for (int tt = 0; tt < 16; ++tt) { const float tu = (float)(t0 + hf * 16 + tt) / (float)(L - 1 > 1 ? L - 1 : 1); dst[tt] = acc[tt][q] * expf(-tu * dec); }
        }
    }
    __syncthreads();
}
__device__ __forceinline__ void item_transpose(const Frame& F, const float* src, int ldn, int nvalid, half_t* dst, int K, int k0, int n0) {
    float* tile = (float*)F.smem;
    for (int i = F.tid; i < 64 * 16; i += NT) {
        const int r = i >> 4, c4 = (i & 15) * 4;
        float v[4];
#pragma unroll
        for (int q = 0; q < 4; ++q) v[q] = (n0 + c4 + q < nvalid) ? src[(size_t)(k0 + r) * ldn + n0 + c4 + q] : 0.f;
#pragma unroll
        for (int q = 0; q < 4; ++q) tile[r * 65 + c4 + q] = v[q];
    }
    __syncthreads();
    { const int n = F.tid >> 3, kc = (F.tid & 7) * 8; half8 h;
#pragma unroll
      for (int q = 0; q < 8; ++q) h[q] = (half_t)tile[(kc + q) * 65 + n];
      *(half8*)(dst + (size_t)(n0 + n) * K + k0 + kc) = h; }
    __syncthreads();
}
__device__ __forceinline__ void item_router_w(const Frame& F, int layer) {
    half_t* dst = (half_t*)(F.ws + WS_WR) + (size_t)layer * 2 * 48 * D;
    for (int i = F.tid; i < 48 * D; i += NT) {
        const int col = i / D, k = i % D;
        float w = 0.f;
        if (col < 4) w = F.in(I_GRW)[((size_t)layer * D + k) * 4 + col]; else if (col < 36) w = F.in(I_ERW)[((size_t)layer * D + k) * 32 + (col - 4)];
        const half_t hi = (half_t)w; const half_t lo = (half_t)((w - (float)hi) * 2048.f);
        dst[i] = hi; dst[48 * D + i] = lo;
    }
}
constexpr int IT_TW = (TWN + NT - 1) / NT;
constexpr int IT_MOD = 2 * (NMOD / 64);
constexpr int IT_FILT = 2 * (SEQ / 32) + (CTXL / 32);
constexpr int IT_TWIN = 2 * 16 * (NINP / 64);
constexpr int IT_TWOUT = 2 * 16 * 16;
constexpr int IT_TMOE = 32 * 192;
__device__ __forceinline__ void moe_transpose_item(const Frame& F, int layer, int it) {
    const int e = it / 192, r = it % 192, which = r / 64, t = r % 64;
    half_t* base = (half_t*)(F.ws + WS_WMOE) + (size_t)e * 3 * 262144;
    if (which < 2) {
        const float* src = F.in(which == 0 ? I_MG : I_MU) + ((size_t)layer * 32 + e) * 262144;
        item_transpose(F, src, 256, 256, base + which * 262144, 1024, (t >> 2) * 64, (t & 3) * 64);
    } else {
        const float* src = F.in(I_MD) + ((size_t)layer * 32 + e) * 262144;
        item_transpose(F, src, 1024, 1024, base + 2 * 262144, 256, (t >> 4) * 64, (t & 15) * 64);
    }
}
__device__ __forceinline__ void phase_setup(const Frame& F) {
    if (blockIdx.x == 0 && F.tid < 128) ((unsigned*)(F.ws + WS_CTL))[CW_CNT + F.tid] = 0u;
    const int total = IT_TW + IT_MOD + IT_FILT + IT_TWIN + IT_TWOUT + 2;
    for (int it = blockIdx.x; it < total; it += gridDim.x) {
        int i = it;
        if (i < 2) { item_router_w(F, i); continue; } i -= 2;
        if (i < IT_MOD) { item_mod(F, i); continue; } i -= IT_MOD;
        if (i < IT_FILT) { if (i < 2 * (SEQ / 32)) item_filter(F, i / (SEQ / 32), 0, i % (SEQ / 32)); else item_filter(F, 0, 1, i - 2 * (SEQ / 32)); continue; } i -= IT_FILT;
        if (i < IT_TW) { item_twiddle(F, i); continue; } i -= IT_TW;
        if (i < IT_TWIN) { const int layer = i / (16 * (NINP / 64)), r = i % (16 * (NINP / 64));
            item_transpose(F, F.in(I_WIN) + (size_t)layer * D * NIN, NIN, NIN, (half_t*)(F.ws + WS_WIN) + (size_t)layer * NINP * D, D, (r / (NINP / 64)) * 64, (r % (NINP / 64)) * 64); continue; } i -= IT_TWIN;
        if (i < IT_TWOUT) { const int layer = i / 256, r = i % 256;
            item_transpose(F, F.in(I_WOUT) + (size_t)layer * D * D, D, D, (half_t*)(F.ws + WS_WOUT) + (size_t)layer * D * D, D, (r >> 4) * 64, (r & 15) * 64); continue; }
    }
}

__device__ __forceinline__ void norm1_rows4(const Frame& F, int layer, int row0) {
    half_t* xn = (half_t*)(F.ws + WS_XN);
    const int m = row_mod(row0), lane = F.lane;
    f32x4 v[4][4];
#pragma unroll
    for (int r = 0; r < 4; ++r) { const float* x = F.xrow_in(layer, row0 + r);
#pragma unroll
        for (int q = 0; q < 4; ++q) v[r][q] = *(const f32x4*)(x + q * 256 + lane * 4); }
    const float* nw = F.in(I_N1W) + layer * D; const float* sh = modp(F, layer, m, 0); const float* scl = modp(F, layer, m, 1);
    f32x4 g[4], s4[4];
#pragma unroll
    for (int q = 0; q < 4; ++q) { const int k = q * 256 + lane * 4; const f32x4 a = *(const f32x4*)(nw + k), b = *(const f32x4*)(scl + k); s4[q] = *(const f32x4*)(sh + k);
#pragma unroll
        for (int e = 0; e < 4; ++e) g[q][e] = a[e] * (1.0f + b[e]); }
#pragma unroll
    for (int r = 0; r < 4; ++r) {
        float ss = 0.f;
#pragma unroll
        for (int q = 0; q < 4; ++q) ss += v[r][q][0] * v[r][q][0] + v[r][q][1] * v[r][q][1] + v[r][q][2] * v[r][q][2] + v[r][q][3] * v[r][q][3];
        ss = wave_sum(ss);
        const float rs = 1.0f / sqrtf(ss * (1.0f / D) + EPSF);
        const int row = row0 + r; int srow = row;
        if (layer == 1 && row < TL) { const int b = row / SEQ, l = row % SEQ; srow = b * SEQ + (l % GW) * GROWS + l / GW; }
#pragma unroll
        for (int q = 0; q < 4; ++q) { const int k = q * 256 + lane * 4; half4 h;
#pragma unroll
            for (int e = 0; e < 4; ++e) h[e] = (half_t)(v[r][q][e] * rs * g[q][e] + s4[q][e]);
            *(half4*)(xn + (size_t)srow * D + k) = h; }
    }
}
__device__ __forceinline__ void phase_norm1(const Frame& F, int layer) {
    for (int it = blockIdx.x; it < TT / 32; it += gridDim.x) norm1_rows4(F, layer, it * 32 + F.wave * 4);
}

struct EpiInproj {
    half_t* u16; float* ug; half_t* hyt;
    __device__ __forceinline__ void operator()(const f32x4 (&acc)[2][2][4][2], const g8::Unit& u, int wr, int wc, int fr, int fq) const {
#pragma unroll
        for (int ai = 0; ai < 2; ++ai)
#pragma unroll
            for (int m = 0; m < 4; ++m) {
                const int row = u.pm * 256 + ai * 128 + wr * 64 + m * 16 + fr;
#pragma unroll
                for (int bj = 0; bj < 2; ++bj)
#pragma unroll
                    for (int n = 0; n < 2; ++n) {
                        const int c0 = u.pn * 256 + bj * 128 + wc * 32 + n * 16 + 4 * fq; const f32x4 v = acc[ai][bj][m][n];
                        if (c0 < 1024) *(half4*)(u16 + (size_t)row * UW + c0) = to_half4(v);
                        else if (c0 < 1036) *(f32x4*)(ug + (size_t)row * UGW + (c0 - 1024)) = v;
                        else if (c0 < 1804) { const int ch = c0 - 1036;
                            half_t* dst = row < TL ? hyt + ((size_t)(row / SEQ) * 768 + ch) * SEQ + row % SEQ : hyt + (size_t)NB * 768 * SEQ + ((size_t)((row - TL) / CTXL) * 768 + ch) * CTXL + (row - TL) % CTXL;
                            const size_t st = row < TL ? SEQ : CTXL;
#pragma unroll
                            for (int i = 0; i < 4; ++i) dst[i * st] = (half_t)v[i]; }
                        else if (c0 < 3340) *(half4*)(u16 + (size_t)row * UW + (c0 - 1804 + 1024)) = to_half4(v);
                        else if (c0 < NIN) *(f32x4*)(ug + (size_t)row * UGW + 12 + (c0 - 3340)) = v;
                    }
            }
    }
};
__device__ __forceinline__ void phase_inproj(const Frame& F, int layer) {
    g8::DenseSched S; S.abase = (const char*)(F.ws + WS_XN); S.bbase = (const char*)((const half_t*)(F.ws + WS_WIN) + (size_t)layer * NINP * D); S.K = D; S.nM = TT / 256; S.nN = NINP / 256; S.G = gridDim.x; S.c = blockIdx.x;
    EpiInproj E{(half_t*)(F.ws + WS_U16), (float*)(F.ws + WS_UG), (half_t*)(F.ws + WS_HYT)};
    g8::gemm_phase(F.smem, D, S, E);
}


constexpr int SA = 72, SB = 136;

__device__ __forceinline__ void load_rows10(const half_t* u16, int rowbase, int Lseq, int dir, int jj0, int ucol, half8 (&rr)[10]) {
#pragma unroll
    for (int t = 0; t < 10; ++t) {
        const int jj = jj0 - 1 + t;
        half8 v;
        if (jj >= 0 && jj < Lseq) { const int pos = dir == 0 ? jj : Lseq - 1 - jj; v = *(const half8*)(u16 + (size_t)(rowbase + pos) * UW + ucol); }
        else {
#pragma unroll
            for (int i = 0; i < 8; ++i) v[i] = (half_t)0.f; }
        rr[t] = v;
    }
}
__device__ __forceinline__ void load_taps(const float* cw, const float* cb, int C, int ch, int dir, float (&w0)[8], float (&w1)[8], float (&w2)[8], float (&wb)[8]) {
#pragma unroll
    for (int q = 0; q < 2; ++q) {
        const f32x4 a = *(const f32x4*)(cw + (dir ? 2 : 0) * C + ch + q * 4), b = *(const f32x4*)(cw + C + ch + q * 4), c = *(const f32x4*)(cw + (dir ? 0 : 2) * C + ch + q * 4), d = *(const f32x4*)(cb + ch + q * 4);
#pragma unroll
        for (int i = 0; i < 4; ++i) { w0[q * 4 + i] = a[i]; w1[q * 4 + i] = b[i]; w2[q * 4 + i] = c[i]; wb[q * 4 + i] = d[i]; }
    }
}

__device__ __forceinline__ void ssd_block(const Frame& F, int layer, int b, int h, int dir) {
    half_t* Cs = (half_t*)F.smem;
    half_t* Bs = Cs + 128 * SA;
    half_t* BT = Bs + 128 * SA;
    half_t* XT = BT + 64 * SB;
    half_t* SC = XT + 64 * SB;
    half_t* ST = SC + 128 * SB;
    float* cum = (float*)(ST + 64 * SA);
    float* dtv = cum + 128;
    float* wes = dtv + 128;
    const half_t* u16 = (const half_t*)(F.ws + WS_U16); const float* ug = (const float*)(F.ws + WS_UG);
    half_t* yout = (half_t*)(F.ws + WS_YF) + (size_t)dir * TT * 384;
    const float* cw = F.in(I_SCW) + layer * 3 * 640; const float* cb = F.in(I_SCB) + layer * 640;
    const float dtb = F.in(I_DTB)[(layer * 2 + dir) * 6 + h];
    const float Aneg = -expf(F.in(I_ALOG)[(layer * 2 + dir) * 6 + h]);
    const float Dh = F.in(I_SD)[layer * 6 + h];
    const int g = h / 3, tid = F.tid, lane = F.lane, wave = F.wave;
    const int kind = tid >> 7, c8 = (tid & 7) * 8, j0 = ((tid >> 3) & 15) * 8;
    const int ch = kind == 0 ? h * 64 + c8 : (kind == 1 ? 384 + g * 64 + c8 : 512 + g * 64 + c8);
    f32x4 accS[1][2]; zero_acc(accS);
    for (int i = tid; i < 64 * SA; i += NT) ST[i] = (half_t)0.f;
    constexpr int NC0 = CTXL / 128, NCT = NC0 + SEQ / 128;
    half8 rr[10]; float ug0 = 0.f, ug1 = 0.f;
    if (kind < 3) load_rows10(u16, TL + b * CTXL, CTXL, dir, j0, 384 + ch, rr);
    if (wave == 7) { const int p0 = dir == 0 ? 2 * lane : CTXL - 1 - 2 * lane, p1 = dir == 0 ? p0 + 1 : p0 - 1;
        ug0 = ug[(size_t)(TL + b * CTXL + p0) * UGW + dir * 6 + h]; ug1 = ug[(size_t)(TL + b * CTXL + p1) * UGW + dir * 6 + h]; }
    __syncthreads();
    for (int cc = 0; cc < NCT; ++cc) {
        const int seg = cc >= NC0 ? 1 : 0, c = seg ? cc - NC0 : cc;
        const int Lseq = seg == 0 ? CTXL : SEQ, rowbase = seg == 0 ? TL + b * CTXL : b * SEQ;
        const bool want_y = (seg == 1) || (layer == 0);
        const int nseg = (cc + 1) >= NC0 ? 1 : 0, ncn = nseg ? cc + 1 - NC0 : cc + 1, nL = nseg == 0 ? CTXL : SEQ, nrb = nseg == 0 ? TL + b * CTXL : b * SEQ;
        if (wave == 7) {
            const float dt0 = softplusf_(ug0 + dtb), dt1 = softplusf_(ug1 + dtb);
            const float a0 = dt0 * Aneg, a1 = dt1 * Aneg;
            const float incl = wave_scan_sum(a0 + a1, lane);
            const float c1 = incl, c0 = incl - a1;
            const float cl = __shfl(incl, 63);
            cum[2 * lane] = c0; cum[2 * lane + 1] = c1; dtv[2 * lane] = dt0; dtv[2 * lane + 1] = dt1;
            wes[2 * lane] = dt0 * fexp(cl - c0); wes[2 * lane + 1] = dt1 * fexp(cl - c1);
            if (cc + 1 < NCT) { const int pi = ncn * 128 + 2 * lane, p0 = dir == 0 ? pi : nL - 1 - pi, p1 = dir == 0 ? p0 + 1 : p0 - 1;
                ug0 = ug[(size_t)(nrb + p0) * UGW + dir * 6 + h]; ug1 = ug[(size_t)(nrb + p1) * UGW + dir * 6 + h]; }
        }
        if (kind < 3) {
#pragma unroll
            for (int hh = 0; hh < 2; ++hh) {
                f32x4 w0, w1, w2, wb; load_taps4(cw, cb, 640, ch + hh * 4, dir, w0, w1, w2, wb);
                if (kind == 0) {
                    half8 xt[4];
#pragma unroll
                    for (int k = 0; k < 8; ++k)
#pragma unroll
                        for (int i = 0; i < 4; ++i) xt[i][k] = (half_t)fsilu(CONV4(k, i));
#pragma unroll
                    for (int i = 0; i < 4; ++i) *(half8*)(XT + (c8 + hh * 4 + i) * SB + j0) = xt[i];
                } else if (kind == 1) {
                    half8 bt[4];
#pragma unroll
                    for (int k = 0; k < 8; ++k) { half4 hb;
#pragma unroll
                        for (int i = 0; i < 4; ++i) { const half_t v = (half_t)fsilu(CONV4(k, i)); hb[i] = v; bt[i][k] = v; }
                        *(half4*)(Bs + (j0 + k) * SA + c8 + hh * 4) = hb; }
#pragma unroll
                    for (int i = 0; i < 4; ++i) *(half8*)(BT + (c8 + hh * 4 + i) * SB + j0) = bt[i];
                } else {
#pragma unroll
                    for (int k = 0; k < 8; ++k) { half4 hc;
#pragma unroll
                        for (int i = 0; i < 4; ++i) hc[i] = (half_t)fsilu(CONV4(k, i));
                        *(half4*)(Cs + (j0 + k) * SA + c8 + hh * 4) = hc; }
                }
                LOADER_FENCE();
            }
        }
        __syncthreads();
        const float cl = cum[127];
        if (want_y) {
            { const int ws_ = wave & 1, wl = wave >> 1;
              if (!(ws_ == 1 && wl < 2)) {
                f32x4 g_[4][2]; zero_acc(g_);
                mma_lds<4, 2>(g_, Bs + ws_ * 64 * SA, SA, Cs + wl * 32 * SA, SA, 2, lane);
#pragma unroll
                for (int a = 0; a < 4; ++a) {
                    const int s0 = ws_ * 64 + a * 16 + (lane >> 4) * 4;
                    const f32x4 cs4 = *(const f32x4*)(cum + s0), dt4 = *(const f32x4*)(dtv + s0);
#pragma unroll
                    for (int q = 0; q < 2; ++q) {
                        const int l = wl * 32 + q * 16 + (lane & 15); const float cl_ = cum[l]; half4 hv;
#pragma unroll
                        for (int i = 0; i < 4; ++i) hv[i] = (half_t)((s0 + i) <= l ? g_[a][q][i] * fexp(cl_ - cs4[i]) * dt4[i] : 0.f);
                        *(half4*)(SC + l * SB + s0) = hv;
                    } }
              } }
            f32x4 y1[4][1]; zero_acc(y1);
            mma_lds<4, 1>(y1, ST, SA, Cs + wave * 16 * SA, SA, 2, lane);
            __syncthreads();
            f32x4 y2[4][1]; zero_acc(y2);
            mma_lds<4, 1>(y2, XT, SB, SC + wave * 16 * SB, SB, wave / 2 + 1, lane);
            { const int l = wave * 16 + (lane & 15); const float el = fexp(cum[l]);
              const int pi = c * 128 + l, pos = dir == 0 ? pi : Lseq - 1 - pi;
#pragma unroll
              for (int a = 0; a < 4; ++a) { const int p0 = a * 16 + (lane >> 4) * 4; f32x4 y;
#pragma unroll
                  for (int i = 0; i < 4; ++i) y[i] = y1[a][0][i] * el + y2[a][0][i];
                  if (dir == 0) {
#pragma unroll
                      for (int i = 0; i < 4; ++i) y[i] += Dh * (float)XT[(p0 + i) * SB + l]; }
                  *(half4*)(yout + (size_t)(rowbase + pos) * 384 + h * 64 + p0) = to_half4(y); } }
        }
        if (kind < 3 && cc + 1 < NCT) load_rows10(u16, nrb, nL, dir, ncn * 128 + j0, 384 + ch, rr);
        { const float dec = fexp(cl);
#pragma unroll
          for (int q = 0; q < 2; ++q) accS[0][q] *= dec;
          const int r = lane & 15, kq = (lane >> 4) * 8;
#pragma unroll
          for (int ks = 0; ks < 4; ++ks) {
              const half8 a = *(const half8*)(BT + ((wave >> 1) * 16 + r) * SB + ks * 32 + kq);
              const f32x4 e0 = *(const f32x4*)(wes + ks * 32 + kq), e1 = *(const f32x4*)(wes + ks * 32 + kq + 4);
#pragma unroll
              for (int q = 0; q < 2; ++q) { half8 bb = *(const half8*)(XT + ((wave & 1) * 32 + q * 16 + r) * SB + ks * 32 + kq);
#pragma unroll
                  for (int i = 0; i < 4; ++i) { bb[i] = (half_t)((float)bb[i] * e0[i]); bb[4 + i] = (half_t)((float)bb[4 + i] * e1[i]); }
                  accS[0][q] = mfma16(a, bb, accS[0][q]); } } }
        __syncthreads();
#pragma unroll
        for (int q = 0; q < 2; ++q) { const int p = (wave & 1) * 32 + q * 16 + (lane & 15), n0 = (wave >> 1) * 16 + (lane >> 4) * 4; *(half4*)(ST + p * SA + n0) = to_half4(accS[0][q]); }
    }
    __syncthreads();
}

__device__ __forceinline__ void mlstm_block(const Frame& F, int layer, int b, int h, int dir) {
    half_t* Qs = (half_t*)F.smem;
    half_t* Ks = Qs + 128 * SA;
    half_t* KT = Ks + 128 * SA;
    half_t* VT = KT + 64 * SB;
    half_t* SC = VT + 64 * SB;
    half_t* CS = SC + 128 * SB;
    float* ig = (float*)(CS + 64 * SA);
    float* cumf = ig + 128; float* gsv = cumf + 128; float* mtv = gsv + 128; float* ee = mtv + 128; float* dn = ee + 128;
    float* nvec = dn + 128;
    float* scal = nvec + 64;
    const half_t* u16 = (const half_t*)(F.ws + WS_U16); const float* ug = (const float*)(F.ws + WS_UG);
    half_t* hout = (half_t*)(F.ws + WS_YF) + (size_t)(2 + dir) * TT * 384;
    const float* cw = F.in(I_MCW) + layer * 3 * 768; const float* cb = F.in(I_MCB) + layer * 768;
    const float bi = F.in(I_MGB)[((layer * 2 + dir) * 2 + 0) * 6 + h], bf = F.in(I_MGB)[((layer * 2 + dir) * 2 + 1) * 6 + h];
    const int tid = F.tid, lane = F.lane, wave = F.wave;
    const int kind = tid >> 7, c8 = (tid & 7) * 8, j0 = ((tid >> 3) & 15) * 8;
    const int ch = kind == 0 ? h * 64 + c8 : 384 + h * 64 + c8;
    f32x4 accC[1][2]; zero_acc(accC);
    float m_in = 0.f;
    for (int i = tid; i < 64 * SA; i += NT) CS[i] = (half_t)0.f;
    if (tid < 64) nvec[tid] = 0.f;
    constexpr int NC0 = CTXL / 128, NCT = NC0 + SEQ / 128;
    half8 rr[10]; float gi0 = 0.f, gi1 = 0.f, gf0 = 0.f, gf1 = 0.f;
    const int ucol = kind == 2 ? 1792 + h * 64 + c8 : 1024 + ch;
    if (kind < 3) load_rows10(u16, TL + b * CTXL, CTXL, dir, j0, ucol, rr);
    if (wave == 7) { const int p0 = dir == 0 ? 2 * lane : CTXL - 1 - 2 * lane, p1 = dir == 0 ? p0 + 1 : p0 - 1;
        const float* g0 = ug + (size_t)(TL + b * CTXL + p0) * UGW + 12 + dir * 12; const float* g1 = ug + (size_t)(TL + b * CTXL + p1) * UGW + 12 + dir * 12;
        gi0 = g0[h]; gf0 = g0[6 + h]; gi1 = g1[h]; gf1 = g1[6 + h]; }
    half8 ones;
#pragma unroll
    for (int i = 0; i < 8; ++i) ones[i] = (half_t)1.0f;
    __syncthreads();
    for (int cc = 0; cc < NCT; ++cc) {
        const int seg = cc >= NC0 ? 1 : 0, c = seg ? cc - NC0 : cc;
        const int Lseq = seg == 0 ? CTXL : SEQ, rowbase = seg == 0 ? TL + b * CTXL : b * SEQ;
        const bool want_y = (seg == 1) || (layer == 0);
        const int nseg = (cc + 1) >= NC0 ? 1 : 0, ncn = nseg ? cc + 1 - NC0 : cc + 1, nL = nseg == 0 ? CTXL : SEQ, nrb = nseg == 0 ? TL + b * CTXL : b * SEQ;
        if (wave == 7) {
            const float i0 = gi0 + bi, i1 = gi1 + bi, lf0 = logsigmoidf_(gf0 + bf), lf1 = logsigmoidf_(gf1 + bf);
            const float incl = wave_scan_sum(lf0 + lf1, lane);
            const float c1 = incl, c0 = incl - lf1;
            const float tot = __shfl(incl, 63);
            const float r0 = i0 - c0, r1 = i1 - c1;
            const float pincl = wave_scan_max(fmaxf(r0, r1), lane);
            float pexcl = __shfl_up(pincl, 1); if (lane == 0) pexcl = -3.0e38f;
            const float pm0 = fmaxf(pexcl, r0), pm1 = pincl;
            const float pmlast = __shfl(pincl, 63);
            const float m_new = fmaxf(tot + m_in, tot + pmlast);
            ig[2 * lane] = i0; ig[2 * lane + 1] = i1; cumf[2 * lane] = c0; cumf[2 * lane + 1] = c1; gsv[2 * lane] = r0; gsv[2 * lane + 1] = r1;
            mtv[2 * lane] = fmaxf(c0 + m_in, c0 + pm0); mtv[2 * lane + 1] = fmaxf(c1 + m_in, c1 + pm1);
            ee[2 * lane] = fexp(r0 + tot - m_new); ee[2 * lane + 1] = fexp(r1 + tot - m_new);
            if (lane == 0) { scal[0] = tot; scal[1] = m_new; }
            if (cc + 1 < NCT) { const int pi = ncn * 128 + 2 * lane, p0 = dir == 0 ? pi : nL - 1 - pi, p1 = dir == 0 ? p0 + 1 : p0 - 1;
                const float* g0 = ug + (size_t)(nrb + p0) * UGW + 12 + dir * 12; const float* g1 = ug + (size_t)(nrb + p1) * UGW + 12 + dir * 12;
                gi0 = g0[h]; gf0 = g0[6 + h]; gi1 = g1[h]; gf1 = g1[6 + h]; }
        }
        if (kind < 2) {
#pragma unroll
            for (int hh = 0; hh < 2; ++hh) {
                f32x4 w0, w1, w2, wb; load_taps4(cw, cb, 768, ch + hh * 4, dir, w0, w1, w2, wb);
                if (kind == 0) {
#pragma unroll
                    for (int k = 0; k < 8; ++k) { half4 hq;
#pragma unroll
                        for (int i = 0; i < 4; ++i) hq[i] = (half_t)fsilu(CONV4(k, i));
                        *(half4*)(Qs + (j0 + k) * SA + c8 + hh * 4) = hq; }
                } else {
                    half8 kt[4];
#pragma unroll
                    for (int k = 0; k < 8; ++k) { half4 hk;
#pragma unroll
                        for (int i = 0; i < 4; ++i) { const half_t v = (half_t)(0.125f * fsilu(CONV4(k, i))); hk[i] = v; kt[i][k] = v; }
                        *(half4*)(Ks + (j0 + k) * SA + c8 + hh * 4) = hk; }
#pragma unroll
                    for (int i = 0; i < 4; ++i) *(half8*)(KT + (c8 + hh * 4 + i) * SB + j0) = kt[i];
                }
                LOADER_FENCE();
            }
        } else if (kind == 2) {
            half8 vt[8];
#pragma unroll
            for (int k = 0; k < 8; ++k) { const half8 hv = rr[k + 1];
#pragma unroll
                for (int i = 0; i < 8; ++i) vt[i][k] = hv[i]; }
#pragma unroll
            for (int i = 0; i < 8; ++i) *(half8*)(VT + (c8 + i) * SB + j0) = vt[i];
        }
        __syncthreads();
        const float tot = scal[0], m_new = scal[1];
        if (want_y) {
            { const int ws_ = wave & 1, wl = wave >> 1;
              if (!(ws_ == 1 && wl < 2)) {
                f32x4 g_[4][2]; zero_acc(g_);
                mma_lds<4, 2>(g_, Ks + ws_ * 64 * SA, SA, Qs + wl * 32 * SA, SA, 2, lane);
#pragma unroll
                for (int a = 0; a < 4; ++a) {
                    const int s0 = ws_ * 64 + a * 16 + (lane >> 4) * 4; const f32x4 gs4 = *(const f32x4*)(gsv + s0);
#pragma unroll
                    for (int q = 0; q < 2; ++q) {
                        const int l = wl * 32 + q * 16 + (lane & 15); const float cm = cumf[l] - mtv[l]; half4 hv;
#pragma unroll
                        for (int i = 0; i < 4; ++i) hv[i] = (half_t)((s0 + i) <= l ? g_[a][q][i] * fexp(cm + gs4[i]) : 0.f);
                        *(half4*)(SC + l * SB + s0) = hv;
                    } }
              } }
            f32x4 h1[4][1]; zero_acc(h1);
            mma_lds<4, 1>(h1, CS, SA, Qs + wave * 16 * SA, SA, 2, lane);
            if (tid < 128) { float s = 0.f;
#pragma unroll
                for (int d8 = 0; d8 < 8; ++d8) { const half8 qv = *(const half8*)(Qs + tid * SA + d8 * 8); const f32x4 n0 = *(const f32x4*)(nvec + d8 * 8), n1 = *(const f32x4*)(nvec + d8 * 8 + 4);
#pragma unroll
                    for (int i = 0; i < 4; ++i) s += (float)qv[i] * n0[i] + (float)qv[4 + i] * n1[i]; }
                dn[tid] = s * fexp(cumf[tid] + m_in - mtv[tid]); }
            __syncthreads();
            f32x4 h2[4]; f32x4 d1 = {0.f, 0.f, 0.f, 0.f};
#pragma unroll
            for (int a = 0; a < 4; ++a) h2[a] = (f32x4){0.f, 0.f, 0.f, 0.f};
            { const int r = lane & 15, kq = (lane >> 4) * 8;
              for (int ks = 0; ks < wave / 2 + 1; ++ks) {
                  const half8 bfr = *(const half8*)(SC + (wave * 16 + r) * SB + ks * 32 + kq);
#pragma unroll
                  for (int a = 0; a < 4; ++a) { const half8 afr = *(const half8*)(VT + (a * 16 + r) * SB + ks * 32 + kq); h2[a] = mfma16(afr, bfr, h2[a]); }
                  d1 = mfma16(ones, bfr, d1); } }
            { const int l = wave * 16 + (lane & 15); const float ai = fexp(cumf[l] + m_in - mtv[l]); const float rden = 1.0f / fmaxf(fabsf(dn[l] + d1[0]), fexp(-mtv[l]));
              const int pi = c * 128 + l, pos = dir == 0 ? pi : Lseq - 1 - pi;
#pragma unroll
              for (int a = 0; a < 4; ++a) { const int v0 = a * 16 + (lane >> 4) * 4; f32x4 y;
#pragma unroll
                  for (int i = 0; i < 4; ++i) y[i] = (h1[a][0][i] * ai + h2[a][i]) * rden;
                  *(half4*)(hout + (size_t)(rowbase + pos) * 384 + h * 64 + v0) = to_half4(y); } }
        }
        if (kind < 3 && cc + 1 < NCT) load_rows10(u16, nrb, nL, dir, ncn * 128 + j0, ucol, rr);
        { const float sc = fexp(tot + m_in - m_new);
#pragma unroll
          for (int q = 0; q < 2; ++q) accC[0][q] *= sc;
          { const int r = lane & 15, kq = (lane >> 4) * 8;
#pragma unroll
            for (int ks = 0; ks < 4; ++ks) {
              const half8 a = *(const half8*)(KT + ((wave >> 1) * 16 + r) * SB + ks * 32 + kq);
              const f32x4 e0 = *(const f32x4*)(ee + ks * 32 + kq), e1 = *(const f32x4*)(ee + ks * 32 + kq + 4);
#pragma unroll
              for (int q = 0; q < 2; ++q) { half8 bb = *(const half8*)(VT + ((wave & 1) * 32 + q * 16 + r) * SB + ks * 32 + kq);
#pragma unroll
                  for (int i = 0; i < 4; ++i) { bb[i] = (half_t)((float)bb[i] * e0[i]); bb[4 + i] = (half_t)((float)bb[4 + i] * e1[i]); }
                  accC[0][q] = mfma16(a, bb, accC[0][q]); } } }
          if (tid < 64) { float s = 0.f;
#pragma unroll 4
              for (int k8 = 0; k8 < 16; ++k8) { const half8 kv = *(const half8*)(KT + tid * SB + k8 * 8); const f32x4 e0 = *(const f32x4*)(ee + k8 * 8), e1 = *(const f32x4*)(ee + k8 * 8 + 4);
#pragma unroll
                  for (int i = 0; i < 4; ++i) s += e0[i] * (float)kv[i] + e1[i] * (float)kv[4 + i]; }
              nvec[tid] = sc * nvec[tid] + s; } }
        m_in = m_new;
        __syncthreads();
#pragma unroll
        for (int q = 0; q < 2; ++q) { const int v = (wave & 1) * 32 + q * 16 + (lane & 15), d0 = (wave >> 1) * 16 + (lane >> 4) * 4; *(half4*)(CS + v * SA + d0) = to_half4(accC[0][q]); }
    }
    __syncthreads();
}

__device__ __forceinline__ cplx cmul(cplx a, cplx b) { return cplx{a.x * b.x - a.y * b.y, a.x * b.y + a.y * b.x}; }
__device__ __forceinline__ cplx cadd(cplx a, cplx b) { return cplx{a.x + b.x, a.y + b.y}; }
__device__ __forceinline__ cplx csub(cplx a, cplx b) { return cplx{a.x - b.x, a.y - b.y}; }
__device__ __forceinline__ void sincos_turns(float x, float& s, float& c) {
#ifdef EMU
    s = sinf(6.283185307179586f * x); c = cosf(6.283185307179586f * x);
#else
    s = __builtin_amdgcn_sinf(x); c = __builtin_amdgcn_cosf(x);
#endif
}
#define PADI(i) ((i) + ((i) >> 5))
template <bool INV> __device__ __forceinline__ void r4(cplx& a0, cplx& a1, cplx& a2, cplx& a3) {
    const cplx t0 = cadd(a0, a2), t1 = csub(a0, a2), t2 = cadd(a1, a3), t3 = csub(a1, a3);
    a0 = cadd(t0, t2); a2 = csub(t0, t2);
    if (!INV) { a1 = cplx{t1.x + t3.y, t1.y - t3.x}; a3 = cplx{t1.x - t3.y, t1.y + t3.x}; }
    else      { a1 = cplx{t1.x - t3.y, t1.y + t3.x}; a3 = cplx{t1.x + t3.y, t1.y - t3.x}; }
}
template <bool INV> __device__ __forceinline__ void fft16(cplx (&v)[16]) {
#pragma unroll
    for (int l0 = 0; l0 < 4; ++l0) r4<INV>(v[l0], v[l0 + 4], v[l0 + 8], v[l0 + 12]);
    const float C1 = 0.9238795325112867f, S1 = 0.3826834323650898f, C2 = 0.7071067811865476f;
    const float sg = INV ? 1.f : -1.f;
#define TWM(idx, cr, ci) v[idx] = cmul(v[idx], cplx{(cr), sg * (ci)})
    TWM(1 + 4 * 1, C1, S1); TWM(2 + 4 * 1, C2, C2); TWM(3 + 4 * 1, S1, C1);
    TWM(1 + 4 * 2, C2, C2); TWM(2 + 4 * 2, 0.f, 1.f); TWM(3 + 4 * 2, -C2, C2);
    TWM(1 + 4 * 3, S1, C1); TWM(2 + 4 * 3, -C2, C2); TWM(3 + 4 * 3, -C1, -S1);
#undef TWM
    cplx o[16];
#pragma unroll
    for (int m0 = 0; m0 < 4; ++m0) { cplx a0 = v[4 * m0], a1 = v[4 * m0 + 1], a2 = v[4 * m0 + 2], a3 = v[4 * m0 + 3]; r4<INV>(a0, a1, a2, a3);
        o[m0] = a0; o[m0 + 4] = a1; o[m0 + 8] = a2; o[m0 + 12] = a3; }
#pragma unroll
    for (int i = 0; i < 16; ++i) v[i] = o[i];
}
__device__ __forceinline__ void twpow(cplx w1, cplx (&w)[16]) {
    w[1] = w1; w[2] = cmul(w1, w1); w[3] = cmul(w[2], w1); w[4] = cmul(w[2], w[2]); w[5] = cmul(w[4], w1); w[6] = cmul(w[4], w[2]); w[7] = cmul(w[4], w[3]); w[8] = cmul(w[4], w[4]);
#pragma unroll
    for (int m = 9; m < 16; ++m) w[m] = cmul(w[8], w[m - 8]);
}
__device__ __forceinline__ void fft_fwd16(cplx* buf, int N, int tid) {
    for (int n = N; n >= 32; n >>= 4) { const int q = n >> 4;
        for (int i = tid; i < N / 16; i += NT) {
            const int blk = i / q, j = i - blk * q, base = blk * n + j;
            cplx v[16];
#pragma unroll
            for (int l = 0; l < 16; ++l) v[l] = buf[PADI(base + l * q)];
            fft16<false>(v);
            float s, c; sincos_turns(-(float)j / (float)n, s, c);
            cplx w[16]; twpow(cplx{c, s}, w);
            buf[PADI(base)] = v[0];
#pragma unroll
            for (int m = 1; m < 16; ++m) buf[PADI(base + m * q)] = cmul(v[m], w[m]);
        }
        __syncthreads(); }
}
__device__ __forceinline__ void fft_inv16(cplx* buf, int N, int tid) {
    for (int n = 32; n <= N; n <<= 4) { const int q = n >> 4;
        for (int i = tid; i < N / 16; i += NT) {
            const int blk = i / q, j = i - blk * q, base = blk * n + j;
            float s, c; sincos_turns((float)j / (float)n, s, c);
            cplx w[16]; twpow(cplx{c, s}, w);
            cplx v[16];
            v[0] = buf[PADI(base)];
#pragma unroll
            for (int m = 1; m < 16; ++m) v[m] = cmul(buf[PADI(base + m * q)], w[m]);
            fft16<true>(v);
#pragma unroll
            for (int l = 0; l < 16; ++l) buf[PADI(base + l * q)] = v[l];
        }
        __syncthreads(); }
}
static_assert(2 * SEQ == 512 || 2 * SEQ == 8192 || 2 * SEQ == 131072, "FFT size must be 2*16^k");
static_assert(2 * CTXL == 512 || 2 * CTXL == 8192, "FFT size must be 2*16^k");
constexpr int HBUF = (2 * SEQ + (2 * SEQ) / 32 + 8);
__device__ __forceinline__ void hy_conv8(const half_t* p, int t0, int L, float w0, float w1, float w2, float bsv, float (&o)[8]) {
    const half8 m = *(const half8*)(p + t0);
    float e[10]; e[0] = t0 > 0 ? (float)p[t0 - 1] : 0.f; e[9] = t0 + 8 < L ? (float)p[t0 + 8] : 0.f;
#pragma unroll
    for (int i = 0; i < 8; ++i) e[i + 1] = (float)m[i];
#pragma unroll
    for (int i = 0; i < 8; ++i) o[i] = w0 * e[i] + w1 * e[i + 1] + w2 * e[i + 2] + bsv;
}
__device__ __forceinline__ void hyena_channel(const Frame& F, int layer, int c) {
    cplx* bufA = (cplx*)F.smem;
    cplx* bufH = bufA + HBUF;
    float* red = (float*)(bufH + HBUF);
    const int tid = F.tid;
    const float* cwp = F.in(I_HCW) + layer * 3 * 768; const float* cbp = F.in(I_HCB) + layer * 768;
    for (int seg = 0; seg < (layer == 0 ? 2 : 1); ++seg) {
        const int L = seg == 0 ? SEQ : CTXL, N = 2 * L;
        const half_t* hyt = (const half_t*)(F.ws + WS_HYT) + (seg == 0 ? 0 : (size_t)NB * 768 * SEQ);
        float* z1 = (float*)(F.ws + WS_XN) + (seg == 0 ? 0 : (size_t)NB * 256 * SEQ);
        float* yht = (float*)(F.ws + WS_YHT) + (seg == 0 ? 0 : (size_t)NB * 256 * SEQ);
        const float* ft = (const float*)(F.ws + WS_FT) + (seg == 0 ? (size_t)layer * 256 * 4 * SEQ : (size_t)2 * 256 * 4 * SEQ);
        for (int order = 0; order < 2; ++order) {
            const float* hfw = ft + ((size_t)(c * 2 + order) * 2 + 0) * L; const float* hbw = ft + ((size_t)(c * 2 + order) * 2 + 1) * L;
            float asum = 0.f;
            for (int i = tid; i < N; i += NT) { const float v = i < L ? hfw[i] : (i == L ? 0.f : hbw[N - i]); bufH[PADI(i)] = cplx{v, 0.f}; asum += fabsf(v); }
            asum = wave_sum(asum);
            if (F.lane == 0) red[F.wave] = asum;
            __syncthreads();
            float tot = 0.f; for (int w = 0; w < NT / 64; ++w) tot += red[w];
            const float scale = 1.0f / (tot * (float)N);
            fft_fwd16(bufH, N, tid);
            for (int i = tid; i < N / 2; i += NT) { const cplx a = bufH[PADI(2 * i)], b_ = bufH[PADI(2 * i + 1)]; const cplx s = cadd(a, b_), d = csub(a, b_);
                bufH[PADI(2 * i)] = cplx{s.x * scale, s.y * scale}; bufH[PADI(2 * i + 1)] = cplx{d.x * scale, d.y * scale}; }
            __syncthreads();
            const int gch = 256 * (order + 1) + c;
            const float gw0 = cwp[gch], gw1 = cwp[768 + gch], gw2 = cwp[1536 + gch], gb = cbp[gch];
            const float vw0 = cwp[c], vw1 = cwp[768 + c], vw2 = cwp[1536 + c], vb = cbp[c];
            const float skip = F.in(I_HSKIP)[(layer * 2 + order) * 256 + c];
            for (int pr = 0; pr < NB / 2; ++pr) {
                const int b0 = 2 * pr, b1 = b0 + 1;
                const half_t* v0p = hyt + ((size_t)b0 * 768 + c) * L; const half_t* v1p = hyt + ((size_t)b1 * 768 + c) * L;
                const float* z0q = z1 + ((size_t)b0 * 256 + c) * L; const float* z1q = z1 + ((size_t)b1 * 256 + c) * L;
                for (int t0 = tid * 8; t0 < N; t0 += NT * 8) {
                    if (t0 < L) { float za[8], zb[8];
                        if (order == 0) { hy_conv8(v0p, t0, L, vw0, vw1, vw2, vb, za); hy_conv8(v1p, t0, L, vw0, vw1, vw2, vb, zb); }
                        else {
#pragma unroll
                            for (int i = 0; i < 8; ++i) { za[i] = z0q[t0 + i]; zb[i] = z1q[t0 + i]; } }
#pragma unroll
                        for (int i = 0; i < 8; ++i) bufA[PADI(t0 + i)] = cplx{za[i], zb[i]}; }
                    else {
#pragma unroll
                        for (int i = 0; i < 8; ++i) bufA[PADI(t0 + i)] = cplx{0.f, 0.f}; }
                }
                __syncthreads();
                fft_fwd16(bufA, N, tid);
                for (int i = tid; i < N / 2; i += NT) { const cplx a = bufA[PADI(2 * i)], b_ = bufA[PADI(2 * i + 1)];
                    const cplx s = cmul(cadd(a, b_), bufH[PADI(2 * i)]), d = cmul(csub(a, b_), bufH[PADI(2 * i + 1)]);
                    bufA[PADI(2 * i)] = cadd(s, d); bufA[PADI(2 * i + 1)] = csub(s, d); }
                __syncthreads();
                fft_inv16(bufA, N, tid);
                const half_t* g0p = hyt + ((size_t)b0 * 768 + gch) * L; const half_t* g1p = hyt + ((size_t)b1 * 768 + gch) * L;
                float* d0 = (order == 0 ? z1 : yht) + ((size_t)b0 * 256 + c) * L; float* d1 = (order == 0 ? z1 : yht) + ((size_t)b1 * 256 + c) * L;
                for (int t0 = tid * 8; t0 < L; t0 += NT * 8) {
                    float za[8], zb[8], ga[8], gb_[8];
                    if (order == 0) { hy_conv8(v0p, t0, L, vw0, vw1, vw2, vb, za); hy_conv8(v1p, t0, L, vw0, vw1, vw2, vb, zb); }
                    else {
#pragma unroll
                        for (int i = 0; i < 8; ++i) { za[i] = z0q[t0 + i]; zb[i] = z1q[t0 + i]; } }
                    hy_conv8(g0p, t0, L, gw0, gw1, gw2, gb, ga); hy_conv8(g1p, t0, L, gw0, gw1, gw2, gb, gb_);
                    f32x4 oa[2], ob[2];
#pragma unroll
                    for (int i = 0; i < 8; ++i) { const cplx y = bufA[PADI(t0 + i)]; oa[i >> 2][i & 3] = ga[i] * (y.x + skip * za[i]); ob[i >> 2][i & 3] = gb_[i] * (y.y + skip * zb[i]); }
                    *(f32x4*)(d0 + t0) = oa[0]; *(f32x4*)(d0 + t0 + 4) = oa[1]; *(f32x4*)(d1 + t0) = ob[0]; *(f32x4*)(d1 + t0 + 4) = ob[1];
                }
                __syncthreads();
            }
        }
    }
}
__device__ __forceinline__ void phase_mixers(const Frame& F, int layer) {
    const int G = gridDim.x, bid = blockIdx.x;
    constexpr int NSCAN = 2 * NB * 6 * 2;
    if (bid < NSCAN) {
        const int k = bid >> 1, kind = bid & 1, dir = k % 2, h = (k / 2) % 6, b = k / 12;
#ifndef MIXMASK
#define MIXMASK 7
#endif
        if (kind == 0) { if (MIXMASK & 1) ssd_block(F, layer, b, h, dir); } else { if (MIXMASK & 2) mlstm_block(F, layer, b, h, dir); }
    } else {
        for (int c = bid - NSCAN; c < 256; c += G - NSCAN) if (MIXMASK & 4) hyena_channel(F, layer, c);
        for (int it = bid - NSCAN; it < IT_TMOE; it += G - NSCAN) moe_transpose_item(F, layer, it);
    }
}

__device__ __forceinline__ void phase_combine(const Frame& F, int layer) {
    const int nrows = layer == 0 ? TT : TL, total = nrows / 32;
    const half_t* u16 = (const half_t*)(F.ws + WS_U16);
    const half_t* yf = (const half_t*)(F.ws + WS_YF); const half_t* yb = yf + (size_t)TT * 384; const half_t* hf = yb + (size_t)TT * 384; const half_t* hb = hf + (size_t)TT * 384;
    half_t* yl = (half_t*)(F.ws + WS_XN);
    const float* snw = F.in(I_SNW) + layer * 384; const float* mnw = F.in(I_MNW) + layer * 384;
    for (int it = blockIdx.x; it < total; it += gridDim.x) {
        const int row0 = it * 32;
        for (int rr = F.wave; rr < 32; rr += NT / 64) {
            const int row = row0 + rr;
            float g[6]; float ss = 0.f;
#pragma unroll
            for (int i = 0; i < 6; ++i) { const int k = i * 64 + F.lane; const float y = (float)yf[(size_t)row * 384 + k] + (float)yb[(size_t)row * 384 + k];
                g[i] = y * siluf((float)u16[(size_t)row * UW + k]); ss += g[i] * g[i]; }
            ss = wave_sum(ss);
            const float rs = 1.0f / sqrtf(ss * (1.0f / 384.f) + EPSF);
#pragma unroll
            for (int i = 0; i < 6; ++i) { const int k = i * 64 + F.lane; yl[(size_t)row * D + k] = (half_t)(g[i] * rs * snw[k]); }
#pragma unroll
            for (int i = 0; i < 6; ++i) { const int k = i * 64 + F.lane; const float hv = (float)hf[(size_t)row * 384 + k] + (float)hb[(size_t)row * 384 + k];
                const float mu = wave_sum(hv) * (1.0f / 64.f); const float hc = hv - mu; const float var = wave_sum(hc * hc) * (1.0f / 64.f);
                const float hn = hc * (1.0f / sqrtf(var + EPSF)) * mnw[k];
                yl[(size_t)row * D + 640 + k] = (half_t)(sigmoidf_((float)u16[(size_t)row * UW + 2176 + k]) * hn); }
        }
        { const bool isl = row0 < TL; const int L = isl ? SEQ : CTXL; const int rc = isl ? row0 : row0 - TL; const int b = rc / L, t0 = rc % L;
          const float* yht = (const float*)(F.ws + WS_YHT) + (isl ? 0 : (size_t)NB * 256 * SEQ);
          if (F.tid < 256) { const int c = F.tid; const float* src = yht + ((size_t)b * 256 + c) * L + t0;
              for (int i = 0; i < 32; ++i) yl[(size_t)(row0 + i) * D + 384 + c] = (half_t)src[i]; } }
    }
}

struct EpiOutproj {
    Frame F; int layer;
    __device__ __forceinline__ void operator()(const f32x4 (&acc)[2][2][4][2], const g8::Unit& u, int wr, int wc, int fr, int fq) const {
#pragma unroll
        for (int ai = 0; ai < 2; ++ai)
#pragma unroll
            for (int m = 0; m < 4; ++m) {
                const int srow = u.pm * 256 + ai * 128 + wr * 64 + m * 16 + fr;
                int row = srow;
                if (layer == 1 && srow < TL) { const int b = srow / SEQ, s = srow % SEQ; row = b * SEQ + (s % GROWS) * GW + s / GROWS; }
                const float* g1 = modp(F, layer, row_mod(row), 2);
                const float* xi = F.xrow_in(layer, row); float* xo = F.xrow(row);
#pragma unroll
                for (int bj = 0; bj < 2; ++bj)
#pragma unroll
                    for (int n = 0; n < 2; ++n) { const int c0 = u.pn * 256 + bj * 128 + wc * 32 + n * 16 + 4 * fq;
                        const f32x4 xv = *(const f32x4*)(xi + c0), gv = *(const f32x4*)(g1 + c0);
                        *(f32x4*)(xo + c0) = xv + gv * acc[ai][bj][m][n]; }
#ifndef EMU
                asm volatile("" ::: "memory");
#endif
            }
    }
};
__device__ __forceinline__ void phase_outproj(const Frame& F, int layer) {
    const int nrows = layer == 0 ? TT : TL;
    g8::DenseSched S; S.abase = (const char*)(F.ws + WS_XN); S.bbase = (const char*)((const half_t*)(F.ws + WS_WOUT) + (size_t)layer * D * D); S.K = D; S.nM = nrows / 256; S.nN = D / 256; S.G = gridDim.x; S.c = blockIdx.x;
    EpiOutproj E{F, layer};
    g8::gemm_phase(F.smem, D, S, E);
}

constexpr int RLD = D + 8;
__device__ __forceinline__ void phase_router(const Frame& F, int layer, bool dry = false) {
    const int nrows = layer == 0 ? TT : TL, total = nrows / 32;
    half_t* Th = (half_t*)F.smem;
    half_t* Tl = Th + 32 * RLD;
    float* LG = (float*)(Tl + 32 * RLD);
    half_t* tb = (half_t*)(F.ws + WS_XN);
    unsigned* cnt = (unsigned*)(F.ws + WS_CTL) + CW_CNT + layer * 64;
    int* list = (int*)(F.ws + WS_LIST); float* pw = (float*)(F.ws + WS_PW);
    const float* nw = F.in(I_N2W) + layer * D;
    const half_t* wr = (const half_t*)(F.ws + WS_WR) + (size_t)layer * 2 * 48 * D;
    for (int it = blockIdx.x; it < total; it += gridDim.x) {
        const int row0 = it * 32;
        {
            const int r4 = F.wave * 4, m = row_mod(row0), lane = F.lane;
            f32x4 v[4][4];
#pragma unroll
            for (int r = 0; r < 4; ++r) { const float* x = F.xrow(row0 + r4 + r);
#pragma unroll
                for (int q = 0; q < 4; ++q) v[r][q] = *(const f32x4*)(x + q * 256 + lane * 4); }
            const float* sh = modp(F, layer, m, 3); const float* scl = modp(F, layer, m, 4);
            f32x4 g[4], s4[4];
#pragma unroll
            for (int q = 0; q < 4; ++q) { const int k = q * 256 + lane * 4; const f32x4 a = *(const f32x4*)(nw + k), b = *(const f32x4*)(scl + k); s4[q] = *(const f32x4*)(sh + k);
#pragma unroll
                for (int e = 0; e < 4; ++e) g[q][e] = a[e] * (1.0f + b[e]); }
#pragma unroll
            for (int r = 0; r < 4; ++r) {
                float ss = 0.f;
#pragma unroll
                for (int q = 0; q < 4; ++q) ss += v[r][q][0] * v[r][q][0] + v[r][q][1] * v[r][q][1] + v[r][q][2] * v[r][q][2] + v[r][q][3] * v[r][q][3];
                ss = wave_sum(ss);
                const float rs = 1.0f / sqrtf(ss * (1.0f / D) + EPSF);
                const int rr = r4 + r, row = row0 + rr;
#pragma unroll
                for (int q = 0; q < 4; ++q) { const int k = q * 256 + lane * 4; half4 h, l;
#pragma unroll
                    for (int e = 0; e < 4; ++e) { const float tv = v[r][q][e] * rs * g[q][e] + s4[q][e]; h[e] = (half_t)tv; l[e] = (half_t)((tv - (float)h[e]) * 2048.f); }
                    *(half4*)(tb + (size_t)row * D + k) = h; *(half4*)(Th + rr * RLD + k) = h; *(half4*)(Tl + rr * RLD + k) = l; }
            }
        }
        __syncthreads();
        {
            const int kb = F.wave * 128, r = F.lane & 15, kq = (F.lane >> 4) * 8;
            f32x4 ah[2][3], al[2][3]; zero_acc(ah); zero_acc(al);
#pragma unroll
            for (int hf = 0; hf < 2; ++hf) {
                half8 bh[3][2], bl[3][2];
#pragma unroll
                for (int nt = 0; nt < 3; ++nt)
#pragma unroll
                    for (int ks = 0; ks < 2; ++ks) { const size_t o = (size_t)(nt * 16 + r) * D + kb + (hf * 2 + ks) * 32 + kq; bh[nt][ks] = *(const half8*)(wr + o); bl[nt][ks] = *(const half8*)(wr + (size_t)48 * D + o); }
#pragma unroll
                for (int ks = 0; ks < 2; ++ks)
#pragma unroll
                    for (int mt = 0; mt < 2; ++mt) {
                        const half8 a_h = *(const half8*)(Th + (mt * 16 + r) * RLD + kb + (hf * 2 + ks) * 32 + kq), a_l = *(const half8*)(Tl + (mt * 16 + r) * RLD + kb + (hf * 2 + ks) * 32 + kq);
#pragma unroll
                        for (int nt = 0; nt < 3; ++nt) { ah[mt][nt] = mfma16(a_h, bh[nt][ks], ah[mt][nt]); al[mt][nt] = mfma16(a_l, bh[nt][ks], al[mt][nt]); al[mt][nt] = mfma16(a_h, bl[nt][ks], al[mt][nt]); }
                    }
            }
            __syncthreads();
            float* PART = (float*)Th;
#pragma unroll
            for (int mt = 0; mt < 2; ++mt)
#pragma unroll
                for (int nt = 0; nt < 3; ++nt)
#pragma unroll
                    for (int i = 0; i < 4; ++i) PART[(F.wave * 32 + mt * 16 + (F.lane >> 4) * 4 + i) * 48 + nt * 16 + r] = ah[mt][nt][i] + al[mt][nt][i] * (1.0f / 2048.f);
            __syncthreads();
            for (int o = F.tid; o < 32 * 48; o += NT) { const int col = o % 48; float sum = 0.f;
#pragma unroll
                for (int w = 0; w < 8; ++w) sum += PART[w * 32 * 48 + o];
                float bias = 0.f; if (col < 4) bias = F.in(I_GRB)[layer * 4 + col]; else if (col < 36) bias = F.in(I_ERB)[layer * 32 + col - 4];
                LG[o] = sum + bias; }
        }
        __syncthreads();
        if (F.tid < 32) {
            const int row = row0 + F.tid; const float* lg = LG + F.tid * 48;
            int gi = 0; float gm = lg[0];
            for (int q = 1; q < 4; ++q) if (lg[q] > gm) { gm = lg[q]; gi = q; }
            float gs = 0.f; for (int q = 0; q < 4; ++q) gs += expf(lg[q] - gm);
            const float grp_p = 1.0f / gs;
            const float* el = lg + 4 + gi * 8;
            int i0 = 0; float e0 = el[0];
            for (int q = 1; q < 8; ++q) if (el[q] > e0) { e0 = el[q]; i0 = q; }
            int i1 = -1; float e1 = -3.0e38f;
            for (int q = 0; q < 8; ++q) if (q != i0 && el[q] > e1) { e1 = el[q]; i1 = q; }
            const float p1 = expf(e1 - e0);
            const float w0 = grp_p * (1.0f / (1.0f + p1)), w1 = grp_p * (p1 / (1.0f + p1));
            const int ea = gi * 8 + i0, eb = gi * 8 + i1;
            if (!dry) { const unsigned pa = atomicAdd(&cnt[ea * 2 + 0], 1u), pb = atomicAdd(&cnt[eb * 2 + 1], 1u);
            list[(size_t)(ea * 2 + 0) * LCAP + pa] = row * 2 + 0; list[(size_t)(eb * 2 + 1) * LCAP + pb] = row * 2 + 1;
            pw[row * 2 + 0] = w0; pw[row * 2 + 1] = w1; } else if (w0 == 1234.5f) pw[row * 2] = w1;
        }
        __syncthreads();
    }
}

constexpr int MOE_PRE_OFF = g8::STAGE_BYTES;
struct MoeSchedA {
    const char* abase; const char* wbase; const int* pre; const unsigned* cnt; const int* list; int G, c;
    __device__ __forceinline__ int entry(int e, int r) const { const int c0 = (int)cnt[e * 2]; return r < c0 ? list[(size_t)(e * 2) * LCAP + r] : list[(size_t)(e * 2 + 1) * LCAP + (r - c0)]; }
    __device__ __forceinline__ bool next(int i, g8::Unit& u) const {
        const int L = i * G + c; if (L >= pre[32]) return false;
        int e = 0; while (L >= pre[e + 1]) ++e;
        const int loc = L - pre[e]; u.e = e; u.n = (int)(cnt[e * 2] + cnt[e * 2 + 1]); u.pm = loc >> 1; u.pn = loc & 1; return true;
    }
    __device__ __forceinline__ unsigned a_off(const g8::Unit& u, int r) const { const int rr = u.pm * 256 + r; const int pid = entry(u.e, rr < u.n ? rr : 0); return (unsigned)(pid >> 1) * (unsigned)(D * 2); }
    __device__ __forceinline__ const char* b_half(const g8::Unit& u, int h) const { return wbase + ((size_t)u.e * 3 * 262144 + (size_t)h * 262144 + (size_t)u.pn * 128 * D) * 2; }
};
struct EpiMoeA {
    MoeSchedA S; const float* pw; half_t* hid;
    __device__ __forceinline__ void operator()(const f32x4 (&acc)[2][2][4][2], const g8::Unit& u, int wr, int wc, int fr, int fq) const {
#pragma unroll
        for (int ai = 0; ai < 2; ++ai)
#pragma unroll
            for (int m = 0; m < 4; ++m) {
                const int rr = u.pm * 256 + ai * 128 + wr * 64 + m * 16 + fr;
                if (rr < u.n) { const int pid = S.entry(u.e, rr); const float w = pw[pid];
#pragma unroll
                    for (int n = 0; n < 2; ++n) { const int f = u.pn * 128 + wc * 32 + n * 16 + 4 * fq; const f32x4 g = acc[ai][0][m][n], up = acc[ai][1][m][n]; f32x4 o;
#pragma unroll
                        for (int i = 0; i < 4; ++i) o[i] = siluf(g[i]) * up[i] * w;
                        *(half4*)(hid + (size_t)pid * 256 + f) = to_half4(o); } }
            }
    }
};
__device__ __forceinline__ void phase_moe_a(const Frame& F, int layer) {
    int* pre = (int*)(F.smem + MOE_PRE_OFF);
    const unsigned* cnt = (const unsigned*)(F.ws + WS_CTL) + CW_CNT + layer * 64;
    if (F.tid == 0) { int s = 0; for (int e = 0; e < 32; ++e) { pre[e] = s; s += (((int)(cnt[e * 2] + cnt[e * 2 + 1]) + 255) / 256) * 2; } pre[32] = s; }
    __syncthreads();
    MoeSchedA S; S.abase = (const char*)(F.ws + WS_XN); S.wbase = (const char*)(F.ws + WS_WMOE); S.pre = pre; S.cnt = cnt; S.list = (const int*)(F.ws + WS_LIST); S.G = gridDim.x; S.c = blockIdx.x;
    EpiMoeA E{S, (const float*)(F.ws + WS_PW), (half_t*)(F.ws + WS_U16)};
    g8::gemm_phase(F.smem, D, S, E);
    __syncthreads();
}
struct MoeSchedB {
    const char* abase; const char* wbase; const int* pre; const unsigned* cnt; const int* list; int slot, G, c;
    __device__ __forceinline__ bool next(int i, g8::Unit& u) const {
        const int L = i * G + c; if (L >= pre[32]) return false;
        int e = 0; while (L >= pre[e + 1]) ++e;
        const int loc = L - pre[e]; u.e = e; u.n = (int)cnt[e * 2 + slot]; u.pm = loc >> 2; u.pn = loc & 3; return true;
    }
    __device__ __forceinline__ int entry(const g8::Unit& u, int rr) const { return list[(size_t)(u.e * 2 + slot) * LCAP + (rr < u.n ? rr : 0)]; }
    __device__ __forceinline__ unsigned a_off(const g8::Unit& u, int r) const { return (unsigned)entry(u, u.pm * 256 + r) * 512u; }
    __device__ __forceinline__ const char* b_half(const g8::Unit& u, int h) const { return wbase + ((size_t)u.e * 3 * 262144 + 2 * 262144 + (size_t)(u.pn * 256 + h * 128) * 256) * 2; }
};
struct EpiMoeB {
    MoeSchedB S; Frame F; int layer;
    __device__ __forceinline__ void operator()(const f32x4 (&acc)[2][2][4][2], const g8::Unit& u, int wr, int wc, int fr, int fq) const {
#pragma unroll
        for (int ai = 0; ai < 2; ++ai)
#pragma unroll
            for (int m = 0; m < 4; ++m) {
                const int rr = u.pm * 256 + ai * 128 + wr * 64 + m * 16 + fr;
                if (rr < u.n) { const int row = S.entry(u, rr) >> 1; float* xo = F.xrow(row); const float* g5 = modp(F, layer, row_mod(row), 5);
#pragma unroll
                    for (int bj = 0; bj < 2; ++bj) {
#pragma unroll
                        for (int n = 0; n < 2; ++n) { const int d = u.pn * 256 + bj * 128 + wc * 32 + n * 16 + 4 * fq;
                            const f32x4 xv = *(const f32x4*)(xo + d), gv = *(const f32x4*)(g5 + d); *(f32x4*)(xo + d) = xv + gv * acc[ai][bj][m][n]; }
#ifndef EMU
                        asm volatile("" ::: "memory");
#endif
                    } }
            }
    }
};
__device__ __forceinline__ void phase_moe_b(const Frame& F, int layer, int slot) {
    int* pre = (int*)(F.smem + MOE_PRE_OFF);
    const unsigned* cnt = (const unsigned*)(F.ws + WS_CTL) + CW_CNT + layer * 64;
    if (F.tid == 0) { int s = 0; for (int e = 0; e < 32; ++e) { pre[e] = s; s += (((int)cnt[e * 2 + slot] + 255) / 256) * 4; } pre[32] = s; }
    __syncthreads();
    MoeSchedB S; S.abase = (const char*)(F.ws + WS_U16); S.wbase = (const char*)(F.ws + WS_WMOE); S.pre = pre; S.cnt = cnt; S.list = (const int*)(F.ws + WS_LIST); S.slot = slot; S.G = gridDim.x; S.c = blockIdx.x;
    EpiMoeB E{S, F, layer};
    g8::gemm_phase(F.smem, 256, S, E);
    __syncthreads();
}

__device__ __forceinline__ void phase_final(const Frame& F) {
    const float* fw = F.in(I_FNW);
    f32x4 w4[4];
#pragma unroll
    for (int q = 0; q < 4; ++q) w4[q] = *(const f32x4*)(fw + q * 256 + F.lane * 4);
    for (int it = blockIdx.x; it < TL / 32; it += gridDim.x) {
        float* x0 = F.P->out + (size_t)(it * 32 + F.wave * 4) * D;
        f32x4 v[4][4];
#pragma unroll
        for (int r = 0; r < 4; ++r)
#pragma unroll
            for (int q = 0; q < 4; ++q) v[r][q] = *(const f32x4*)(x0 + (size_t)r * D + q * 256 + F.lane * 4);
#pragma unroll
        for (int r = 0; r < 4; ++r) {
            float ss = 0.f;
#pragma unroll
            for (int q = 0; q < 4; ++q) ss += v[r][q][0] * v[r][q][0] + v[r][q][1] * v[r][q][1] + v[r][q][2] * v[r][q][2] + v[r][q][3] * v[r][q][3];
            ss = wave_sum(ss);
            const float rs = 1.0f / sqrtf(ss * (1.0f / D) + EPSF);
#pragma unroll
            for (int q = 0; q < 4; ++q) *(f32x4*)(x0 + (size_t)r * D + q * 256 + F.lane * 4) = v[r][q] * rs * w4[q];
        }
    }
}

constexpr int NPHASE = 1 + 2 * 9 + 1;
#ifndef ONLY
#define ONLY -1
#endif
#define EN(x) (ONLY < 0 || ONLY == (x))
__device__ __forceinline__ void run_phase(const Frame& F, int ph) {
    if (ph == 0) { if (EN(0)) phase_setup(F); return; }
    if (ph == NPHASE - 1) { if (EN(10)) phase_final(F); return; }
    const int layer = (ph - 1) / 9, k = (ph - 1) % 9;
    switch (k) {
        case 0: if (EN(1)) phase_norm1(F, layer); break;
        case 1: if (EN(2)) phase_inproj(F, layer); break;
        case 2: if (EN(3)) phase_mixers(F, layer); break;
        case 3: if (EN(4)) phase_combine(F, layer); break;
        case 4: if (EN(5)) phase_outproj(F, layer); break;
        case 5: if (EN(6)) phase_router(F, layer); break;
        case 6: if (EN(7)) phase_moe_a(F, layer); break;
        case 7: if (EN(8)) phase_moe_b(F, layer, 0); break;
        default: if (EN(9)) phase_moe_b(F, layer, 1); break;
    }
}

#ifdef EMU
void mega(const Params* Pp) {
    Frame F; F.P = Pp; F.ws = Pp->ws; F.smem = emu_blk->smem; F.tid = threadIdx.x; F.lane = F.tid & 63; F.wave = F.tid >> 6;
    for (int ph = Pp->ph_lo; ph < Pp->ph_hi; ++ph) { run_phase(F, ph); __syncthreads(); }
}
#else
__global__ void __launch_bounds__(NT) mega(Params P) {
    extern __shared__ __attribute__((aligned(16))) unsigned char smem_dyn[];
    cg::grid_group grid = cg::this_grid();
    Frame F; F.P = (ParamsPtr)__builtin_amdgcn_kernarg_segment_ptr(); F.ws = P.ws; F.smem = smem_dyn; F.tid = threadIdx.x; F.lane = F.tid & 63; F.wave = F.tid >> 6;
    volatile LAS unsigned* bst = (volatile LAS unsigned*)(smem_dyn + LDS_BYTES - 16);
    if (F.tid < 4) bst[F.tid] = 0u;
    __syncthreads();
    XcdBarrier xb = xcd_barrier_post((unsigned*)(P.ws + WS_CTL) + CW_BAR, bst);
    if (P.ph_lo < 0) grid.sync();
#define DUP -1
#define PHASE_STEP(i) if (P.ph_lo <= (i) && (i) < P.ph_hi) { run_phase(F, (i)); if (DUP == (i)) { xcd_barrier(xb); if (DUP == 6) phase_router(F, 0, true); else run_phase(F, (i)); } if ((i) + 1 < P.ph_hi) xcd_barrier(xb); }
    PHASE_STEP(0) PHASE_STEP(1) PHASE_STEP(2) PHASE_STEP(3) PHASE_STEP(4) PHASE_STEP(5) PHASE_STEP(6) PHASE_STEP(7) PHASE_STEP(8) PHASE_STEP(9)
    PHASE_STEP(10) PHASE_STEP(11) PHASE_STEP(12) PHASE_STEP(13) PHASE_STEP(14) PHASE_STEP(15) PHASE_STEP(16) PHASE_STEP(17) PHASE_STEP(18) PHASE_STEP(19)
    static_assert(NPHASE == 20, "phase list");
}

extern "C" void kernel_launch(void* const* d_in, const int* in_sizes, int n_in, void* d_out, int out_size, void* d_ws, size_t ws_size, hipStream_t stream) {
    static int grid_blocks = 0;
    if (grid_blocks == 0) {
        if (n_in != 38 || out_size != TL * D || ws_size < WS_END) { fprintf(stderr, "kernel_launch: unexpected shapes (n_in %d out %d ws %zu need %zu)\n", n_in, out_size, ws_size, (size_t)WS_END); grid_blocks = -1; return; }
        int dev = 0, cus = 0, per_cu = 0;
        hipGetDevice(&dev);
        hipDeviceGetAttribute(&cus, hipDeviceAttributeMultiprocessorCount, dev);
        hipFuncSetAttribute((const void*)mega, hipFuncAttributeMaxDynamicSharedMemorySize, LDS_BYTES);
        hipOccupancyMaxActiveBlocksPerMultiprocessor(&per_cu, (const void*)mega, NT, LDS_BYTES);
        if (per_cu < 1) { fprintf(stderr, "kernel_launch: occupancy query says 0 blocks per CU\n"); grid_blocks = -1; return; }
        grid_blocks = cus;
    }
    if (grid_blocks < 0) return;
    if (hipMemsetAsync((char*)d_ws + WS_CTL, 0, CTL_BYTES, stream) != hipSuccess) { fprintf(stderr, "kernel_launch: memset failed\n"); return; }
    Params p{};
    for (int i = 0; i < 38; ++i) p.in[i] = (const float*)d_in[i];
    p.out = (float*)d_out; p.ws = (unsigned char*)d_ws; p.ph_lo = 0; p.ph_hi = NPHASE;
    void* args[] = {&p};
    hipError_t e = hipLaunchCooperativeKernel((const void*)mega, dim3(grid_blocks), dim3(NT), args, LDS_BYTES, stream);
    if (e != hipSuccess) fprintf(stderr, "cooperative launch failed: %s (grid %d)\n", hipGetErrorString(e), grid_blocks);
}
#endif
```

```cpp
#ifdef EMU
#include "gpuemu.h"
#else
#include <hip/hip_runtime.h>
#include <hip/hip_cooperative_groups.h>
#include <cstdio>
namespace cg = cooperative_groups;
#endif
#include <stdint.h>

#ifndef CFG_B
#define CFG_B 4
#endif
#ifndef CFG_SEQ
#define CFG_SEQ 4096
#endif
#ifndef CFG_CTX
#define CFG_CTX 256
#endif

typedef _Float16 half_t;
typedef _Float16 half8 __attribute__((ext_vector_type(8)));
typedef _Float16 half4 __attribute__((ext_vector_type(4)));
typedef float f32x4 __attribute__((ext_vector_type(4)));
struct cplx { float x, y; };

constexpr int D = 1024, NB = CFG_B, SEQ = CFG_SEQ, CTXL = CFG_CTX, GW = 64, GROWS = SEQ / GW;
constexpr int TL = NB * SEQ, TC = NB * CTXL, TT = TL + TC;
constexpr int NIN = 3364, NINP = 3584;
constexpr int UW = 2560;
constexpr int UGW = 36;
constexpr int NT = 512;
constexpr int TWN = 2 * SEQ > 2 * CTXL ? 2 * SEQ : 2 * CTXL;
constexpr int NMOD = 6 * D;
constexpr int LCAP = TT;
constexpr float EPSF = 1e-6f;

constexpr size_t al256(size_t x) { return (x + 255) / 256 * 256; }
constexpr size_t WS_CTL    = 0;
constexpr size_t WS_MOD    = 32768;
constexpr size_t WS_TW     = WS_MOD + al256(sizeof(float) * 2 * 5 * NMOD);
constexpr size_t WS_WIN    = WS_TW + al256(sizeof(cplx) * TWN);
constexpr size_t WS_WOUT   = WS_WIN + al256(2ull * 2 * NINP * D);
constexpr size_t WS_WMOE   = WS_WOUT + al256(2ull * 2 * D * D);
constexpr size_t WS_XC     = WS_WMOE + al256(2ull * 32 * 3 * 262144);
constexpr size_t WS_XN     = WS_XC + al256(4ull * TC * D);
constexpr size_t WS_U16    = WS_XN + al256(2ull * TT * D);
constexpr size_t WS_UG     = WS_U16 + al256(2ull * TT * UW);
constexpr size_t WS_HYT    = WS_UG + al256(4ull * TT * UGW);
constexpr size_t WS_YF     = WS_HYT + al256(2ull * NB * 768 * (SEQ + CTXL));
constexpr size_t WS_YHT    = WS_YF + al256(2ull * 4 * TT * 384);
constexpr size_t WS_FT     = WS_YHT + al256(4ull * NB * 256 * (SEQ + CTXL));
constexpr size_t WS_LIST   = WS_FT + al256(4ull * (2 * 256 * 4 * SEQ + 256 * 4 * CTXL));
constexpr size_t WS_PW     = WS_LIST + al256(4ull * 64 * LCAP);
constexpr size_t WS_WR     = WS_PW + al256(4ull * TT * 2);
constexpr size_t WS_END    = WS_WR + al256(2ull * 2 * 2 * 48 * D);
static_assert(4ull * NB * 256 * (SEQ + CTXL) <= 2ull * TT * D, "Z1 scratch must fit in the XN region");
static_assert(2ull * TT * 2 * 256 <= 2ull * TT * UW, "HID must fit in the U16 region");

constexpr int CW_CNT = 0;
constexpr int CW_BAR = 1024;
constexpr size_t CTL_BYTES = 32768;

constexpr int LDS_BYTES = 156 * 1024;

struct Params {
    const float* in[38];
    float* out;
    unsigned char* ws;
    int ph_lo, ph_hi;
};

enum { I_X = 0, I_C, I_CTX, I_CCTX, I_WMOD, I_BMOD, I_N1W, I_N2W, I_WIN, I_WOUT, I_SCW, I_SCB, I_DTB, I_ALOG, I_SD, I_SNW,
       I_HCW, I_HCB, I_HW1, I_HB1, I_HW2, I_HB2, I_HW3, I_HFREQ, I_HDEC, I_HSKIP, I_MCW, I_MCB, I_MGB, I_MNW,
       I_GRW, I_GRB, I_ERW, I_ERB, I_MG, I_MU, I_MD, I_FNW };

__device__ __forceinline__ float siluf(float x) { return x / (1.0f + expf(-x)); }
__device__ __forceinline__ float sigmoidf_(float x) { return 1.0f / (1.0f + expf(-x)); }
__device__ __forceinline__ float softplusf_(float x) { return x > 20.f ? x : log1pf(expf(x)); }
__device__ __forceinline__ float logsigmoidf_(float x) { return fminf(x, 0.f) - log1pf(expf(-fabsf(x))); }

__device__ __forceinline__ float fexp(float x) {
#ifdef EMU
    return expf(x);
#else
    return __expf(x);
#endif
}
__device__ __forceinline__ float fsilu(float x) {
#ifdef EMU
    return x / (1.0f + expf(-x));
#else
    return __fdividef(x, 1.0f + __expf(-x));
#endif
}
__device__ __forceinline__ float wave_sum(float v) {
#pragma unroll
    for (int m = 32; m >= 1; m >>= 1) v += __shfl_xor(v, m);
    return v;
}
__device__ __forceinline__ float wave_max(float v) {
#pragma unroll
    for (int m = 32; m >= 1; m >>= 1) v = fmaxf(v, __shfl_xor(v, m));
    return v;
}
__device__ __forceinline__ float wave_scan_sum(float v, int lane) {
#pragma unroll
    for (int d = 1; d < 64; d <<= 1) { float o = __shfl_up(v, d); if (lane >= d) v += o; }
    return v;
}
__device__ __forceinline__ float wave_scan_max(float v, int lane) {
#pragma unroll
    for (int d = 1; d < 64; d <<= 1) { float o = __shfl_up(v, d); if (lane >= d) v = fmaxf(v, o); }
    return v;
}

template <int MT, int NTL>
__device__ __forceinline__ void mma_lds(f32x4 (&acc)[MT][NTL], const half_t* A, int lda, const half_t* B, int ldb, int ksteps, int lane) {
#ifndef EMU
    const int r = lane & 15, kq = (lane >> 4) * 8;
    for (int ks = 0; ks < ksteps; ++ks) {
        half8 a[MT], b[NTL];
#pragma unroll
        for (int mt = 0; mt < MT; ++mt) a[mt] = *(const half8*)(A + (mt * 16 + r) * lda + ks * 32 + kq);
#pragma unroll
        for (int nt = 0; nt < NTL; ++nt) b[nt] = *(const half8*)(B + (nt * 16 + r) * ldb + ks * 32 + kq);
#pragma unroll
        for (int mt = 0; mt < MT; ++mt)
#pragma unroll
            for (int nt = 0; nt < NTL; ++nt) acc[mt][nt] = __builtin_amdgcn_mfma_f32_16x16x32_f16(a[mt], b[nt], acc[mt][nt], 0, 0, 0);
    }
#else
    for (int mt = 0; mt < MT; ++mt) for (int nt = 0; nt < NTL; ++nt) for (int i = 0; i < 4; ++i) {
        const int row = mt * 16 + (lane >> 4) * 4 + i, col = nt * 16 + (lane & 15);
        float s = acc[mt][nt][i];
        for (int k = 0; k < ksteps * 32; ++k) s += (float)A[row * lda + k] * (float)B[col * ldb + k];
        acc[mt][nt][i] = s;
    }
#endif
}

__device__ __forceinline__ f32x4 mfma16(half8 a, half8 b, f32x4 c) {
#ifdef EMU
    return emu_mfma16(a, b, c);
#else
    return __builtin_amdgcn_mfma_f32_16x16x32_f16(a, b, c, 0, 0, 0);
#endif
}
template <int MT, int NTL> __device__ __forceinline__ void zero_acc(f32x4 (&acc)[MT][NTL]) {
#pragma unroll
    for (int mt = 0; mt < MT; ++mt)
#pragma unroll
        for (int nt = 0; nt < NTL; ++nt) acc[mt][nt] = (f32x4){0.f, 0.f, 0.f, 0.f};
}

__device__ __forceinline__ void load_taps4(const float* cw, const float* cb, int C, int ch, int dir, f32x4& w0, f32x4& w1, f32x4& w2, f32x4& wb) {
    w0 = *(const f32x4*)(cw + (dir ? 2 : 0) * C + ch); w1 = *(const f32x4*)(cw + C + ch); w2 = *(const f32x4*)(cw + (dir ? 0 : 2) * C + ch); wb = *(const f32x4*)(cb + ch);
}
#ifdef EMU
#define LOADER_FENCE()
#else
#define LOADER_FENCE() asm volatile("" ::: "memory")
#endif
#define CONV4(k, i) (w0[i] * (float)rr[k][hh * 4 + i] + w1[i] * (float)rr[(k) + 1][hh * 4 + i] + w2[i] * (float)rr[(k) + 2][hh * 4 + i] + wb[i])
__device__ __forceinline__ half4 to_half4(const f32x4 v) { half4 h; h[0] = (half_t)v[0]; h[1] = (half_t)v[1]; h[2] = (half_t)v[2]; h[3] = (half_t)v[3]; return h; }
namespace g8 {
constexpr int BM = 256, BK = 64, HALF = 128, HTB = HALF * BK * 2, STAGE_BYTES = 8 * HTB;
__device__ __forceinline__ int lds_byte(int r, int c) { const int st = (r >> 4) * 2 + (c >> 5), rr = r & 15, cc = c & 31, ob = rr * 64 + cc * 2; return st * 1024 + (ob ^ (((ob >> 9) & 1) << 5)); }
__device__ __forceinline__ void stage_rc(int b, int& R, int& C) { const int st = b / 1024, sb = b % 1024, swz = sb ^ (((sb >> 9) & 1) << 5); R = (st >> 1) * 16 + swz / 64; C = (st & 1) * 32 + (swz % 64) / 2; }
struct Unit { int pm, pn, e, n, c0; };

struct DenseSched {
    const char* abase; const char* bbase; int K, nM, nN, G, c;
    __device__ __forceinline__ bool next(int i, Unit& u) const {
        const int nwg = nM * nN; const long L = (long)i * G + c; if (L >= nwg) return false;
        int wgid = (int)L; { const int q = nwg / 8, r = nwg % 8, xcd = wgid % 8, off = wgid / 8; wgid = (xcd < r ? xcd * (q + 1) : r * (q + 1) + (xcd - r) * q) + off; }
        const int nig = 8 * nN, gid = wgid / nig, fm = gid * 8, gsz = (nM - fm) < 8 ? (nM - fm) : 8;
        u.pm = fm + ((wgid % nig) % gsz); u.pn = (wgid % nig) / gsz; u.e = 0; u.n = 0; u.c0 = 0; return true;
    }
    __device__ __forceinline__ unsigned a_off(const Unit& u, int r) const { return (unsigned)((size_t)(u.pm * 256 + r) * K * 2); }
    __device__ __forceinline__ const char* b_half(const Unit& u, int h) const { return bbase + (size_t)(u.pn * 256 + h * 128) * K * 2; }
};

template <class Epi, class Sched>
__device__ __forceinline__ void gemm_phase(unsigned char* smem, const int K, const Sched& S, const Epi& E) {
    const int tid = threadIdx.x, lane = tid & 63;
#ifdef EMU
    const int wid = tid >> 6, wr = wid >> 2, wc = wid & 3, fr = lane & 15, fq = lane >> 4;
    half_t* As = (half_t*)smem; half_t* Bs = As + 256 * 72;
    Unit cur;
    for (int ui = 0; S.next(ui, cur); ++ui) {
        f32x4 acc[2][2][4][2];
        for (int a = 0; a < 2; ++a) for (int b = 0; b < 2; ++b) for (int m = 0; m < 4; ++m) for (int n = 0; n < 2; ++n) acc[a][b][m][n] = (f32x4){0.f, 0.f, 0.f, 0.f};
        for (int kt = 0; kt < K / 64; ++kt) {
            { const int row = tid >> 1, c0 = (tid & 1) * 32;
              const half_t* sa = (const half_t*)(S.abase + S.a_off(cur, row)) + kt * 64 + c0;
              const half_t* sb = (const half_t*)(S.b_half(cur, row >> 7)) + (size_t)(row & 127) * K + kt * 64 + c0;
              for (int q = 0; q < 32; ++q) { As[row * 72 + c0 + q] = sa[q]; Bs[row * 72 + c0 + q] = sb[q]; } }
            __syncthreads();
            for (int a = 0; a < 2; ++a) for (int b = 0; b < 2; ++b) for (int m = 0; m < 4; ++m) for (int n = 0; n < 2; ++n) for (int i = 0; i < 4; ++i) {
                const int row = 128 * a + 64 * wr + 16 * m + fr, col = 128 * b + 32 * wc + 16 * n + 4 * fq + i; float s = acc[a][b][m][n][i];
                for (int k = 0; k < 64; ++k) s += (float)As[row * 72 + k] * (float)Bs[col * 72 + k];
                acc[a][b][m][n][i] = s; }
            __syncthreads();
        }
        E(acc, cur, wr, wc, fr, fq);
    }
#else
    typedef __attribute__((address_space(3))) unsigned char* ldsp_t;
    const ldsp_t lds = (ldsp_t)smem;
    const int wid = __builtin_amdgcn_readfirstlane(tid >> 6), wr = wid >> 2, wc = wid & 3, fr = lane & 15, fq = lane >> 4;
    const int nt = K / BK;
    int Rr[2], Cc[2]; unsigned voffB[2];
#pragma unroll
    for (int i = 0; i < 2; ++i) { stage_rc(tid * 16 + i * 8192, Rr[i], Cc[i]); voffB[i] = (unsigned)(Rr[i] * K + Cc[i]) * 2u; }
    const size_t kstep = (size_t)(BK * 2);
    const unsigned ldsw = (unsigned)wid * 1024u;
    const int aoffl = lds_byte(wr * 64 + fr, fq * 8), boffl = lds_byte(wc * 32 + fr, fq * 8);
#define G8_SA(b, h) (((b) * 2 + (h)) * HTB)
#define G8_SB(b, h) ((4 + (b) * 2 + (h)) * HTB)
#define G8_STAGE(bufoff, gbase, voff) do { _Pragma("unroll") for (int _i = 0; _i < 2; ++_i) \
        __builtin_amdgcn_global_load_lds((const unsigned*)((const char*)(gbase) + (voff)[_i]), (__attribute__((address_space(3))) unsigned*)(lds + (bufoff) + ldsw + _i * 8192), 16, 0, 0); } while (0)
#define G8_LDA(dst, b, h) do { _Pragma("unroll") for (int m = 0; m < 4; ++m) _Pragma("unroll") for (int k = 0; k < 2; ++k) dst[m][k] = *(const __attribute__((address_space(3))) half8*)(lds + G8_SA(b, h) + aoffl + m * 2048 + k * 1024); } while (0)
#define G8_LDB(dst, b, h) do { _Pragma("unroll") for (int n = 0; n < 2; ++n) _Pragma("unroll") for (int k = 0; k < 2; ++k) dst[n][k] = *(const __attribute__((address_space(3))) half8*)(lds + G8_SB(b, h) + boffl + n * 2048 + k * 1024); } while (0)
#define G8_MMA(ai, bj, At, Bt) do { __builtin_amdgcn_s_setprio(1); _Pragma("unroll") for (int m = 0; m < 4; ++m) _Pragma("unroll") for (int n = 0; n < 2; ++n) _Pragma("unroll") for (int k = 0; k < 2; ++k) \
        acc[ai][bj][m][n] = __builtin_amdgcn_mfma_f32_16x16x32_f16(Bt[n][k], At[m][k], acc[ai][bj][m][n], 0, 0, 0); __builtin_amdgcn_s_setprio(0); } while (0)
#define G8_WAIT_V(n) asm volatile("s_waitcnt vmcnt(" #n ")" ::: "memory")
#define G8_WAIT_L(n) asm volatile("s_waitcnt lgkmcnt(" #n ")" ::: "memory")
#define G8_BAR __builtin_amdgcn_s_barrier()
#define G8_SCHED __builtin_amdgcn_sched_barrier(0)
#define G8_AOFF(dst, u) do { _Pragma("unroll") for (int _h = 0; _h < 2; ++_h) _Pragma("unroll") for (int _i = 0; _i < 2; ++_i) dst[_h][_i] = S.a_off(u, _h * 128 + Rr[_i]) + (unsigned)Cc[_i] * 2u; } while (0)
    Unit cur, nxt; int ui = 0;
    if (!S.next(0, cur)) return;
    f32x4 acc[2][2][4][2];
#pragma unroll
    for (int a = 0; a < 2; ++a)
#pragma unroll
        for (int b = 0; b < 2; ++b)
#pragma unroll
            for (int m = 0; m < 4; ++m)
#pragma unroll
                for (int n = 0; n < 2; ++n) acc[a][b][m][n] = (f32x4){0.f, 0.f, 0.f, 0.f};
    half8 At[4][2], B0[2][2], B1[2][2];
    unsigned caoff[2][2], naoff[2][2];
    G8_AOFF(caoff, cur);
    const char* cA = S.abase; const char* cB0 = S.b_half(cur, 0); const char* cB1 = S.b_half(cur, 1);
    G8_STAGE(G8_SB(0, 0), cB0, voffB); G8_STAGE(G8_SA(0, 0), cA, caoff[0]); G8_STAGE(G8_SB(0, 1), cB1, voffB); G8_STAGE(G8_SA(0, 1), cA, caoff[1]);
    if (wr == 1) G8_BAR;
    G8_WAIT_V(4); G8_BAR;
    G8_STAGE(G8_SB(1, 0), cB0 + kstep, voffB); G8_STAGE(G8_SA(1, 0), cA + kstep, caoff[0]); G8_STAGE(G8_SB(1, 1), cB1 + kstep, voffB);
    G8_WAIT_V(6); G8_BAR;
    for (;;) {
        const bool has_next = S.next(ui + 1, nxt);
        if (!has_next) nxt = cur;
        G8_AOFF(naoff, nxt);
        const char* nB0 = S.b_half(nxt, 0); const char* nB1 = S.b_half(nxt, 1);
#pragma unroll 1
        for (int t = 0; t < nt; t += 2) {
            const bool last = (t == nt - 2);
            const char* a1 = cA + (size_t)(t + 1) * kstep;
            const char* a2 = last ? cA : cA + (size_t)(t + 2) * kstep;
            const char* b20 = last ? nB0 : cB0 + (size_t)(t + 2) * kstep; const char* b21 = last ? nB1 : cB1 + (size_t)(t + 2) * kstep;
            const char* a3 = a2 + kstep; const char* b30 = b20 + kstep; const char* b31 = b21 + kstep;
            unsigned xoff[2][2];
#pragma unroll
            for (int h = 0; h < 2; ++h)
#pragma unroll
                for (int i = 0; i < 2; ++i) xoff[h][i] = last ? naoff[h][i] : caoff[h][i];
            G8_LDB(B0, 0, 0); G8_SCHED; G8_LDA(At, 0, 0); G8_STAGE(G8_SA(1, 1), a1, caoff[1]);
            G8_WAIT_L(8); G8_BAR; G8_WAIT_L(0); G8_MMA(0, 0, At, B0); G8_BAR; G8_SCHED;
            G8_LDB(B1, 0, 1); G8_STAGE(G8_SB(0, 0), b20, voffB);
            G8_BAR; G8_WAIT_L(0); G8_MMA(0, 1, At, B1); G8_BAR;
            G8_LDA(At, 0, 1); G8_STAGE(G8_SA(0, 0), a2, xoff[0]);
            G8_BAR; G8_WAIT_L(0); G8_MMA(1, 0, At, B0); G8_BAR; G8_SCHED;
            G8_STAGE(G8_SB(0, 1), b21, voffB);
            G8_WAIT_V(6); G8_BAR; G8_MMA(1, 1, At, B1); G8_BAR;
            G8_LDB(B0, 1, 0); G8_SCHED; G8_LDA(At, 1, 0); G8_STAGE(G8_SA(0, 1), a2, xoff[1]);
            G8_WAIT_L(8); G8_BAR; G8_WAIT_L(0); G8_MMA(0, 0, At, B0); G8_BAR; G8_SCHED;
            G8_LDB(B1, 1, 1); G8_STAGE(G8_SB(1, 0), b30, voffB);
            G8_BAR; G8_WAIT_L(0); G8_MMA(0, 1, At, B1); G8_BAR;
            G8_LDA(At, 1, 1); G8_STAGE(G8_SA(1, 0), a3, xoff[0]);
            G8_BAR; G8_WAIT_L(0); G8_MMA(1, 0, At, B0); G8_BAR; G8_SCHED;
            G8_STAGE(G8_SB(1, 1), b31, voffB);
            G8_WAIT_V(6); G8_BAR; G8_MMA(1, 1, At, B1); G8_BAR;
        }
        E(acc, cur, wr, wc, fr, fq);
        if (!has_next) break;
#pragma unroll
        for (int a = 0; a < 2; ++a)
#pragma unroll
            for (int b = 0; b < 2; ++b)
#pragma unroll
                for (int m = 0; m < 4; ++m)
#pragma unroll
                    for (int n = 0; n < 2; ++n) acc[a][b][m][n] = (f32x4){0.f, 0.f, 0.f, 0.f};
        cur = nxt; cB0 = nB0; cB1 = nB1; ++ui;
#pragma unroll
        for (int h = 0; h < 2; ++h)
#pragma unroll
            for (int i = 0; i < 2; ++i) caoff[h][i] = naoff[h][i];
    }
    G8_WAIT_V(0);
    if (wr == 0) G8_BAR;
    G8_BAR;
#undef G8_SA
#undef G8_SB
#undef G8_STAGE
#undef G8_LDA
#undef G8_LDB
#undef G8_MMA
#undef G8_WAIT_V
#undef G8_WAIT_L
#undef G8_BAR
#undef G8_SCHED
#undef G8_AOFF
#endif
}
}

#ifdef EMU
typedef const Params* ParamsPtr;
#else
typedef const __attribute__((address_space(4))) Params* ParamsPtr;
#endif
struct Frame {
    ParamsPtr P; unsigned char* ws; unsigned char* smem; int tid, lane, wave;
    __device__ __forceinline__ const float* in(int i) const { return P->in[i]; }
    __device__ __forceinline__ float* xrow(int row) const { return row < TL ? P->out + (size_t)row * D : (float*)(ws + WS_XC) + (size_t)(row - TL) * D; }
    __device__ __forceinline__ const float* xrow_in(int layer, int row) const {
        if (layer == 0) return row < TL ? in(I_X) + (size_t)row * D : in(I_CTX) + (size_t)(row - TL) * D;
        return xrow(row);
    }
};
__device__ __forceinline__ int row_mod(int row) { return row < TL ? row / SEQ : NB; }
__device__ __forceinline__ const float* modp(const Frame& F, int layer, int m, int chunk) { return (const float*)(F.ws + WS_MOD) + ((size_t)(layer * 5 + m) * 6 + chunk) * D; }


#ifndef EMU
#define XB_TMO      128
#define XB_XCNT(j)  (256  + 64 * (j))
#define XB_XSUB(j)  (1280 + 64 * (j))
#define XB_XGEN(j)  (2304 + 64 * (j))
#define XB_TOP      3328
#define XB_TOPGEN   3392
#define XCD_BAR_WORDS 3456
#define XB_SPIN_CAP (1u << 26)
#define LAS __attribute__((address_space(3)))
static_assert((CW_BAR + XCD_BAR_WORDS) * 4 <= CTL_BYTES, "control region");
__device__ __forceinline__ unsigned xb_ld(unsigned* p)              { return __hip_atomic_load(p, __ATOMIC_RELAXED, __HIP_MEMORY_SCOPE_AGENT); }
__device__ __forceinline__ unsigned xb_add(unsigned* p, unsigned v) { return __hip_atomic_fetch_add(p, v, __ATOMIC_RELAXED, __HIP_MEMORY_SCOPE_AGENT); }
__device__ __forceinline__ unsigned xb_xcc_id() { return (unsigned)__builtin_amdgcn_s_getreg((3 << 11) | 20) & 0xFu; }
#define XB_SPIN(cond, bar) do { unsigned _sp = 0; while (cond) { __builtin_amdgcn_s_sleep(1); \
    if ((++_sp & 255u) == 0u) { if (xb_ld(&(bar)[XB_TMO])) break; if (_sp > XB_SPIN_CAP) { atomicAdd(&(bar)[XB_TMO], 1u); break; } } } } while (0)
struct XcdBarrier { unsigned* bar; unsigned x; volatile LAS unsigned* st; };
__device__ __forceinline__ XcdBarrier xcd_barrier_post(unsigned* bar, volatile LAS unsigned* st) {
    XcdBarrier b; b.bar = bar; b.x = xb_xcc_id(); b.st = st;
    if (threadIdx.x == 0) (void)xb_add(&bar[XB_XCNT(b.x)], 1u);
    return b;
}
__device__ __forceinline__ void xcd_barrier_complete(unsigned* bar, unsigned x, unsigned& nloc, unsigned& nx) {
    const unsigned G = gridDim.x * gridDim.y * gridDim.z;
    unsigned sum, cnt, mine, sp = 0u;
    for (;;) {
        sum = 0u; cnt = 0u; mine = 0u;
#pragma unroll
        for (unsigned j = 0; j < 16; ++j) { const unsigned c = xb_ld(&bar[XB_XCNT(j)]); sum += c; cnt += (c > 0u) ? 1u : 0u; mine = (j == x) ? c : mine; }
        if (sum == G) break;
        __builtin_amdgcn_s_sleep(1);
        if ((++sp & 255u) == 0u) { if (xb_ld(&bar[XB_TMO])) break; if (sp > XB_SPIN_CAP) { atomicAdd(&bar[XB_TMO], 1u); break; } }
    }
    nloc = mine > 0u ? mine : 1u; nx = cnt > 0u ? cnt : 1u;
}
__device__ __forceinline__ void xcd_barrier(const XcdBarrier& b) {
    asm volatile("s_waitcnt vmcnt(0)" ::: "memory");
    __syncthreads();
    if (threadIdx.x == 0) {
        unsigned* bar = b.bar;
        __builtin_amdgcn_s_waitcnt(0);
        unsigned nloc = b.st[0], nx = b.st[1];
        if (nloc == 0u) { xcd_barrier_complete(bar, b.x, nloc, nx); b.st[0] = nloc; b.st[1] = nx; }
        const unsigned old = xb_add(&bar[XB_XSUB(b.x)], 1u);
        const unsigned gen = old / nloc;
        if (old + 1u == (gen + 1u) * nloc) {
            __builtin_amdgcn_fence(__ATOMIC_RELEASE, "agent");
            asm volatile("s_waitcnt vmcnt(0)" ::: "memory");
            const unsigned og = xb_add(&bar[XB_TOP], 1u);
            const unsigned tg = og / nx;
            if (og + 1u == (tg + 1u) * nx) xb_add(&bar[XB_TOPGEN], 1u);
            else XB_SPIN(xb_ld(&bar[XB_TOPGEN]) == tg, bar);
            __builtin_amdgcn_fence(__ATOMIC_ACQUIRE, "agent");
            xb_add(&bar[XB_XGEN(b.x)], 1u);
            asm volatile("s_waitcnt vmcnt(0)" ::: "memory");
        } else {
            XB_SPIN(xb_ld(&bar[XB_XGEN(b.x)]) == gen, bar);
            __builtin_amdgcn_fence(__ATOMIC_ACQUIRE, "agent");
            asm volatile("s_waitcnt vmcnt(0)" ::: "memory");
        }
    }
    __syncthreads();
}
#endif

__device__ __forceinline__ void item_twiddle(const Frame& F, int it) {
    cplx* tw = (cplx*)(F.ws + WS_TW);
    const int k = it * NT + F.tid;
    if (k < TWN) { float s, c; const float a = -6.283185307179586f * (float)k / (float)TWN; s = sinf(a); c = cosf(a); tw[k].x = c; tw[k].y = s; }
}
__device__ __forceinline__ void item_mod(const Frame& F, int it) {
    const int layer = it / (NMOD / 64), n0 = (it % (NMOD / 64)) * 64;
    float* sc = (float*)F.smem;
    float* red = sc + 5 * D;
    for (int i = F.tid; i < 5 * D; i += NT) { const int m = i / D, k = i % D; const float v = m < NB ? F.in(I_C)[m * D + k] : F.in(I_CCTX)[k]; sc[i] = siluf(v); }
    __syncthreads();
    const int j = F.tid & 63, ks = F.tid >> 6;
    const float* w = F.in(I_WMOD) + (size_t)layer * D * NMOD + n0 + j;
    float a[5] = {0, 0, 0, 0, 0};
    for (int k = ks * 128; k < ks * 128 + 128; ++k) { const float wv = w[(size_t)k * NMOD];
#pragma unroll
        for (int m = 0; m < 5; ++m) a[m] += sc[m * D + k] * wv; }
#pragma unroll
    for (int m = 0; m < 5; ++m) red[(ks * 5 + m) * 64 + j] = a[m];
    __syncthreads();
    if (F.tid < 5 * 64) { const int m = F.tid / 64, jj = F.tid % 64; float s = 0; for (int q = 0; q < 8; ++q) s += red[(q * 5 + m) * 64 + jj];
        ((float*)(F.ws + WS_MOD))[(size_t)(layer * 5 + m) * NMOD + n0 + jj] = s + F.in(I_BMOD)[layer * NMOD + n0 + jj]; }
    __syncthreads();
}
__device__ __forceinline__ void item_filter(const Frame& F, int layer, int isctx, int tb) {
    const int L = isctx ? CTXL : SEQ;
    float* feats = (float*)F.smem;
    float* h1 = feats + 32 * 33;
    float* h2 = h1 + 32 * 64;
    const int t0 = tb * 32;
    for (int i = F.tid; i < 32 * 33; i += NT) {
        const int tt = i / 33, f = i % 33; const float t = (float)(t0 + tt);
        float v;
        if (f == 0) v = t / (float)(L - 1 > 1 ? L - 1 : 1);
        else { const int bi = (f - 1) & 15; const float band = 1e-4f + (float)bi * ((15.0f - 1e-4f) / 15.0f);
               const float ang = (6.283185307179586f / (float)L) * t * band; v = (f <= 16) ? cosf(ang) : -sinf(ang); }
        feats[i] = v;
    }
    __syncthreads();
    const float* w1 = F.in(I_HW1) + layer * 33 * 64; const float* b1 = F.in(I_HB1) + layer * 64;
    const float* w2 = F.in(I_HW2) + layer * 64 * 64; const float* b2 = F.in(I_HB2) + layer * 64;
    const float* fr = F.in(I_HFREQ) + layer * 64;
    for (int i = F.tid; i < 32 * 64; i += NT) { const int tt = i >> 6, j = i & 63; float s = b1[j]; for (int k = 0; k < 33; ++k) s += feats[tt * 33 + k] * w1[k * 64 + j]; h1[i] = sinf(fr[j] * s); }
    __syncthreads();
    for (int i = F.tid; i < 32 * 64; i += NT) { const int tt = i >> 6, j = i & 63; float s = b2[j]; for (int k = 0; k < 64; ++k) s += h1[tt * 64 + k] * w2[k * 64 + j]; h2[i] = sinf(fr[j] * s); }
    __syncthreads();
    const float* w3 = F.in(I_HW3) + (size_t)layer * 64 * 1024;
    const int c0 = F.tid * 2;
    float* ft = (float*)(F.ws + WS_FT) + (isctx ? (size_t)2 * 256 * 4 * SEQ : (size_t)layer * 256 * 4 * SEQ);
    for (int hf = 0; hf < 2; ++hf) {
        float acc[16][2];
        for (int tt = 0; tt < 16; ++tt) { acc[tt][0] = 0.f; acc[tt][1] = 0.f; }
        for (int k = 0; k < 64; ++k) { const float wa = w3[k * 1024 + c0], wb = w3[k * 1024 + c0 + 1];
#pragma unroll
            for (int tt = 0; tt < 16; ++tt) { const float hv = h2[(hf * 16 + tt) * 64 + k]; acc[tt][0] += hv * wa; acc[tt][1] += hv * wb; } }
#pragma unroll
        for (int q = 0; q < 2; ++q) {
            const int col = c0 + q, dir = col >> 9, order = (col >> 8) & 1, c = col & 255;
            const float dec = fabsf(F.in(I_HDEC)[((layer * 2 + dir) * 2 + order) * 256 + c]);
            float* dst = ft + ((size_t)(c * 2 + order) * 2 + dir) * L + t0 + hf * 16;
#pragma unroll
            for (int tt = 0; tt < 16; ++tt) { const float tu = (float)(t0 + hf * 16 + tt) / (float)(L - 1 > 1 ? L - 1 : 1); dst[tt] = acc[tt][q] * expf(-tu * dec); }
        }
    }
    __syncthreads();
}
__device__ __forceinline__ void item_transpose(const Frame& F, const float* src, int ldn, int nvalid, half_t* dst, int K, int k0, int n0) {
    float* tile = (float*)F.smem;
    f32x4 v[8];
#pragma unroll
    for (int q = 0; q < 8; ++q) { const int i = F.tid + q * NT, r = i >> 6, c4 = (i & 63) * 4;
        if (n0 + c4 + 3 < nvalid) v[q] = *(const f32x4*)(src + (size_t)(k0 + r) * ldn + n0 + c4);
        else {
#pragma unroll
            for (int e = 0; e < 4; ++e) v[q][e] = (n0 + c4 + e < nvalid) ? src[(size_t)(k0 + r) * ldn + n0 + c4 + e] : 0.f; } }
#pragma unroll
    for (int q = 0; q < 8; ++q) { const int i = F.tid + q * NT, r = i >> 6, c4 = (i & 63) * 4; *(f32x4*)(tile + r * 260 + c4) = v[q]; }
    __syncthreads();
#pragma unroll
    for (int q = 0; q < 4; ++q) { const int i = F.tid + q * NT, n = i >> 3, kc = (i & 7) * 8; half8 h;
#pragma unroll
        for (int e = 0; e < 8; ++e) h[e] = (half_t)tile[(kc + e) * 260 + n];
        *(half8*)(dst + (size_t)(n0 + n) * K + k0 + kc) = h; }
    __syncthreads();
}
__device__ __forceinline__ void item_router_w(const Frame& F, int layer) {
    half_t* dst = (half_t*)(F.ws + WS_WR) + (size_t)layer * 2 * 48 * D;
    for (int i = F.tid; i < 48 * D; i += NT) {
        const int col = i / D, k = i % D;
        float w = 0.f;
        if (col < 4) w = F.in(I_GRW)[((size_t)layer * D + k) * 4 + col]; else if (col < 36) w = F.in(I_ERW)[((size_t)layer * D + k) * 32 + (col - 4)];
        const half_t hi = (half_t)w; const half_t lo = (half_t)((w - (float)hi) * 2048.f);
        dst[i] = hi; dst[48 * D + i] = lo;
    }
}
constexpr int IT_TW = (TWN + NT - 1) / NT;
constexpr int IT_MOD = 2 * (NMOD / 64);
constexpr int IT_FILT = 2 * (SEQ / 32) + (CTXL / 32);
constexpr int IT_TWIN = 2 * 16 * (NINP / 256);
constexpr int IT_TWOUT = 2 * 16 * 4;
constexpr int IT_TMOE = 32 * 48;
__device__ __forceinline__ void moe_transpose_item(const Frame& F, int layer, int it) {
    const int e = it / 48, r = it % 48, which = r / 16, t = r % 16;
    half_t* base = (half_t*)(F.ws + WS_WMOE) + (size_t)e * 3 * 262144;
    if (which < 2) {
        const float* src = F.in(which == 0 ? I_MG : I_MU) + ((size_t)layer * 32 + e) * 262144;
        item_transpose(F, src, 256, 256, base + which * 262144, 1024, t * 64, 0);
    } else {
        const float* src = F.in(I_MD) + ((size_t)layer * 32 + e) * 262144;
        item_transpose(F, src, 1024, 1024, base + 2 * 262144, 256, (t >> 2) * 64, (t & 3) * 256);
    }
}
__device__ __forceinline__ void phase_setup(const Frame& F) {
    if (blockIdx.x == 0 && F.tid < 128) ((unsigned*)(F.ws + WS_CTL))[CW_CNT + F.tid] = 0u;
    const int total = IT_TW + IT_MOD + IT_FILT + IT_TWIN + IT_TWOUT + 2;
    for (int it = blockIdx.x; it < total; it += gridDim.x) {
        int i = it;
        if (i < 2) { item_router_w(F, i); continue; } i -= 2;
        if (i < IT_MOD) { item_mod(F, i); continue; } i -= IT_MOD;
        if (i < IT_FILT) { if (i < 2 * (SEQ / 32)) item_filter(F, i / (SEQ / 32), 0, i % (SEQ / 32)); else item_filter(F, 0, 1, i - 2 * (SEQ / 32)); continue; } i -= IT_FILT;
        if (i < IT_TW) { item_twiddle(F, i); continue; } i -= IT_TW;
        if (i < IT_TWIN) { const int layer = i / (16 * (NINP / 256)), r = i % (16 * (NINP / 256));
            item_transpose(F, F.in(I_WIN) + (size_t)layer * D * NIN, NIN, NIN, (half_t*)(F.ws + WS_WIN) + (size_t)layer * NINP * D, D, (r / (NINP / 256)) * 64, (r % (NINP / 256)) * 256); continue; } i -= IT_TWIN;
        if (i < IT_TWOUT) { const int layer = i / 64, r = i % 64;
            item_transpose(F, F.in(I_WOUT) + (size_t)layer * D * D, D, D, (half_t*)(F.ws + WS_WOUT) + (size_t)layer * D * D, D, (r >> 2) * 64, (r & 3) * 256); continue; }
    }
}

__device__ __forceinline__ void norm1_rows4(const Frame& F, int layer, int row0) {
    half_t* xn = (half_t*)(F.ws + WS_XN);
    const int m = row_mod(row0), lane = F.lane;
    f32x4 v[4][4];
#pragma unroll
    for (int r = 0; r < 4; ++r) { const float* x = F.xrow_in(layer, row0 + r);
#pragma unroll
        for (int q = 0; q < 4; ++q) v[r][q] = *(const f32x4*)(x + q * 256 + lane * 4); }
    const float* nw = F.in(I_N1W) + layer * D; const float* sh = modp(F, layer, m, 0); const float* scl = modp(F, layer, m, 1);
    f32x4 g[4], s4[4];
#pragma unroll
    for (int q = 0; q < 4; ++q) { const int k = q * 256 + lane * 4; const f32x4 a = *(const f32x4*)(nw + k), b = *(const f32x4*)(scl + k); s4[q] = *(const f32x4*)(sh + k);
#pragma unroll
        for (int e = 0; e < 4; ++e) g[q][e] = a[e] * (1.0f + b[e]); }
#pragma unroll
    for (int r = 0; r < 4; ++r) {
        float ss = 0.f;
#pragma unroll
        for (int q = 0; q < 4; ++q) ss += v[r][q][0] * v[r][q][0] + v[r][q][1] * v[r][q][1] + v[r][q][2] * v[r][q][2] + v[r][q][3] * v[r][q][3];
        ss = wave_sum(ss);
        const float rs = 1.0f / sqrtf(ss * (1.0f / D) + EPSF);
        const int row = row0 + r; int srow = row;
        if (layer == 1 && row < TL) { const int b = row / SEQ, l = row % SEQ; srow = b * SEQ + (l % GW) * GROWS + l / GW; }
#pragma unroll
        for (int q = 0; q < 4; ++q) { const int k = q * 256 + lane * 4; half4 h;
#pragma unroll
            for (int e = 0; e < 4; ++e) h[e] = (half_t)(v[r][q][e] * rs * g[q][e] + s4[q][e]);
            *(half4*)(xn + (size_t)srow * D + k) = h; }
    }
}
__device__ __forceinline__ void phase_norm1(const Frame& F, int layer) {
    for (int it = blockIdx.x; it < TT / 32; it += gridDim.x) norm1_rows4(F, layer, it * 32 + F.wave * 4);
}

struct EpiInproj {
    half_t* u16; float* ug; half_t* hyt;
    __device__ __forceinline__ void operator()(const f32x4 (&acc)[2][2][4][2], const g8::Unit& u, int wr, int wc, int fr, int fq) const {
#pragma unroll
        for (int ai = 0; ai < 2; ++ai)
#pragma unroll
            for (int m = 0; m < 4; ++m) {
                const int row = u.pm * 256 + ai * 128 + wr * 64 + m * 16 + fr;
#pragma unroll
                for (int bj = 0; bj < 2; ++bj)
#pragma unroll
                    for (int n = 0; n < 2; ++n) {
                        const int c0 = u.pn * 256 + bj * 128 + wc * 32 + n * 16 + 4 * fq; const f32x4 v = acc[ai][bj][m][n];
                        if (c0 < 1024) *(half4*)(u16 + (size_t)row * UW + c0) = to_half4(v);
                        else if (c0 < 1036) *(f32x4*)(ug + (size_t)row * UGW + (c0 - 1024)) = v;
                        else if (c0 < 1804) { const int ch = c0 - 1036;
                            half_t* dst = row < TL ? hyt + ((size_t)(row / SEQ) * 768 + ch) * SEQ + row % SEQ : hyt + (size_t)NB * 768 * SEQ + ((size_t)((row - TL) / CTXL) * 768 + ch) * CTXL + (row - TL) % CTXL;
                            const size_t st = row < TL ? SEQ : CTXL;
#pragma unroll
                            for (int i = 0; i < 4; ++i) dst[i * st] = (half_t)v[i]; }
                        else if (c0 < 3340) *(half4*)(u16 + (size_t)row * UW + (c0 - 1804 + 1024)) = to_half4(v);
                        else if (c0 < NIN) *(f32x4*)(ug + (size_t)row * UGW + 12 + (c0 - 3340)) = v;
                    }
            }
    }
};
__device__ __forceinline__ void phase_inproj(const Frame& F, int layer) {
    g8::DenseSched S; S.abase = (const char*)(F.ws + WS_XN); S.bbase = (const char*)((const half_t*)(F.ws + WS_WIN) + (size_t)layer * NINP * D); S.K = D; S.nM = TT / 256; S.nN = NINP / 256; S.G = gridDim.x; S.c = blockIdx.x;
    EpiInproj E{(half_t*)(F.ws + WS_U16), (float*)(F.ws + WS_UG), (half_t*)(F.ws + WS_HYT)};
    g8::gemm_phase(F.smem, D, S, E);
}


constexpr int SA = 72, SB = 136;

__device__ __forceinline__ void load_rows10(const half_t* u16, int rowbase, int Lseq, int dir, int jj0, int ucol, half8 (&rr)[10]) {
#pragma unroll
    for (int t = 0; t < 10; ++t) {
        const int jj = jj0 - 1 + t;
        half8 v;
        if (jj >= 0 && jj < Lseq) { const int pos = dir == 0 ? jj : Lseq - 1 - jj; v = *(const half8*)(u16 + (size_t)(rowbase + pos) * UW + ucol); }
        else {
#pragma unroll
            for (int i = 0; i < 8; ++i) v[i] = (half_t)0.f; }
        rr[t] = v;
    }
}
__device__ __forceinline__ void load_taps(const float* cw, const float* cb, int C, int ch, int dir, float (&w0)[8], float (&w1)[8], float (&w2)[8], float (&wb)[8]) {
#pragma unroll
    for (int q = 0; q < 2; ++q) {
        const f32x4 a = *(const f32x4*)(cw + (dir ? 2 : 0) * C + ch + q * 4), b = *(const f32x4*)(cw + C + ch + q * 4), c = *(const f32x4*)(cw + (dir ? 0 : 2) * C + ch + q * 4), d = *(const f32x4*)(cb + ch + q * 4);
#pragma unroll
        for (int i = 0; i < 4; ++i) { w0[q * 4 + i] = a[i]; w1[q * 4 + i] = b[i]; w2[q * 4 + i] = c[i]; wb[q * 4 + i] = d[i]; }
    }
}

__device__ __forceinline__ void ssd_block(const Frame& F, int layer, int b, int h, int dir) {
    half_t* Cs = (half_t*)F.smem;
    half_t* Bs = Cs + 128 * SA;
    half_t* BT = Bs + 128 * SA;
    half_t* XT = BT + 64 * SB;
    half_t* SC = XT + 64 * SB;
    half_t* ST = SC + 128 * SB;
    float* cum = (float*)(ST + 64 * SA);
    float* dtv = cum + 128;
    float* wes = dtv + 128;
    const half_t* u16 = (const half_t*)(F.ws + WS_U16); const float* ug = (const float*)(F.ws + WS_UG);
    half_t* yout = (half_t*)(F.ws + WS_YF) + (size_t)dir * TT * 384;
    const float* cw = F.in(I_SCW) + layer * 3 * 640; const float* cb = F.in(I_SCB) + layer * 640;
    const float dtb = F.in(I_DTB)[(layer * 2 + dir) * 6 + h];
    const float Aneg = -expf(F.in(I_ALOG)[(layer * 2 + dir) * 6 + h]);
    const float Dh = F.in(I_SD)[layer * 6 + h];
    const int g = h / 3, tid = F.tid, lane = F.lane, wave = F.wave;
    const int kind = tid >> 7, c8 = (tid & 7) * 8, j0 = ((tid >> 3) & 15) * 8;
    const int ch = kind == 0 ? h * 64 + c8 : (kind == 1 ? 384 + g * 64 + c8 : 512 + g * 64 + c8);
    f32x4 accS[1][2]; zero_acc(accS);
    for (int i = tid; i < 64 * SA; i += NT) ST[i] = (half_t)0.f;
    constexpr int NC0 = CTXL / 128, NCT = NC0 + SEQ / 128;
    half8 rr[10]; float ug0 = 0.f, ug1 = 0.f;
    if (kind < 3) load_rows10(u16, TL + b * CTXL, CTXL, dir, j0, 384 + ch, rr);
    if (wave == 7) { const int p0 = dir == 0 ? 2 * lane : CTXL - 1 - 2 * lane, p1 = dir == 0 ? p0 + 1 : p0 - 1;
        ug0 = ug[(size_t)(TL + b * CTXL + p0) * UGW + dir * 6 + h]; ug1 = ug[(size_t)(TL + b * CTXL + p1) * UGW + dir * 6 + h]; }
    __syncthreads();
    for (int cc = 0; cc < NCT; ++cc) {
        const int seg = cc >= NC0 ? 1 : 0, c = seg ? cc - NC0 : cc;
        const int Lseq = seg == 0 ? CTXL : SEQ, rowbase = seg == 0 ? TL + b * CTXL : b * SEQ;
        const bool want_y = (seg == 1) || (layer == 0);
        const int nseg = (cc + 1) >= NC0 ? 1 : 0, ncn = nseg ? cc + 1 - NC0 : cc + 1, nL = nseg == 0 ? CTXL : SEQ, nrb = nseg == 0 ? TL + b * CTXL : b * SEQ;
        if (wave == 7) {
            const float dt0 = softplusf_(ug0 + dtb), dt1 = softplusf_(ug1 + dtb);
            const float a0 = dt0 * Aneg, a1 = dt1 * Aneg;
            const float incl = wave_scan_sum(a0 + a1, lane);
            const float c1 = incl, c0 = incl - a1;
            const float cl = __shfl(incl, 63);
            cum[2 * lane] = c0; cum[2 * lane + 1] = c1; dtv[2 * lane] = dt0; dtv[2 * lane + 1] = dt1;
            wes[2 * lane] = dt0 * fexp(cl - c0); wes[2 * lane + 1] = dt1 * fexp(cl - c1);
            if (cc + 1 < NCT) { const int pi = ncn * 128 + 2 * lane, p0 = dir == 0 ? pi : nL - 1 - pi, p1 = dir == 0 ? p0 + 1 : p0 - 1;
                ug0 = ug[(size_t)(nrb + p0) * UGW + dir * 6 + h]; ug1 = ug[(size_t)(nrb + p1) * UGW + dir * 6 + h]; }
        }
        if (kind < 3) {
#pragma unroll
            for (int hh = 0; hh < 2; ++hh) {
                f32x4 w0, w1, w2, wb; load_taps4(cw, cb, 640, ch + hh * 4, dir, w0, w1, w2, wb);
                if (kind == 0) {
                    half8 xt[4];
#pragma unroll
                    for (int k = 0; k < 8; ++k)
#pragma unroll
                        for (int i = 0; i < 4; ++i) xt[i][k] = (half_t)fsilu(CONV4(k, i));
#pragma unroll
                    for (int i = 0; i < 4; ++i) *(half8*)(XT + (c8 + hh * 4 + i) * SB + j0) = xt[i];
                } else if (kind == 1) {
                    half8 bt[4];
#pragma unroll
                    for (int k = 0; k < 8; ++k) { half4 hb;
#pragma unroll
                        for (int i = 0; i < 4; ++i) { const half_t v = (half_t)fsilu(CONV4(k, i)); hb[i] = v; bt[i][k] = v; }
                        *(half4*)(Bs + (j0 + k) * SA + c8 + hh * 4) = hb; }
#pragma unroll
                    for (int i = 0; i < 4; ++i) *(half8*)(BT + (c8 + hh * 4 + i) * SB + j0) = bt[i];
                } else {
#pragma unroll
                    for (int k = 0; k < 8; ++k) { half4 hc;
#pragma unroll
                        for (int i = 0; i < 4; ++i) hc[i] = (half_t)fsilu(CONV4(k, i));
                        *(half4*)(Cs + (j0 + k) * SA + c8 + hh * 4) = hc; }
                }
                LOADER_FENCE();
            }
            if (cc + 1 < NCT) load_rows10(u16, nrb, nL, dir, ncn * 128 + j0, 384 + ch, rr);
        }
        __syncthreads();
        const float cl = cum[127];
        if (want_y) {
            { const int ws_ = wave & 1, wl = wave >> 1;
              if (!(ws_ == 1 && wl < 2)) {
                f32x4 g_[4][2]; zero_acc(g_);
                mma_lds<4, 2>(g_, Bs + ws_ * 64 * SA, SA, Cs + wl * 32 * SA, SA, 2, lane);
#pragma unroll
                for (int a = 0; a < 4; ++a) {
                    const int s0 = ws_ * 64 + a * 16 + (lane >> 4) * 4;
                    const f32x4 cs4 = *(const f32x4*)(cum + s0), dt4 = *(const f32x4*)(dtv + s0);
#pragma unroll
                    for (int q = 0; q < 2; ++q) {
                        const int l = wl * 32 + q * 16 + (lane & 15); const float cl_ = cum[l]; half4 hv;
#pragma unroll
                        for (int i = 0; i < 4; ++i) hv[i] = (half_t)((s0 + i) <= l ? g_[a][q][i] * fexp(cl_ - cs4[i]) * dt4[i] : 0.f);
                        *(half4*)(SC + l * SB + s0) = hv;
                    } }
              } }
            f32x4 y1[4][1]; zero_acc(y1);
            mma_lds<4, 1>(y1, ST, SA, Cs + wave * 16 * SA, SA, 2, lane);
            __syncthreads();
            f32x4 y2[4][1]; zero_acc(y2);
            mma_lds<4, 1>(y2, XT, SB, SC + wave * 16 * SB, SB, wave / 2 + 1, lane);
            { const int l = wave * 16 + (lane & 15); const float el = fexp(cum[l]);
              const int pi = c * 128 + l, pos = dir == 0 ? pi : Lseq - 1 - pi;
#pragma unroll
              for (int a = 0; a < 4; ++a) { const int p0 = a * 16 + (lane >> 4) * 4; f32x4 y;
#pragma unroll
                  for (int i = 0; i < 4; ++i) y[i] = y1[a][0][i] * el + y2[a][0][i];
                  if (dir == 0) {
#pragma unroll
                      for (int i = 0; i < 4; ++i) y[i] += Dh * (float)XT[(p0 + i) * SB + l]; }
                  *(half4*)(yout + (size_t)(rowbase + pos) * 384 + h * 64 + p0) = to_half4(y); } }
        }
        { const float dec = fexp(cl);
#pragma unroll
          for (int q = 0; q < 2; ++q) accS[0][q] *= dec;
          const int r = lane & 15, kq = (lane >> 4) * 8;
#pragma unroll
          for (int ks = 0; ks < 4; ++ks) {
              const half8 a = *(const half8*)(BT + ((wave >> 1) * 16 + r) * SB + ks * 32 + kq);
              const f32x4 e0 = *(const f32x4*)(wes + ks * 32 + kq), e1 = *(const f32x4*)(wes + ks * 32 + kq + 4);
#pragma unroll
              for (int q = 0; q < 2; ++q) { half8 bb = *(const half8*)(XT + ((wave & 1) * 32 + q * 16 + r) * SB + ks * 32 + kq);
#pragma unroll
                  for (int i = 0; i < 4; ++i) { bb[i] = (half_t)((float)bb[i] * e0[i]); bb[4 + i] = (half_t)((float)bb[4 + i] * e1[i]); }
                  accS[0][q] = mfma16(a, bb, accS[0][q]); } } }
        __syncthreads();
#pragma unroll
        for (int q = 0; q < 2; ++q) { const int p = (wave & 1) * 32 + q * 16 + (lane & 15), n0 = (wave >> 1) * 16 + (lane >> 4) * 4; *(half4*)(ST + p * SA + n0) = to_half4(accS[0][q]); }
    }
    __syncthreads();
}

__device__ __forceinline__ void mlstm_block(const Frame& F, int layer, int b, int h, int dir) {
    half_t* Qs = (half_t*)F.smem;
    half_t* Ks = Qs + 128 * SA;
    half_t* KT = Ks + 128 * SA;
    half_t* VT = KT + 64 * SB;
    half_t* SC = VT + 64 * SB;
    half_t* CS = SC + 128 * SB;
    float* ig = (float*)(CS + 64 * SA);
    float* cumf = ig + 128; float* gsv = cumf + 128; float* mtv = gsv + 128; float* ee = mtv + 128; float* dn = ee + 128;
    float* nvec = dn + 128;
    float* scal = nvec + 64;
    const half_t* u16 = (const half_t*)(F.ws + WS_U16); const float* ug = (const float*)(F.ws + WS_UG);
    half_t* hout = (half_t*)(F.ws + WS_YF) + (size_t)(2 + dir) * TT * 384;
    const float* cw = F.in(I_MCW) + layer * 3 * 768; const float* cb = F.in(I_MCB) + layer * 768;
    const float bi = F.in(I_MGB)[((layer * 2 + dir) * 2 + 0) * 6 + h], bf = F.in(I_MGB)[((layer * 2 + dir) * 2 + 1) * 6 + h];
    const int tid = F.tid, lane = F.lane, wave = F.wave;
    const int kind = tid >> 7, c8 = (tid & 7) * 8, j0 = ((tid >> 3) & 15) * 8;
    const int ch = kind == 0 ? h * 64 + c8 : 384 + h * 64 + c8;
    f32x4 accC[1][2]; zero_acc(accC);
    float m_in = 0.f;
    for (int i = tid; i < 64 * SA; i += NT) CS[i] = (half_t)0.f;
    if (tid < 64) nvec[tid] = 0.f;
    constexpr int NC0 = CTXL / 128, NCT = NC0 + SEQ / 128;
    half8 rr[10]; float gi0 = 0.f, gi1 = 0.f, gf0 = 0.f, gf1 = 0.f;
    const int ucol = kind == 2 ? 1792 + h * 64 + c8 : 1024 + ch;
    if (kind < 3) load_rows10(u16, TL + b * CTXL, CTXL, dir, j0, ucol, rr);
    if (wave == 7) { const int p0 = dir == 0 ? 2 * lane : CTXL - 1 - 2 * lane, p1 = dir == 0 ? p0 + 1 : p0 - 1;
        const float* g0 = ug + (size_t)(TL + b * CTXL + p0) * UGW + 12 + dir * 12; const float* g1 = ug + (size_t)(TL + b * CTXL + p1) * UGW + 12 + dir * 12;
        gi0 = g0[h]; gf0 = g0[6 + h]; gi1 = g1[h]; gf1 = g1[6 + h]; }
    half8 ones;
#pragma unroll
    for (int i = 0; i < 8; ++i) ones[i] = (half_t)1.0f;
    __syncthreads();
    for (int cc = 0; cc < NCT; ++cc) {
        const int seg = cc >= NC0 ? 1 : 0, c = seg ? cc - NC0 : cc;
        const int Lseq = seg == 0 ? CTXL : SEQ, rowbase = seg == 0 ? TL + b * CTXL : b * SEQ;
        const bool want_y = (seg == 1) || (layer == 0);
        const int nseg = (cc + 1) >= NC0 ? 1 : 0, ncn = nseg ? cc + 1 - NC0 : cc + 1, nL = nseg == 0 ? CTXL : SEQ, nrb = nseg == 0 ? TL + b * CTXL : b * SEQ;
        if (wave == 7) {
            const float i0 = gi0 + bi, i1 = gi1 + bi, lf0 = logsigmoidf_(gf0 + bf), lf1 = logsigmoidf_(gf1 + bf);
            const float incl = wave_scan_sum(lf0 + lf1, lane);
            const float c1 = incl, c0 = incl - lf1;
            const float tot = __shfl(incl, 63);
            const float r0 = i0 - c0, r1 = i1 - c1;
            const float pincl = wave_scan_max(fmaxf(r0, r1), lane);
            float pexcl = __shfl_up(pincl, 1); if (lane == 0) pexcl = -3.0e38f;
            const float pm0 = fmaxf(pexcl, r0), pm1 = pincl;
            const float pmlast = __shfl(pincl, 63);
            const float m_new = fmaxf(tot + m_in, tot + pmlast);
            ig[2 * lane] = i0; ig[2 * lane + 1] = i1; cumf[2 * lane] = c0; cumf[2 * lane + 1] = c1; gsv[2 * lane] = r0; gsv[2 * lane + 1] = r1;
            mtv[2 * lane] = fmaxf(c0 + m_in, c0 + pm0); mtv[2 * lane + 1] = fmaxf(c1 + m_in, c1 + pm1);
            ee[2 * lane] = fexp(r0 + tot - m_new); ee[2 * lane + 1] = fexp(r1 + tot - m_new);
            if (lane == 0) { scal[0] = tot; scal[1] = m_new; }
            if (cc + 1 < NCT) { const int pi = ncn * 128 + 2 * lane, p0 = dir == 0 ? pi : nL - 1 - pi, p1 = dir == 0 ? p0 + 1 : p0 - 1;
                const float* g0 = ug + (size_t)(nrb + p0) * UGW + 12 + dir * 12; const float* g1 = ug + (size_t)(nrb + p1) * UGW + 12 + dir * 12;
                gi0 = g0[h]; gf0 = g0[6 + h]; gi1 = g1[h]; gf1 = g1[6 + h]; }
        }
        if (kind < 2) {
#pragma unroll
            for (int hh = 0; hh < 2; ++hh) {
                f32x4 w0, w1, w2, wb; load_taps4(cw, cb, 768, ch + hh * 4, dir, w0, w1, w2, wb);
                if (kind == 0) {
#pragma unroll
                    for (int k = 0; k < 8; ++k) { half4 hq;
#pragma unroll
                        for (int i = 0; i < 4; ++i) hq[i] = (half_t)fsilu(CONV4(k, i));
                        *(half4*)(Qs + (j0 + k) * SA + c8 + hh * 4) = hq; }
                } else {
                    half8 kt[4];
#pragma unroll
                    for (int k = 0; k < 8; ++k) { half4 hk;
#pragma unroll
                        for (int i = 0; i < 4; ++i) { const half_t v = (half_t)(0.125f * fsilu(CONV4(k, i))); hk[i] = v; kt[i][k] = v; }
                        *(half4*)(Ks + (j0 + k) * SA + c8 + hh * 4) = hk; }
#pragma unroll
                    for (int i = 0; i < 4; ++i) *(half8*)(KT + (c8 + hh * 4 + i) * SB + j0) = kt[i];
                }
                LOADER_FENCE();
            }
        } else if (kind == 2) {
            half8 vt[8];
#pragma unroll
            for (int k = 0; k < 8; ++k) { const half8 hv = rr[k + 1];
#pragma unroll
                for (int i = 0; i < 8; ++i) vt[i][k] = hv[i]; }
#pragma unroll
            for (int i = 0; i < 8; ++i) *(half8*)(VT + (c8 + i) * SB + j0) = vt[i];
        }
        if (kind < 3 && cc + 1 < NCT) load_rows10(u16, nrb, nL, dir, ncn * 128 + j0, ucol, rr);
        __syncthreads();
        const float tot = scal[0], m_new = scal[1];
        if (want_y) {
            { const int ws_ = wave & 1, wl = wave >> 1;
              if (!(ws_ == 1 && wl < 2)) {
                f32x4 g_[4][2]; zero_acc(g_);
                mma_lds<4, 2>(g_, Ks + ws_ * 64 * SA, SA, Qs + wl * 32 * SA, SA, 2, lane);
#pragma unroll
                for (int a = 0; a < 4; ++a) {
                    const int s0 = ws_ * 64 + a * 16 + (lane >> 4) * 4; const f32x4 gs4 = *(const f32x4*)(gsv + s0);
#pragma unroll
                    for (int q = 0; q < 2; ++q) {
                        const int l = wl * 32 + q * 16 + (lane & 15); const float cm = cumf[l] - mtv[l]; half4 hv;
#pragma unroll
                        for (int i = 0; i < 4; ++i) hv[i] = (half_t)((s0 + i) <= l ? g_[a][q][i] * fexp(cm + gs4[i]) : 0.f);
                        *(half4*)(SC + l * SB + s0) = hv;
                    } }
              } }
            f32x4 h1[4][1]; zero_acc(h1);
            mma_lds<4, 1>(h1, CS, SA, Qs + wave * 16 * SA, SA, 2, lane);
            if (tid < 128) { float s = 0.f;
#pragma unroll
                for (int d8 = 0; d8 < 8; ++d8) { const half8 qv = *(const half8*)(Qs + tid * SA + d8 * 8); const f32x4 n0 = *(const f32x4*)(nvec + d8 * 8), n1 = *(const f32x4*)(nvec + d8 * 8 + 4);
#pragma unroll
                    for (int i = 0; i < 4; ++i) s += (float)qv[i] * n0[i] + (float)qv[4 + i] * n1[i]; }
                dn[tid] = s * fexp(cumf[tid] + m_in - mtv[tid]); }
            __syncthreads();
            f32x4 h2[4]; f32x4 d1 = {0.f, 0.f, 0.f, 0.f};
#pragma unroll
            for (int a = 0; a < 4; ++a) h2[a] = (f32x4){0.f, 0.f, 0.f, 0.f};
            { const int r = lane & 15, kq = (lane >> 4) * 8;
              for (int ks = 0; ks < wave / 2 + 1; ++ks) {
                  const half8 bfr = *(const half8*)(SC + (wave * 16 + r) * SB + ks * 32 + kq);
#pragma unroll
                  for (int a = 0; a < 4; ++a) { const half8 afr = *(const half8*)(VT + (a * 16 + r) * SB + ks * 32 + kq); h2[a] = mfma16(afr, bfr, h2[a]); }
                  d1 = mfma16(ones, bfr, d1); } }
            { const int l = wave * 16 + (lane & 15); const float ai = fexp(cumf[l] + m_in - mtv[l]); const float rden = 1.0f / fmaxf(fabsf(dn[l] + d1[0]), fexp(-mtv[l]));
              const int pi = c * 128 + l, pos = dir == 0 ? pi : Lseq - 1 - pi;
#pragma unroll
              for (int a = 0; a < 4; ++a) { const int v0 = a * 16 + (lane >> 4) * 4; f32x4 y;
#pragma unroll
                  for (int i = 0; i < 4; ++i) y[i] = (h1[a][0][i] * ai + h2[a][i]) * rden;
                  *(half4*)(hout + (size_t)(rowbase + pos) * 384 + h * 64 + v0) = to_half4(y); } }
        }
        { const float sc = fexp(tot + m_in - m_new);
#pragma unroll
          for (int q = 0; q < 2; ++q) accC[0][q] *= sc;
          { const int r = lane & 15, kq = (lane >> 4) * 8;
#pragma unroll
            for (int ks = 0; ks < 4; ++ks) {
              const half8 a = *(const half8*)(KT + ((wave >> 1) * 16 + r) * SB + ks * 32 + kq);
              const f32x4 e0 = *(const f32x4*)(ee + ks * 32 + kq), e1 = *(const f32x4*)(ee + ks * 32 + kq + 4);
#pragma unroll
              for (int q = 0; q < 2; ++q) { half8 bb = *(const half8*)(VT + ((wave & 1) * 32 + q * 16 + r) * SB + ks * 32 + kq);
#pragma unroll
                  for (int i = 0; i < 4; ++i) { bb[i] = (half_t)((float)bb[i] * e0[i]); bb[4 + i] = (half_t)((float)bb[4 + i] * e1[i]); }
                  accC[0][q] = mfma16(a, bb, accC[0][q]); } } }
          if (tid < 64) { float s = 0.f;
#pragma unroll 4
              for (int k8 = 0; k8 < 16; ++k8) { const half8 kv = *(const half8*)(KT + tid * SB + k8 * 8); const f32x4 e0 = *(const f32x4*)(ee + k8 * 8), e1 = *(const f32x4*)(ee + k8 * 8 + 4);
#pragma unroll
                  for (int i = 0; i < 4; ++i) s += e0[i] * (float)kv[i] + e1[i] * (float)kv[4 + i]; }
              nvec[tid] = sc * nvec[tid] + s; } }
        m_in = m_new;
        __syncthreads();
#pragma unroll
        for (int q = 0; q < 2; ++q) { const int v = (wave & 1) * 32 + q * 16 + (lane & 15), d0 = (wave >> 1) * 16 + (lane >> 4) * 4; *(half4*)(CS + v * SA + d0) = to_half4(accC[0][q]); }
    }
    __syncthreads();
}

__device__ __forceinline__ cplx cmul(cplx a, cplx b) { return cplx{a.x * b.x - a.y * b.y, a.x * b.y + a.y * b.x}; }
__device__ __forceinline__ cplx cadd(cplx a, cplx b) { return cplx{a.x + b.x, a.y + b.y}; }
__device__ __forceinline__ cplx csub(cplx a, cplx b) { return cplx{a.x - b.x, a.y - b.y}; }
__device__ __forceinline__ void sincos_turns(float x, float& s, float& c) {
#ifdef EMU
    s = sinf(6.283185307179586f * x); c = cosf(6.283185307179586f * x);
#else
    s = __builtin_amdgcn_sinf(x); c = __builtin_amdgcn_cosf(x);
#endif
}
#define PADI(i) ((i) + ((i) >> 5))
template <bool INV> __device__ __forceinline__ void r4(cplx& a0, cplx& a1, cplx& a2, cplx& a3) {
    const cplx t0 = cadd(a0, a2), t1 = csub(a0, a2), t2 = cadd(a1, a3), t3 = csub(a1, a3);
    a0 = cadd(t0, t2); a2 = csub(t0, t2);
    if (!INV) { a1 = cplx{t1.x + t3.y, t1.y - t3.x}; a3 = cplx{t1.x - t3.y, t1.y + t3.x}; }
    else      { a1 = cplx{t1.x - t3.y, t1.y + t3.x}; a3 = cplx{t1.x + t3.y, t1.y - t3.x}; }
}
template <bool INV> __device__ __forceinline__ void fft16(cplx (&v)[16]) {
#pragma unroll
    for (int l0 = 0; l0 < 4; ++l0) r4<INV>(v[l0], v[l0 + 4], v[l0 + 8], v[l0 + 12]);
    const float C1 = 0.9238795325112867f, S1 = 0.3826834323650898f, C2 = 0.7071067811865476f;
    const float sg = INV ? 1.f : -1.f;
#define TWM(idx, cr, ci) v[idx] = cmul(v[idx], cplx{(cr), sg * (ci)})
    TWM(1 + 4 * 1, C1, S1); TWM(2 + 4 * 1, C2, C2); TWM(3 + 4 * 1, S1, C1);
    TWM(1 + 4 * 2, C2, C2); TWM(2 + 4 * 2, 0.f, 1.f); TWM(3 + 4 * 2, -C2, C2);
    TWM(1 + 4 * 3, S1, C1); TWM(2 + 4 * 3, -C2, C2); TWM(3 + 4 * 3, -C1, -S1);
#undef TWM
    cplx o[16];
#pragma unroll
    for (int m0 = 0; m0 < 4; ++m0) { cplx a0 = v[4 * m0], a1 = v[4 * m0 + 1], a2 = v[4 * m0 + 2], a3 = v[4 * m0 + 3]; r4<INV>(a0, a1, a2, a3);
        o[m0] = a0; o[m0 + 4] = a1; o[m0 + 8] = a2; o[m0 + 12] = a3; }
#pragma unroll
    for (int i = 0; i < 16; ++i) v[i] = o[i];
}
__device__ __forceinline__ void twpow(cplx w1, cplx (&w)[16]) {
    w[1] = w1; w[2] = cmul(w1, w1); w[3] = cmul(w[2], w1); w[4] = cmul(w[2], w[2]); w[5] = cmul(w[4], w1); w[6] = cmul(w[4], w[2]); w[7] = cmul(w[4], w[3]); w[8] = cmul(w[4], w[4]);
#pragma unroll
    for (int m = 9; m < 16; ++m) w[m] = cmul(w[8], w[m - 8]);
}
__device__ __forceinline__ void fft_fwd16(cplx* buf, int N, int tid) {
    for (int n = N; n >= 32; n >>= 4) { const int q = n >> 4;
        for (int i = tid; i < N / 16; i += NT) {
            const int blk = i / q, j = i - blk * q, base = blk * n + j;
            cplx v[16];
#pragma unroll
            for (int l = 0; l < 16; ++l) v[l] = buf[PADI(base + l * q)];
            fft16<false>(v);
            float s, c; sincos_turns(-(float)j / (float)n, s, c);
            cplx w[16]; twpow(cplx{c, s}, w);
            buf[PADI(base)] = v[0];
#pragma unroll
            for (int m = 1; m < 16; ++m) buf[PADI(base + m * q)] = cmul(v[m], w[m]);
        }
        __syncthreads(); }
}
__device__ __forceinline__ void fft_inv16(cplx* buf, int N, int tid) {
    for (int n = 32; n <= N; n <<= 4) { const int q = n >> 4;
        for (int i = tid; i < N / 16; i += NT) {
            const int blk = i / q, j = i - blk * q, base = blk * n + j;
            float s, c; sincos_turns((float)j / (float)n, s, c);
            cplx w[16]; twpow(cplx{c, s}, w);
            cplx v[16];
            v[0] = buf[PADI(base)];
#pragma unroll
            for (int m = 1; m < 16; ++m) v[m] = cmul(buf[PADI(base + m * q)], w[m]);
            fft16<true>(v);
#pragma unroll
            for (int l = 0; l < 16; ++l) buf[PADI(base + l * q)] = v[l];
        }
        __syncthreads(); }
}
static_assert(2 * SEQ == 512 || 2 * SEQ == 8192 || 2 * SEQ == 131072, "FFT size must be 2*16^k");
static_assert(2 * CTXL == 512 || 2 * CTXL == 8192, "FFT size must be 2*16^k");
constexpr int HBUF = (2 * SEQ + (2 * SEQ) / 32 + 8);
__device__ __forceinline__ void hy_conv8(const half_t* p, int t0, int L, float w0, float w1, float w2, float bsv, float (&o)[8]) {
    const half8 m = *(const half8*)(p + t0);
    float e[10]; e[0] = t0 > 0 ? (float)p[t0 - 1] : 0.f; e[9] = t0 + 8 < L ? (float)p[t0 + 8] : 0.f;
#pragma unroll
    for (int i = 0; i < 8; ++i) e[i + 1] = (float)m[i];
#pragma unroll
    for (int i = 0; i < 8; ++i) o[i] = w0 * e[i] + w1 * e[i + 1] + w2 * e[i + 2] + bsv;
}
__device__ __forceinline__ void hyena_channel(const Frame& F, int layer, int c) {
    cplx* bufA = (cplx*)F.smem;
    cplx* bufH = bufA + HBUF;
    float* red = (float*)(bufH + HBUF);
    const int tid = F.tid;
    const float* cwp = F.in(I_HCW) + layer * 3 * 768; const float* cbp = F.in(I_HCB) + layer * 768;
    for (int seg = 0; seg < (layer == 0 ? 2 : 1); ++seg) {
        const int L = seg == 0 ? SEQ : CTXL, N = 2 * L;
        const half_t* hyt = (const half_t*)(F.ws + WS_HYT) + (seg == 0 ? 0 : (size_t)NB * 768 * SEQ);
        float* z1 = (float*)(F.ws + WS_XN) + (seg == 0 ? 0 : (size_t)NB * 256 * SEQ);
        float* yht = (float*)(F.ws + WS_YHT) + (seg == 0 ? 0 : (size_t)NB * 256 * SEQ);
        const float* ft = (const float*)(F.ws + WS_FT) + (seg == 0 ? (size_t)layer * 256 * 4 * SEQ : (size_t)2 * 256 * 4 * SEQ);
        for (int order = 0; order < 2; ++order) {
            const float* hfw = ft + ((size_t)(c * 2 + order) * 2 + 0) * L; const float* hbw = ft + ((size_t)(c * 2 + order) * 2 + 1) * L;
            float asum = 0.f;
            for (int i = tid; i < N; i += NT) { const float v = i < L ? hfw[i] : (i == L ? 0.f : hbw[N - i]); bufH[PADI(i)] = cplx{v, 0.f}; asum += fabsf(v); }
            asum = wave_sum(asum);
            if (F.lane == 0) red[F.wave] = asum;
            __syncthreads();
            float tot = 0.f; for (int w = 0; w < NT / 64; ++w) tot += red[w];
            const float scale = 1.0f / (tot * (float)N);
            fft_fwd16(bufH, N, tid);
            for (int i = tid; i < N / 2; i += NT) { const cplx a = bufH[PADI(2 * i)], b_ = bufH[PADI(2 * i + 1)]; const cplx s = cadd(a, b_), d = csub(a, b_);
                bufH[PADI(2 * i)] = cplx{s.x * scale, s.y * scale}; bufH[PADI(2 * i + 1)] = cplx{d.x * scale, d.y * scale}; }
            __syncthreads();
            const int gch = 256 * (order + 1) + c;
            const float gw0 = cwp[gch], gw1 = cwp[768 + gch], gw2 = cwp[1536 + gch], gb = cbp[gch];
            const float vw0 = cwp[c], vw1 = cwp[768 + c], vw2 = cwp[1536 + c], vb = cbp[c];
            const float skip = F.in(I_HSKIP)[(layer * 2 + order) * 256 + c];
            for (int pr = 0; pr < NB / 2; ++pr) {
                const int b0 = 2 * pr, b1 = b0 + 1;
                const half_t* v0p = hyt + ((size_t)b0 * 768 + c) * L; const half_t* v1p = hyt + ((size_t)b1 * 768 + c) * L;
                const float* z0q = z1 + ((size_t)b0 * 256 + c) * L; const float* z1q = z1 + ((size_t)b1 * 256 + c) * L;
                for (int t0 = tid * 8; t0 < N; t0 += NT * 8) {
                    if (t0 < L) { float za[8], zb[8];
                        if (order == 0) { hy_conv8(v0p, t0, L, vw0, vw1, vw2, vb, za); hy_conv8(v1p, t0, L, vw0, vw1, vw2, vb, zb); }
                        else {
#pragma unroll
                            for (int i = 0; i < 8; ++i) { za[i] = z0q[t0 + i]; zb[i] = z1q[t0 + i]; } }
#pragma unroll
                        for (int i = 0; i < 8; ++i) bufA[PADI(t0 + i)] = cplx{za[i], zb[i]}; }
                    else {
#pragma unroll
                        for (int i = 0; i < 8; ++i) bufA[PADI(t0 + i)] = cplx{0.f, 0.f}; }
                }
                __syncthreads();
                fft_fwd16(bufA, N, tid);
                for (int i = tid; i < N / 2; i += NT) { const cplx a = bufA[PADI(2 * i)], b_ = bufA[PADI(2 * i + 1)];
                    const cplx s = cmul(cadd(a, b_), bufH[PADI(2 * i)]), d = cmul(csub(a, b_), bufH[PADI(2 * i + 1)]);
                    bufA[PADI(2 * i)] = cadd(s, d); bufA[PADI(2 * i + 1)] = csub(s, d); }
                __syncthreads();
                fft_inv16(bufA, N, tid);
                const half_t* g0p = hyt + ((size_t)b0 * 768 + gch) * L; const half_t* g1p = hyt + ((size_t)b1 * 768 + gch) * L;
                float* d0 = (order == 0 ? z1 : yht) + ((size_t)b0 * 256 + c) * L; float* d1 = (order == 0 ? z1 : yht) + ((size_t)b1 * 256 + c) * L;
                for (int t0 = tid * 8; t0 < L; t0 += NT * 8) {
                    float za[8], zb[8], ga[8], gb_[8];
                    if (order == 0) { hy_conv8(v0p, t0, L, vw0, vw1, vw2, vb, za); hy_conv8(v1p, t0, L, vw0, vw1, vw2, vb, zb); }
                    else {
#pragma unroll
                        for (int i = 0; i < 8; ++i) { za[i] = z0q[t0 + i]; zb[i] = z1q[t0 + i]; } }
                    hy_conv8(g0p, t0, L, gw0, gw1, gw2, gb, ga); hy_conv8(g1p, t0, L, gw0, gw1, gw2, gb, gb_);
                    f32x4 oa[2], ob[2];
#pragma unroll
                    for (int i = 0; i < 8; ++i) { const cplx y = bufA[PADI(t0 + i)]; oa[i >> 2][i & 3] = ga[i] * (y.x + skip * za[i]); ob[i >> 2][i & 3] = gb_[i] * (y.y + skip * zb[i]); }
                    *(f32x4*)(d0 + t0) = oa[0]; *(f32x4*)(d0 + t0 + 4) = oa[1]; *(f32x4*)(d1 + t0) = ob[0]; *(f32x4*)(d1 + t0 + 4) = ob[1];
                }
                __syncthreads();
            }
        }
    }
}
__device__ __forceinline__ void phase_mixers(const Frame& F, int layer) {
    const int G = gridDim.x, bid = blockIdx.x;
    constexpr int NSCAN = 2 * NB * 6 * 2;
    if (bid < NSCAN) {
        const int k = bid >> 1, kind = bid & 1, dir = k % 2, h = (k / 2) % 6, b = k / 12;
#ifndef MIXMASK
#define MIXMASK 7
#endif
        if (kind == 0) { if (MIXMASK & 1) ssd_block(F, layer, b, h, dir); } else { if (MIXMASK & 2) mlstm_block(F, layer, b, h, dir); }
    } else {
        for (int c = bid - NSCAN; c < 256; c += G - NSCAN) if (MIXMASK & 4) hyena_channel(F, layer, c);
        for (int it = bid - NSCAN; it < IT_TMOE; it += G - NSCAN) moe_transpose_item(F, layer, it);
    }
}

__device__ __forceinline__ void phase_combine(const Frame& F, int layer) {
    const int nrows = layer == 0 ? TT : TL, total = nrows / 32;
    const half_t* u16 = (const half_t*)(F.ws + WS_U16);
    const half_t* yf = (const half_t*)(F.ws + WS_YF); const half_t* yb = yf + (size_t)TT * 384; const half_t* hf = yb + (size_t)TT * 384; const half_t* hb = hf + (size_t)TT * 384;
    half_t* yl = (half_t*)(F.ws + WS_XN);
    const float* snw = F.in(I_SNW) + layer * 384; const float* mnw = F.in(I_MNW) + layer * 384;
    const int lane = F.lane, k8 = (lane < 48 ? lane : 0) * 8;
    f32x4 sw[2], mw[2];
#pragma unroll
    for (int q = 0; q < 2; ++q) { sw[q] = *(const f32x4*)(snw + k8 + q * 4); mw[q] = *(const f32x4*)(mnw + k8 + q * 4); }
    for (int it = blockIdx.x; it < total; it += gridDim.x) {
        const int row0 = it * 32, rw = row0 + F.wave * 4;
        half8 a[4][6];
#pragma unroll
        for (int r = 0; r < 4; ++r) { const size_t ro = (size_t)(rw + r);
            a[r][0] = *(const half8*)(yf + ro * 384 + k8); a[r][1] = *(const half8*)(yb + ro * 384 + k8); a[r][2] = *(const half8*)(u16 + ro * UW + k8);
            a[r][3] = *(const half8*)(hf + ro * 384 + k8); a[r][4] = *(const half8*)(hb + ro * 384 + k8); a[r][5] = *(const half8*)(u16 + ro * UW + 2176 + k8); }
#pragma unroll
        for (int r = 0; r < 4; ++r) {
            const size_t ro = (size_t)(rw + r);
            float g[8], hv[8]; float ss = 0.f, hs = 0.f;
#pragma unroll
            for (int i = 0; i < 8; ++i) { g[i] = ((float)a[r][0][i] + (float)a[r][1][i]) * fsilu((float)a[r][2][i]); ss += g[i] * g[i]; hv[i] = (float)a[r][3][i] + (float)a[r][4][i]; hs += hv[i]; }
            if (lane >= 48) ss = 0.f;
            ss = wave_sum(ss);
            hs += __shfl_xor(hs, 1); hs += __shfl_xor(hs, 2); hs += __shfl_xor(hs, 4);
            const float mu = hs * (1.0f / 64.f);
            float vs = 0.f;
#pragma unroll
            for (int i = 0; i < 8; ++i) { hv[i] -= mu; vs += hv[i] * hv[i]; }
            vs += __shfl_xor(vs, 1); vs += __shfl_xor(vs, 2); vs += __shfl_xor(vs, 4);
            const float rs = 1.0f / sqrtf(ss * (1.0f / 384.f) + EPSF), rstd = 1.0f / sqrtf(vs * (1.0f / 64.f) + EPSF);
            if (lane < 48) { half8 o1, o2;
#pragma unroll
                for (int i = 0; i < 8; ++i) { o1[i] = (half_t)(g[i] * rs * sw[i >> 2][i & 3]); o2[i] = (half_t)(hv[i] * rstd * mw[i >> 2][i & 3] / (1.0f + fexp(-(float)a[r][5][i]))); }
                *(half8*)(yl + ro * D + k8) = o1; *(half8*)(yl + ro * D + 640 + k8) = o2; }
        }
        { const bool isl = row0 < TL; const int L = isl ? SEQ : CTXL; const int rc = isl ? row0 : row0 - TL; const int b = rc / L, t0 = rc % L;
          const float* yht = (const float*)(F.ws + WS_YHT) + (isl ? 0 : (size_t)NB * 256 * SEQ);
          if (F.tid < 256) { const int c = F.tid; const float* src = yht + ((size_t)b * 256 + c) * L + t0;
              f32x4 v[8];
#pragma unroll
              for (int q = 0; q < 8; ++q) v[q] = *(const f32x4*)(src + q * 4);
#pragma unroll
              for (int i = 0; i < 32; ++i) yl[(size_t)(row0 + i) * D + 384 + c] = (half_t)v[i >> 2][i & 3]; } }
    }
}

struct EpiOutproj {
    Frame F; int layer;
    __device__ __forceinline__ void operator()(const f32x4 (&acc)[2][2][4][2], const g8::Unit& u, int wr, int wc, int fr, int fq) const {
#pragma unroll
        for (int ai = 0; ai < 2; ++ai)
#pragma unroll
            for (int m = 0; m < 4; ++m) {
                const int srow = u.pm * 256 + ai * 128 + wr * 64 + m * 16 + fr;
                int row = srow;
                if (layer == 1 && srow < TL) { const int b = srow / SEQ, s = srow % SEQ; row = b * SEQ + (s % GROWS) * GW + s / GROWS; }
                const float* g1 = modp(F, layer, row_mod(row), 2);
                const float* xi = F.xrow_in(layer, row); float* xo = F.xrow(row);
#pragma unroll
                for (int bj = 0; bj < 2; ++bj)
#pragma unroll
                    for (int n = 0; n < 2; ++n) { const int c0 = u.pn * 256 + bj * 128 + wc * 32 + n * 16 + 4 * fq;
                        const f32x4 xv = *(const f32x4*)(xi + c0), gv = *(const f32x4*)(g1 + c0);
                        *(f32x4*)(xo + c0) = xv + gv * acc[ai][bj][m][n]; }
            }
    }
};
__device__ __forceinline__ void phase_outproj(const Frame& F, int layer) {
    const int nrows = layer == 0 ? TT : TL;
    g8::DenseSched S; S.abase = (const char*)(F.ws + WS_XN); S.bbase = (const char*)((const half_t*)(F.ws + WS_WOUT) + (size_t)layer * D * D); S.K = D; S.nM = nrows / 256; S.nN = D / 256; S.G = gridDim.x; S.c = blockIdx.x;
    EpiOutproj E{F, layer};
    g8::gemm_phase(F.smem, D, S, E);
}

constexpr int RLD = D + 8;
__device__ __forceinline__ void phase_router(const Frame& F, int layer, bool dry = false) {
    const int nrows = layer == 0 ? TT : TL, total = nrows / 32;
    half_t* Th = (half_t*)F.smem;
    half_t* Tl = Th + 32 * RLD;
    float* LG = (float*)(Tl + 32 * RLD);
    half_t* tb = (half_t*)(F.ws + WS_XN);
    unsigned* cnt = (unsigned*)(F.ws + WS_CTL) + CW_CNT + layer * 64;
    int* list = (int*)(F.ws + WS_LIST); float* pw = (float*)(F.ws + WS_PW);
    const float* nw = F.in(I_N2W) + layer * D;
    const half_t* wr = (const half_t*)(F.ws + WS_WR) + (size_t)layer * 2 * 48 * D;
    for (int it = blockIdx.x; it < total; it += gridDim.x) {
        const int row0 = it * 32;
        {
            const int r4 = F.wave * 4, m = row_mod(row0), lane = F.lane;
            f32x4 v[4][4];
#pragma unroll
            for (int r = 0; r < 4; ++r) { const float* x = F.xrow(row0 + r4 + r);
#pragma unroll
                for (int q = 0; q < 4; ++q) v[r][q] = *(const f32x4*)(x + q * 256 + lane * 4); }
            const float* sh = modp(F, layer, m, 3); const float* scl = modp(F, layer, m, 4);
            f32x4 g[4], s4[4];
#pragma unroll
            for (int q = 0; q < 4; ++q) { const int k = q * 256 + lane * 4; const f32x4 a = *(const f32x4*)(nw + k), b = *(const f32x4*)(scl + k); s4[q] = *(const f32x4*)(sh + k);
#pragma unroll
                for (int e = 0; e < 4; ++e) g[q][e] = a[e] * (1.0f + b[e]); }
#pragma unroll
            for (int r = 0; r < 4; ++r) {
                float ss = 0.f;
#pragma unroll
                for (int q = 0; q < 4; ++q) ss += v[r][q][0] * v[r][q][0] + v[r][q][1] * v[r][q][1] + v[r][q][2] * v[r][q][2] + v[r][q][3] * v[r][q][3];
                ss = wave_sum(ss);
                const float rs = 1.0f / sqrtf(ss * (1.0f / D) + EPSF);
                const int rr = r4 + r, row = row0 + rr;
#pragma unroll
                for (int q = 0; q < 4; ++q) { const int k = q * 256 + lane * 4; half4 h, l;
#pragma unroll
                    for (int e = 0; e < 4; ++e) { const float tv = v[r][q][e] * rs * g[q][e] + s4[q][e]; h[e] = (half_t)tv; l[e] = (half_t)((tv - (float)h[e]) * 2048.f); }
                    *(half4*)(tb + (size_t)row * D + k) = h; *(half4*)(Th + rr * RLD + k) = h; *(half4*)(Tl + rr * RLD + k) = l; }
            }
        }
        __syncthreads();
        {
            const int kb = F.wave * 128, r = F.lane & 15, kq = (F.lane >> 4) * 8;
            f32x4 ah[2][3], al[2][3]; zero_acc(ah); zero_acc(al);
#pragma unroll
            for (int hf = 0; hf < 2; ++hf) {
                half8 bh[3][2], bl[3][2];
#pragma unroll
                for (int nt = 0; nt < 3; ++nt)
#pragma unroll
                    for (int ks = 0; ks < 2; ++ks) { const size_t o = (size_t)(nt * 16 + r) * D + kb + (hf * 2 + ks) * 32 + kq; bh[nt][ks] = *(const half8*)(wr + o); bl[nt][ks] = *(const half8*)(wr + (size_t)48 * D + o); }
#pragma unroll
                for (int ks = 0; ks < 2; ++ks)
#pragma unroll
                    for (int mt = 0; mt < 2; ++mt) {
                        const half8 a_h = *(const half8*)(Th + (mt * 16 + r) * RLD + kb + (hf * 2 + ks) * 32 + kq), a_l = *(const half8*)(Tl + (mt * 16 + r) * RLD + kb + (hf * 2 + ks) * 32 + kq);
#pragma unroll
                        for (int nt = 0; nt < 3; ++nt) { ah[mt][nt] = mfma16(a_h, bh[nt][ks], ah[mt][nt]); al[mt][nt] = mfma16(a_l, bh[nt][ks], al[mt][nt]); al[mt][nt] = mfma16(a_h, bl[nt][ks], al[mt][nt]); }
                    }
            }
            __syncthreads();
            float* PART = (float*)Th;
#pragma unroll
            for (int mt = 0; mt < 2; ++mt)
#pragma unroll
                for (int nt = 0; nt < 3; ++nt)
#pragma unroll
                    for (int i = 0; i < 4; ++i) PART[(F.wave * 32 + mt * 16 + (F.lane >> 4) * 4 + i) * 48 + nt * 16 + r] = ah[mt][nt][i] + al[mt][nt][i] * (1.0f / 2048.f);
            __syncthreads();
            for (int o = F.tid; o < 32 * 48; o += NT) { const int col = o % 48; float sum = 0.f;
#pragma unroll
                for (int w = 0; w < 8; ++w) sum += PART[w * 32 * 48 + o];
                float bias = 0.f; if (col < 4) bias = F.in(I_GRB)[layer * 4 + col]; else if (col < 36) bias = F.in(I_ERB)[layer * 32 + col - 4];
                LG[o] = sum + bias; }
        }
        __syncthreads();
        if (F.tid < 32) {
            const int row = row0 + F.tid; const float* lg = LG + F.tid * 48;
            int gi = 0; float gm = lg[0];
            for (int q = 1; q < 4; ++q) if (lg[q] > gm) { gm = lg[q]; gi = q; }
            float gs = 0.f; for (int q = 0; q < 4; ++q) gs += expf(lg[q] - gm);
            const float grp_p = 1.0f / gs;
            const float* el = lg + 4 + gi * 8;
            int i0 = 0; float e0 = el[0];
            for (int q = 1; q < 8; ++q) if (el[q] > e0) { e0 = el[q]; i0 = q; }
            int i1 = -1; float e1 = -3.0e38f;
            for (int q = 0; q < 8; ++q) if (q != i0 && el[q] > e1) { e1 = el[q]; i1 = q; }
            const float p1 = expf(e1 - e0);
            const float w0 = grp_p * (1.0f / (1.0f + p1)), w1 = grp_p * (p1 / (1.0f + p1));
            const int ea = gi * 8 + i0, eb = gi * 8 + i1;
            if (!dry) { const unsigned pa = atomicAdd(&cnt[ea * 2 + 0], 1u), pb = atomicAdd(&cnt[eb * 2 + 1], 1u);
            list[(size_t)(ea * 2 + 0) * LCAP + pa] = row * 2 + 0; list[(size_t)(eb * 2 + 1) * LCAP + pb] = row * 2 + 1;
            pw[row * 2 + 0] = w0; pw[row * 2 + 1] = w1; } else if (w0 == 1234.5f) pw[row * 2] = w1;
        }
        __syncthreads();
    }
}

constexpr int MOE_PRE_OFF = g8::STAGE_BYTES;
struct MoeSchedA {
    const char* abase; const char* wbase; const int* pre; const unsigned* cnt; const int* list; int G, c;
    __device__ __forceinline__ int entry(const g8::Unit& u, int r) const { const int rc = r < u.n ? r : 0; return rc < u.c0 ? list[(size_t)(u.e * 2) * LCAP + rc] : list[(size_t)(u.e * 2 + 1) * LCAP + (rc - u.c0)]; }
    __device__ __forceinline__ bool next(int i, g8::Unit& u) const {
        const int L = i * G + c; if (L >= pre[32]) return false;
        int e = 0; while (L >= pre[e + 1]) ++e;
        const int loc = L - pre[e]; u.e = e; u.c0 = (int)cnt[e * 2]; u.n = u.c0 + (int)cnt[e * 2 + 1]; u.pm = loc >> 1; u.pn = loc & 1; return true;
    }
    __device__ __forceinline__ unsigned a_off(const g8::Unit& u, int r) const { return (unsigned)(entry(u, u.pm * 256 + r) >> 1) * (unsigned)(D * 2); }
    __device__ __forceinline__ const char* b_half(const g8::Unit& u, int h) const { return wbase + ((size_t)u.e * 3 * 262144 + (size_t)h * 262144 + (size_t)u.pn * 128 * D) * 2; }
};
struct EpiMoeA {
    MoeSchedA S; const float* pw; half_t* hid;
    __device__ __forceinline__ void operator()(const f32x4 (&acc)[2][2][4][2], const g8::Unit& u, int wr, int wc, int fr, int fq) const {
        int pid[8]; float w[8];
#pragma unroll
        for (int g = 0; g < 8; ++g) pid[g] = S.entry(u, u.pm * 256 + (g >> 2) * 128 + wr * 64 + (g & 3) * 16 + fr);
#pragma unroll
        for (int g = 0; g < 8; ++g) w[g] = pw[pid[g]];
#pragma unroll
        for (int ai = 0; ai < 2; ++ai)
#pragma unroll
            for (int m = 0; m < 4; ++m) {
                const int rr = u.pm * 256 + ai * 128 + wr * 64 + m * 16 + fr;
                if (rr < u.n) {
#pragma unroll
                    for (int n = 0; n < 2; ++n) { const int f = u.pn * 128 + wc * 32 + n * 16 + 4 * fq; const f32x4 g = acc[ai][0][m][n], up = acc[ai][1][m][n]; f32x4 o;
#pragma unroll
                        for (int i = 0; i < 4; ++i) o[i] = fsilu(g[i]) * up[i] * w[ai * 4 + m];
                        *(half4*)(hid + (size_t)pid[ai * 4 + m] * 256 + f) = to_half4(o); } }
            }
    }
};
__device__ __forceinline__ void phase_moe_a(const Frame& F, int layer) {
    int* pre = (int*)(F.smem + MOE_PRE_OFF);
    const unsigned* cnt = (const unsigned*)(F.ws + WS_CTL) + CW_CNT + layer * 64;
    if (F.tid == 0) { int s = 0; for (int e = 0; e < 32; ++e) { pre[e] = s; s += (((int)(cnt[e * 2] + cnt[e * 2 + 1]) + 255) / 256) * 2; } pre[32] = s; }
    __syncthreads();
    MoeSchedA S; S.abase = (const char*)(F.ws + WS_XN); S.wbase = (const char*)(F.ws + WS_WMOE); S.pre = pre; S.cnt = cnt; S.list = (const int*)(F.ws + WS_LIST); S.G = gridDim.x; S.c = blockIdx.x;
    EpiMoeA E{S, (const float*)(F.ws + WS_PW), (half_t*)(F.ws + WS_U16)};
    g8::gemm_phase(F.smem, D, S, E);
    __syncthreads();
}
struct MoeSchedB {
    const char* abase; const char* wbase; const int* pre; const unsigned* cnt; const int* list; int slot, G, c;
    __device__ __forceinline__ bool next(int i, g8::Unit& u) const {
        const int L = i * G + c; if (L >= pre[32]) return false;
        int e = 0; while (L >= pre[e + 1]) ++e;
        const int loc = L - pre[e]; u.e = e; u.n = (int)cnt[e * 2 + slot]; u.c0 = 0; u.pm = loc >> 2; u.pn = loc & 3; return true;
    }
    __device__ __forceinline__ int entry(const g8::Unit& u, int rr) const { return list[(size_t)(u.e * 2 + slot) * LCAP + (rr < u.n ? rr : 0)]; }
    __device__ __forceinline__ unsigned a_off(const g8::Unit& u, int r) const { return (unsigned)entry(u, u.pm * 256 + r) * 512u; }
    __device__ __forceinline__ const char* b_half(const g8::Unit& u, int h) const { return wbase + ((size_t)u.e * 3 * 262144 + 2 * 262144 + (size_t)(u.pn * 256 + h * 128) * 256) * 2; }
};
struct EpiMoeB {
    MoeSchedB S; Frame F; int layer;
    __device__ __forceinline__ void operator()(const f32x4 (&acc)[2][2][4][2], const g8::Unit& u, int wr, int wc, int fr, int fq) const {
        int row[8];
#pragma unroll
        for (int g = 0; g < 8; ++g) row[g] = S.entry(u, u.pm * 256 + (g >> 2) * 128 + wr * 64 + (g & 3) * 16 + fr) >> 1;
#pragma unroll
        for (int ai = 0; ai < 2; ++ai)
#pragma unroll
            for (int m = 0; m < 4; ++m) {
                const int rr = u.pm * 256 + ai * 128 + wr * 64 + m * 16 + fr;
                if (rr < u.n) { const int rw = row[ai * 4 + m]; float* xo = F.xrow(rw); const float* g5 = modp(F, layer, row_mod(rw), 5);
#pragma unroll
                    for (int bj = 0; bj < 2; ++bj)
#pragma unroll
                        for (int n = 0; n < 2; ++n) { const int d = u.pn * 256 + bj * 128 + wc * 32 + n * 16 + 4 * fq;
                            const f32x4 xv = *(const f32x4*)(xo + d), gv = *(const f32x4*)(g5 + d); *(f32x4*)(xo + d) = xv + gv * acc[ai][bj][m][n]; } }
            }
    }
};
__device__ __forceinline__ void phase_moe_b(const Frame& F, int layer, int slot) {
    int* pre = (int*)(F.smem + MOE_PRE_OFF);
    const unsigned* cnt = (const unsigned*)(F.ws + WS_CTL) + CW_CNT + layer * 64;
    if (F.tid == 0) { int s = 0; for (int e = 0; e < 32; ++e) { pre[e] = s; s += (((int)cnt[e * 2 + slot] + 255) / 256) * 4; } pre[32] = s; }
    __syncthreads();
    MoeSchedB S; S.abase = (const char*)(F.ws + WS_U16); S.wbase = (const char*)(F.ws + WS_WMOE); S.pre = pre; S.cnt = cnt; S.list = (const int*)(F.ws + WS_LIST); S.slot = slot; S.G = gridDim.x; S.c = blockIdx.x;
    EpiMoeB E{S, F, layer};
    g8::gemm_phase(F.smem, 256, S, E);
    __syncthreads();
}

__device__ __forceinline__ void phase_final(const Frame& F) {
    const float* fw = F.in(I_FNW);
    f32x4 w4[4];
#pragma unroll
    for (int q = 0; q < 4; ++q) w4[q] = *(const f32x4*)(fw + q * 256 + F.lane * 4);
    for (int it = blockIdx.x; it < TL / 32; it += gridDim.x) {
        float* x0 = F.P->out + (size_t)(it * 32 + F.wave * 4) * D;
        f32x4 v[4][4];
#pragma unroll
        for (int r = 0; r < 4; ++r)
#pragma unroll
            for (int q = 0; q < 4; ++q) v[r][q] = *(const f32x4*)(x0 + (size_t)r * D + q * 256 + F.lane * 4);
#pragma unroll
        for (int r = 0; r < 4; ++r) {
            float ss = 0.f;
#pragma unroll
            for (int q = 0; q < 4; ++q) ss += v[r][q][0] * v[r][q][0] + v[r][q][1] * v[r][q][1] + v[r][q][2] * v[r][q][2] + v[r][q][3] * v[r][q][3];
            ss = wave_sum(ss);
            const float rs = 1.0f / sqrtf(ss * (1.0f / D) + EPSF);
#pragma unroll
            for (int q = 0; q < 4; ++q) *(f32x4*)(x0 + (size_t)r * D + q * 256 + F.lane * 4) = v[r][q] * rs * w4[q];
        }
    }
}

constexpr int NPHASE = 1 + 2 * 9 + 1;
#ifndef ONLY
#define ONLY -1
#endif
#define EN(x) (ONLY < 0 || ONLY == (x))
__device__ __forceinline__ void run_phase(const Frame& F, int ph) {
    if (ph == 0) { if (EN(0)) phase_setup(F); return; }
    if (ph == NPHASE - 1) { if (EN(10)) phase_final(F); return; }
    const int layer = (ph - 1) / 9, k = (ph - 1) % 9;
    switch (k) {
        case 0: if (EN(1)) phase_norm1(F, layer); break;
        case 1: if (EN(2)) phase_inproj(F, layer); break;
        case 2: if (EN(3)) phase_mixers(F, layer); break;
        case 3: if (EN(4)) phase_combine(F, layer); break;
        case 4: if (EN(5)) phase_outproj(F, layer); break;
        case 5: if (EN(6)) phase_router(F, layer); break;
        case 6: if (EN(7)) phase_moe_a(F, layer); break;
        case 7: if (EN(8)) phase_moe_b(F, layer, 0); break;
        default: if (EN(9)) phase_moe_b(F, layer, 1); break;
    }
}

#ifdef EMU
void mega(const Params* Pp) {
    Frame F; F.P = Pp; F.ws = Pp->ws; F.smem = emu_blk->smem; F.tid = threadIdx.x; F.lane = F.tid & 63; F.wave = F.tid >> 6;
    for (int ph = Pp->ph_lo; ph < Pp->ph_hi; ++ph) { run_phase(F, ph); __syncthreads(); }
}
#else
__global__ void __launch_bounds__(NT) mega(Params P) {
    extern __shared__ __attribute__((aligned(16))) unsigned char smem_dyn[];
    cg::grid_group grid = cg::this_grid();
    Frame F; F.P = (ParamsPtr)__builtin_amdgcn_kernarg_segment_ptr(); F.ws = P.ws; F.smem = smem_dyn; F.tid = threadIdx.x; F.lane = F.tid & 63; F.wave = F.tid >> 6;
    volatile LAS unsigned* bst = (volatile LAS unsigned*)(smem_dyn + LDS_BYTES - 16);
    if (F.tid < 4) bst[F.tid] = 0u;
    __syncthreads();
    XcdBarrier xb = xcd_barrier_post((unsigned*)(P.ws + WS_CTL) + CW_BAR, bst);
    if (P.ph_lo < 0) grid.sync();
#define DUP -1
#define PHASE_STEP(i) if (P.ph_lo <= (i) && (i) < P.ph_hi) { run_phase(F, (i)); if (DUP == (i)) { xcd_barrier(xb); if (DUP == 6) phase_router(F, 0, true); else run_phase(F, (i)); } if ((i) + 1 < P.ph_hi) xcd_barrier(xb); }
    PHASE_STEP(0) PHASE_STEP(1) PHASE_STEP(2) PHASE_STEP(3) PHASE_STEP(4) PHASE_STEP(5) PHASE_STEP(6) PHASE_STEP(7) PHASE_STEP(8) PHASE_STEP(9)
    PHASE_STEP(10) PHASE_STEP(11) PHASE_STEP(12) PHASE_STEP(13) PHASE_STEP(14) PHASE_STEP(15) PHASE_STEP(16) PHASE_STEP(17) PHASE_STEP(18) PHASE_STEP(19)
    static_assert(NPHASE == 20, "phase list");
}

extern "C" void kernel_launch(void* const* d_in, const int* in_sizes, int n_in, void* d_out, int out_size, void* d_ws, size_t ws_size, hipStream_t stream) {
    static int grid_blocks = 0;
    if (grid_blocks == 0) {
        if (n_in != 38 || out_size != TL * D || ws_size < WS_END) { fprintf(stderr, "kernel_launch: unexpected shapes (n_in %d out %d ws %zu need %zu)\n", n_in, out_size, ws_size, (size_t)WS_END); grid_blocks = -1; return; }
        int dev = 0, cus = 0, per_cu = 0;
        hipGetDevice(&dev);
        hipDeviceGetAttribute(&cus, hipDeviceAttributeMultiprocessorCount, dev);
        hipFuncSetAttribute((const void*)mega, hipFuncAttributeMaxDynamicSharedMemorySize, LDS_BYTES);
        hipOccupancyMaxActiveBlocksPerMultiprocessor(&per_cu, (const void*)mega, NT, LDS_BYTES);
        if (per_cu < 1) { fprintf(stderr, "kernel_launch: occupancy query says 0 blocks per CU\n"); grid_blocks = -1; return; }
        grid_blocks = cus;
    }
    if (grid_blocks < 0) return;
    if (hipMemsetAsync((char*)d_ws + WS_CTL, 0, CTL_BYTES, stream) != hipSuccess) { fprintf(stderr, "kernel_launch: memset failed\n"); return; }
    Params p{};
    for (int i = 0; i < 38; ++i) p.in[i] = (const float*)d_in[i];
    p.out = (float*)d_out; p.ws = (unsigned char*)d_ws; p.ph_lo = 0; p.ph_hi = NPHASE;
    void* args[] = {&p};
    hipError_t e = hipLaunchCooperativeKernel((const void*)mega, dim3(grid_blocks), dim3(NT), args, LDS_BYTES, stream);
    if (e != hipSuccess) fprintf(stderr, "cooperative launch failed: %s (grid %d)\n", hipGetErrorString(e), grid_blocks);
}
#endif
```

```cpp
#ifdef EMU
#include "gpuemu.h"
#else
#include <hip/hip_runtime.h>
#include <hip/hip_cooperative_groups.h>
#include <cstdio>
namespace cg = cooperative_groups;
#endif
#include <stdint.h>

#ifndef CFG_B
#define CFG_B 4
#endif
#ifndef CFG_SEQ
#define CFG_SEQ 4096
#endif
#ifndef CFG_CTX
#define CFG_CTX 256
#endif

typedef _Float16 half_t;
typedef _Float16 half8 __attribute__((ext_vector_type(8)));
typedef _Float16 half4 __attribute__((ext_vector_type(4)));
typedef float f32x4 __attribute__((ext_vector_type(4)));
struct cplx { float x, y; };

constexpr int D = 1024, NB = CFG_B, SEQ = CFG_SEQ, CTXL = CFG_CTX, GW = 64, GROWS = SEQ / GW;
constexpr int TL = NB * SEQ, TC = NB * CTXL, TT = TL + TC;
constexpr int NIN = 3364, NINP = 3584;
constexpr int UW = 2560;
constexpr int UGW = 36;
constexpr int NT = 512;
constexpr int TWN = 2 * SEQ > 2 * CTXL ? 2 * SEQ : 2 * CTXL;
constexpr int NMOD = 6 * D;
constexpr int LCAP = TT;
constexpr float EPSF = 1e-6f;

constexpr size_t al256(size_t x) { return (x + 255) / 256 * 256; }
constexpr size_t WS_CTL    = 0;
constexpr size_t WS_MOD    = 32768;
constexpr size_t WS_TW     = WS_MOD + al256(sizeof(float) * 2 * 5 * NMOD);
constexpr size_t WS_WIN    = WS_TW + al256(sizeof(cplx) * TWN);
constexpr size_t WS_WOUT   = WS_WIN + al256(2ull * 2 * NINP * D);
constexpr size_t WS_WMOE   = WS_WOUT + al256(2ull * 2 * D * D);
constexpr size_t WS_XC     = WS_WMOE + al256(2ull * 32 * 3 * 262144);
constexpr size_t WS_XN     = WS_XC + al256(4ull * TC * D);
constexpr size_t WS_U16    = WS_XN + al256(2ull * TT * D);
constexpr size_t WS_UG     = WS_U16 + al256(2ull * TT * UW);
constexpr size_t WS_HYT    = WS_UG + al256(4ull * TT * UGW);
constexpr size_t WS_YF     = WS_HYT + al256(2ull * NB * 768 * (SEQ + CTXL));
constexpr size_t WS_YHT    = WS_YF + al256(2ull * 4 * TT * 384);
constexpr size_t WS_FT     = WS_YHT + al256(4ull * NB * 256 * (SEQ + CTXL));
constexpr size_t WS_LIST   = WS_FT + al256(4ull * (2 * 256 * 4 * SEQ + 256 * 4 * CTXL));
constexpr size_t WS_PW     = WS_LIST + al256(4ull * 64 * LCAP);
constexpr size_t WS_WR     = WS_PW + al256(4ull * TT * 2);
constexpr size_t WS_HALO   = WS_WR + al256(2ull * 2 * 2 * 48 * D);
constexpr size_t WS_END    = WS_HALO + al256(2ull * (TT / 16) * 2 * 1408);
static_assert(4ull * NB * 256 * (SEQ + CTXL) <= 2ull * TT * D, "Z1 scratch must fit in the XN region");
static_assert(2ull * TT * 2 * 256 <= 2ull * TT * UW, "HID must fit in the U16 region");

constexpr int CW_CNT = 0;
constexpr int CW_BAR = 1024;
constexpr size_t CTL_BYTES = 32768;

constexpr int LDS_BYTES = 156 * 1024;

struct Params {
    const float* in[38];
    float* out;
    unsigned char* ws;
    int ph_lo, ph_hi;
};

enum { I_X = 0, I_C, I_CTX, I_CCTX, I_WMOD, I_BMOD, I_N1W, I_N2W, I_WIN, I_WOUT, I_SCW, I_SCB, I_DTB, I_ALOG, I_SD, I_SNW,
       I_HCW, I_HCB, I_HW1, I_HB1, I_HW2, I_HB2, I_HW3, I_HFREQ, I_HDEC, I_HSKIP, I_MCW, I_MCB, I_MGB, I_MNW,
       I_GRW, I_GRB, I_ERW, I_ERB, I_MG, I_MU, I_MD, I_FNW };

__device__ __forceinline__ float siluf(float x) { return x / (1.0f + expf(-x)); }
__device__ __forceinline__ float sigmoidf_(float x) { return 1.0f / (1.0f + expf(-x)); }
__device__ __forceinline__ float softplusf_(float x) { return x > 20.f ? x : log1pf(expf(x)); }
__device__ __forceinline__ float logsigmoidf_(float x) { return fminf(x, 0.f) - log1pf(expf(-fabsf(x))); }

__device__ __forceinline__ float fexp(float x) {
#ifdef EMU
    return expf(x);
#else
    return __expf(x);
#endif
}
__device__ __forceinline__ float fsilu(float x) {
#ifdef EMU
    return x / (1.0f + expf(-x));
#else
    return __fdividef(x, 1.0f + __expf(-x));
#endif
}
__device__ __forceinline__ float wave_sum(float v) {
#pragma unroll
    for (int m = 32; m >= 1; m >>= 1) v += __shfl_xor(v, m);
    return v;
}
__device__ __forceinline__ float wave_max(float v) {
#pragma unroll
    for (int m = 32; m >= 1; m >>= 1) v = fmaxf(v, __shfl_xor(v, m));
    return v;
}
__device__ __forceinline__ float wave_scan_sum(float v, int lane) {
#pragma unroll
    for (int d = 1; d < 64; d <<= 1) { float o = __shfl_up(v, d); if (lane >= d) v += o; }
    return v;
}
__device__ __forceinline__ float wave_scan_max(float v, int lane) {
#pragma unroll
    for (int d = 1; d < 64; d <<= 1) { float o = __shfl_up(v, d); if (lane >= d) v = fmaxf(v, o); }
    return v;
}

template <int MT, int NTL>
__device__ __forceinline__ void mma_lds(f32x4 (&acc)[MT][NTL], const half_t* A, int lda, const half_t* B, int ldb, int ksteps, int lane) {
#ifndef EMU
    const int r = lane & 15, kq = (lane >> 4) * 8;
    for (int ks = 0; ks < ksteps; ++ks) {
        half8 a[MT], b[NTL];
#pragma unroll
        for (int mt = 0; mt < MT; ++mt) a[mt] = *(const half8*)(A + (mt * 16 + r) * lda + ks * 32 + kq);
#pragma unroll
        for (int nt = 0; nt < NTL; ++nt) b[nt] = *(const half8*)(B + (nt * 16 + r) * ldb + ks * 32 + kq);
#pragma unroll
        for (int mt = 0; mt < MT; ++mt)
#pragma unroll
            for (int nt = 0; nt < NTL; ++nt) acc[mt][nt] = __builtin_amdgcn_mfma_f32_16x16x32_f16(a[mt], b[nt], acc[mt][nt], 0, 0, 0);
    }
#else
    for (int mt = 0; mt < MT; ++mt) for (int nt = 0; nt < NTL; ++nt) for (int i = 0; i < 4; ++i) {
        const int row = mt * 16 + (lane >> 4) * 4 + i, col = nt * 16 + (lane & 15);
        float s = acc[mt][nt][i];
        for (int k = 0; k < ksteps * 32; ++k) s += (float)A[row * lda + k] * (float)B[col * ldb + k];
        acc[mt][nt][i] = s;
    }
#endif
}

__device__ __forceinline__ f32x4 mfma16(half8 a, half8 b, f32x4 c) {
#ifdef EMU
    return emu_mfma16(a, b, c);
#else
    return __builtin_amdgcn_mfma_f32_16x16x32_f16(a, b, c, 0, 0, 0);
#endif
}
template <int MT, int NTL> __device__ __forceinline__ void zero_acc(f32x4 (&acc)[MT][NTL]) {
#pragma unroll
    for (int mt = 0; mt < MT; ++mt)
#pragma unroll
        for (int nt = 0; nt < NTL; ++nt) acc[mt][nt] = (f32x4){0.f, 0.f, 0.f, 0.f};
}

__device__ __forceinline__ void load_taps4(const float* cw, const float* cb, int C, int ch, int dir, f32x4& w0, f32x4& w1, f32x4& w2, f32x4& wb) {
    w0 = *(const f32x4*)(cw + (dir ? 2 : 0) * C + ch); w1 = *(const f32x4*)(cw + C + ch); w2 = *(const f32x4*)(cw + (dir ? 0 : 2) * C + ch); wb = *(const f32x4*)(cb + ch);
}
#ifdef EMU
#define LOADER_FENCE()
#else
#define LOADER_FENCE() asm volatile("" ::: "memory")
#endif
#define CONV4(k, i) (w0[i] * (float)rr[k][hh * 4 + i] + w1[i] * (float)rr[(k) + 1][hh * 4 + i] + w2[i] * (float)rr[(k) + 2][hh * 4 + i] + wb[i])
__device__ __forceinline__ half4 to_half4(const f32x4 v) { half4 h; h[0] = (half_t)v[0]; h[1] = (half_t)v[1]; h[2] = (half_t)v[2]; h[3] = (half_t)v[3]; return h; }
namespace g8 {
constexpr int BM = 256, BK = 64, HALF = 128, HTB = HALF * BK * 2, STAGE_BYTES = 8 * HTB;
__device__ __forceinline__ int lds_byte(int r, int c) { const int st = (r >> 4) * 2 + (c >> 5), rr = r & 15, cc = c & 31, ob = rr * 64 + cc * 2; return st * 1024 + (ob ^ (((ob >> 9) & 1) << 5)); }
__device__ __forceinline__ void stage_rc(int b, int& R, int& C) { const int st = b / 1024, sb = b % 1024, swz = sb ^ (((sb >> 9) & 1) << 5); R = (st >> 1) * 16 + swz / 64; C = (st & 1) * 32 + (swz % 64) / 2; }
struct Unit { int pm, pn, e, n, c0; };

struct DenseSched {
    const char* abase; const char* bbase; int K, nM, nN, G, c;
    __device__ __forceinline__ bool next(int i, Unit& u) const {
        const int nwg = nM * nN; const long L = (long)i * G + c; if (L >= nwg) return false;
        int wgid = (int)L; { const int q = nwg / 8, r = nwg % 8, xcd = wgid % 8, off = wgid / 8; wgid = (xcd < r ? xcd * (q + 1) : r * (q + 1) + (xcd - r) * q) + off; }
        const int nig = 8 * nN, gid = wgid / nig, fm = gid * 8, gsz = (nM - fm) < 8 ? (nM - fm) : 8;
        u.pm = fm + ((wgid % nig) % gsz); u.pn = (wgid % nig) / gsz; u.e = 0; u.n = 0; u.c0 = 0; return true;
    }
    __device__ __forceinline__ unsigned a_off(const Unit& u, int r) const { return (unsigned)((size_t)(u.pm * 256 + r) * K * 2); }
    __device__ __forceinline__ const char* b_half(const Unit& u, int h) const { return bbase + (size_t)(u.pn * 256 + h * 128) * K * 2; }
};

template <class Epi, class Sched>
__device__ __forceinline__ void gemm_phase(unsigned char* smem, const int K, const Sched& S, const Epi& E) {
    const int tid = threadIdx.x, lane = tid & 63;
#ifdef EMU
    const int wid = tid >> 6, wr = wid >> 2, wc = wid & 3, fr = lane & 15, fq = lane >> 4;
    half_t* As = (half_t*)smem; half_t* Bs = As + 256 * 72;
    Unit cur;
    for (int ui = 0; S.next(ui, cur); ++ui) {
        f32x4 acc[2][2][4][2];
        for (int a = 0; a < 2; ++a) for (int b = 0; b < 2; ++b) for (int m = 0; m < 4; ++m) for (int n = 0; n < 2; ++n) acc[a][b][m][n] = (f32x4){0.f, 0.f, 0.f, 0.f};
        for (int kt = 0; kt < K / 64; ++kt) {
            { const int row = tid >> 1, c0 = (tid & 1) * 32;
              const half_t* sa = (const half_t*)(S.abase + S.a_off(cur, row)) + kt * 64 + c0;
              const half_t* sb = (const half_t*)(S.b_half(cur, row >> 7)) + (size_t)(row & 127) * K + kt * 64 + c0;
              for (int q = 0; q < 32; ++q) { As[row * 72 + c0 + q] = sa[q]; Bs[row * 72 + c0 + q] = sb[q]; } }
            __syncthreads();
            for (int a = 0; a < 2; ++a) for (int b = 0; b < 2; ++b) for (int m = 0; m < 4; ++m) for (int n = 0; n < 2; ++n) for (int i = 0; i < 4; ++i) {
                const int row = 128 * a + 64 * wr + 16 * m + fr, col = 128 * b + 32 * wc + 16 * n + 4 * fq + i; float s = acc[a][b][m][n][i];
                for (int k = 0; k < 64; ++k) s += (float)As[row * 72 + k] * (float)Bs[col * 72 + k];
                acc[a][b][m][n][i] = s; }
            __syncthreads();
        }
        E(acc, cur, wr, wc, fr, fq);
    }
#else
    typedef __attribute__((address_space(3))) unsigned char* ldsp_t;
    const ldsp_t lds = (ldsp_t)smem;
    const int wid = __builtin_amdgcn_readfirstlane(tid >> 6), wr = wid >> 2, wc = wid & 3, fr = lane & 15, fq = lane >> 4;
    const int nt = K / BK;
    int Rr[2], Cc[2]; unsigned voffB[2];
#pragma unroll
    for (int i = 0; i < 2; ++i) { stage_rc(tid * 16 + i * 8192, Rr[i], Cc[i]); voffB[i] = (unsigned)(Rr[i] * K + Cc[i]) * 2u; }
    const size_t kstep = (size_t)(BK * 2);
    const unsigned ldsw = (unsigned)wid * 1024u;
    const int aoffl = lds_byte(wr * 64 + fr, fq * 8), boffl = lds_byte(wc * 32 + fr, fq * 8);
#define G8_SA(b, h) (((b) * 2 + (h)) * HTB)
#define G8_SB(b, h) ((4 + (b) * 2 + (h)) * HTB)
#define G8_STAGE(bufoff, gbase, voff) do { _Pragma("unroll") for (int _i = 0; _i < 2; ++_i) \
        __builtin_amdgcn_global_load_lds((const unsigned*)((const char*)(gbase) + (voff)[_i]), (__attribute__((address_space(3))) unsigned*)(lds + (bufoff) + ldsw + _i * 8192), 16, 0, 0); } while (0)
#define G8_LDA(dst, b, h) do { _Pragma("unroll") for (int m = 0; m < 4; ++m) _Pragma("unroll") for (int k = 0; k < 2; ++k) dst[m][k] = *(const __attribute__((address_space(3))) half8*)(lds + G8_SA(b, h) + aoffl + m * 2048 + k * 1024); } while (0)
#define G8_LDB(dst, b, h) do { _Pragma("unroll") for (int n = 0; n < 2; ++n) _Pragma("unroll") for (int k = 0; k < 2; ++k) dst[n][k] = *(const __attribute__((address_space(3))) half8*)(lds + G8_SB(b, h) + boffl + n * 2048 + k * 1024); } while (0)
#define G8_MMA(ai, bj, At, Bt) do { __builtin_amdgcn_s_setprio(1); _Pragma("unroll") for (int m = 0; m < 4; ++m) _Pragma("unroll") for (int n = 0; n < 2; ++n) _Pragma("unroll") for (int k = 0; k < 2; ++k) \
        acc[ai][bj][m][n] = __builtin_amdgcn_mfma_f32_16x16x32_f16(Bt[n][k], At[m][k], acc[ai][bj][m][n], 0, 0, 0); __builtin_amdgcn_s_setprio(0); } while (0)
#define G8_WAIT_V(n) asm volatile("s_waitcnt vmcnt(" #n ")" ::: "memory")
#define G8_WAIT_L(n) asm volatile("s_waitcnt lgkmcnt(" #n ")" ::: "memory")
#define G8_BAR __builtin_amdgcn_s_barrier()
#define G8_SCHED __builtin_amdgcn_sched_barrier(0)
#define G8_AOFF(dst, u) do { _Pragma("unroll") for (int _h = 0; _h < 2; ++_h) _Pragma("unroll") for (int _i = 0; _i < 2; ++_i) dst[_h][_i] = S.a_off(u, _h * 128 + Rr[_i]) + (unsigned)Cc[_i] * 2u; } while (0)
    Unit cur, nxt; int ui = 0;
    if (!S.next(0, cur)) return;
    f32x4 acc[2][2][4][2];
#pragma unroll
    for (int a = 0; a < 2; ++a)
#pragma unroll
        for (int b = 0; b < 2; ++b)
#pragma unroll
            for (int m = 0; m < 4; ++m)
#pragma unroll
                for (int n = 0; n < 2; ++n) acc[a][b][m][n] = (f32x4){0.f, 0.f, 0.f, 0.f};
    half8 At[4][2], B0[2][2], B1[2][2];
    unsigned caoff[2][2], naoff[2][2];
    G8_AOFF(caoff, cur);
    const char* cA = S.abase; const char* cB0 = S.b_half(cur, 0); const char* cB1 = S.b_half(cur, 1);
    G8_STAGE(G8_SB(0, 0), cB0, voffB); G8_STAGE(G8_SA(0, 0), cA, caoff[0]); G8_STAGE(G8_SB(0, 1), cB1, voffB); G8_STAGE(G8_SA(0, 1), cA, caoff[1]);
    if (wr == 1) G8_BAR;
    G8_WAIT_V(4); G8_BAR;
    G8_STAGE(G8_SB(1, 0), cB0 + kstep, voffB); G8_STAGE(G8_SA(1, 0), cA + kstep, caoff[0]); G8_STAGE(G8_SB(1, 1), cB1 + kstep, voffB);
    G8_WAIT_V(6); G8_BAR;
    for (;;) {
        const bool has_next = S.next(ui + 1, nxt);
        if (!has_next) nxt = cur;
        G8_AOFF(naoff, nxt);
        const char* nB0 = S.b_half(nxt, 0); const char* nB1 = S.b_half(nxt, 1);
#pragma unroll 1
        for (int t = 0; t < nt; t += 2) {
            const bool last = (t == nt - 2);
            const char* a1 = cA + (size_t)(t + 1) * kstep;
            const char* a2 = last ? cA : cA + (size_t)(t + 2) * kstep;
            const char* b20 = last ? nB0 : cB0 + (size_t)(t + 2) * kstep; const char* b21 = last ? nB1 : cB1 + (size_t)(t + 2) * kstep;
            const char* a3 = a2 + kstep; const char* b30 = b20 + kstep; const char* b31 = b21 + kstep;
            unsigned xoff[2][2];
#pragma unroll
            for (int h = 0; h < 2; ++h)
#pragma unroll
                for (int i = 0; i < 2; ++i) xoff[h][i] = last ? naoff[h][i] : caoff[h][i];
            G8_LDB(B0, 0, 0); G8_SCHED; G8_LDA(At, 0, 0); G8_STAGE(G8_SA(1, 1), a1, caoff[1]);
            G8_WAIT_L(8); G8_BAR; G8_WAIT_L(0); G8_MMA(0, 0, At, B0); G8_BAR; G8_SCHED;
            G8_LDB(B1, 0, 1); G8_STAGE(G8_SB(0, 0), b20, voffB);
            G8_BAR; G8_WAIT_L(0); G8_MMA(0, 1, At, B1); G8_BAR;
            G8_LDA(At, 0, 1); G8_STAGE(G8_SA(0, 0), a2, xoff[0]);
            G8_BAR; G8_WAIT_L(0); G8_MMA(1, 0, At, B0); G8_BAR; G8_SCHED;
            G8_STAGE(G8_SB(0, 1), b21, voffB);
            G8_WAIT_V(6); G8_BAR; G8_MMA(1, 1, At, B1); G8_BAR;
            G8_LDB(B0, 1, 0); G8_SCHED; G8_LDA(At, 1, 0); G8_STAGE(G8_SA(0, 1), a2, xoff[1]);
            G8_WAIT_L(8); G8_BAR; G8_WAIT_L(0); G8_MMA(0, 0, At, B0); G8_BAR; G8_SCHED;
            G8_LDB(B1, 1, 1); G8_STAGE(G8_SB(1, 0), b30, voffB);
            G8_BAR; G8_WAIT_L(0); G8_MMA(0, 1, At, B1); G8_BAR;
            G8_LDA(At, 1, 1); G8_STAGE(G8_SA(1, 0), a3, xoff[0]);
            G8_BAR; G8_WAIT_L(0); G8_MMA(1, 0, At, B0); G8_BAR; G8_SCHED;
            G8_STAGE(G8_SB(1, 1), b31, voffB);
            G8_WAIT_V(6); G8_BAR; G8_MMA(1, 1, At, B1); G8_BAR;
        }
        E(acc, cur, wr, wc, fr, fq);
        if (!has_next) break;
#pragma unroll
        for (int a = 0; a < 2; ++a)
#pragma unroll
            for (int b = 0; b < 2; ++b)
#pragma unroll
                for (int m = 0; m < 4; ++m)
#pragma unroll
                    for (int n = 0; n < 2; ++n) acc[a][b][m][n] = (f32x4){0.f, 0.f, 0.f, 0.f};
        cur = nxt; cB0 = nB0; cB1 = nB1; ++ui;
#pragma unroll
        for (int h = 0; h < 2; ++h)
#pragma unroll
            for (int i = 0; i < 2; ++i) caoff[h][i] = naoff[h][i];
    }
    G8_WAIT_V(0);
    if (wr == 0) G8_BAR;
    G8_BAR;
#undef G8_SA
#undef G8_SB
#undef G8_STAGE
#undef G8_LDA
#undef G8_LDB
#undef G8_MMA
#undef G8_WAIT_V
#undef G8_WAIT_L
#undef G8_BAR
#undef G8_SCHED
#undef G8_AOFF
#endif
}
}

#ifdef EMU
typedef const Params* ParamsPtr;
#else
typedef const __attribute__((address_space(4))) Params* ParamsPtr;
#endif
struct Frame {
    ParamsPtr P; unsigned char* ws; unsigned char* smem; int tid, lane, wave;
    __device__ __forceinline__ const float* in(int i) const { return P->in[i]; }
    __device__ __forceinline__ float* xrow(int row) const { return row < TL ? P->out + (size_t)row * D : (float*)(ws + WS_XC) + (size_t)(row - TL) * D; }
    __device__ __forceinline__ const float* xrow_in(int layer, int row) const {
        if (layer == 0) return row < TL ? in(I_X) + (size_t)row * D : in(I_CTX) + (size_t)(row - TL) * D;
        return xrow(row);
    }
};
__device__ __forceinline__ int row_mod(int row) { return row < TL ? row / SEQ : NB; }
__device__ __forceinline__ const float* modp(const Frame& F, int layer, int m, int chunk) { return (const float*)(F.ws + WS_MOD) + ((size_t)(layer * 5 + m) * 6 + chunk) * D; }


#ifndef EMU
#define XB_TMO      128
#define XB_XCNT(j)  (256  + 64 * (j))
#define XB_XSUB(j)  (1280 + 64 * (j))
#define XB_XGEN(j)  (2304 + 64 * (j))
#define XB_TOP      3328
#define XB_TOPGEN   3392
#define XCD_BAR_WORDS 3456
#define XB_SPIN_CAP (1u << 26)
#define LAS __attribute__((address_space(3)))
static_assert((CW_BAR + XCD_BAR_WORDS) * 4 <= CTL_BYTES, "control region");
__device__ __forceinline__ unsigned xb_ld(unsigned* p)              { return __hip_atomic_load(p, __ATOMIC_RELAXED, __HIP_MEMORY_SCOPE_AGENT); }
__device__ __forceinline__ unsigned xb_add(unsigned* p, unsigned v) { return __hip_atomic_fetch_add(p, v, __ATOMIC_RELAXED, __HIP_MEMORY_SCOPE_AGENT); }
__device__ __forceinline__ unsigned xb_xcc_id() { return (unsigned)__builtin_amdgcn_s_getreg((3 << 11) | 20) & 0xFu; }
#define XB_SPIN(cond, bar) do { unsigned _sp = 0; while (cond) { __builtin_amdgcn_s_sleep(1); \
    if ((++_sp & 255u) == 0u) { if (xb_ld(&(bar)[XB_TMO])) break; if (_sp > XB_SPIN_CAP) { atomicAdd(&(bar)[XB_TMO], 1u); break; } } } } while (0)
struct XcdBarrier { unsigned* bar; unsigned x; volatile LAS unsigned* st; };
__device__ __forceinline__ XcdBarrier xcd_barrier_post(unsigned* bar, volatile LAS unsigned* st) {
    XcdBarrier b; b.bar = bar; b.x = xb_xcc_id(); b.st = st;
    if (threadIdx.x == 0) (void)xb_add(&bar[XB_XCNT(b.x)], 1u);
    return b;
}
__device__ __forceinline__ void xcd_barrier_complete(unsigned* bar, unsigned x, unsigned& nloc, unsigned& nx) {
    const unsigned G = gridDim.x * gridDim.y * gridDim.z;
    unsigned sum, cnt, mine, sp = 0u;
    for (;;) {
        sum = 0u; cnt = 0u; mine = 0u;
#pragma unroll
        for (unsigned j = 0; j < 16; ++j) { const unsigned c = xb_ld(&bar[XB_XCNT(j)]); sum += c; cnt += (c > 0u) ? 1u : 0u; mine = (j == x) ? c : mine; }
        if (sum == G) break;
        __builtin_amdgcn_s_sleep(1);
        if ((++sp & 255u) == 0u) { if (xb_ld(&bar[XB_TMO])) break; if (sp > XB_SPIN_CAP) { atomicAdd(&bar[XB_TMO], 1u); break; } }
    }
    nloc = mine > 0u ? mine : 1u; nx = cnt > 0u ? cnt : 1u;
}
__device__ __forceinline__ void xcd_barrier(const XcdBarrier& b) {
    asm volatile("s_waitcnt vmcnt(0)" ::: "memory");
    __syncthreads();
    if (threadIdx.x == 0) {
        unsigned* bar = b.bar;
        __builtin_amdgcn_s_waitcnt(0);
        unsigned nloc = b.st[0], nx = b.st[1];
        if (nloc == 0u) { xcd_barrier_complete(bar, b.x, nloc, nx); b.st[0] = nloc; b.st[1] = nx; }
        const unsigned old = xb_add(&bar[XB_XSUB(b.x)], 1u);
        const unsigned gen = old / nloc;
        if (old + 1u == (gen + 1u) * nloc) {
            __builtin_amdgcn_fence(__ATOMIC_RELEASE, "agent");
            asm volatile("s_waitcnt vmcnt(0)" ::: "memory");
            const unsigned og = xb_add(&bar[XB_TOP], 1u);
            const unsigned tg = og / nx;
            if (og + 1u == (tg + 1u) * nx) xb_add(&bar[XB_TOPGEN], 1u);
            else XB_SPIN(xb_ld(&bar[XB_TOPGEN]) == tg, bar);
            __builtin_amdgcn_fence(__ATOMIC_ACQUIRE, "agent");
            xb_add(&bar[XB_XGEN(b.x)], 1u);
            asm volatile("s_waitcnt vmcnt(0)" ::: "memory");
        } else {
            XB_SPIN(xb_ld(&bar[XB_XGEN(b.x)]) == gen, bar);
            __builtin_amdgcn_fence(__ATOMIC_ACQUIRE, "agent");
            asm volatile("s_waitcnt vmcnt(0)" ::: "memory");
        }
    }
    __syncthreads();
}
#endif

__device__ __forceinline__ void item_twiddle(const Frame& F, int it) {
    cplx* tw = (cplx*)(F.ws + WS_TW);
    const int k = it * NT + F.tid;
    if (k < TWN) { float s, c; const float a = -6.283185307179586f * (float)k / (float)TWN; s = sinf(a); c = cosf(a); tw[k].x = c; tw[k].y = s; }
}
__device__ __forceinline__ void item_mod(const Frame& F, int it) {
    const int layer = it / (NMOD / 64), n0 = (it % (NMOD / 64)) * 64;
    float* sc = (float*)F.smem;
    float* red = sc + 5 * D;
    for (int i = F.tid; i < 5 * D; i += NT) { const int m = i / D, k = i % D; const float v = m < NB ? F.in(I_C)[m * D + k] : F.in(I_CCTX)[k]; sc[i] = siluf(v); }
    __syncthreads();
    const int j = F.tid & 63, ks = F.tid >> 6;
    const float* w = F.in(I_WMOD) + (size_t)layer * D * NMOD + n0 + j;
    float a[5] = {0, 0, 0, 0, 0};
#pragma unroll 1
    for (int k0 = ks * 128; k0 < ks * 128 + 128; k0 += 16) {
        float wv[16];
#pragma unroll
        for (int q = 0; q < 16; ++q) wv[q] = w[(size_t)(k0 + q) * NMOD];
#pragma unroll
        for (int q = 0; q < 16; ++q)
#pragma unroll
            for (int m = 0; m < 5; ++m) a[m] += sc[m * D + k0 + q] * wv[q]; }
#pragma unroll
    for (int m = 0; m < 5; ++m) red[(ks * 5 + m) * 64 + j] = a[m];
    __syncthreads();
    if (F.tid < 5 * 64) { const int m = F.tid / 64, jj = F.tid % 64; float s = 0; for (int q = 0; q < 8; ++q) s += red[(q * 5 + m) * 64 + jj];
        ((float*)(F.ws + WS_MOD))[(size_t)(layer * 5 + m) * NMOD + n0 + jj] = s + F.in(I_BMOD)[layer * NMOD + n0 + jj]; }
    __syncthreads();
}
__device__ __forceinline__ void item_filter(const Frame& F, int layer, int isctx, int tb) {
    const int L = isctx ? CTXL : SEQ;
    float* feats = (float*)F.smem;
    float* h1 = feats + 32 * 33;
    float* h2 = h1 + 32 * 64;
    const int t0 = tb * 32;
    for (int i = F.tid; i < 32 * 33; i += NT) {
        const int tt = i / 33, f = i % 33; const float t = (float)(t0 + tt);
        float v;
        if (f == 0) v = t / (float)(L - 1 > 1 ? L - 1 : 1);
        else { const int bi = (f - 1) & 15; const float band = 1e-4f + (float)bi * ((15.0f - 1e-4f) / 15.0f);
               const float ang = (6.283185307179586f / (float)L) * t * band; v = (f <= 16) ? cosf(ang) : -sinf(ang); }
        feats[i] = v;
    }
    __syncthreads();
    const float* w1 = F.in(I_HW1) + layer * 33 * 64; const float* b1 = F.in(I_HB1) + layer * 64;
    const float* w2 = F.in(I_HW2) + layer * 64 * 64; const float* b2 = F.in(I_HB2) + layer * 64;
    const float* fr = F.in(I_HFREQ) + layer * 64;
    for (int i = F.tid; i < 32 * 64; i += NT) { const int tt = i >> 6, j = i & 63; float s = b1[j]; for (int k = 0; k < 33; ++k) s += feats[tt * 33 + k] * w1[k * 64 + j]; h1[i] = sinf(fr[j] * s); }
    __syncthreads();
    for (int i = F.tid; i < 32 * 64; i += NT) { const int tt = i >> 6, j = i & 63; float s = b2[j]; for (int k = 0; k < 64; ++k) s += h1[tt * 64 + k] * w2[k * 64 + j]; h2[i] = sinf(fr[j] * s); }
    __syncthreads();
    const float* w3 = F.in(I_HW3) + (size_t)layer * 64 * 1024;
    const int c0 = F.tid * 2;
    float* ft = (float*)(F.ws + WS_FT) + (isctx ? (size_t)2 * 256 * 4 * SEQ : (size_t)layer * 256 * 4 * SEQ);
    for (int hf = 0; hf < 2; ++hf) {
        float acc[16][2];
        for (int tt = 0; tt < 16; ++tt) { acc[tt][0] = 0.f; acc[tt][1] = 0.f; }
#pragma unroll 4
        for (int k = 0; k < 64; ++k) { const float wa = w3[k * 1024 + c0], wb = w3[k * 1024 + c0 + 1];
#pragma unroll
            for (int tt = 0; tt < 16; ++tt) { const float hv = h2[(hf * 16 + tt) * 64 + k]; acc[tt][0] += hv * wa; acc[tt][1] += hv * wb; } }
#pragma unroll
        for (int q = 0; q < 2; ++q) {
            const int col = c0 + q, dir = col >> 9, order = (col >> 8) & 1, c = col & 255;
            const float dec = fabsf(F.in(I_HDEC)[((layer * 2 + dir) * 2 + order) * 256 + c]);
            float* dst = ft + ((size_t)(c * 2 + order) * 2 + dir) * L + t0 + hf * 16;
#pragma unroll
            for (int tt = 0; tt < 16; ++tt) { const float tu = (float)(t0 + hf * 16 + tt) / (float)(L - 1 > 1 ? L - 1 : 1); dst[tt] = acc[tt][q] * expf(-tu * dec); }
        }
    }
    __syncthreads();
}
__device__ __forceinline__ void item_transpose(const Frame& F, const float* src, int ldn, int nvalid, half_t* dst, int K, int k0, int n0) {
    float* tile = (float*)F.smem;
    f32x4 v[8];
#pragma unroll
    for (int q = 0; q < 8; ++q) { const int i = F.tid + q * NT, r = i >> 6, c4 = (i & 63) * 4;
        if (n0 + c4 + 3 < nvalid) v[q] = *(const f32x4*)(src + (size_t)(k0 + r) * ldn + n0 + c4);
        else {
#pragma unroll
            for (int e = 0; e < 4; ++e) v[q][e] = (n0 + c4 + e < nvalid) ? src[(size_t)(k0 + r) * ldn + n0 + c4 + e] : 0.f; } }
#pragma unroll
    for (int q = 0; q < 8; ++q) { const int i = F.tid + q * NT, r = i >> 6, c4 = (i & 63) * 4; *(f32x4*)(tile + r * 260 + c4) = v[q]; }
    __syncthreads();
#pragma unroll
    for (int q = 0; q < 4; ++q) { const int i = F.tid + q * NT, n = i >> 3, kc = (i & 7) * 8; half8 h;
#pragma unroll
        for (int e = 0; e < 8; ++e) h[e] = (half_t)tile[(kc + e) * 260 + n];
        *(half8*)(dst + (size_t)(n0 + n) * K + k0 + kc) = h; }
    __syncthreads();
}
__device__ __forceinline__ void item_router_w(const Frame& F, int layer) {
    half_t* dst = (half_t*)(F.ws + WS_WR) + (size_t)layer * 2 * 48 * D;
#pragma unroll 4
    for (int i = F.tid; i < 32 * D; i += NT) {
        const int k = i >> 5, c = i & 31; const float w = F.in(I_ERW)[(size_t)layer * D * 32 + i];
        const half_t hi = (half_t)w; dst[(size_t)(4 + c) * D + k] = hi; dst[(size_t)(48 + 4 + c) * D + k] = (half_t)((w - (float)hi) * 2048.f); }
#pragma unroll 4
    for (int i = F.tid; i < 4 * D; i += NT) {
        const int k = i >> 2, c = i & 3; const float w = F.in(I_GRW)[(size_t)layer * D * 4 + i];
        const half_t hi = (half_t)w; dst[(size_t)c * D + k] = hi; dst[(size_t)(48 + c) * D + k] = (half_t)((w - (float)hi) * 2048.f); }
#pragma unroll 4
    for (int i = F.tid; i < 12 * D; i += NT) { dst[(size_t)36 * D + i] = (half_t)0.f; dst[(size_t)(48 + 36) * D + i] = (half_t)0.f; }
}
constexpr int IT_TW = (TWN + NT - 1) / NT;
constexpr int IT_MOD = 2 * (NMOD / 64);
constexpr int IT_FILT = 2 * (SEQ / 32) + (CTXL / 32);
constexpr int IT_TWIN = 2 * 16 * (NINP / 256);
constexpr int IT_TWOUT = 2 * 16 * 4;
constexpr int IT_TMOE = 32 * 48;
__device__ __forceinline__ void moe_transpose_item(const Frame& F, int layer, int it) {
    const int e = it / 48, r = it % 48, which = r / 16, t = r % 16;
    half_t* base = (half_t*)(F.ws + WS_WMOE) + (size_t)e * 3 * 262144;
    if (which < 2) {
        const float* src = F.in(which == 0 ? I_MG : I_MU) + ((size_t)layer * 32 + e) * 262144;
        item_transpose(F, src, 256, 256, base + which * 262144, 1024, t * 64, 0);
    } else {
        const float* src = F.in(I_MD) + ((size_t)layer * 32 + e) * 262144;
        item_transpose(F, src, 1024, 1024, base + 2 * 262144, 256, (t >> 2) * 64, (t & 3) * 256);
    }
}
__device__ __forceinline__ void phase_setup(const Frame& F) {
    if (blockIdx.x == 0 && F.tid < 128) ((unsigned*)(F.ws + WS_CTL))[CW_CNT + F.tid] = 0u;
    const int G = gridDim.x; int rot = blockIdx.x;
    for (int i = rot; i < IT_MOD; i += G) item_mod(F, i);
    rot = (rot + G - (IT_MOD % G)) % G;
    for (int i = rot; i < IT_TWIN; i += G) { const int layer = i / (16 * (NINP / 256)), r = i % (16 * (NINP / 256));
        item_transpose(F, F.in(I_WIN) + (size_t)layer * D * NIN, NIN, NIN, (half_t*)(F.ws + WS_WIN) + (size_t)layer * NINP * D, D, (r / (NINP / 256)) * 64, (r % (NINP / 256)) * 256); }
    rot = (rot + G - (IT_TWIN % G)) % G;
    for (int i = rot; i < IT_FILT; i += G) { if (i < 2 * (SEQ / 32)) item_filter(F, i / (SEQ / 32), 0, i % (SEQ / 32)); else item_filter(F, 0, 1, i - 2 * (SEQ / 32)); }
    rot = (rot + G - (IT_FILT % G)) % G;
    for (int i = rot; i < IT_TWOUT; i += G) { const int layer = i / 64, r = i % 64;
        item_transpose(F, F.in(I_WOUT) + (size_t)layer * D * D, D, D, (half_t*)(F.ws + WS_WOUT) + (size_t)layer * D * D, D, (r >> 2) * 64, (r & 3) * 256); }
    rot = (rot + G - (IT_TWOUT % G)) % G;
    for (int i = rot; i < IT_TW; i += G) item_twiddle(F, i);
    rot = (rot + G - (IT_TW % G)) % G;
    for (int i = rot; i < 2; i += G) item_router_w(F, i);
}

__device__ __forceinline__ void norm1_rows4(const Frame& F, int layer, int row0) {
    half_t* xn = (half_t*)(F.ws + WS_XN);
    const int m = row_mod(row0), lane = F.lane;
    f32x4 v[4][4];
#pragma unroll
    for (int r = 0; r < 4; ++r) { const float* x = F.xrow_in(layer, row0 + r);
#pragma unroll
        for (int q = 0; q < 4; ++q) v[r][q] = *(const f32x4*)(x + q * 256 + lane * 4); }
    const float* nw = F.in(I_N1W) + layer * D; const float* sh = modp(F, layer, m, 0); const float* scl = modp(F, layer, m, 1);
    f32x4 g[4], s4[4];
#pragma unroll
    for (int q = 0; q < 4; ++q) { const int k = q * 256 + lane * 4; const f32x4 a = *(const f32x4*)(nw + k), b = *(const f32x4*)(scl + k); s4[q] = *(const f32x4*)(sh + k);
#pragma unroll
        for (int e = 0; e < 4; ++e) g[q][e] = a[e] * (1.0f + b[e]); }
#pragma unroll
    for (int r = 0; r < 4; ++r) {
        float ss = 0.f;
#pragma unroll
        for (int q = 0; q < 4; ++q) ss += v[r][q][0] * v[r][q][0] + v[r][q][1] * v[r][q][1] + v[r][q][2] * v[r][q][2] + v[r][q][3] * v[r][q][3];
        ss = wave_sum(ss);
        const float rs = 1.0f / sqrtf(ss * (1.0f / D) + EPSF);
        const int row = row0 + r; int srow = row;
        if (layer == 1 && row < TL) { const int b = row / SEQ, l = row % SEQ; srow = b * SEQ + (l % GW) * GROWS + l / GW; }
#pragma unroll
        for (int q = 0; q < 4; ++q) { const int k = q * 256 + lane * 4; half4 h;
#pragma unroll
            for (int e = 0; e < 4; ++e) h[e] = (half_t)(v[r][q][e] * rs * g[q][e] + s4[q][e]);
            *(half4*)(xn + (size_t)srow * D + k) = h; }
    }
}
__device__ __forceinline__ void phase_norm1(const Frame& F, int layer) {
    for (int it = blockIdx.x; it < TT / 32; it += gridDim.x) norm1_rows4(F, layer, it * 32 + F.wave * 4);
}

struct EpiInproj {
    half_t* u16; float* ug; half_t* hyt; half_t* halo;
    __device__ __forceinline__ void operator()(const f32x4 (&acc)[2][2][4][2], const g8::Unit& u, int wr, int wc, int fr, int fq) const {
#pragma unroll
        for (int ai = 0; ai < 2; ++ai)
#pragma unroll
            for (int m = 0; m < 4; ++m) {
                const int row = u.pm * 256 + ai * 128 + wr * 64 + m * 16 + fr;
#pragma unroll
                for (int bj = 0; bj < 2; ++bj)
#pragma unroll
                    for (int n = 0; n < 2; ++n) {
                        const int c0 = u.pn * 256 + bj * 128 + wc * 32 + n * 16 + 4 * fq; const f32x4 v = acc[ai][bj][m][n];
                        const bool edge = (fr == 0) || (fr == 15);
                        if (c0 < 1024) { *(half4*)(u16 + (size_t)row * UW + c0) = to_half4(v);
                            if (edge && c0 >= 384) *(half4*)(halo + ((size_t)(row >> 4) * 2 + (fr == 15)) * 1408 + (c0 - 384)) = to_half4(v); }
                        else if (c0 < 1036) *(f32x4*)(ug + (size_t)row * UGW + (c0 - 1024)) = v;
                        else if (c0 < 1804) { const int ch = c0 - 1036;
                            half_t* dst = row < TL ? hyt + ((size_t)(row / SEQ) * 768 + ch) * SEQ + row % SEQ : hyt + (size_t)NB * 768 * SEQ + ((size_t)((row - TL) / CTXL) * 768 + ch) * CTXL + (row - TL) % CTXL;
                            const size_t st = row < TL ? SEQ : CTXL;
#pragma unroll
                            for (int i = 0; i < 4; ++i) dst[i * st] = (half_t)v[i]; }
                        else if (c0 < 3340) { const int uc = c0 - 1804 + 1024; *(half4*)(u16 + (size_t)row * UW + uc) = to_half4(v);
                            if (edge && uc < 1792) *(half4*)(halo + ((size_t)(row >> 4) * 2 + (fr == 15)) * 1408 + (uc - 384)) = to_half4(v); }
                        else if (c0 < NIN) *(f32x4*)(ug + (size_t)row * UGW + 12 + (c0 - 3340)) = v;
                    }
            }
    }
};
__device__ __forceinline__ void phase_inproj(const Frame& F, int layer) {
    g8::DenseSched S; S.abase = (const char*)(F.ws + WS_XN); S.bbase = (const char*)((const half_t*)(F.ws + WS_WIN) + (size_t)layer * NINP * D); S.K = D; S.nM = TT / 256; S.nN = NINP / 256; S.G = gridDim.x; S.c = blockIdx.x;
    EpiInproj E{(half_t*)(F.ws + WS_U16), (float*)(F.ws + WS_UG), (half_t*)(F.ws + WS_HYT), (half_t*)(F.ws + WS_HALO)};
    g8::gemm_phase(F.smem, D, S, E);
}


__device__ __forceinline__ void phase_act(const Frame& F, int layer) {
    half_t* u16 = (half_t*)(F.ws + WS_U16); const half_t* halo = (const half_t*)(F.ws + WS_HALO);
    const int tid = F.tid, g = tid % 176, hf = tid / 176;
    const bool active = tid < 352;
    const bool isml = g >= 80; const int ch = isml ? (g - 80) * 8 : g * 8, C = isml ? 768 : 640;
    const float* cw = isml ? F.in(I_MCW) + layer * 3 * 768 : F.in(I_SCW) + layer * 3 * 640; const float* cb = isml ? F.in(I_MCB) + layer * 768 : F.in(I_SCB) + layer * 640;
    const float osc = (isml && ch >= 384) ? 0.125f : 1.0f;
    float w0[8], w1[8], w2[8], wb[8];
#pragma unroll
    for (int i = 0; i < 8; ++i) { const int cc = active ? ch + i : 0; w0[i] = cw[cc]; w1[i] = cw[C + cc]; w2[i] = cw[2 * C + cc]; wb[i] = cb[cc]; }
    for (int it = blockIdx.x; it < TT / 16; it += gridDim.x) {
        const int rb = it * 16, r0 = rb + hf * 8;
        const bool isl = rb < TL; const int L = isl ? SEQ : CTXL; const int pos0 = (isl ? rb : rb - TL) % L;
        half8 rr[10]; half8 zz;
#pragma unroll
        for (int i = 0; i < 8; ++i) zz[i] = (half_t)0.f;
        if (active) {
            const size_t col = 384 + g * 8;
#pragma unroll
            for (int k = 0; k < 8; ++k) rr[k + 1] = *(const half8*)(u16 + (size_t)(r0 + k) * UW + col);
            if (hf == 0) { rr[0] = pos0 > 0 ? *(const half8*)(halo + ((size_t)(it - 1) * 2 + 1) * 1408 + g * 8) : zz; rr[9] = *(const half8*)(u16 + (size_t)(rb + 8) * UW + col); }
            else { rr[0] = *(const half8*)(u16 + (size_t)(rb + 7) * UW + col); rr[9] = pos0 + 16 < L ? *(const half8*)(halo + ((size_t)(it + 1) * 2 + 0) * 1408 + g * 8) : zz; }
        }
        half8 o[8];
        if (active) {
#pragma unroll
            for (int k = 0; k < 8; ++k)
#pragma unroll
                for (int i = 0; i < 8; ++i) o[k][i] = (half_t)(osc * fsilu(w0[i] * (float)rr[k][i] + w1[i] * (float)rr[k + 1][i] + w2[i] * (float)rr[k + 2][i] + wb[i]));
        }
        __syncthreads();
        if (active) {
#pragma unroll
            for (int k = 0; k < 8; ++k) *(half8*)(u16 + (size_t)(r0 + k) * UW + 384 + g * 8) = o[k];
        }
    }
}

constexpr int SA = 72, SB = 136;

__device__ __forceinline__ void load_rows8(const half_t* u16, int rowbase, int Lseq, int dir, int jj0, int ucol, half8 (&rr)[8]) {
#pragma unroll
    for (int k = 0; k < 8; ++k) { const int jj = jj0 + k, pos = dir == 0 ? jj : Lseq - 1 - jj; rr[k] = *(const half8*)(u16 + (size_t)(rowbase + pos) * UW + ucol); }
}
__device__ __forceinline__ void transpose8(const half8 (&rr)[8], half8 (&t)[8]) {
#pragma unroll
    for (int i = 0; i < 8; ++i)
#pragma unroll
        for (int k = 0; k < 8; ++k) t[i][k] = rr[k][i];
}
__device__ __forceinline__ void ssd_block(const Frame& F, int layer, int b, int h, int dir) {
    half_t* Cs = (half_t*)F.smem;
    half_t* Bs = Cs + 128 * SA;
    half_t* BT = Bs + 128 * SA;
    half_t* XT = BT + 64 * SB;
    half_t* SC = XT + 64 * SB;
    half_t* ST = SC + 128 * SB;
    float* cum = (float*)(ST + 64 * SA);
    float* dtv = cum + 128;
    float* wes = dtv + 128;
    const half_t* u16 = (const half_t*)(F.ws + WS_U16); const float* ug = (const float*)(F.ws + WS_UG);
    half_t* yout = (half_t*)(F.ws + WS_YF) + (size_t)dir * TT * 384;
    const float* cw = F.in(I_SCW) + layer * 3 * 640; const float* cb = F.in(I_SCB) + layer * 640;
    const float dtb = F.in(I_DTB)[(layer * 2 + dir) * 6 + h];
    const float Aneg = -expf(F.in(I_ALOG)[(layer * 2 + dir) * 6 + h]);
    const float Dh = F.in(I_SD)[layer * 6 + h];
    const int g = h / 3, tid = F.tid, lane = F.lane, wave = F.wave;
    const int kind = tid >> 7, c8 = (tid & 7) * 8, j0 = ((tid >> 3) & 15) * 8;
    const int ch = kind == 0 ? h * 64 + c8 : (kind == 1 ? 384 + g * 64 + c8 : 512 + g * 64 + c8);
    f32x4 accS[1][2]; zero_acc(accS);
    for (int i = tid; i < 64 * SA; i += NT) ST[i] = (half_t)0.f;
    constexpr int NC0 = CTXL / 128, NCT = NC0 + SEQ / 128;
    half8 rr[8]; float ug0 = 0.f, ug1 = 0.f;
    if (kind < 3) load_rows8(u16, TL + b * CTXL, CTXL, dir, j0, 384 + ch, rr);
    if (wave == 7) { const int p0 = dir == 0 ? 2 * lane : CTXL - 1 - 2 * lane, p1 = dir == 0 ? p0 + 1 : p0 - 1;
        ug0 = ug[(size_t)(TL + b * CTXL + p0) * UGW + dir * 6 + h]; ug1 = ug[(size_t)(TL + b * CTXL + p1) * UGW + dir * 6 + h]; }
    __syncthreads();
    for (int cc = 0; cc < NCT; ++cc) {
        const int seg = cc >= NC0 ? 1 : 0, c = seg ? cc - NC0 : cc;
        const int Lseq = seg == 0 ? CTXL : SEQ, rowbase = seg == 0 ? TL + b * CTXL : b * SEQ;
        const bool want_y = (seg == 1) || (layer == 0);
        const int nseg = (cc + 1) >= NC0 ? 1 : 0, ncn = nseg ? cc + 1 - NC0 : cc + 1, nL = nseg == 0 ? CTXL : SEQ, nrb = nseg == 0 ? TL + b * CTXL : b * SEQ;
        if (wave == 7) {
            const float dt0 = softplusf_(ug0 + dtb), dt1 = softplusf_(ug1 + dtb);
            const float a0 = dt0 * Aneg, a1 = dt1 * Aneg;
            const float incl = wave_scan_sum(a0 + a1, lane);
            const float c1 = incl, c0 = incl - a1;
            const float cl = __shfl(incl, 63);
            cum[2 * lane] = c0; cum[2 * lane + 1] = c1; dtv[2 * lane] = dt0; dtv[2 * lane + 1] = dt1;
            wes[2 * lane] = dt0 * fexp(cl - c0); wes[2 * lane + 1] = dt1 * fexp(cl - c1);
            if (cc + 1 < NCT) { const int pi = ncn * 128 + 2 * lane, p0 = dir == 0 ? pi : nL - 1 - pi, p1 = dir == 0 ? p0 + 1 : p0 - 1;
                ug0 = ug[(size_t)(nrb + p0) * UGW + dir * 6 + h]; ug1 = ug[(size_t)(nrb + p1) * UGW + dir * 6 + h]; }
        }
        if (kind < 3) {
            if (kind == 0) { half8 t[8]; transpose8(rr, t);
#pragma unroll
                for (int i = 0; i < 8; ++i) *(half8*)(XT + (c8 + i) * SB + j0) = t[i];
            } else if (kind == 1) { half8 t[8]; transpose8(rr, t);
#pragma unroll
                for (int k = 0; k < 8; ++k) *(half8*)(Bs + (j0 + k) * SA + c8) = rr[k];
#pragma unroll
                for (int i = 0; i < 8; ++i) *(half8*)(BT + (c8 + i) * SB + j0) = t[i];
            } else {
#pragma unroll
                for (int k = 0; k < 8; ++k) *(half8*)(Cs + (j0 + k) * SA + c8) = rr[k];
            }
            if (cc + 1 < NCT) load_rows8(u16, nrb, nL, dir, ncn * 128 + j0, 384 + ch, rr);
        }
        __syncthreads();
        const float cl = cum[127];
        if (want_y) {
            { const int ws_ = wave & 1, wl = wave >> 1;
              if (!(ws_ == 1 && wl < 2)) {
                f32x4 g_[4][2]; zero_acc(g_);
                mma_lds<4, 2>(g_, Bs + ws_ * 64 * SA, SA, Cs + wl * 32 * SA, SA, 2, lane);
#pragma unroll
                for (int a = 0; a < 4; ++a) {
                    const int s0 = ws_ * 64 + a * 16 + (lane >> 4) * 4;
                    const f32x4 cs4 = *(const f32x4*)(cum + s0), dt4 = *(const f32x4*)(dtv + s0);
#pragma unroll
                    for (int q = 0; q < 2; ++q) {
                        const int l = wl * 32 + q * 16 + (lane & 15); const float cl_ = cum[l]; half4 hv;
#pragma unroll
                        for (int i = 0; i < 4; ++i) hv[i] = (half_t)((s0 + i) <= l ? g_[a][q][i] * fexp(cl_ - cs4[i]) * dt4[i] : 0.f);
                        *(half4*)(SC + l * SB + s0) = hv;
                    } }
              } }
            f32x4 y1[4][1]; zero_acc(y1);
            mma_lds<4, 1>(y1, ST, SA, Cs + wave * 16 * SA, SA, 2, lane);
            __syncthreads();
            f32x4 y2[4][1]; zero_acc(y2);
            mma_lds<4, 1>(y2, XT, SB, SC + wave * 16 * SB, SB, wave / 2 + 1, lane);
            { const int l = wave * 16 + (lane & 15); const float el = fexp(cum[l]);
              const int pi = c * 128 + l, pos = dir == 0 ? pi : Lseq - 1 - pi;
#pragma unroll
              for (int a = 0; a < 4; ++a) { const int p0 = a * 16 + (lane >> 4) * 4; f32x4 y;
#pragma unroll
                  for (int i = 0; i < 4; ++i) y[i] = y1[a][0][i] * el + y2[a][0][i];
                  if (dir == 0) {
#pragma unroll
                      for (int i = 0; i < 4; ++i) y[i] += Dh * (float)XT[(p0 + i) * SB + l]; }
                  *(half4*)(yout + (size_t)(rowbase + pos) * 384 + h * 64 + p0) = to_half4(y); } }
        }
        { const float dec = fexp(cl);
#pragma unroll
          for (int q = 0; q < 2; ++q) accS[0][q] *= dec;
          const int r = lane & 15, kq = (lane >> 4) * 8;
#pragma unroll
          for (int ks = 0; ks < 4; ++ks) {
              const half8 a = *(const half8*)(BT + ((wave >> 1) * 16 + r) * SB + ks * 32 + kq);
              const f32x4 e0 = *(const f32x4*)(wes + ks * 32 + kq), e1 = *(const f32x4*)(wes + ks * 32 + kq + 4);
#pragma unroll
              for (int q = 0; q < 2; ++q) { half8 bb = *(const half8*)(XT + ((wave & 1) * 32 + q * 16 + r) * SB + ks * 32 + kq);
#pragma unroll
                  for (int i = 0; i < 4; ++i) { bb[i] = (half_t)((float)bb[i] * e0[i]); bb[4 + i] = (half_t)((float)bb[4 + i] * e1[i]); }
                  accS[0][q] = mfma16(a, bb, accS[0][q]); } } }
        __syncthreads();
#pragma unroll
        for (int q = 0; q < 2; ++q) { const int p = (wave & 1) * 32 + q * 16 + (lane & 15), n0 = (wave >> 1) * 16 + (lane >> 4) * 4; *(half4*)(ST + p * SA + n0) = to_half4(accS[0][q]); }
    }
    __syncthreads();
}

__device__ __forceinline__ void mlstm_block(const Frame& F, int layer, int b, int h, int dir) {
    half_t* Qs = (half_t*)F.smem;
    half_t* Ks = Qs + 128 * SA;
    half_t* KT = Ks + 128 * SA;
    half_t* VT = KT + 64 * SB;
    half_t* SC = VT + 64 * SB;
    half_t* CS = SC + 128 * SB;
    float* ig = (float*)(CS + 64 * SA);
    float* cumf = ig + 128; float* gsv = cumf + 128; float* mtv = gsv + 128; float* ee = mtv + 128; float* dn = ee + 128;
    float* nvec = dn + 128;
    float* scal = nvec + 64;
    const half_t* u16 = (const half_t*)(F.ws + WS_U16); const float* ug = (const float*)(F.ws + WS_UG);
    half_t* hout = (half_t*)(F.ws + WS_YF) + (size_t)(2 + dir) * TT * 384;
    const float* cw = F.in(I_MCW) + layer * 3 * 768; const float* cb = F.in(I_MCB) + layer * 768;
    const float bi = F.in(I_MGB)[((layer * 2 + dir) * 2 + 0) * 6 + h], bf = F.in(I_MGB)[((layer * 2 + dir) * 2 + 1) * 6 + h];
    const int tid = F.tid, lane = F.lane, wave = F.wave;
    const int kind = tid >> 7, c8 = (tid & 7) * 8, j0 = ((tid >> 3) & 15) * 8;
    const int ch = kind == 0 ? h * 64 + c8 : 384 + h * 64 + c8;
    f32x4 accC[1][2]; zero_acc(accC);
    float m_in = 0.f;
    for (int i = tid; i < 64 * SA; i += NT) CS[i] = (half_t)0.f;
    if (tid < 64) nvec[tid] = 0.f;
    constexpr int NC0 = CTXL / 128, NCT = NC0 + SEQ / 128;
    half8 rr[8]; float gi0 = 0.f, gi1 = 0.f, gf0 = 0.f, gf1 = 0.f;
    const int ucol = kind == 2 ? 1792 + h * 64 + c8 : 1024 + ch;
    if (kind < 3) load_rows8(u16, TL + b * CTXL, CTXL, dir, j0, ucol, rr);
    if (wave == 7) { const int p0 = dir == 0 ? 2 * lane : CTXL - 1 - 2 * lane, p1 = dir == 0 ? p0 + 1 : p0 - 1;
        const float* g0 = ug + (size_t)(TL + b * CTXL + p0) * UGW + 12 + dir * 12; const float* g1 = ug + (size_t)(TL + b * CTXL + p1) * UGW + 12 + dir * 12;
        gi0 = g0[h]; gf0 = g0[6 + h]; gi1 = g1[h]; gf1 = g1[6 + h]; }
    half8 ones;
#pragma unroll
    for (int i = 0; i < 8; ++i) ones[i] = (half_t)1.0f;
    __syncthreads();
    for (int cc = 0; cc < NCT; ++cc) {
        const int seg = cc >= NC0 ? 1 : 0, c = seg ? cc - NC0 : cc;
        const int Lseq = seg == 0 ? CTXL : SEQ, rowbase = seg == 0 ? TL + b * CTXL : b * SEQ;
        const bool want_y = (seg == 1) || (layer == 0);
        const int nseg = (cc + 1) >= NC0 ? 1 : 0, ncn = nseg ? cc + 1 - NC0 : cc + 1, nL = nseg == 0 ? CTXL : SEQ, nrb = nseg == 0 ? TL + b * CTXL : b * SEQ;
        if (wave == 7) {
            const float i0 = gi0 + bi, i1 = gi1 + bi, lf0 = logsigmoidf_(gf0 + bf), lf1 = logsigmoidf_(gf1 + bf);
            const float incl = wave_scan_sum(lf0 + lf1, lane);
            const float c1 = incl, c0 = incl - lf1;
            const float tot = __shfl(incl, 63);
            const float r0 = i0 - c0, r1 = i1 - c1;
            const float pincl = wave_scan_max(fmaxf(r0, r1), lane);
            float pexcl = __shfl_up(pincl, 1); if (lane == 0) pexcl = -3.0e38f;
            const float pm0 = fmaxf(pexcl, r0), pm1 = pincl;
            const float pmlast = __shfl(pincl, 63);
            const float m_new = fmaxf(tot + m_in, tot + pmlast);
            ig[2 * lane] = i0; ig[2 * lane + 1] = i1; cumf[2 * lane] = c0; cumf[2 * lane + 1] = c1; gsv[2 * lane] = r0; gsv[2 * lane + 1] = r1;
            mtv[2 * lane] = fmaxf(c0 + m_in, c0 + pm0); mtv[2 * lane + 1] = fmaxf(c1 + m_in, c1 + pm1);
            ee[2 * lane] = fexp(r0 + tot - m_new); ee[2 * lane + 1] = fexp(r1 + tot - m_new);
            if (lane == 0) { scal[0] = tot; scal[1] = m_new; }
            if (cc + 1 < NCT) { const int pi = ncn * 128 + 2 * lane, p0 = dir == 0 ? pi : nL - 1 - pi, p1 = dir == 0 ? p0 + 1 : p0 - 1;
                const float* g0 = ug + (size_t)(nrb + p0) * UGW + 12 + dir * 12; const float* g1 = ug + (size_t)(nrb + p1) * UGW + 12 + dir * 12;
                gi0 = g0[h]; gf0 = g0[6 + h]; gi1 = g1[h]; gf1 = g1[6 + h]; }
        }
        if (kind == 0) {
#pragma unroll
            for (int k = 0; k < 8; ++k) *(half8*)(Qs + (j0 + k) * SA + c8) = rr[k];
        } else if (kind == 1) { half8 t[8]; transpose8(rr, t);
#pragma unroll
            for (int k = 0; k < 8; ++k) *(half8*)(Ks + (j0 + k) * SA + c8) = rr[k];
#pragma unroll
            for (int i = 0; i < 8; ++i) *(half8*)(KT + (c8 + i) * SB + j0) = t[i];
        } else if (kind == 2) { half8 t[8]; transpose8(rr, t);
#pragma unroll
            for (int i = 0; i < 8; ++i) *(half8*)(VT + (c8 + i) * SB + j0) = t[i];
        }
        if (kind < 3 && cc + 1 < NCT) load_rows8(u16, nrb, nL, dir, ncn * 128 + j0, ucol, rr);
        __syncthreads();
        const float tot = scal[0], m_new = scal[1];
        if (want_y) {
            { const int ws_ = wave & 1, wl = wave >> 1;
              if (!(ws_ == 1 && wl < 2)) {
                f32x4 g_[4][2]; zero_acc(g_);
                mma_lds<4, 2>(g_, Ks + ws_ * 64 * SA, SA, Qs + wl * 32 * SA, SA, 2, lane);
#pragma unroll
                for (int a = 0; a < 4; ++a) {
                    const int s0 = ws_ * 64 + a * 16 + (lane >> 4) * 4; const f32x4 gs4 = *(const f32x4*)(gsv + s0);
#pragma unroll
                    for (int q = 0; q < 2; ++q) {
                        const int l = wl * 32 + q * 16 + (lane & 15); const float cm = cumf[l] - mtv[l]; half4 hv;
#pragma unroll
                        for (int i = 0; i < 4; ++i) hv[i] = (half_t)((s0 + i) <= l ? g_[a][q][i] * fexp(cm + gs4[i]) : 0.f);
                        *(half4*)(SC + l * SB + s0) = hv;
                    } }
              } }
            f32x4 h1[4][1]; zero_acc(h1);
            mma_lds<4, 1>(h1, CS, SA, Qs + wave * 16 * SA, SA, 2, lane);
            if (tid < 128) { float s = 0.f;
#pragma unroll
                for (int d8 = 0; d8 < 8; ++d8) { const half8 qv = *(const half8*)(Qs + tid * SA + d8 * 8); const f32x4 n0 = *(const f32x4*)(nvec + d8 * 8), n1 = *(const f32x4*)(nvec + d8 * 8 + 4);
#pragma unroll
                    for (int i = 0; i < 4; ++i) s += (float)qv[i] * n0[i] + (float)qv[4 + i] * n1[i]; }
                dn[tid] = s * fexp(cumf[tid] + m_in - mtv[tid]); }
            __syncthreads();
            f32x4 h2[4]; f32x4 d1 = {0.f, 0.f, 0.f, 0.f};
#pragma unroll
            for (int a = 0; a < 4; ++a) h2[a] = (f32x4){0.f, 0.f, 0.f, 0.f};
            { const int r = lane & 15, kq = (lane >> 4) * 8;
              for (int ks = 0; ks < wave / 2 + 1; ++ks) {
                  const half8 bfr = *(const half8*)(SC + (wave * 16 + r) * SB + ks * 32 + kq);
#pragma unroll
                  for (int a = 0; a < 4; ++a) { const half8 afr = *(const half8*)(VT + (a * 16 + r) * SB + ks * 32 + kq); h2[a] = mfma16(afr, bfr, h2[a]); }
                  d1 = mfma16(ones, bfr, d1); } }
            { const int l = wave * 16 + (lane & 15); const float ai = fexp(cumf[l] + m_in - mtv[l]); const float rden = 1.0f / fmaxf(fabsf(dn[l] + d1[0]), fexp(-mtv[l]));
              const int pi = c * 128 + l, pos = dir == 0 ? pi : Lseq - 1 - pi;
#pragma unroll
              for (int a = 0; a < 4; ++a) { const int v0 = a * 16 + (lane >> 4) * 4; f32x4 y;
#pragma unroll
                  for (int i = 0; i < 4; ++i) y[i] = (h1[a][0][i] * ai + h2[a][i]) * rden;
                  *(half4*)(hout + (size_t)(rowbase + pos) * 384 + h * 64 + v0) = to_half4(y); } }
        }
        { const float sc = fexp(tot + m_in - m_new);
#pragma unroll
          for (int q = 0; q < 2; ++q) accC[0][q] *= sc;
          { const int r = lane & 15, kq = (lane >> 4) * 8;
#pragma unroll
            for (int ks = 0; ks < 4; ++ks) {
              const half8 a = *(const half8*)(KT + ((wave >> 1) * 16 + r) * SB + ks * 32 + kq);
              const f32x4 e0 = *(const f32x4*)(ee + ks * 32 + kq), e1 = *(const f32x4*)(ee + ks * 32 + kq + 4);
#pragma unroll
              for (int q = 0; q < 2; ++q) { half8 bb = *(const half8*)(VT + ((wave & 1) * 32 + q * 16 + r) * SB + ks * 32 + kq);
#pragma unroll
                  for (int i = 0; i < 4; ++i) { bb[i] = (half_t)((float)bb[i] * e0[i]); bb[4 + i] = (half_t)((float)bb[4 + i] * e1[i]); }
                  accC[0][q] = mfma16(a, bb, accC[0][q]); } } }
          if (tid < 64) { float s = 0.f;
#pragma unroll 4
              for (int k8 = 0; k8 < 16; ++k8) { const half8 kv = *(const half8*)(KT + tid * SB + k8 * 8); const f32x4 e0 = *(const f32x4*)(ee + k8 * 8), e1 = *(const f32x4*)(ee + k8 * 8 + 4);
#pragma unroll
                  for (int i = 0; i < 4; ++i) s += e0[i] * (float)kv[i] + e1[i] * (float)kv[4 + i]; }
              nvec[tid] = sc * nvec[tid] + s; } }
        m_in = m_new;
        __syncthreads();
#pragma unroll
        for (int q = 0; q < 2; ++q) { const int v = (wave & 1) * 32 + q * 16 + (lane & 15), d0 = (wave >> 1) * 16 + (lane >> 4) * 4; *(half4*)(CS + v * SA + d0) = to_half4(accC[0][q]); }
    }
    __syncthreads();
}

__device__ __forceinline__ cplx cmul(cplx a, cplx b) { return cplx{a.x * b.x - a.y * b.y, a.x * b.y + a.y * b.x}; }
__device__ __forceinline__ cplx cadd(cplx a, cplx b) { return cplx{a.x + b.x, a.y + b.y}; }
__device__ __forceinline__ cplx csub(cplx a, cplx b) { return cplx{a.x - b.x, a.y - b.y}; }
__device__ __forceinline__ void sincos_turns(float x, float& s, float& c) {
#ifdef EMU
    s = sinf(6.283185307179586f * x); c = cosf(6.283185307179586f * x);
#else
    s = __builtin_amdgcn_sinf(x); c = __builtin_amdgcn_cosf(x);
#endif
}
#define PADI(i) ((i) + ((i) >> 5))
template <bool INV> __device__ __forceinline__ void r4(cplx& a0, cplx& a1, cplx& a2, cplx& a3) {
    const cplx t0 = cadd(a0, a2), t1 = csub(a0, a2), t2 = cadd(a1, a3), t3 = csub(a1, a3);
    a0 = cadd(t0, t2); a2 = csub(t0, t2);
    if (!INV) { a1 = cplx{t1.x + t3.y, t1.y - t3.x}; a3 = cplx{t1.x - t3.y, t1.y + t3.x}; }
    else      { a1 = cplx{t1.x - t3.y, t1.y + t3.x}; a3 = cplx{t1.x + t3.y, t1.y - t3.x}; }
}
template <bool INV> __device__ __forceinline__ void fft16(cplx (&v)[16]) {
#pragma unroll
    for (int l0 = 0; l0 < 4; ++l0) r4<INV>(v[l0], v[l0 + 4], v[l0 + 8], v[l0 + 12]);
    const float C1 = 0.9238795325112867f, S1 = 0.3826834323650898f, C2 = 0.7071067811865476f;
    const float sg = INV ? 1.f : -1.f;
#define TWM(idx, cr, ci) v[idx] = cmul(v[idx], cplx{(cr), sg * (ci)})
    TWM(1 + 4 * 1, C1, S1); TWM(2 + 4 * 1, C2, C2); TWM(3 + 4 * 1, S1, C1);
    TWM(1 + 4 * 2, C2, C2); TWM(2 + 4 * 2, 0.f, 1.f); TWM(3 + 4 * 2, -C2, C2);
    TWM(1 + 4 * 3, S1, C1); TWM(2 + 4 * 3, -C2, C2); TWM(3 + 4 * 3, -C1, -S1);
#undef TWM
    cplx o[16];
#pragma unroll
    for (int m0 = 0; m0 < 4; ++m0) { cplx a0 = v[4 * m0], a1 = v[4 * m0 + 1], a2 = v[4 * m0 + 2], a3 = v[4 * m0 + 3]; r4<INV>(a0, a1, a2, a3);
        o[m0] = a0; o[m0 + 4] = a1; o[m0 + 8] = a2; o[m0 + 12] = a3; }
#pragma unroll
    for (int i = 0; i < 16; ++i) v[i] = o[i];
}
__device__ __forceinline__ void twpow(cplx w1, cplx (&w)[16]) {
    w[1] = w1; w[2] = cmul(w1, w1); w[3] = cmul(w[2], w1); w[4] = cmul(w[2], w[2]); w[5] = cmul(w[4], w1); w[6] = cmul(w[4], w[2]); w[7] = cmul(w[4], w[3]); w[8] = cmul(w[4], w[4]);
#pragma unroll
    for (int m = 9; m < 16; ++m) w[m] = cmul(w[8], w[m - 8]);
}
__device__ __forceinline__ void fft_fwd16(cplx* buf, int N, int tid) {
    for (int n = N; n >= 32; n >>= 4) { const int q = n >> 4;
        for (int i = tid; i < N / 16; i += NT) {
            const int blk = i / q, j = i - blk * q, base = blk * n + j;
            cplx v[16];
#pragma unroll
            for (int l = 0; l < 16; ++l) v[l] = buf[PADI(base + l * q)];
            fft16<false>(v);
            float s, c; sincos_turns(-(float)j / (float)n, s, c);
            cplx w[16]; twpow(cplx{c, s}, w);
            buf[PADI(base)] = v[0];
#pragma unroll
            for (int m = 1; m < 16; ++m) buf[PADI(base + m * q)] = cmul(v[m], w[m]);
        }
        __syncthreads(); }
}
__device__ __forceinline__ void fft_inv16(cplx* buf, int N, int tid) {
    for (int n = 32; n <= N; n <<= 4) { const int q = n >> 4;
        for (int i = tid; i < N / 16; i += NT) {
            const int blk = i / q, j = i - blk * q, base = blk * n + j;
            float s, c; sincos_turns((float)j / (float)n, s, c);
            cplx w[16]; twpow(cplx{c, s}, w);
            cplx v[16];
            v[0] = buf[PADI(base)];
#pragma unroll
            for (int m = 1; m < 16; ++m) v[m] = cmul(buf[PADI(base + m * q)], w[m]);
            fft16<true>(v);
#pragma unroll
            for (int l = 0; l < 16; ++l) buf[PADI(base + l * q)] = v[l];
        }
        __syncthreads(); }
}
static_assert(2 * SEQ == 512 || 2 * SEQ == 8192 || 2 * SEQ == 131072, "FFT size must be 2*16^k");
static_assert(2 * CTXL == 512 || 2 * CTXL == 8192, "FFT size must be 2*16^k");
constexpr int HBUF = (2 * SEQ + (2 * SEQ) / 32 + 8);
__device__ __forceinline__ void hy_conv8(const half_t* p, int t0, int L, float w0, float w1, float w2, float bsv, float (&o)[8]) {
    const half8 m = *(const half8*)(p + t0);
    float e[10]; e[0] = t0 > 0 ? (float)p[t0 - 1] : 0.f; e[9] = t0 + 8 < L ? (float)p[t0 + 8] : 0.f;
#pragma unroll
    for (int i = 0; i < 8; ++i) e[i + 1] = (float)m[i];
#pragma unroll
    for (int i = 0; i < 8; ++i) o[i] = w0 * e[i] + w1 * e[i + 1] + w2 * e[i + 2] + bsv;
}
__device__ __forceinline__ void hyena_channel(const Frame& F, int layer, int c) {
    cplx* bufA = (cplx*)F.smem;
    cplx* bufH = bufA + HBUF;
    float* red = (float*)(bufH + HBUF);
    const int tid = F.tid;
    const float* cwp = F.in(I_HCW) + layer * 3 * 768; const float* cbp = F.in(I_HCB) + layer * 768;
    for (int seg = 0; seg < (layer == 0 ? 2 : 1); ++seg) {
        const int L = seg == 0 ? SEQ : CTXL, N = 2 * L;
        const half_t* hyt = (const half_t*)(F.ws + WS_HYT) + (seg == 0 ? 0 : (size_t)NB * 768 * SEQ);
        float* z1 = (float*)(F.ws + WS_XN) + (seg == 0 ? 0 : (size_t)NB * 256 * SEQ);
        float* yht = (float*)(F.ws + WS_YHT) + (seg == 0 ? 0 : (size_t)NB * 256 * SEQ);
        const float* ft = (const float*)(F.ws + WS_FT) + (seg == 0 ? (size_t)layer * 256 * 4 * SEQ : (size_t)2 * 256 * 4 * SEQ);
        for (int order = 0; order < 2; ++order) {
            const float* hfw = ft + ((size_t)(c * 2 + order) * 2 + 0) * L; const float* hbw = ft + ((size_t)(c * 2 + order) * 2 + 1) * L;
            float asum = 0.f;
            for (int i = tid; i < N; i += NT) { const float v = i < L ? hfw[i] : (i == L ? 0.f : hbw[N - i]); bufH[PADI(i)] = cplx{v, 0.f}; asum += fabsf(v); }
            asum = wave_sum(asum);
            if (F.lane == 0) red[F.wave] = asum;
            __syncthreads();
            float tot = 0.f; for (int w = 0; w < NT / 64; ++w) tot += red[w];
            const float scale = 1.0f / (tot * (float)N);
            fft_fwd16(bufH, N, tid);
            for (int i = tid; i < N / 2; i += NT) { const cplx a = bufH[PADI(2 * i)], b_ = bufH[PADI(2 * i + 1)]; const cplx s = cadd(a, b_), d = csub(a, b_);
                bufH[PADI(2 * i)] = cplx{s.x * scale, s.y * scale}; bufH[PADI(2 * i + 1)] = cplx{d.x * scale, d.y * scale}; }
            __syncthreads();
            const int gch = 256 * (order + 1) + c;
            const float gw0 = cwp[gch], gw1 = cwp[768 + gch], gw2 = cwp[1536 + gch], gb = cbp[gch];
            const float vw0 = cwp[c], vw1 = cwp[768 + c], vw2 = cwp[1536 + c], vb = cbp[c];
            const float skip = F.in(I_HSKIP)[(layer * 2 + order) * 256 + c];
            for (int pr = 0; pr < NB / 2; ++pr) {
                const int b0 = 2 * pr, b1 = b0 + 1;
                const half_t* v0p = hyt + ((size_t)b0 * 768 + c) * L; const half_t* v1p = hyt + ((size_t)b1 * 768 + c) * L;
                const float* z0q = z1 + ((size_t)b0 * 256 + c) * L; const float* z1q = z1 + ((size_t)b1 * 256 + c) * L;
                for (int t0 = tid * 8; t0 < N; t0 += NT * 8) {
                    if (t0 < L) { float za[8], zb[8];
                        if (order == 0) { hy_conv8(v0p, t0, L, vw0, vw1, vw2, vb, za); hy_conv8(v1p, t0, L, vw0, vw1, vw2, vb, zb); }
                        else {
#pragma unroll
                            for (int i = 0; i < 8; ++i) { za[i] = z0q[t0 + i]; zb[i] = z1q[t0 + i]; } }
#pragma unroll
                        for (int i = 0; i < 8; ++i) bufA[PADI(t0 + i)] = cplx{za[i], zb[i]}; }
                    else {
#pragma unroll
                        for (int i = 0; i < 8; ++i) bufA[PADI(t0 + i)] = cplx{0.f, 0.f}; }
                }
                __syncthreads();
                fft_fwd16(bufA, N, tid);
                for (int i = tid; i < N / 2; i += NT) { const cplx a = bufA[PADI(2 * i)], b_ = bufA[PADI(2 * i + 1)];
                    const cplx s = cmul(cadd(a, b_), bufH[PADI(2 * i)]), d = cmul(csub(a, b_), bufH[PADI(2 * i + 1)]);
                    bufA[PADI(2 * i)] = cadd(s, d); bufA[PADI(2 * i + 1)] = csub(s, d); }
                __syncthreads();
                fft_inv16(bufA, N, tid);
                const half_t* g0p = hyt + ((size_t)b0 * 768 + gch) * L; const half_t* g1p = hyt + ((size_t)b1 * 768 + gch) * L;
                float* d0 = (order == 0 ? z1 : yht) + ((size_t)b0 * 256 + c) * L; float* d1 = (order == 0 ? z1 : yht) + ((size_t)b1 * 256 + c) * L;
                for (int t0 = tid * 8; t0 < L; t0 += NT * 8) {
                    float za[8], zb[8], ga[8], gb_[8];
                    if (order == 0) { hy_conv8(v0p, t0, L, vw0, vw1, vw2, vb, za); hy_conv8(v1p, t0, L, vw0, vw1, vw2, vb, zb); }
                    else {
#pragma unroll
                        for (int i = 0; i < 8; ++i) { za[i] = z0q[t0 + i]; zb[i] = z1q[t0 + i]; } }
                    hy_conv8(g0p, t0, L, gw0, gw1, gw2, gb, ga); hy_conv8(g1p, t0, L, gw0, gw1, gw2, gb, gb_);
                    f32x4 oa[2], ob[2];
#pragma unroll
                    for (int i = 0; i < 8; ++i) { const cplx y = bufA[PADI(t0 + i)]; oa[i >> 2][i & 3] = ga[i] * (y.x + skip * za[i]); ob[i >> 2][i & 3] = gb_[i] * (y.y + skip * zb[i]); }
                    *(f32x4*)(d0 + t0) = oa[0]; *(f32x4*)(d0 + t0 + 4) = oa[1]; *(f32x4*)(d1 + t0) = ob[0]; *(f32x4*)(d1 + t0 + 4) = ob[1];
                }
                __syncthreads();
            }
        }
    }
}
__device__ __forceinline__ void phase_mixers(const Frame& F, int layer) {
    const int G = gridDim.x, bid = blockIdx.x;
    constexpr int NSCAN = 2 * NB * 6 * 2;
    if (bid < NSCAN) {
        const int k = bid >> 1, kind = bid & 1, dir = k % 2, h = (k / 2) % 6, b = k / 12;
#ifndef MIXMASK
#define MIXMASK 7
#endif
        if (kind == 0) { if (MIXMASK & 1) ssd_block(F, layer, b, h, dir); } else { if (MIXMASK & 2) mlstm_block(F, layer, b, h, dir); }
    } else {
        for (int c = bid - NSCAN; c < 256; c += G - NSCAN) if (MIXMASK & 4) hyena_channel(F, layer, c);
        { const int hb = bid - NSCAN, nhb = G - NSCAN, first1 = 256 - nhb > 0 ? 256 - nhb : 0, n1 = nhb - first1;
          if (n1 > 0) { if (hb >= first1) for (int it = hb - first1; it < IT_TMOE; it += n1) moe_transpose_item(F, layer, it); }
          else for (int it = hb; it < IT_TMOE; it += nhb) moe_transpose_item(F, layer, it); }
    }
}

__device__ __forceinline__ void phase_combine(const Frame& F, int layer) {
    const int nrows = layer == 0 ? TT : TL, total = nrows / 32;
    const half_t* u16 = (const half_t*)(F.ws + WS_U16);
    const half_t* yf = (const half_t*)(F.ws + WS_YF); const half_t* yb = yf + (size_t)TT * 384; const half_t* hf = yb + (size_t)TT * 384; const half_t* hb = hf + (size_t)TT * 384;
    half_t* yl = (half_t*)(F.ws + WS_XN);
    const float* snw = F.in(I_SNW) + layer * 384; const float* mnw = F.in(I_MNW) + layer * 384;
    const int lane = F.lane, k8 = (lane < 48 ? lane : 0) * 8;
    f32x4 sw[2], mw[2];
#pragma unroll
    for (int q = 0; q < 2; ++q) { sw[q] = *(const f32x4*)(snw + k8 + q * 4); mw[q] = *(const f32x4*)(mnw + k8 + q * 4); }
    for (int it = blockIdx.x; it < total; it += gridDim.x) {
        const int row0 = it * 32, rw = row0 + F.wave * 4;
        half8 a[4][6];
#pragma unroll
        for (int r = 0; r < 4; ++r) { const size_t ro = (size_t)(rw + r);
            a[r][0] = *(const half8*)(yf + ro * 384 + k8); a[r][1] = *(const half8*)(yb + ro * 384 + k8); a[r][2] = *(const half8*)(u16 + ro * UW + k8);
            a[r][3] = *(const half8*)(hf + ro * 384 + k8); a[r][4] = *(const half8*)(hb + ro * 384 + k8); a[r][5] = *(const half8*)(u16 + ro * UW + 2176 + k8); }
#pragma unroll
        for (int r = 0; r < 4; ++r) {
            const size_t ro = (size_t)(rw + r);
            float g[8], hv[8]; float ss = 0.f, hs = 0.f;
#pragma unroll
            for (int i = 0; i < 8; ++i) { g[i] = ((float)a[r][0][i] + (float)a[r][1][i]) * fsilu((float)a[r][2][i]); ss += g[i] * g[i]; hv[i] = (float)a[r][3][i] + (float)a[r][4][i]; hs += hv[i]; }
            if (lane >= 48) ss = 0.f;
            ss = wave_sum(ss);
            hs += __shfl_xor(hs, 1); hs += __shfl_xor(hs, 2); hs += __shfl_xor(hs, 4);
            const float mu = hs * (1.0f / 64.f);
            float vs = 0.f;
#pragma unroll
            for (int i = 0; i < 8; ++i) { hv[i] -= mu; vs += hv[i] * hv[i]; }
            vs += __shfl_xor(vs, 1); vs += __shfl_xor(vs, 2); vs += __shfl_xor(vs, 4);
            const float rs = 1.0f / sqrtf(ss * (1.0f / 384.f) + EPSF), rstd = 1.0f / sqrtf(vs * (1.0f / 64.f) + EPSF);
            if (lane < 48) { half8 o1, o2;
#pragma unroll
                for (int i = 0; i < 8; ++i) { o1[i] = (half_t)(g[i] * rs * sw[i >> 2][i & 3]); o2[i] = (half_t)(hv[i] * rstd * mw[i >> 2][i & 3] / (1.0f + fexp(-(float)a[r][5][i]))); }
                *(half8*)(yl + ro * D + k8) = o1; *(half8*)(yl + ro * D + 640 + k8) = o2; }
        }
        { const bool isl = row0 < TL; const int L = isl ? SEQ : CTXL; const int rc = isl ? row0 : row0 - TL; const int b = rc / L, t0 = rc % L;
          const float* yht = (const float*)(F.ws + WS_YHT) + (isl ? 0 : (size_t)NB * 256 * SEQ);
          if (F.tid < 256) { const int c = F.tid; const float* src = yht + ((size_t)b * 256 + c) * L + t0;
              f32x4 v[8];
#pragma unroll
              for (int q = 0; q < 8; ++q) v[q] = *(const f32x4*)(src + q * 4);
#pragma unroll
              for (int i = 0; i < 32; ++i) yl[(size_t)(row0 + i) * D + 384 + c] = (half_t)v[i >> 2][i & 3]; } }
    }
}

struct EpiOutproj {
    Frame F; int layer;
    __device__ __forceinline__ void operator()(const f32x4 (&acc)[2][2][4][2], const g8::Unit& u, int wr, int wc, int fr, int fq) const {
#pragma unroll
        for (int ai = 0; ai < 2; ++ai)
#pragma unroll
            for (int m = 0; m < 4; ++m) {
                const int srow = u.pm * 256 + ai * 128 + wr * 64 + m * 16 + fr;
                int row = srow;
                if (layer == 1 && srow < TL) { const int b = srow / SEQ, s = srow % SEQ; row = b * SEQ + (s % GROWS) * GW + s / GROWS; }
                const float* g1 = modp(F, layer, row_mod(row), 2);
                const float* xi = F.xrow_in(layer, row); float* xo = F.xrow(row);
#pragma unroll
                for (int bj = 0; bj < 2; ++bj)
#pragma unroll
                    for (int n = 0; n < 2; ++n) { const int c0 = u.pn * 256 + bj * 128 + wc * 32 + n * 16 + 4 * fq;
                        const f32x4 xv = *(const f32x4*)(xi + c0), gv = *(const f32x4*)(g1 + c0);
                        *(f32x4*)(xo + c0) = xv + gv * acc[ai][bj][m][n]; }
            }
    }
};
__device__ __forceinline__ void phase_outproj(const Frame& F, int layer) {
    const int nrows = layer == 0 ? TT : TL;
    g8::DenseSched S; S.abase = (const char*)(F.ws + WS_XN); S.bbase = (const char*)((const half_t*)(F.ws + WS_WOUT) + (size_t)layer * D * D); S.K = D; S.nM = nrows / 256; S.nN = D / 256; S.G = gridDim.x; S.c = blockIdx.x;
    EpiOutproj E{F, layer};
    g8::gemm_phase(F.smem, D, S, E);
}

constexpr int RLD = D + 8;
__device__ __forceinline__ void phase_router(const Frame& F, int layer, bool dry = false) {
    const int nrows = layer == 0 ? TT : TL, total = nrows / 32;
    half_t* Th = (half_t*)F.smem;
    half_t* Tl = Th + 32 * RLD;
    float* LG = (float*)(Tl + 32 * RLD);
    half_t* tb = (half_t*)(F.ws + WS_XN);
    unsigned* cnt = (unsigned*)(F.ws + WS_CTL) + CW_CNT + layer * 64;
    int* list = (int*)(F.ws + WS_LIST); float* pw = (float*)(F.ws + WS_PW);
    const float* nw = F.in(I_N2W) + layer * D;
    const half_t* wr = (const half_t*)(F.ws + WS_WR) + (size_t)layer * 2 * 48 * D;
    for (int it = blockIdx.x; it < total; it += gridDim.x) {
        const int row0 = it * 32;
        {
            const int r4 = F.wave * 4, m = row_mod(row0), lane = F.lane;
            f32x4 v[4][4];
#pragma unroll
            for (int r = 0; r < 4; ++r) { const float* x = F.xrow(row0 + r4 + r);
#pragma unroll
                for (int q = 0; q < 4; ++q) v[r][q] = *(const f32x4*)(x + q * 256 + lane * 4); }
            const float* sh = modp(F, layer, m, 3); const float* scl = modp(F, layer, m, 4);
            f32x4 g[4], s4[4];
#pragma unroll
            for (int q = 0; q < 4; ++q) { const int k = q * 256 + lane * 4; const f32x4 a = *(const f32x4*)(nw + k), b = *(const f32x4*)(scl + k); s4[q] = *(const f32x4*)(sh + k);
#pragma unroll
                for (int e = 0; e < 4; ++e) g[q][e] = a[e] * (1.0f + b[e]); }
#pragma unroll
            for (int r = 0; r < 4; ++r) {
                float ss = 0.f;
#pragma unroll
                for (int q = 0; q < 4; ++q) ss += v[r][q][0] * v[r][q][0] + v[r][q][1] * v[r][q][1] + v[r][q][2] * v[r][q][2] + v[r][q][3] * v[r][q][3];
                ss = wave_sum(ss);
                const float rs = 1.0f / sqrtf(ss * (1.0f / D) + EPSF);
                const int rr = r4 + r, row = row0 + rr;
#pragma unroll
                for (int q = 0; q < 4; ++q) { const int k = q * 256 + lane * 4; half4 h, l;
#pragma unroll
                    for (int e = 0; e < 4; ++e) { const float tv = v[r][q][e] * rs * g[q][e] + s4[q][e]; h[e] = (half_t)tv; l[e] = (half_t)((tv - (float)h[e]) * 2048.f); }
                    *(half4*)(tb + (size_t)row * D + k) = h; *(half4*)(Th + rr * RLD + k) = h; *(half4*)(Tl + rr * RLD + k) = l; }
            }
        }
        __syncthreads();
        {
            const int kb = F.wave * 128, r = F.lane & 15, kq = (F.lane >> 4) * 8;
            f32x4 ah[2][3], al[2][3]; zero_acc(ah); zero_acc(al);
#pragma unroll
            for (int hf = 0; hf < 2; ++hf) {
                half8 bh[3][2], bl[3][2];
#pragma unroll
                for (int nt = 0; nt < 3; ++nt)
#pragma unroll
                    for (int ks = 0; ks < 2; ++ks) { const size_t o = (size_t)(nt * 16 + r) * D + kb + (hf * 2 + ks) * 32 + kq; bh[nt][ks] = *(const half8*)(wr + o); bl[nt][ks] = *(const half8*)(wr + (size_t)48 * D + o); }
#pragma unroll
                for (int ks = 0; ks < 2; ++ks)
#pragma unroll
                    for (int mt = 0; mt < 2; ++mt) {
                        const half8 a_h = *(const half8*)(Th + (mt * 16 + r) * RLD + kb + (hf * 2 + ks) * 32 + kq), a_l = *(const half8*)(Tl + (mt * 16 + r) * RLD + kb + (hf * 2 + ks) * 32 + kq);
#pragma unroll
                        for (int nt = 0; nt < 3; ++nt) { ah[mt][nt] = mfma16(a_h, bh[nt][ks], ah[mt][nt]); al[mt][nt] = mfma16(a_l, bh[nt][ks], al[mt][nt]); al[mt][nt] = mfma16(a_h, bl[nt][ks], al[mt][nt]); }
                    }
            }
            __syncthreads();
            float* PART = (float*)Th;
#pragma unroll
            for (int mt = 0; mt < 2; ++mt)
#pragma unroll
                for (int nt = 0; nt < 3; ++nt)
#pragma unroll
                    for (int i = 0; i < 4; ++i) PART[(F.wave * 32 + mt * 16 + (F.lane >> 4) * 4 + i) * 48 + nt * 16 + r] = ah[mt][nt][i] + al[mt][nt][i] * (1.0f / 2048.f);
            __syncthreads();
            for (int o = F.tid; o < 32 * 48; o += NT) { const int col = o % 48; float sum = 0.f;
#pragma unroll
                for (int w = 0; w < 8; ++w) sum += PART[w * 32 * 48 + o];
                float bias = 0.f; if (col < 4) bias = F.in(I_GRB)[layer * 4 + col]; else if (col < 36) bias = F.in(I_ERB)[layer * 32 + col - 4];
                LG[o] = sum + bias; }
        }
        __syncthreads();
        if (F.tid < 32) {
            const int row = row0 + F.tid; const float* lg = LG + F.tid * 48;
            int gi = 0; float gm = lg[0];
            for (int q = 1; q < 4; ++q) if (lg[q] > gm) { gm = lg[q]; gi = q; }
            float gs = 0.f; for (int q = 0; q < 4; ++q) gs += expf(lg[q] - gm);
            const float grp_p = 1.0f / gs;
            const float* el = lg + 4 + gi * 8;
            int i0 = 0; float e0 = el[0];
            for (int q = 1; q < 8; ++q) if (el[q] > e0) { e0 = el[q]; i0 = q; }
            int i1 = -1; float e1 = -3.0e38f;
            for (int q = 0; q < 8; ++q) if (q != i0 && el[q] > e1) { e1 = el[q]; i1 = q; }
            const float p1 = expf(e1 - e0);
            const float w0 = grp_p * (1.0f / (1.0f + p1)), w1 = grp_p * (p1 / (1.0f + p1));
            const int ea = gi * 8 + i0, eb = gi * 8 + i1;
            if (!dry) { const unsigned pa = atomicAdd(&cnt[ea * 2 + 0], 1u), pb = atomicAdd(&cnt[eb * 2 + 1], 1u);
            list[(size_t)(ea * 2 + 0) * LCAP + pa] = row * 2 + 0; list[(size_t)(eb * 2 + 1) * LCAP + pb] = row * 2 + 1;
            pw[row * 2 + 0] = w0; pw[row * 2 + 1] = w1; } else if (w0 == 1234.5f) pw[row * 2] = w1;
        }
        __syncthreads();
    }
}

constexpr int MOE_PRE_OFF = g8::STAGE_BYTES;
struct MoeSchedA {
    const char* abase; const char* wbase; const int* pre; const unsigned* cnt; const int* list; int G, c;
    __device__ __forceinline__ int entry(const g8::Unit& u, int r) const { const int rc = r < u.n ? r : 0; return rc < u.c0 ? list[(size_t)(u.e * 2) * LCAP + rc] : list[(size_t)(u.e * 2 + 1) * LCAP + (rc - u.c0)]; }
    __device__ __forceinline__ bool next(int i, g8::Unit& u) const {
        const int L = i * G + c; if (L >= pre[32]) return false;
        int e = 0; while (L >= pre[e + 1]) ++e;
        const int loc = L - pre[e]; u.e = e; u.c0 = (int)cnt[e * 2]; u.n = u.c0 + (int)cnt[e * 2 + 1]; u.pm = loc >> 1; u.pn = loc & 1; return true;
    }
    __device__ __forceinline__ unsigned a_off(const g8::Unit& u, int r) const { return (unsigned)(entry(u, u.pm * 256 + r) >> 1) * (unsigned)(D * 2); }
    __device__ __forceinline__ const char* b_half(const g8::Unit& u, int h) const { return wbase + ((size_t)u.e * 3 * 262144 + (size_t)h * 262144 + (size_t)u.pn * 128 * D) * 2; }
};
struct EpiMoeA {
    MoeSchedA S; const float* pw; half_t* hid;
    __device__ __forceinline__ void operator()(const f32x4 (&acc)[2][2][4][2], const g8::Unit& u, int wr, int wc, int fr, int fq) const {
        int pid[8]; float w[8];
#pragma unroll
        for (int g = 0; g < 8; ++g) pid[g] = S.entry(u, u.pm * 256 + (g >> 2) * 128 + wr * 64 + (g & 3) * 16 + fr);
#pragma unroll
        for (int g = 0; g < 8; ++g) w[g] = pw[pid[g]];
#pragma unroll
        for (int ai = 0; ai < 2; ++ai)
#pragma unroll
            for (int m = 0; m < 4; ++m) {
                const int rr = u.pm * 256 + ai * 128 + wr * 64 + m * 16 + fr;
                if (rr < u.n) {
#pragma unroll
                    for (int n = 0; n < 2; ++n) { const int f = u.pn * 128 + wc * 32 + n * 16 + 4 * fq; const f32x4 g = acc[ai][0][m][n], up = acc[ai][1][m][n]; f32x4 o;
#pragma unroll
                        for (int i = 0; i < 4; ++i) o[i] = fsilu(g[i]) * up[i] * w[ai * 4 + m];
                        *(half4*)(hid + (size_t)pid[ai * 4 + m] * 256 + f) = to_half4(o); } }
            }
    }
};
__device__ __forceinline__ void phase_moe_a(const Frame& F, int layer) {
    int* pre = (int*)(F.smem + MOE_PRE_OFF);
    const unsigned* cnt = (const unsigned*)(F.ws + WS_CTL) + CW_CNT + layer * 64;
    if (F.tid == 0) { int s = 0; for (int e = 0; e < 32; ++e) { pre[e] = s; s += (((int)(cnt[e * 2] + cnt[e * 2 + 1]) + 255) / 256) * 2; } pre[32] = s; }
    __syncthreads();
    MoeSchedA S; S.abase = (const char*)(F.ws + WS_XN); S.wbase = (const char*)(F.ws + WS_WMOE); S.pre = pre; S.cnt = cnt; S.list = (const int*)(F.ws + WS_LIST); S.G = gridDim.x; S.c = blockIdx.x;
    EpiMoeA E{S, (const float*)(F.ws + WS_PW), (half_t*)(F.ws + WS_U16)};
    g8::gemm_phase(F.smem, D, S, E);
    __syncthreads();
}
struct MoeSchedB {
    const char* abase; const char* wbase; const int* pre; const unsigned* cnt; const int* list; int slot, G, c;
    __device__ __forceinline__ bool next(int i, g8::Unit& u) const {
        const int L = i * G + c; if (L >= pre[32]) return false;
        int e = 0; while (L >= pre[e + 1]) ++e;
        const int loc = L - pre[e]; u.e = e; u.n = (int)cnt[e * 2 + slot]; u.c0 = 0; u.pm = loc >> 2; u.pn = loc & 3; return true;
    }
    __device__ __forceinline__ int entry(const g8::Unit& u, int rr) const { return list[(size_t)(u.e * 2 + slot) * LCAP + (rr < u.n ? rr : 0)]; }
    __device__ __forceinline__ unsigned a_off(const g8::Unit& u, int r) const { return (unsigned)entry(u, u.pm * 256 + r) * 512u; }
    __device__ __forceinline__ const char* b_half(const g8::Unit& u, int h) const { return wbase + ((size_t)u.e * 3 * 262144 + 2 * 262144 + (size_t)(u.pn * 256 + h * 128) * 256) * 2; }
};
struct EpiMoeB {
    MoeSchedB S; Frame F; int layer;
    __device__ __forceinline__ void operator()(const f32x4 (&acc)[2][2][4][2], const g8::Unit& u, int wr, int wc, int fr, int fq) const {
        int row[8];
#pragma unroll
        for (int g = 0; g < 8; ++g) row[g] = S.entry(u, u.pm * 256 + (g >> 2) * 128 + wr * 64 + (g & 3) * 16 + fr) >> 1;
#pragma unroll
        for (int ai = 0; ai < 2; ++ai)
#pragma unroll
            for (int m = 0; m < 4; ++m) {
                const int rr = u.pm * 256 + ai * 128 + wr * 64 + m * 16 + fr;
                if (rr < u.n) { const int rw = row[ai * 4 + m]; float* xo = F.xrow(rw); const float* g5 = modp(F, layer, row_mod(rw), 5);
#pragma unroll
                    for (int bj = 0; bj < 2; ++bj)
#pragma unroll
                        for (int n = 0; n < 2; ++n) { const int d = u.pn * 256 + bj * 128 + wc * 32 + n * 16 + 4 * fq;
                            const f32x4 xv = *(const f32x4*)(xo + d), gv = *(const f32x4*)(g5 + d); *(f32x4*)(xo + d) = xv + gv * acc[ai][bj][m][n]; } }
            }
    }
};
__device__ __forceinline__ void phase_moe_b(const Frame& F, int layer, int slot) {
    int* pre = (int*)(F.smem + MOE_PRE_OFF);
    const unsigned* cnt = (const unsigned*)(F.ws + WS_CTL) + CW_CNT + layer * 64;
    if (F.tid == 0) { int s = 0; for (int e = 0; e < 32; ++e) { pre[e] = s; s += (((int)cnt[e * 2 + slot] + 255) / 256) * 4; } pre[32] = s; }
    __syncthreads();
    MoeSchedB S; S.abase = (const char*)(F.ws + WS_U16); S.wbase = (const char*)(F.ws + WS_WMOE); S.pre = pre; S.cnt = cnt; S.list = (const int*)(F.ws + WS_LIST); S.slot = slot; S.G = gridDim.x; S.c = blockIdx.x;
    EpiMoeB E{S, F, layer};
    g8::gemm_phase(F.smem, 256, S, E);
    __syncthreads();
}

__device__ __forceinline__ void phase_final(const Frame& F) {
    const float* fw = F.in(I_FNW);
    f32x4 w4[4];
#pragma unroll
    for (int q = 0; q < 4; ++q) w4[q] = *(const f32x4*)(fw + q * 256 + F.lane * 4);
    for (int it = blockIdx.x; it < TL / 32; it += gridDim.x) {
        float* x0 = F.P->out + (size_t)(it * 32 + F.wave * 4) * D;
        f32x4 v[4][4];
#pragma unroll
        for (int r = 0; r < 4; ++r)
#pragma unroll
            for (int q = 0; q < 4; ++q) v[r][q] = *(const f32x4*)(x0 + (size_t)r * D + q * 256 + F.lane * 4);
#pragma unroll
        for (int r = 0; r < 4; ++r) {
            float ss = 0.f;
#pragma unroll
            for (int q = 0; q < 4; ++q) ss += v[r][q][0] * v[r][q][0] + v[r][q][1] * v[r][q][1] + v[r][q][2] * v[r][q][2] + v[r][q][3] * v[r][q][3];
            ss = wave_sum(ss);
            const float rs = 1.0f / sqrtf(ss * (1.0f / D) + EPSF);
#pragma unroll
            for (int q = 0; q < 4; ++q) *(f32x4*)(x0 + (size_t)r * D + q * 256 + F.lane * 4) = v[r][q] * rs * w4[q];
        }
    }
}

constexpr int NPHASE = 1 + 2 * 10 + 1;
#ifndef ONLY
#define ONLY -1
#endif
#define EN(x) (ONLY < 0 || ONLY == (x))
__device__ __forceinline__ void run_phase(const Frame& F, int ph) {
    if (ph == 0) { if (EN(0)) phase_setup(F); return; }
    if (ph == NPHASE - 1) { if (EN(11)) phase_final(F); return; }
    const int layer = (ph - 1) / 10, k = (ph - 1) % 10;
    switch (k) {
        case 0: if (EN(1)) phase_norm1(F, layer); break;
        case 1: if (EN(2)) phase_inproj(F, layer); break;
        case 2: if (EN(10)) phase_act(F, layer); break;
        case 3: if (EN(3)) phase_mixers(F, layer); break;
        case 4: if (EN(4)) phase_combine(F, layer); break;
        case 5: if (EN(5)) phase_outproj(F, layer); break;
        case 6: if (EN(6)) phase_router(F, layer); break;
        case 7: if (EN(7)) phase_moe_a(F, layer); break;
        case 8: if (EN(8)) phase_moe_b(F, layer, 0); break;
        default: if (EN(9)) phase_moe_b(F, layer, 1); break;
    }
}

#ifdef EMU
void mega(const Params* Pp) {
    Frame F; F.P = Pp; F.ws = Pp->ws; F.smem = emu_blk->smem; F.tid = threadIdx.x; F.lane = F.tid & 63; F.wave = F.tid >> 6;
    for (int ph = Pp->ph_lo; ph < Pp->ph_hi; ++ph) { run_phase(F, ph); __syncthreads(); }
}
#else
__global__ void __launch_bounds__(NT) mega(Params P) {
    extern __shared__ __attribute__((aligned(16))) unsigned char smem_dyn[];
    cg::grid_group grid = cg::this_grid();
    Frame F; F.P = (ParamsPtr)__builtin_amdgcn_kernarg_segment_ptr(); F.ws = P.ws; F.smem = smem_dyn; F.tid = threadIdx.x; F.lane = F.tid & 63; F.wave = F.tid >> 6;
    volatile LAS unsigned* bst = (volatile LAS unsigned*)(smem_dyn + LDS_BYTES - 16);
    if (F.tid < 4) bst[F.tid] = 0u;
    __syncthreads();
    XcdBarrier xb = xcd_barrier_post((unsigned*)(P.ws + WS_CTL) + CW_BAR, bst);
    if (P.ph_lo < 0) grid.sync();
#define DUP -1
#define PHASE_STEP(i) if (P.ph_lo <= (i) && (i) < P.ph_hi) { run_phase(F, (i)); if (DUP == (i)) { xcd_barrier(xb); if (DUP == 6) phase_router(F, 0, true); else run_phase(F, (i)); } if ((i) + 1 < P.ph_hi) xcd_barrier(xb); }
    PHASE_STEP(0) PHASE_STEP(1) PHASE_STEP(2) PHASE_STEP(3) PHASE_STEP(4) PHASE_STEP(5) PHASE_STEP(6) PHASE_STEP(7) PHASE_STEP(8) PHASE_STEP(9)
    PHASE_STEP(10) PHASE_STEP(11) PHASE_STEP(12) PHASE_STEP(13) PHASE_STEP(14) PHASE_STEP(15) PHASE_STEP(16) PHASE_STEP(17) PHASE_STEP(18) PHASE_STEP(19)
    PHASE_STEP(20) PHASE_STEP(21)
    static_assert(NPHASE == 22, "phase list");
}

extern "C" void kernel_launch(void* const* d_in, const int* in_sizes, int n_in, void* d_out, int out_size, void* d_ws, size_t ws_size, hipStream_t stream) {
    static int grid_blocks = 0;
    if (grid_blocks == 0) {
        if (n_in != 38 || out_size != TL * D || ws_size < WS_END) { fprintf(stderr, "kernel_launch: unexpected shapes (n_in %d out %d ws %zu need %zu)\n", n_in, out_size, ws_size, (size_t)WS_END); grid_blocks = -1; return; }
        int dev = 0, cus = 0, per_cu = 0;
        hipGetDevice(&dev);
        hipDeviceGetAttribute(&cus, hipDeviceAttributeMultiprocessorCount, dev);
        hipFuncSetAttribute((const void*)mega, hipFuncAttributeMaxDynamicSharedMemorySize, LDS_BYTES);
        hipOccupancyMaxActiveBlocksPerMultiprocessor(&per_cu, (const void*)mega, NT, LDS_BYTES);
        if (per_cu < 1) { fprintf(stderr, "kernel_launch: occupancy query says 0 blocks per CU\n"); grid_blocks = -1; return; }
        grid_blocks = cus;
    }
    if (grid_blocks < 0) return;
    if (hipMemsetAsync((char*)d_ws + WS_CTL, 0, CTL_BYTES, stream) != hipSuccess) { fprintf(stderr, "kernel_launch: memset failed\n"); return; }
    Params p{};
    for (int i = 0; i < 38; ++i) p.in[i] = (const float*)d_in[i];
    p.out = (float*)d_out; p.ws = (unsigned char*)d_ws; p.ph_lo = 0; p.ph_hi = NPHASE;
    void* args[] = {&p};
    hipError_t e = hipLaunchCooperativeKernel((const void*)mega, dim3(grid_blocks), dim3(NT), args, LDS_BYTES, stream);
    if (e != hipSuccess) fprintf(stderr, "cooperative launch failed: %s (grid %d)\n", hipGetErrorString(e), grid_blocks);
}
#endif
```

```cpp
#ifdef EMU
#include "gpuemu.h"
#else
#include <hip/hip_runtime.h>
#include <hip/hip_cooperative_groups.h>
#include <cstdio>
namespace cg = cooperative_groups;
#endif
#include <stdint.h>

#ifndef CFG_B
#define CFG_B 4
#endif
#ifndef CFG_SEQ
#define CFG_SEQ 4096
#endif
#ifndef CFG_CTX
#define CFG_CTX 256
#endif

typedef _Float16 half_t;
typedef _Float16 half8 __attribute__((ext_vector_type(8)));
typedef _Float16 half4 __attribute__((ext_vector_type(4)));
typedef float f32x4 __attribute__((ext_vector_type(4)));
struct cplx { float x, y; };

constexpr int D = 1024, NB = CFG_B, SEQ = CFG_SEQ, CTXL = CFG_CTX, GW = 64, GROWS = SEQ / GW;
constexpr int TL = NB * SEQ, TC = NB * CTXL, TT = TL + TC;
constexpr int NIN = 3364, NINP = 3584;
constexpr int UW = 2560;
constexpr int UGW = 36;
constexpr int NT = 512;
constexpr int TWN = 2 * SEQ > 2 * CTXL ? 2 * SEQ : 2 * CTXL;
constexpr int NMOD = 6 * D;
constexpr int LCAP = TT;
constexpr float EPSF = 1e-6f;

constexpr size_t al256(size_t x) { return (x + 255) / 256 * 256; }
constexpr size_t WS_CTL    = 0;
constexpr size_t WS_MOD    = 65536;
constexpr size_t WS_TW     = WS_MOD + al256(sizeof(float) * 2 * 5 * NMOD);
constexpr size_t WS_WIN    = WS_TW + al256(sizeof(cplx) * TWN);
constexpr size_t WS_WOUT   = WS_WIN + al256(2ull * 2 * NINP * D);
constexpr size_t WS_WMOE   = WS_WOUT + al256(2ull * 2 * D * D);
constexpr size_t WS_XC     = WS_WMOE + al256(2ull * 32 * 3 * 262144);
constexpr size_t WS_XN     = WS_XC + al256(4ull * TC * D);
constexpr size_t WS_U16    = WS_XN + al256(2ull * TT * D);
constexpr size_t WS_UG     = WS_U16 + al256(2ull * TT * UW);
constexpr size_t WS_HYT    = WS_UG + al256(4ull * TT * UGW);
constexpr size_t WS_YF     = WS_HYT + al256(2ull * NB * 768 * (SEQ + CTXL));
constexpr size_t WS_YHT    = WS_YF + al256(2ull * 4 * TT * 384);
constexpr size_t WS_FT     = WS_YHT + al256(4ull * NB * 256 * (SEQ + CTXL));
constexpr size_t WS_LIST   = WS_FT + al256(4ull * (2 * 256 * 4 * SEQ + 256 * 4 * CTXL));
constexpr size_t WS_PW     = WS_LIST + al256(4ull * 64 * LCAP);
constexpr size_t WS_WR     = WS_PW + al256(4ull * TT * 2);
constexpr size_t WS_HALO   = WS_WR + al256(2ull * 2 * 2 * 48 * D);
constexpr size_t WS_END    = WS_HALO + al256(2ull * (TT / 16) * 2 * 1408);
static_assert(4ull * NB * 256 * (SEQ + CTXL) <= 2ull * TT * D, "Z1 scratch must fit in the XN region");
static_assert(2ull * TT * 2 * 256 <= 2ull * TT * UW, "HID must fit in the U16 region");
constexpr size_t XAB_OFF = 2ull * TT * 2 * 256;
static_assert(XAB_OFF + 2ull * 2 * TT * D <= 2ull * TT * UW, "HID + XA + XB must fit in the U16 region");

constexpr int CW_CNT = 8192;
constexpr int CSTR = 64;
constexpr int CW_QUE = 256;
constexpr int CW_BAR = 1024;
constexpr size_t CTL_BYTES = 65536;

constexpr int LDS_BYTES = 156 * 1024;

struct Params {
    const float* in[38];
    float* out;
    unsigned char* ws;
    int ph_lo, ph_hi;
};

enum { I_X = 0, I_C, I_CTX, I_CCTX, I_WMOD, I_BMOD, I_N1W, I_N2W, I_WIN, I_WOUT, I_SCW, I_SCB, I_DTB, I_ALOG, I_SD, I_SNW,
       I_HCW, I_HCB, I_HW1, I_HB1, I_HW2, I_HB2, I_HW3, I_HFREQ, I_HDEC, I_HSKIP, I_MCW, I_MCB, I_MGB, I_MNW,
       I_GRW, I_GRB, I_ERW, I_ERB, I_MG, I_MU, I_MD, I_FNW };

__device__ __forceinline__ float siluf(float x) { return x / (1.0f + expf(-x)); }
__device__ __forceinline__ float sigmoidf_(float x) { return 1.0f / (1.0f + expf(-x)); }
__device__ __forceinline__ float softplusf_(float x) { return x > 20.f ? x : log1pf(expf(x)); }
__device__ __forceinline__ float logsigmoidf_(float x) { return fminf(x, 0.f) - log1pf(expf(-fabsf(x))); }

__device__ __forceinline__ float fsoftplus(float x) {
#ifdef EMU
    return x > 20.f ? x : log1pf(expf(x));
#else
    const float e = __expf(x);
    return x > 20.f ? x : (e < 1e-3f ? e * (1.0f - 0.5f * e) : __logf(1.0f + e));
#endif
}
__device__ __forceinline__ float flogsigmoid(float x) { return fminf(x, 0.f) - fsoftplus(-fabsf(x)); }
__device__ __forceinline__ float fexp(float x) {
#ifdef EMU
    return expf(x);
#else
    return __expf(x);
#endif
}
__device__ __forceinline__ float fsilu(float x) {
#ifdef EMU
    return x / (1.0f + expf(-x));
#else
    return __fdividef(x, 1.0f + __expf(-x));
#endif
}
__device__ __forceinline__ float wave_sum(float v) {
#pragma unroll
    for (int m = 32; m >= 1; m >>= 1) v += __shfl_xor(v, m);
    return v;
}
__device__ __forceinline__ float wave_max(float v) {
#pragma unroll
    for (int m = 32; m >= 1; m >>= 1) v = fmaxf(v, __shfl_xor(v, m));
    return v;
}
#ifndef EMU
#define DPP_F(oldv, v, ctrl, rmask) __builtin_bit_cast(float, __builtin_amdgcn_update_dpp(__builtin_bit_cast(int, (float)(oldv)), __builtin_bit_cast(int, (float)(v)), (ctrl), (rmask), 0xF, false))
#endif
__device__ __forceinline__ float wave_scan_sum(float v, int lane) {
#ifdef EMU
    for (int d = 1; d < 64; d <<= 1) { float o = __shfl_up(v, d); if (lane >= d) v += o; }
    return v;
#else
    v += DPP_F(0.f, v, 0x111, 0xF);
    v += DPP_F(0.f, v, 0x112, 0xF);
    v += DPP_F(0.f, v, 0x114, 0xF);
    v += DPP_F(0.f, v, 0x118, 0xF);
    v += DPP_F(0.f, v, 0x142, 0xA);
    v += DPP_F(0.f, v, 0x143, 0xC);
    return v;
#endif
}
__device__ __forceinline__ float wave_last(float v) {
#ifdef EMU
    return __shfl(v, 63);
#else
    return __builtin_bit_cast(float, __builtin_amdgcn_readlane(__builtin_bit_cast(int, v), 63));
#endif
}
__device__ __forceinline__ float wave_shr1(float v, float fill, int lane) {
#ifdef EMU
    float o = __shfl_up(v, 1); return lane == 0 ? fill : o;
#else
    return DPP_F(fill, v, 0x138, 0xF);
#endif
}
__device__ __forceinline__ float wave_scan_max(float v, int lane) {
#ifdef EMU
    for (int d = 1; d < 64; d <<= 1) { float o = __shfl_up(v, d); if (lane >= d) v = fmaxf(v, o); }
    return v;
#else
    const float NI = -3.0e38f;
    v = fmaxf(v, DPP_F(NI, v, 0x111, 0xF));
    v = fmaxf(v, DPP_F(NI, v, 0x112, 0xF));
    v = fmaxf(v, DPP_F(NI, v, 0x114, 0xF));
    v = fmaxf(v, DPP_F(NI, v, 0x118, 0xF));
    v = fmaxf(v, DPP_F(NI, v, 0x142, 0xA));
    v = fmaxf(v, DPP_F(NI, v, 0x143, 0xC));
    return v;
#endif
}

template <int MT, int NTL>
__device__ __forceinline__ void mma_lds(f32x4 (&acc)[MT][NTL], const half_t* A, int lda, const half_t* B, int ldb, int ksteps, int lane) {
#ifndef EMU
    const int r = lane & 15, kq = (lane >> 4) * 8;
    for (int ks = 0; ks < ksteps; ++ks) {
        half8 a[MT], b[NTL];
#pragma unroll
        for (int mt = 0; mt < MT; ++mt) a[mt] = *(const half8*)(A + (mt * 16 + r) * lda + ks * 32 + kq);
#pragma unroll
        for (int nt = 0; nt < NTL; ++nt) b[nt] = *(const half8*)(B + (nt * 16 + r) * ldb + ks * 32 + kq);
#pragma unroll
        for (int mt = 0; mt < MT; ++mt)
#pragma unroll
            for (int nt = 0; nt < NTL; ++nt) acc[mt][nt] = __builtin_amdgcn_mfma_f32_16x16x32_f16(a[mt], b[nt], acc[mt][nt], 0, 0, 0);
    }
#else
    for (int mt = 0; mt < MT; ++mt) for (int nt = 0; nt < NTL; ++nt) for (int i = 0; i < 4; ++i) {
        const int row = mt * 16 + (lane >> 4) * 4 + i, col = nt * 16 + (lane & 15);
        float s = acc[mt][nt][i];
        for (int k = 0; k < ksteps * 32; ++k) s += (float)A[row * lda + k] * (float)B[col * ldb + k];
        acc[mt][nt][i] = s;
    }
#endif
}

__device__ __forceinline__ f32x4 mfma16(half8 a, half8 b, f32x4 c) {
#ifdef EMU
    return emu_mfma16(a, b, c);
#else
    return __builtin_amdgcn_mfma_f32_16x16x32_f16(a, b, c, 0, 0, 0);
#endif
}
template <int MT, int NTL> __device__ __forceinline__ void zero_acc(f32x4 (&acc)[MT][NTL]) {
#pragma unroll
    for (int mt = 0; mt < MT; ++mt)
#pragma unroll
        for (int nt = 0; nt < NTL; ++nt) acc[mt][nt] = (f32x4){0.f, 0.f, 0.f, 0.f};
}

__device__ __forceinline__ void load_taps4(const float* cw, const float* cb, int C, int ch, int dir, f32x4& w0, f32x4& w1, f32x4& w2, f32x4& wb) {
    w0 = *(const f32x4*)(cw + (dir ? 2 : 0) * C + ch); w1 = *(const f32x4*)(cw + C + ch); w2 = *(const f32x4*)(cw + (dir ? 0 : 2) * C + ch); wb = *(const f32x4*)(cb + ch);
}
#ifdef EMU
#define LOADER_FENCE()
#else
#define LOADER_FENCE() asm volatile("" ::: "memory")
#endif
#define CONV4(k, i) (w0[i] * (float)rr[k][hh * 4 + i] + w1[i] * (float)rr[(k) + 1][hh * 4 + i] + w2[i] * (float)rr[(k) + 2][hh * 4 + i] + wb[i])
__device__ __forceinline__ half4 to_half4(const f32x4 v) { half4 h; h[0] = (half_t)v[0]; h[1] = (half_t)v[1]; h[2] = (half_t)v[2]; h[3] = (half_t)v[3]; return h; }
namespace g8 {
constexpr int BM = 256, BK = 64, HALF = 128, HTB = HALF * BK * 2, STAGE_BYTES = 8 * HTB;
__device__ __forceinline__ int lds_byte(int r, int c) { const int st = (r >> 4) * 2 + (c >> 5), rr = r & 15, cc = c & 31, ob = rr * 64 + cc * 2; return st * 1024 + (ob ^ (((ob >> 9) & 1) << 5)); }
__device__ __forceinline__ void stage_rc(int b, int& R, int& C) { const int st = b / 1024, sb = b % 1024, swz = sb ^ (((sb >> 9) & 1) << 5); R = (st >> 1) * 16 + swz / 64; C = (st & 1) * 32 + (swz % 64) / 2; }
struct Unit { int pm, pn, e, n, c0; };

struct DenseSched {
    const char* abase; const char* bbase; int K, nM, nN, G, c;
    __device__ __forceinline__ bool next(int i, Unit& u) const {
        const int nwg = nM * nN; const long L = (long)i * G + c; if (L >= nwg) return false;
        int wgid = (int)L; { const int q = nwg / 8, r = nwg % 8, xcd = wgid % 8, off = wgid / 8; wgid = (xcd < r ? xcd * (q + 1) : r * (q + 1) + (xcd - r) * q) + off; }
        const int nig = 8 * nN, gid = wgid / nig, fm = gid * 8, gsz = (nM - fm) < 8 ? (nM - fm) : 8;
        u.pm = fm + ((wgid % nig) % gsz); u.pn = (wgid % nig) / gsz; u.e = 0; u.n = 0; u.c0 = 0; return true;
    }
    __device__ __forceinline__ unsigned a_off(const Unit& u, int r) const { return (unsigned)((size_t)(u.pm * 256 + r) * K * 2); }
    __device__ __forceinline__ const char* b_half(const Unit& u, int h) const { return bbase + (size_t)(u.pn * 256 + h * 128) * K * 2; }
};

template <class Epi, class Sched>
__device__ __forceinline__ void gemm_phase(unsigned char* smem, const int K, const Sched& S, const Epi& E) {
    const int tid = threadIdx.x, lane = tid & 63;
#ifdef EMU
    const int wid = tid >> 6, wr = wid >> 2, wc = wid & 3, fr = lane & 15, fq = lane >> 4;
    half_t* As = (half_t*)smem; half_t* Bs = As + 256 * 72;
    Unit cur;
    for (int ui = 0; S.next(ui, cur); ++ui) {
        f32x4 acc[2][2][4][2];
        for (int a = 0; a < 2; ++a) for (int b = 0; b < 2; ++b) for (int m = 0; m < 4; ++m) for (int n = 0; n < 2; ++n) acc[a][b][m][n] = (f32x4){0.f, 0.f, 0.f, 0.f};
        for (int kt = 0; kt < K / 64; ++kt) {
            { const int row = tid >> 1, c0 = (tid & 1) * 32;
              const half_t* sa = (const half_t*)(S.abase + S.a_off(cur, row)) + kt * 64 + c0;
              const half_t* sb = (const half_t*)(S.b_half(cur, row >> 7)) + (size_t)(row & 127) * K + kt * 64 + c0;
              for (int q = 0; q < 32; ++q) { As[row * 72 + c0 + q] = sa[q]; Bs[row * 72 + c0 + q] = sb[q]; } }
            __syncthreads();
            for (int a = 0; a < 2; ++a) for (int b = 0; b < 2; ++b) for (int m = 0; m < 4; ++m) for (int n = 0; n < 2; ++n) for (int i = 0; i < 4; ++i) {
                const int row = 128 * a + 64 * wr + 16 * m + fr, col = 128 * b + 32 * wc + 16 * n + 4 * fq + i; float s = acc[a][b][m][n][i];
                for (int k = 0; k < 64; ++k) s += (float)As[row * 72 + k] * (float)Bs[col * 72 + k];
                acc[a][b][m][n][i] = s; }
            __syncthreads();
        }
        E(acc, cur, wr, wc, fr, fq);
    }
#else
    typedef __attribute__((address_space(3))) unsigned char* ldsp_t;
    const ldsp_t lds = (ldsp_t)smem;
    const int wid = __builtin_amdgcn_readfirstlane(tid >> 6), wr = wid >> 2, wc = wid & 3, fr = lane & 15, fq = lane >> 4;
    const int nt = K / BK;
    int Rr[2], Cc[2]; unsigned voffB[2];
#pragma unroll
    for (int i = 0; i < 2; ++i) { stage_rc(tid * 16 + i * 8192, Rr[i], Cc[i]); voffB[i] = (unsigned)(Rr[i] * K + Cc[i]) * 2u; }
    const size_t kstep = (size_t)(BK * 2);
    const unsigned ldsw = (unsigned)wid * 1024u;
    const int aoffl = lds_byte(wr * 64 + fr, fq * 8), boffl = lds_byte(wc * 32 + fr, fq * 8);
#define G8_SA(b, h) (((b) * 2 + (h)) * HTB)
#define G8_SB(b, h) ((4 + (b) * 2 + (h)) * HTB)
#define G8_STAGE(bufoff, gbase, voff) do { _Pragma("unroll") for (int _i = 0; _i < 2; ++_i) \
        __builtin_amdgcn_global_load_lds((const unsigned*)((const char*)(gbase) + (voff)[_i]), (__attribute__((address_space(3))) unsigned*)(lds + (bufoff) + ldsw + _i * 8192), 16, 0, 0); } while (0)
#define G8_LDA(dst, b, h) do { _Pragma("unroll") for (int m = 0; m < 4; ++m) _Pragma("unroll") for (int k = 0; k < 2; ++k) dst[m][k] = *(const __attribute__((address_space(3))) half8*)(lds + G8_SA(b, h) + aoffl + m * 2048 + k * 1024); } while (0)
#define G8_LDB(dst, b, h) do { _Pragma("unroll") for (int n = 0; n < 2; ++n) _Pragma("unroll") for (int k = 0; k < 2; ++k) dst[n][k] = *(const __attribute__((address_space(3))) half8*)(lds + G8_SB(b, h) + boffl + n * 2048 + k * 1024); } while (0)
#define G8_MMA(ai, bj, At, Bt) do { __builtin_amdgcn_s_setprio(1); _Pragma("unroll") for (int m = 0; m < 4; ++m) _Pragma("unroll") for (int n = 0; n < 2; ++n) _Pragma("unroll") for (int k = 0; k < 2; ++k) \
        acc[ai][bj][m][n] = __builtin_amdgcn_mfma_f32_16x16x32_f16(Bt[n][k], At[m][k], acc[ai][bj][m][n], 0, 0, 0); __builtin_amdgcn_s_setprio(0); } while (0)
#define G8_WAIT_V(n) asm volatile("s_waitcnt vmcnt(" #n ")" ::: "memory")
#define G8_WAIT_L(n) asm volatile("s_waitcnt lgkmcnt(" #n ")" ::: "memory")
#define G8_BAR __builtin_amdgcn_s_barrier()
#define G8_SCHED __builtin_amdgcn_sched_barrier(0)
#define G8_AOFF(dst, u) do { _Pragma("unroll") for (int _h = 0; _h < 2; ++_h) _Pragma("unroll") for (int _i = 0; _i < 2; ++_i) dst[_h][_i] = S.a_off(u, _h * 128 + Rr[_i]) + (unsigned)Cc[_i] * 2u; } while (0)
    Unit cur, nxt; int ui = 0;
    if (!S.next(0, cur)) return;
    f32x4 acc[2][2][4][2];
#pragma unroll
    for (int a = 0; a < 2; ++a)
#pragma unroll
        for (int b = 0; b < 2; ++b)
#pragma unroll
            for (int m = 0; m < 4; ++m)
#pragma unroll
                for (int n = 0; n < 2; ++n) acc[a][b][m][n] = (f32x4){0.f, 0.f, 0.f, 0.f};
    half8 At[4][2], B0[2][2], B1[2][2];
    unsigned caoff[2][2], naoff[2][2];
    G8_AOFF(caoff, cur);
    const char* cA = S.abase; const char* cB0 = S.b_half(cur, 0); const char* cB1 = S.b_half(cur, 1);
    G8_STAGE(G8_SB(0, 0), cB0, voffB); G8_STAGE(G8_SA(0, 0), cA, caoff[0]); G8_STAGE(G8_SB(0, 1), cB1, voffB); G8_STAGE(G8_SA(0, 1), cA, caoff[1]);
    if (wr == 1) G8_BAR;
    G8_WAIT_V(4); G8_BAR;
    G8_STAGE(G8_SB(1, 0), cB0 + kstep, voffB); G8_STAGE(G8_SA(1, 0), cA + kstep, caoff[0]); G8_STAGE(G8_SB(1, 1), cB1 + kstep, voffB);
    G8_WAIT_V(6); G8_BAR;
    for (;;) {
        const bool has_next = S.next(ui + 1, nxt);
        if (!has_next) nxt = cur;
        G8_AOFF(naoff, nxt);
        const char* nB0 = S.b_half(nxt, 0); const char* nB1 = S.b_half(nxt, 1);
#pragma unroll 1
        for (int t = 0; t < nt; t += 2) {
            const bool last = (t == nt - 2);
            const char* a1 = cA + (size_t)(t + 1) * kstep;
            const char* a2 = last ? cA : cA + (size_t)(t + 2) * kstep;
            const char* b20 = last ? nB0 : cB0 + (size_t)(t + 2) * kstep; const char* b21 = last ? nB1 : cB1 + (size_t)(t + 2) * kstep;
            const char* a3 = a2 + kstep; const char* b30 = b20 + kstep; const char* b31 = b21 + kstep;
            unsigned xoff[2][2];
#pragma unroll
            for (int h = 0; h < 2; ++h)
#pragma unroll
                for (int i = 0; i < 2; ++i) xoff[h][i] = last ? naoff[h][i] : caoff[h][i];
            G8_LDB(B0, 0, 0); G8_SCHED; G8_LDA(At, 0, 0); G8_STAGE(G8_SA(1, 1), a1, caoff[1]);
            G8_WAIT_L(8); G8_BAR; G8_WAIT_L(0); G8_MMA(0, 0, At, B0); G8_BAR; G8_SCHED;
            G8_LDB(B1, 0, 1); G8_STAGE(G8_SB(0, 0), b20, voffB);
            G8_BAR; G8_WAIT_L(0); G8_MMA(0, 1, At, B1); G8_BAR;
            G8_LDA(At, 0, 1); G8_STAGE(G8_SA(0, 0), a2, xoff[0]);
            G8_BAR; G8_WAIT_L(0); G8_MMA(1, 0, At, B0); G8_BAR; G8_SCHED;
            G8_STAGE(G8_SB(0, 1), b21, voffB);
            G8_WAIT_V(6); G8_BAR; G8_MMA(1, 1, At, B1); G8_BAR;
            G8_LDB(B0, 1, 0); G8_SCHED; G8_LDA(At, 1, 0); G8_STAGE(G8_SA(0, 1), a2, xoff[1]);
            G8_WAIT_L(8); G8_BAR; G8_WAIT_L(0); G8_MMA(0, 0, At, B0); G8_BAR; G8_SCHED;
            G8_LDB(B1, 1, 1); G8_STAGE(G8_SB(1, 0), b30, voffB);
            G8_BAR; G8_WAIT_L(0); G8_MMA(0, 1, At, B1); G8_BAR;
            G8_LDA(At, 1, 1); G8_STAGE(G8_SA(1, 0), a3, xoff[0]);
            G8_BAR; G8_WAIT_L(0); G8_MMA(1, 0, At, B0); G8_BAR; G8_SCHED;
            G8_STAGE(G8_SB(1, 1), b31, voffB);
            G8_WAIT_V(6); G8_BAR; G8_MMA(1, 1, At, B1); G8_BAR;
        }
        E(acc, cur, wr, wc, fr, fq);
        if (!has_next) break;
#pragma unroll
        for (int a = 0; a < 2; ++a)
#pragma unroll
            for (int b = 0; b < 2; ++b)
#pragma unroll
                for (int m = 0; m < 4; ++m)
#pragma unroll
                    for (int n = 0; n < 2; ++n) acc[a][b][m][n] = (f32x4){0.f, 0.f, 0.f, 0.f};
        cur = nxt; cB0 = nB0; cB1 = nB1; ++ui;
#pragma unroll
        for (int h = 0; h < 2; ++h)
#pragma unroll
            for (int i = 0; i < 2; ++i) caoff[h][i] = naoff[h][i];
    }
    G8_WAIT_V(0);
    if (wr == 0) G8_BAR;
    G8_BAR;
#undef G8_SA
#undef G8_SB
#undef G8_STAGE
#undef G8_LDA
#undef G8_LDB
#undef G8_MMA
#undef G8_WAIT_V
#undef G8_WAIT_L
#undef G8_BAR
#undef G8_SCHED
#undef G8_AOFF
#endif
}
}

#ifdef EMU
typedef const Params* ParamsPtr;
#else
typedef const __attribute__((address_space(4))) Params* ParamsPtr;
#endif
struct Frame {
    ParamsPtr P; unsigned char* ws; unsigned char* smem; int tid, lane, wave;
    __device__ __forceinline__ const float* in(int i) const { return P->in[i]; }
    __device__ __forceinline__ float* xrow(int row) const { return row < TL ? P->out + (size_t)row * D : (float*)(ws + WS_XC) + (size_t)(row - TL) * D; }
    __device__ __forceinline__ const float* xrow_in(int layer, int row) const {
        if (layer == 0) return row < TL ? in(I_X) + (size_t)row * D : in(I_CTX) + (size_t)(row - TL) * D;
        return xrow(row);
    }
};
__device__ __forceinline__ int row_mod(int row) { return row < TL ? row / SEQ : NB; }
__device__ __forceinline__ const float* modp(const Frame& F, int layer, int m, int chunk) { return (const float*)(F.ws + WS_MOD) + ((size_t)(layer * 5 + m) * 6 + chunk) * D; }


#ifndef EMU
#define XB_TMO      128
#define XB_XCNT(j)  (256  + 64 * (j))
#define XB_XSUB(j)  (1280 + 64 * (j))
#define XB_XGEN(j)  (2304 + 64 * (j))
#define XB_TOP      3328
#define XB_TOPGEN   3392
#define XCD_BAR_WORDS 3456
#define XB_SPIN_CAP (1u << 26)
#define LAS __attribute__((address_space(3)))
static_assert((CW_BAR + XCD_BAR_WORDS) * 4 <= CTL_BYTES, "control region");
__device__ __forceinline__ unsigned xb_ld(unsigned* p)              { return __hip_atomic_load(p, __ATOMIC_RELAXED, __HIP_MEMORY_SCOPE_AGENT); }
__device__ __forceinline__ unsigned xb_add(unsigned* p, unsigned v) { return __hip_atomic_fetch_add(p, v, __ATOMIC_RELAXED, __HIP_MEMORY_SCOPE_AGENT); }
__device__ __forceinline__ unsigned xb_xcc_id() { return (unsigned)__builtin_amdgcn_s_getreg((3 << 11) | 20) & 0xFu; }
#define XB_SPIN(cond, bar) do { unsigned _sp = 0; while (cond) { __builtin_amdgcn_s_sleep(1); \
    if ((++_sp & 255u) == 0u) { if (xb_ld(&(bar)[XB_TMO])) break; if (_sp > XB_SPIN_CAP) { atomicAdd(&(bar)[XB_TMO], 1u); break; } } } } while (0)
struct XcdBarrier { unsigned* bar; unsigned x; volatile LAS unsigned* st; };
__device__ __forceinline__ XcdBarrier xcd_barrier_post(unsigned* bar, volatile LAS unsigned* st) {
    XcdBarrier b; b.bar = bar; b.x = xb_xcc_id(); b.st = st;
    if (threadIdx.x == 0) (void)xb_add(&bar[XB_XCNT(b.x)], 1u);
    return b;
}
__device__ __forceinline__ void xcd_barrier_complete(unsigned* bar, unsigned x, unsigned& nloc, unsigned& nx) {
    const unsigned G = gridDim.x * gridDim.y * gridDim.z;
    unsigned sum, cnt, mine, sp = 0u;
    for (;;) {
        sum = 0u; cnt = 0u; mine = 0u;
#pragma unroll
        for (unsigned j = 0; j < 16; ++j) { const unsigned c = xb_ld(&bar[XB_XCNT(j)]); sum += c; cnt += (c > 0u) ? 1u : 0u; mine = (j == x) ? c : mine; }
        if (sum == G) break;
        __builtin_amdgcn_s_sleep(1);
        if ((++sp & 255u) == 0u) { if (xb_ld(&bar[XB_TMO])) break; if (sp > XB_SPIN_CAP) { atomicAdd(&bar[XB_TMO], 1u); break; } }
    }
    nloc = mine > 0u ? mine : 1u; nx = cnt > 0u ? cnt : 1u;
}
__device__ __forceinline__ void xcd_barrier(const XcdBarrier& b) {
    asm volatile("s_waitcnt vmcnt(0)" ::: "memory");
    __syncthreads();
    if (threadIdx.x == 0) {
        unsigned* bar = b.bar;
        __builtin_amdgcn_s_waitcnt(0);
        unsigned nloc = b.st[0], nx = b.st[1];
        if (nloc == 0u) { xcd_barrier_complete(bar, b.x, nloc, nx); b.st[0] = nloc; b.st[1] = nx; }
        const unsigned old = xb_add(&bar[XB_XSUB(b.x)], 1u);
        const unsigned gen = old / nloc;
        if (old + 1u == (gen + 1u) * nloc) {
            __builtin_amdgcn_fence(__ATOMIC_RELEASE, "agent");
            asm volatile("s_waitcnt vmcnt(0)" ::: "memory");
            const unsigned og = xb_add(&bar[XB_TOP], 1u);
            const unsigned tg = og / nx;
            if (og + 1u == (tg + 1u) * nx) xb_add(&bar[XB_TOPGEN], 1u);
            else XB_SPIN(xb_ld(&bar[XB_TOPGEN]) == tg, bar);
            __builtin_amdgcn_fence(__ATOMIC_ACQUIRE, "agent");
            xb_add(&bar[XB_XGEN(b.x)], 1u);
            asm volatile("s_waitcnt vmcnt(0)" ::: "memory");
        } else {
            XB_SPIN(xb_ld(&bar[XB_XGEN(b.x)]) == gen, bar);
            __builtin_amdgcn_fence(__ATOMIC_ACQUIRE, "agent");
            asm volatile("s_waitcnt vmcnt(0)" ::: "memory");
        }
    }
    __syncthreads();
}
#endif

__device__ __forceinline__ void item_twiddle(const Frame& F, int it) {
    cplx* tw = (cplx*)(F.ws + WS_TW);
    const int k = it * NT + F.tid;
    if (k < TWN) { float s, c; const float a = -6.283185307179586f * (float)k / (float)TWN; s = sinf(a); c = cosf(a); tw[k].x = c; tw[k].y = s; }
}
__device__ __forceinline__ void item_mod(const Frame& F, int it) {
    const int layer = it / (NMOD / 64), n0 = (it % (NMOD / 64)) * 64;
    float* sc = (float*)F.smem;
    float* red = sc + 5 * D;
    for (int i = F.tid; i < 5 * D; i += NT) { const int m = i / D, k = i % D; const float v = m < NB ? F.in(I_C)[m * D + k] : F.in(I_CCTX)[k]; sc[i] = siluf(v); }
    __syncthreads();
    const int j = F.tid & 63, ks = F.tid >> 6;
    const float* w = F.in(I_WMOD) + (size_t)layer * D * NMOD + n0 + j;
    float a[5] = {0, 0, 0, 0, 0};
#pragma unroll 1
    for (int k0 = ks * 128; k0 < ks * 128 + 128; k0 += 32) {
        float wv[32];
#pragma unroll
        for (int q = 0; q < 32; ++q) wv[q] = w[(size_t)(k0 + q) * NMOD];
#pragma unroll
        for (int q = 0; q < 32; ++q)
#pragma unroll
            for (int m = 0; m < 5; ++m) a[m] += sc[m * D + k0 + q] * wv[q]; }
#pragma unroll
    for (int m = 0; m < 5; ++m) red[(ks * 5 + m) * 64 + j] = a[m];
    __syncthreads();
    if (F.tid < 5 * 64) { const int m = F.tid / 64, jj = F.tid % 64; float s = 0; for (int q = 0; q < 8; ++q) s += red[(q * 5 + m) * 64 + jj];
        ((float*)(F.ws + WS_MOD))[(size_t)(layer * 5 + m) * NMOD + n0 + jj] = s + F.in(I_BMOD)[layer * NMOD + n0 + jj]; }
    __syncthreads();
}
__device__ __forceinline__ void item_filter(const Frame& F, int layer, int isctx, int tb) {
    const int L = isctx ? CTXL : SEQ;
    float* feats = (float*)F.smem;
    float* h1 = feats + 32 * 33;
    float* h2 = h1 + 32 * 64;
    const int t0 = tb * 32;
    for (int i = F.tid; i < 32 * 33; i += NT) {
        const int tt = i / 33, f = i % 33; const float t = (float)(t0 + tt);
        float v;
        if (f == 0) v = t / (float)(L - 1 > 1 ? L - 1 : 1);
        else { const int bi = (f - 1) & 15; const float band = 1e-4f + (float)bi * ((15.0f - 1e-4f) / 15.0f);
               const float ang = (6.283185307179586f / (float)L) * t * band; v = (f <= 16) ? cosf(ang) : -sinf(ang); }
        feats[i] = v;
    }
    __syncthreads();
    const float* w1 = F.in(I_HW1) + layer * 33 * 64; const float* b1 = F.in(I_HB1) + layer * 64;
    const float* w2 = F.in(I_HW2) + layer * 64 * 64; const float* b2 = F.in(I_HB2) + layer * 64;
    const float* fr = F.in(I_HFREQ) + layer * 64;
    for (int i = F.tid; i < 32 * 64; i += NT) { const int tt = i >> 6, j = i & 63; float s = b1[j]; for (int k = 0; k < 33; ++k) s += feats[tt * 33 + k] * w1[k * 64 + j]; h1[i] = sinf(fr[j] * s); }
    __syncthreads();
    for (int i = F.tid; i < 32 * 64; i += NT) { const int tt = i >> 6, j = i & 63; float s = b2[j]; for (int k = 0; k < 64; ++k) s += h1[tt * 64 + k] * w2[k * 64 + j]; h2[i] = sinf(fr[j] * s); }
    __syncthreads();
    const float* w3 = F.in(I_HW3) + (size_t)layer * 64 * 1024;
    const int c0 = F.tid * 2;
    float* ft = (float*)(F.ws + WS_FT) + (isctx ? (size_t)2 * 256 * 4 * SEQ : (size_t)layer * 256 * 4 * SEQ);
    for (int hf = 0; hf < 2; ++hf) {
        float acc[16][2];
        for (int tt = 0; tt < 16; ++tt) { acc[tt][0] = 0.f; acc[tt][1] = 0.f; }
#pragma unroll 4
        for (int k = 0; k < 64; ++k) { const float wa = w3[k * 1024 + c0], wb = w3[k * 1024 + c0 + 1];
#pragma unroll
            for (int tt = 0; tt < 16; ++tt) { const float hv = h2[(hf * 16 + tt) * 64 + k]; acc[tt][0] += hv * wa; acc[tt][1] += hv * wb; } }
#pragma unroll
        for (int q = 0; q < 2; ++q) {
            const int col = c0 + q, dir = col >> 9, order = (col >> 8) & 1, c = col & 255;
            const float dec = fabsf(F.in(I_HDEC)[((layer * 2 + dir) * 2 + order) * 256 + c]);
            float* dst = ft + ((size_t)(c * 2 + order) * 2 + dir) * L + t0 + hf * 16;
#pragma unroll
            for (int tt = 0; tt < 16; ++tt) { const float tu = (float)(t0 + hf * 16 + tt) / (float)(L - 1 > 1 ? L - 1 : 1); dst[tt] = acc[tt][q] * expf(-tu * dec); }
        }
    }
    __syncthreads();
}
__device__ __forceinline__ void item_transpose(const Frame& F, const float* src, int ldn, int nvalid, half_t* dst, int K, int k0, int n0) {
    float* tile = (float*)F.smem;
    f32x4 v[8];
#pragma unroll
    for (int q = 0; q < 8; ++q) { const int i = F.tid + q * NT, r = i >> 6, c4 = (i & 63) * 4;
        if (n0 + c4 + 3 < nvalid) v[q] = *(const f32x4*)(src + (size_t)(k0 + r) * ldn + n0 + c4);
        else {
#pragma unroll
            for (int e = 0; e < 4; ++e) v[q][e] = (n0 + c4 + e < nvalid) ? src[(size_t)(k0 + r) * ldn + n0 + c4 + e] : 0.f; } }
#pragma unroll
    for (int q = 0; q < 8; ++q) { const int i = F.tid + q * NT, r = i >> 6, c4 = (i & 63) * 4; *(f32x4*)(tile + r * 260 + c4) = v[q]; }
    __syncthreads();
#pragma unroll
    for (int q = 0; q < 4; ++q) { const int i = F.tid + q * NT, n = i >> 3, kc = (i & 7) * 8; half8 h;
#pragma unroll
        for (int e = 0; e < 8; ++e) h[e] = (half_t)tile[(kc + e) * 260 + n];
        *(half8*)(dst + (size_t)(n0 + n) * K + k0 + kc) = h; }
    __syncthreads();
}
__device__ __forceinline__ void item_router_w(const Frame& F, int layer) {
    half_t* dst = (half_t*)(F.ws + WS_WR) + (size_t)layer * 2 * 48 * D;
#pragma unroll 4
    for (int i = F.tid; i < 32 * D; i += NT) {
        const int k = i >> 5, c = i & 31; const float w = F.in(I_ERW)[(size_t)layer * D * 32 + i];
        const half_t hi = (half_t)w; dst[(size_t)(4 + c) * D + k] = hi; dst[(size_t)(48 + 4 + c) * D + k] = (half_t)((w - (float)hi) * 2048.f); }
#pragma unroll 4
    for (int i = F.tid; i < 4 * D; i += NT) {
        const int k = i >> 2, c = i & 3; const float w = F.in(I_GRW)[(size_t)layer * D * 4 + i];
        const half_t hi = (half_t)w; dst[(size_t)c * D + k] = hi; dst[(size_t)(48 + c) * D + k] = (half_t)((w - (float)hi) * 2048.f); }
#pragma unroll 4
    for (int i = F.tid; i < 12 * D; i += NT) { dst[(size_t)36 * D + i] = (half_t)0.f; dst[(size_t)(48 + 36) * D + i] = (half_t)0.f; }
}
constexpr int IT_TW = (TWN + NT - 1) / NT;
constexpr int IT_MOD = 2 * (NMOD / 64);
constexpr int IT_FILT = 2 * (SEQ / 32) + (CTXL / 32);
constexpr int IT_TWIN = 2 * 16 * (NINP / 256);
constexpr int IT_TWOUT = 2 * 16 * 4;
constexpr int IT_TMOE = 32 * 48;
__device__ __forceinline__ void moe_transpose_item(const Frame& F, int layer, int it) {
    const int e = it / 48, r = it % 48, which = r / 16, t = r % 16;
    half_t* base = (half_t*)(F.ws + WS_WMOE) + (size_t)e * 3 * 262144;
    if (which < 2) {
        const float* src = F.in(which == 0 ? I_MG : I_MU) + ((size_t)layer * 32 + e) * 262144;
        item_transpose(F, src, 256, 256, base + which * 262144, 1024, t * 64, 0);
    } else {
        const float* src = F.in(I_MD) + ((size_t)layer * 32 + e) * 262144;
        item_transpose(F, src, 1024, 1024, base + 2 * 262144, 256, (t >> 2) * 64, (t & 3) * 256);
    }
}
__device__ __forceinline__ void phase_setup(const Frame& F) {
    const int G = gridDim.x; int rot = blockIdx.x;
    for (int i = rot; i < IT_MOD; i += G) item_mod(F, i);
    rot = (rot + G - (IT_MOD % G)) % G;
    for (int i = rot; i < IT_TWIN; i += G) { const int layer = i / (16 * (NINP / 256)), r = i % (16 * (NINP / 256));
        item_transpose(F, F.in(I_WIN) + (size_t)layer * D * NIN, NIN, NIN, (half_t*)(F.ws + WS_WIN) + (size_t)layer * NINP * D, D, (r / (NINP / 256)) * 64, (r % (NINP / 256)) * 256); }
    rot = (rot + G - (IT_TWIN % G)) % G;
    for (int i = rot; i < IT_FILT; i += G) { if (i < 2 * (SEQ / 32)) item_filter(F, i / (SEQ / 32), 0, i % (SEQ / 32)); else item_filter(F, 0, 1, i - 2 * (SEQ / 32)); }
    rot = (rot + G - (IT_FILT % G)) % G;
    for (int i = rot; i < IT_TWOUT; i += G) { const int layer = i / 64, r = i % 64;
        item_transpose(F, F.in(I_WOUT) + (size_t)layer * D * D, D, D, (half_t*)(F.ws + WS_WOUT) + (size_t)layer * D * D, D, (r >> 2) * 64, (r & 3) * 256); }
    rot = (rot + G - (IT_TWOUT % G)) % G;
    for (int i = rot; i < IT_TW; i += G) item_twiddle(F, i);
    rot = (rot + G - (IT_TW % G)) % G;
    for (int i = rot; i < 2; i += G) item_router_w(F, i);
}

__device__ __forceinline__ void phase_norm1(const Frame& F, int layer) {
    half_t* xn = (half_t*)(F.ws + WS_XN);
    const int lane = F.lane, nwaves = gridDim.x * (NT / 64);
    const float* nw = F.in(I_N1W) + layer * D;
    int mc = -1; f32x4 g[4], s4[4];
    int row = blockIdx.x * (NT / 64) + F.wave;
    f32x4 v[4];
    if (row < TT) { const float* x = F.xrow_in(layer, row);
#pragma unroll
        for (int q = 0; q < 4; ++q) v[q] = *(const f32x4*)(x + q * 256 + lane * 4); }
    for (; row < TT; row += nwaves) {
        const int nrow = row + nwaves;
        f32x4 vn[4];
        if (nrow < TT) { const float* x = F.xrow_in(layer, nrow);
#pragma unroll
            for (int q = 0; q < 4; ++q) vn[q] = *(const f32x4*)(x + q * 256 + lane * 4); }
        if (layer > 0) {
            const half_t* xa = (const half_t*)(F.ws + WS_U16 + XAB_OFF) + (size_t)row * D; const half_t* xb = xa + (size_t)TT * D; float* xw = F.xrow(row);
#pragma unroll
            for (int q = 0; q < 4; ++q) { const int k = q * 256 + lane * 4; const half4 a4 = *(const half4*)(xa + k), b4 = *(const half4*)(xb + k);
#pragma unroll
                for (int e = 0; e < 4; ++e) v[q][e] += (float)a4[e] + (float)b4[e];
                *(f32x4*)(xw + k) = v[q]; } }
        const int m = row_mod(row);
        if (m != mc) { mc = m; const float* sh = modp(F, layer, m, 0); const float* scl = modp(F, layer, m, 1);
#pragma unroll
            for (int q = 0; q < 4; ++q) { const int k = q * 256 + lane * 4; const f32x4 a = *(const f32x4*)(nw + k), b = *(const f32x4*)(scl + k); s4[q] = *(const f32x4*)(sh + k);
#pragma unroll
                for (int e = 0; e < 4; ++e) g[q][e] = a[e] * (1.0f + b[e]); } }
        float ss = 0.f;
#pragma unroll
        for (int q = 0; q < 4; ++q) ss += v[q][0] * v[q][0] + v[q][1] * v[q][1] + v[q][2] * v[q][2] + v[q][3] * v[q][3];
        ss = wave_sum(ss);
        const float rs = 1.0f / sqrtf(ss * (1.0f / D) + EPSF);
        int srow = row;
        if (layer == 1 && row < TL) { const int b = row / SEQ, l = row % SEQ; srow = b * SEQ + (l % GW) * GROWS + l / GW; }
#pragma unroll
        for (int q = 0; q < 4; ++q) { const int k = q * 256 + lane * 4; half4 h;
#pragma unroll
            for (int e = 0; e < 4; ++e) h[e] = (half_t)(v[q][e] * rs * g[q][e] + s4[q][e]);
            *(half4*)(xn + (size_t)srow * D + k) = h; }
#pragma unroll
        for (int q = 0; q < 4; ++q) v[q] = vn[q];
    }
}

struct EpiInproj {
    half_t* u16; float* ug; half_t* hyt; half_t* halo;
    __device__ __forceinline__ void operator()(const f32x4 (&acc)[2][2][4][2], const g8::Unit& u, int wr, int wc, int fr, int fq) const {
        const int rowb = u.pm * 256 + wr * 64 + fr;
        const bool edge = (fr == 0) || (fr == 15);
#pragma unroll
        for (int bj = 0; bj < 2; ++bj)
#pragma unroll
            for (int n = 0; n < 2; ++n) {
                const int c0 = u.pn * 256 + bj * 128 + wc * 32 + n * 16 + 4 * fq;
                if (c0 < 1024 || (c0 >= 1804 && c0 < 3340)) {
                    const int uc = c0 < 1024 ? c0 : c0 - 1804 + 1024; const bool hal = edge && uc >= 384 && uc < 1792;
#pragma unroll
                    for (int ai = 0; ai < 2; ++ai)
#pragma unroll
                        for (int m = 0; m < 4; ++m) { const int row = rowb + ai * 128 + m * 16; const half4 h = to_half4(acc[ai][bj][m][n]);
                            *(half4*)(u16 + (size_t)row * UW + uc) = h;
                            if (hal) *(half4*)(halo + ((size_t)(row >> 4) * 2 + (fr == 15)) * 1408 + (uc - 384)) = h; }
                } else if (c0 < 1036 || (c0 >= 3340 && c0 < NIN)) {
                    const int gc = c0 < 1036 ? c0 - 1024 : 12 + (c0 - 3340);
#pragma unroll
                    for (int ai = 0; ai < 2; ++ai)
#pragma unroll
                        for (int m = 0; m < 4; ++m) { const int row = rowb + ai * 128 + m * 16; *(f32x4*)(ug + (size_t)row * UGW + gc) = acc[ai][bj][m][n]; }
                } else if (c0 < 1804) {
                    const int ch = c0 - 1036;
#pragma unroll
                    for (int ai = 0; ai < 2; ++ai)
#pragma unroll
                        for (int m = 0; m < 4; ++m) { const int row = rowb + ai * 128 + m * 16; const f32x4 v = acc[ai][bj][m][n];
                            half_t* dst = row < TL ? hyt + ((size_t)(row / SEQ) * 768 + ch) * SEQ + row % SEQ : hyt + (size_t)NB * 768 * SEQ + ((size_t)((row - TL) / CTXL) * 768 + ch) * CTXL + (row - TL) % CTXL;
                            const size_t st = row < TL ? SEQ : CTXL;
#pragma unroll
                            for (int i = 0; i < 4; ++i) dst[i * st] = (half_t)v[i]; }
                }
            }
    }
};
__device__ __forceinline__ void phase_inproj(const Frame& F, int layer) {
    g8::DenseSched S; S.abase = (const char*)(F.ws + WS_XN); S.bbase = (const char*)((const half_t*)(F.ws + WS_WIN) + (size_t)layer * NINP * D); S.K = D; S.nM = TT / 256; S.nN = NINP / 256; S.G = gridDim.x; S.c = blockIdx.x;
    EpiInproj E{(half_t*)(F.ws + WS_U16), (float*)(F.ws + WS_UG), (half_t*)(F.ws + WS_HYT), (half_t*)(F.ws + WS_HALO)};
    g8::gemm_phase(F.smem, D, S, E);
}


__device__ __forceinline__ void phase_act(const Frame& F, int layer) {
    half_t* u16 = (half_t*)(F.ws + WS_U16); const half_t* halo = (const half_t*)(F.ws + WS_HALO);
    const int tid = F.tid, g = tid % 176, hf = tid / 176;
    const bool active = tid < 352;
    const bool isml = g >= 80; const int ch = isml ? (g - 80) * 8 : g * 8, C = isml ? 768 : 640;
    const float* cw = isml ? F.in(I_MCW) + layer * 3 * 768 : F.in(I_SCW) + layer * 3 * 640; const float* cb = isml ? F.in(I_MCB) + layer * 768 : F.in(I_SCB) + layer * 640;
    const float osc = (isml && ch >= 384) ? 0.125f : 1.0f;
    float w0[8], w1[8], w2[8], wb[8];
#pragma unroll
    for (int i = 0; i < 8; ++i) { const int cc = active ? ch + i : 0; w0[i] = cw[cc]; w1[i] = cw[C + cc]; w2[i] = cw[2 * C + cc]; wb[i] = cb[cc]; }
    for (int it = blockIdx.x; it < TT / 16; it += gridDim.x) {
        const int rb = it * 16, r0 = rb + hf * 8;
        const bool isl = rb < TL; const int L = isl ? SEQ : CTXL; const int pos0 = (isl ? rb : rb - TL) % L;
        half8 rr[10]; half8 zz;
#pragma unroll
        for (int i = 0; i < 8; ++i) zz[i] = (half_t)0.f;
        if (active) {
            const size_t col = 384 + g * 8;
#pragma unroll
            for (int k = 0; k < 8; ++k) rr[k + 1] = *(const half8*)(u16 + (size_t)(r0 + k) * UW + col);
            if (hf == 0) { rr[0] = pos0 > 0 ? *(const half8*)(halo + ((size_t)(it - 1) * 2 + 1) * 1408 + g * 8) : zz; rr[9] = *(const half8*)(u16 + (size_t)(rb + 8) * UW + col); }
            else { rr[0] = *(const half8*)(u16 + (size_t)(rb + 7) * UW + col); rr[9] = pos0 + 16 < L ? *(const half8*)(halo + ((size_t)(it + 1) * 2 + 0) * 1408 + g * 8) : zz; }
        }
        half8 o[8];
        if (active) {
#pragma unroll
            for (int k = 0; k < 8; ++k)
#pragma unroll
                for (int i = 0; i < 8; ++i) o[k][i] = (half_t)(osc * fsilu(w0[i] * (float)rr[k][i] + w1[i] * (float)rr[k + 1][i] + w2[i] * (float)rr[k + 2][i] + wb[i]));
        }
        __syncthreads();
        if (active) {
#pragma unroll
            for (int k = 0; k < 8; ++k) *(half8*)(u16 + (size_t)(r0 + k) * UW + 384 + g * 8) = o[k];
        }
    }
}

constexpr int SA = 72, SB = 136;

__device__ __forceinline__ void load_rows8(const half_t* u16, int rowbase, int Lseq, int dir, int jj0, int ucol, half8 (&rr)[8]) {
#pragma unroll
    for (int k = 0; k < 8; ++k) { const int jj = jj0 + k, pos = dir == 0 ? jj : Lseq - 1 - jj; rr[k] = *(const half8*)(u16 + (size_t)(rowbase + pos) * UW + ucol); }
}
__device__ __forceinline__ void transpose8(const half8 (&rr)[8], half8 (&t)[8]) {
#pragma unroll
    for (int i = 0; i < 8; ++i)
#pragma unroll
        for (int k = 0; k < 8; ++k) t[i][k] = rr[k][i];
}
__device__ __forceinline__ void ssd_block(const Frame& F, int layer, int b, int h, int dir) {
    half_t* Cs = (half_t*)F.smem;
    half_t* Bs = Cs + 128 * SA;
    half_t* BT = Bs + 128 * SA;
    half_t* XT = BT + 64 * SB;
    half_t* SC = XT + 64 * SB;
    half_t* ST = SC + 128 * SB;
    float* cum = (float*)(ST + 64 * SA);
    float* dtv = cum + 128;
    float* wes = dtv + 128;
    const half_t* u16 = (const half_t*)(F.ws + WS_U16); const float* ug = (const float*)(F.ws + WS_UG);
    half_t* yout = (half_t*)(F.ws + WS_YF) + (size_t)dir * TT * 384;
    const float* cw = F.in(I_SCW) + layer * 3 * 640; const float* cb = F.in(I_SCB) + layer * 640;
    const float dtb = F.in(I_DTB)[(layer * 2 + dir) * 6 + h];
    const float Aneg = -expf(F.in(I_ALOG)[(layer * 2 + dir) * 6 + h]);
    const float Dh = F.in(I_SD)[layer * 6 + h];
    const int g = h / 3, tid = F.tid, lane = F.lane, wave = F.wave;
    const int kind = tid >> 7, c8 = (tid & 7) * 8, j0 = ((tid >> 3) & 15) * 8;
    const int ch = kind == 0 ? h * 64 + c8 : (kind == 1 ? 384 + g * 64 + c8 : 512 + g * 64 + c8);
    f32x4 accS[1][2]; zero_acc(accS);
    for (int i = tid; i < 64 * SA; i += NT) ST[i] = (half_t)0.f;
    constexpr int NC0 = CTXL / 128, NCT = NC0 + SEQ / 128;
    half8 rr[8]; float ug0 = 0.f, ug1 = 0.f;
    if (kind < 3) load_rows8(u16, TL + b * CTXL, CTXL, dir, j0, 384 + ch, rr);
    if (wave == 7) { const int p0 = dir == 0 ? 2 * lane : CTXL - 1 - 2 * lane, p1 = dir == 0 ? p0 + 1 : p0 - 1;
        ug0 = ug[(size_t)(TL + b * CTXL + p0) * UGW + dir * 6 + h]; ug1 = ug[(size_t)(TL + b * CTXL + p1) * UGW + dir * 6 + h]; }
    __syncthreads();
    for (int cc = 0; cc < NCT; ++cc) {
        const int seg = cc >= NC0 ? 1 : 0, c = seg ? cc - NC0 : cc;
        const int Lseq = seg == 0 ? CTXL : SEQ, rowbase = seg == 0 ? TL + b * CTXL : b * SEQ;
        const bool want_y = (seg == 1) || (layer == 0);
        const int nseg = (cc + 1) >= NC0 ? 1 : 0, ncn = nseg ? cc + 1 - NC0 : cc + 1, nL = nseg == 0 ? CTXL : SEQ, nrb = nseg == 0 ? TL + b * CTXL : b * SEQ;
        if (wave == 7) {
            const float dt0 = fsoftplus(ug0 + dtb), dt1 = fsoftplus(ug1 + dtb);
            const float a0 = dt0 * Aneg, a1 = dt1 * Aneg;
            const float incl = wave_scan_sum(a0 + a1, lane);
            const float c1 = incl, c0 = incl - a1;
            const float cl = wave_last(incl);
            cum[2 * lane] = c0; cum[2 * lane + 1] = c1; dtv[2 * lane] = dt0; dtv[2 * lane + 1] = dt1;
            wes[2 * lane] = dt0 * fexp(cl - c0); wes[2 * lane + 1] = dt1 * fexp(cl - c1);
            if (cc + 1 < NCT) { const int pi = ncn * 128 + 2 * lane, p0 = dir == 0 ? pi : nL - 1 - pi, p1 = dir == 0 ? p0 + 1 : p0 - 1;
                ug0 = ug[(size_t)(nrb + p0) * UGW + dir * 6 + h]; ug1 = ug[(size_t)(nrb + p1) * UGW + dir * 6 + h]; }
        }
        if (kind < 3) {
            if (kind == 0) { half8 t[8]; transpose8(rr, t);
#pragma unroll
                for (int i = 0; i < 8; ++i) *(half8*)(XT + (c8 + i) * SB + j0) = t[i];
            } else if (kind == 1) { half8 t[8]; transpose8(rr, t);
#pragma unroll
                for (int k = 0; k < 8; ++k) *(half8*)(Bs + (j0 + k) * SA + c8) = rr[k];
#pragma unroll
                for (int i = 0; i < 8; ++i) *(half8*)(BT + (c8 + i) * SB + j0) = t[i];
            } else {
#pragma unroll
                for (int k = 0; k < 8; ++k) *(half8*)(Cs + (j0 + k) * SA + c8) = rr[k];
            }
            if (cc + 1 < NCT) load_rows8(u16, nrb, nL, dir, ncn * 128 + j0, 384 + ch, rr);
        }
        __syncthreads();
        const float cl = cum[127];
        if (want_y) {
            { const int ws_ = wave & 1, wl = wave >> 1;
              if (!(ws_ == 1 && wl < 2)) {
                f32x4 g_[4][2]; zero_acc(g_);
                mma_lds<4, 2>(g_, Bs + ws_ * 64 * SA, SA, Cs + wl * 32 * SA, SA, 2, lane);
#pragma unroll
                for (int a = 0; a < 4; ++a) {
                    const int s0 = ws_ * 64 + a * 16 + (lane >> 4) * 4;
                    const f32x4 cs4 = *(const f32x4*)(cum + s0), dt4 = *(const f32x4*)(dtv + s0);
#pragma unroll
                    for (int q = 0; q < 2; ++q) {
                        const int l = wl * 32 + q * 16 + (lane & 15); const float cl_ = cum[l]; half4 hv;
#pragma unroll
                        for (int i = 0; i < 4; ++i) hv[i] = (half_t)((s0 + i) <= l ? g_[a][q][i] * fexp(cl_ - cs4[i]) * dt4[i] : 0.f);
                        *(half4*)(SC + l * SB + s0) = hv;
                    } }
              } }
            f32x4 y1[4][1]; zero_acc(y1);
            mma_lds<4, 1>(y1, ST, SA, Cs + wave * 16 * SA, SA, 2, lane);
            __syncthreads();
            f32x4 y2[4][1]; zero_acc(y2);
            mma_lds<4, 1>(y2, XT, SB, SC + wave * 16 * SB, SB, wave / 2 + 1, lane);
            { const int l = wave * 16 + (lane & 15); const float el = fexp(cum[l]);
              const int pi = c * 128 + l, pos = dir == 0 ? pi : Lseq - 1 - pi;
#pragma unroll
              for (int a = 0; a < 4; ++a) { const int p0 = a * 16 + (lane >> 4) * 4; f32x4 y;
#pragma unroll
                  for (int i = 0; i < 4; ++i) y[i] = y1[a][0][i] * el + y2[a][0][i];
                  if (dir == 0) {
#pragma unroll
                      for (int i = 0; i < 4; ++i) y[i] += Dh * (float)XT[(p0 + i) * SB + l]; }
                  *(half4*)(yout + (size_t)(rowbase + pos) * 384 + h * 64 + p0) = to_half4(y); } }
        }
        { const float dec = fexp(cl);
#pragma unroll
          for (int q = 0; q < 2; ++q) accS[0][q] *= dec;
          const int r = lane & 15, kq = (lane >> 4) * 8;
#pragma unroll
          for (int ks = 0; ks < 4; ++ks) {
              const half8 a = *(const half8*)(BT + ((wave >> 1) * 16 + r) * SB + ks * 32 + kq);
              const f32x4 e0 = *(const f32x4*)(wes + ks * 32 + kq), e1 = *(const f32x4*)(wes + ks * 32 + kq + 4);
#pragma unroll
              for (int q = 0; q < 2; ++q) { half8 bb = *(const half8*)(XT + ((wave & 1) * 32 + q * 16 + r) * SB + ks * 32 + kq);
#pragma unroll
                  for (int i = 0; i < 4; ++i) { bb[i] = (half_t)((float)bb[i] * e0[i]); bb[4 + i] = (half_t)((float)bb[4 + i] * e1[i]); }
                  accS[0][q] = mfma16(a, bb, accS[0][q]); } } }
        __syncthreads();
#pragma unroll
        for (int q = 0; q < 2; ++q) { const int p = (wave & 1) * 32 + q * 16 + (lane & 15), n0 = (wave >> 1) * 16 + (lane >> 4) * 4; *(half4*)(ST + p * SA + n0) = to_half4(accS[0][q]); }
    }
    __syncthreads();
}

__device__ __forceinline__ void mlstm_block(const Frame& F, int layer, int b, int h, int dir) {
    half_t* Qs = (half_t*)F.smem;
    half_t* Ks = Qs + 128 * SA;
    half_t* KT = Ks + 128 * SA;
    half_t* VT = KT + 64 * SB;
    half_t* SC = VT + 64 * SB;
    half_t* CS = SC + 128 * SB;
    float* ig = (float*)(CS + 64 * SA);
    float* cumf = ig + 128; float* gsv = cumf + 128; float* mtv = gsv + 128; float* ee = mtv + 128; float* dn = ee + 128;
    float* nvec = dn + 128;
    float* scal = nvec + 64;
    const half_t* u16 = (const half_t*)(F.ws + WS_U16); const float* ug = (const float*)(F.ws + WS_UG);
    half_t* hout = (half_t*)(F.ws + WS_YF) + (size_t)(2 + dir) * TT * 384;
    const float* cw = F.in(I_MCW) + layer * 3 * 768; const float* cb = F.in(I_MCB) + layer * 768;
    const float bi = F.in(I_MGB)[((layer * 2 + dir) * 2 + 0) * 6 + h], bf = F.in(I_MGB)[((layer * 2 + dir) * 2 + 1) * 6 + h];
    const int tid = F.tid, lane = F.lane, wave = F.wave;
    const int kind = tid >> 7, c8 = (tid & 7) * 8, j0 = ((tid >> 3) & 15) * 8;
    const int ch = kind == 0 ? h * 64 + c8 : 384 + h * 64 + c8;
    f32x4 accC[1][2]; zero_acc(accC);
    float m_in = 0.f;
    for (int i = tid; i < 64 * SA; i += NT) CS[i] = (half_t)0.f;
    if (tid < 64) nvec[tid] = 0.f;
    constexpr int NC0 = CTXL / 128, NCT = NC0 + SEQ / 128;
    half8 rr[8]; float gi0 = 0.f, gi1 = 0.f, gf0 = 0.f, gf1 = 0.f;
    const int ucol = kind == 2 ? 1792 + h * 64 + c8 : 1024 + ch;
    if (kind < 3) load_rows8(u16, TL + b * CTXL, CTXL, dir, j0, ucol, rr);
    if (wave == 7) { const int p0 = dir == 0 ? 2 * lane : CTXL - 1 - 2 * lane, p1 = dir == 0 ? p0 + 1 : p0 - 1;
        const float* g0 = ug + (size_t)(TL + b * CTXL + p0) * UGW + 12 + dir * 12; const float* g1 = ug + (size_t)(TL + b * CTXL + p1) * UGW + 12 + dir * 12;
        gi0 = g0[h]; gf0 = g0[6 + h]; gi1 = g1[h]; gf1 = g1[6 + h]; }
    half8 ones;
#pragma unroll
    for (int i = 0; i < 8; ++i) ones[i] = (half_t)1.0f;
    __syncthreads();
    for (int cc = 0; cc < NCT; ++cc) {
        const int seg = cc >= NC0 ? 1 : 0, c = seg ? cc - NC0 : cc;
        const int Lseq = seg == 0 ? CTXL : SEQ, rowbase = seg == 0 ? TL + b * CTXL : b * SEQ;
        const bool want_y = (seg == 1) || (layer == 0);
        const int nseg = (cc + 1) >= NC0 ? 1 : 0, ncn = nseg ? cc + 1 - NC0 : cc + 1, nL = nseg == 0 ? CTXL : SEQ, nrb = nseg == 0 ? TL + b * CTXL : b * SEQ;
        if (wave == 7) {
            const float i0 = gi0 + bi, i1 = gi1 + bi, lf0 = flogsigmoid(gf0 + bf), lf1 = flogsigmoid(gf1 + bf);
            const float incl = wave_scan_sum(lf0 + lf1, lane);
            const float c1 = incl, c0 = incl - lf1;
            const float tot = wave_last(incl);
            const float r0 = i0 - c0, r1 = i1 - c1;
            const float pincl = wave_scan_max(fmaxf(r0, r1), lane);
            const float pexcl = wave_shr1(pincl, -3.0e38f, lane);
            const float pm0 = fmaxf(pexcl, r0), pm1 = pincl;
            const float pmlast = wave_last(pincl);
            const float m_new = fmaxf(tot + m_in, tot + pmlast);
            ig[2 * lane] = i0; ig[2 * lane + 1] = i1; cumf[2 * lane] = c0; cumf[2 * lane + 1] = c1; gsv[2 * lane] = r0; gsv[2 * lane + 1] = r1;
            mtv[2 * lane] = fmaxf(c0 + m_in, c0 + pm0); mtv[2 * lane + 1] = fmaxf(c1 + m_in, c1 + pm1);
            ee[2 * lane] = fexp(r0 + tot - m_new); ee[2 * lane + 1] = fexp(r1 + tot - m_new);
            if (lane == 0) { scal[0] = tot; scal[1] = m_new; }
            if (cc + 1 < NCT) { const int pi = ncn * 128 + 2 * lane, p0 = dir == 0 ? pi : nL - 1 - pi, p1 = dir == 0 ? p0 + 1 : p0 - 1;
                const float* g0 = ug + (size_t)(nrb + p0) * UGW + 12 + dir * 12; const float* g1 = ug + (size_t)(nrb + p1) * UGW + 12 + dir * 12;
                gi0 = g0[h]; gf0 = g0[6 + h]; gi1 = g1[h]; gf1 = g1[6 + h]; }
        }
        if (kind == 0) {
#pragma unroll
            for (int k = 0; k < 8; ++k) *(half8*)(Qs + (j0 + k) * SA + c8) = rr[k];
        } else if (kind == 1) { half8 t[8]; transpose8(rr, t);
#pragma unroll
            for (int k = 0; k < 8; ++k) *(half8*)(Ks + (j0 + k) * SA + c8) = rr[k];
#pragma unroll
            for (int i = 0; i < 8; ++i) *(half8*)(KT + (c8 + i) * SB + j0) = t[i];
        } else if (kind == 2) { half8 t[8]; transpose8(rr, t);
#pragma unroll
            for (int i = 0; i < 8; ++i) *(half8*)(VT + (c8 + i) * SB + j0) = t[i];
        }
        if (kind < 3 && cc + 1 < NCT) load_rows8(u16, nrb, nL, dir, ncn * 128 + j0, ucol, rr);
        __syncthreads();
        const float tot = scal[0], m_new = scal[1];
        if (want_y) {
            { const int ws_ = wave & 1, wl = wave >> 1;
              if (!(ws_ == 1 && wl < 2)) {
                f32x4 g_[4][2]; zero_acc(g_);
                mma_lds<4, 2>(g_, Ks + ws_ * 64 * SA, SA, Qs + wl * 32 * SA, SA, 2, lane);
#pragma unroll
                for (int a = 0; a < 4; ++a) {
                    const int s0 = ws_ * 64 + a * 16 + (lane >> 4) * 4; const f32x4 gs4 = *(const f32x4*)(gsv + s0);
#pragma unroll
                    for (int q = 0; q < 2; ++q) {
                        const int l = wl * 32 + q * 16 + (lane & 15); const float cm = cumf[l] - mtv[l]; half4 hv;
#pragma unroll
                        for (int i = 0; i < 4; ++i) hv[i] = (half_t)((s0 + i) <= l ? g_[a][q][i] * fexp(cm + gs4[i]) : 0.f);
                        *(half4*)(SC + l * SB + s0) = hv;
                    } }
              } }
            f32x4 h1[4][1]; zero_acc(h1);
            mma_lds<4, 1>(h1, CS, SA, Qs + wave * 16 * SA, SA, 2, lane);
            f32x4 dq = {0.f, 0.f, 0.f, 0.f};
            { const int r_ = lane & 15, kq_ = (lane >> 4) * 8;
#pragma unroll
              for (int ks = 0; ks < 2; ++ks) { half8 na; const f32x4 n0 = *(const f32x4*)(nvec + ks * 32 + kq_), n1 = *(const f32x4*)(nvec + ks * 32 + kq_ + 4);
#pragma unroll
                  for (int i = 0; i < 4; ++i) { na[i] = (half_t)n0[i]; na[4 + i] = (half_t)n1[i]; }
                  dq = mfma16(na, *(const half8*)(Qs + (wave * 16 + r_) * SA + ks * 32 + kq_), dq); } }
            __syncthreads();
            f32x4 h2[4]; f32x4 d1 = {0.f, 0.f, 0.f, 0.f};
#pragma unroll
            for (int a = 0; a < 4; ++a) h2[a] = (f32x4){0.f, 0.f, 0.f, 0.f};
            { const int r = lane & 15, kq = (lane >> 4) * 8;
              for (int ks = 0; ks < wave / 2 + 1; ++ks) {
                  const half8 bfr = *(const half8*)(SC + (wave * 16 + r) * SB + ks * 32 + kq);
#pragma unroll
                  for (int a = 0; a < 4; ++a) { const half8 afr = *(const half8*)(VT + (a * 16 + r) * SB + ks * 32 + kq); h2[a] = mfma16(afr, bfr, h2[a]); }
                  d1 = mfma16(ones, bfr, d1); } }
            { const int l = wave * 16 + (lane & 15); const float ai = fexp(cumf[l] + m_in - mtv[l]); const float rden = 1.0f / fmaxf(fabsf(dq[0] * ai + d1[0]), fexp(-mtv[l]));
              const int pi = c * 128 + l, pos = dir == 0 ? pi : Lseq - 1 - pi;
#pragma unroll
              for (int a = 0; a < 4; ++a) { const int v0 = a * 16 + (lane >> 4) * 4; f32x4 y;
#pragma unroll
                  for (int i = 0; i < 4; ++i) y[i] = (h1[a][0][i] * ai + h2[a][i]) * rden;
                  *(half4*)(hout + (size_t)(rowbase + pos) * 384 + h * 64 + v0) = to_half4(y); } }
        }
        { const float sc = fexp(tot + m_in - m_new);
#pragma unroll
          for (int q = 0; q < 2; ++q) accC[0][q] *= sc;
          { const int r = lane & 15, kq = (lane >> 4) * 8;
#pragma unroll
            for (int ks = 0; ks < 4; ++ks) {
              const half8 a = *(const half8*)(KT + ((wave >> 1) * 16 + r) * SB + ks * 32 + kq);
              const f32x4 e0 = *(const f32x4*)(ee + ks * 32 + kq), e1 = *(const f32x4*)(ee + ks * 32 + kq + 4);
#pragma unroll
              for (int q = 0; q < 2; ++q) { half8 bb = *(const half8*)(VT + ((wave & 1) * 32 + q * 16 + r) * SB + ks * 32 + kq);
#pragma unroll
                  for (int i = 0; i < 4; ++i) { bb[i] = (half_t)((float)bb[i] * e0[i]); bb[4 + i] = (half_t)((float)bb[4 + i] * e1[i]); }
                  accC[0][q] = mfma16(a, bb, accC[0][q]); } } }
          if ((wave & 1) == 0) { f32x4 an = {0.f, 0.f, 0.f, 0.f}; const int r_ = lane & 15, kq_ = (lane >> 4) * 8;
#pragma unroll
              for (int ks = 0; ks < 4; ++ks) { half8 eb; const f32x4 e0 = *(const f32x4*)(ee + ks * 32 + kq_), e1 = *(const f32x4*)(ee + ks * 32 + kq_ + 4);
#pragma unroll
                  for (int i = 0; i < 4; ++i) { eb[i] = (half_t)e0[i]; eb[4 + i] = (half_t)e1[i]; }
                  an = mfma16(*(const half8*)(KT + ((wave >> 1) * 16 + r_) * SB + ks * 32 + kq_), eb, an); }
              if ((lane & 15) == 0) {
#pragma unroll
                  for (int i = 0; i < 4; ++i) { const int d = (wave >> 1) * 16 + (lane >> 4) * 4 + i; nvec[d] = sc * nvec[d] + an[i]; } } } }
        m_in = m_new;
        __syncthreads();
#pragma unroll
        for (int q = 0; q < 2; ++q) { const int v = (wave & 1) * 32 + q * 16 + (lane & 15), d0 = (wave >> 1) * 16 + (lane >> 4) * 4; *(half4*)(CS + v * SA + d0) = to_half4(accC[0][q]); }
    }
    __syncthreads();
}

__device__ __forceinline__ cplx cmul(cplx a, cplx b) { return cplx{a.x * b.x - a.y * b.y, a.x * b.y + a.y * b.x}; }
__device__ __forceinline__ cplx cadd(cplx a, cplx b) { return cplx{a.x + b.x, a.y + b.y}; }
__device__ __forceinline__ cplx csub(cplx a, cplx b) { return cplx{a.x - b.x, a.y - b.y}; }
__device__ __forceinline__ void sincos_turns(float x, float& s, float& c) {
#ifdef EMU
    s = sinf(6.283185307179586f * x); c = cosf(6.283185307179586f * x);
#else
    s = __builtin_amdgcn_sinf(x); c = __builtin_amdgcn_cosf(x);
#endif
}
#define PADI(i) ((i) + ((i) >> 5))
template <bool INV> __device__ __forceinline__ void r4(cplx& a0, cplx& a1, cplx& a2, cplx& a3) {
    const cplx t0 = cadd(a0, a2), t1 = csub(a0, a2), t2 = cadd(a1, a3), t3 = csub(a1, a3);
    a0 = cadd(t0, t2); a2 = csub(t0, t2);
    if (!INV) { a1 = cplx{t1.x + t3.y, t1.y - t3.x}; a3 = cplx{t1.x - t3.y, t1.y + t3.x}; }
    else      { a1 = cplx{t1.x - t3.y, t1.y + t3.x}; a3 = cplx{t1.x + t3.y, t1.y - t3.x}; }
}
template <bool INV> __device__ __forceinline__ void fft16(cplx (&v)[16]) {
#pragma unroll
    for (int l0 = 0; l0 < 4; ++l0) r4<INV>(v[l0], v[l0 + 4], v[l0 + 8], v[l0 + 12]);
    const float C1 = 0.9238795325112867f, S1 = 0.3826834323650898f, C2 = 0.7071067811865476f;
    const float sg = INV ? 1.f : -1.f;
#define TWM(idx, cr, ci) v[idx] = cmul(v[idx], cplx{(cr), sg * (ci)})
    TWM(1 + 4 * 1, C1, S1); TWM(2 + 4 * 1, C2, C2); TWM(3 + 4 * 1, S1, C1);
    TWM(1 + 4 * 2, C2, C2); TWM(2 + 4 * 2, 0.f, 1.f); TWM(3 + 4 * 2, -C2, C2);
    TWM(1 + 4 * 3, S1, C1); TWM(2 + 4 * 3, -C2, C2); TWM(3 + 4 * 3, -C1, -S1);
#undef TWM
    cplx o[16];
#pragma unroll
    for (int m0 = 0; m0 < 4; ++m0) { cplx a0 = v[4 * m0], a1 = v[4 * m0 + 1], a2 = v[4 * m0 + 2], a3 = v[4 * m0 + 3]; r4<INV>(a0, a1, a2, a3);
        o[m0] = a0; o[m0 + 4] = a1; o[m0 + 8] = a2; o[m0 + 12] = a3; }
#pragma unroll
    for (int i = 0; i < 16; ++i) v[i] = o[i];
}
__device__ __forceinline__ void twpow(cplx w1, cplx (&w)[16]) {
    w[1] = w1; w[2] = cmul(w1, w1); w[3] = cmul(w[2], w1); w[4] = cmul(w[2], w[2]); w[5] = cmul(w[4], w1); w[6] = cmul(w[4], w[2]); w[7] = cmul(w[4], w[3]); w[8] = cmul(w[4], w[4]);
#pragma unroll
    for (int m = 9; m < 16; ++m) w[m] = cmul(w[8], w[m - 8]);
}
#ifdef EMU
#define OPAQUE_I(x)
#else
#define OPAQUE_I(x) asm volatile("" : "+v"(x))
#endif
template <int NS> __device__ __forceinline__ void fft_fwd16(cplx* buf0, cplx* buf1, int N, int tid) {
#pragma unroll 1
    for (int n = N; n >= 32; n >>= 4) { const int q = n >> 4, qs = q + (q >> 5);
        for (int i = tid; i < N / 16; i += NT) {
            const int blk = i / q, j = i - blk * q; int pb = PADI(blk * n + j); OPAQUE_I(pb);
            float s, c; sincos_turns(-(float)j / (float)n, s, c);
            const cplx w1{c, s};
#pragma unroll
            for (int st = 0; st < NS; ++st) { cplx* buf = (st == 0 ? buf0 : buf1) + pb;
                cplx v[16];
#pragma unroll
                for (int l = 0; l < 16; ++l) v[l] = buf[l * qs];
                fft16<false>(v);
                buf[0] = v[0];
                cplx wm = w1;
#pragma unroll
                for (int m = 1; m < 16; ++m) { buf[m * qs] = cmul(v[m], wm); wm = cmul(wm, w1); }
                LOADER_FENCE(); }
        }
        __syncthreads(); }
}
template <int NS> __device__ __forceinline__ void fft_inv16(cplx* buf0, cplx* buf1, int N, int tid) {
#pragma unroll 1
    for (int n = 32; n <= N; n <<= 4) { const int q = n >> 4, qs = q + (q >> 5);
        for (int i = tid; i < N / 16; i += NT) {
            const int blk = i / q, j = i - blk * q; int pb = PADI(blk * n + j); OPAQUE_I(pb);
            float s, c; sincos_turns((float)j / (float)n, s, c);
            const cplx w1{c, s};
#pragma unroll
            for (int st = 0; st < NS; ++st) { cplx* buf = (st == 0 ? buf0 : buf1) + pb;
                cplx v[16];
                v[0] = buf[0];
                cplx wm = w1;
#pragma unroll
                for (int m = 1; m < 16; ++m) { v[m] = cmul(buf[m * qs], wm); wm = cmul(wm, w1); }
                fft16<true>(v);
#pragma unroll
                for (int l = 0; l < 16; ++l) buf[l * qs] = v[l];
                LOADER_FENCE(); }
        }
        __syncthreads(); }
}
static_assert(2 * SEQ == 512 || 2 * SEQ == 8192, "FFT size must be 2*16^k");
static_assert(2 * CTXL == 512 || 2 * CTXL == 8192, "FFT size must be 2*16^k");
constexpr int HBUF = (2 * SEQ + (2 * SEQ) / 32 + 8);
constexpr int HPT = (SEQ + NT - 1) / NT;
__device__ __forceinline__ void hy_conv8(const half_t* p, int t0, int L, float w0, float w1, float w2, float bsv, float (&o)[8]) {
    const half8 m = *(const half8*)(p + t0);
    float e[10]; e[0] = t0 > 0 ? (float)p[t0 - 1] : 0.f; e[9] = t0 + 8 < L ? (float)p[t0 + 8] : 0.f;
#pragma unroll
    for (int i = 0; i < 8; ++i) e[i + 1] = (float)m[i];
#pragma unroll
    for (int i = 0; i < 8; ++i) o[i] = w0 * e[i] + w1 * e[i + 1] + w2 * e[i + 2] + bsv;
}
template <int NS> __device__ __forceinline__ void hyena_seg_t(const Frame& F, int layer, int c, const int seg) {
    cplx* bufA = (cplx*)F.smem;
    cplx* bufB = bufA + HBUF;
    float* red = (float*)(bufB + HBUF);
    const int tid = F.tid;
    const float* cwp = F.in(I_HCW) + layer * 3 * 768; const float* cbp = F.in(I_HCB) + layer * 768;
    {
        const int L = seg == 0 ? SEQ : CTXL, N = 2 * L;
        const half_t* hyt = (const half_t*)(F.ws + WS_HYT) + (seg == 0 ? 0 : (size_t)NB * 768 * SEQ);
        float* z1 = (float*)(F.ws + WS_XN) + (seg == 0 ? 0 : (size_t)NB * 256 * SEQ);
        float* yht = (float*)(F.ws + WS_YHT) + (seg == 0 ? 0 : (size_t)NB * 256 * SEQ);
        const float* ft = (const float*)(F.ws + WS_FT) + (seg == 0 ? (size_t)layer * 256 * 4 * SEQ : (size_t)2 * 256 * 4 * SEQ);
        for (int order = 0; order < 2; ++order) {
            const float* hfw = ft + ((size_t)(c * 2 + order) * 2 + 0) * L; const float* hbw = ft + ((size_t)(c * 2 + order) * 2 + 1) * L;
            float asum = 0.f;
            for (int i_ = tid; i_ < N; i_ += NT) { int i = i_; OPAQUE_I(i); const float v = i < L ? hfw[i] : (i == L ? 0.f : hbw[N - i]); bufA[PADI(i)] = cplx{v, 0.f}; asum += fabsf(v); }
            asum = wave_sum(asum);
            if (F.lane == 0) red[F.wave] = asum;
            __syncthreads();
            float tot = 0.f; for (int w = 0; w < NT / 64; ++w) tot += red[w];
            fft_fwd16<1>(bufA, bufA, N, tid);
            half4 Hh[HPT];
            const float hs = 1.0f / tot, invN = 1.0f / (float)N;
#pragma unroll
            for (int k = 0; k < HPT; ++k) { int i = tid + k * NT; OPAQUE_I(i); half4 hv;
                if (i < N / 2) { const cplx a = bufA[PADI(2 * i)], b_ = bufA[PADI(2 * i + 1)]; const cplx s = cadd(a, b_), d = csub(a, b_);
                    hv[0] = (half_t)(s.x * hs); hv[1] = (half_t)(s.y * hs); hv[2] = (half_t)(d.x * hs); hv[3] = (half_t)(d.y * hs); }
                else { hv[0] = hv[1] = hv[2] = hv[3] = (half_t)0.f; }
                Hh[k] = hv; LOADER_FENCE(); }
            __syncthreads();
            const int gch = 256 * (order + 1) + c;
            for (int pr = 0; pr < NB / 2; pr += NS) {
#pragma unroll
                for (int st = 0; st < NS; ++st) { cplx* buf = st == 0 ? bufA : bufB; const int b0 = 2 * (pr + st), b1 = b0 + 1;
                    const float vw0 = cwp[c], vw1 = cwp[768 + c], vw2 = cwp[1536 + c], vb = cbp[c];
                    const half_t* v0p = hyt + ((size_t)b0 * 768 + c) * L; const half_t* v1p = hyt + ((size_t)b1 * 768 + c) * L;
                    const float* z0q = z1 + ((size_t)b0 * 256 + c) * L; const float* z1q = z1 + ((size_t)b1 * 256 + c) * L;
                    for (int t0_ = tid * 8; t0_ < N; t0_ += NT * 8) { int t0 = t0_; OPAQUE_I(t0);
                        if (t0 < L) { float za[8], zb[8];
                            if (order == 0) { hy_conv8(v0p, t0, L, vw0, vw1, vw2, vb, za); hy_conv8(v1p, t0, L, vw0, vw1, vw2, vb, zb); }
                            else {
#pragma unroll
                                for (int i = 0; i < 8; ++i) { za[i] = z0q[t0 + i]; zb[i] = z1q[t0 + i]; } }
#pragma unroll
                            for (int i = 0; i < 8; ++i) buf[PADI(t0 + i)] = cplx{za[i], zb[i]}; }
                        else {
#pragma unroll
                            for (int i = 0; i < 8; ++i) buf[PADI(t0 + i)] = cplx{0.f, 0.f}; }
                        LOADER_FENCE();
                    } }
                __syncthreads();
                fft_fwd16<NS>(bufA, bufB, N, tid);
#pragma unroll
                for (int st = 0; st < NS; ++st) { cplx* buf = st == 0 ? bufA : bufB;
#pragma unroll
                    for (int k = 0; k < HPT; ++k) { int i = tid + k * NT; OPAQUE_I(i);
                        if (i < N / 2) { const cplx a = buf[PADI(2 * i)], b_ = buf[PADI(2 * i + 1)];
                            const cplx h0{(float)Hh[k][0] * invN, (float)Hh[k][1] * invN}, h1{(float)Hh[k][2] * invN, (float)Hh[k][3] * invN};
                            const cplx s = cmul(cadd(a, b_), h0), d = cmul(csub(a, b_), h1);
                            buf[PADI(2 * i)] = cadd(s, d); buf[PADI(2 * i + 1)] = csub(s, d); }
                        LOADER_FENCE(); } }
                __syncthreads();
                fft_inv16<NS>(bufA, bufB, N, tid);
#pragma unroll
                for (int st = 0; st < NS; ++st) { cplx* buf = st == 0 ? bufA : bufB; const int b0 = 2 * (pr + st), b1 = b0 + 1;
                    const float gw0 = cwp[gch], gw1 = cwp[768 + gch], gw2 = cwp[1536 + gch], gb = cbp[gch];
                    const float vw0 = cwp[c], vw1 = cwp[768 + c], vw2 = cwp[1536 + c], vb = cbp[c];
                    const float skip = F.in(I_HSKIP)[(layer * 2 + order) * 256 + c];
                    const half_t* v0p = hyt + ((size_t)b0 * 768 + c) * L; const half_t* v1p = hyt + ((size_t)b1 * 768 + c) * L;
                    const float* z0q = z1 + ((size_t)b0 * 256 + c) * L; const float* z1q = z1 + ((size_t)b1 * 256 + c) * L;
                    const half_t* g0p = hyt + ((size_t)b0 * 768 + gch) * L; const half_t* g1p = hyt + ((size_t)b1 * 768 + gch) * L;
                    float* d0 = (order == 0 ? z1 : yht) + ((size_t)b0 * 256 + c) * L; float* d1 = (order == 0 ? z1 : yht) + ((size_t)b1 * 256 + c) * L;
                    for (int t0_ = tid * 8; t0_ < L; t0_ += NT * 8) { int t0 = t0_; OPAQUE_I(t0);
                        float za[8], zb[8], ga[8], gb_[8];
                        if (order == 0) { hy_conv8(v0p, t0, L, vw0, vw1, vw2, vb, za); hy_conv8(v1p, t0, L, vw0, vw1, vw2, vb, zb); }
                        else {
#pragma unroll
                            for (int i = 0; i < 8; ++i) { za[i] = z0q[t0 + i]; zb[i] = z1q[t0 + i]; } }
                        hy_conv8(g0p, t0, L, gw0, gw1, gw2, gb, ga); hy_conv8(g1p, t0, L, gw0, gw1, gw2, gb, gb_);
                        f32x4 oa[2], ob[2];
#pragma unroll
                        for (int i = 0; i < 8; ++i) { const cplx y = buf[PADI(t0 + i)]; oa[i >> 2][i & 3] = ga[i] * (y.x + skip * za[i]); ob[i >> 2][i & 3] = gb_[i] * (y.y + skip * zb[i]); }
                        *(f32x4*)(d0 + t0) = oa[0]; *(f32x4*)(d0 + t0 + 4) = oa[1]; *(f32x4*)(d1 + t0) = ob[0]; *(f32x4*)(d1 + t0 + 4) = ob[1];
                        LOADER_FENCE();
                    } }
                __syncthreads();
            }
        }
    }
}
__device__ __forceinline__ void hyena_channel(const Frame& F, int layer, int c) {
    constexpr int NS = (NB % 4 == 0) ? 2 : 1;
    for (int seg = 0; seg < (layer == 0 ? 2 : 1); ++seg) hyena_seg_t<NS>(F, layer, c, seg);
}
__device__ __forceinline__ int queue_pull(const Frame& F, unsigned* head) {
    int* slot = (int*)(F.smem + LDS_BYTES - 64);
    __syncthreads();
    if (F.tid == 0) *slot = (int)atomicAdd(head, 1u);
    __syncthreads();
    const int v = *slot;
    return v;
}
__device__ __forceinline__ void phase_mixers(const Frame& F, int layer) {
    const int bid = blockIdx.x;
    constexpr int NSCAN = 2 * NB * 6 * 2;
    unsigned* qhead = (unsigned*)(F.ws + WS_CTL) + CW_QUE + layer * 128;
    if (bid < NSCAN) {
        const int k = bid >> 1, kind = bid & 1, dir = k % 2, h = (k / 2) % 6, b = k / 12;
        if (kind == 0) ssd_block(F, layer, b, h, dir); else mlstm_block(F, layer, b, h, dir);
    }
    for (;;) { const int c = queue_pull(F, qhead); if (c >= 256) break; hyena_channel(F, layer, c); }
    for (;;) { const int it = queue_pull(F, qhead + 64); if (it >= IT_TMOE) break; moe_transpose_item(F, layer, it); }
}

__device__ __forceinline__ void phase_combine(const Frame& F, int layer) {
    const int nrows = layer == 0 ? TT : TL;
    const half_t* u16 = (const half_t*)(F.ws + WS_U16);
    const half_t* yf = (const half_t*)(F.ws + WS_YF); const half_t* yb = yf + (size_t)TT * 384; const half_t* hf = yb + (size_t)TT * 384; const half_t* hb = hf + (size_t)TT * 384;
    half_t* yl = (half_t*)(F.ws + WS_XN);
    const float* snw = F.in(I_SNW) + layer * 384; const float* mnw = F.in(I_MNW) + layer * 384;
    const int lane = F.lane, k8 = (lane < 48 ? lane : 0) * 8, nwaves = gridDim.x * (NT / 64);
    f32x4 sw[2], mw[2];
#pragma unroll
    for (int q = 0; q < 2; ++q) { sw[q] = *(const f32x4*)(snw + k8 + q * 4); mw[q] = *(const f32x4*)(mnw + k8 + q * 4); }
    int row = blockIdx.x * (NT / 64) + F.wave;
    half8 a[6];
#define COMB_LOAD(dst, r) { const size_t ro = (size_t)(r); dst[0] = *(const half8*)(yf + ro * 384 + k8); dst[1] = *(const half8*)(yb + ro * 384 + k8); dst[2] = *(const half8*)(u16 + ro * UW + k8); \
        dst[3] = *(const half8*)(hf + ro * 384 + k8); dst[4] = *(const half8*)(hb + ro * 384 + k8); dst[5] = *(const half8*)(u16 + ro * UW + 2176 + k8); }
    if (row < nrows) COMB_LOAD(a, row)
    for (; row < nrows; row += nwaves) {
        const int nrow = row + nwaves;
        half8 an[6];
        if (nrow < nrows) COMB_LOAD(an, nrow)
        const size_t ro = (size_t)row;
        float g[8], hv[8]; float ss = 0.f, hs = 0.f;
#pragma unroll
        for (int i = 0; i < 8; ++i) { g[i] = ((float)a[0][i] + (float)a[1][i]) * fsilu((float)a[2][i]); ss += g[i] * g[i]; hv[i] = (float)a[3][i] + (float)a[4][i]; hs += hv[i]; }
        if (lane >= 48) ss = 0.f;
        ss = wave_sum(ss);
        hs += __shfl_xor(hs, 1); hs += __shfl_xor(hs, 2); hs += __shfl_xor(hs, 4);
        const float mu = hs * (1.0f / 64.f);
        float vs = 0.f;
#pragma unroll
        for (int i = 0; i < 8; ++i) { hv[i] -= mu; vs += hv[i] * hv[i]; }
        vs += __shfl_xor(vs, 1); vs += __shfl_xor(vs, 2); vs += __shfl_xor(vs, 4);
        const float rs = 1.0f / sqrtf(ss * (1.0f / 384.f) + EPSF), rstd = 1.0f / sqrtf(vs * (1.0f / 64.f) + EPSF);
        if (lane < 48) { half8 o1, o2;
#pragma unroll
            for (int i = 0; i < 8; ++i) { o1[i] = (half_t)(g[i] * rs * sw[i >> 2][i & 3]); o2[i] = (half_t)(hv[i] * rstd * mw[i >> 2][i & 3] / (1.0f + fexp(-(float)a[5][i]))); }
            *(half8*)(yl + ro * D + k8) = o1; *(half8*)(yl + ro * D + 640 + k8) = o2; }
#pragma unroll
        for (int i = 0; i < 6; ++i) a[i] = an[i];
    }
#undef COMB_LOAD
    { const int ntile = nrows / 32, hbk = blockIdx.x * 2 + (F.tid >> 8), c = F.tid & 255;
      for (int tl = hbk; tl < ntile; tl += gridDim.x * 2) {
          const int row0 = tl * 32; const bool isl = row0 < TL; const int L = isl ? SEQ : CTXL; const int rc = isl ? row0 : row0 - TL; const int b = rc / L, t0 = rc % L;
          const float* src = (const float*)(F.ws + WS_YHT) + (isl ? 0 : (size_t)NB * 256 * SEQ) + ((size_t)b * 256 + c) * L + t0;
          f32x4 v[8];
#pragma unroll
          for (int q = 0; q < 8; ++q) v[q] = *(const f32x4*)(src + q * 4);
#pragma unroll
          for (int i = 0; i < 32; ++i) yl[(size_t)(row0 + i) * D + 384 + c] = (half_t)v[i >> 2][i & 3]; } }
}

struct EpiOutproj {
    Frame F; int layer;
    __device__ __forceinline__ void operator()(const f32x4 (&acc)[2][2][4][2], const g8::Unit& u, int wr, int wc, int fr, int fq) const {
#pragma unroll
        for (int ai = 0; ai < 2; ++ai)
#pragma unroll
            for (int m = 0; m < 4; ++m) {
                const int srow = u.pm * 256 + ai * 128 + wr * 64 + m * 16 + fr;
                int row = srow;
                if (layer == 1 && srow < TL) { const int b = srow / SEQ, s = srow % SEQ; row = b * SEQ + (s % GROWS) * GW + s / GROWS; }
                const float* g1 = modp(F, layer, row_mod(row), 2);
                const float* xi = F.xrow_in(layer, row); float* xo = F.xrow(row);
#pragma unroll
                for (int bj = 0; bj < 2; ++bj)
#pragma unroll
                    for (int n = 0; n < 2; ++n) { const int c0 = u.pn * 256 + bj * 128 + wc * 32 + n * 16 + 4 * fq;
                        const f32x4 xv = *(const f32x4*)(xi + c0), gv = *(const f32x4*)(g1 + c0);
                        *(f32x4*)(xo + c0) = xv + gv * acc[ai][bj][m][n]; }
            }
    }
};
__device__ __forceinline__ void outproj_ctx_tiles(const Frame& F, int layer) {
    const half_t* yl = (const half_t*)(F.ws + WS_XN) + (size_t)TL * D;
    const half_t* wt = (const half_t*)(F.ws + WS_WOUT) + (size_t)layer * D * D;
    const int lane = F.lane, wave = F.wave, r = lane & 15, kq = (lane >> 4) * 8;
    const int ntile = (TC / 64) * (D / 64);
    for (int t = blockIdx.x; t < ntile; t += gridDim.x) {
        const int m0 = (t / (D / 64)) * 64, n0 = (t % (D / 64)) * 64;
        const int mt = wave >> 1, nt0 = (wave & 1) * 2;
        const half_t* ap = yl + (size_t)(m0 + mt * 16 + r) * D + kq;
        const half_t* bp0 = wt + (size_t)(n0 + nt0 * 16 + r) * D + kq; const half_t* bp1 = bp0 + (size_t)16 * D;
        f32x4 c0 = {0.f, 0.f, 0.f, 0.f}, c1 = {0.f, 0.f, 0.f, 0.f};
#pragma unroll 1
        for (int kb = 0; kb < D; kb += 256) {
            half8 a[8], b0[8], b1[8];
#pragma unroll
            for (int q = 0; q < 8; ++q) { a[q] = *(const half8*)(ap + kb + q * 32); b0[q] = *(const half8*)(bp0 + kb + q * 32); b1[q] = *(const half8*)(bp1 + kb + q * 32); }
#pragma unroll
            for (int q = 0; q < 8; ++q) { c0 = mfma16(a[q], b0[q], c0); c1 = mfma16(a[q], b1[q], c1); }
        }
#pragma unroll
        for (int i = 0; i < 4; ++i) {
            const int row = TL + m0 + mt * 16 + (lane >> 4) * 4 + i;
            const float* g1 = modp(F, layer, NB, 2); const float* xi = F.xrow_in(layer, row); float* xo = F.xrow(row);
            const int ca = n0 + nt0 * 16 + r, cb = ca + 16;
            xo[ca] = xi[ca] + g1[ca] * c0[i]; xo[cb] = xi[cb] + g1[cb] * c1[i];
        }
    }
}
__device__ __forceinline__ void phase_outproj(const Frame& F, int layer) {
    if (layer == 0) outproj_ctx_tiles(F, layer);
    g8::DenseSched S; S.abase = (const char*)(F.ws + WS_XN); S.bbase = (const char*)((const half_t*)(F.ws + WS_WOUT) + (size_t)layer * D * D); S.K = D; S.nM = TL / 256; S.nN = D / 256; S.G = gridDim.x; S.c = blockIdx.x;
    EpiOutproj E{F, layer};
    g8::gemm_phase(F.smem, D, S, E);
}

constexpr int RLD = D + 8;
__device__ __forceinline__ void phase_router(const Frame& F, int layer, bool dry = false) {
    const int nrows = layer == 0 ? TT : TL, total = nrows / 16;
    half_t* Th = (half_t*)F.smem;
    half_t* Tl = Th + 16 * RLD;
    float* PART = (float*)(Tl + 16 * RLD);
    float* LG = PART + 8 * 16 * 48;
    half_t* tb = (half_t*)(F.ws + WS_XN);
    unsigned* cnt = (unsigned*)(F.ws + WS_CTL) + CW_CNT + layer * 64 * CSTR;
    int* list = (int*)(F.ws + WS_LIST); float* pw = (float*)(F.ws + WS_PW);
    const float* nw = F.in(I_N2W) + layer * D;
    const half_t* wr = (const half_t*)(F.ws + WS_WR) + (size_t)layer * 2 * 48 * D;
    const int lane = F.lane, wave = F.wave, r = lane & 15, kq = (lane >> 4) * 8, kb = wave * 128;
    half8 bh[3][4];
#pragma unroll
    for (int nt = 0; nt < 3; ++nt)
#pragma unroll
        for (int ks = 0; ks < 4; ++ks) { const size_t o = (size_t)(nt * 16 + r) * D + kb + ks * 32 + kq; bh[nt][ks] = *(const half8*)(wr + o); }
    int mc = -1; f32x4 g[4], s4[4];
    int it = blockIdx.x;
    f32x4 v[2][4];
    if (it < total) {
#pragma unroll
        for (int rr = 0; rr < 2; ++rr) { const float* x = F.xrow(it * 16 + wave * 2 + rr);
#pragma unroll
            for (int q = 0; q < 4; ++q) v[rr][q] = *(const f32x4*)(x + q * 256 + lane * 4); } }
    int p_row = -1, p_ea = 0, p_eb = 0; unsigned p_pa = 0, p_pb = 0; float p_w0 = 0.f, p_w1 = 0.f;
    for (; it < total; it += gridDim.x) {
        const int row0 = it * 16, nit = it + gridDim.x;
        f32x4 vn[2][4];
        if (nit < total) {
#pragma unroll
            for (int rr = 0; rr < 2; ++rr) { const float* x = F.xrow(nit * 16 + wave * 2 + rr);
#pragma unroll
                for (int q = 0; q < 4; ++q) vn[rr][q] = *(const f32x4*)(x + q * 256 + lane * 4); } }
        { const int m = row_mod(row0);
          if (m != mc) { mc = m; const float* sh = modp(F, layer, m, 3); const float* scl = modp(F, layer, m, 4);
#pragma unroll
              for (int q = 0; q < 4; ++q) { const int k = q * 256 + lane * 4; const f32x4 a = *(const f32x4*)(nw + k), b = *(const f32x4*)(scl + k); s4[q] = *(const f32x4*)(sh + k);
#pragma unroll
                  for (int e = 0; e < 4; ++e) g[q][e] = a[e] * (1.0f + b[e]); } } }
#pragma unroll
        for (int rr = 0; rr < 2; ++rr) {
            float ss = 0.f;
#pragma unroll
            for (int q = 0; q < 4; ++q) ss += v[rr][q][0] * v[rr][q][0] + v[rr][q][1] * v[rr][q][1] + v[rr][q][2] * v[rr][q][2] + v[rr][q][3] * v[rr][q][3];
            ss = wave_sum(ss);
            const float rs = 1.0f / sqrtf(ss * (1.0f / D) + EPSF);
            const int lr = wave * 2 + rr, row = row0 + lr;
#pragma unroll
            for (int q = 0; q < 4; ++q) { const int k = q * 256 + lane * 4; half4 h, l;
#pragma unroll
                for (int e = 0; e < 4; ++e) { const float tv = v[rr][q][e] * rs * g[q][e] + s4[q][e]; h[e] = (half_t)tv; l[e] = (half_t)((tv - (float)h[e]) * 2048.f); }
                *(half4*)(tb + (size_t)row * D + k) = h; *(half4*)(Th + lr * RLD + k) = h; *(half4*)(Tl + lr * RLD + k) = l; }
        }
        __syncthreads();
        { f32x4 ah[3], al[3]; half8 bl[3][4];
#pragma unroll
          for (int nt = 0; nt < 3; ++nt)
#pragma unroll
              for (int ks = 0; ks < 4; ++ks) bl[nt][ks] = *(const half8*)(wr + (size_t)48 * D + (size_t)(nt * 16 + r) * D + kb + ks * 32 + kq);
#pragma unroll
          for (int nt = 0; nt < 3; ++nt) { ah[nt] = (f32x4){0.f, 0.f, 0.f, 0.f}; al[nt] = (f32x4){0.f, 0.f, 0.f, 0.f}; }
#pragma unroll
          for (int ks = 0; ks < 4; ++ks) {
              const half8 a_h = *(const half8*)(Th + r * RLD + kb + ks * 32 + kq), a_l = *(const half8*)(Tl + r * RLD + kb + ks * 32 + kq);
#pragma unroll
              for (int nt = 0; nt < 3; ++nt) { ah[nt] = mfma16(a_h, bh[nt][ks], ah[nt]); al[nt] = mfma16(a_l, bh[nt][ks], al[nt]); al[nt] = mfma16(a_h, bl[nt][ks], al[nt]); }
          }
#pragma unroll
          for (int nt = 0; nt < 3; ++nt)
#pragma unroll
              for (int i = 0; i < 4; ++i) PART[(wave * 16 + (lane >> 4) * 4 + i) * 48 + nt * 16 + r] = ah[nt][i] + al[nt][i] * (1.0f / 2048.f); }
        __syncthreads();
        for (int o = F.tid; o < 16 * 48; o += NT) { const int col = o % 48; float sum = 0.f;
#pragma unroll
            for (int w = 0; w < 8; ++w) sum += PART[w * 16 * 48 + o];
            float bias = 0.f; if (col < 4) bias = F.in(I_GRB)[layer * 4 + col]; else if (col < 36) bias = F.in(I_ERB)[layer * 32 + col - 4];
            LG[o] = sum + bias; }
        __syncthreads();
        if (F.tid < 16) {
            if (p_row >= 0 && !dry) { list[(size_t)(p_ea * 2 + 0) * LCAP + p_pa] = p_row * 2 + 0; list[(size_t)(p_eb * 2 + 1) * LCAP + p_pb] = p_row * 2 + 1; pw[p_row * 2 + 0] = p_w0; pw[p_row * 2 + 1] = p_w1; }
            const int row = row0 + F.tid; const float* lg = LG + F.tid * 48;
            int gi = 0; float gm = lg[0];
            for (int q = 1; q < 4; ++q) if (lg[q] > gm) { gm = lg[q]; gi = q; }
            float gs = 0.f; for (int q = 0; q < 4; ++q) gs += expf(lg[q] - gm);
            const float grp_p = 1.0f / gs;
            const float* el = lg + 4 + gi * 8;
            int i0 = 0; float e0 = el[0];
            for (int q = 1; q < 8; ++q) if (el[q] > e0) { e0 = el[q]; i0 = q; }
            int i1 = -1; float e1 = -3.0e38f;
            for (int q = 0; q < 8; ++q) if (q != i0 && el[q] > e1) { e1 = el[q]; i1 = q; }
            const float p1 = expf(e1 - e0);
            p_w0 = grp_p * (1.0f / (1.0f + p1)); p_w1 = grp_p * (p1 / (1.0f + p1));
            p_ea = gi * 8 + i0; p_eb = gi * 8 + i1; p_row = row;
            if (!dry) { p_pa = atomicAdd(&cnt[(p_ea * 2 + 0) * CSTR], 1u); p_pb = atomicAdd(&cnt[(p_eb * 2 + 1) * CSTR], 1u); }
        }
#pragma unroll
        for (int rr = 0; rr < 2; ++rr)
#pragma unroll
            for (int q = 0; q < 4; ++q) v[rr][q] = vn[rr][q];
    }
    if (F.tid < 16 && p_row >= 0 && !dry) { list[(size_t)(p_ea * 2 + 0) * LCAP + p_pa] = p_row * 2 + 0; list[(size_t)(p_eb * 2 + 1) * LCAP + p_pb] = p_row * 2 + 1; pw[p_row * 2 + 0] = p_w0; pw[p_row * 2 + 1] = p_w1; }
    __syncthreads();
}

constexpr int MOE_PRE_OFF = g8::STAGE_BYTES;
struct MoeSchedA {
    const char* abase; const char* wbase; const int* pre; const unsigned* cnt; const int* list; int G, c;
    __device__ __forceinline__ int entry(const g8::Unit& u, int r) const { const int rc = r < u.n ? r : 0; return rc < u.c0 ? list[(size_t)(u.e * 2) * LCAP + rc] : list[(size_t)(u.e * 2 + 1) * LCAP + (rc - u.c0)]; }
    __device__ __forceinline__ bool next(int i, g8::Unit& u) const {
        const int L = i * G + c; if (L >= pre[32]) return false;
        int e = 0; while (L >= pre[e + 1]) ++e;
        const int loc = L - pre[e]; u.e = e; u.c0 = (int)cnt[(e * 2) * CSTR]; u.n = u.c0 + (int)cnt[(e * 2 + 1) * CSTR]; u.pm = loc >> 1; u.pn = loc & 1; return true;
    }
    __device__ __forceinline__ unsigned a_off(const g8::Unit& u, int r) const { return (unsigned)(entry(u, u.pm * 256 + r) >> 1) * (unsigned)(D * 2); }
    __device__ __forceinline__ const char* b_half(const g8::Unit& u, int h) const { return wbase + ((size_t)u.e * 3 * 262144 + (size_t)h * 262144 + (size_t)u.pn * 128 * D) * 2; }
};
struct EpiMoeA {
    MoeSchedA S; const float* pw; half_t* hid;
    __device__ __forceinline__ void operator()(const f32x4 (&acc)[2][2][4][2], const g8::Unit& u, int wr, int wc, int fr, int fq) const {
        int pid[8]; float w[8];
#pragma unroll
        for (int g = 0; g < 8; ++g) pid[g] = S.entry(u, u.pm * 256 + (g >> 2) * 128 + wr * 64 + (g & 3) * 16 + fr);
#pragma unroll
        for (int g = 0; g < 8; ++g) w[g] = pw[pid[g]];
#pragma unroll
        for (int ai = 0; ai < 2; ++ai)
#pragma unroll
            for (int m = 0; m < 4; ++m) {
                const int rr = u.pm * 256 + ai * 128 + wr * 64 + m * 16 + fr;
                if (rr < u.n) {
#pragma unroll
                    for (int n = 0; n < 2; ++n) { const int f = u.pn * 128 + wc * 32 + n * 16 + 4 * fq; const f32x4 g = acc[ai][0][m][n], up = acc[ai][1][m][n]; f32x4 o;
#pragma unroll
                        for (int i = 0; i < 4; ++i) o[i] = fsilu(g[i]) * up[i] * w[ai * 4 + m];
                        *(half4*)(hid + (size_t)pid[ai * 4 + m] * 256 + f) = to_half4(o); } }
            }
    }
};
__device__ __forceinline__ void phase_moe_a(const Frame& F, int layer) {
    int* pre = (int*)(F.smem + MOE_PRE_OFF);
    const unsigned* cnt = (const unsigned*)(F.ws + WS_CTL) + CW_CNT + layer * 64 * CSTR;
    if (F.tid == 0) { int s = 0; for (int e = 0; e < 32; ++e) { pre[e] = s; s += (((int)(cnt[(e * 2) * CSTR] + cnt[(e * 2 + 1) * CSTR]) + 255) / 256) * 2; } pre[32] = s; }
    __syncthreads();
    MoeSchedA S; S.abase = (const char*)(F.ws + WS_XN); S.wbase = (const char*)(F.ws + WS_WMOE); S.pre = pre; S.cnt = cnt; S.list = (const int*)(F.ws + WS_LIST); S.G = gridDim.x; S.c = blockIdx.x;
    EpiMoeA E{S, (const float*)(F.ws + WS_PW), (half_t*)(F.ws + WS_U16)};
    g8::gemm_phase(F.smem, D, S, E);
    __syncthreads();
}
struct MoeSchedB {
    const char* abase; const char* wbase; const int* pre; const unsigned* cnt; const int* list; int G, c;
    __device__ __forceinline__ bool next(int i, g8::Unit& u) const {
        const int L = i * G + c; if (L >= pre[64]) return false;
        int l = 0; while (L >= pre[l + 1]) ++l;
        const int loc = L - pre[l]; u.e = l >> 1; u.c0 = l & 1; u.n = (int)cnt[(l) * CSTR]; u.pm = loc >> 2; u.pn = loc & 3; return true;
    }
    __device__ __forceinline__ int entry(const g8::Unit& u, int rr) const { return list[(size_t)(u.e * 2 + u.c0) * LCAP + (rr < u.n ? rr : 0)]; }
    __device__ __forceinline__ unsigned a_off(const g8::Unit& u, int r) const { return (unsigned)entry(u, u.pm * 256 + r) * 512u; }
    __device__ __forceinline__ const char* b_half(const g8::Unit& u, int h) const { return wbase + ((size_t)u.e * 3 * 262144 + 2 * 262144 + (size_t)(u.pn * 256 + h * 128) * 256) * 2; }
};
struct EpiMoeB {
    MoeSchedB S; Frame F; int layer;
    __device__ __forceinline__ void operator()(const f32x4 (&acc)[2][2][4][2], const g8::Unit& u, int wr, int wc, int fr, int fq) const {
        int row[8];
#pragma unroll
        for (int g = 0; g < 8; ++g) row[g] = S.entry(u, u.pm * 256 + (g >> 2) * 128 + wr * 64 + (g & 3) * 16 + fr) >> 1;
        half_t* xab = (half_t*)(F.ws + WS_U16 + XAB_OFF) + (size_t)u.c0 * TT * D;
#pragma unroll
        for (int ai = 0; ai < 2; ++ai)
#pragma unroll
            for (int m = 0; m < 4; ++m) {
                const int rr = u.pm * 256 + ai * 128 + wr * 64 + m * 16 + fr;
                if (rr < u.n) { const int rw = row[ai * 4 + m]; half_t* xo = xab + (size_t)rw * D; const float* g5 = modp(F, layer, row_mod(rw), 5);
#pragma unroll
                    for (int bj = 0; bj < 2; ++bj)
#pragma unroll
                        for (int n = 0; n < 2; ++n) { const int d = u.pn * 256 + bj * 128 + wc * 32 + n * 16 + 4 * fq;
                            const f32x4 gv = *(const f32x4*)(g5 + d); *(half4*)(xo + d) = to_half4(gv * acc[ai][bj][m][n]); } }
            }
    }
};
__device__ __forceinline__ void phase_moe_b(const Frame& F, int layer) {
    int* pre = (int*)(F.smem + MOE_PRE_OFF);
    const unsigned* cnt = (const unsigned*)(F.ws + WS_CTL) + CW_CNT + layer * 64 * CSTR;
    if (F.tid == 0) { int s = 0; for (int l = 0; l < 64; ++l) { pre[l] = s; s += (((int)cnt[(l) * CSTR] + 255) / 256) * 4; } pre[64] = s; }
    __syncthreads();
    MoeSchedB S; S.abase = (const char*)(F.ws + WS_U16); S.wbase = (const char*)(F.ws + WS_WMOE); S.pre = pre; S.cnt = cnt; S.list = (const int*)(F.ws + WS_LIST); S.G = gridDim.x; S.c = blockIdx.x;
    EpiMoeB E{S, F, layer};
    g8::gemm_phase(F.smem, 256, S, E);
    __syncthreads();
}

__device__ __forceinline__ void phase_final(const Frame& F) {
    const float* fw = F.in(I_FNW);
    const int lane = F.lane, nwaves = gridDim.x * (NT / 64);
    f32x4 w4[4];
#pragma unroll
    for (int q = 0; q < 4; ++q) w4[q] = *(const f32x4*)(fw + q * 256 + lane * 4);
    int row = blockIdx.x * (NT / 64) + F.wave;
    f32x4 v[4];
    if (row < TL) {
#pragma unroll
        for (int q = 0; q < 4; ++q) v[q] = *(const f32x4*)(F.P->out + (size_t)row * D + q * 256 + lane * 4); }
    for (; row < TL; row += nwaves) {
        const int nrow = row + nwaves;
        f32x4 vn[4];
        if (nrow < TL) {
#pragma unroll
            for (int q = 0; q < 4; ++q) vn[q] = *(const f32x4*)(F.P->out + (size_t)nrow * D + q * 256 + lane * 4); }
        { const half_t* xa = (const half_t*)(F.ws + WS_U16 + XAB_OFF) + (size_t)row * D; const half_t* xb = xa + (size_t)TT * D;
#pragma unroll
          for (int q = 0; q < 4; ++q) { const int k = q * 256 + lane * 4; const half4 a4 = *(const half4*)(xa + k), b4 = *(const half4*)(xb + k);
#pragma unroll
              for (int e = 0; e < 4; ++e) v[q][e] += (float)a4[e] + (float)b4[e]; } }
        float ss = 0.f;
#pragma unroll
        for (int q = 0; q < 4; ++q) ss += v[q][0] * v[q][0] + v[q][1] * v[q][1] + v[q][2] * v[q][2] + v[q][3] * v[q][3];
        ss = wave_sum(ss);
        const float rs = 1.0f / sqrtf(ss * (1.0f / D) + EPSF);
#pragma unroll
        for (int q = 0; q < 4; ++q) *(f32x4*)(F.P->out + (size_t)row * D + q * 256 + lane * 4) = v[q] * rs * w4[q];
#pragma unroll
        for (int q = 0; q < 4; ++q) v[q] = vn[q];
    }
}

constexpr int NPHASE = 1 + 2 * 9 + 1;
#ifndef ONLY
#define ONLY -1
#endif
#define EN(x) (ONLY < 0 || ONLY == (x))
__device__ __forceinline__ void run_phase(const Frame& F, int ph) {
    if (ph == 0) { if (EN(0)) phase_setup(F); return; }
    if (ph == NPHASE - 1) { if (EN(11)) phase_final(F); return; }
    const int layer = (ph - 1) / 9, k = (ph - 1) % 9;
    switch (k) {
        case 0: if (EN(1)) phase_norm1(F, layer); break;
        case 1: if (EN(2)) phase_inproj(F, layer); break;
        case 2: if (EN(10)) phase_act(F, layer); break;
        case 3: if (EN(3)) phase_mixers(F, layer); break;
        case 4: if (EN(4)) phase_combine(F, layer); break;
        case 5: if (EN(5)) phase_outproj(F, layer); break;
        case 6: if (EN(6)) phase_router(F, layer); break;
        case 7: if (EN(7)) phase_moe_a(F, layer); break;
        default: if (EN(8)) phase_moe_b(F, layer); break;
    }
}

#ifdef EMU
void mega(const Params* Pp) {
    Frame F; F.P = Pp; F.ws = Pp->ws; F.smem = emu_blk->smem; F.tid = threadIdx.x; F.lane = F.tid & 63; F.wave = F.tid >> 6;
    for (int ph = Pp->ph_lo; ph < Pp->ph_hi; ++ph) { run_phase(F, ph); __syncthreads(); }
}
#else
__global__ void __launch_bounds__(NT) mega(Params P) {
    extern __shared__ __attribute__((aligned(16))) unsigned char smem_dyn[];
    cg::grid_group grid = cg::this_grid();
    Frame F; F.P = (ParamsPtr)__builtin_amdgcn_kernarg_segment_ptr(); F.ws = P.ws; F.smem = smem_dyn; F.tid = threadIdx.x; F.lane = F.tid & 63; F.wave = F.tid >> 6;
    volatile LAS unsigned* bst = (volatile LAS unsigned*)(smem_dyn + LDS_BYTES - 16);
    if (F.tid < 4) bst[F.tid] = 0u;
    __syncthreads();
    XcdBarrier xb = xcd_barrier_post((unsigned*)(P.ws + WS_CTL) + CW_BAR, bst);
    if (P.ph_lo < 0) grid.sync();
#define DUP -1
#define AMP -1
#define PHASE_STEP(i) if (P.ph_lo <= (i) && (i) < P.ph_hi) { \
        unsigned long long t0_ = 0; if (AMP == (i)) t0_ = __builtin_amdgcn_s_memrealtime(); \
        run_phase(F, (i)); \
        if ((i) + 1 < P.ph_hi || AMP == (i)) xcd_barrier(xb); \
        if (AMP == (i)) { const unsigned long long t1_ = __builtin_amdgcn_s_memrealtime(); if (blockIdx.x == 0) { while (__builtin_amdgcn_s_memrealtime() - t1_ < t1_ - t0_) __builtin_amdgcn_s_sleep(8); } xcd_barrier(xb); } }
    PHASE_STEP(0) PHASE_STEP(1) PHASE_STEP(2) PHASE_STEP(3) PHASE_STEP(4) PHASE_STEP(5) PHASE_STEP(6) PHASE_STEP(7) PHASE_STEP(8) PHASE_STEP(9)
    PHASE_STEP(10) PHASE_STEP(11) PHASE_STEP(12) PHASE_STEP(13) PHASE_STEP(14) PHASE_STEP(15) PHASE_STEP(16) PHASE_STEP(17) PHASE_STEP(18) PHASE_STEP(19)
    static_assert(NPHASE == 20, "phase list");
}

extern "C" void kernel_launch(void* const* d_in, const int* in_sizes, int n_in, void* d_out, int out_size, void* d_ws, size_t ws_size, hipStream_t stream) {
    static int grid_blocks = 0;
    if (grid_blocks == 0) {
        if (n_in != 38 || out_size != TL * D || ws_size < WS_END) { fprintf(stderr, "kernel_launch: unexpected shapes (n_in %d out %d ws %zu need %zu)\n", n_in, out_size, ws_size, (size_t)WS_END); grid_blocks = -1; return; }
        int dev = 0, cus = 0, per_cu = 0;
        hipGetDevice(&dev);
        hipDeviceGetAttribute(&cus, hipDeviceAttributeMultiprocessorCount, dev);
        hipFuncSetAttribute((const void*)mega, hipFuncAttributeMaxDynamicSharedMemorySize, LDS_BYTES);
        hipOccupancyMaxActiveBlocksPerMultiprocessor(&per_cu, (const void*)mega, NT, LDS_BYTES);
        if (per_cu < 1) { fprintf(stderr, "kernel_launch: occupancy query says 0 blocks per CU\n"); grid_blocks = -1; return; }
        grid_blocks = cus;
    }
    if (grid_blocks < 0) return;
    if (hipMemsetAsync((char*)d_ws + WS_CTL, 0, CTL_BYTES, stream) != hipSuccess) { fprintf(stderr, "kernel_launch: memset failed\n"); return; }
    Params p{};
    for (int i = 0; i < 38; ++i) p.in[i] = (const float*)d_in[i];
    p.out = (float*)d_out; p.ws = (unsigned char*)d_ws; p.ph_lo = 0; p.ph_hi = NPHASE;
    void* args[] = {&p};
    hipError_t e = hipLaunchCooperativeKernel((const void*)mega, dim3(grid_blocks), dim3(NT), args, LDS_BYTES, stream);
    if (e != hipSuccess) fprintf(stderr, "cooperative launch failed: %s (grid %d)\n", hipGetErrorString(e), grid_blocks);
}
#endif
```

```cpp
#ifdef EMU
#include "gpuemu.h"
#else
#include <hip/hip_runtime.h>
#include <hip/hip_cooperative_groups.h>
#include <cstdio>
namespace cg = cooperative_groups;
#endif
#include <stdint.h>

#ifndef CFG_B
#define CFG_B 4
#endif
#ifndef CFG_SEQ
#define CFG_SEQ 4096
#endif
#ifndef CFG_CTX
#define CFG_CTX 256
#endif

typedef _Float16 half_t;
typedef _Float16 half8 __attribute__((ext_vector_type(8)));
typedef _Float16 half4 __attribute__((ext_vector_type(4)));
typedef float f32x4 __attribute__((ext_vector_type(4)));
struct cplx { float x, y; };

constexpr int D = 1024, NB = CFG_B, SEQ = CFG_SEQ, CTXL = CFG_CTX, GW = 64, GROWS = SEQ / GW;
constexpr int TL = NB * SEQ, TC = NB * CTXL, TT = TL + TC;
constexpr int NIN = 3364, NINP = 3584;
constexpr int UW = 2560;
constexpr int UGW = 36;
constexpr int NT = 512;
constexpr int TWN = 2 * SEQ > 2 * CTXL ? 2 * SEQ : 2 * CTXL;
constexpr int NMOD = 6 * D;
constexpr int LCAP = TT;
constexpr float EPSF = 1e-6f;

constexpr size_t al256(size_t x) { return (x + 255) / 256 * 256; }
constexpr size_t WS_CTL    = 0;
constexpr size_t WS_MOD    = 65536;
constexpr size_t WS_TW     = WS_MOD + al256(sizeof(float) * 2 * 5 * NMOD);
constexpr size_t WS_WIN    = WS_TW + al256(sizeof(cplx) * TWN);
constexpr size_t WS_WOUT   = WS_WIN + al256(2ull * 2 * NINP * D);
constexpr size_t WS_WMOE   = WS_WOUT + al256(2ull * 2 * D * D);
constexpr size_t WS_XC     = WS_WMOE + al256(2ull * 32 * 3 * 262144);
constexpr size_t WS_XN     = WS_XC + al256(4ull * TC * D);
constexpr size_t WS_U16    = WS_XN + al256(2ull * TT * D);
constexpr size_t WS_UG     = WS_U16 + al256(2ull * TT * UW);
constexpr size_t WS_HYT    = WS_UG + al256(4ull * TT * UGW);
constexpr size_t WS_YF     = WS_HYT + al256(2ull * NB * 768 * (SEQ + CTXL));
constexpr size_t WS_YHT    = WS_YF + al256(2ull * 4 * TT * 384);
constexpr size_t WS_FT     = WS_YHT + al256(4ull * NB * 256 * (SEQ + CTXL));
constexpr size_t WS_LIST   = WS_FT + al256(4ull * (2 * 256 * 4 * SEQ + 256 * 4 * CTXL));
constexpr size_t WS_PW     = WS_LIST + al256(4ull * 64 * LCAP);
constexpr size_t WS_WR     = WS_PW + al256(4ull * TT * 2);
constexpr size_t WS_HALO   = WS_WR + al256(2ull * 2 * 2 * 48 * D);
constexpr size_t WS_END    = WS_HALO + al256(2ull * (TT / 16) * 2 * 1408);
static_assert(4ull * NB * 256 * (SEQ + CTXL) <= 2ull * TT * D, "Z1 scratch must fit in the XN region");
static_assert(2ull * TT * 2 * 256 <= 2ull * TT * UW, "HID must fit in the U16 region");
constexpr size_t XAB_OFF = 2ull * TT * 2 * 256;
static_assert(XAB_OFF + 2ull * 2 * TT * D <= 2ull * TT * UW, "HID + XA + XB must fit in the U16 region");

constexpr int CW_CNT = 8192;
constexpr int CSTR = 64;
constexpr int CW_QUE = 256;
constexpr int CW_BAR = 1024;
constexpr size_t CTL_BYTES = 65536;

constexpr int LDS_BYTES = 156 * 1024;

struct Params {
    const float* in[38];
    float* out;
    unsigned char* ws;
    int ph_lo, ph_hi;
};

enum { I_X = 0, I_C, I_CTX, I_CCTX, I_WMOD, I_BMOD, I_N1W, I_N2W, I_WIN, I_WOUT, I_SCW, I_SCB, I_DTB, I_ALOG, I_SD, I_SNW,
       I_HCW, I_HCB, I_HW1, I_HB1, I_HW2, I_HB2, I_HW3, I_HFREQ, I_HDEC, I_HSKIP, I_MCW, I_MCB, I_MGB, I_MNW,
       I_GRW, I_GRB, I_ERW, I_ERB, I_MG, I_MU, I_MD, I_FNW };

__device__ __forceinline__ float siluf(float x) { return x / (1.0f + expf(-x)); }
__device__ __forceinline__ float sigmoidf_(float x) { return 1.0f / (1.0f + expf(-x)); }
__device__ __forceinline__ float softplusf_(float x) { return x > 20.f ? x : log1pf(expf(x)); }
__device__ __forceinline__ float logsigmoidf_(float x) { return fminf(x, 0.f) - log1pf(expf(-fabsf(x))); }

__device__ __forceinline__ float fsoftplus(float x) {
#ifdef EMU
    return x > 20.f ? x : log1pf(expf(x));
#else
    const float e = __expf(x);
    return x > 20.f ? x : (e < 1e-3f ? e * (1.0f - 0.5f * e) : __logf(1.0f + e));
#endif
}
__device__ __forceinline__ float flogsigmoid(float x) { return fminf(x, 0.f) - fsoftplus(-fabsf(x)); }
__device__ __forceinline__ float fexp(float x) {
#ifdef EMU
    return expf(x);
#else
    return __expf(x);
#endif
}
__device__ __forceinline__ float fsilu(float x) {
#ifdef EMU
    return x / (1.0f + expf(-x));
#else
    return __fdividef(x, 1.0f + __expf(-x));
#endif
}
__device__ __forceinline__ float wave_sum(float v) {
#pragma unroll
    for (int m = 32; m >= 1; m >>= 1) v += __shfl_xor(v, m);
    return v;
}
__device__ __forceinline__ float wave_max(float v) {
#pragma unroll
    for (int m = 32; m >= 1; m >>= 1) v = fmaxf(v, __shfl_xor(v, m));
    return v;
}
#ifndef EMU
#define DPP_F(oldv, v, ctrl, rmask) __builtin_bit_cast(float, __builtin_amdgcn_update_dpp(__builtin_bit_cast(int, (float)(oldv)), __builtin_bit_cast(int, (float)(v)), (ctrl), (rmask), 0xF, false))
#endif
__device__ __forceinline__ float wave_scan_sum(float v, int lane) {
#ifdef EMU
    for (int d = 1; d < 64; d <<= 1) { float o = __shfl_up(v, d); if (lane >= d) v += o; }
    return v;
#else
    v += DPP_F(0.f, v, 0x111, 0xF);
    v += DPP_F(0.f, v, 0x112, 0xF);
    v += DPP_F(0.f, v, 0x114, 0xF);
    v += DPP_F(0.f, v, 0x118, 0xF);
    v += DPP_F(0.f, v, 0x142, 0xA);
    v += DPP_F(0.f, v, 0x143, 0xC);
    return v;
#endif
}
__device__ __forceinline__ float wave_last(float v) {
#ifdef EMU
    return __shfl(v, 63);
#else
    return __builtin_bit_cast(float, __builtin_amdgcn_readlane(__builtin_bit_cast(int, v), 63));
#endif
}
__device__ __forceinline__ float wave_shr1(float v, float fill, int lane) {
#ifdef EMU
    float o = __shfl_up(v, 1); return lane == 0 ? fill : o;
#else
    return DPP_F(fill, v, 0x138, 0xF);
#endif
}
__device__ __forceinline__ float wave_scan_max(float v, int lane) {
#ifdef EMU
    for (int d = 1; d < 64; d <<= 1) { float o = __shfl_up(v, d); if (lane >= d) v = fmaxf(v, o); }
    return v;
#else
    const float NI = -3.0e38f;
    v = fmaxf(v, DPP_F(NI, v, 0x111, 0xF));
    v = fmaxf(v, DPP_F(NI, v, 0x112, 0xF));
    v = fmaxf(v, DPP_F(NI, v, 0x114, 0xF));
    v = fmaxf(v, DPP_F(NI, v, 0x118, 0xF));
    v = fmaxf(v, DPP_F(NI, v, 0x142, 0xA));
    v = fmaxf(v, DPP_F(NI, v, 0x143, 0xC));
    return v;
#endif
}

template <int MT, int NTL>
__device__ __forceinline__ void mma_lds(f32x4 (&acc)[MT][NTL], const half_t* A, int lda, const half_t* B, int ldb, int ksteps, int lane) {
#ifndef EMU
    const int r = lane & 15, kq = (lane >> 4) * 8;
    for (int ks = 0; ks < ksteps; ++ks) {
        half8 a[MT], b[NTL];
#pragma unroll
        for (int mt = 0; mt < MT; ++mt) a[mt] = *(const half8*)(A + (mt * 16 + r) * lda + ks * 32 + kq);
#pragma unroll
        for (int nt = 0; nt < NTL; ++nt) b[nt] = *(const half8*)(B + (nt * 16 + r) * ldb + ks * 32 + kq);
#pragma unroll
        for (int mt = 0; mt < MT; ++mt)
#pragma unroll
            for (int nt = 0; nt < NTL; ++nt) acc[mt][nt] = __builtin_amdgcn_mfma_f32_16x16x32_f16(a[mt], b[nt], acc[mt][nt], 0, 0, 0);
    }
#else
    for (int mt = 0; mt < MT; ++mt) for (int nt = 0; nt < NTL; ++nt) for (int i = 0; i < 4; ++i) {
        const int row = mt * 16 + (lane >> 4) * 4 + i, col = nt * 16 + (lane & 15);
        float s = acc[mt][nt][i];
        for (int k = 0; k < ksteps * 32; ++k) s += (float)A[row * lda + k] * (float)B[col * ldb + k];
        acc[mt][nt][i] = s;
    }
#endif
}

__device__ __forceinline__ f32x4 mfma16(half8 a, half8 b, f32x4 c) {
#ifdef EMU
    return emu_mfma16(a, b, c);
#else
    return __builtin_amdgcn_mfma_f32_16x16x32_f16(a, b, c, 0, 0, 0);
#endif
}
template <int MT, int NTL> __device__ __forceinline__ void zero_acc(f32x4 (&acc)[MT][NTL]) {
#pragma unroll
    for (int mt = 0; mt < MT; ++mt)
#pragma unroll
        for (int nt = 0; nt < NTL; ++nt) acc[mt][nt] = (f32x4){0.f, 0.f, 0.f, 0.f};
}

__device__ __forceinline__ void load_taps4(const float* cw, const float* cb, int C, int ch, int dir, f32x4& w0, f32x4& w1, f32x4& w2, f32x4& wb) {
    w0 = *(const f32x4*)(cw + (dir ? 2 : 0) * C + ch); w1 = *(const f32x4*)(cw + C + ch); w2 = *(const f32x4*)(cw + (dir ? 0 : 2) * C + ch); wb = *(const f32x4*)(cb + ch);
}
#ifdef EMU
#define LOADER_FENCE()
#else
#define LOADER_FENCE() asm volatile("" ::: "memory")
#endif
#define CONV4(k, i) (w0[i] * (float)rr[k][hh * 4 + i] + w1[i] * (float)rr[(k) + 1][hh * 4 + i] + w2[i] * (float)rr[(k) + 2][hh * 4 + i] + wb[i])
__device__ __forceinline__ half4 to_half4(const f32x4 v) { half4 h; h[0] = (half_t)v[0]; h[1] = (half_t)v[1]; h[2] = (half_t)v[2]; h[3] = (half_t)v[3]; return h; }
namespace g8 {
constexpr int BM = 256, BK = 64, HALF = 128, HTB = HALF * BK * 2, STAGE_BYTES = 8 * HTB;
__device__ __forceinline__ int lds_byte(int r, int c) { const int st = (r >> 4) * 2 + (c >> 5), rr = r & 15, cc = c & 31, ob = rr * 64 + cc * 2; return st * 1024 + (ob ^ (((ob >> 9) & 1) << 5)); }
__device__ __forceinline__ int perm32(int rho) { const int n = rho >> 4, i = rho & 15; return 8 * (i >> 2) + 4 * n + (i & 3); }
__device__ __forceinline__ void stage_rc(int b, int& R, int& C) { const int st = b / 1024, sb = b % 1024, swz = sb ^ (((sb >> 9) & 1) << 5); R = (st >> 1) * 16 + swz / 64; C = (st & 1) * 32 + (swz % 64) / 2; }
struct Unit { int pm, pn, e, n, c0; };

struct DenseSched {
    const char* abase; const char* bbase; int K, nM, nN, G, c;
    __device__ __forceinline__ bool next(int i, Unit& u) const {
        const int nwg = nM * nN; const long L = (long)i * G + c; if (L >= nwg) return false;
        int wgid = (int)L; { const int q = nwg / 8, r = nwg % 8, xcd = wgid % 8, off = wgid / 8; wgid = (xcd < r ? xcd * (q + 1) : r * (q + 1) + (xcd - r) * q) + off; }
        const int nig = 8 * nN, gid = wgid / nig, fm = gid * 8, gsz = (nM - fm) < 8 ? (nM - fm) : 8;
        u.pm = fm + ((wgid % nig) % gsz); u.pn = (wgid % nig) / gsz; u.e = 0; u.n = 0; u.c0 = 0; return true;
    }
    __device__ __forceinline__ unsigned a_off(const Unit& u, int r) const { return (unsigned)((size_t)(u.pm * 256 + r) * K * 2); }
    __device__ __forceinline__ const char* b_half(const Unit& u, int h) const { return bbase + (size_t)(u.pn * 256 + h * 128) * K * 2; }
};

template <class Epi, class Sched>
__device__ __forceinline__ void gemm_phase(unsigned char* smem, const int K, const Sched& S, const Epi& E) {
    const int tid = threadIdx.x, lane = tid & 63;
#ifdef EMU
    const int wid = tid >> 6, wr = wid >> 2, wc = wid & 3, fr = lane & 15, fq = lane >> 4;
    half_t* As = (half_t*)smem; half_t* Bs = As + 256 * 72;
    Unit cur;
    for (int ui = 0; S.next(ui, cur); ++ui) {
        f32x4 acc[2][2][4][2];
        for (int a = 0; a < 2; ++a) for (int b = 0; b < 2; ++b) for (int m = 0; m < 4; ++m) for (int n = 0; n < 2; ++n) acc[a][b][m][n] = (f32x4){0.f, 0.f, 0.f, 0.f};
        for (int kt = 0; kt < K / 64; ++kt) {
            { const int row = tid >> 1, c0 = (tid & 1) * 32;
              const half_t* sa = (const half_t*)(S.abase + S.a_off(cur, row)) + kt * 64 + c0;
              const half_t* sb = (const half_t*)(S.b_half(cur, row >> 7)) + (size_t)(row & 127) * K + kt * 64 + c0;
              for (int q = 0; q < 32; ++q) { As[row * 72 + c0 + q] = sa[q]; Bs[row * 72 + c0 + q] = sb[q]; } }
            __syncthreads();
            for (int a = 0; a < 2; ++a) for (int b = 0; b < 2; ++b) for (int m = 0; m < 4; ++m) for (int n = 0; n < 2; ++n) for (int i = 0; i < 4; ++i) {
                const int row = 128 * a + 64 * wr + 16 * m + fr, col = 128 * b + 32 * wc + (Epi::PERM ? 8 * fq + 4 * n + i : 16 * n + 4 * fq + i); float s = acc[a][b][m][n][i];
                for (int k = 0; k < 64; ++k) s += (float)As[row * 72 + k] * (float)Bs[col * 72 + k];
                acc[a][b][m][n][i] = s; }
            __syncthreads();
        }
        E(acc, cur, wr, wc, fr, fq);
    }
#else
    typedef __attribute__((address_space(3))) unsigned char* ldsp_t;
    const ldsp_t lds = (ldsp_t)smem;
    const int wid = __builtin_amdgcn_readfirstlane(tid >> 6), wr = wid >> 2, wc = wid & 3, fr = lane & 15, fq = lane >> 4;
    const int nt = K / BK;
    int Rr[2], Cc[2]; unsigned voffB[2];
#pragma unroll
    for (int i = 0; i < 2; ++i) { stage_rc(tid * 16 + i * 8192, Rr[i], Cc[i]); const int Rb = Epi::PERM ? ((Rr[i] & ~31) + perm32(Rr[i] & 31)) : Rr[i]; voffB[i] = (unsigned)(Rb * K + Cc[i]) * 2u; }
    const size_t kstep = (size_t)(BK * 2);
    const unsigned ldsw = (unsigned)wid * 1024u;
    const int aoffl = lds_byte(wr * 64 + fr, fq * 8), boffl = lds_byte(wc * 32 + fr, fq * 8);
#define G8_SA(b, h) (((b) * 2 + (h)) * HTB)
#define G8_SB(b, h) ((4 + (b) * 2 + (h)) * HTB)
#define G8_STAGE(bufoff, gbase, voff) do { _Pragma("unroll") for (int _i = 0; _i < 2; ++_i) \
        __builtin_amdgcn_global_load_lds((const unsigned*)((const char*)(gbase) + (voff)[_i]), (__attribute__((address_space(3))) unsigned*)(lds + (bufoff) + ldsw + _i * 8192), 16, 0, 0); } while (0)
#define G8_LDA(dst, b, h) do { _Pragma("unroll") for (int m = 0; m < 4; ++m) _Pragma("unroll") for (int k = 0; k < 2; ++k) dst[m][k] = *(const __attribute__((address_space(3))) half8*)(lds + G8_SA(b, h) + aoffl + m * 2048 + k * 1024); } while (0)
#define G8_LDB(dst, b, h) do { _Pragma("unroll") for (int n = 0; n < 2; ++n) _Pragma("unroll") for (int k = 0; k < 2; ++k) dst[n][k] = *(const __attribute__((address_space(3))) half8*)(lds + G8_SB(b, h) + boffl + n * 2048 + k * 1024); } while (0)
#define G8_MMA(ai, bj, At, Bt) do { __builtin_amdgcn_s_setprio(1); _Pragma("unroll") for (int m = 0; m < 4; ++m) _Pragma("unroll") for (int n = 0; n < 2; ++n) _Pragma("unroll") for (int k = 0; k < 2; ++k) \
        acc[ai][bj][m][n] = __builtin_amdgcn_mfma_f32_16x16x32_f16(Bt[n][k], At[m][k], acc[ai][bj][m][n], 0, 0, 0); __builtin_amdgcn_s_setprio(0); } while (0)
#define G8_WAIT_V(n) asm volatile("s_waitcnt vmcnt(" #n ")" ::: "memory")
#define G8_WAIT_L(n) asm volatile("s_waitcnt lgkmcnt(" #n ")" ::: "memory")
#define G8_BAR __builtin_amdgcn_s_barrier()
#define G8_SCHED __builtin_amdgcn_sched_barrier(0)
#define G8_AOFF(dst, u) do { _Pragma("unroll") for (int _h = 0; _h < 2; ++_h) _Pragma("unroll") for (int _i = 0; _i < 2; ++_i) dst[_h][_i] = S.a_off(u, _h * 128 + Rr[_i]) + (unsigned)Cc[_i] * 2u; } while (0)
    Unit cur, nxt; int ui = 0;
    if (!S.next(0, cur)) return;
    f32x4 acc[2][2][4][2];
#pragma unroll
    for (int a = 0; a < 2; ++a)
#pragma unroll
        for (int b = 0; b < 2; ++b)
#pragma unroll
            for (int m = 0; m < 4; ++m)
#pragma unroll
                for (int n = 0; n < 2; ++n) acc[a][b][m][n] = (f32x4){0.f, 0.f, 0.f, 0.f};
    half8 At[4][2], B0[2][2], B1[2][2];
    unsigned caoff[2][2], naoff[2][2];
    G8_AOFF(caoff, cur);
    const char* cA = S.abase; const char* cB0 = S.b_half(cur, 0); const char* cB1 = S.b_half(cur, 1);
    G8_STAGE(G8_SB(0, 0), cB0, voffB); G8_STAGE(G8_SA(0, 0), cA, caoff[0]); G8_STAGE(G8_SB(0, 1), cB1, voffB); G8_STAGE(G8_SA(0, 1), cA, caoff[1]);
    if (wr == 1) G8_BAR;
    G8_WAIT_V(4); G8_BAR;
    G8_STAGE(G8_SB(1, 0), cB0 + kstep, voffB); G8_STAGE(G8_SA(1, 0), cA + kstep, caoff[0]); G8_STAGE(G8_SB(1, 1), cB1 + kstep, voffB);
    G8_WAIT_V(6); G8_BAR;
    for (;;) {
        const bool has_next = S.next(ui + 1, nxt);
        if (!has_next) nxt = cur;
        G8_AOFF(naoff, nxt);
        const char* nB0 = S.b_half(nxt, 0); const char* nB1 = S.b_half(nxt, 1);
#pragma unroll 1
        for (int t = 0; t < nt; t += 2) {
            const bool last = (t == nt - 2);
            const char* a1 = cA + (size_t)(t + 1) * kstep;
            const char* a2 = last ? cA : cA + (size_t)(t + 2) * kstep;
            const char* b20 = last ? nB0 : cB0 + (size_t)(t + 2) * kstep; const char* b21 = last ? nB1 : cB1 + (size_t)(t + 2) * kstep;
            const char* a3 = a2 + kstep; const char* b30 = b20 + kstep; const char* b31 = b21 + kstep;
            unsigned xoff[2][2];
#pragma unroll
            for (int h = 0; h < 2; ++h)
#pragma unroll
                for (int i = 0; i < 2; ++i) xoff[h][i] = last ? naoff[h][i] : caoff[h][i];
            G8_LDB(B0, 0, 0); G8_SCHED; G8_LDA(At, 0, 0); G8_STAGE(G8_SA(1, 1), a1, caoff[1]);
            G8_WAIT_L(8); G8_BAR; G8_WAIT_L(0); G8_MMA(0, 0, At, B0); G8_BAR; G8_SCHED;
            G8_LDB(B1, 0, 1); G8_STAGE(G8_SB(0, 0), b20, voffB);
            G8_BAR; G8_WAIT_L(0); G8_MMA(0, 1, At, B1); G8_BAR;
            G8_LDA(At, 0, 1); G8_STAGE(G8_SA(0, 0), a2, xoff[0]);
            G8_BAR; G8_WAIT_L(0); G8_MMA(1, 0, At, B0); G8_BAR; G8_SCHED;
            G8_STAGE(G8_SB(0, 1), b21, voffB);
            G8_WAIT_V(6); G8_BAR; G8_MMA(1, 1, At, B1); G8_BAR;
            G8_LDB(B0, 1, 0); G8_SCHED; G8_LDA(At, 1, 0); G8_STAGE(G8_SA(0, 1), a2, xoff[1]);
            G8_WAIT_L(8); G8_BAR; G8_WAIT_L(0); G8_MMA(0, 0, At, B0); G8_BAR; G8_SCHED;
            G8_LDB(B1, 1, 1); G8_STAGE(G8_SB(1, 0), b30, voffB);
            G8_BAR; G8_WAIT_L(0); G8_MMA(0, 1, At, B1); G8_BAR;
            G8_LDA(At, 1, 1); G8_STAGE(G8_SA(1, 0), a3, xoff[0]);
            G8_BAR; G8_WAIT_L(0); G8_MMA(1, 0, At, B0); G8_BAR; G8_SCHED;
            G8_STAGE(G8_SB(1, 1), b31, voffB);
            G8_WAIT_V(6); G8_BAR; G8_MMA(1, 1, At, B1); G8_BAR;
        }
        E(acc, cur, wr, wc, fr, fq);
        if (!has_next) break;
#pragma unroll
        for (int a = 0; a < 2; ++a)
#pragma unroll
            for (int b = 0; b < 2; ++b)
#pragma unroll
                for (int m = 0; m < 4; ++m)
#pragma unroll
                    for (int n = 0; n < 2; ++n) acc[a][b][m][n] = (f32x4){0.f, 0.f, 0.f, 0.f};
        cur = nxt; cB0 = nB0; cB1 = nB1; ++ui;
#pragma unroll
        for (int h = 0; h < 2; ++h)
#pragma unroll
            for (int i = 0; i < 2; ++i) caoff[h][i] = naoff[h][i];
    }
    G8_WAIT_V(0);
    if (wr == 0) G8_BAR;
    G8_BAR;
#undef G8_SA
#undef G8_SB
#undef G8_STAGE
#undef G8_LDA
#undef G8_LDB
#undef G8_MMA
#undef G8_WAIT_V
#undef G8_WAIT_L
#undef G8_BAR
#undef G8_SCHED
#undef G8_AOFF
#endif
}
}

#ifdef EMU
typedef const Params* ParamsPtr;
#else
typedef const __attribute__((address_space(4))) Params* ParamsPtr;
#endif
struct Frame {
    ParamsPtr P; unsigned char* ws; unsigned char* smem; int tid, lane, wave;
    __device__ __forceinline__ const float* in(int i) const { return P->in[i]; }
    __device__ __forceinline__ float* xrow(int row) const { return row < TL ? P->out + (size_t)row * D : (float*)(ws + WS_XC) + (size_t)(row - TL) * D; }
    __device__ __forceinline__ const float* xrow_in(int layer, int row) const {
        if (layer == 0) return row < TL ? in(I_X) + (size_t)row * D : in(I_CTX) + (size_t)(row - TL) * D;
        return xrow(row);
    }
};
__device__ __forceinline__ int row_mod(int row) { return row < TL ? row / SEQ : NB; }
__device__ __forceinline__ const float* modp(const Frame& F, int layer, int m, int chunk) { return (const float*)(F.ws + WS_MOD) + ((size_t)(layer * 5 + m) * 6 + chunk) * D; }


#ifndef EMU
#define XB_TMO      128
#define XB_XCNT(j)  (256  + 64 * (j))
#define XB_XSUB(j)  (1280 + 64 * (j))
#define XB_XGEN(j)  (2304 + 64 * (j))
#define XB_TOP      3328
#define XB_TOPGEN   3392
#define XCD_BAR_WORDS 3456
#define XB_SPIN_CAP (1u << 26)
#define LAS __attribute__((address_space(3)))
static_assert((CW_BAR + XCD_BAR_WORDS) * 4 <= CTL_BYTES, "control region");
__device__ __forceinline__ unsigned xb_ld(unsigned* p)              { return __hip_atomic_load(p, __ATOMIC_RELAXED, __HIP_MEMORY_SCOPE_AGENT); }
__device__ __forceinline__ unsigned xb_add(unsigned* p, unsigned v) { return __hip_atomic_fetch_add(p, v, __ATOMIC_RELAXED, __HIP_MEMORY_SCOPE_AGENT); }
__device__ __forceinline__ unsigned xb_xcc_id() { return (unsigned)__builtin_amdgcn_s_getreg((3 << 11) | 20) & 0xFu; }
#define XB_SPIN(cond, bar) do { unsigned _sp = 0; while (cond) { __builtin_amdgcn_s_sleep(1); \
    if ((++_sp & 255u) == 0u) { if (xb_ld(&(bar)[XB_TMO])) break; if (_sp > XB_SPIN_CAP) { atomicAdd(&(bar)[XB_TMO], 1u); break; } } } } while (0)
struct XcdBarrier { unsigned* bar; unsigned x; volatile LAS unsigned* st; };
__device__ __forceinline__ XcdBarrier xcd_barrier_post(unsigned* bar, volatile LAS unsigned* st) {
    XcdBarrier b; b.bar = bar; b.x = xb_xcc_id(); b.st = st;
    if (threadIdx.x == 0) (void)xb_add(&bar[XB_XCNT(b.x)], 1u);
    return b;
}
__device__ __forceinline__ void xcd_barrier_complete(unsigned* bar, unsigned x, unsigned& nloc, unsigned& nx) {
    const unsigned G = gridDim.x * gridDim.y * gridDim.z;
    unsigned sum, cnt, mine, sp = 0u;
    for (;;) {
        sum = 0u; cnt = 0u; mine = 0u;
#pragma unroll
        for (unsigned j = 0; j < 16; ++j) { const unsigned c = xb_ld(&bar[XB_XCNT(j)]); sum += c; cnt += (c > 0u) ? 1u : 0u; mine = (j == x) ? c : mine; }
        if (sum == G) break;
        __builtin_amdgcn_s_sleep(1);
        if ((++sp & 255u) == 0u) { if (xb_ld(&bar[XB_TMO])) break; if (sp > XB_SPIN_CAP) { atomicAdd(&bar[XB_TMO], 1u); break; } }
    }
    nloc = mine > 0u ? mine : 1u; nx = cnt > 0u ? cnt : 1u;
}
__device__ __forceinline__ void xcd_barrier(const XcdBarrier& b) {
    asm volatile("s_waitcnt vmcnt(0)" ::: "memory");
    __syncthreads();
    if (threadIdx.x == 0) {
        unsigned* bar = b.bar;
        __builtin_amdgcn_s_waitcnt(0);
        unsigned nloc = b.st[0], nx = b.st[1];
        if (nloc == 0u) { xcd_barrier_complete(bar, b.x, nloc, nx); b.st[0] = nloc; b.st[1] = nx; }
        const unsigned old = xb_add(&bar[XB_XSUB(b.x)], 1u);
        const unsigned gen = old / nloc;
        if (old + 1u == (gen + 1u) * nloc) {
            __builtin_amdgcn_fence(__ATOMIC_RELEASE, "agent");
            asm volatile("s_waitcnt vmcnt(0)" ::: "memory");
            const unsigned og = xb_add(&bar[XB_TOP], 1u);
            const unsigned tg = og / nx;
            if (og + 1u == (tg + 1u) * nx) xb_add(&bar[XB_TOPGEN], 1u);
            else XB_SPIN(xb_ld(&bar[XB_TOPGEN]) == tg, bar);
            __builtin_amdgcn_fence(__ATOMIC_ACQUIRE, "agent");
            xb_add(&bar[XB_XGEN(b.x)], 1u);
            asm volatile("s_waitcnt vmcnt(0)" ::: "memory");
        } else {
            XB_SPIN(xb_ld(&bar[XB_XGEN(b.x)]) == gen, bar);
            __builtin_amdgcn_fence(__ATOMIC_ACQUIRE, "agent");
            asm volatile("s_waitcnt vmcnt(0)" ::: "memory");
        }
    }
    __syncthreads();
}
#endif

__device__ __forceinline__ void item_twiddle(const Frame& F, int it) {
    cplx* tw = (cplx*)(F.ws + WS_TW);
    const int k = it * NT + F.tid;
    if (k < TWN) { float s, c; const float a = -6.283185307179586f * (float)k / (float)TWN; s = sinf(a); c = cosf(a); tw[k].x = c; tw[k].y = s; }
}
__device__ __forceinline__ void item_mod(const Frame& F, int it) {
    const int layer = it / (NMOD / 64), n0 = (it % (NMOD / 64)) * 64;
    float* sc = (float*)F.smem;
    float* red = sc + 5 * D;
    for (int i = F.tid; i < 5 * D; i += NT) { const int m = i / D, k = i % D; const float v = m < NB ? F.in(I_C)[m * D + k] : F.in(I_CCTX)[k]; sc[i] = siluf(v); }
    __syncthreads();
    const int j = F.tid & 63, ks = F.tid >> 6;
    const float* w = F.in(I_WMOD) + (size_t)layer * D * NMOD + n0 + j;
    float a[5] = {0, 0, 0, 0, 0};
#pragma unroll 1
    for (int k0 = ks * 128; k0 < ks * 128 + 128; k0 += 32) {
        float wv[32];
#pragma unroll
        for (int q = 0; q < 32; ++q) wv[q] = w[(size_t)(k0 + q) * NMOD];
#pragma unroll
        for (int q = 0; q < 32; ++q)
#pragma unroll
            for (int m = 0; m < 5; ++m) a[m] += sc[m * D + k0 + q] * wv[q]; }
#pragma unroll
    for (int m = 0; m < 5; ++m) red[(ks * 5 + m) * 64 + j] = a[m];
    __syncthreads();
    if (F.tid < 5 * 64) { const int m = F.tid / 64, jj = F.tid % 64; float s = 0; for (int q = 0; q < 8; ++q) s += red[(q * 5 + m) * 64 + jj];
        ((float*)(F.ws + WS_MOD))[(size_t)(layer * 5 + m) * NMOD + n0 + jj] = s + F.in(I_BMOD)[layer * NMOD + n0 + jj]; }
    __syncthreads();
}
__device__ __forceinline__ void item_filter(const Frame& F, int layer, int isctx, int tb) {
    const int L = isctx ? CTXL : SEQ;
    float* feats = (float*)F.smem;
    float* h1 = feats + 32 * 33;
    float* h2 = h1 + 32 * 64;
    const int t0 = tb * 32;
    for (int i = F.tid; i < 32 * 33; i += NT) {
        const int tt = i / 33, f = i % 33; const float t = (float)(t0 + tt);
        float v;
        if (f == 0) v = t / (float)(L - 1 > 1 ? L - 1 : 1);
        else { const int bi = (f - 1) & 15; const float band = 1e-4f + (float)bi * ((15.0f - 1e-4f) / 15.0f);
               const float ang = (6.283185307179586f / (float)L) * t * band; v = (f <= 16) ? cosf(ang) : -sinf(ang); }
        feats[i] = v;
    }
    __syncthreads();
    const float* w1 = F.in(I_HW1) + layer * 33 * 64; const float* b1 = F.in(I_HB1) + layer * 64;
    const float* w2 = F.in(I_HW2) + layer * 64 * 64; const float* b2 = F.in(I_HB2) + layer * 64;
    const float* fr = F.in(I_HFREQ) + layer * 64;
    for (int i = F.tid; i < 32 * 64; i += NT) { const int tt = i >> 6, j = i & 63; float s = b1[j]; for (int k = 0; k < 33; ++k) s += feats[tt * 33 + k] * w1[k * 64 + j]; h1[i] = sinf(fr[j] * s); }
    __syncthreads();
    for (int i = F.tid; i < 32 * 64; i += NT) { const int tt = i >> 6, j = i & 63; float s = b2[j]; for (int k = 0; k < 64; ++k) s += h1[tt * 64 + k] * w2[k * 64 + j]; h2[i] = sinf(fr[j] * s); }
    __syncthreads();
    const float* w3 = F.in(I_HW3) + (size_t)layer * 64 * 1024;
    const int c0 = F.tid * 2;
    float* ft = (float*)(F.ws + WS_FT) + (isctx ? (size_t)2 * 256 * 4 * SEQ : (size_t)layer * 256 * 4 * SEQ);
    for (int hf = 0; hf < 2; ++hf) {
        float acc[16][2];
        for (int tt = 0; tt < 16; ++tt) { acc[tt][0] = 0.f; acc[tt][1] = 0.f; }
#pragma unroll 4
        for (int k = 0; k < 64; ++k) { const float wa = w3[k * 1024 + c0], wb = w3[k * 1024 + c0 + 1];
#pragma unroll
            for (int tt = 0; tt < 16; ++tt) { const float hv = h2[(hf * 16 + tt) * 64 + k]; acc[tt][0] += hv * wa; acc[tt][1] += hv * wb; } }
#pragma unroll
        for (int q = 0; q < 2; ++q) {
            const int col = c0 + q, dir = col >> 9, order = (col >> 8) & 1, c = col & 255;
            const float dec = fabsf(F.in(I_HDEC)[((layer * 2 + dir) * 2 + order) * 256 + c]);
            float* dst = ft + ((size_t)(c * 2 + order) * 2 + dir) * L + t0 + hf * 16;
#pragma unroll
            for (int tt = 0; tt < 16; ++tt) { const float tu = (float)(t0 + hf * 16 + tt) / (float)(L - 1 > 1 ? L - 1 : 1); dst[tt] = acc[tt][q] * expf(-tu * dec); }
        }
    }
    __syncthreads();
}
__device__ __forceinline__ void item_transpose(const Frame& F, const float* src, int ldn, int nvalid, half_t* dst, int K, int k0, int n0) {
    float* tile = (float*)F.smem;
    f32x4 v[8];
#pragma unroll
    for (int q = 0; q < 8; ++q) { const int i = F.tid + q * NT, r = i >> 6, c4 = (i & 63) * 4;
        if (n0 + c4 + 3 < nvalid) v[q] = *(const f32x4*)(src + (size_t)(k0 + r) * ldn + n0 + c4);
        else {
#pragma unroll
            for (int e = 0; e < 4; ++e) v[q][e] = (n0 + c4 + e < nvalid) ? src[(size_t)(k0 + r) * ldn + n0 + c4 + e] : 0.f; } }
#pragma unroll
    for (int q = 0; q < 8; ++q) { const int i = F.tid + q * NT, r = i >> 6, c4 = (i & 63) * 4; *(f32x4*)(tile + r * 260 + c4) = v[q]; }
    __syncthreads();
#pragma unroll
    for (int q = 0; q < 4; ++q) { const int i = F.tid + q * NT, n = i >> 3, kc = (i & 7) * 8; half8 h;
#pragma unroll
        for (int e = 0; e < 8; ++e) h[e] = (half_t)tile[(kc + e) * 260 + n];
        *(half8*)(dst + (size_t)(n0 + n) * K + k0 + kc) = h; }
    __syncthreads();
}
__device__ __forceinline__ void item_router_w(const Frame& F, int layer) {
    half_t* dst = (half_t*)(F.ws + WS_WR) + (size_t)layer * 2 * 48 * D;
#pragma unroll 4
    for (int i = F.tid; i < 32 * D; i += NT) {
        const int k = i >> 5, c = i & 31; const float w = F.in(I_ERW)[(size_t)layer * D * 32 + i];
        const half_t hi = (half_t)w; dst[(size_t)(4 + c) * D + k] = hi; dst[(size_t)(48 + 4 + c) * D + k] = (half_t)((w - (float)hi) * 2048.f); }
#pragma unroll 4
    for (int i = F.tid; i < 4 * D; i += NT) {
        const int k = i >> 2, c = i & 3; const float w = F.in(I_GRW)[(size_t)layer * D * 4 + i];
        const half_t hi = (half_t)w; dst[(size_t)c * D + k] = hi; dst[(size_t)(48 + c) * D + k] = (half_t)((w - (float)hi) * 2048.f); }
#pragma unroll 4
    for (int i = F.tid; i < 12 * D; i += NT) { dst[(size_t)36 * D + i] = (half_t)0.f; dst[(size_t)(48 + 36) * D + i] = (half_t)0.f; }
}
constexpr int IT_TW = (TWN + NT - 1) / NT;
constexpr int IT_MOD = 2 * (NMOD / 64);
constexpr int IT_FILT = 2 * (SEQ / 32) + (CTXL / 32);
constexpr int IT_TWIN = 2 * 16 * (NINP / 256);
constexpr int IT_TWOUT = 2 * 16 * 4;
constexpr int IT_TMOE = 32 * 48;
__device__ __forceinline__ void moe_transpose_item(const Frame& F, int layer, int it) {
    const int e = it / 48, r = it % 48, which = r / 16, t = r % 16;
    half_t* base = (half_t*)(F.ws + WS_WMOE) + (size_t)e * 3 * 262144;
    if (which < 2) {
        const float* src = F.in(which == 0 ? I_MG : I_MU) + ((size_t)layer * 32 + e) * 262144;
        item_transpose(F, src, 256, 256, base + which * 262144, 1024, t * 64, 0);
    } else {
        const float* src = F.in(I_MD) + ((size_t)layer * 32 + e) * 262144;
        item_transpose(F, src, 1024, 1024, base + 2 * 262144, 256, (t >> 2) * 64, (t & 3) * 256);
    }
}
__device__ __forceinline__ void phase_setup(const Frame& F) {
    const int G = gridDim.x; int rot = blockIdx.x;
    for (int i = rot; i < IT_MOD; i += G) item_mod(F, i);
    rot = (rot + G - (IT_MOD % G)) % G;
    for (int i = rot; i < IT_TWIN; i += G) { const int layer = i / (16 * (NINP / 256)), r = i % (16 * (NINP / 256));
        item_transpose(F, F.in(I_WIN) + (size_t)layer * D * NIN, NIN, NIN, (half_t*)(F.ws + WS_WIN) + (size_t)layer * NINP * D, D, (r / (NINP / 256)) * 64, (r % (NINP / 256)) * 256); }
    rot = (rot + G - (IT_TWIN % G)) % G;
    for (int i = rot; i < IT_FILT; i += G) { if (i < 2 * (SEQ / 32)) item_filter(F, i / (SEQ / 32), 0, i % (SEQ / 32)); else item_filter(F, 0, 1, i - 2 * (SEQ / 32)); }
    rot = (rot + G - (IT_FILT % G)) % G;
    for (int i = rot; i < IT_TWOUT; i += G) { const int layer = i / 64, r = i % 64;
        item_transpose(F, F.in(I_WOUT) + (size_t)layer * D * D, D, D, (half_t*)(F.ws + WS_WOUT) + (size_t)layer * D * D, D, (r >> 2) * 64, (r & 3) * 256); }
    rot = (rot + G - (IT_TWOUT % G)) % G;
    for (int i = rot; i < IT_TW; i += G) item_twiddle(F, i);
    rot = (rot + G - (IT_TW % G)) % G;
    for (int i = rot; i < 2; i += G) item_router_w(F, i);
}

__device__ __forceinline__ void phase_norm1(const Frame& F, int layer) {
    half_t* xn = (half_t*)(F.ws + WS_XN);
    const int lane = F.lane, nwaves = gridDim.x * (NT / 64);
    const float* nw = F.in(I_N1W) + layer * D;
    int mc = -1; f32x4 g[4], s4[4];
    int row = blockIdx.x * (NT / 64) + F.wave;
    f32x4 v[4];
    if (row < TT) { const float* x = F.xrow_in(layer, row);
#pragma unroll
        for (int q = 0; q < 4; ++q) v[q] = *(const f32x4*)(x + q * 256 + lane * 4); }
    for (; row < TT; row += nwaves) {
        const int nrow = row + nwaves;
        f32x4 vn[4];
        if (nrow < TT) { const float* x = F.xrow_in(layer, nrow);
#pragma unroll
            for (int q = 0; q < 4; ++q) vn[q] = *(const f32x4*)(x + q * 256 + lane * 4); }
        if (layer > 0) {
            const half_t* xa = (const half_t*)(F.ws + WS_U16 + XAB_OFF) + (size_t)row * D; const half_t* xb = xa + (size_t)TT * D; float* xw = F.xrow(row);
#pragma unroll
            for (int q = 0; q < 4; ++q) { const int k = q * 256 + lane * 4; const half4 a4 = *(const half4*)(xa + k), b4 = *(const half4*)(xb + k);
#pragma unroll
                for (int e = 0; e < 4; ++e) v[q][e] += (float)a4[e] + (float)b4[e];
                *(f32x4*)(xw + k) = v[q]; } }
        const int m = row_mod(row);
        if (m != mc) { mc = m; const float* sh = modp(F, layer, m, 0); const float* scl = modp(F, layer, m, 1);
#pragma unroll
            for (int q = 0; q < 4; ++q) { const int k = q * 256 + lane * 4; const f32x4 a = *(const f32x4*)(nw + k), b = *(const f32x4*)(scl + k); s4[q] = *(const f32x4*)(sh + k);
#pragma unroll
                for (int e = 0; e < 4; ++e) g[q][e] = a[e] * (1.0f + b[e]); } }
        float ss = 0.f;
#pragma unroll
        for (int q = 0; q < 4; ++q) ss += v[q][0] * v[q][0] + v[q][1] * v[q][1] + v[q][2] * v[q][2] + v[q][3] * v[q][3];
        ss = wave_sum(ss);
        const float rs = 1.0f / sqrtf(ss * (1.0f / D) + EPSF);
        int srow = row;
        if (layer == 1 && row < TL) { const int b = row / SEQ, l = row % SEQ; srow = b * SEQ + (l % GW) * GROWS + l / GW; }
#pragma unroll
        for (int q = 0; q < 4; ++q) { const int k = q * 256 + lane * 4; half4 h;
#pragma unroll
            for (int e = 0; e < 4; ++e) h[e] = (half_t)(v[q][e] * rs * g[q][e] + s4[q][e]);
            *(half4*)(xn + (size_t)srow * D + k) = h; }
#pragma unroll
        for (int q = 0; q < 4; ++q) v[q] = vn[q];
    }
}

struct EpiInproj {
    static constexpr bool PERM = true;
    half_t* u16; float* ug; half_t* hyt; half_t* halo;
    __device__ __forceinline__ void operator()(const f32x4 (&acc)[2][2][4][2], const g8::Unit& u, int wr, int wc, int fr, int fq) const {
        const int rowb = u.pm * 256 + wr * 64 + fr;
        const bool edge = (fr == 0) || (fr == 15);
#pragma unroll
        for (int bj = 0; bj < 2; ++bj) {
            const int c8 = u.pn * 256 + bj * 128 + wc * 32 + 8 * fq;
            if (c8 + 8 <= 1024) {
                const bool hal = edge && c8 >= 384;
#pragma unroll
                for (int ai = 0; ai < 2; ++ai)
#pragma unroll
                    for (int m = 0; m < 4; ++m) { const int row = rowb + ai * 128 + m * 16; const f32x4 a0 = acc[ai][bj][m][0], a1 = acc[ai][bj][m][1]; half8 h;
                        h[0] = (half_t)a0[0]; h[1] = (half_t)a0[1]; h[2] = (half_t)a0[2]; h[3] = (half_t)a0[3]; h[4] = (half_t)a1[0]; h[5] = (half_t)a1[1]; h[6] = (half_t)a1[2]; h[7] = (half_t)a1[3];
                        *(half8*)(u16 + (size_t)row * UW + c8) = h;
                        if (hal) *(half8*)(halo + ((size_t)(row >> 4) * 2 + (fr == 15)) * 1408 + (c8 - 384)) = h; }
                continue;
            }
#pragma unroll
            for (int n = 0; n < 2; ++n) {
                const int c0 = c8 + 4 * n;
                if (c0 >= 1804 && c0 < 3340) {
                    const int uc = c0 - 1804 + 1024; const bool hal = edge && uc < 1792;
#pragma unroll
                    for (int ai = 0; ai < 2; ++ai)
#pragma unroll
                        for (int m = 0; m < 4; ++m) { const int row = rowb + ai * 128 + m * 16; const half4 h = to_half4(acc[ai][bj][m][n]);
                            *(half4*)(u16 + (size_t)row * UW + uc) = h;
                            if (hal) *(half4*)(halo + ((size_t)(row >> 4) * 2 + (fr == 15)) * 1408 + (uc - 384)) = h; }
                } else if ((c0 >= 1024 && c0 < 1036) || (c0 >= 3340 && c0 < NIN)) {
                    const int gc = c0 < 1036 ? c0 - 1024 : 12 + (c0 - 3340);
#pragma unroll
                    for (int ai = 0; ai < 2; ++ai)
#pragma unroll
                        for (int m = 0; m < 4; ++m) { const int row = rowb + ai * 128 + m * 16; *(f32x4*)(ug + (size_t)row * UGW + gc) = acc[ai][bj][m][n]; }
                } else if (c0 >= 1036 && c0 < 1804) {
                    const int ch = c0 - 1036;
#pragma unroll
                    for (int ai = 0; ai < 2; ++ai)
#pragma unroll
                        for (int m = 0; m < 4; ++m) { const int row = rowb + ai * 128 + m * 16; const f32x4 v = acc[ai][bj][m][n];
                            half_t* dst = row < TL ? hyt + ((size_t)(row / SEQ) * 768 + ch) * SEQ + row % SEQ : hyt + (size_t)NB * 768 * SEQ + ((size_t)((row - TL) / CTXL) * 768 + ch) * CTXL + (row - TL) % CTXL;
                            const size_t st = row < TL ? SEQ : CTXL;
#pragma unroll
                            for (int i = 0; i < 4; ++i) dst[i * st] = (half_t)v[i]; }
                }
            }
        }
    }
};
__device__ __forceinline__ void phase_inproj(const Frame& F, int layer) {
    g8::DenseSched S; S.abase = (const char*)(F.ws + WS_XN); S.bbase = (const char*)((const half_t*)(F.ws + WS_WIN) + (size_t)layer * NINP * D); S.K = D; S.nM = TT / 256; S.nN = NINP / 256; S.G = gridDim.x; S.c = blockIdx.x;
    EpiInproj E{(half_t*)(F.ws + WS_U16), (float*)(F.ws + WS_UG), (half_t*)(F.ws + WS_HYT), (half_t*)(F.ws + WS_HALO)};
    g8::gemm_phase(F.smem, D, S, E);
}


__device__ __forceinline__ void phase_act(const Frame& F, int layer) {
    half_t* u16 = (half_t*)(F.ws + WS_U16); const half_t* halo = (const half_t*)(F.ws + WS_HALO);
    const int tid = F.tid, g = tid % 176, hf = tid / 176;
    const bool active = tid < 352;
    const bool isml = g >= 80; const int ch = isml ? (g - 80) * 8 : g * 8, C = isml ? 768 : 640;
    const float* cw = isml ? F.in(I_MCW) + layer * 3 * 768 : F.in(I_SCW) + layer * 3 * 640; const float* cb = isml ? F.in(I_MCB) + layer * 768 : F.in(I_SCB) + layer * 640;
    const float osc = (isml && ch >= 384) ? 0.125f : 1.0f;
    float w0[8], w1[8], w2[8], wb[8];
#pragma unroll
    for (int i = 0; i < 8; ++i) { const int cc = active ? ch + i : 0; w0[i] = cw[cc]; w1[i] = cw[C + cc]; w2[i] = cw[2 * C + cc]; wb[i] = cb[cc]; }
    for (int it = blockIdx.x; it < TT / 16; it += gridDim.x) {
        const int rb = it * 16, r0 = rb + hf * 8;
        const bool isl = rb < TL; const int L = isl ? SEQ : CTXL; const int pos0 = (isl ? rb : rb - TL) % L;
        half8 rr[10]; half8 zz;
#pragma unroll
        for (int i = 0; i < 8; ++i) zz[i] = (half_t)0.f;
        if (active) {
            const size_t col = 384 + g * 8;
#pragma unroll
            for (int k = 0; k < 8; ++k) rr[k + 1] = *(const half8*)(u16 + (size_t)(r0 + k) * UW + col);
            if (hf == 0) { rr[0] = pos0 > 0 ? *(const half8*)(halo + ((size_t)(it - 1) * 2 + 1) * 1408 + g * 8) : zz; rr[9] = *(const half8*)(u16 + (size_t)(rb + 8) * UW + col); }
            else { rr[0] = *(const half8*)(u16 + (size_t)(rb + 7) * UW + col); rr[9] = pos0 + 16 < L ? *(const half8*)(halo + ((size_t)(it + 1) * 2 + 0) * 1408 + g * 8) : zz; }
        }
        half8 o[8];
        if (active) {
#pragma unroll
            for (int k = 0; k < 8; ++k)
#pragma unroll
                for (int i = 0; i < 8; ++i) o[k][i] = (half_t)(osc * fsilu(w0[i] * (float)rr[k][i] + w1[i] * (float)rr[k + 1][i] + w2[i] * (float)rr[k + 2][i] + wb[i]));
        }
        __syncthreads();
        if (active) {
#pragma unroll
            for (int k = 0; k < 8; ++k) *(half8*)(u16 + (size_t)(r0 + k) * UW + 384 + g * 8) = o[k];
        }
    }
}

constexpr int SA = 72, SB = 136;

__device__ __forceinline__ void load_rows8(const half_t* u16, int rowbase, int Lseq, int dir, int jj0, int ucol, half8 (&rr)[8]) {
#pragma unroll
    for (int k = 0; k < 8; ++k) { const int jj = jj0 + k, pos = dir == 0 ? jj : Lseq - 1 - jj; rr[k] = *(const half8*)(u16 + (size_t)(rowbase + pos) * UW + ucol); }
}
__device__ __forceinline__ void transpose8(const half8 (&rr)[8], half8 (&t)[8]) {
#pragma unroll
    for (int i = 0; i < 8; ++i)
#pragma unroll
        for (int k = 0; k < 8; ++k) t[i][k] = rr[k][i];
}
__device__ __forceinline__ void ssd_block(const Frame& F, int layer, int b, int h, int dir) {
    half_t* Cs = (half_t*)F.smem;
    half_t* Bs = Cs + 128 * SA;
    half_t* BT = Bs + 128 * SA;
    half_t* XT = BT + 64 * SB;
    half_t* SC = XT + 64 * SB;
    half_t* ST = SC + 128 * SB;
    float* cum = (float*)(ST + 64 * SA);
    float* dtv = cum + 128;
    float* wes = dtv + 128;
    const half_t* u16 = (const half_t*)(F.ws + WS_U16); const float* ug = (const float*)(F.ws + WS_UG);
    half_t* yout = (half_t*)(F.ws + WS_YF) + (size_t)dir * TT * 384;
    const float* cw = F.in(I_SCW) + layer * 3 * 640; const float* cb = F.in(I_SCB) + layer * 640;
    const float dtb = F.in(I_DTB)[(layer * 2 + dir) * 6 + h];
    const float Aneg = -expf(F.in(I_ALOG)[(layer * 2 + dir) * 6 + h]);
    const float Dh = F.in(I_SD)[layer * 6 + h];
    const int g = h / 3, tid = F.tid, lane = F.lane, wave = F.wave;
    const int kind = tid >> 7, c8 = (tid & 7) * 8, j0 = ((tid >> 3) & 15) * 8;
    const int ch = kind == 0 ? h * 64 + c8 : (kind == 1 ? 384 + g * 64 + c8 : 512 + g * 64 + c8);
    f32x4 accS[1][2]; zero_acc(accS);
    for (int i = tid; i < 64 * SA; i += NT) ST[i] = (half_t)0.f;
    constexpr int NC0 = CTXL / 128, NCT = NC0 + SEQ / 128;
    half8 rr[8]; float ug0 = 0.f, ug1 = 0.f;
    if (kind < 3) load_rows8(u16, TL + b * CTXL, CTXL, dir, j0, 384 + ch, rr);
    if (wave == 7) { const int p0 = dir == 0 ? 2 * lane : CTXL - 1 - 2 * lane, p1 = dir == 0 ? p0 + 1 : p0 - 1;
        ug0 = ug[(size_t)(TL + b * CTXL + p0) * UGW + dir * 6 + h]; ug1 = ug[(size_t)(TL + b * CTXL + p1) * UGW + dir * 6 + h]; }
    __syncthreads();
    for (int cc = 0; cc < NCT; ++cc) {
        const int seg = cc >= NC0 ? 1 : 0, c = seg ? cc - NC0 : cc;
        const int Lseq = seg == 0 ? CTXL : SEQ, rowbase = seg == 0 ? TL + b * CTXL : b * SEQ;
        const bool want_y = (seg == 1) || (layer == 0);
        const int nseg = (cc + 1) >= NC0 ? 1 : 0, ncn = nseg ? cc + 1 - NC0 : cc + 1, nL = nseg == 0 ? CTXL : SEQ, nrb = nseg == 0 ? TL + b * CTXL : b * SEQ;
        if (wave == 7) {
            const float dt0 = fsoftplus(ug0 + dtb), dt1 = fsoftplus(ug1 + dtb);
            const float a0 = dt0 * Aneg, a1 = dt1 * Aneg;
            const float incl = wave_scan_sum(a0 + a1, lane);
            const float c1 = incl, c0 = incl - a1;
            const float cl = wave_last(incl);
            cum[2 * lane] = c0; cum[2 * lane + 1] = c1; dtv[2 * lane] = dt0; dtv[2 * lane + 1] = dt1;
            wes[2 * lane] = dt0 * fexp(cl - c0); wes[2 * lane + 1] = dt1 * fexp(cl - c1);
            if (cc + 1 < NCT) { const int pi = ncn * 128 + 2 * lane, p0 = dir == 0 ? pi : nL - 1 - pi, p1 = dir == 0 ? p0 + 1 : p0 - 1;
                ug0 = ug[(size_t)(nrb + p0) * UGW + dir * 6 + h]; ug1 = ug[(size_t)(nrb + p1) * UGW + dir * 6 + h]; }
        }
        if (kind < 3) {
            if (kind == 0) { half8 t[8]; transpose8(rr, t);
#pragma unroll
                for (int i = 0; i < 8; ++i) *(half8*)(XT + (c8 + i) * SB + j0) = t[i];
            } else if (kind == 1) { half8 t[8]; transpose8(rr, t);
#pragma unroll
                for (int k = 0; k < 8; ++k) *(half8*)(Bs + (j0 + k) * SA + c8) = rr[k];
#pragma unroll
                for (int i = 0; i < 8; ++i) *(half8*)(BT + (c8 + i) * SB + j0) = t[i];
            } else {
#pragma unroll
                for (int k = 0; k < 8; ++k) *(half8*)(Cs + (j0 + k) * SA + c8) = rr[k];
            }
            if (cc + 1 < NCT) load_rows8(u16, nrb, nL, dir, ncn * 128 + j0, 384 + ch, rr);
        }
        __syncthreads();
        const float cl = cum[127];
        if (want_y) {
            { const int ws_ = wave & 1, wl = wave >> 1;
              if (!(ws_ == 1 && wl < 2)) {
                f32x4 g_[4][2]; zero_acc(g_);
                mma_lds<4, 2>(g_, Bs + ws_ * 64 * SA, SA, Cs + wl * 32 * SA, SA, 2, lane);
#pragma unroll
                for (int a = 0; a < 4; ++a) {
                    const int s0 = ws_ * 64 + a * 16 + (lane >> 4) * 4;
                    const f32x4 cs4 = *(const f32x4*)(cum + s0), dt4 = *(const f32x4*)(dtv + s0);
#pragma unroll
                    for (int q = 0; q < 2; ++q) {
                        const int l = wl * 32 + q * 16 + (lane & 15); const float cl_ = cum[l]; half4 hv;
#pragma unroll
                        for (int i = 0; i < 4; ++i) hv[i] = (half_t)((s0 + i) <= l ? g_[a][q][i] * fexp(cl_ - cs4[i]) * dt4[i] : 0.f);
                        *(half4*)(SC + l * SB + s0) = hv;
                    } }
              } }
            f32x4 y1[4][1]; zero_acc(y1);
            mma_lds<4, 1>(y1, ST, SA, Cs + wave * 16 * SA, SA, 2, lane);
            __syncthreads();
            f32x4 y2[4][1]; zero_acc(y2);
            mma_lds<4, 1>(y2, XT, SB, SC + wave * 16 * SB, SB, wave / 2 + 1, lane);
            { const int l = wave * 16 + (lane & 15); const float el = fexp(cum[l]);
              const int pi = c * 128 + l, pos = dir == 0 ? pi : Lseq - 1 - pi;
#pragma unroll
              for (int a = 0; a < 4; ++a) { const int p0 = a * 16 + (lane >> 4) * 4; f32x4 y;
#pragma unroll
                  for (int i = 0; i < 4; ++i) y[i] = y1[a][0][i] * el + y2[a][0][i];
                  if (dir == 0) {
#pragma unroll
                      for (int i = 0; i < 4; ++i) y[i] += Dh * (float)XT[(p0 + i) * SB + l]; }
                  *(half4*)(yout + (size_t)(rowbase + pos) * 384 + h * 64 + p0) = to_half4(y); } }
        }
        { const float dec = fexp(cl);
#pragma unroll
          for (int q = 0; q < 2; ++q) accS[0][q] *= dec;
          const int r = lane & 15, kq = (lane >> 4) * 8;
#pragma unroll
          for (int ks = 0; ks < 4; ++ks) {
              const half8 a = *(const half8*)(BT + ((wave >> 1) * 16 + r) * SB + ks * 32 + kq);
              const f32x4 e0 = *(const f32x4*)(wes + ks * 32 + kq), e1 = *(const f32x4*)(wes + ks * 32 + kq + 4);
#pragma unroll
              for (int q = 0; q < 2; ++q) { half8 bb = *(const half8*)(XT + ((wave & 1) * 32 + q * 16 + r) * SB + ks * 32 + kq);
#pragma unroll
                  for (int i = 0; i < 4; ++i) { bb[i] = (half_t)((float)bb[i] * e0[i]); bb[4 + i] = (half_t)((float)bb[4 + i] * e1[i]); }
                  accS[0][q] = mfma16(a, bb, accS[0][q]); } } }
        __syncthreads();
#pragma unroll
        for (int q = 0; q < 2; ++q) { const int p = (wave & 1) * 32 + q * 16 + (lane & 15), n0 = (wave >> 1) * 16 + (lane >> 4) * 4; *(half4*)(ST + p * SA + n0) = to_half4(accS[0][q]); }
    }
    __syncthreads();
}

__device__ __forceinline__ void mlstm_block(const Frame& F, int layer, int b, int h, int dir) {
    half_t* Qs = (half_t*)F.smem;
    half_t* Ks = Qs + 128 * SA;
    half_t* KT = Ks + 128 * SA;
    half_t* VT = KT + 64 * SB;
    half_t* SC = VT + 64 * SB;
    half_t* CS = SC + 128 * SB;
    float* ig = (float*)(CS + 64 * SA);
    float* cumf = ig + 128; float* gsv = cumf + 128; float* mtv = gsv + 128; float* ee = mtv + 128; float* dn = ee + 128;
    float* nvec = dn + 128;
    float* scal = nvec + 64;
    const half_t* u16 = (const half_t*)(F.ws + WS_U16); const float* ug = (const float*)(F.ws + WS_UG);
    half_t* hout = (half_t*)(F.ws + WS_YF) + (size_t)(2 + dir) * TT * 384;
    const float* cw = F.in(I_MCW) + layer * 3 * 768; const float* cb = F.in(I_MCB) + layer * 768;
    const float bi = F.in(I_MGB)[((layer * 2 + dir) * 2 + 0) * 6 + h], bf = F.in(I_MGB)[((layer * 2 + dir) * 2 + 1) * 6 + h];
    const int tid = F.tid, lane = F.lane, wave = F.wave;
    const int kind = tid >> 7, c8 = (tid & 7) * 8, j0 = ((tid >> 3) & 15) * 8;
    const int ch = kind == 0 ? h * 64 + c8 : 384 + h * 64 + c8;
    f32x4 accC[1][2]; zero_acc(accC);
    float m_in = 0.f;
    for (int i = tid; i < 64 * SA; i += NT) CS[i] = (half_t)0.f;
    if (tid < 64) nvec[tid] = 0.f;
    constexpr int NC0 = CTXL / 128, NCT = NC0 + SEQ / 128;
    half8 rr[8]; float gi0 = 0.f, gi1 = 0.f, gf0 = 0.f, gf1 = 0.f;
    const int ucol = kind == 2 ? 1792 + h * 64 + c8 : 1024 + ch;
    if (kind < 3) load_rows8(u16, TL + b * CTXL, CTXL, dir, j0, ucol, rr);
    if (wave == 7) { const int p0 = dir == 0 ? 2 * lane : CTXL - 1 - 2 * lane, p1 = dir == 0 ? p0 + 1 : p0 - 1;
        const float* g0 = ug + (size_t)(TL + b * CTXL + p0) * UGW + 12 + dir * 12; const float* g1 = ug + (size_t)(TL + b * CTXL + p1) * UGW + 12 + dir * 12;
        gi0 = g0[h]; gf0 = g0[6 + h]; gi1 = g1[h]; gf1 = g1[6 + h]; }
    half8 ones;
#pragma unroll
    for (int i = 0; i < 8; ++i) ones[i] = (half_t)1.0f;
    __syncthreads();
    for (int cc = 0; cc < NCT; ++cc) {
        const int seg = cc >= NC0 ? 1 : 0, c = seg ? cc - NC0 : cc;
        const int Lseq = seg == 0 ? CTXL : SEQ, rowbase = seg == 0 ? TL + b * CTXL : b * SEQ;
        const bool want_y = (seg == 1) || (layer == 0);
        const int nseg = (cc + 1) >= NC0 ? 1 : 0, ncn = nseg ? cc + 1 - NC0 : cc + 1, nL = nseg == 0 ? CTXL : SEQ, nrb = nseg == 0 ? TL + b * CTXL : b * SEQ;
        if (wave == 7) {
            const float i0 = gi0 + bi, i1 = gi1 + bi, lf0 = flogsigmoid(gf0 + bf), lf1 = flogsigmoid(gf1 + bf);
            const float incl = wave_scan_sum(lf0 + lf1, lane);
            const float c1 = incl, c0 = incl - lf1;
            const float tot = wave_last(incl);
            const float r0 = i0 - c0, r1 = i1 - c1;
            const float pincl = wave_scan_max(fmaxf(r0, r1), lane);
            const float pexcl = wave_shr1(pincl, -3.0e38f, lane);
            const float pm0 = fmaxf(pexcl, r0), pm1 = pincl;
            const float pmlast = wave_last(pincl);
            const float m_new = fmaxf(tot + m_in, tot + pmlast);
            ig[2 * lane] = i0; ig[2 * lane + 1] = i1; cumf[2 * lane] = c0; cumf[2 * lane + 1] = c1; gsv[2 * lane] = r0; gsv[2 * lane + 1] = r1;
            mtv[2 * lane] = fmaxf(c0 + m_in, c0 + pm0); mtv[2 * lane + 1] = fmaxf(c1 + m_in, c1 + pm1);
            ee[2 * lane] = fexp(r0 + tot - m_new); ee[2 * lane + 1] = fexp(r1 + tot - m_new);
            if (lane == 0) { scal[0] = tot; scal[1] = m_new; }
            if (cc + 1 < NCT) { const int pi = ncn * 128 + 2 * lane, p0 = dir == 0 ? pi : nL - 1 - pi, p1 = dir == 0 ? p0 + 1 : p0 - 1;
                const float* g0 = ug + (size_t)(nrb + p0) * UGW + 12 + dir * 12; const float* g1 = ug + (size_t)(nrb + p1) * UGW + 12 + dir * 12;
                gi0 = g0[h]; gf0 = g0[6 + h]; gi1 = g1[h]; gf1 = g1[6 + h]; }
        }
        if (kind == 0) {
#pragma unroll
            for (int k = 0; k < 8; ++k) *(half8*)(Qs + (j0 + k) * SA + c8) = rr[k];
        } else if (kind == 1) { half8 t[8]; transpose8(rr, t);
#pragma unroll
            for (int k = 0; k < 8; ++k) *(half8*)(Ks + (j0 + k) * SA + c8) = rr[k];
#pragma unroll
            for (int i = 0; i < 8; ++i) *(half8*)(KT + (c8 + i) * SB + j0) = t[i];
        } else if (kind == 2) { half8 t[8]; transpose8(rr, t);
#pragma unroll
            for (int i = 0; i < 8; ++i) *(half8*)(VT + (c8 + i) * SB + j0) = t[i];
        }
        if (kind < 3 && cc + 1 < NCT) load_rows8(u16, nrb, nL, dir, ncn * 128 + j0, ucol, rr);
        __syncthreads();
        const float tot = scal[0], m_new = scal[1];
        if (want_y) {
            { const int ws_ = wave & 1, wl = wave >> 1;
              if (!(ws_ == 1 && wl < 2)) {
                f32x4 g_[4][2]; zero_acc(g_);
                mma_lds<4, 2>(g_, Ks + ws_ * 64 * SA, SA, Qs + wl * 32 * SA, SA, 2, lane);
#pragma unroll
                for (int a = 0; a < 4; ++a) {
                    const int s0 = ws_ * 64 + a * 16 + (lane >> 4) * 4; const f32x4 gs4 = *(const f32x4*)(gsv + s0);
#pragma unroll
                    for (int q = 0; q < 2; ++q) {
                        const int l = wl * 32 + q * 16 + (lane & 15); const float cm = cumf[l] - mtv[l]; half4 hv;
#pragma unroll
                        for (int i = 0; i < 4; ++i) hv[i] = (half_t)((s0 + i) <= l ? g_[a][q][i] * fexp(cm + gs4[i]) : 0.f);
                        *(half4*)(SC + l * SB + s0) = hv;
                    } }
              } }
            f32x4 h1[4][1]; zero_acc(h1);
            mma_lds<4, 1>(h1, CS, SA, Qs + wave * 16 * SA, SA, 2, lane);
            f32x4 dq = {0.f, 0.f, 0.f, 0.f};
            { const int r_ = lane & 15, kq_ = (lane >> 4) * 8;
#pragma unroll
              for (int ks = 0; ks < 2; ++ks) { half8 na; const f32x4 n0 = *(const f32x4*)(nvec + ks * 32 + kq_), n1 = *(const f32x4*)(nvec + ks * 32 + kq_ + 4);
#pragma unroll
                  for (int i = 0; i < 4; ++i) { na[i] = (half_t)n0[i]; na[4 + i] = (half_t)n1[i]; }
                  dq = mfma16(na, *(const half8*)(Qs + (wave * 16 + r_) * SA + ks * 32 + kq_), dq); } }
            __syncthreads();
            f32x4 h2[4]; f32x4 d1 = {0.f, 0.f, 0.f, 0.f};
#pragma unroll
            for (int a = 0; a < 4; ++a) h2[a] = (f32x4){0.f, 0.f, 0.f, 0.f};
            { const int r = lane & 15, kq = (lane >> 4) * 8;
              for (int ks = 0; ks < wave / 2 + 1; ++ks) {
                  const half8 bfr = *(const half8*)(SC + (wave * 16 + r) * SB + ks * 32 + kq);
#pragma unroll
                  for (int a = 0; a < 4; ++a) { const half8 afr = *(const half8*)(VT + (a * 16 + r) * SB + ks * 32 + kq); h2[a] = mfma16(afr, bfr, h2[a]); }
                  d1 = mfma16(ones, bfr, d1); } }
            { const int l = wave * 16 + (lane & 15); const float ai = fexp(cumf[l] + m_in - mtv[l]); const float rden = 1.0f / fmaxf(fabsf(dq[0] * ai + d1[0]), fexp(-mtv[l]));
              const int pi = c * 128 + l, pos = dir == 0 ? pi : Lseq - 1 - pi;
#pragma unroll
              for (int a = 0; a < 4; ++a) { const int v0 = a * 16 + (lane >> 4) * 4; f32x4 y;
#pragma unroll
                  for (int i = 0; i < 4; ++i) y[i] = (h1[a][0][i] * ai + h2[a][i]) * rden;
                  *(half4*)(hout + (size_t)(rowbase + pos) * 384 + h * 64 + v0) = to_half4(y); } }
        }
        { const float sc = fexp(tot + m_in - m_new);
#pragma unroll
          for (int q = 0; q < 2; ++q) accC[0][q] *= sc;
          { const int r = lane & 15, kq = (lane >> 4) * 8;
#pragma unroll
            for (int ks = 0; ks < 4; ++ks) {
              const half8 a = *(const half8*)(KT + ((wave >> 1) * 16 + r) * SB + ks * 32 + kq);
              const f32x4 e0 = *(const f32x4*)(ee + ks * 32 + kq), e1 = *(const f32x4*)(ee + ks * 32 + kq + 4);
#pragma unroll
              for (int q = 0; q < 2; ++q) { half8 bb = *(const half8*)(VT + ((wave & 1) * 32 + q * 16 + r) * SB + ks * 32 + kq);
#pragma unroll
                  for (int i = 0; i < 4; ++i) { bb[i] = (half_t)((float)bb[i] * e0[i]); bb[4 + i] = (half_t)((float)bb[4 + i] * e1[i]); }
                  accC[0][q] = mfma16(a, bb, accC[0][q]); } } }
          if ((wave & 1) == 0) { f32x4 an = {0.f, 0.f, 0.f, 0.f}; const int r_ = lane & 15, kq_ = (lane >> 4) * 8;
#pragma unroll
              for (int ks = 0; ks < 4; ++ks) { half8 eb; const f32x4 e0 = *(const f32x4*)(ee + ks * 32 + kq_), e1 = *(const f32x4*)(ee + ks * 32 + kq_ + 4);
#pragma unroll
                  for (int i = 0; i < 4; ++i) { eb[i] = (half_t)e0[i]; eb[4 + i] = (half_t)e1[i]; }
                  an = mfma16(*(const half8*)(KT + ((wave >> 1) * 16 + r_) * SB + ks * 32 + kq_), eb, an); }
              if ((lane & 15) == 0) {
#pragma unroll
                  for (int i = 0; i < 4; ++i) { const int d = (wave >> 1) * 16 + (lane >> 4) * 4 + i; nvec[d] = sc * nvec[d] + an[i]; } } } }
        m_in = m_new;
        __syncthreads();
#pragma unroll
        for (int q = 0; q < 2; ++q) { const int v = (wave & 1) * 32 + q * 16 + (lane & 15), d0 = (wave >> 1) * 16 + (lane >> 4) * 4; *(half4*)(CS + v * SA + d0) = to_half4(accC[0][q]); }
    }
    __syncthreads();
}

__device__ __forceinline__ cplx cmul(cplx a, cplx b) { return cplx{a.x * b.x - a.y * b.y, a.x * b.y + a.y * b.x}; }
__device__ __forceinline__ cplx cadd(cplx a, cplx b) { return cplx{a.x + b.x, a.y + b.y}; }
__device__ __forceinline__ cplx csub(cplx a, cplx b) { return cplx{a.x - b.x, a.y - b.y}; }
__device__ __forceinline__ void sincos_turns(float x, float& s, float& c) {
#ifdef EMU
    s = sinf(6.283185307179586f * x); c = cosf(6.283185307179586f * x);
#else
    s = __builtin_amdgcn_sinf(x); c = __builtin_amdgcn_cosf(x);
#endif
}
#define PADI(i) ((i) + ((i) >> 5))
template <bool INV> __device__ __forceinline__ void r4(cplx& a0, cplx& a1, cplx& a2, cplx& a3) {
    const cplx t0 = cadd(a0, a2), t1 = csub(a0, a2), t2 = cadd(a1, a3), t3 = csub(a1, a3);
    a0 = cadd(t0, t2); a2 = csub(t0, t2);
    if (!INV) { a1 = cplx{t1.x + t3.y, t1.y - t3.x}; a3 = cplx{t1.x - t3.y, t1.y + t3.x}; }
    else      { a1 = cplx{t1.x - t3.y, t1.y + t3.x}; a3 = cplx{t1.x + t3.y, t1.y - t3.x}; }
}
template <bool INV> __device__ __forceinline__ void fft16(cplx (&v)[16]) {
#pragma unroll
    for (int l0 = 0; l0 < 4; ++l0) r4<INV>(v[l0], v[l0 + 4], v[l0 + 8], v[l0 + 12]);
    const float C1 = 0.9238795325112867f, S1 = 0.3826834323650898f, C2 = 0.7071067811865476f;
    const float sg = INV ? 1.f : -1.f;
#define TWM(idx, cr, ci) v[idx] = cmul(v[idx], cplx{(cr), sg * (ci)})
    TWM(1 + 4 * 1, C1, S1); TWM(2 + 4 * 1, C2, C2); TWM(3 + 4 * 1, S1, C1);
    TWM(1 + 4 * 2, C2, C2); TWM(2 + 4 * 2, 0.f, 1.f); TWM(3 + 4 * 2, -C2, C2);
    TWM(1 + 4 * 3, S1, C1); TWM(2 + 4 * 3, -C2, C2); TWM(3 + 4 * 3, -C1, -S1);
#undef TWM
    cplx o[16];
#pragma unroll
    for (int m0 = 0; m0 < 4; ++m0) { cplx a0 = v[4 * m0], a1 = v[4 * m0 + 1], a2 = v[4 * m0 + 2], a3 = v[4 * m0 + 3]; r4<INV>(a0, a1, a2, a3);
        o[m0] = a0; o[m0 + 4] = a1; o[m0 + 8] = a2; o[m0 + 12] = a3; }
#pragma unroll
    for (int i = 0; i < 16; ++i) v[i] = o[i];
}
__device__ __forceinline__ void twpow(cplx w1, cplx (&w)[16]) {
    w[1] = w1; w[2] = cmul(w1, w1); w[3] = cmul(w[2], w1); w[4] = cmul(w[2], w[2]); w[5] = cmul(w[4], w1); w[6] = cmul(w[4], w[2]); w[7] = cmul(w[4], w[3]); w[8] = cmul(w[4], w[4]);
#pragma unroll
    for (int m = 9; m < 16; ++m) w[m] = cmul(w[8], w[m - 8]);
}
#ifdef EMU
#define OPAQUE_I(x)
#else
#define OPAQUE_I(x) asm volatile("" : "+v"(x))
#endif
template <int NS> __device__ __forceinline__ void fft_fwd16(cplx* buf0, cplx* buf1, int N, int tid) {
#pragma unroll 1
    for (int n = N; n >= 32; n >>= 4) { const int q = n >> 4, qs = q + (q >> 5);
        for (int i = tid; i < N / 16; i += NT) {
            const int blk = i / q, j = i - blk * q; int pb = PADI(blk * n + j); OPAQUE_I(pb);
            float s, c; sincos_turns(-(float)j / (float)n, s, c);
            const cplx w1{c, s};
#pragma unroll
            for (int st = 0; st < NS; ++st) { cplx* buf = (st == 0 ? buf0 : buf1) + pb;
                cplx v[16];
#pragma unroll
                for (int l = 0; l < 16; ++l) v[l] = buf[l * qs];
                fft16<false>(v);
                buf[0] = v[0];
                cplx wm = w1;
#pragma unroll
                for (int m = 1; m < 16; ++m) { buf[m * qs] = cmul(v[m], wm); wm = cmul(wm, w1); }
                LOADER_FENCE(); }
        }
        __syncthreads(); }
}
template <int NS> __device__ __forceinline__ void fft_inv16(cplx* buf0, cplx* buf1, int N, int tid) {
#pragma unroll 1
    for (int n = 32; n <= N; n <<= 4) { const int q = n >> 4, qs = q + (q >> 5);
        for (int i = tid; i < N / 16; i += NT) {
            const int blk = i / q, j = i - blk * q; int pb = PADI(blk * n + j); OPAQUE_I(pb);
            float s, c; sincos_turns((float)j / (float)n, s, c);
            const cplx w1{c, s};
#pragma unroll
            for (int st = 0; st < NS; ++st) { cplx* buf = (st == 0 ? buf0 : buf1) + pb;
                cplx v[16];
                v[0] = buf[0];
                cplx wm = w1;
#pragma unroll
                for (int m = 1; m < 16; ++m) { v[m] = cmul(buf[m * qs], wm); wm = cmul(wm, w1); }
                fft16<true>(v);
#pragma unroll
                for (int l = 0; l < 16; ++l) buf[l * qs] = v[l];
                LOADER_FENCE(); }
        }
        __syncthreads(); }
}
static_assert(2 * SEQ == 512 || 2 * SEQ == 8192, "FFT size must be 2*16^k");
static_assert(2 * CTXL == 512 || 2 * CTXL == 8192, "FFT size must be 2*16^k");
constexpr int HBUF = (2 * SEQ + (2 * SEQ) / 32 + 8);
constexpr int HPT = (SEQ + NT - 1) / NT;
__device__ __forceinline__ void hy_conv8(const half_t* p, int t0, int L, float w0, float w1, float w2, float bsv, float (&o)[8]) {
    const half8 m = *(const half8*)(p + t0);
    float e[10]; e[0] = t0 > 0 ? (float)p[t0 - 1] : 0.f; e[9] = t0 + 8 < L ? (float)p[t0 + 8] : 0.f;
#pragma unroll
    for (int i = 0; i < 8; ++i) e[i + 1] = (float)m[i];
#pragma unroll
    for (int i = 0; i < 8; ++i) o[i] = w0 * e[i] + w1 * e[i + 1] + w2 * e[i + 2] + bsv;
}
template <int NS> __device__ __forceinline__ void hyena_seg_t(const Frame& F, int layer, int c, const int seg) {
    cplx* bufA = (cplx*)F.smem;
    cplx* bufB = bufA + HBUF;
    float* red = (float*)(bufB + HBUF);
    const int tid = F.tid;
    const float* cwp = F.in(I_HCW) + layer * 3 * 768; const float* cbp = F.in(I_HCB) + layer * 768;
    {
        const int L = seg == 0 ? SEQ : CTXL, N = 2 * L;
        const half_t* hyt = (const half_t*)(F.ws + WS_HYT) + (seg == 0 ? 0 : (size_t)NB * 768 * SEQ);
        float* z1 = (float*)(F.ws + WS_XN) + (seg == 0 ? 0 : (size_t)NB * 256 * SEQ);
        float* yht = (float*)(F.ws + WS_YHT) + (seg == 0 ? 0 : (size_t)NB * 256 * SEQ);
        const float* ft = (const float*)(F.ws + WS_FT) + (seg == 0 ? (size_t)layer * 256 * 4 * SEQ : (size_t)2 * 256 * 4 * SEQ);
        for (int order = 0; order < 2; ++order) {
            const float* hfw = ft + ((size_t)(c * 2 + order) * 2 + 0) * L; const float* hbw = ft + ((size_t)(c * 2 + order) * 2 + 1) * L;
            float asum = 0.f;
            for (int i_ = tid; i_ < N; i_ += NT) { int i = i_; OPAQUE_I(i); const float v = i < L ? hfw[i] : (i == L ? 0.f : hbw[N - i]); bufA[PADI(i)] = cplx{v, 0.f}; asum += fabsf(v); }
            asum = wave_sum(asum);
            if (F.lane == 0) red[F.wave] = asum;
            __syncthreads();
            float tot = 0.f; for (int w = 0; w < NT / 64; ++w) tot += red[w];
            fft_fwd16<1>(bufA, bufA, N, tid);
            half4 Hh[HPT];
            const float hs = 1.0f / tot, invN = 1.0f / (float)N;
#pragma unroll
            for (int k = 0; k < HPT; ++k) { int i = tid + k * NT; OPAQUE_I(i); half4 hv;
                if (i < N / 2) { const cplx a = bufA[PADI(2 * i)], b_ = bufA[PADI(2 * i + 1)]; const cplx s = cadd(a, b_), d = csub(a, b_);
                    hv[0] = (half_t)(s.x * hs); hv[1] = (half_t)(s.y * hs); hv[2] = (half_t)(d.x * hs); hv[3] = (half_t)(d.y * hs); }
                else { hv[0] = hv[1] = hv[2] = hv[3] = (half_t)0.f; }
                Hh[k] = hv; LOADER_FENCE(); }
            __syncthreads();
            const int gch = 256 * (order + 1) + c;
            for (int pr = 0; pr < NB / 2; pr += NS) {
#pragma unroll
                for (int st = 0; st < NS; ++st) { cplx* buf = st == 0 ? bufA : bufB; const int b0 = 2 * (pr + st), b1 = b0 + 1;
                    const float vw0 = cwp[c], vw1 = cwp[768 + c], vw2 = cwp[1536 + c], vb = cbp[c];
                    const half_t* v0p = hyt + ((size_t)b0 * 768 + c) * L; const half_t* v1p = hyt + ((size_t)b1 * 768 + c) * L;
                    const float* z0q = z1 + ((size_t)b0 * 256 + c) * L; const float* z1q = z1 + ((size_t)b1 * 256 + c) * L;
                    for (int t0_ = tid * 8; t0_ < N; t0_ += NT * 8) { int t0 = t0_; OPAQUE_I(t0);
                        if (t0 < L) { float za[8], zb[8];
                            if (order == 0) { hy_conv8(v0p, t0, L, vw0, vw1, vw2, vb, za); hy_conv8(v1p, t0, L, vw0, vw1, vw2, vb, zb); }
                            else {
#pragma unroll
                                for (int i = 0; i < 8; ++i) { za[i] = z0q[t0 + i]; zb[i] = z1q[t0 + i]; } }
#pragma unroll
                            for (int i = 0; i < 8; ++i) buf[PADI(t0 + i)] = cplx{za[i], zb[i]}; }
                        else {
#pragma unroll
                            for (int i = 0; i < 8; ++i) buf[PADI(t0 + i)] = cplx{0.f, 0.f}; }
                        LOADER_FENCE();
                    } }
                __syncthreads();
                fft_fwd16<NS>(bufA, bufB, N, tid);
#pragma unroll
                for (int st = 0; st < NS; ++st) { cplx* buf = st == 0 ? bufA : bufB;
#pragma unroll
                    for (int k = 0; k < HPT; ++k) { int i = tid + k * NT; OPAQUE_I(i);
                        if (i < N / 2) { const cplx a = buf[PADI(2 * i)], b_ = buf[PADI(2 * i + 1)];
                            const cplx h0{(float)Hh[k][0] * invN, (float)Hh[k][1] * invN}, h1{(float)Hh[k][2] * invN, (float)Hh[k][3] * invN};
                            const cplx s = cmul(cadd(a, b_), h0), d = cmul(csub(a, b_), h1);
                            buf[PADI(2 * i)] = cadd(s, d); buf[PADI(2 * i + 1)] = csub(s, d); }
                        LOADER_FENCE(); } }
                __syncthreads();
                fft_inv16<NS>(bufA, bufB, N, tid);
#pragma unroll
                for (int st = 0; st < NS; ++st) { cplx* buf = st == 0 ? bufA : bufB; const int b0 = 2 * (pr + st), b1 = b0 + 1;
                    const float gw0 = cwp[gch], gw1 = cwp[768 + gch], gw2 = cwp[1536 + gch], gb = cbp[gch];
                    const float vw0 = cwp[c], vw1 = cwp[768 + c], vw2 = cwp[1536 + c], vb = cbp[c];
                    const float skip = F.in(I_HSKIP)[(layer * 2 + order) * 256 + c];
                    const half_t* v0p = hyt + ((size_t)b0 * 768 + c) * L; const half_t* v1p = hyt + ((size_t)b1 * 768 + c) * L;
                    const float* z0q = z1 + ((size_t)b0 * 256 + c) * L; const float* z1q = z1 + ((size_t)b1 * 256 + c) * L;
                    const half_t* g0p = hyt + ((size_t)b0 * 768 + gch) * L; const half_t* g1p = hyt + ((size_t)b1 * 768 + gch) * L;
                    float* d0 = (order == 0 ? z1 : yht) + ((size_t)b0 * 256 + c) * L; float* d1 = (order == 0 ? z1 : yht) + ((size_t)b1 * 256 + c) * L;
                    for (int t0_ = tid * 8; t0_ < L; t0_ += NT * 8) { int t0 = t0_; OPAQUE_I(t0);
                        float za[8], zb[8], ga[8], gb_[8];
                        if (order == 0) { hy_conv8(v0p, t0, L, vw0, vw1, vw2, vb, za); hy_conv8(v1p, t0, L, vw0, vw1, vw2, vb, zb); }
                        else {
#pragma unroll
                            for (int i = 0; i < 8; ++i) { za[i] = z0q[t0 + i]; zb[i] = z1q[t0 + i]; } }
                        hy_conv8(g0p, t0, L, gw0, gw1, gw2, gb, ga); hy_conv8(g1p, t0, L, gw0, gw1, gw2, gb, gb_);
                        f32x4 oa[2], ob[2];
#pragma unroll
                        for (int i = 0; i < 8; ++i) { const cplx y = buf[PADI(t0 + i)]; oa[i >> 2][i & 3] = ga[i] * (y.x + skip * za[i]); ob[i >> 2][i & 3] = gb_[i] * (y.y + skip * zb[i]); }
                        *(f32x4*)(d0 + t0) = oa[0]; *(f32x4*)(d0 + t0 + 4) = oa[1]; *(f32x4*)(d1 + t0) = ob[0]; *(f32x4*)(d1 + t0 + 4) = ob[1];
                        LOADER_FENCE();
                    } }
                __syncthreads();
            }
        }
    }
}
__device__ __forceinline__ void hyena_channel(const Frame& F, int layer, int c) {
    constexpr int NS = (NB % 4 == 0) ? 2 : 1;
    for (int seg = 0; seg < (layer == 0 ? 2 : 1); ++seg) hyena_seg_t<NS>(F, layer, c, seg);
}
__device__ __forceinline__ int queue_pull(const Frame& F, unsigned* head) {
    int* slot = (int*)(F.smem + LDS_BYTES - 64);
    __syncthreads();
    if (F.tid == 0) *slot = (int)atomicAdd(head, 1u);
    __syncthreads();
    const int v = *slot;
    return v;
}
__device__ __forceinline__ void phase_mixers(const Frame& F, int layer) {
    const int bid = blockIdx.x;
    constexpr int NSCAN = 2 * NB * 6 * 2;
    unsigned* qhead = (unsigned*)(F.ws + WS_CTL) + CW_QUE + layer * 128;
    if (bid < NSCAN) {
        const int k = bid >> 1, kind = bid & 1, dir = k % 2, h = (k / 2) % 6, b = k / 12;
        if (kind == 0) ssd_block(F, layer, b, h, dir); else mlstm_block(F, layer, b, h, dir);
    }
    for (;;) { const int c = queue_pull(F, qhead); if (c >= 256) break; hyena_channel(F, layer, c); }
    for (;;) { const int it = queue_pull(F, qhead + 64); if (it >= IT_TMOE) break; moe_transpose_item(F, layer, it); }
}

__device__ __forceinline__ void phase_combine(const Frame& F, int layer) {
    const int nrows = layer == 0 ? TT : TL;
    const half_t* u16 = (const half_t*)(F.ws + WS_U16);
    const half_t* yf = (const half_t*)(F.ws + WS_YF); const half_t* yb = yf + (size_t)TT * 384; const half_t* hf = yb + (size_t)TT * 384; const half_t* hb = hf + (size_t)TT * 384;
    half_t* yl = (half_t*)(F.ws + WS_XN);
    const float* snw = F.in(I_SNW) + layer * 384; const float* mnw = F.in(I_MNW) + layer * 384;
    const int lane = F.lane, k8 = (lane < 48 ? lane : 0) * 8, nwaves = gridDim.x * (NT / 64);
    f32x4 sw[2], mw[2];
#pragma unroll
    for (int q = 0; q < 2; ++q) { sw[q] = *(const f32x4*)(snw + k8 + q * 4); mw[q] = *(const f32x4*)(mnw + k8 + q * 4); }
    int row = blockIdx.x * (NT / 64) + F.wave;
    half8 a[6];
#define COMB_LOAD(dst, r) { const size_t ro = (size_t)(r); dst[0] = *(const half8*)(yf + ro * 384 + k8); dst[1] = *(const half8*)(yb + ro * 384 + k8); dst[2] = *(const half8*)(u16 + ro * UW + k8); \
        dst[3] = *(const half8*)(hf + ro * 384 + k8); dst[4] = *(const half8*)(hb + ro * 384 + k8); dst[5] = *(const half8*)(u16 + ro * UW + 2176 + k8); }
    if (row < nrows) COMB_LOAD(a, row)
    for (; row < nrows; row += nwaves) {
        const int nrow = row + nwaves;
        half8 an[6];
        if (nrow < nrows) COMB_LOAD(an, nrow)
        const size_t ro = (size_t)row;
        float g[8], hv[8]; float ss = 0.f, hs = 0.f;
#pragma unroll
        for (int i = 0; i < 8; ++i) { g[i] = ((float)a[0][i] + (float)a[1][i]) * fsilu((float)a[2][i]); ss += g[i] * g[i]; hv[i] = (float)a[3][i] + (float)a[4][i]; hs += hv[i]; }
        if (lane >= 48) ss = 0.f;
        ss = wave_sum(ss);
        hs += __shfl_xor(hs, 1); hs += __shfl_xor(hs, 2); hs += __shfl_xor(hs, 4);
        const float mu = hs * (1.0f / 64.f);
        float vs = 0.f;
#pragma unroll
        for (int i = 0; i < 8; ++i) { hv[i] -= mu; vs += hv[i] * hv[i]; }
        vs += __shfl_xor(vs, 1); vs += __shfl_xor(vs, 2); vs += __shfl_xor(vs, 4);
        const float rs = 1.0f / sqrtf(ss * (1.0f / 384.f) + EPSF), rstd = 1.0f / sqrtf(vs * (1.0f / 64.f) + EPSF);
        if (lane < 48) { half8 o1, o2;
#pragma unroll
            for (int i = 0; i < 8; ++i) { o1[i] = (half_t)(g[i] * rs * sw[i >> 2][i & 3]); o2[i] = (half_t)(hv[i] * rstd * mw[i >> 2][i & 3] / (1.0f + fexp(-(float)a[5][i]))); }
            *(half8*)(yl + ro * D + k8) = o1; *(half8*)(yl + ro * D + 640 + k8) = o2; }
#pragma unroll
        for (int i = 0; i < 6; ++i) a[i] = an[i];
    }
#undef COMB_LOAD
    { const int ntile = nrows / 32, hbk = blockIdx.x * 2 + (F.tid >> 8), c = F.tid & 255;
      for (int tl = hbk; tl < ntile; tl += gridDim.x * 2) {
          const int row0 = tl * 32; const bool isl = row0 < TL; const int L = isl ? SEQ : CTXL; const int rc = isl ? row0 : row0 - TL; const int b = rc / L, t0 = rc % L;
          const float* src = (const float*)(F.ws + WS_YHT) + (isl ? 0 : (size_t)NB * 256 * SEQ) + ((size_t)b * 256 + c) * L + t0;
          f32x4 v[8];
#pragma unroll
          for (int q = 0; q < 8; ++q) v[q] = *(const f32x4*)(src + q * 4);
#pragma unroll
          for (int i = 0; i < 32; ++i) yl[(size_t)(row0 + i) * D + 384 + c] = (half_t)v[i >> 2][i & 3]; } }
}

struct EpiOutproj {
    static constexpr bool PERM = true;
    Frame F; int layer;
    __device__ __forceinline__ void operator()(const f32x4 (&acc)[2][2][4][2], const g8::Unit& u, int wr, int wc, int fr, int fq) const {
#pragma unroll
        for (int ai = 0; ai < 2; ++ai)
#pragma unroll
            for (int m = 0; m < 4; ++m) {
                const int srow = u.pm * 256 + ai * 128 + wr * 64 + m * 16 + fr;
                int row = srow;
                if (layer == 1 && srow < TL) { const int b = srow / SEQ, s = srow % SEQ; row = b * SEQ + (s % GROWS) * GW + s / GROWS; }
                const float* g1 = modp(F, layer, row_mod(row), 2);
                const float* xi = F.xrow_in(layer, row); float* xo = F.xrow(row);
#pragma unroll
                for (int bj = 0; bj < 2; ++bj) { const int c0 = u.pn * 256 + bj * 128 + wc * 32 + 8 * fq;
                    const f32x4 x0 = *(const f32x4*)(xi + c0), x1 = *(const f32x4*)(xi + c0 + 4), g0 = *(const f32x4*)(g1 + c0), g1v = *(const f32x4*)(g1 + c0 + 4);
                    *(f32x4*)(xo + c0) = x0 + g0 * acc[ai][bj][m][0]; *(f32x4*)(xo + c0 + 4) = x1 + g1v * acc[ai][bj][m][1]; }
            }
    }
};
__device__ __forceinline__ void outproj_ctx_tiles(const Frame& F, int layer) {
    const half_t* yl = (const half_t*)(F.ws + WS_XN) + (size_t)TL * D;
    const half_t* wt = (const half_t*)(F.ws + WS_WOUT) + (size_t)layer * D * D;
    const int lane = F.lane, wave = F.wave, r = lane & 15, kq = (lane >> 4) * 8;
    const int ntile = (TC / 64) * (D / 64);
    for (int t = blockIdx.x; t < ntile; t += gridDim.x) {
        const int m0 = (t / (D / 64)) * 64, n0 = (t % (D / 64)) * 64;
        const int mt = wave >> 1, nt0 = (wave & 1) * 2;
        const half_t* ap = yl + (size_t)(m0 + mt * 16 + r) * D + kq;
        const half_t* bp0 = wt + (size_t)(n0 + nt0 * 16 + r) * D + kq; const half_t* bp1 = bp0 + (size_t)16 * D;
        f32x4 c0 = {0.f, 0.f, 0.f, 0.f}, c1 = {0.f, 0.f, 0.f, 0.f};
#pragma unroll 1
        for (int kb = 0; kb < D; kb += 256) {
            half8 a[8], b0[8], b1[8];
#pragma unroll
            for (int q = 0; q < 8; ++q) { a[q] = *(const half8*)(ap + kb + q * 32); b0[q] = *(const half8*)(bp0 + kb + q * 32); b1[q] = *(const half8*)(bp1 + kb + q * 32); }
#pragma unroll
            for (int q = 0; q < 8; ++q) { c0 = mfma16(a[q], b0[q], c0); c1 = mfma16(a[q], b1[q], c1); }
        }
#pragma unroll
        for (int i = 0; i < 4; ++i) {
            const int row = TL + m0 + mt * 16 + (lane >> 4) * 4 + i;
            const float* g1 = modp(F, layer, NB, 2); const float* xi = F.xrow_in(layer, row); float* xo = F.xrow(row);
            const int ca = n0 + nt0 * 16 + r, cb = ca + 16;
            xo[ca] = xi[ca] + g1[ca] * c0[i]; xo[cb] = xi[cb] + g1[cb] * c1[i];
        }
    }
}
__device__ __forceinline__ void phase_outproj(const Frame& F, int layer) {
    if (layer == 0) outproj_ctx_tiles(F, layer);
    g8::DenseSched S; S.abase = (const char*)(F.ws + WS_XN); S.bbase = (const char*)((const half_t*)(F.ws + WS_WOUT) + (size_t)layer * D * D); S.K = D; S.nM = TL / 256; S.nN = D / 256; S.G = gridDim.x; S.c = blockIdx.x;
    EpiOutproj E{F, layer};
    g8::gemm_phase(F.smem, D, S, E);
}

constexpr int RLD = D + 8;
__device__ __forceinline__ void phase_router(const Frame& F, int layer, bool dry = false) {
    const int nrows = layer == 0 ? TT : TL, total = nrows / 16;
    half_t* Th = (half_t*)F.smem;
    half_t* Tl = Th + 16 * RLD;
    float* PART = (float*)(Tl + 16 * RLD);
    float* LG = PART + 8 * 16 * 48;
    half_t* tb = (half_t*)(F.ws + WS_XN);
    unsigned* cnt = (unsigned*)(F.ws + WS_CTL) + CW_CNT + layer * 64 * CSTR;
    int* list = (int*)(F.ws + WS_LIST); float* pw = (float*)(F.ws + WS_PW);
    const float* nw = F.in(I_N2W) + layer * D;
    const half_t* wr = (const half_t*)(F.ws + WS_WR) + (size_t)layer * 2 * 48 * D;
    const int lane = F.lane, wave = F.wave, r = lane & 15, kq = (lane >> 4) * 8, kb = wave * 128;
    half8 bh[3][4];
#pragma unroll
    for (int nt = 0; nt < 3; ++nt)
#pragma unroll
        for (int ks = 0; ks < 4; ++ks) { const size_t o = (size_t)(nt * 16 + r) * D + kb + ks * 32 + kq; bh[nt][ks] = *(const half8*)(wr + o); }
    int mc = -1; f32x4 g[4], s4[4];
    int it = blockIdx.x;
    f32x4 v[2][4];
    if (it < total) {
#pragma unroll
        for (int rr = 0; rr < 2; ++rr) { const float* x = F.xrow(it * 16 + wave * 2 + rr);
#pragma unroll
            for (int q = 0; q < 4; ++q) v[rr][q] = *(const f32x4*)(x + q * 256 + lane * 4); } }
    int p_row = -1, p_ea = 0, p_eb = 0; unsigned p_pa = 0, p_pb = 0; float p_w0 = 0.f, p_w1 = 0.f;
    for (; it < total; it += gridDim.x) {
        const int row0 = it * 16, nit = it + gridDim.x;
        f32x4 vn[2][4];
        if (nit < total) {
#pragma unroll
            for (int rr = 0; rr < 2; ++rr) { const float* x = F.xrow(nit * 16 + wave * 2 + rr);
#pragma unroll
                for (int q = 0; q < 4; ++q) vn[rr][q] = *(const f32x4*)(x + q * 256 + lane * 4); } }
        { const int m = row_mod(row0);
          if (m != mc) { mc = m; const float* sh = modp(F, layer, m, 3); const float* scl = modp(F, layer, m, 4);
#pragma unroll
              for (int q = 0; q < 4; ++q) { const int k = q * 256 + lane * 4; const f32x4 a = *(const f32x4*)(nw + k), b = *(const f32x4*)(scl + k); s4[q] = *(const f32x4*)(sh + k);
#pragma unroll
                  for (int e = 0; e < 4; ++e) g[q][e] = a[e] * (1.0f + b[e]); } } }
#pragma unroll
        for (int rr = 0; rr < 2; ++rr) {
            float ss = 0.f;
#pragma unroll
            for (int q = 0; q < 4; ++q) ss += v[rr][q][0] * v[rr][q][0] + v[rr][q][1] * v[rr][q][1] + v[rr][q][2] * v[rr][q][2] + v[rr][q][3] * v[rr][q][3];
            ss = wave_sum(ss);
            const float rs = 1.0f / sqrtf(ss * (1.0f / D) + EPSF);
            const int lr = wave * 2 + rr, row = row0 + lr;
#pragma unroll
            for (int q = 0; q < 4; ++q) { const int k = q * 256 + lane * 4; half4 h, l;
#pragma unroll
                for (int e = 0; e < 4; ++e) { const float tv = v[rr][q][e] * rs * g[q][e] + s4[q][e]; h[e] = (half_t)tv; l[e] = (half_t)((tv - (float)h[e]) * 2048.f); }
                *(half4*)(tb + (size_t)row * D + k) = h; *(half4*)(Th + lr * RLD + k) = h; *(half4*)(Tl + lr * RLD + k) = l; }
        }
        __syncthreads();
        { f32x4 ah[3], al[3]; half8 bl[3][4];
#pragma unroll
          for (int nt = 0; nt < 3; ++nt)
#pragma unroll
              for (int ks = 0; ks < 4; ++ks) bl[nt][ks] = *(const half8*)(wr + (size_t)48 * D + (size_t)(nt * 16 + r) * D + kb + ks * 32 + kq);
#pragma unroll
          for (int nt = 0; nt < 3; ++nt) { ah[nt] = (f32x4){0.f, 0.f, 0.f, 0.f}; al[nt] = (f32x4){0.f, 0.f, 0.f, 0.f}; }
#pragma unroll
          for (int ks = 0; ks < 4; ++ks) {
              const half8 a_h = *(const half8*)(Th + r * RLD + kb + ks * 32 + kq), a_l = *(const half8*)(Tl + r * RLD + kb + ks * 32 + kq);
#pragma unroll
              for (int nt = 0; nt < 3; ++nt) { ah[nt] = mfma16(a_h, bh[nt][ks], ah[nt]); al[nt] = mfma16(a_l, bh[nt][ks], al[nt]); al[nt] = mfma16(a_h, bl[nt][ks], al[nt]); }
          }
#pragma unroll
          for (int nt = 0; nt < 3; ++nt)
#pragma unroll
              for (int i = 0; i < 4; ++i) PART[(wave * 16 + (lane >> 4) * 4 + i) * 48 + nt * 16 + r] = ah[nt][i] + al[nt][i] * (1.0f / 2048.f); }
        __syncthreads();
        for (int o = F.tid; o < 16 * 48; o += NT) { const int col = o % 48; float sum = 0.f;
#pragma unroll
            for (int w = 0; w < 8; ++w) sum += PART[w * 16 * 48 + o];
            float bias = 0.f; if (col < 4) bias = F.in(I_GRB)[layer * 4 + col]; else if (col < 36) bias = F.in(I_ERB)[layer * 32 + col - 4];
            LG[o] = sum + bias; }
        __syncthreads();
        if (F.tid < 16) {
            if (p_row >= 0 && !dry) { list[(size_t)(p_ea * 2 + 0) * LCAP + p_pa] = p_row * 2 + 0; list[(size_t)(p_eb * 2 + 1) * LCAP + p_pb] = p_row * 2 + 1; pw[p_row * 2 + 0] = p_w0; pw[p_row * 2 + 1] = p_w1; }
            const int row = row0 + F.tid; const float* lg = LG + F.tid * 48;
            int gi = 0; float gm = lg[0];
            for (int q = 1; q < 4; ++q) if (lg[q] > gm) { gm = lg[q]; gi = q; }
            float gs = 0.f; for (int q = 0; q < 4; ++q) gs += expf(lg[q] - gm);
            const float grp_p = 1.0f / gs;
            const float* el = lg + 4 + gi * 8;
            int i0 = 0; float e0 = el[0];
            for (int q = 1; q < 8; ++q) if (el[q] > e0) { e0 = el[q]; i0 = q; }
            int i1 = -1; float e1 = -3.0e38f;
            for (int q = 0; q < 8; ++q) if (q != i0 && el[q] > e1) { e1 = el[q]; i1 = q; }
            const float p1 = expf(e1 - e0);
            p_w0 = grp_p * (1.0f / (1.0f + p1)); p_w1 = grp_p * (p1 / (1.0f + p1));
            p_ea = gi * 8 + i0; p_eb = gi * 8 + i1; p_row = row;
            if (!dry) { p_pa = atomicAdd(&cnt[(p_ea * 2 + 0) * CSTR], 1u); p_pb = atomicAdd(&cnt[(p_eb * 2 + 1) * CSTR], 1u); }
        }
#pragma unroll
        for (int rr = 0; rr < 2; ++rr)
#pragma unroll
            for (int q = 0; q < 4; ++q) v[rr][q] = vn[rr][q];
    }
    if (F.tid < 16 && p_row >= 0 && !dry) { list[(size_t)(p_ea * 2 + 0) * LCAP + p_pa] = p_row * 2 + 0; list[(size_t)(p_eb * 2 + 1) * LCAP + p_pb] = p_row * 2 + 1; pw[p_row * 2 + 0] = p_w0; pw[p_row * 2 + 1] = p_w1; }
    __syncthreads();
}

constexpr int MOE_PRE_OFF = g8::STAGE_BYTES;
struct MoeSchedA {
    const char* abase; const char* wbase; const int* pre; const unsigned* cnt; const int* list; int G, c;
    __device__ __forceinline__ int entry(const g8::Unit& u, int r) const { const int rc = r < u.n ? r : 0; return rc < u.c0 ? list[(size_t)(u.e * 2) * LCAP + rc] : list[(size_t)(u.e * 2 + 1) * LCAP + (rc - u.c0)]; }
    __device__ __forceinline__ bool next(int i, g8::Unit& u) const {
        const int L = i * G + c; if (L >= pre[32]) return false;
        int e = 0; while (L >= pre[e + 1]) ++e;
        const int loc = L - pre[e]; u.e = e; u.c0 = (int)cnt[(e * 2) * CSTR]; u.n = u.c0 + (int)cnt[(e * 2 + 1) * CSTR]; u.pm = loc >> 1; u.pn = loc & 1; return true;
    }
    __device__ __forceinline__ unsigned a_off(const g8::Unit& u, int r) const { return (unsigned)(entry(u, u.pm * 256 + r) >> 1) * (unsigned)(D * 2); }
    __device__ __forceinline__ const char* b_half(const g8::Unit& u, int h) const { return wbase + ((size_t)u.e * 3 * 262144 + (size_t)h * 262144 + (size_t)u.pn * 128 * D) * 2; }
};
struct EpiMoeA {
    static constexpr bool PERM = true;
    MoeSchedA S; const float* pw; half_t* hid;
    __device__ __forceinline__ void operator()(const f32x4 (&acc)[2][2][4][2], const g8::Unit& u, int wr, int wc, int fr, int fq) const {
        int pid[8]; float w[8];
#pragma unroll
        for (int g = 0; g < 8; ++g) pid[g] = S.entry(u, u.pm * 256 + (g >> 2) * 128 + wr * 64 + (g & 3) * 16 + fr);
#pragma unroll
        for (int g = 0; g < 8; ++g) w[g] = pw[pid[g]];
        const int f = u.pn * 128 + wc * 32 + 8 * fq;
#pragma unroll
        for (int ai = 0; ai < 2; ++ai)
#pragma unroll
            for (int m = 0; m < 4; ++m) {
                const int rr = u.pm * 256 + ai * 128 + wr * 64 + m * 16 + fr;
                if (rr < u.n) { half8 h;
#pragma unroll
                    for (int n = 0; n < 2; ++n) { const f32x4 g = acc[ai][0][m][n], up = acc[ai][1][m][n];
#pragma unroll
                        for (int i = 0; i < 4; ++i) h[n * 4 + i] = (half_t)(fsilu(g[i]) * up[i] * w[ai * 4 + m]); }
                    *(half8*)(hid + (size_t)pid[ai * 4 + m] * 256 + f) = h; }
            }
    }
};
__device__ __forceinline__ void phase_moe_a(const Frame& F, int layer) {
    int* pre = (int*)(F.smem + MOE_PRE_OFF);
    const unsigned* cnt = (const unsigned*)(F.ws + WS_CTL) + CW_CNT + layer * 64 * CSTR;
    if (F.tid == 0) { int s = 0; for (int e = 0; e < 32; ++e) { pre[e] = s; s += (((int)(cnt[(e * 2) * CSTR] + cnt[(e * 2 + 1) * CSTR]) + 255) / 256) * 2; } pre[32] = s; }
    __syncthreads();
    MoeSchedA S; S.abase = (const char*)(F.ws + WS_XN); S.wbase = (const char*)(F.ws + WS_WMOE); S.pre = pre; S.cnt = cnt; S.list = (const int*)(F.ws + WS_LIST); S.G = gridDim.x; S.c = blockIdx.x;
    EpiMoeA E{S, (const float*)(F.ws + WS_PW), (half_t*)(F.ws + WS_U16)};
    g8::gemm_phase(F.smem, D, S, E);
    __syncthreads();
}
struct MoeSchedB {
    const char* abase; const char* wbase; const int* pre; const unsigned* cnt; const int* list; int G, c;
    __device__ __forceinline__ bool next(int i, g8::Unit& u) const {
        const int L = i * G + c; if (L >= pre[64]) return false;
        int l = 0; while (L >= pre[l + 1]) ++l;
        const int loc = L - pre[l]; u.e = l >> 1; u.c0 = l & 1; u.n = (int)cnt[(l) * CSTR]; u.pm = loc >> 2; u.pn = loc & 3; return true;
    }
    __device__ __forceinline__ int entry(const g8::Unit& u, int rr) const { return list[(size_t)(u.e * 2 + u.c0) * LCAP + (rr < u.n ? rr : 0)]; }
    __device__ __forceinline__ unsigned a_off(const g8::Unit& u, int r) const { return (unsigned)entry(u, u.pm * 256 + r) * 512u; }
    __device__ __forceinline__ const char* b_half(const g8::Unit& u, int h) const { return wbase + ((size_t)u.e * 3 * 262144 + 2 * 262144 + (size_t)(u.pn * 256 + h * 128) * 256) * 2; }
};
struct EpiMoeB {
    static constexpr bool PERM = true;
    MoeSchedB S; Frame F; int layer;
    __device__ __forceinline__ void operator()(const f32x4 (&acc)[2][2][4][2], const g8::Unit& u, int wr, int wc, int fr, int fq) const {
        int row[8];
#pragma unroll
        for (int g = 0; g < 8; ++g) row[g] = S.entry(u, u.pm * 256 + (g >> 2) * 128 + wr * 64 + (g & 3) * 16 + fr) >> 1;
        half_t* xab = (half_t*)(F.ws + WS_U16 + XAB_OFF) + (size_t)u.c0 * TT * D;
#pragma unroll
        for (int ai = 0; ai < 2; ++ai)
#pragma unroll
            for (int m = 0; m < 4; ++m) {
                const int rr = u.pm * 256 + ai * 128 + wr * 64 + m * 16 + fr;
                if (rr < u.n) { const int rw = row[ai * 4 + m]; half_t* xo = xab + (size_t)rw * D; const float* g5 = modp(F, layer, row_mod(rw), 5);
#pragma unroll
                    for (int bj = 0; bj < 2; ++bj) { const int d = u.pn * 256 + bj * 128 + wc * 32 + 8 * fq;
                        const f32x4 g0 = *(const f32x4*)(g5 + d), g1 = *(const f32x4*)(g5 + d + 4); const f32x4 a0 = g0 * acc[ai][bj][m][0], a1 = g1 * acc[ai][bj][m][1];
                        half8 h; h[0] = (half_t)a0[0]; h[1] = (half_t)a0[1]; h[2] = (half_t)a0[2]; h[3] = (half_t)a0[3]; h[4] = (half_t)a1[0]; h[5] = (half_t)a1[1]; h[6] = (half_t)a1[2]; h[7] = (half_t)a1[3];
                        *(half8*)(xo + d) = h; } }
            }
    }
};
__device__ __forceinline__ void phase_moe_b(const Frame& F, int layer) {
    int* pre = (int*)(F.smem + MOE_PRE_OFF);
    const unsigned* cnt = (const unsigned*)(F.ws + WS_CTL) + CW_CNT + layer * 64 * CSTR;
    if (F.tid == 0) { int s = 0; for (int l = 0; l < 64; ++l) { pre[l] = s; s += (((int)cnt[(l) * CSTR] + 255) / 256) * 4; } pre[64] = s; }
    __syncthreads();
    MoeSchedB S; S.abase = (const char*)(F.ws + WS_U16); S.wbase = (const char*)(F.ws + WS_WMOE); S.pre = pre; S.cnt = cnt; S.list = (const int*)(F.ws + WS_LIST); S.G = gridDim.x; S.c = blockIdx.x;
    EpiMoeB E{S, F, layer};
    g8::gemm_phase(F.smem, 256, S, E);
    __syncthreads();
}

__device__ __forceinline__ void phase_final(const Frame& F) {
    const float* fw = F.in(I_FNW);
    const int lane = F.lane, nwaves = gridDim.x * (NT / 64);
    f32x4 w4[4];
#pragma unroll
    for (int q = 0; q < 4; ++q) w4[q] = *(const f32x4*)(fw + q * 256 + lane * 4);
    int row = blockIdx.x * (NT / 64) + F.wave;
    f32x4 v[4];
    if (row < TL) {
#pragma unroll
        for (int q = 0; q < 4; ++q) v[q] = *(const f32x4*)(F.P->out + (size_t)row * D + q * 256 + lane * 4); }
    for (; row < TL; row += nwaves) {
        const int nrow = row + nwaves;
        f32x4 vn[4];
        if (nrow < TL) {
#pragma unroll
            for (int q = 0; q < 4; ++q) vn[q] = *(const f32x4*)(F.P->out + (size_t)nrow * D + q * 256 + lane * 4); }
        { const half_t* xa = (const half_t*)(F.ws + WS_U16 + XAB_OFF) + (size_t)row * D; const half_t* xb = xa + (size_t)TT * D;
#pragma unroll
          for (int q = 0; q < 4; ++q) { const int k = q * 256 + lane * 4; const half4 a4 = *(const half4*)(xa + k), b4 = *(const half4*)(xb + k);
#pragma unroll
              for (int e = 0; e < 4; ++e) v[q][e] += (float)a4[e] + (float)b4[e]; } }
        float ss = 0.f;
#pragma unroll
        for (int q = 0; q < 4; ++q) ss += v[q][0] * v[q][0] + v[q][1] * v[q][1] + v[q][2] * v[q][2] + v[q][3] * v[q][3];
        ss = wave_sum(ss);
        const float rs = 1.0f / sqrtf(ss * (1.0f / D) + EPSF);
#pragma unroll
        for (int q = 0; q < 4; ++q) *(f32x4*)(F.P->out + (size_t)row * D + q * 256 + lane * 4) = v[q] * rs * w4[q];
#pragma unroll
        for (int q = 0; q < 4; ++q) v[q] = vn[q];
    }
}

constexpr int NPHASE = 1 + 2 * 9 + 1;
#ifndef ONLY
#define ONLY -1
#endif
#define EN(x) (ONLY < 0 || ONLY == (x))
__device__ __forceinline__ void run_phase(const Frame& F, int ph) {
    if (ph == 0) { if (EN(0)) phase_setup(F); return; }
    if (ph == NPHASE - 1) { if (EN(11)) phase_final(F); return; }
    const int layer = (ph - 1) / 9, k = (ph - 1) % 9;
    switch (k) {
        case 0: if (EN(1)) phase_norm1(F, layer); break;
        case 1: if (EN(2)) phase_inproj(F, layer); break;
        case 2: if (EN(10)) phase_act(F, layer); break;
        case 3: if (EN(3)) phase_mixers(F, layer); break;
        case 4: if (EN(4)) phase_combine(F, layer); break;
        case 5: if (EN(5)) phase_outproj(F, layer); break;
        case 6: if (EN(6)) phase_router(F, layer); break;
        case 7: if (EN(7)) phase_moe_a(F, layer); break;
        default: if (EN(8)) phase_moe_b(F, layer); break;
    }
}

#ifdef EMU
void mega(const Params* Pp) {
    Frame F; F.P = Pp; F.ws = Pp->ws; F.smem = emu_blk->smem; F.tid = threadIdx.x; F.lane = F.tid & 63; F.wave = F.tid >> 6;
    for (int ph = Pp->ph_lo; ph < Pp->ph_hi; ++ph) { run_phase(F, ph); __syncthreads(); }
}
#else
__global__ void __launch_bounds__(NT) mega(Params P) {
    extern __shared__ __attribute__((aligned(16))) unsigned char smem_dyn[];
    cg::grid_group grid = cg::this_grid();
    Frame F; F.P = (ParamsPtr)__builtin_amdgcn_kernarg_segment_ptr(); F.ws = P.ws; F.smem = smem_dyn; F.tid = threadIdx.x; F.lane = F.tid & 63; F.wave = F.tid >> 6;
    volatile LAS unsigned* bst = (volatile LAS unsigned*)(smem_dyn + LDS_BYTES - 16);
    if (F.tid < 4) bst[F.tid] = 0u;
    __syncthreads();
    XcdBarrier xb = xcd_barrier_post((unsigned*)(P.ws + WS_CTL) + CW_BAR, bst);
    if (P.ph_lo < 0) grid.sync();
#define DUP -1
#define AMP -1
#define PHASE_STEP(i) if (P.ph_lo <= (i) && (i) < P.ph_hi) { \
        unsigned long long t0_ = 0; if (AMP == (i)) t0_ = __builtin_amdgcn_s_memrealtime(); \
        run_phase(F, (i)); \
        if ((i) + 1 < P.ph_hi || AMP == (i)) xcd_barrier(xb); \
        if (AMP == (i)) { const unsigned long long t1_ = __builtin_amdgcn_s_memrealtime(); if (blockIdx.x == 0) { while (__builtin_amdgcn_s_memrealtime() - t1_ < t1_ - t0_) __builtin_amdgcn_s_sleep(8); } xcd_barrier(xb); } }
    PHASE_STEP(0) PHASE_STEP(1) PHASE_STEP(2) PHASE_STEP(3) PHASE_STEP(4) PHASE_STEP(5) PHASE_STEP(6) PHASE_STEP(7) PHASE_STEP(8) PHASE_STEP(9)
    PHASE_STEP(10) PHASE_STEP(11) PHASE_STEP(12) PHASE_STEP(13) PHASE_STEP(14) PHASE_STEP(15) PHASE_STEP(16) PHASE_STEP(17) PHASE_STEP(18) PHASE_STEP(19)
    static_assert(NPHASE == 20, "phase list");
}

extern "C" void kernel_launch(void* const* d_in, const int* in_sizes, int n_in, void* d_out, int out_size, void* d_ws, size_t ws_size, hipStream_t stream) {
    static int grid_blocks = 0;
    if (grid_blocks == 0) {
        if (n_in != 38 || out_size != TL * D || ws_size < WS_END) { fprintf(stderr, "kernel_launch: unexpected shapes (n_in %d out %d ws %zu need %zu)\n", n_in, out_size, ws_size, (size_t)WS_END); grid_blocks = -1; return; }
        int dev = 0, cus = 0, per_cu = 0;
        hipGetDevice(&dev);
        hipDeviceGetAttribute(&cus, hipDeviceAttributeMultiprocessorCount, dev);
        hipFuncSetAttribute((const void*)mega, hipFuncAttributeMaxDynamicSharedMemorySize, LDS_BYTES);
        hipOccupancyMaxActiveBlocksPerMultiprocessor(&per_cu, (const void*)mega, NT, LDS_BYTES);
        if (per_cu < 1) { fprintf(stderr, "kernel_launch: occupancy query says 0 blocks per CU\n"); grid_blocks = -1; return; }
        grid_blocks = cus;
    }
    if (grid_blocks < 0) return;
    if (hipMemsetAsync((char*)d_ws + WS_CTL, 0, CTL_BYTES, stream) != hipSuccess) { fprintf(stderr, "kernel_launch: memset failed\n"); return; }
    Params p{};
    for (int i = 0; i < 38; ++i) p.in[i] = (const float*)d_in[i];
    p.out = (float*)d_out; p.ws = (unsigned char*)d_ws; p.ph_lo = 0; p.ph_hi = NPHASE;
    void* args[] = {&p};
    hipError_t e = hipLaunchCooperativeKernel((const void*)mega, dim3(grid_blocks), dim3(NT), args, LDS_BYTES, stream);
    if (e != hipSuccess) fprintf(stderr, "cooperative launch failed: %s (grid %d)\n", hipGetErrorString(e), grid_blocks);
}
#endif
```

```cpp
#ifdef EMU
#include "gpuemu.h"
#else
#include <hip/hip_runtime.h>
#include <hip/hip_cooperative_groups.h>
#include <cstdio>
namespace cg = cooperative_groups;
#endif
#include <stdint.h>

#ifndef CFG_B
#define CFG_B 4
#endif
#ifndef CFG_SEQ
#define CFG_SEQ 4096
#endif
#ifndef CFG_CTX
#define CFG_CTX 256
#endif

typedef _Float16 half_t;
typedef _Float16 half8 __attribute__((ext_vector_type(8)));
typedef _Float16 half4 __attribute__((ext_vector_type(4)));
typedef float f32x4 __attribute__((ext_vector_type(4)));
struct cplx { float x, y; };

constexpr int D = 1024, NB = CFG_B, SEQ = CFG_SEQ, CTXL = CFG_CTX, GW = 64, GROWS = SEQ / GW;
constexpr int TL = NB * SEQ, TC = NB * CTXL, TT = TL + TC;
constexpr int NIN = 3364, NINP = 3584;
constexpr int UW = 2560;
constexpr int UGW = 36;
constexpr int NT = 512;
constexpr int TWN = 2 * SEQ > 2 * CTXL ? 2 * SEQ : 2 * CTXL;
constexpr int NMOD = 6 * D;
constexpr int LCAP = TT;
constexpr float EPSF = 1e-6f;

constexpr size_t al256(size_t x) { return (x + 255) / 256 * 256; }
constexpr size_t WS_CTL    = 0;
constexpr size_t WS_MOD    = 65536;
constexpr size_t WS_TW     = WS_MOD + al256(sizeof(float) * 2 * 5 * NMOD);
constexpr size_t WS_WIN    = WS_TW + al256(sizeof(cplx) * TWN);
constexpr size_t WS_WOUT   = WS_WIN + al256(2ull * 2 * NINP * D);
constexpr size_t WS_WMOE   = WS_WOUT + al256(2ull * 2 * D * D);
constexpr size_t WS_XC     = WS_WMOE + al256(2ull * 32 * 3 * 262144);
constexpr size_t WS_XN     = WS_XC + al256(4ull * TC * D);
constexpr size_t WS_U16    = WS_XN + al256(2ull * TT * D);
constexpr size_t WS_UG     = WS_U16 + al256(2ull * TT * UW);
constexpr size_t WS_HYT    = WS_UG + al256(4ull * TT * UGW);
constexpr size_t WS_YF     = WS_HYT + al256(2ull * NB * 768 * (SEQ + CTXL));
constexpr size_t WS_YHT    = WS_YF + al256(2ull * 4 * TT * 384);
constexpr size_t WS_FT     = WS_YHT + al256(4ull * NB * 256 * (SEQ + CTXL));
constexpr size_t WS_LIST   = WS_FT + al256(4ull * (2 * 256 * 4 * SEQ + 256 * 4 * CTXL));
constexpr size_t WS_PW     = WS_LIST + al256(4ull * 64 * LCAP);
constexpr size_t WS_WR     = WS_PW + al256(4ull * TT * 2);
constexpr size_t WS_HALO   = WS_WR + al256(2ull * 2 * 2 * 48 * D);
constexpr size_t WS_END    = WS_HALO + al256(2ull * (TT / 16) * 2 * 1408);
static_assert(4ull * NB * 256 * (SEQ + CTXL) <= 2ull * TT * D, "Z1 scratch must fit in the XN region");
static_assert(2ull * TT * 2 * 256 <= 2ull * TT * UW, "HID must fit in the U16 region");
constexpr size_t XAB_OFF = 2ull * TT * 2 * 256;
static_assert(XAB_OFF + 2ull * 2 * TT * D <= 2ull * TT * UW, "HID + XA + XB must fit in the U16 region");

constexpr int CW_CNT = 8192;
constexpr int CSTR = 64;
constexpr int CW_QUE = 256;
constexpr int CW_BAR = 1024;
constexpr size_t CTL_BYTES = 65536;

constexpr int LDS_BYTES = 156 * 1024;

struct Params {
    const float* in[38];
    float* out;
    unsigned char* ws;
    int ph_lo, ph_hi;
};

enum { I_X = 0, I_C, I_CTX, I_CCTX, I_WMOD, I_BMOD, I_N1W, I_N2W, I_WIN, I_WOUT, I_SCW, I_SCB, I_DTB, I_ALOG, I_SD, I_SNW,
       I_HCW, I_HCB, I_HW1, I_HB1, I_HW2, I_HB2, I_HW3, I_HFREQ, I_HDEC, I_HSKIP, I_MCW, I_MCB, I_MGB, I_MNW,
       I_GRW, I_GRB, I_ERW, I_ERB, I_MG, I_MU, I_MD, I_FNW };

__device__ __forceinline__ float siluf(float x) { return x / (1.0f + expf(-x)); }
__device__ __forceinline__ float sigmoidf_(float x) { return 1.0f / (1.0f + expf(-x)); }
__device__ __forceinline__ float softplusf_(float x) { return x > 20.f ? x : log1pf(expf(x)); }
__device__ __forceinline__ float logsigmoidf_(float x) { return fminf(x, 0.f) - log1pf(expf(-fabsf(x))); }

__device__ __forceinline__ float fsoftplus(float x) {
#ifdef EMU
    return x > 20.f ? x : log1pf(expf(x));
#else
    const float e = __expf(x);
    return x > 20.f ? x : (e < 1e-3f ? e * (1.0f - 0.5f * e) : __logf(1.0f + e));
#endif
}
__device__ __forceinline__ float flogsigmoid(float x) { return fminf(x, 0.f) - fsoftplus(-fabsf(x)); }
__device__ __forceinline__ float fexp(float x) {
#ifdef EMU
    return expf(x);
#else
    return __expf(x);
#endif
}
__device__ __forceinline__ float fsilu(float x) {
#ifdef EMU
    return x / (1.0f + expf(-x));
#else
    return __fdividef(x, 1.0f + __expf(-x));
#endif
}
__device__ __forceinline__ float wave_sum(float v) {
#pragma unroll
    for (int m = 32; m >= 1; m >>= 1) v += __shfl_xor(v, m);
    return v;
}
__device__ __forceinline__ float wave_max(float v) {
#pragma unroll
    for (int m = 32; m >= 1; m >>= 1) v = fmaxf(v, __shfl_xor(v, m));
    return v;
}
#ifndef EMU
#define DPP_F(oldv, v, ctrl, rmask) __builtin_bit_cast(float, __builtin_amdgcn_update_dpp(__builtin_bit_cast(int, (float)(oldv)), __builtin_bit_cast(int, (float)(v)), (ctrl), (rmask), 0xF, false))
#endif
__device__ __forceinline__ float wave_scan_sum(float v, int lane) {
#ifdef EMU
    for (int d = 1; d < 64; d <<= 1) { float o = __shfl_up(v, d); if (lane >= d) v += o; }
    return v;
#else
    v += DPP_F(0.f, v, 0x111, 0xF);
    v += DPP_F(0.f, v, 0x112, 0xF);
    v += DPP_F(0.f, v, 0x114, 0xF);
    v += DPP_F(0.f, v, 0x118, 0xF);
    v += DPP_F(0.f, v, 0x142, 0xA);
    v += DPP_F(0.f, v, 0x143, 0xC);
    return v;
#endif
}
__device__ __forceinline__ float wave_last(float v) {
#ifdef EMU
    return __shfl(v, 63);
#else
    return __builtin_bit_cast(float, __builtin_amdgcn_readlane(__builtin_bit_cast(int, v), 63));
#endif
}
__device__ __forceinline__ float wave_shr1(float v, float fill, int lane) {
#ifdef EMU
    float o = __shfl_up(v, 1); return lane == 0 ? fill : o;
#else
    return DPP_F(fill, v, 0x138, 0xF);
#endif
}
__device__ __forceinline__ float wave_scan_max(float v, int lane) {
#ifdef EMU
    for (int d = 1; d < 64; d <<= 1) { float o = __shfl_up(v, d); if (lane >= d) v = fmaxf(v, o); }
    return v;
#else
    const float NI = -3.0e38f;
    v = fmaxf(v, DPP_F(NI, v, 0x111, 0xF));
    v = fmaxf(v, DPP_F(NI, v, 0x112, 0xF));
    v = fmaxf(v, DPP_F(NI, v, 0x114, 0xF));
    v = fmaxf(v, DPP_F(NI, v, 0x118, 0xF));
    v = fmaxf(v, DPP_F(NI, v, 0x142, 0xA));
    v = fmaxf(v, DPP_F(NI, v, 0x143, 0xC));
    return v;
#endif
}

template <int MT, int NTL>
__device__ __forceinline__ void mma_lds(f32x4 (&acc)[MT][NTL], const half_t* A, int lda, const half_t* B, int ldb, int ksteps, int lane) {
#ifndef EMU
    const int r = lane & 15, kq = (lane >> 4) * 8;
    for (int ks = 0; ks < ksteps; ++ks) {
        half8 a[MT], b[NTL];
#pragma unroll
        for (int mt = 0; mt < MT; ++mt) a[mt] = *(const half8*)(A + (mt * 16 + r) * lda + ks * 32 + kq);
#pragma unroll
        for (int nt = 0; nt < NTL; ++nt) b[nt] = *(const half8*)(B + (nt * 16 + r) * ldb + ks * 32 + kq);
#pragma unroll
        for (int mt = 0; mt < MT; ++mt)
#pragma unroll
            for (int nt = 0; nt < NTL; ++nt) acc[mt][nt] = __builtin_amdgcn_mfma_f32_16x16x32_f16(a[mt], b[nt], acc[mt][nt], 0, 0, 0);
    }
#else
    for (int mt = 0; mt < MT; ++mt) for (int nt = 0; nt < NTL; ++nt) for (int i = 0; i < 4; ++i) {
        const int row = mt * 16 + (lane >> 4) * 4 + i, col = nt * 16 + (lane & 15);
        float s = acc[mt][nt][i];
        for (int k = 0; k < ksteps * 32; ++k) s += (float)A[row * lda + k] * (float)B[col * ldb + k];
        acc[mt][nt][i] = s;
    }
#endif
}

__device__ __forceinline__ f32x4 mfma16(half8 a, half8 b, f32x4 c) {
#ifdef EMU
    return emu_mfma16(a, b, c);
#else
    return __builtin_amdgcn_mfma_f32_16x16x32_f16(a, b, c, 0, 0, 0);
#endif
}
template <int MT, int NTL> __device__ __forceinline__ void zero_acc(f32x4 (&acc)[MT][NTL]) {
#pragma unroll
    for (int mt = 0; mt < MT; ++mt)
#pragma unroll
        for (int nt = 0; nt < NTL; ++nt) acc[mt][nt] = (f32x4){0.f, 0.f, 0.f, 0.f};
}

__device__ __forceinline__ void load_taps4(const float* cw, const float* cb, int C, int ch, int dir, f32x4& w0, f32x4& w1, f32x4& w2, f32x4& wb) {
    w0 = *(const f32x4*)(cw + (dir ? 2 : 0) * C + ch); w1 = *(const f32x4*)(cw + C + ch); w2 = *(const f32x4*)(cw + (dir ? 0 : 2) * C + ch); wb = *(const f32x4*)(cb + ch);
}
#ifdef EMU
#define LOADER_FENCE()
#else
#define LOADER_FENCE() asm volatile("" ::: "memory")
#endif
#define CONV4(k, i) (w0[i] * (float)rr[k][hh * 4 + i] + w1[i] * (float)rr[(k) + 1][hh * 4 + i] + w2[i] * (float)rr[(k) + 2][hh * 4 + i] + wb[i])
__device__ __forceinline__ half4 to_half4(const f32x4 v) { half4 h; h[0] = (half_t)v[0]; h[1] = (half_t)v[1]; h[2] = (half_t)v[2]; h[3] = (half_t)v[3]; return h; }
namespace g8 {
constexpr int BM = 256, BK = 64, HALF = 128, HTB = HALF * BK * 2, STAGE_BYTES = 8 * HTB;
__device__ __forceinline__ int lds_byte(int r, int c) { const int st = (r >> 4) * 2 + (c >> 5), rr = r & 15, cc = c & 31, ob = rr * 64 + cc * 2; return st * 1024 + (ob ^ (((ob >> 9) & 1) << 5)); }
__device__ __forceinline__ int perm32(int rho) { const int n = rho >> 4, i = rho & 15; return 8 * (i >> 2) + 4 * n + (i & 3); }
__device__ __forceinline__ void stage_rc(int b, int& R, int& C) { const int st = b / 1024, sb = b % 1024, swz = sb ^ (((sb >> 9) & 1) << 5); R = (st >> 1) * 16 + swz / 64; C = (st & 1) * 32 + (swz % 64) / 2; }
struct Unit { int pm, pn, e, n, c0; };

struct DenseSched {
    const char* abase; const char* bbase; int K, nM, nN, G, c;
    __device__ __forceinline__ bool next(int i, Unit& u) const {
        const int nwg = nM * nN; const long L = (long)i * G + c; if (L >= nwg) return false;
        int wgid = (int)L; { const int q = nwg / 8, r = nwg % 8, xcd = wgid % 8, off = wgid / 8; wgid = (xcd < r ? xcd * (q + 1) : r * (q + 1) + (xcd - r) * q) + off; }
        const int nig = 8 * nN, gid = wgid / nig, fm = gid * 8, gsz = (nM - fm) < 8 ? (nM - fm) : 8;
        u.pm = fm + ((wgid % nig) % gsz); u.pn = (wgid % nig) / gsz; u.e = 0; u.n = 0; u.c0 = 0; return true;
    }
    __device__ __forceinline__ unsigned a_off(const Unit& u, int r) const { return (unsigned)((size_t)(u.pm * 256 + r) * K * 2); }
    __device__ __forceinline__ const char* b_half(const Unit& u, int h) const { return bbase + (size_t)(u.pn * 256 + h * 128) * K * 2; }
};

template <class Epi, class Sched>
__device__ __forceinline__ void gemm_phase(unsigned char* smem, const int K, const Sched& S, const Epi& E) {
    const int tid = threadIdx.x, lane = tid & 63;
#ifdef EMU
    const int wid = tid >> 6, wr = wid >> 2, wc = wid & 3, fr = lane & 15, fq = lane >> 4;
    half_t* As = (half_t*)smem; half_t* Bs = As + 256 * 72;
    Unit cur;
    for (int ui = 0; S.next(ui, cur); ++ui) {
        f32x4 acc[2][2][4][2];
        for (int a = 0; a < 2; ++a) for (int b = 0; b < 2; ++b) for (int m = 0; m < 4; ++m) for (int n = 0; n < 2; ++n) acc[a][b][m][n] = (f32x4){0.f, 0.f, 0.f, 0.f};
        for (int kt = 0; kt < K / 64; ++kt) {
            { const int row = tid >> 1, c0 = (tid & 1) * 32;
              const half_t* sa = (const half_t*)(S.abase + S.a_off(cur, row)) + kt * 64 + c0;
              const half_t* sb = (const half_t*)(S.b_half(cur, row >> 7)) + (size_t)(row & 127) * K + kt * 64 + c0;
              for (int q = 0; q < 32; ++q) { As[row * 72 + c0 + q] = sa[q]; Bs[row * 72 + c0 + q] = sb[q]; } }
            __syncthreads();
            for (int a = 0; a < 2; ++a) for (int b = 0; b < 2; ++b) for (int m = 0; m < 4; ++m) for (int n = 0; n < 2; ++n) for (int i = 0; i < 4; ++i) {
                const int row = 128 * a + 64 * wr + 16 * m + fr, col = 128 * b + 32 * wc + (Epi::PERM ? 8 * fq + 4 * n + i : 16 * n + 4 * fq + i); float s = acc[a][b][m][n][i];
                for (int k = 0; k < 64; ++k) s += (float)As[row * 72 + k] * (float)Bs[col * 72 + k];
                acc[a][b][m][n][i] = s; }
            __syncthreads();
        }
        E(acc, cur, wr, wc, fr, fq);
    }
#else
    typedef __attribute__((address_space(3))) unsigned char* ldsp_t;
    const ldsp_t lds = (ldsp_t)smem;
    const int wid = __builtin_amdgcn_readfirstlane(tid >> 6), wr = wid >> 2, wc = wid & 3, fr = lane & 15, fq = lane >> 4;
    const int nt = K / BK;
    int Rr[2], Cc[2]; unsigned voffB[2];
#pragma unroll
    for (int i = 0; i < 2; ++i) { stage_rc(tid * 16 + i * 8192, Rr[i], Cc[i]); const int Rb = Epi::PERM ? ((Rr[i] & ~31) + perm32(Rr[i] & 31)) : Rr[i]; voffB[i] = (unsigned)(Rb * K + Cc[i]) * 2u; }
    const size_t kstep = (size_t)(BK * 2);
    const unsigned ldsw = (unsigned)wid * 1024u;
    const int aoffl = lds_byte(wr * 64 + fr, fq * 8), boffl = lds_byte(wc * 32 + fr, fq * 8);
#define G8_SA(b, h) (((b) * 2 + (h)) * HTB)
#define G8_SB(b, h) ((4 + (b) * 2 + (h)) * HTB)
#define G8_STAGE(bufoff, gbase, voff) do { _Pragma("unroll") for (int _i = 0; _i < 2; ++_i) \
        __builtin_amdgcn_global_load_lds((const unsigned*)((const char*)(gbase) + (voff)[_i]), (__attribute__((address_space(3))) unsigned*)(lds + (bufoff) + ldsw + _i * 8192), 16, 0, 0); } while (0)
#define G8_LDA(dst, b, h) do { _Pragma("unroll") for (int m = 0; m < 4; ++m) _Pragma("unroll") for (int k = 0; k < 2; ++k) dst[m][k] = *(const __attribute__((address_space(3))) half8*)(lds + G8_SA(b, h) + aoffl + m * 2048 + k * 1024); } while (0)
#define G8_LDB(dst, b, h) do { _Pragma("unroll") for (int n = 0; n < 2; ++n) _Pragma("unroll") for (int k = 0; k < 2; ++k) dst[n][k] = *(const __attribute__((address_space(3))) half8*)(lds + G8_SB(b, h) + boffl + n * 2048 + k * 1024); } while (0)
#define G8_MMA(ai, bj, At, Bt) do { __builtin_amdgcn_s_setprio(1); _Pragma("unroll") for (int m = 0; m < 4; ++m) _Pragma("unroll") for (int n = 0; n < 2; ++n) _Pragma("unroll") for (int k = 0; k < 2; ++k) \
        acc[ai][bj][m][n] = __builtin_amdgcn_mfma_f32_16x16x32_f16(Bt[n][k], At[m][k], acc[ai][bj][m][n], 0, 0, 0); __builtin_amdgcn_s_setprio(0); } while (0)
#define G8_WAIT_V(n) asm volatile("s_waitcnt vmcnt(" #n ")" ::: "memory")
#define G8_WAIT_L(n) asm volatile("s_waitcnt lgkmcnt(" #n ")" ::: "memory")
#define G8_BAR __builtin_amdgcn_s_barrier()
#define G8_SCHED __builtin_amdgcn_sched_barrier(0)
#define G8_AOFF(dst, u) do { _Pragma("unroll") for (int _h = 0; _h < 2; ++_h) _Pragma("unroll") for (int _i = 0; _i < 2; ++_i) dst[_h][_i] = S.a_off(u, _h * 128 + Rr[_i]) + (unsigned)Cc[_i] * 2u; } while (0)
    Unit cur, nxt; int ui = 0;
    if (!S.next(0, cur)) return;
    f32x4 acc[2][2][4][2];
#pragma unroll
    for (int a = 0; a < 2; ++a)
#pragma unroll
        for (int b = 0; b < 2; ++b)
#pragma unroll
            for (int m = 0; m < 4; ++m)
#pragma unroll
                for (int n = 0; n < 2; ++n) acc[a][b][m][n] = (f32x4){0.f, 0.f, 0.f, 0.f};
    half8 At[4][2], B0[2][2], B1[2][2];
    unsigned caoff[2][2], naoff[2][2];
    G8_AOFF(caoff, cur);
    const char* cA = S.abase; const char* cB0 = S.b_half(cur, 0); const char* cB1 = S.b_half(cur, 1);
    G8_STAGE(G8_SB(0, 0), cB0, voffB); G8_STAGE(G8_SA(0, 0), cA, caoff[0]); G8_STAGE(G8_SB(0, 1), cB1, voffB); G8_STAGE(G8_SA(0, 1), cA, caoff[1]);
    if (wr == 1) G8_BAR;
    G8_WAIT_V(4); G8_BAR;
    G8_STAGE(G8_SB(1, 0), cB0 + kstep, voffB); G8_STAGE(G8_SA(1, 0), cA + kstep, caoff[0]); G8_STAGE(G8_SB(1, 1), cB1 + kstep, voffB);
    G8_WAIT_V(6); G8_BAR;
    for (;;) {
        const bool has_next = S.next(ui + 1, nxt);
        if (!has_next) nxt = cur;
        G8_AOFF(naoff, nxt);
        const char* nB0 = S.b_half(nxt, 0); const char* nB1 = S.b_half(nxt, 1);
#pragma unroll 1
        for (int t = 0; t < nt; t += 2) {
            const bool last = (t == nt - 2);
            const char* a1 = cA + (size_t)(t + 1) * kstep;
            const char* a2 = last ? cA : cA + (size_t)(t + 2) * kstep;
            const char* b20 = last ? nB0 : cB0 + (size_t)(t + 2) * kstep; const char* b21 = last ? nB1 : cB1 + (size_t)(t + 2) * kstep;
            const char* a3 = a2 + kstep; const char* b30 = b20 + kstep; const char* b31 = b21 + kstep;
            unsigned xoff[2][2];
#pragma unroll
            for (int h = 0; h < 2; ++h)
#pragma unroll
                for (int i = 0; i < 2; ++i) xoff[h][i] = last ? naoff[h][i] : caoff[h][i];
            G8_LDB(B0, 0, 0); G8_SCHED; G8_LDA(At, 0, 0); G8_STAGE(G8_SA(1, 1), a1, caoff[1]);
            G8_WAIT_L(8); G8_BAR; G8_WAIT_L(0); G8_MMA(0, 0, At, B0); G8_BAR; G8_SCHED;
            G8_LDB(B1, 0, 1); G8_STAGE(G8_SB(0, 0), b20, voffB);
            G8_BAR; G8_WAIT_L(0); G8_MMA(0, 1, At, B1); G8_BAR;
            G8_LDA(At, 0, 1); G8_STAGE(G8_SA(0, 0), a2, xoff[0]);
            G8_BAR; G8_WAIT_L(0); G8_MMA(1, 0, At, B0); G8_BAR; G8_SCHED;
            G8_STAGE(G8_SB(0, 1), b21, voffB);
            G8_WAIT_V(6); G8_BAR; G8_MMA(1, 1, At, B1); G8_BAR;
            G8_LDB(B0, 1, 0); G8_SCHED; G8_LDA(At, 1, 0); G8_STAGE(G8_SA(0, 1), a2, xoff[1]);
            G8_WAIT_L(8); G8_BAR; G8_WAIT_L(0); G8_MMA(0, 0, At, B0); G8_BAR; G8_SCHED;
            G8_LDB(B1, 1, 1); G8_STAGE(G8_SB(1, 0), b30, voffB);
            G8_BAR; G8_WAIT_L(0); G8_MMA(0, 1, At, B1); G8_BAR;
            G8_LDA(At, 1, 1); G8_STAGE(G8_SA(1, 0), a3, xoff[0]);
            G8_BAR; G8_WAIT_L(0); G8_MMA(1, 0, At, B0); G8_BAR; G8_SCHED;
            G8_STAGE(G8_SB(1, 1), b31, voffB);
            G8_WAIT_V(6); G8_BAR; G8_MMA(1, 1, At, B1); G8_BAR;
        }
        E(acc, cur, wr, wc, fr, fq);
        if (!has_next) break;
#pragma unroll
        for (int a = 0; a < 2; ++a)
#pragma unroll
            for (int b = 0; b < 2; ++b)
#pragma unroll
                for (int m = 0; m < 4; ++m)
#pragma unroll
                    for (int n = 0; n < 2; ++n) acc[a][b][m][n] = (f32x4){0.f, 0.f, 0.f, 0.f};
        cur = nxt; cB0 = nB0; cB1 = nB1; ++ui;
#pragma unroll
        for (int h = 0; h < 2; ++h)
#pragma unroll
            for (int i = 0; i < 2; ++i) caoff[h][i] = naoff[h][i];
    }
    G8_WAIT_V(0);
    if (wr == 0) G8_BAR;
    G8_BAR;
#undef G8_SA
#undef G8_SB
#undef G8_STAGE
#undef G8_LDA
#undef G8_LDB
#undef G8_MMA
#undef G8_WAIT_V
#undef G8_WAIT_L
#undef G8_BAR
#undef G8_SCHED
#undef G8_AOFF
#endif
}
}

#ifdef EMU
typedef const Params* ParamsPtr;
#else
typedef const __attribute__((address_space(4))) Params* ParamsPtr;
#endif
struct Frame {
    ParamsPtr P; unsigned char* ws; unsigned char* smem; int tid, lane, wave;
    __device__ __forceinline__ const float* in(int i) const { return P->in[i]; }
    __device__ __forceinline__ float* xrow(int row) const { return row < TL ? P->out + (size_t)row * D : (float*)(ws + WS_XC) + (size_t)(row - TL) * D; }
    __device__ __forceinline__ const float* xrow_in(int layer, int row) const {
        if (layer == 0) return row < TL ? in(I_X) + (size_t)row * D : in(I_CTX) + (size_t)(row - TL) * D;
        return xrow(row);
    }
};
__device__ __forceinline__ int row_mod(int row) { return row < TL ? row / SEQ : NB; }
__device__ __forceinline__ const float* modp(const Frame& F, int layer, int m, int chunk) { return (const float*)(F.ws + WS_MOD) + ((size_t)(layer * 5 + m) * 6 + chunk) * D; }


#ifndef EMU
#define XB_TMO      128
#define XB_XCNT(j)  (256  + 64 * (j))
#define XB_XSUB(j)  (1280 + 64 * (j))
#define XB_XGEN(j)  (2304 + 64 * (j))
#define XB_TOP      3328
#define XB_TOPGEN   3392
#define XCD_BAR_WORDS 3456
#define XB_SPIN_CAP (1u << 26)
#define LAS __attribute__((address_space(3)))
static_assert((CW_BAR + XCD_BAR_WORDS) * 4 <= CTL_BYTES, "control region");
__device__ __forceinline__ unsigned xb_ld(unsigned* p)              { return __hip_atomic_load(p, __ATOMIC_RELAXED, __HIP_MEMORY_SCOPE_AGENT); }
__device__ __forceinline__ unsigned xb_add(unsigned* p, unsigned v) { return __hip_atomic_fetch_add(p, v, __ATOMIC_RELAXED, __HIP_MEMORY_SCOPE_AGENT); }
__device__ __forceinline__ unsigned xb_xcc_id() { return (unsigned)__builtin_amdgcn_s_getreg((3 << 11) | 20) & 0xFu; }
#define XB_SPIN(cond, bar) do { unsigned _sp = 0; while (cond) { __builtin_amdgcn_s_sleep(1); \
    if ((++_sp & 255u) == 0u) { if (xb_ld(&(bar)[XB_TMO])) break; if (_sp > XB_SPIN_CAP) { atomicAdd(&(bar)[XB_TMO], 1u); break; } } } } while (0)
struct XcdBarrier { unsigned* bar; unsigned x; volatile LAS unsigned* st; };
__device__ __forceinline__ XcdBarrier xcd_barrier_post(unsigned* bar, volatile LAS unsigned* st) {
    XcdBarrier b; b.bar = bar; b.x = xb_xcc_id(); b.st = st;
    if (threadIdx.x == 0) (void)xb_add(&bar[XB_XCNT(b.x)], 1u);
    return b;
}
__device__ __forceinline__ void xcd_barrier_complete(unsigned* bar, unsigned x, unsigned& nloc, unsigned& nx) {
    const unsigned G = gridDim.x * gridDim.y * gridDim.z;
    unsigned sum, cnt, mine, sp = 0u;
    for (;;) {
        sum = 0u; cnt = 0u; mine = 0u;
#pragma unroll
        for (unsigned j = 0; j < 16; ++j) { const unsigned c = xb_ld(&bar[XB_XCNT(j)]); sum += c; cnt += (c > 0u) ? 1u : 0u; mine = (j == x) ? c : mine; }
        if (sum == G) break;
        __builtin_amdgcn_s_sleep(1);
        if ((++sp & 255u) == 0u) { if (xb_ld(&bar[XB_TMO])) break; if (sp > XB_SPIN_CAP) { atomicAdd(&bar[XB_TMO], 1u); break; } }
    }
    nloc = mine > 0u ? mine : 1u; nx = cnt > 0u ? cnt : 1u;
}
__device__ __forceinline__ void xcd_barrier(const XcdBarrier& b) {
    asm volatile("s_waitcnt vmcnt(0)" ::: "memory");
    __syncthreads();
    if (threadIdx.x == 0) {
        unsigned* bar = b.bar;
        __builtin_amdgcn_s_waitcnt(0);
        unsigned nloc = b.st[0], nx = b.st[1];
        if (nloc == 0u) { xcd_barrier_complete(bar, b.x, nloc, nx); b.st[0] = nloc; b.st[1] = nx; }
        const unsigned old = xb_add(&bar[XB_XSUB(b.x)], 1u);
        const unsigned gen = old / nloc;
        if (old + 1u == (gen + 1u) * nloc) {
            __builtin_amdgcn_fence(__ATOMIC_RELEASE, "agent");
            asm volatile("s_waitcnt vmcnt(0)" ::: "memory");
            const unsigned og = xb_add(&bar[XB_TOP], 1u);
            const unsigned tg = og / nx;
            if (og + 1u == (tg + 1u) * nx) xb_add(&bar[XB_TOPGEN], 1u);
            else XB_SPIN(xb_ld(&bar[XB_TOPGEN]) == tg, bar);
            __builtin_amdgcn_fence(__ATOMIC_ACQUIRE, "agent");
            xb_add(&bar[XB_XGEN(b.x)], 1u);
            asm volatile("s_waitcnt vmcnt(0)" ::: "memory");
        } else {
            XB_SPIN(xb_ld(&bar[XB_XGEN(b.x)]) == gen, bar);
            __builtin_amdgcn_fence(__ATOMIC_ACQUIRE, "agent");
            asm volatile("s_waitcnt vmcnt(0)" ::: "memory");
        }
    }
    __syncthreads();
}
#endif

__device__ __forceinline__ void item_twiddle(const Frame& F, int it) {
    cplx* tw = (cplx*)(F.ws + WS_TW);
    const int k = it * NT + F.tid;
    if (k < TWN) { float s, c; const float a = -6.283185307179586f * (float)k / (float)TWN; s = sinf(a); c = cosf(a); tw[k].x = c; tw[k].y = s; }
}
__device__ __forceinline__ void item_mod(const Frame& F, int it) {
    const int layer = it / (NMOD / 64), n0 = (it % (NMOD / 64)) * 64;
    float* sc = (float*)F.smem;
    float* red = sc + 5 * D;
    for (int i = F.tid; i < 5 * D; i += NT) { const int m = i / D, k = i % D; const float v = m < NB ? F.in(I_C)[m * D + k] : F.in(I_CCTX)[k]; sc[i] = siluf(v); }
    __syncthreads();
    const int j = F.tid & 63, ks = F.tid >> 6;
    const float* w = F.in(I_WMOD) + (size_t)layer * D * NMOD + n0 + j;
    float a[5] = {0, 0, 0, 0, 0};
#pragma unroll 1
    for (int k0 = ks * 128; k0 < ks * 128 + 128; k0 += 32) {
        float wv[32];
#pragma unroll
        for (int q = 0; q < 32; ++q) wv[q] = w[(size_t)(k0 + q) * NMOD];
#pragma unroll
        for (int q = 0; q < 32; ++q)
#pragma unroll
            for (int m = 0; m < 5; ++m) a[m] += sc[m * D + k0 + q] * wv[q]; }
#pragma unroll
    for (int m = 0; m < 5; ++m) red[(ks * 5 + m) * 64 + j] = a[m];
    __syncthreads();
    if (F.tid < 5 * 64) { const int m = F.tid / 64, jj = F.tid % 64; float s = 0; for (int q = 0; q < 8; ++q) s += red[(q * 5 + m) * 64 + jj];
        ((float*)(F.ws + WS_MOD))[(size_t)(layer * 5 + m) * NMOD + n0 + jj] = s + F.in(I_BMOD)[layer * NMOD + n0 + jj]; }
    __syncthreads();
}
__device__ __forceinline__ void item_filter(const Frame& F, int layer, int isctx, int tb) {
    const int L = isctx ? CTXL : SEQ;
    float* feats = (float*)F.smem;
    float* h1 = feats + 32 * 33;
    float* h2 = h1 + 32 * 64;
    const int t0 = tb * 32;
    for (int i = F.tid; i < 32 * 33; i += NT) {
        const int tt = i / 33, f = i % 33; const float t = (float)(t0 + tt);
        float v;
        if (f == 0) v = t / (float)(L - 1 > 1 ? L - 1 : 1);
        else { const int bi = (f - 1) & 15; const float band = 1e-4f + (float)bi * ((15.0f - 1e-4f) / 15.0f);
               const float ang = (6.283185307179586f / (float)L) * t * band; v = (f <= 16) ? cosf(ang) : -sinf(ang); }
        feats[i] = v;
    }
    __syncthreads();
    const float* w1 = F.in(I_HW1) + layer * 33 * 64; const float* b1 = F.in(I_HB1) + layer * 64;
    const float* w2 = F.in(I_HW2) + layer * 64 * 64; const float* b2 = F.in(I_HB2) + layer * 64;
    const float* fr = F.in(I_HFREQ) + layer * 64;
    for (int i = F.tid; i < 32 * 64; i += NT) { const int tt = i >> 6, j = i & 63; float s = b1[j]; for (int k = 0; k < 33; ++k) s += feats[tt * 33 + k] * w1[k * 64 + j]; h1[i] = sinf(fr[j] * s); }
    __syncthreads();
    for (int i = F.tid; i < 32 * 64; i += NT) { const int tt = i >> 6, j = i & 63; float s = b2[j]; for (int k = 0; k < 64; ++k) s += h1[tt * 64 + k] * w2[k * 64 + j]; h2[i] = sinf(fr[j] * s); }
    __syncthreads();
    const float* w3 = F.in(I_HW3) + (size_t)layer * 64 * 1024;
    const int c0 = F.tid * 2;
    float* ft = (float*)(F.ws + WS_FT) + (isctx ? (size_t)2 * 256 * 4 * SEQ : (size_t)layer * 256 * 4 * SEQ);
    for (int hf = 0; hf < 2; ++hf) {
        float acc[16][2];
        for (int tt = 0; tt < 16; ++tt) { acc[tt][0] = 0.f; acc[tt][1] = 0.f; }
#pragma unroll 4
        for (int k = 0; k < 64; ++k) { const float wa = w3[k * 1024 + c0], wb = w3[k * 1024 + c0 + 1];
#pragma unroll
            for (int tt = 0; tt < 16; ++tt) { const float hv = h2[(hf * 16 + tt) * 64 + k]; acc[tt][0] += hv * wa; acc[tt][1] += hv * wb; } }
#pragma unroll
        for (int q = 0; q < 2; ++q) {
            const int col = c0 + q, dir = col >> 9, order = (col >> 8) & 1, c = col & 255;
            const float dec = fabsf(F.in(I_HDEC)[((layer * 2 + dir) * 2 + order) * 256 + c]);
            float* dst = ft + ((size_t)(c * 2 + order) * 2 + dir) * L + t0 + hf * 16;
#pragma unroll
            for (int tt = 0; tt < 16; ++tt) { const float tu = (float)(t0 + hf * 16 + tt) / (float)(L - 1 > 1 ? L - 1 : 1); dst[tt] = acc[tt][q] * expf(-tu * dec); }
        }
    }
    __syncthreads();
}
__device__ __forceinline__ int inproj_src_col(int j) { return j < 1024 ? j : (j < 3328 ? j + 12 : (j < 3340 ? j - 2304 : (j < NIN ? j : -1))); }
__device__ __forceinline__ void item_transpose(const Frame& F, const float* src, int ldn, int nvalid, half_t* dst, int K, int k0, int n0, int inmap = 0) {
    float* tile = (float*)F.smem;
    f32x4 v[8];
#pragma unroll
    for (int q = 0; q < 8; ++q) { const int i = F.tid + q * NT, r = i >> 6, c4 = (i & 63) * 4;
        if (inmap) { const int sc = inproj_src_col(n0 + c4); v[q] = sc >= 0 ? *(const f32x4*)(src + (size_t)(k0 + r) * ldn + sc) : (f32x4){0.f, 0.f, 0.f, 0.f}; }
        else if (n0 + c4 + 3 < nvalid) v[q] = *(const f32x4*)(src + (size_t)(k0 + r) * ldn + n0 + c4);
        else {
#pragma unroll
            for (int e = 0; e < 4; ++e) v[q][e] = (n0 + c4 + e < nvalid) ? src[(size_t)(k0 + r) * ldn + n0 + c4 + e] : 0.f; } }
#pragma unroll
    for (int q = 0; q < 8; ++q) { const int i = F.tid + q * NT, r = i >> 6, c4 = (i & 63) * 4; *(f32x4*)(tile + r * 260 + c4) = v[q]; }
    __syncthreads();
#pragma unroll
    for (int q = 0; q < 4; ++q) { const int i = F.tid + q * NT, n = i >> 3, kc = (i & 7) * 8; half8 h;
#pragma unroll
        for (int e = 0; e < 8; ++e) h[e] = (half_t)tile[(kc + e) * 260 + n];
        *(half8*)(dst + (size_t)(n0 + n) * K + k0 + kc) = h; }
    __syncthreads();
}
__device__ __forceinline__ void item_router_w(const Frame& F, int layer) {
    half_t* dst = (half_t*)(F.ws + WS_WR) + (size_t)layer * 2 * 48 * D;
#pragma unroll 4
    for (int i = F.tid; i < 32 * D; i += NT) {
        const int k = i >> 5, c = i & 31; const float w = F.in(I_ERW)[(size_t)layer * D * 32 + i];
        const half_t hi = (half_t)w; dst[(size_t)(4 + c) * D + k] = hi; dst[(size_t)(48 + 4 + c) * D + k] = (half_t)((w - (float)hi) * 2048.f); }
#pragma unroll 4
    for (int i = F.tid; i < 4 * D; i += NT) {
        const int k = i >> 2, c = i & 3; const float w = F.in(I_GRW)[(size_t)layer * D * 4 + i];
        const half_t hi = (half_t)w; dst[(size_t)c * D + k] = hi; dst[(size_t)(48 + c) * D + k] = (half_t)((w - (float)hi) * 2048.f); }
#pragma unroll 4
    for (int i = F.tid; i < 12 * D; i += NT) { dst[(size_t)36 * D + i] = (half_t)0.f; dst[(size_t)(48 + 36) * D + i] = (half_t)0.f; }
}
constexpr int IT_TW = (TWN + NT - 1) / NT;
constexpr int IT_MOD = 2 * (NMOD / 64);
constexpr int IT_FILT = 2 * (SEQ / 32) + (CTXL / 32);
constexpr int IT_TWIN = 2 * 16 * (NINP / 256);
constexpr int IT_TWOUT = 2 * 16 * 4;
constexpr int IT_TMOE = 32 * 48;
__device__ __forceinline__ void moe_transpose_item(const Frame& F, int layer, int it) {
    const int e = it / 48, r = it % 48, which = r / 16, t = r % 16;
    half_t* base = (half_t*)(F.ws + WS_WMOE) + (size_t)e * 3 * 262144;
    if (which < 2) {
        const float* src = F.in(which == 0 ? I_MG : I_MU) + ((size_t)layer * 32 + e) * 262144;
        item_transpose(F, src, 256, 256, base + which * 262144, 1024, t * 64, 0);
    } else {
        const float* src = F.in(I_MD) + ((size_t)layer * 32 + e) * 262144;
        item_transpose(F, src, 1024, 1024, base + 2 * 262144, 256, (t >> 2) * 64, (t & 3) * 256);
    }
}
__device__ __forceinline__ void phase_setup(const Frame& F) {
    const int G = gridDim.x; int rot = blockIdx.x;
    for (int i = rot; i < IT_MOD; i += G) item_mod(F, i);
    rot = (rot + G - (IT_MOD % G)) % G;
    for (int i = rot; i < IT_TWIN; i += G) { const int layer = i / (16 * (NINP / 256)), r = i % (16 * (NINP / 256));
        item_transpose(F, F.in(I_WIN) + (size_t)layer * D * NIN, NIN, NIN, (half_t*)(F.ws + WS_WIN) + (size_t)layer * NINP * D, D, (r / (NINP / 256)) * 64, (r % (NINP / 256)) * 256, 1); }
    rot = (rot + G - (IT_TWIN % G)) % G;
    for (int i = rot; i < IT_FILT; i += G) { if (i < 2 * (SEQ / 32)) item_filter(F, i / (SEQ / 32), 0, i % (SEQ / 32)); else item_filter(F, 0, 1, i - 2 * (SEQ / 32)); }
    rot = (rot + G - (IT_FILT % G)) % G;
    for (int i = rot; i < IT_TWOUT; i += G) { const int layer = i / 64, r = i % 64;
        item_transpose(F, F.in(I_WOUT) + (size_t)layer * D * D, D, D, (half_t*)(F.ws + WS_WOUT) + (size_t)layer * D * D, D, (r >> 2) * 64, (r & 3) * 256); }
    rot = (rot + G - (IT_TWOUT % G)) % G;
    for (int i = rot; i < IT_TW; i += G) item_twiddle(F, i);
    rot = (rot + G - (IT_TW % G)) % G;
    for (int i = rot; i < 2; i += G) item_router_w(F, i);
}

__device__ __forceinline__ void phase_norm1(const Frame& F, int layer) {
    half_t* xn = (half_t*)(F.ws + WS_XN);
    const int lane = F.lane, nwaves = gridDim.x * (NT / 64);
    const float* nw = F.in(I_N1W) + layer * D;
    int mc = -1; f32x4 g[4], s4[4];
    int row = blockIdx.x * (NT / 64) + F.wave;
    f32x4 v[4];
    if (row < TT) { const float* x = F.xrow_in(layer, row);
#pragma unroll
        for (int q = 0; q < 4; ++q) v[q] = *(const f32x4*)(x + q * 256 + lane * 4); }
    for (; row < TT; row += nwaves) {
        const int nrow = row + nwaves;
        f32x4 vn[4];
        if (nrow < TT) { const float* x = F.xrow_in(layer, nrow);
#pragma unroll
            for (int q = 0; q < 4; ++q) vn[q] = *(const f32x4*)(x + q * 256 + lane * 4); }
        if (layer > 0) {
            const half_t* xa = (const half_t*)(F.ws + WS_U16 + XAB_OFF) + (size_t)row * D; const half_t* xb = xa + (size_t)TT * D; float* xw = F.xrow(row);
            const float* g5 = modp(F, layer - 1, row_mod(row), 5);
#pragma unroll
            for (int q = 0; q < 4; ++q) { const int k = q * 256 + lane * 4; const half4 a4 = *(const half4*)(xa + k), b4 = *(const half4*)(xb + k); const f32x4 gv = *(const f32x4*)(g5 + k);
#pragma unroll
                for (int e = 0; e < 4; ++e) v[q][e] += gv[e] * ((float)a4[e] + (float)b4[e]);
                *(f32x4*)(xw + k) = v[q]; } }
        const int m = row_mod(row);
        if (m != mc) { mc = m; const float* sh = modp(F, layer, m, 0); const float* scl = modp(F, layer, m, 1);
#pragma unroll
            for (int q = 0; q < 4; ++q) { const int k = q * 256 + lane * 4; const f32x4 a = *(const f32x4*)(nw + k), b = *(const f32x4*)(scl + k); s4[q] = *(const f32x4*)(sh + k);
#pragma unroll
                for (int e = 0; e < 4; ++e) g[q][e] = a[e] * (1.0f + b[e]); } }
        float ss = 0.f;
#pragma unroll
        for (int q = 0; q < 4; ++q) ss += v[q][0] * v[q][0] + v[q][1] * v[q][1] + v[q][2] * v[q][2] + v[q][3] * v[q][3];
        ss = wave_sum(ss);
        const float rs = 1.0f / sqrtf(ss * (1.0f / D) + EPSF);
        int srow = row;
        if (layer == 1 && row < TL) { const int b = row / SEQ, l = row % SEQ; srow = b * SEQ + (l % GW) * GROWS + l / GW; }
#pragma unroll
        for (int q = 0; q < 4; ++q) { const int k = q * 256 + lane * 4; half4 h;
#pragma unroll
            for (int e = 0; e < 4; ++e) h[e] = (half_t)(v[q][e] * rs * g[q][e] + s4[q][e]);
            *(half4*)(xn + (size_t)srow * D + k) = h; }
#pragma unroll
        for (int q = 0; q < 4; ++q) v[q] = vn[q];
    }
}

#ifdef EMU
#define WAVE_SYNC() emu_wave_barrier()
#else
#define WAVE_SYNC() __builtin_amdgcn_wave_barrier()
#endif
constexpr int HYTR_OFF = g8::STAGE_BYTES + 2048;
struct EpiInproj {
    static constexpr bool PERM = true;
    half_t* u16; float* ug; half_t* hyt; half_t* halo; unsigned char* smem;
    __device__ __forceinline__ void operator()(const f32x4 (&acc)[2][2][4][2], const g8::Unit& u, int wr, int wc, int fr, int fq) const {
        const int rowb = u.pm * 256 + wr * 64 + fr;
        const bool edge = (fr == 0) || (fr == 15);
        const int lane = fq * 16 + fr;
        half_t* T = (half_t*)(smem + HYTR_OFF) + (wr * 4 + wc) * (32 * 24);
#pragma unroll
        for (int bj = 0; bj < 2; ++bj) {
            const int c8 = u.pn * 256 + bj * 128 + wc * 32 + 8 * fq;
            if (c8 < 1024 || (c8 >= 1792 && c8 < 3328)) {
                const int uc = c8 < 1024 ? c8 : c8 - 768; const bool hal = edge && uc >= 384 && uc < 1792;
#pragma unroll
                for (int ai = 0; ai < 2; ++ai)
#pragma unroll
                    for (int m = 0; m < 4; ++m) { const int row = rowb + ai * 128 + m * 16; const f32x4 a0 = acc[ai][bj][m][0], a1 = acc[ai][bj][m][1]; half8 h;
                        h[0] = (half_t)a0[0]; h[1] = (half_t)a0[1]; h[2] = (half_t)a0[2]; h[3] = (half_t)a0[3]; h[4] = (half_t)a1[0]; h[5] = (half_t)a1[1]; h[6] = (half_t)a1[2]; h[7] = (half_t)a1[3];
                        *(half8*)(u16 + (size_t)row * UW + uc) = h;
                        if (hal) *(half8*)(halo + ((size_t)(row >> 4) * 2 + (fr == 15)) * 1408 + (uc - 384)) = h; }
            } else if (c8 < 1792) {
                const int chb = (c8 - 8 * fq) - 1024;
#pragma unroll
                for (int ai = 0; ai < 2; ++ai)
#pragma unroll
                    for (int m = 0; m < 4; ++m) {
                        const f32x4 a0 = acc[ai][bj][m][0], a1 = acc[ai][bj][m][1];
                        WAVE_SYNC();
#pragma unroll
                        for (int j = 0; j < 4; ++j) { T[(8 * fq + j) * 24 + fr] = (half_t)a0[j]; T[(8 * fq + 4 + j) * 24 + fr] = (half_t)a1[j]; }
                        WAVE_SYNC();
                        const int ch = lane >> 1, th = lane & 1; const half8 hv = *(const half8*)(T + ch * 24 + th * 8);
                        const int row0 = rowb - fr + ai * 128 + m * 16;
                        half_t* dst = row0 < TL ? hyt + ((size_t)(row0 / SEQ) * 768 + chb + ch) * SEQ + row0 % SEQ : hyt + (size_t)NB * 768 * SEQ + ((size_t)((row0 - TL) / CTXL) * 768 + chb + ch) * CTXL + (row0 - TL) % CTXL;
                        *(half8*)(dst + th * 8) = hv; }
            } else {
#pragma unroll
                for (int n = 0; n < 2; ++n) { const int c0 = c8 + 4 * n;
                    if (c0 < NIN) { const int gc = c0 < 3340 ? c0 - 3328 : 12 + (c0 - 3340);
#pragma unroll
                        for (int ai = 0; ai < 2; ++ai)
#pragma unroll
                            for (int m = 0; m < 4; ++m) { const int row = rowb + ai * 128 + m * 16; *(f32x4*)(ug + (size_t)row * UGW + gc) = acc[ai][bj][m][n]; } } }
            }
        }
    }
};
__device__ __forceinline__ void phase_inproj(const Frame& F, int layer) {
    g8::DenseSched S; S.abase = (const char*)(F.ws + WS_XN); S.bbase = (const char*)((const half_t*)(F.ws + WS_WIN) + (size_t)layer * NINP * D); S.K = D; S.nM = TT / 256; S.nN = NINP / 256; S.G = gridDim.x; S.c = blockIdx.x;
    EpiInproj E{(half_t*)(F.ws + WS_U16), (float*)(F.ws + WS_UG), (half_t*)(F.ws + WS_HYT), (half_t*)(F.ws + WS_HALO), F.smem};
    g8::gemm_phase(F.smem, D, S, E);
}


__device__ __forceinline__ void phase_act(const Frame& F, int layer) {
    half_t* u16 = (half_t*)(F.ws + WS_U16); const half_t* halo = (const half_t*)(F.ws + WS_HALO);
    const int tid = F.tid, g = tid % 176, hf = tid / 176;
    const bool active = tid < 352;
    const bool isml = g >= 80; const int ch = isml ? (g - 80) * 8 : g * 8, C = isml ? 768 : 640;
    const float* cw = isml ? F.in(I_MCW) + layer * 3 * 768 : F.in(I_SCW) + layer * 3 * 640; const float* cb = isml ? F.in(I_MCB) + layer * 768 : F.in(I_SCB) + layer * 640;
    const float osc = (isml && ch >= 384) ? 0.125f : 1.0f;
    float w0[8], w1[8], w2[8], wb[8];
#pragma unroll
    for (int i = 0; i < 8; ++i) { const int cc = active ? ch + i : 0; w0[i] = cw[cc]; w1[i] = cw[C + cc]; w2[i] = cw[2 * C + cc]; wb[i] = cb[cc]; }
    for (int it = blockIdx.x; it < TT / 16; it += gridDim.x) {
        const int rb = it * 16, r0 = rb + hf * 8;
        const bool isl = rb < TL; const int L = isl ? SEQ : CTXL; const int pos0 = (isl ? rb : rb - TL) % L;
        half8 rr[10]; half8 zz;
#pragma unroll
        for (int i = 0; i < 8; ++i) zz[i] = (half_t)0.f;
        if (active) {
            const size_t col = 384 + g * 8;
#pragma unroll
            for (int k = 0; k < 8; ++k) rr[k + 1] = *(const half8*)(u16 + (size_t)(r0 + k) * UW + col);
            if (hf == 0) { rr[0] = pos0 > 0 ? *(const half8*)(halo + ((size_t)(it - 1) * 2 + 1) * 1408 + g * 8) : zz; rr[9] = *(const half8*)(u16 + (size_t)(rb + 8) * UW + col); }
            else { rr[0] = *(const half8*)(u16 + (size_t)(rb + 7) * UW + col); rr[9] = pos0 + 16 < L ? *(const half8*)(halo + ((size_t)(it + 1) * 2 + 0) * 1408 + g * 8) : zz; }
        }
        half8 o[8];
        if (active) {
#pragma unroll
            for (int k = 0; k < 8; ++k)
#pragma unroll
                for (int i = 0; i < 8; ++i) o[k][i] = (half_t)(osc * fsilu(w0[i] * (float)rr[k][i] + w1[i] * (float)rr[k + 1][i] + w2[i] * (float)rr[k + 2][i] + wb[i]));
        }
        __syncthreads();
        if (active) {
#pragma unroll
            for (int k = 0; k < 8; ++k) *(half8*)(u16 + (size_t)(r0 + k) * UW + 384 + g * 8) = o[k];
        }
    }
}

constexpr int SA = 72, SB = 136;

__device__ __forceinline__ void load_rows8(const half_t* u16, int rowbase, int Lseq, int dir, int jj0, int ucol, half8 (&rr)[8]) {
#pragma unroll
    for (int k = 0; k < 8; ++k) { const int jj = jj0 + k, pos = dir == 0 ? jj : Lseq - 1 - jj; rr[k] = *(const half8*)(u16 + (size_t)(rowbase + pos) * UW + ucol); }
}
__device__ __forceinline__ void transpose8(const half8 (&rr)[8], half8 (&t)[8]) {
#pragma unroll
    for (int i = 0; i < 8; ++i)
#pragma unroll
        for (int k = 0; k < 8; ++k) t[i][k] = rr[k][i];
}
__device__ __forceinline__ void ssd_block(const Frame& F, int layer, int b, int h, int dir) {
    half_t* Cs = (half_t*)F.smem;
    half_t* Bs = Cs + 128 * SA;
    half_t* BT = Bs + 128 * SA;
    half_t* XT = BT + 64 * SB;
    half_t* SC = XT + 64 * SB;
    half_t* ST = SC + 128 * SB;
    float* cum = (float*)(ST + 64 * SA);
    float* dtv = cum + 128;
    float* wes = dtv + 128;
    const half_t* u16 = (const half_t*)(F.ws + WS_U16); const float* ug = (const float*)(F.ws + WS_UG);
    half_t* yout = (half_t*)(F.ws + WS_YF) + (size_t)dir * TT * 384;
    const float* cw = F.in(I_SCW) + layer * 3 * 640; const float* cb = F.in(I_SCB) + layer * 640;
    const float dtb = F.in(I_DTB)[(layer * 2 + dir) * 6 + h];
    const float Aneg = -expf(F.in(I_ALOG)[(layer * 2 + dir) * 6 + h]);
    const float Dh = F.in(I_SD)[layer * 6 + h];
    const int g = h / 3, tid = F.tid, lane = F.lane, wave = F.wave;
    const int kind = tid >> 7, c8 = (tid & 7) * 8, j0 = ((tid >> 3) & 15) * 8;
    const int ch = kind == 0 ? h * 64 + c8 : (kind == 1 ? 384 + g * 64 + c8 : 512 + g * 64 + c8);
    f32x4 accS[1][2]; zero_acc(accS);
    for (int i = tid; i < 64 * SA; i += NT) ST[i] = (half_t)0.f;
    constexpr int NC0 = CTXL / 128, NCT = NC0 + SEQ / 128;
    half8 rr[8]; float ug0 = 0.f, ug1 = 0.f;
    if (kind < 3) load_rows8(u16, TL + b * CTXL, CTXL, dir, j0, 384 + ch, rr);
    if (wave == 7) { const int p0 = dir == 0 ? 2 * lane : CTXL - 1 - 2 * lane, p1 = dir == 0 ? p0 + 1 : p0 - 1;
        ug0 = ug[(size_t)(TL + b * CTXL + p0) * UGW + dir * 6 + h]; ug1 = ug[(size_t)(TL + b * CTXL + p1) * UGW + dir * 6 + h]; }
    __syncthreads();
    for (int cc = 0; cc < NCT; ++cc) {
        const int seg = cc >= NC0 ? 1 : 0, c = seg ? cc - NC0 : cc;
        const int Lseq = seg == 0 ? CTXL : SEQ, rowbase = seg == 0 ? TL + b * CTXL : b * SEQ;
        const bool want_y = (seg == 1) || (layer == 0);
        const int nseg = (cc + 1) >= NC0 ? 1 : 0, ncn = nseg ? cc + 1 - NC0 : cc + 1, nL = nseg == 0 ? CTXL : SEQ, nrb = nseg == 0 ? TL + b * CTXL : b * SEQ;
        if (wave == 7) {
            const float dt0 = fsoftplus(ug0 + dtb), dt1 = fsoftplus(ug1 + dtb);
            const float a0 = dt0 * Aneg, a1 = dt1 * Aneg;
            const float incl = wave_scan_sum(a0 + a1, lane);
            const float c1 = incl, c0 = incl - a1;
            const float cl = wave_last(incl);
            cum[2 * lane] = c0; cum[2 * lane + 1] = c1; dtv[2 * lane] = dt0; dtv[2 * lane + 1] = dt1;
            wes[2 * lane] = dt0 * fexp(cl - c0); wes[2 * lane + 1] = dt1 * fexp(cl - c1);
            if (cc + 1 < NCT) { const int pi = ncn * 128 + 2 * lane, p0 = dir == 0 ? pi : nL - 1 - pi, p1 = dir == 0 ? p0 + 1 : p0 - 1;
                ug0 = ug[(size_t)(nrb + p0) * UGW + dir * 6 + h]; ug1 = ug[(size_t)(nrb + p1) * UGW + dir * 6 + h]; }
        }
        if (kind < 3) {
            if (kind == 0) { half8 t[8]; transpose8(rr, t);
#pragma unroll
                for (int i = 0; i < 8; ++i) *(half8*)(XT + (c8 + i) * SB + j0) = t[i];
            } else if (kind == 1) { half8 t[8]; transpose8(rr, t);
#pragma unroll
                for (int k = 0; k < 8; ++k) *(half8*)(Bs + (j0 + k) * SA + c8) = rr[k];
#pragma unroll
                for (int i = 0; i < 8; ++i) *(half8*)(BT + (c8 + i) * SB + j0) = t[i];
            } else {
#pragma unroll
                for (int k = 0; k < 8; ++k) *(half8*)(Cs + (j0 + k) * SA + c8) = rr[k];
            }
            if (cc + 1 < NCT) load_rows8(u16, nrb, nL, dir, ncn * 128 + j0, 384 + ch, rr);
        }
        __syncthreads();
        const float cl = cum[127];
        if (want_y) {
            { const int ws_ = wave & 1, wl = wave >> 1;
              if (!(ws_ == 1 && wl < 2)) {
                f32x4 g_[4][2]; zero_acc(g_);
                mma_lds<4, 2>(g_, Bs + ws_ * 64 * SA, SA, Cs + wl * 32 * SA, SA, 2, lane);
#pragma unroll
                for (int a = 0; a < 4; ++a) {
                    const int s0 = ws_ * 64 + a * 16 + (lane >> 4) * 4;
                    const f32x4 cs4 = *(const f32x4*)(cum + s0), dt4 = *(const f32x4*)(dtv + s0);
#pragma unroll
                    for (int q = 0; q < 2; ++q) {
                        const int l = wl * 32 + q * 16 + (lane & 15); const float cl_ = cum[l]; half4 hv;
#pragma unroll
                        for (int i = 0; i < 4; ++i) hv[i] = (half_t)((s0 + i) <= l ? g_[a][q][i] * fexp(cl_ - cs4[i]) * dt4[i] : 0.f);
                        *(half4*)(SC + l * SB + s0) = hv;
                    } }
              } }
            f32x4 y1[4][1]; zero_acc(y1);
            mma_lds<4, 1>(y1, ST, SA, Cs + wave * 16 * SA, SA, 2, lane);
            __syncthreads();
            f32x4 y2[4][1]; zero_acc(y2);
            mma_lds<4, 1>(y2, XT, SB, SC + wave * 16 * SB, SB, wave / 2 + 1, lane);
            { const int l = wave * 16 + (lane & 15); const float el = fexp(cum[l]);
              const int pi = c * 128 + l, pos = dir == 0 ? pi : Lseq - 1 - pi;
#pragma unroll
              for (int a = 0; a < 4; ++a) { const int p0 = a * 16 + (lane >> 4) * 4; f32x4 y;
#pragma unroll
                  for (int i = 0; i < 4; ++i) y[i] = y1[a][0][i] * el + y2[a][0][i];
                  if (dir == 0) {
#pragma unroll
                      for (int i = 0; i < 4; ++i) y[i] += Dh * (float)XT[(p0 + i) * SB + l]; }
                  *(half4*)(yout + (size_t)(rowbase + pos) * 384 + h * 64 + p0) = to_half4(y); } }
        }
        { const float dec = fexp(cl);
#pragma unroll
          for (int q = 0; q < 2; ++q) accS[0][q] *= dec;
          const int r = lane & 15, kq = (lane >> 4) * 8;
#pragma unroll
          for (int ks = 0; ks < 4; ++ks) {
              const half8 a = *(const half8*)(BT + ((wave >> 1) * 16 + r) * SB + ks * 32 + kq);
              const f32x4 e0 = *(const f32x4*)(wes + ks * 32 + kq), e1 = *(const f32x4*)(wes + ks * 32 + kq + 4);
#pragma unroll
              for (int q = 0; q < 2; ++q) { half8 bb = *(const half8*)(XT + ((wave & 1) * 32 + q * 16 + r) * SB + ks * 32 + kq);
#pragma unroll
                  for (int i = 0; i < 4; ++i) { bb[i] = (half_t)((float)bb[i] * e0[i]); bb[4 + i] = (half_t)((float)bb[4 + i] * e1[i]); }
                  accS[0][q] = mfma16(a, bb, accS[0][q]); } } }
        __syncthreads();
#pragma unroll
        for (int q = 0; q < 2; ++q) { const int p = (wave & 1) * 32 + q * 16 + (lane & 15), n0 = (wave >> 1) * 16 + (lane >> 4) * 4; *(half4*)(ST + p * SA + n0) = to_half4(accS[0][q]); }
    }
    __syncthreads();
}

__device__ __forceinline__ void mlstm_block(const Frame& F, int layer, int b, int h, int dir) {
    half_t* Qs = (half_t*)F.smem;
    half_t* Ks = Qs + 128 * SA;
    half_t* KT = Ks + 128 * SA;
    half_t* VT = KT + 64 * SB;
    half_t* SC = VT + 64 * SB;
    half_t* CS = SC + 128 * SB;
    float* ig = (float*)(CS + 64 * SA);
    float* cumf = ig + 128; float* gsv = cumf + 128; float* mtv = gsv + 128; float* ee = mtv + 128; float* dn = ee + 128;
    float* nvec = dn + 128;
    float* scal = nvec + 64;
    const half_t* u16 = (const half_t*)(F.ws + WS_U16); const float* ug = (const float*)(F.ws + WS_UG);
    half_t* hout = (half_t*)(F.ws + WS_YF) + (size_t)(2 + dir) * TT * 384;
    const float* cw = F.in(I_MCW) + layer * 3 * 768; const float* cb = F.in(I_MCB) + layer * 768;
    const float bi = F.in(I_MGB)[((layer * 2 + dir) * 2 + 0) * 6 + h], bf = F.in(I_MGB)[((layer * 2 + dir) * 2 + 1) * 6 + h];
    const int tid = F.tid, lane = F.lane, wave = F.wave;
    const int kind = tid >> 7, c8 = (tid & 7) * 8, j0 = ((tid >> 3) & 15) * 8;
    const int ch = kind == 0 ? h * 64 + c8 : 384 + h * 64 + c8;
    f32x4 accC[1][2]; zero_acc(accC);
    float m_in = 0.f;
    for (int i = tid; i < 64 * SA; i += NT) CS[i] = (half_t)0.f;
    if (tid < 64) nvec[tid] = 0.f;
    constexpr int NC0 = CTXL / 128, NCT = NC0 + SEQ / 128;
    half8 rr[8]; float gi0 = 0.f, gi1 = 0.f, gf0 = 0.f, gf1 = 0.f;
    const int ucol = kind == 2 ? 1792 + h * 64 + c8 : 1024 + ch;
    if (kind < 3) load_rows8(u16, TL + b * CTXL, CTXL, dir, j0, ucol, rr);
    if (wave == 7) { const int p0 = dir == 0 ? 2 * lane : CTXL - 1 - 2 * lane, p1 = dir == 0 ? p0 + 1 : p0 - 1;
        const float* g0 = ug + (size_t)(TL + b * CTXL + p0) * UGW + 12 + dir * 12; const float* g1 = ug + (size_t)(TL + b * CTXL + p1) * UGW + 12 + dir * 12;
        gi0 = g0[h]; gf0 = g0[6 + h]; gi1 = g1[h]; gf1 = g1[6 + h]; }
    half8 ones;
#pragma unroll
    for (int i = 0; i < 8; ++i) ones[i] = (half_t)1.0f;
    __syncthreads();
    for (int cc = 0; cc < NCT; ++cc) {
        const int seg = cc >= NC0 ? 1 : 0, c = seg ? cc - NC0 : cc;
        const int Lseq = seg == 0 ? CTXL : SEQ, rowbase = seg == 0 ? TL + b * CTXL : b * SEQ;
        const bool want_y = (seg == 1) || (layer == 0);
        const int nseg = (cc + 1) >= NC0 ? 1 : 0, ncn = nseg ? cc + 1 - NC0 : cc + 1, nL = nseg == 0 ? CTXL : SEQ, nrb = nseg == 0 ? TL + b * CTXL : b * SEQ;
        if (wave == 7) {
            const float i0 = gi0 + bi, i1 = gi1 + bi, lf0 = flogsigmoid(gf0 + bf), lf1 = flogsigmoid(gf1 + bf);
            const float incl = wave_scan_sum(lf0 + lf1, lane);
            const float c1 = incl, c0 = incl - lf1;
            const float tot = wave_last(incl);
            const float r0 = i0 - c0, r1 = i1 - c1;
            const float pincl = wave_scan_max(fmaxf(r0, r1), lane);
            const float pexcl = wave_shr1(pincl, -3.0e38f, lane);
            const float pm0 = fmaxf(pexcl, r0), pm1 = pincl;
            const float pmlast = wave_last(pincl);
            const float m_new = fmaxf(tot + m_in, tot + pmlast);
            ig[2 * lane] = i0; ig[2 * lane + 1] = i1; cumf[2 * lane] = c0; cumf[2 * lane + 1] = c1; gsv[2 * lane] = r0; gsv[2 * lane + 1] = r1;
            mtv[2 * lane] = fmaxf(c0 + m_in, c0 + pm0); mtv[2 * lane + 1] = fmaxf(c1 + m_in, c1 + pm1);
            ee[2 * lane] = fexp(r0 + tot - m_new); ee[2 * lane + 1] = fexp(r1 + tot - m_new);
            if (lane == 0) { scal[0] = tot; scal[1] = m_new; }
            if (cc + 1 < NCT) { const int pi = ncn * 128 + 2 * lane, p0 = dir == 0 ? pi : nL - 1 - pi, p1 = dir == 0 ? p0 + 1 : p0 - 1;
                const float* g0 = ug + (size_t)(nrb + p0) * UGW + 12 + dir * 12; const float* g1 = ug + (size_t)(nrb + p1) * UGW + 12 + dir * 12;
                gi0 = g0[h]; gf0 = g0[6 + h]; gi1 = g1[h]; gf1 = g1[6 + h]; }
        }
        if (kind == 0) {
#pragma unroll
            for (int k = 0; k < 8; ++k) *(half8*)(Qs + (j0 + k) * SA + c8) = rr[k];
        } else if (kind == 1) { half8 t[8]; transpose8(rr, t);
#pragma unroll
            for (int k = 0; k < 8; ++k) *(half8*)(Ks + (j0 + k) * SA + c8) = rr[k];
#pragma unroll
            for (int i = 0; i < 8; ++i) *(half8*)(KT + (c8 + i) * SB + j0) = t[i];
        } else if (kind == 2) { half8 t[8]; transpose8(rr, t);
#pragma unroll
            for (int i = 0; i < 8; ++i) *(half8*)(VT + (c8 + i) * SB + j0) = t[i];
        }
        if (kind < 3 && cc + 1 < NCT) load_rows8(u16, nrb, nL, dir, ncn * 128 + j0, ucol, rr);
        __syncthreads();
        const float tot = scal[0], m_new = scal[1];
        if (want_y) {
            { const int ws_ = wave & 1, wl = wave >> 1;
              if (!(ws_ == 1 && wl < 2)) {
                f32x4 g_[4][2]; zero_acc(g_);
                mma_lds<4, 2>(g_, Ks + ws_ * 64 * SA, SA, Qs + wl * 32 * SA, SA, 2, lane);
#pragma unroll
                for (int a = 0; a < 4; ++a) {
                    const int s0 = ws_ * 64 + a * 16 + (lane >> 4) * 4; const f32x4 gs4 = *(const f32x4*)(gsv + s0);
#pragma unroll
                    for (int q = 0; q < 2; ++q) {
                        const int l = wl * 32 + q * 16 + (lane & 15); const float cm = cumf[l] - mtv[l]; half4 hv;
#pragma unroll
                        for (int i = 0; i < 4; ++i) hv[i] = (half_t)((s0 + i) <= l ? g_[a][q][i] * fexp(cm + gs4[i]) : 0.f);
                        *(half4*)(SC + l * SB + s0) = hv;
                    } }
              } }
            f32x4 h1[4][1]; zero_acc(h1);
            mma_lds<4, 1>(h1, CS, SA, Qs + wave * 16 * SA, SA, 2, lane);
            f32x4 dq = {0.f, 0.f, 0.f, 0.f};
            { const int r_ = lane & 15, kq_ = (lane >> 4) * 8;
#pragma unroll
              for (int ks = 0; ks < 2; ++ks) { half8 na; const f32x4 n0 = *(const f32x4*)(nvec + ks * 32 + kq_), n1 = *(const f32x4*)(nvec + ks * 32 + kq_ + 4);
#pragma unroll
                  for (int i = 0; i < 4; ++i) { na[i] = (half_t)n0[i]; na[4 + i] = (half_t)n1[i]; }
                  dq = mfma16(na, *(const half8*)(Qs + (wave * 16 + r_) * SA + ks * 32 + kq_), dq); } }
            __syncthreads();
            f32x4 h2[4]; f32x4 d1 = {0.f, 0.f, 0.f, 0.f};
#pragma unroll
            for (int a = 0; a < 4; ++a) h2[a] = (f32x4){0.f, 0.f, 0.f, 0.f};
            { const int r = lane & 15, kq = (lane >> 4) * 8;
              for (int ks = 0; ks < wave / 2 + 1; ++ks) {
                  const half8 bfr = *(const half8*)(SC + (wave * 16 + r) * SB + ks * 32 + kq);
#pragma unroll
                  for (int a = 0; a < 4; ++a) { const half8 afr = *(const half8*)(VT + (a * 16 + r) * SB + ks * 32 + kq); h2[a] = mfma16(afr, bfr, h2[a]); }
                  d1 = mfma16(ones, bfr, d1); } }
            { const int l = wave * 16 + (lane & 15); const float ai = fexp(cumf[l] + m_in - mtv[l]); const float rden = 1.0f / fmaxf(fabsf(dq[0] * ai + d1[0]), fexp(-mtv[l]));
              const int pi = c * 128 + l, pos = dir == 0 ? pi : Lseq - 1 - pi;
#pragma unroll
              for (int a = 0; a < 4; ++a) { const int v0 = a * 16 + (lane >> 4) * 4; f32x4 y;
#pragma unroll
                  for (int i = 0; i < 4; ++i) y[i] = (h1[a][0][i] * ai + h2[a][i]) * rden;
                  *(half4*)(hout + (size_t)(rowbase + pos) * 384 + h * 64 + v0) = to_half4(y); } }
        }
        { const float sc = fexp(tot + m_in - m_new);
#pragma unroll
          for (int q = 0; q < 2; ++q) accC[0][q] *= sc;
          { const int r = lane & 15, kq = (lane >> 4) * 8;
#pragma unroll
            for (int ks = 0; ks < 4; ++ks) {
              const half8 a = *(const half8*)(KT + ((wave >> 1) * 16 + r) * SB + ks * 32 + kq);
              const f32x4 e0 = *(const f32x4*)(ee + ks * 32 + kq), e1 = *(const f32x4*)(ee + ks * 32 + kq + 4);
#pragma unroll
              for (int q = 0; q < 2; ++q) { half8 bb = *(const half8*)(VT + ((wave & 1) * 32 + q * 16 + r) * SB + ks * 32 + kq);
#pragma unroll
                  for (int i = 0; i < 4; ++i) { bb[i] = (half_t)((float)bb[i] * e0[i]); bb[4 + i] = (half_t)((float)bb[4 + i] * e1[i]); }
                  accC[0][q] = mfma16(a, bb, accC[0][q]); } } }
          if ((wave & 1) == 0) { f32x4 an = {0.f, 0.f, 0.f, 0.f}; const int r_ = lane & 15, kq_ = (lane >> 4) * 8;
#pragma unroll
              for (int ks = 0; ks < 4; ++ks) { half8 eb; const f32x4 e0 = *(const f32x4*)(ee + ks * 32 + kq_), e1 = *(const f32x4*)(ee + ks * 32 + kq_ + 4);
#pragma unroll
                  for (int i = 0; i < 4; ++i) { eb[i] = (half_t)e0[i]; eb[4 + i] = (half_t)e1[i]; }
                  an = mfma16(*(const half8*)(KT + ((wave >> 1) * 16 + r_) * SB + ks * 32 + kq_), eb, an); }
              if ((lane & 15) == 0) {
#pragma unroll
                  for (int i = 0; i < 4; ++i) { const int d = (wave >> 1) * 16 + (lane >> 4) * 4 + i; nvec[d] = sc * nvec[d] + an[i]; } } } }
        m_in = m_new;
        __syncthreads();
#pragma unroll
        for (int q = 0; q < 2; ++q) { const int v = (wave & 1) * 32 + q * 16 + (lane & 15), d0 = (wave >> 1) * 16 + (lane >> 4) * 4; *(half4*)(CS + v * SA + d0) = to_half4(accC[0][q]); }
    }
    __syncthreads();
}

__device__ __forceinline__ cplx cmul(cplx a, cplx b) { return cplx{a.x * b.x - a.y * b.y, a.x * b.y + a.y * b.x}; }
__device__ __forceinline__ cplx cadd(cplx a, cplx b) { return cplx{a.x + b.x, a.y + b.y}; }
__device__ __forceinline__ cplx csub(cplx a, cplx b) { return cplx{a.x - b.x, a.y - b.y}; }
__device__ __forceinline__ void sincos_turns(float x, float& s, float& c) {
#ifdef EMU
    s = sinf(6.283185307179586f * x); c = cosf(6.283185307179586f * x);
#else
    s = __builtin_amdgcn_sinf(x); c = __builtin_amdgcn_cosf(x);
#endif
}
#define PADI(i) ((i) + ((i) >> 5))
template <bool INV> __device__ __forceinline__ void r4(cplx& a0, cplx& a1, cplx& a2, cplx& a3) {
    const cplx t0 = cadd(a0, a2), t1 = csub(a0, a2), t2 = cadd(a1, a3), t3 = csub(a1, a3);
    a0 = cadd(t0, t2); a2 = csub(t0, t2);
    if (!INV) { a1 = cplx{t1.x + t3.y, t1.y - t3.x}; a3 = cplx{t1.x - t3.y, t1.y + t3.x}; }
    else      { a1 = cplx{t1.x - t3.y, t1.y + t3.x}; a3 = cplx{t1.x + t3.y, t1.y - t3.x}; }
}
template <bool INV> __device__ __forceinline__ void fft16(cplx (&v)[16]) {
#pragma unroll
    for (int l0 = 0; l0 < 4; ++l0) r4<INV>(v[l0], v[l0 + 4], v[l0 + 8], v[l0 + 12]);
    const float C1 = 0.9238795325112867f, S1 = 0.3826834323650898f, C2 = 0.7071067811865476f;
    const float sg = INV ? 1.f : -1.f;
#define TWM(idx, cr, ci) v[idx] = cmul(v[idx], cplx{(cr), sg * (ci)})
    TWM(1 + 4 * 1, C1, S1); TWM(2 + 4 * 1, C2, C2); TWM(3 + 4 * 1, S1, C1);
    TWM(1 + 4 * 2, C2, C2); TWM(2 + 4 * 2, 0.f, 1.f); TWM(3 + 4 * 2, -C2, C2);
    TWM(1 + 4 * 3, S1, C1); TWM(2 + 4 * 3, -C2, C2); TWM(3 + 4 * 3, -C1, -S1);
#undef TWM
    cplx o[16];
#pragma unroll
    for (int m0 = 0; m0 < 4; ++m0) { cplx a0 = v[4 * m0], a1 = v[4 * m0 + 1], a2 = v[4 * m0 + 2], a3 = v[4 * m0 + 3]; r4<INV>(a0, a1, a2, a3);
        o[m0] = a0; o[m0 + 4] = a1; o[m0 + 8] = a2; o[m0 + 12] = a3; }
#pragma unroll
    for (int i = 0; i < 16; ++i) v[i] = o[i];
}
__device__ __forceinline__ void twpow(cplx w1, cplx (&w)[16]) {
    w[1] = w1; w[2] = cmul(w1, w1); w[3] = cmul(w[2], w1); w[4] = cmul(w[2], w[2]); w[5] = cmul(w[4], w1); w[6] = cmul(w[4], w[2]); w[7] = cmul(w[4], w[3]); w[8] = cmul(w[4], w[4]);
#pragma unroll
    for (int m = 9; m < 16; ++m) w[m] = cmul(w[8], w[m - 8]);
}
#ifdef EMU
#define OPAQUE_I(x)
#else
#define OPAQUE_I(x) asm volatile("" : "+v"(x))
#endif
template <int NS> __device__ __forceinline__ void fft_fwd16(cplx* buf0, cplx* buf1, int N, int tid) {
#pragma unroll 1
    for (int n = N; n >= 32; n >>= 4) { const int q = n >> 4, qs = q + (q >> 5);
        for (int i = tid; i < N / 16; i += NT) {
            const int blk = i / q, j = i - blk * q; int pb = PADI(blk * n + j); OPAQUE_I(pb);
            float s, c; sincos_turns(-(float)j / (float)n, s, c);
            const cplx w1{c, s};
#pragma unroll
            for (int st = 0; st < NS; ++st) { cplx* buf = (st == 0 ? buf0 : buf1) + pb;
                cplx v[16];
#pragma unroll
                for (int l = 0; l < 16; ++l) v[l] = buf[l * qs];
                fft16<false>(v);
                buf[0] = v[0];
                cplx wm = w1;
#pragma unroll
                for (int m = 1; m < 16; ++m) { buf[m * qs] = cmul(v[m], wm); wm = cmul(wm, w1); }
                LOADER_FENCE(); }
        }
        __syncthreads(); }
}
template <int NS> __device__ __forceinline__ void fft_inv16(cplx* buf0, cplx* buf1, int N, int tid) {
#pragma unroll 1
    for (int n = 32; n <= N; n <<= 4) { const int q = n >> 4, qs = q + (q >> 5);
        for (int i = tid; i < N / 16; i += NT) {
            const int blk = i / q, j = i - blk * q; int pb = PADI(blk * n + j); OPAQUE_I(pb);
            float s, c; sincos_turns((float)j / (float)n, s, c);
            const cplx w1{c, s};
#pragma unroll
            for (int st = 0; st < NS; ++st) { cplx* buf = (st == 0 ? buf0 : buf1) + pb;
                cplx v[16];
                v[0] = buf[0];
                cplx wm = w1;
#pragma unroll
                for (int m = 1; m < 16; ++m) { v[m] = cmul(buf[m * qs], wm); wm = cmul(wm, w1); }
                fft16<true>(v);
#pragma unroll
                for (int l = 0; l < 16; ++l) buf[l * qs] = v[l];
                LOADER_FENCE(); }
        }
        __syncthreads(); }
}
static_assert(2 * SEQ == 512 || 2 * SEQ == 8192, "FFT size must be 2*16^k");
static_assert(2 * CTXL == 512 || 2 * CTXL == 8192, "FFT size must be 2*16^k");
constexpr int HBUF = (2 * SEQ + (2 * SEQ) / 32 + 8);
constexpr int HPT = (SEQ + NT - 1) / NT;
__device__ __forceinline__ void hy_conv8(const half_t* p, int t0, int L, float w0, float w1, float w2, float bsv, float (&o)[8]) {
    const half8 m = *(const half8*)(p + t0);
    float e[10]; e[0] = t0 > 0 ? (float)p[t0 - 1] : 0.f; e[9] = t0 + 8 < L ? (float)p[t0 + 8] : 0.f;
#pragma unroll
    for (int i = 0; i < 8; ++i) e[i + 1] = (float)m[i];
#pragma unroll
    for (int i = 0; i < 8; ++i) o[i] = w0 * e[i] + w1 * e[i + 1] + w2 * e[i + 2] + bsv;
}
template <int NS> __device__ __forceinline__ void hyena_seg_t(const Frame& F, int layer, int c, const int seg) {
    cplx* bufA = (cplx*)F.smem;
    cplx* bufB = bufA + HBUF;
    float* red = (float*)(bufB + HBUF);
    const int tid = F.tid;
    const float* cwp = F.in(I_HCW) + layer * 3 * 768; const float* cbp = F.in(I_HCB) + layer * 768;
    {
        const int L = seg == 0 ? SEQ : CTXL, N = 2 * L;
        const half_t* hyt = (const half_t*)(F.ws + WS_HYT) + (seg == 0 ? 0 : (size_t)NB * 768 * SEQ);
        float* z1 = (float*)(F.ws + WS_XN) + (seg == 0 ? 0 : (size_t)NB * 256 * SEQ);
        float* yht = (float*)(F.ws + WS_YHT) + (seg == 0 ? 0 : (size_t)NB * 256 * SEQ);
        const float* ft = (const float*)(F.ws + WS_FT) + (seg == 0 ? (size_t)layer * 256 * 4 * SEQ : (size_t)2 * 256 * 4 * SEQ);
        for (int order = 0; order < 2; ++order) {
            const float* hfw = ft + ((size_t)(c * 2 + order) * 2 + 0) * L; const float* hbw = ft + ((size_t)(c * 2 + order) * 2 + 1) * L;
            float asum = 0.f;
            for (int i_ = tid; i_ < N; i_ += NT) { int i = i_; OPAQUE_I(i); const float v = i < L ? hfw[i] : (i == L ? 0.f : hbw[N - i]); bufA[PADI(i)] = cplx{v, 0.f}; asum += fabsf(v); }
            asum = wave_sum(asum);
            if (F.lane == 0) red[F.wave] = asum;
            __syncthreads();
            float tot = 0.f; for (int w = 0; w < NT / 64; ++w) tot += red[w];
            fft_fwd16<1>(bufA, bufA, N, tid);
            half4 Hh[HPT];
            const float hs = 1.0f / tot, invN = 1.0f / (float)N;
#pragma unroll
            for (int k = 0; k < HPT; ++k) { int i = tid + k * NT; OPAQUE_I(i); half4 hv;
                if (i < N / 2) { const cplx a = bufA[PADI(2 * i)], b_ = bufA[PADI(2 * i + 1)]; const cplx s = cadd(a, b_), d = csub(a, b_);
                    hv[0] = (half_t)(s.x * hs); hv[1] = (half_t)(s.y * hs); hv[2] = (half_t)(d.x * hs); hv[3] = (half_t)(d.y * hs); }
                else { hv[0] = hv[1] = hv[2] = hv[3] = (half_t)0.f; }
                Hh[k] = hv; LOADER_FENCE(); }
            __syncthreads();
            const int gch = 256 * (order + 1) + c;
            for (int pr = 0; pr < NB / 2; pr += NS) {
#pragma unroll
                for (int st = 0; st < NS; ++st) { cplx* buf = st == 0 ? bufA : bufB; const int b0 = 2 * (pr + st), b1 = b0 + 1;
                    const float vw0 = cwp[c], vw1 = cwp[768 + c], vw2 = cwp[1536 + c], vb = cbp[c];
                    const half_t* v0p = hyt + ((size_t)b0 * 768 + c) * L; const half_t* v1p = hyt + ((size_t)b1 * 768 + c) * L;
                    const float* z0q = z1 + ((size_t)b0 * 256 + c) * L; const float* z1q = z1 + ((size_t)b1 * 256 + c) * L;
                    for (int t0_ = tid * 8; t0_ < N; t0_ += NT * 8) { int t0 = t0_; OPAQUE_I(t0);
                        if (t0 < L) { float za[8], zb[8];
                            if (order == 0) { hy_conv8(v0p, t0, L, vw0, vw1, vw2, vb, za); hy_conv8(v1p, t0, L, vw0, vw1, vw2, vb, zb); }
                            else {
#pragma unroll
                                for (int i = 0; i < 8; ++i) { za[i] = z0q[t0 + i]; zb[i] = z1q[t0 + i]; } }
#pragma unroll
                            for (int i = 0; i < 8; ++i) buf[PADI(t0 + i)] = cplx{za[i], zb[i]}; }
                        else {
#pragma unroll
                            for (int i = 0; i < 8; ++i) buf[PADI(t0 + i)] = cplx{0.f, 0.f}; }
                        LOADER_FENCE();
                    } }
                __syncthreads();
                fft_fwd16<NS>(bufA, bufB, N, tid);
#pragma unroll
                for (int st = 0; st < NS; ++st) { cplx* buf = st == 0 ? bufA : bufB;
#pragma unroll
                    for (int k = 0; k < HPT; ++k) { int i = tid + k * NT; OPAQUE_I(i);
                        if (i < N / 2) { const cplx a = buf[PADI(2 * i)], b_ = buf[PADI(2 * i + 1)];
                            const cplx h0{(float)Hh[k][0] * invN, (float)Hh[k][1] * invN}, h1{(float)Hh[k][2] * invN, (float)Hh[k][3] * invN};
                            const cplx s = cmul(cadd(a, b_), h0), d = cmul(csub(a, b_), h1);
                            buf[PADI(2 * i)] = cadd(s, d); buf[PADI(2 * i + 1)] = csub(s, d); }
                        LOADER_FENCE(); } }
                __syncthreads();
                fft_inv16<NS>(bufA, bufB, N, tid);
#pragma unroll
                for (int st = 0; st < NS; ++st) { cplx* buf = st == 0 ? bufA : bufB; const int b0 = 2 * (pr + st), b1 = b0 + 1;
                    const float gw0 = cwp[gch], gw1 = cwp[768 + gch], gw2 = cwp[1536 + gch], gb = cbp[gch];
                    const float vw0 = cwp[c], vw1 = cwp[768 + c], vw2 = cwp[1536 + c], vb = cbp[c];
                    const float skip = F.in(I_HSKIP)[(layer * 2 + order) * 256 + c];
                    const half_t* v0p = hyt + ((size_t)b0 * 768 + c) * L; const half_t* v1p = hyt + ((size_t)b1 * 768 + c) * L;
                    const float* z0q = z1 + ((size_t)b0 * 256 + c) * L; const float* z1q = z1 + ((size_t)b1 * 256 + c) * L;
                    const half_t* g0p = hyt + ((size_t)b0 * 768 + gch) * L; const half_t* g1p = hyt + ((size_t)b1 * 768 + gch) * L;
                    float* d0 = (order == 0 ? z1 : yht) + ((size_t)b0 * 256 + c) * L; float* d1 = (order == 0 ? z1 : yht) + ((size_t)b1 * 256 + c) * L;
                    for (int t0_ = tid * 8; t0_ < L; t0_ += NT * 8) { int t0 = t0_; OPAQUE_I(t0);
                        float za[8], zb[8], ga[8], gb_[8];
                        if (order == 0) { hy_conv8(v0p, t0, L, vw0, vw1, vw2, vb, za); hy_conv8(v1p, t0, L, vw0, vw1, vw2, vb, zb); }
                        else {
#pragma unroll
                            for (int i = 0; i < 8; ++i) { za[i] = z0q[t0 + i]; zb[i] = z1q[t0 + i]; } }
                        hy_conv8(g0p, t0, L, gw0, gw1, gw2, gb, ga); hy_conv8(g1p, t0, L, gw0, gw1, gw2, gb, gb_);
                        f32x4 oa[2], ob[2];
#pragma unroll
                        for (int i = 0; i < 8; ++i) { const cplx y = buf[PADI(t0 + i)]; oa[i >> 2][i & 3] = ga[i] * (y.x + skip * za[i]); ob[i >> 2][i & 3] = gb_[i] * (y.y + skip * zb[i]); }
                        *(f32x4*)(d0 + t0) = oa[0]; *(f32x4*)(d0 + t0 + 4) = oa[1]; *(f32x4*)(d1 + t0) = ob[0]; *(f32x4*)(d1 + t0 + 4) = ob[1];
                        LOADER_FENCE();
                    } }
                __syncthreads();
            }
        }
    }
}
__device__ __forceinline__ void hyena_channel(const Frame& F, int layer, int c) {
    constexpr int NS = (NB % 4 == 0) ? 2 : 1;
    for (int seg = 0; seg < (layer == 0 ? 2 : 1); ++seg) hyena_seg_t<NS>(F, layer, c, seg);
}
__device__ __forceinline__ int queue_pull(const Frame& F, unsigned* head) {
    int* slot = (int*)(F.smem + LDS_BYTES - 64);
    __syncthreads();
    if (F.tid == 0) *slot = (int)atomicAdd(head, 1u);
    __syncthreads();
    const int v = *slot;
    return v;
}
__device__ __forceinline__ void phase_mixers(const Frame& F, int layer) {
    const int bid = blockIdx.x;
    constexpr int NSCAN = 2 * NB * 6 * 2;
    unsigned* qhead = (unsigned*)(F.ws + WS_CTL) + CW_QUE + layer * 128;
    if (bid < NSCAN) {
        const int k = bid >> 1, kind = bid & 1, dir = k % 2, h = (k / 2) % 6, b = k / 12;
        if (kind == 0) ssd_block(F, layer, b, h, dir); else mlstm_block(F, layer, b, h, dir);
    }
    for (;;) { const int c = queue_pull(F, qhead); if (c >= 256) break; hyena_channel(F, layer, c); }
    for (;;) { const int it = queue_pull(F, qhead + 64); if (it >= IT_TMOE) break; moe_transpose_item(F, layer, it); }
}

__device__ __forceinline__ void phase_combine(const Frame& F, int layer) {
    const int nrows = layer == 0 ? TT : TL;
    const half_t* u16 = (const half_t*)(F.ws + WS_U16);
    const half_t* yf = (const half_t*)(F.ws + WS_YF); const half_t* yb = yf + (size_t)TT * 384; const half_t* hf = yb + (size_t)TT * 384; const half_t* hb = hf + (size_t)TT * 384;
    half_t* yl = (half_t*)(F.ws + WS_XN);
    const float* snw = F.in(I_SNW) + layer * 384; const float* mnw = F.in(I_MNW) + layer * 384;
    const int lane = F.lane, k8 = (lane < 48 ? lane : 0) * 8, nwaves = gridDim.x * (NT / 64);
    f32x4 sw[2], mw[2];
#pragma unroll
    for (int q = 0; q < 2; ++q) { sw[q] = *(const f32x4*)(snw + k8 + q * 4); mw[q] = *(const f32x4*)(mnw + k8 + q * 4); }
    int row = blockIdx.x * (NT / 64) + F.wave;
    half8 a[6];
#define COMB_LOAD(dst, r) { const size_t ro = (size_t)(r); dst[0] = *(const half8*)(yf + ro * 384 + k8); dst[1] = *(const half8*)(yb + ro * 384 + k8); dst[2] = *(const half8*)(u16 + ro * UW + k8); \
        dst[3] = *(const half8*)(hf + ro * 384 + k8); dst[4] = *(const half8*)(hb + ro * 384 + k8); dst[5] = *(const half8*)(u16 + ro * UW + 2176 + k8); }
    if (row < nrows) COMB_LOAD(a, row)
    for (; row < nrows; row += nwaves) {
        const int nrow = row + nwaves;
        half8 an[6];
        if (nrow < nrows) COMB_LOAD(an, nrow)
        const size_t ro = (size_t)row;
        float g[8], hv[8]; float ss = 0.f, hs = 0.f;
#pragma unroll
        for (int i = 0; i < 8; ++i) { g[i] = ((float)a[0][i] + (float)a[1][i]) * fsilu((float)a[2][i]); ss += g[i] * g[i]; hv[i] = (float)a[3][i] + (float)a[4][i]; hs += hv[i]; }
        if (lane >= 48) ss = 0.f;
        ss = wave_sum(ss);
        hs += __shfl_xor(hs, 1); hs += __shfl_xor(hs, 2); hs += __shfl_xor(hs, 4);
        const float mu = hs * (1.0f / 64.f);
        float vs = 0.f;
#pragma unroll
        for (int i = 0; i < 8; ++i) { hv[i] -= mu; vs += hv[i] * hv[i]; }
        vs += __shfl_xor(vs, 1); vs += __shfl_xor(vs, 2); vs += __shfl_xor(vs, 4);
        const float rs = 1.0f / sqrtf(ss * (1.0f / 384.f) + EPSF), rstd = 1.0f / sqrtf(vs * (1.0f / 64.f) + EPSF);
        if (lane < 48) { half8 o1, o2;
#pragma unroll
            for (int i = 0; i < 8; ++i) { o1[i] = (half_t)(g[i] * rs * sw[i >> 2][i & 3]); o2[i] = (half_t)(hv[i] * rstd * mw[i >> 2][i & 3] / (1.0f + fexp(-(float)a[5][i]))); }
            *(half8*)(yl + ro * D + k8) = o1; *(half8*)(yl + ro * D + 640 + k8) = o2; }
#pragma unroll
        for (int i = 0; i < 6; ++i) a[i] = an[i];
    }
#undef COMB_LOAD
    { const int ntile = nrows / 32, hbk = blockIdx.x * 2 + (F.tid >> 8), c = F.tid & 255;
      for (int tl = hbk; tl < ntile; tl += gridDim.x * 2) {
          const int row0 = tl * 32; const bool isl = row0 < TL; const int L = isl ? SEQ : CTXL; const int rc = isl ? row0 : row0 - TL; const int b = rc / L, t0 = rc % L;
          const float* src = (const float*)(F.ws + WS_YHT) + (isl ? 0 : (size_t)NB * 256 * SEQ) + ((size_t)b * 256 + c) * L + t0;
          f32x4 v[8];
#pragma unroll
          for (int q = 0; q < 8; ++q) v[q] = *(const f32x4*)(src + q * 4);
#pragma unroll
          for (int i = 0; i < 32; ++i) yl[(size_t)(row0 + i) * D + 384 + c] = (half_t)v[i >> 2][i & 3]; } }
}

struct EpiOutproj {
    static constexpr bool PERM = true;
    Frame F; int layer;
    __device__ __forceinline__ void operator()(const f32x4 (&acc)[2][2][4][2], const g8::Unit& u, int wr, int wc, int fr, int fq) const {
#pragma unroll
        for (int ai = 0; ai < 2; ++ai)
#pragma unroll
            for (int m = 0; m < 4; ++m) {
                const int srow = u.pm * 256 + ai * 128 + wr * 64 + m * 16 + fr;
                int row = srow;
                if (layer == 1 && srow < TL) { const int b = srow / SEQ, s = srow % SEQ; row = b * SEQ + (s % GROWS) * GW + s / GROWS; }
                const float* g1 = modp(F, layer, row_mod(row), 2);
                const float* xi = F.xrow_in(layer, row); float* xo = F.xrow(row);
#pragma unroll
                for (int bj = 0; bj < 2; ++bj) { const int c0 = u.pn * 256 + bj * 128 + wc * 32 + 8 * fq;
                    const f32x4 x0 = *(const f32x4*)(xi + c0), x1 = *(const f32x4*)(xi + c0 + 4), g0 = *(const f32x4*)(g1 + c0), g1v = *(const f32x4*)(g1 + c0 + 4);
                    *(f32x4*)(xo + c0) = x0 + g0 * acc[ai][bj][m][0]; *(f32x4*)(xo + c0 + 4) = x1 + g1v * acc[ai][bj][m][1]; }
            }
    }
};
__device__ __forceinline__ void outproj_ctx_tiles(const Frame& F, int layer) {
    const half_t* yl = (const half_t*)(F.ws + WS_XN) + (size_t)TL * D;
    const half_t* wt = (const half_t*)(F.ws + WS_WOUT) + (size_t)layer * D * D;
    const int lane = F.lane, wave = F.wave, r = lane & 15, kq = (lane >> 4) * 8;
    const int ntile = (TC / 64) * (D / 64);
    for (int t = blockIdx.x; t < ntile; t += gridDim.x) {
        const int m0 = (t / (D / 64)) * 64, n0 = (t % (D / 64)) * 64;
        const int mt = wave >> 1, nt0 = (wave & 1) * 2;
        const half_t* ap = yl + (size_t)(m0 + mt * 16 + r) * D + kq;
        const half_t* bp0 = wt + (size_t)(n0 + nt0 * 16 + r) * D + kq; const half_t* bp1 = bp0 + (size_t)16 * D;
        f32x4 c0 = {0.f, 0.f, 0.f, 0.f}, c1 = {0.f, 0.f, 0.f, 0.f};
#pragma unroll 1
        for (int kb = 0; kb < D; kb += 256) {
            half8 a[8], b0[8], b1[8];
#pragma unroll
            for (int q = 0; q < 8; ++q) { a[q] = *(const half8*)(ap + kb + q * 32); b0[q] = *(const half8*)(bp0 + kb + q * 32); b1[q] = *(const half8*)(bp1 + kb + q * 32); }
#pragma unroll
            for (int q = 0; q < 8; ++q) { c0 = mfma16(a[q], b0[q], c0); c1 = mfma16(a[q], b1[q], c1); }
        }
#pragma unroll
        for (int i = 0; i < 4; ++i) {
            const int row = TL + m0 + mt * 16 + (lane >> 4) * 4 + i;
            const float* g1 = modp(F, layer, NB, 2); const float* xi = F.xrow_in(layer, row); float* xo = F.xrow(row);
            const int ca = n0 + nt0 * 16 + r, cb = ca + 16;
            xo[ca] = xi[ca] + g1[ca] * c0[i]; xo[cb] = xi[cb] + g1[cb] * c1[i];
        }
    }
}
__device__ __forceinline__ void phase_outproj(const Frame& F, int layer) {
    if (layer == 0) outproj_ctx_tiles(F, layer);
    g8::DenseSched S; S.abase = (const char*)(F.ws + WS_XN); S.bbase = (const char*)((const half_t*)(F.ws + WS_WOUT) + (size_t)layer * D * D); S.K = D; S.nM = TL / 256; S.nN = D / 256; S.G = gridDim.x; S.c = blockIdx.x;
    EpiOutproj E{F, layer};
    g8::gemm_phase(F.smem, D, S, E);
}

constexpr int RLD = D + 8;
__device__ __forceinline__ void phase_router(const Frame& F, int layer, bool dry = false) {
    const int nrows = layer == 0 ? TT : TL, total = nrows / 16;
    half_t* Th = (half_t*)F.smem;
    half_t* Tl = Th + 16 * RLD;
    float* PART = (float*)(Tl + 16 * RLD);
    float* LG = PART + 8 * 16 * 48;
    half_t* tb = (half_t*)(F.ws + WS_XN);
    unsigned* cnt = (unsigned*)(F.ws + WS_CTL) + CW_CNT + layer * 64 * CSTR;
    int* list = (int*)(F.ws + WS_LIST); float* pw = (float*)(F.ws + WS_PW);
    const float* nw = F.in(I_N2W) + layer * D;
    const half_t* wr = (const half_t*)(F.ws + WS_WR) + (size_t)layer * 2 * 48 * D;
    const int lane = F.lane, wave = F.wave, r = lane & 15, kq = (lane >> 4) * 8, kb = wave * 128;
    half8 bh[3][4];
#pragma unroll
    for (int nt = 0; nt < 3; ++nt)
#pragma unroll
        for (int ks = 0; ks < 4; ++ks) { const size_t o = (size_t)(nt * 16 + r) * D + kb + ks * 32 + kq; bh[nt][ks] = *(const half8*)(wr + o); }
    int mc = -1; f32x4 g[4], s4[4];
    int it = blockIdx.x;
    f32x4 v[2][4];
    if (it < total) {
#pragma unroll
        for (int rr = 0; rr < 2; ++rr) { const float* x = F.xrow(it * 16 + wave * 2 + rr);
#pragma unroll
            for (int q = 0; q < 4; ++q) v[rr][q] = *(const f32x4*)(x + q * 256 + lane * 4); } }
    int p_row = -1, p_ea = 0, p_eb = 0; unsigned p_pa = 0, p_pb = 0; float p_w0 = 0.f, p_w1 = 0.f;
    for (; it < total; it += gridDim.x) {
        const int row0 = it * 16, nit = it + gridDim.x;
        f32x4 vn[2][4];
        if (nit < total) {
#pragma unroll
            for (int rr = 0; rr < 2; ++rr) { const float* x = F.xrow(nit * 16 + wave * 2 + rr);
#pragma unroll
                for (int q = 0; q < 4; ++q) vn[rr][q] = *(const f32x4*)(x + q * 256 + lane * 4); } }
        { const int m = row_mod(row0);
          if (m != mc) { mc = m; const float* sh = modp(F, layer, m, 3); const float* scl = modp(F, layer, m, 4);
#pragma unroll
              for (int q = 0; q < 4; ++q) { const int k = q * 256 + lane * 4; const f32x4 a = *(const f32x4*)(nw + k), b = *(const f32x4*)(scl + k); s4[q] = *(const f32x4*)(sh + k);
#pragma unroll
                  for (int e = 0; e < 4; ++e) g[q][e] = a[e] * (1.0f + b[e]); } } }
#pragma unroll
        for (int rr = 0; rr < 2; ++rr) {
            float ss = 0.f;
#pragma unroll
            for (int q = 0; q < 4; ++q) ss += v[rr][q][0] * v[rr][q][0] + v[rr][q][1] * v[rr][q][1] + v[rr][q][2] * v[rr][q][2] + v[rr][q][3] * v[rr][q][3];
            ss = wave_sum(ss);
            const float rs = 1.0f / sqrtf(ss * (1.0f / D) + EPSF);
            const int lr = wave * 2 + rr, row = row0 + lr;
#pragma unroll
            for (int q = 0; q < 4; ++q) { const int k = q * 256 + lane * 4; half4 h, l;
#pragma unroll
                for (int e = 0; e < 4; ++e) { const float tv = v[rr][q][e] * rs * g[q][e] + s4[q][e]; h[e] = (half_t)tv; l[e] = (half_t)((tv - (float)h[e]) * 2048.f); }
                *(half4*)(tb + (size_t)row * D + k) = h; *(half4*)(Th + lr * RLD + k) = h; *(half4*)(Tl + lr * RLD + k) = l; }
        }
        __syncthreads();
        { f32x4 ah[3], al[3]; half8 bl[3][4];
#pragma unroll
          for (int nt = 0; nt < 3; ++nt)
#pragma unroll
              for (int ks = 0; ks < 4; ++ks) bl[nt][ks] = *(const half8*)(wr + (size_t)48 * D + (size_t)(nt * 16 + r) * D + kb + ks * 32 + kq);
#pragma unroll
          for (int nt = 0; nt < 3; ++nt) { ah[nt] = (f32x4){0.f, 0.f, 0.f, 0.f}; al[nt] = (f32x4){0.f, 0.f, 0.f, 0.f}; }
#pragma unroll
          for (int ks = 0; ks < 4; ++ks) {
              const half8 a_h = *(const half8*)(Th + r * RLD + kb + ks * 32 + kq), a_l = *(const half8*)(Tl + r * RLD + kb + ks * 32 + kq);
#pragma unroll
              for (int nt = 0; nt < 3; ++nt) { ah[nt] = mfma16(a_h, bh[nt][ks], ah[nt]); al[nt] = mfma16(a_l, bh[nt][ks], al[nt]); al[nt] = mfma16(a_h, bl[nt][ks], al[nt]); }
          }
#pragma unroll
          for (int nt = 0; nt < 3; ++nt)
#pragma unroll
              for (int i = 0; i < 4; ++i) PART[(wave * 16 + (lane >> 4) * 4 + i) * 48 + nt * 16 + r] = ah[nt][i] + al[nt][i] * (1.0f / 2048.f); }
        __syncthreads();
        for (int o = F.tid; o < 16 * 48; o += NT) { const int col = o % 48; float sum = 0.f;
#pragma unroll
            for (int w = 0; w < 8; ++w) sum += PART[w * 16 * 48 + o];
            float bias = 0.f; if (col < 4) bias = F.in(I_GRB)[layer * 4 + col]; else if (col < 36) bias = F.in(I_ERB)[layer * 32 + col - 4];
            LG[o] = sum + bias; }
        __syncthreads();
        if (F.tid < 16) {
            if (p_row >= 0 && !dry) { list[(size_t)(p_ea * 2 + 0) * LCAP + p_pa] = p_row * 2 + 0; list[(size_t)(p_eb * 2 + 1) * LCAP + p_pb] = p_row * 2 + 1; pw[p_row * 2 + 0] = p_w0; pw[p_row * 2 + 1] = p_w1; }
            const int row = row0 + F.tid; const float* lg = LG + F.tid * 48;
            int gi = 0; float gm = lg[0];
            for (int q = 1; q < 4; ++q) if (lg[q] > gm) { gm = lg[q]; gi = q; }
            float gs = 0.f; for (int q = 0; q < 4; ++q) gs += expf(lg[q] - gm);
            const float grp_p = 1.0f / gs;
            const float* el = lg + 4 + gi * 8;
            int i0 = 0; float e0 = el[0];
            for (int q = 1; q < 8; ++q) if (el[q] > e0) { e0 = el[q]; i0 = q; }
            int i1 = -1; float e1 = -3.0e38f;
            for (int q = 0; q < 8; ++q) if (q != i0 && el[q] > e1) { e1 = el[q]; i1 = q; }
            const float p1 = expf(e1 - e0);
            p_w0 = grp_p * (1.0f / (1.0f + p1)); p_w1 = grp_p * (p1 / (1.0f + p1));
            p_ea = gi * 8 + i0; p_eb = gi * 8 + i1; p_row = row;
            if (!dry) { p_pa = atomicAdd(&cnt[(p_ea * 2 + 0) * CSTR], 1u); p_pb = atomicAdd(&cnt[(p_eb * 2 + 1) * CSTR], 1u); }
        }
#pragma unroll
        for (int rr = 0; rr < 2; ++rr)
#pragma unroll
            for (int q = 0; q < 4; ++q) v[rr][q] = vn[rr][q];
    }
    if (F.tid < 16 && p_row >= 0 && !dry) { list[(size_t)(p_ea * 2 + 0) * LCAP + p_pa] = p_row * 2 + 0; list[(size_t)(p_eb * 2 + 1) * LCAP + p_pb] = p_row * 2 + 1; pw[p_row * 2 + 0] = p_w0; pw[p_row * 2 + 1] = p_w1; }
    __syncthreads();
}

constexpr int MOE_PRE_OFF = g8::STAGE_BYTES;
struct MoeSchedA {
    const char* abase; const char* wbase; const int* pre; const unsigned* cnt; const int* list; int G, c;
    __device__ __forceinline__ int entry(const g8::Unit& u, int r) const { const int rc = r < u.n ? r : 0; return rc < u.c0 ? list[(size_t)(u.e * 2) * LCAP + rc] : list[(size_t)(u.e * 2 + 1) * LCAP + (rc - u.c0)]; }
    __device__ __forceinline__ bool next(int i, g8::Unit& u) const {
        const int L = i * G + c; if (L >= pre[32]) return false;
        int e = 0; while (L >= pre[e + 1]) ++e;
        const int loc = L - pre[e]; u.e = e; u.c0 = (int)cnt[(e * 2) * CSTR]; u.n = u.c0 + (int)cnt[(e * 2 + 1) * CSTR]; u.pm = loc >> 1; u.pn = loc & 1; return true;
    }
    __device__ __forceinline__ unsigned a_off(const g8::Unit& u, int r) const { return (unsigned)(entry(u, u.pm * 256 + r) >> 1) * (unsigned)(D * 2); }
    __device__ __forceinline__ const char* b_half(const g8::Unit& u, int h) const { return wbase + ((size_t)u.e * 3 * 262144 + (size_t)h * 262144 + (size_t)u.pn * 128 * D) * 2; }
};
struct EpiMoeA {
    static constexpr bool PERM = true;
    MoeSchedA S; const float* pw; half_t* hid;
    __device__ __forceinline__ void operator()(const f32x4 (&acc)[2][2][4][2], const g8::Unit& u, int wr, int wc, int fr, int fq) const {
        int pid[8]; float w[8];
#pragma unroll
        for (int g = 0; g < 8; ++g) pid[g] = S.entry(u, u.pm * 256 + (g >> 2) * 128 + wr * 64 + (g & 3) * 16 + fr);
#pragma unroll
        for (int g = 0; g < 8; ++g) w[g] = pw[pid[g]];
        const int f = u.pn * 128 + wc * 32 + 8 * fq;
#pragma unroll
        for (int ai = 0; ai < 2; ++ai)
#pragma unroll
            for (int m = 0; m < 4; ++m) {
                const int rr = u.pm * 256 + ai * 128 + wr * 64 + m * 16 + fr;
                if (rr < u.n) { half8 h;
#pragma unroll
                    for (int n = 0; n < 2; ++n) { const f32x4 g = acc[ai][0][m][n], up = acc[ai][1][m][n];
#pragma unroll
                        for (int i = 0; i < 4; ++i) h[n * 4 + i] = (half_t)(fsilu(g[i]) * up[i] * w[ai * 4 + m]); }
                    *(half8*)(hid + (size_t)pid[ai * 4 + m] * 256 + f) = h; }
            }
    }
};
__device__ __forceinline__ void phase_moe_a(const Frame& F, int layer) {
    int* pre = (int*)(F.smem + MOE_PRE_OFF);
    const unsigned* cnt = (const unsigned*)(F.ws + WS_CTL) + CW_CNT + layer * 64 * CSTR;
    if (F.tid == 0) { int s = 0; for (int e = 0; e < 32; ++e) { pre[e] = s; s += (((int)(cnt[(e * 2) * CSTR] + cnt[(e * 2 + 1) * CSTR]) + 255) / 256) * 2; } pre[32] = s; }
    __syncthreads();
    MoeSchedA S; S.abase = (const char*)(F.ws + WS_XN); S.wbase = (const char*)(F.ws + WS_WMOE); S.pre = pre; S.cnt = cnt; S.list = (const int*)(F.ws + WS_LIST); S.G = gridDim.x; S.c = blockIdx.x;
    EpiMoeA E{S, (const float*)(F.ws + WS_PW), (half_t*)(F.ws + WS_U16)};
    g8::gemm_phase(F.smem, D, S, E);
    __syncthreads();
}
struct MoeSchedB {
    const char* abase; const char* wbase; const int* pre; const unsigned* cnt; const int* list; int G, c;
    __device__ __forceinline__ bool next(int i, g8::Unit& u) const {
        const int L = i * G + c; if (L >= pre[64]) return false;
        int l = 0; while (L >= pre[l + 1]) ++l;
        const int loc = L - pre[l]; u.e = l >> 1; u.c0 = l & 1; u.n = (int)cnt[(l) * CSTR]; u.pm = loc >> 2; u.pn = loc & 3; return true;
    }
    __device__ __forceinline__ int entry(const g8::Unit& u, int rr) const { return list[(size_t)(u.e * 2 + u.c0) * LCAP + (rr < u.n ? rr : 0)]; }
    __device__ __forceinline__ unsigned a_off(const g8::Unit& u, int r) const { return (unsigned)entry(u, u.pm * 256 + r) * 512u; }
    __device__ __forceinline__ const char* b_half(const g8::Unit& u, int h) const { return wbase + ((size_t)u.e * 3 * 262144 + 2 * 262144 + (size_t)(u.pn * 256 + h * 128) * 256) * 2; }
};
struct EpiMoeB {
    static constexpr bool PERM = true;
    MoeSchedB S; Frame F; int layer;
    __device__ __forceinline__ void operator()(const f32x4 (&acc)[2][2][4][2], const g8::Unit& u, int wr, int wc, int fr, int fq) const {
        int row[8];
#pragma unroll
        for (int g = 0; g < 8; ++g) row[g] = S.entry(u, u.pm * 256 + (g >> 2) * 128 + wr * 64 + (g & 3) * 16 + fr) >> 1;
        half_t* xab = (half_t*)(F.ws + WS_U16 + XAB_OFF) + (size_t)u.c0 * TT * D;
#pragma unroll
        for (int ai = 0; ai < 2; ++ai)
#pragma unroll
            for (int m = 0; m < 4; ++m) {
                const int rr = u.pm * 256 + ai * 128 + wr * 64 + m * 16 + fr;
                if (rr < u.n) { const int rw = row[ai * 4 + m]; half_t* xo = xab + (size_t)rw * D;
#pragma unroll
                    for (int bj = 0; bj < 2; ++bj) { const int d = u.pn * 256 + bj * 128 + wc * 32 + 8 * fq;
                        const f32x4 a0 = acc[ai][bj][m][0], a1 = acc[ai][bj][m][1];
                        half8 h; h[0] = (half_t)a0[0]; h[1] = (half_t)a0[1]; h[2] = (half_t)a0[2]; h[3] = (half_t)a0[3]; h[4] = (half_t)a1[0]; h[5] = (half_t)a1[1]; h[6] = (half_t)a1[2]; h[7] = (half_t)a1[3];
                        *(half8*)(xo + d) = h; } }
            }
    }
};
__device__ __forceinline__ void phase_moe_b(const Frame& F, int layer) {
    int* pre = (int*)(F.smem + MOE_PRE_OFF);
    const unsigned* cnt = (const unsigned*)(F.ws + WS_CTL) + CW_CNT + layer * 64 * CSTR;
    if (F.tid == 0) { int s = 0; for (int l = 0; l < 64; ++l) { pre[l] = s; s += (((int)cnt[(l) * CSTR] + 255) / 256) * 4; } pre[64] = s; }
    __syncthreads();
    MoeSchedB S; S.abase = (const char*)(F.ws + WS_U16); S.wbase = (const char*)(F.ws + WS_WMOE); S.pre = pre; S.cnt = cnt; S.list = (const int*)(F.ws + WS_LIST); S.G = gridDim.x; S.c = blockIdx.x;
    EpiMoeB E{S, F, layer};
    g8::gemm_phase(F.smem, 256, S, E);
    __syncthreads();
}

__device__ __forceinline__ void phase_final(const Frame& F) {
    const float* fw = F.in(I_FNW);
    const int lane = F.lane, nwaves = gridDim.x * (NT / 64);
    f32x4 w4[4];
#pragma unroll
    for (int q = 0; q < 4; ++q) w4[q] = *(const f32x4*)(fw + q * 256 + lane * 4);
    int row = blockIdx.x * (NT / 64) + F.wave;
    f32x4 v[4];
    if (row < TL) {
#pragma unroll
        for (int q = 0; q < 4; ++q) v[q] = *(const f32x4*)(F.P->out + (size_t)row * D + q * 256 + lane * 4); }
    for (; row < TL; row += nwaves) {
        const int nrow = row + nwaves;
        f32x4 vn[4];
        if (nrow < TL) {
#pragma unroll
            for (int q = 0; q < 4; ++q) vn[q] = *(const f32x4*)(F.P->out + (size_t)nrow * D + q * 256 + lane * 4); }
        { const half_t* xa = (const half_t*)(F.ws + WS_U16 + XAB_OFF) + (size_t)row * D; const half_t* xb = xa + (size_t)TT * D;
          const float* g5 = modp(F, 1, row_mod(row), 5);
#pragma unroll
          for (int q = 0; q < 4; ++q) { const int k = q * 256 + lane * 4; const half4 a4 = *(const half4*)(xa + k), b4 = *(const half4*)(xb + k); const f32x4 gv = *(const f32x4*)(g5 + k);
#pragma unroll
              for (int e = 0; e < 4; ++e) v[q][e] += gv[e] * ((float)a4[e] + (float)b4[e]); } }
        float ss = 0.f;
#pragma unroll
        for (int q = 0; q < 4; ++q) ss += v[q][0] * v[q][0] + v[q][1] * v[q][1] + v[q][2] * v[q][2] + v[q][3] * v[q][3];
        ss = wave_sum(ss);
        const float rs = 1.0f / sqrtf(ss * (1.0f / D) + EPSF);
#pragma unroll
        for (int q = 0; q < 4; ++q) *(f32x4*)(F.P->out + (size_t)row * D + q * 256 + lane * 4) = v[q] * rs * w4[q];
#pragma unroll
        for (int q = 0; q < 4; ++q) v[q] = vn[q];
    }
}

constexpr int NPHASE = 1 + 2 * 9 + 1;
#ifndef ONLY
#define ONLY -1
#endif
#define EN(x) (ONLY < 0 || ONLY == (x))
__device__ __forceinline__ void run_phase(const Frame& F, int ph) {
    if (ph == 0) { if (EN(0)) phase_setup(F); return; }
    if (ph == NPHASE - 1) { if (EN(11)) phase_final(F); return; }
    const int layer = (ph - 1) / 9, k = (ph - 1) % 9;
    switch (k) {
        case 0: if (EN(1)) phase_norm1(F, layer); break;
        case 1: if (EN(2)) phase_inproj(F, layer); break;
        case 2: if (EN(10)) phase_act(F, layer); break;
        case 3: if (EN(3)) phase_mixers(F, layer); break;
        case 4: if (EN(4)) phase_combine(F, layer); break;
        case 5: if (EN(5)) phase_outproj(F, layer); break;
        case 6: if (EN(6)) phase_router(F, layer); break;
        case 7: if (EN(7)) phase_moe_a(F, layer); break;
        default: if (EN(8)) phase_moe_b(F, layer); break;
    }
}

#ifdef EMU
void mega(const Params* Pp) {
    Frame F; F.P = Pp; F.ws = Pp->ws; F.smem = emu_blk->smem; F.tid = threadIdx.x; F.lane = F.tid & 63; F.wave = F.tid >> 6;
    for (int ph = Pp->ph_lo; ph < Pp->ph_hi; ++ph) { run_phase(F, ph); __syncthreads(); }
}
#else
__global__ void __launch_bounds__(NT) mega(Params P) {
    extern __shared__ __attribute__((aligned(16))) unsigned char smem_dyn[];
    cg::grid_group grid = cg::this_grid();
    Frame F; F.P = (ParamsPtr)__builtin_amdgcn_kernarg_segment_ptr(); F.ws = P.ws; F.smem = smem_dyn; F.tid = threadIdx.x; F.lane = F.tid & 63; F.wave = F.tid >> 6;
    volatile LAS unsigned* bst = (volatile LAS unsigned*)(smem_dyn + LDS_BYTES - 16);
    if (F.tid < 4) bst[F.tid] = 0u;
    __syncthreads();
    XcdBarrier xb = xcd_barrier_post((unsigned*)(P.ws + WS_CTL) + CW_BAR, bst);
    if (P.ph_lo < 0) grid.sync();
#define DUP -1
#define AMP -1
#define PHASE_STEP(i) if (P.ph_lo <= (i) && (i) < P.ph_hi) { \
        unsigned long long t0_ = 0; if (AMP == (i)) t0_ = __builtin_amdgcn_s_memrealtime(); \
        run_phase(F, (i)); \
        if ((i) + 1 < P.ph_hi || AMP == (i)) xcd_barrier(xb); \
        if (AMP == (i)) { const unsigned long long t1_ = __builtin_amdgcn_s_memrealtime(); if (blockIdx.x == 0) { while (__builtin_amdgcn_s_memrealtime() - t1_ < t1_ - t0_) __builtin_amdgcn_s_sleep(8); } xcd_barrier(xb); } }
    PHASE_STEP(0) PHASE_STEP(1) PHASE_STEP(2) PHASE_STEP(3) PHASE_STEP(4) PHASE_STEP(5) PHASE_STEP(6) PHASE_STEP(7) PHASE_STEP(8) PHASE_STEP(9)
    PHASE_STEP(10) PHASE_STEP(11) PHASE_STEP(12) PHASE_STEP(13) PHASE_STEP(14) PHASE_STEP(15) PHASE_STEP(16) PHASE_STEP(17) PHASE_STEP(18) PHASE_STEP(19)
    static_assert(NPHASE == 20, "phase list");
}

extern "C" void kernel_launch(void* const* d_in, const int* in_sizes, int n_in, void* d_out, int out_size, void* d_ws, size_t ws_size, hipStream_t stream) {
    static int grid_blocks = 0;
    if (grid_blocks == 0) {
        if (n_in != 38 || out_size != TL * D || ws_size < WS_END) { fprintf(stderr, "kernel_launch: unexpected shapes (n_in %d out %d ws %zu need %zu)\n", n_in, out_size, ws_size, (size_t)WS_END); grid_blocks = -1; return; }
        int dev = 0, cus = 0, per_cu = 0;
        hipGetDevice(&dev);
        hipDeviceGetAttribute(&cus, hipDeviceAttributeMultiprocessorCount, dev);
        hipFuncSetAttribute((const void*)mega, hipFuncAttributeMaxDynamicSharedMemorySize, LDS_BYTES);
        hipOccupancyMaxActiveBlocksPerMultiprocessor(&per_cu, (const void*)mega, NT, LDS_BYTES);
        if (per_cu < 1) { fprintf(stderr, "kernel_launch: occupancy query says 0 blocks per CU\n"); grid_blocks = -1; return; }
        grid_blocks = cus;
    }
    if (grid_blocks < 0) return;
    if (hipMemsetAsync((char*)d_ws + WS_CTL, 0, CTL_BYTES, stream) != hipSuccess) { fprintf(stderr, "kernel_launch: memset failed\n"); return; }
    Params p{};
    for (int i = 0; i < 38; ++i) p.in[i] = (const float*)d_in[i];
    p.out = (float*)d_out; p.ws = (unsigned char*)d_ws; p.ph_lo = 0; p.ph_hi = NPHASE;
    void* args[] = {&p};
    hipError_t e = hipLaunchCooperativeKernel((const void*)mega, dim3(grid_blocks), dim3(NT), args, LDS_BYTES, stream);
    if (e != hipSuccess) fprintf(stderr, "cooperative launch failed: %s (grid %d)\n", hipGetErrorString(e), grid_blocks);
}
#endif
```

```cpp
#ifdef EMU
#include "gpuemu.h"
#else
#include <hip/hip_runtime.h>
#include <hip/hip_cooperative_groups.h>
#include <cstdio>
namespace cg = cooperative_groups;
#endif
#include <stdint.h>

#ifndef CFG_B
#define CFG_B 4
#endif
#ifndef CFG_SEQ
#define CFG_SEQ 4096
#endif
#ifndef CFG_CTX
#define CFG_CTX 256
#endif

typedef _Float16 half_t;
typedef _Float16 half8 __attribute__((ext_vector_type(8)));
typedef _Float16 half4 __attribute__((ext_vector_type(4)));
typedef float f32x4 __attribute__((ext_vector_type(4)));
struct cplx { float x, y; };

constexpr int D = 1024, NB = CFG_B, SEQ = CFG_SEQ, CTXL = CFG_CTX, GW = 64, GROWS = SEQ / GW;
constexpr int TL = NB * SEQ, TC = NB * CTXL, TT = TL + TC;
constexpr int NIN = 3364, NINP = 3584;
constexpr int UW = 2560;
constexpr int UGW = 36;
constexpr int NT = 512;
constexpr int TWN = 2 * SEQ > 2 * CTXL ? 2 * SEQ : 2 * CTXL;
constexpr int NMOD = 6 * D;
constexpr int LCAP = TT;
constexpr float EPSF = 1e-6f;

constexpr size_t al256(size_t x) { return (x + 255) / 256 * 256; }
constexpr size_t WS_CTL    = 0;
constexpr size_t WS_MOD    = 65536;
constexpr size_t WS_TW     = WS_MOD + al256(sizeof(float) * 2 * 5 * NMOD);
constexpr size_t WS_WIN    = WS_TW + al256(sizeof(cplx) * TWN);
constexpr size_t WS_WOUT   = WS_WIN + al256(2ull * 2 * NINP * D);
constexpr size_t WS_WMOE   = WS_WOUT + al256(2ull * 2 * D * D);
constexpr size_t WS_XC     = WS_WMOE + al256(2ull * 32 * 3 * 262144);
constexpr size_t WS_XN     = WS_XC + al256(4ull * TC * D);
constexpr size_t WS_U16    = WS_XN + al256(2ull * TT * D);
constexpr size_t WS_UG     = WS_U16 + al256(2ull * TT * UW);
constexpr size_t WS_HYT    = WS_UG + al256(4ull * TT * UGW);
constexpr size_t WS_YF     = WS_HYT + al256(2ull * NB * 768 * (SEQ + CTXL));
constexpr size_t WS_YHT    = WS_YF + al256(2ull * 4 * TT * 384);
constexpr size_t WS_FT     = WS_YHT + al256(4ull * NB * 256 * (SEQ + CTXL));
constexpr size_t WS_LIST   = WS_FT + al256(4ull * (2 * 256 * 4 * SEQ + 256 * 4 * CTXL));
constexpr size_t WS_PW     = WS_LIST + al256(4ull * 64 * LCAP);
constexpr size_t WS_WR     = WS_PW + al256(4ull * TT * 2);
constexpr size_t WS_HALO   = WS_WR + al256(2ull * 2 * 2 * 48 * D);
constexpr size_t WS_END    = WS_HALO + al256(2ull * (TT / 16) * 2 * 1408);
static_assert(4ull * NB * 256 * (SEQ + CTXL) <= 2ull * TT * D, "Z1 scratch must fit in the XN region");
static_assert(2ull * TT * 2 * 256 <= 2ull * TT * UW, "HID must fit in the U16 region");
constexpr size_t XAB_OFF = 2ull * TT * 2 * 256;
static_assert(XAB_OFF + 2ull * 2 * TT * D <= 2ull * TT * UW, "HID + XA + XB must fit in the U16 region");

constexpr int CW_CNT = 8192;
constexpr int CSTR = 64;
constexpr int CW_QUE = 256;
constexpr int CW_BAR = 1024;
constexpr size_t CTL_BYTES = 65536;

constexpr int LDS_BYTES = 156 * 1024;

struct Params {
    const float* in[38];
    float* out;
    unsigned char* ws;
    int ph_lo, ph_hi;
};

enum { I_X = 0, I_C, I_CTX, I_CCTX, I_WMOD, I_BMOD, I_N1W, I_N2W, I_WIN, I_WOUT, I_SCW, I_SCB, I_DTB, I_ALOG, I_SD, I_SNW,
       I_HCW, I_HCB, I_HW1, I_HB1, I_HW2, I_HB2, I_HW3, I_HFREQ, I_HDEC, I_HSKIP, I_MCW, I_MCB, I_MGB, I_MNW,
       I_GRW, I_GRB, I_ERW, I_ERB, I_MG, I_MU, I_MD, I_FNW };

__device__ __forceinline__ float siluf(float x) { return x / (1.0f + expf(-x)); }
__device__ __forceinline__ float sigmoidf_(float x) { return 1.0f / (1.0f + expf(-x)); }
__device__ __forceinline__ float softplusf_(float x) { return x > 20.f ? x : log1pf(expf(x)); }
__device__ __forceinline__ float logsigmoidf_(float x) { return fminf(x, 0.f) - log1pf(expf(-fabsf(x))); }

__device__ __forceinline__ float fsoftplus(float x) {
#ifdef EMU
    return x > 20.f ? x : log1pf(expf(x));
#else
    const float e = __expf(x);
    return x > 20.f ? x : (e < 1e-3f ? e * (1.0f - 0.5f * e) : __logf(1.0f + e));
#endif
}
__device__ __forceinline__ float flogsigmoid(float x) { return fminf(x, 0.f) - fsoftplus(-fabsf(x)); }
__device__ __forceinline__ float fexp(float x) {
#ifdef EMU
    return expf(x);
#else
    return __expf(x);
#endif
}
__device__ __forceinline__ float fsilu(float x) {
#ifdef EMU
    return x / (1.0f + expf(-x));
#else
    return __fdividef(x, 1.0f + __expf(-x));
#endif
}
__device__ __forceinline__ float wave_sum(float v) {
#pragma unroll
    for (int m = 32; m >= 1; m >>= 1) v += __shfl_xor(v, m);
    return v;
}
__device__ __forceinline__ float wave_max(float v) {
#pragma unroll
    for (int m = 32; m >= 1; m >>= 1) v = fmaxf(v, __shfl_xor(v, m));
    return v;
}
#ifndef EMU
#define DPP_F(oldv, v, ctrl, rmask) __builtin_bit_cast(float, __builtin_amdgcn_update_dpp(__builtin_bit_cast(int, (float)(oldv)), __builtin_bit_cast(int, (float)(v)), (ctrl), (rmask), 0xF, false))
#endif
__device__ __forceinline__ float wave_scan_sum(float v, int lane) {
#ifdef EMU
    for (int d = 1; d < 64; d <<= 1) { float o = __shfl_up(v, d); if (lane >= d) v += o; }
    return v;
#else
    v += DPP_F(0.f, v, 0x111, 0xF);
    v += DPP_F(0.f, v, 0x112, 0xF);
    v += DPP_F(0.f, v, 0x114, 0xF);
    v += DPP_F(0.f, v, 0x118, 0xF);
    v += DPP_F(0.f, v, 0x142, 0xA);
    v += DPP_F(0.f, v, 0x143, 0xC);
    return v;
#endif
}
__device__ __forceinline__ float wave_last(float v) {
#ifdef EMU
    return __shfl(v, 63);
#else
    return __builtin_bit_cast(float, __builtin_amdgcn_readlane(__builtin_bit_cast(int, v), 63));
#endif
}
__device__ __forceinline__ float wave_shr1(float v, float fill, int lane) {
#ifdef EMU
    float o = __shfl_up(v, 1); return lane == 0 ? fill : o;
#else
    return DPP_F(fill, v, 0x138, 0xF);
#endif
}
__device__ __forceinline__ float wave_scan_max(float v, int lane) {
#ifdef EMU
    for (int d = 1; d < 64; d <<= 1) { float o = __shfl_up(v, d); if (lane >= d) v = fmaxf(v, o); }
    return v;
#else
    const float NI = -3.0e38f;
    v = fmaxf(v, DPP_F(NI, v, 0x111, 0xF));
    v = fmaxf(v, DPP_F(NI, v, 0x112, 0xF));
    v = fmaxf(v, DPP_F(NI, v, 0x114, 0xF));
    v = fmaxf(v, DPP_F(NI, v, 0x118, 0xF));
    v = fmaxf(v, DPP_F(NI, v, 0x142, 0xA));
    v = fmaxf(v, DPP_F(NI, v, 0x143, 0xC));
    return v;
#endif
}

template <int MT, int NTL>
__device__ __forceinline__ void mma_lds(f32x4 (&acc)[MT][NTL], const half_t* A, int lda, const half_t* B, int ldb, int ksteps, int lane) {
#ifndef EMU
    const int r = lane & 15, kq = (lane >> 4) * 8;
    for (int ks = 0; ks < ksteps; ++ks) {
        half8 a[MT], b[NTL];
#pragma unroll
        for (int mt = 0; mt < MT; ++mt) a[mt] = *(const half8*)(A + (mt * 16 + r) * lda + ks * 32 + kq);
#pragma unroll
        for (int nt = 0; nt < NTL; ++nt) b[nt] = *(const half8*)(B + (nt * 16 + r) * ldb + ks * 32 + kq);
#pragma unroll
        for (int mt = 0; mt < MT; ++mt)
#pragma unroll
            for (int nt = 0; nt < NTL; ++nt) acc[mt][nt] = __builtin_amdgcn_mfma_f32_16x16x32_f16(a[mt], b[nt], acc[mt][nt], 0, 0, 0);
    }
#else
    for (int mt = 0; mt < MT; ++mt) for (int nt = 0; nt < NTL; ++nt) for (int i = 0; i < 4; ++i) {
        const int row = mt * 16 + (lane >> 4) * 4 + i, col = nt * 16 + (lane & 15);
        float s = acc[mt][nt][i];
        for (int k = 0; k < ksteps * 32; ++k) s += (float)A[row * lda + k] * (float)B[col * ldb + k];
        acc[mt][nt][i] = s;
    }
#endif
}

__device__ __forceinline__ f32x4 mfma16(half8 a, half8 b, f32x4 c) {
#ifdef EMU
    return emu_mfma16(a, b, c);
#else
    return __builtin_amdgcn_mfma_f32_16x16x32_f16(a, b, c, 0, 0, 0);
#endif
}
template <int MT, int NTL> __device__ __forceinline__ void zero_acc(f32x4 (&acc)[MT][NTL]) {
#pragma unroll
    for (int mt = 0; mt < MT; ++mt)
#pragma unroll
        for (int nt = 0; nt < NTL; ++nt) acc[mt][nt] = (f32x4){0.f, 0.f, 0.f, 0.f};
}

__device__ __forceinline__ void load_taps4(const float* cw, const float* cb, int C, int ch, int dir, f32x4& w0, f32x4& w1, f32x4& w2, f32x4& wb) {
    w0 = *(const f32x4*)(cw + (dir ? 2 : 0) * C + ch); w1 = *(const f32x4*)(cw + C + ch); w2 = *(const f32x4*)(cw + (dir ? 0 : 2) * C + ch); wb = *(const f32x4*)(cb + ch);
}
#ifdef EMU
#define LOADER_FENCE()
#else
#define LOADER_FENCE() asm volatile("" ::: "memory")
#endif
#define CONV4(k, i) (w0[i] * (float)rr[k][hh * 4 + i] + w1[i] * (float)rr[(k) + 1][hh * 4 + i] + w2[i] * (float)rr[(k) + 2][hh * 4 + i] + wb[i])
__device__ __forceinline__ half4 to_half4(const f32x4 v) { half4 h; h[0] = (half_t)v[0]; h[1] = (half_t)v[1]; h[2] = (half_t)v[2]; h[3] = (half_t)v[3]; return h; }
namespace g8 {
constexpr int BM = 256, BK = 64, HALF = 128, HTB = HALF * BK * 2, STAGE_BYTES = 8 * HTB;
__device__ __forceinline__ int lds_byte(int r, int c) { const int st = (r >> 4) * 2 + (c >> 5), rr = r & 15, cc = c & 31, ob = rr * 64 + cc * 2; return st * 1024 + (ob ^ (((ob >> 9) & 1) << 5)); }
__device__ __forceinline__ int perm32(int rho) { const int n = rho >> 4, i = rho & 15; return 8 * (i >> 2) + 4 * n + (i & 3); }
__device__ __forceinline__ void stage_rc(int b, int& R, int& C) { const int st = b / 1024, sb = b % 1024, swz = sb ^ (((sb >> 9) & 1) << 5); R = (st >> 1) * 16 + swz / 64; C = (st & 1) * 32 + (swz % 64) / 2; }
struct Unit { int pm, pn, e, n, c0; };

struct DenseSched {
    const char* abase; const char* bbase; int K, nM, nN, G, c;
    __device__ __forceinline__ bool next(int i, Unit& u) const {
        const int nwg = nM * nN; const long L = (long)i * G + c; if (L >= nwg) return false;
        int wgid = (int)L; { const int q = nwg / 8, r = nwg % 8, xcd = wgid % 8, off = wgid / 8; wgid = (xcd < r ? xcd * (q + 1) : r * (q + 1) + (xcd - r) * q) + off; }
        const int nig = 8 * nN, gid = wgid / nig, fm = gid * 8, gsz = (nM - fm) < 8 ? (nM - fm) : 8;
        u.pm = fm + ((wgid % nig) % gsz); u.pn = (wgid % nig) / gsz; u.e = 0; u.n = 0; u.c0 = 0; return true;
    }
    __device__ __forceinline__ unsigned a_off(const Unit& u, int r) const { return (unsigned)((size_t)(u.pm * 256 + r) * K * 2); }
    __device__ __forceinline__ const char* b_half(const Unit& u, int h) const { return bbase + (size_t)(u.pn * 256 + h * 128) * K * 2; }
};

template <class Epi, class Sched>
__device__ __forceinline__ void gemm_phase(unsigned char* smem, const int K, const Sched& S, const Epi& E) {
    const int tid = threadIdx.x, lane = tid & 63;
#ifdef EMU
    const int wid = tid >> 6, wr = wid >> 2, wc = wid & 3, fr = lane & 15, fq = lane >> 4;
    half_t* As = (half_t*)smem; half_t* Bs = As + 256 * 72;
    Unit cur;
    for (int ui = 0; S.next(ui, cur); ++ui) {
        f32x4 acc[2][2][4][2];
        for (int a = 0; a < 2; ++a) for (int b = 0; b < 2; ++b) for (int m = 0; m < 4; ++m) for (int n = 0; n < 2; ++n) acc[a][b][m][n] = (f32x4){0.f, 0.f, 0.f, 0.f};
        for (int kt = 0; kt < K / 64; ++kt) {
            { const int row = tid >> 1, c0 = (tid & 1) * 32;
              const half_t* sa = (const half_t*)(S.abase + S.a_off(cur, row)) + kt * 64 + c0;
              const half_t* sb = (const half_t*)(S.b_half(cur, row >> 7)) + (size_t)(row & 127) * K + kt * 64 + c0;
              for (int q = 0; q < 32; ++q) { As[row * 72 + c0 + q] = sa[q]; Bs[row * 72 + c0 + q] = sb[q]; } }
            __syncthreads();
            for (int a = 0; a < 2; ++a) for (int b = 0; b < 2; ++b) for (int m = 0; m < 4; ++m) for (int n = 0; n < 2; ++n) for (int i = 0; i < 4; ++i) {
                const int row = 128 * a + 64 * wr + 16 * m + fr, col = 128 * b + 32 * wc + (Epi::PERM ? 8 * fq + 4 * n + i : 16 * n + 4 * fq + i); float s = acc[a][b][m][n][i];
                for (int k = 0; k < 64; ++k) s += (float)As[row * 72 + k] * (float)Bs[col * 72 + k];
                acc[a][b][m][n][i] = s; }
            __syncthreads();
        }
        E(acc, cur, wr, wc, fr, fq);
    }
#else
    typedef __attribute__((address_space(3))) unsigned char* ldsp_t;
    const ldsp_t lds = (ldsp_t)smem;
    const int wid = __builtin_amdgcn_readfirstlane(tid >> 6), wr = wid >> 2, wc = wid & 3, fr = lane & 15, fq = lane >> 4;
    const int nt = K / BK;
    int Rr[2], Cc[2]; unsigned voffB[2];
#pragma unroll
    for (int i = 0; i < 2; ++i) { stage_rc(tid * 16 + i * 8192, Rr[i], Cc[i]); const int Rb = Epi::PERM ? ((Rr[i] & ~31) + perm32(Rr[i] & 31)) : Rr[i]; voffB[i] = (unsigned)(Rb * K + Cc[i]) * 2u; }
    const size_t kstep = (size_t)(BK * 2);
    const unsigned ldsw = (unsigned)wid * 1024u;
    const int aoffl = lds_byte(wr * 64 + fr, fq * 8), boffl = lds_byte(wc * 32 + fr, fq * 8);
#define G8_SA(b, h) (((b) * 2 + (h)) * HTB)
#define G8_SB(b, h) ((4 + (b) * 2 + (h)) * HTB)
#define G8_STAGE(bufoff, gbase, voff) do { _Pragma("unroll") for (int _i = 0; _i < 2; ++_i) \
        __builtin_amdgcn_global_load_lds((const unsigned*)((const char*)(gbase) + (voff)[_i]), (__attribute__((address_space(3))) unsigned*)(lds + (bufoff) + ldsw + _i * 8192), 16, 0, 0); } while (0)
#define G8_LDA(dst, b, h) do { _Pragma("unroll") for (int m = 0; m < 4; ++m) _Pragma("unroll") for (int k = 0; k < 2; ++k) dst[m][k] = *(const __attribute__((address_space(3))) half8*)(lds + G8_SA(b, h) + aoffl + m * 2048 + k * 1024); } while (0)
#define G8_LDB(dst, b, h) do { _Pragma("unroll") for (int n = 0; n < 2; ++n) _Pragma("unroll") for (int k = 0; k < 2; ++k) dst[n][k] = *(const __attribute__((address_space(3))) half8*)(lds + G8_SB(b, h) + boffl + n * 2048 + k * 1024); } while (0)
#define G8_MMA(ai, bj, At, Bt) do { __builtin_amdgcn_s_setprio(1); _Pragma("unroll") for (int m = 0; m < 4; ++m) _Pragma("unroll") for (int n = 0; n < 2; ++n) _Pragma("unroll") for (int k = 0; k < 2; ++k) \
        acc[ai][bj][m][n] = __builtin_amdgcn_mfma_f32_16x16x32_f16(Bt[n][k], At[m][k], acc[ai][bj][m][n], 0, 0, 0); __builtin_amdgcn_s_setprio(0); } while (0)
#define G8_WAIT_V(n) asm volatile("s_waitcnt vmcnt(" #n ")" ::: "memory")
#define G8_WAIT_L(n) asm volatile("s_waitcnt lgkmcnt(" #n ")" ::: "memory")
#define G8_BAR __builtin_amdgcn_s_barrier()
#define G8_SCHED __builtin_amdgcn_sched_barrier(0)
#define G8_AOFF(dst, u) do { _Pragma("unroll") for (int _h = 0; _h < 2; ++_h) _Pragma("unroll") for (int _i = 0; _i < 2; ++_i) dst[_h][_i] = S.a_off(u, _h * 128 + Rr[_i]) + (unsigned)Cc[_i] * 2u; } while (0)
    Unit cur, nxt; int ui = 0;
    if (!S.next(0, cur)) return;
    f32x4 acc[2][2][4][2];
#pragma unroll
    for (int a = 0; a < 2; ++a)
#pragma unroll
        for (int b = 0; b < 2; ++b)
#pragma unroll
            for (int m = 0; m < 4; ++m)
#pragma unroll
                for (int n = 0; n < 2; ++n) acc[a][b][m][n] = (f32x4){0.f, 0.f, 0.f, 0.f};
    half8 At[4][2], B0[2][2], B1[2][2];
    unsigned caoff[2][2], naoff[2][2];
    G8_AOFF(caoff, cur);
    const char* cA = S.abase; const char* cB0 = S.b_half(cur, 0); const char* cB1 = S.b_half(cur, 1);
    G8_STAGE(G8_SB(0, 0), cB0, voffB); G8_STAGE(G8_SA(0, 0), cA, caoff[0]); G8_STAGE(G8_SB(0, 1), cB1, voffB); G8_STAGE(G8_SA(0, 1), cA, caoff[1]);
    if (wr == 1) G8_BAR;
    G8_WAIT_V(4); G8_BAR;
    G8_STAGE(G8_SB(1, 0), cB0 + kstep, voffB); G8_STAGE(G8_SA(1, 0), cA + kstep, caoff[0]); G8_STAGE(G8_SB(1, 1), cB1 + kstep, voffB);
    G8_WAIT_V(6); G8_BAR;
    for (;;) {
        const bool has_next = S.next(ui + 1, nxt);
        if (!has_next) nxt = cur;
        G8_AOFF(naoff, nxt);
        const char* nB0 = S.b_half(nxt, 0); const char* nB1 = S.b_half(nxt, 1);
#pragma unroll 1
        for (int t = 0; t < nt; t += 2) {
            const bool last = (t == nt - 2);
            const char* a1 = cA + (size_t)(t + 1) * kstep;
            const char* a2 = last ? cA : cA + (size_t)(t + 2) * kstep;
            const char* b20 = last ? nB0 : cB0 + (size_t)(t + 2) * kstep; const char* b21 = last ? nB1 : cB1 + (size_t)(t + 2) * kstep;
            const char* a3 = a2 + kstep; const char* b30 = b20 + kstep; const char* b31 = b21 + kstep;
            unsigned xoff[2][2];
#pragma unroll
            for (int h = 0; h < 2; ++h)
#pragma unroll
                for (int i = 0; i < 2; ++i) xoff[h][i] = last ? naoff[h][i] : caoff[h][i];
            G8_LDB(B0, 0, 0); G8_SCHED; G8_LDA(At, 0, 0); G8_STAGE(G8_SA(1, 1), a1, caoff[1]);
            G8_WAIT_L(8); G8_BAR; G8_WAIT_L(0); G8_MMA(0, 0, At, B0); G8_BAR; G8_SCHED;
            G8_LDB(B1, 0, 1); G8_STAGE(G8_SB(0, 0), b20, voffB);
            G8_BAR; G8_WAIT_L(0); G8_MMA(0, 1, At, B1); G8_BAR;
            G8_LDA(At, 0, 1); G8_STAGE(G8_SA(0, 0), a2, xoff[0]);
            G8_BAR; G8_WAIT_L(0); G8_MMA(1, 0, At, B0); G8_BAR; G8_SCHED;
            G8_STAGE(G8_SB(0, 1), b21, voffB);
            G8_WAIT_V(6); G8_BAR; G8_MMA(1, 1, At, B1); G8_BAR;
            G8_LDB(B0, 1, 0); G8_SCHED; G8_LDA(At, 1, 0); G8_STAGE(G8_SA(0, 1), a2, xoff[1]);
            G8_WAIT_L(8); G8_BAR; G8_WAIT_L(0); G8_MMA(0, 0, At, B0); G8_BAR; G8_SCHED;
            G8_LDB(B1, 1, 1); G8_STAGE(G8_SB(1, 0), b30, voffB);
            G8_BAR; G8_WAIT_L(0); G8_MMA(0, 1, At, B1); G8_BAR;
            G8_LDA(At, 1, 1); G8_STAGE(G8_SA(1, 0), a3, xoff[0]);
            G8_BAR; G8_WAIT_L(0); G8_MMA(1, 0, At, B0); G8_BAR; G8_SCHED;
            G8_STAGE(G8_SB(1, 1), b31, voffB);
            G8_WAIT_V(6); G8_BAR; G8_MMA(1, 1, At, B1); G8_BAR;
        }
        E(acc, cur, wr, wc, fr, fq);
        if (!has_next) break;
#pragma unroll
        for (int a = 0; a < 2; ++a)
#pragma unroll
            for (int b = 0; b < 2; ++b)
#pragma unroll
                for (int m = 0; m < 4; ++m)
#pragma unroll
                    for (int n = 0; n < 2; ++n) acc[a][b][m][n] = (f32x4){0.f, 0.f, 0.f, 0.f};
        cur = nxt; cB0 = nB0; cB1 = nB1; ++ui;
#pragma unroll
        for (int h = 0; h < 2; ++h)
#pragma unroll
            for (int i = 0; i < 2; ++i) caoff[h][i] = naoff[h][i];
    }
    G8_WAIT_V(0);
    if (wr == 0) G8_BAR;
    G8_BAR;
#undef G8_SA
#undef G8_SB
#undef G8_STAGE
#undef G8_LDA
#undef G8_LDB
#undef G8_MMA
#undef G8_WAIT_V
#undef G8_WAIT_L
#undef G8_BAR
#undef G8_SCHED
#undef G8_AOFF
#endif
}
}

#ifdef EMU
typedef const Params* ParamsPtr;
#else
typedef const __attribute__((address_space(4))) Params* ParamsPtr;
#endif
struct Frame {
    ParamsPtr P; unsigned char* ws; unsigned char* smem; int tid, lane, wave;
    __device__ __forceinline__ const float* in(int i) const { return P->in[i]; }
    __device__ __forceinline__ float* xrow(int row) const { return row < TL ? P->out + (size_t)row * D : (float*)(ws + WS_XC) + (size_t)(row - TL) * D; }
    __device__ __forceinline__ const float* xrow_in(int layer, int row) const {
        if (layer == 0) return row < TL ? in(I_X) + (size_t)row * D : in(I_CTX) + (size_t)(row - TL) * D;
        return xrow(row);
    }
};
__device__ __forceinline__ int row_mod(int row) { return row < TL ? row / SEQ : NB; }
__device__ __forceinline__ const float* modp(const Frame& F, int layer, int m, int chunk) { return (const float*)(F.ws + WS_MOD) + ((size_t)(layer * 5 + m) * 6 + chunk) * D; }


#ifndef EMU
#define XB_TMO      128
#define XB_XCNT(j)  (256  + 64 * (j))
#define XB_XSUB(j)  (1280 + 64 * (j))
#define XB_XGEN(j)  (2304 + 64 * (j))
#define XB_TOP      3328
#define XB_TOPGEN   3392
#define XCD_BAR_WORDS 3456
#define XB_SPIN_CAP (1u << 26)
#define LAS __attribute__((address_space(3)))
static_assert((CW_BAR + XCD_BAR_WORDS) * 4 <= CTL_BYTES, "control region");
__device__ __forceinline__ unsigned xb_ld(unsigned* p)              { return __hip_atomic_load(p, __ATOMIC_RELAXED, __HIP_MEMORY_SCOPE_AGENT); }
__device__ __forceinline__ unsigned xb_add(unsigned* p, unsigned v) { return __hip_atomic_fetch_add(p, v, __ATOMIC_RELAXED, __HIP_MEMORY_SCOPE_AGENT); }
__device__ __forceinline__ unsigned xb_xcc_id() { return (unsigned)__builtin_amdgcn_s_getreg((3 << 11) | 20) & 0xFu; }
#define XB_SPIN(cond, bar) do { unsigned _sp = 0; while (cond) { __builtin_amdgcn_s_sleep(1); \
    if ((++_sp & 255u) == 0u) { if (xb_ld(&(bar)[XB_TMO])) break; if (_sp > XB_SPIN_CAP) { atomicAdd(&(bar)[XB_TMO], 1u); break; } } } } while (0)
struct XcdBarrier { unsigned* bar; unsigned x; volatile LAS unsigned* st; };
__device__ __forceinline__ XcdBarrier xcd_barrier_post(unsigned* bar, volatile LAS unsigned* st) {
    XcdBarrier b; b.bar = bar; b.x = xb_xcc_id(); b.st = st;
    if (threadIdx.x == 0) (void)xb_add(&bar[XB_XCNT(b.x)], 1u);
    return b;
}
__device__ __forceinline__ void xcd_barrier_complete(unsigned* bar, unsigned x, unsigned& nloc, unsigned& nx) {
    const unsigned G = gridDim.x * gridDim.y * gridDim.z;
    unsigned sum, cnt, mine, sp = 0u;
    for (;;) {
        sum = 0u; cnt = 0u; mine = 0u;
#pragma unroll
        for (unsigned j = 0; j < 16; ++j) { const unsigned c = xb_ld(&bar[XB_XCNT(j)]); sum += c; cnt += (c > 0u) ? 1u : 0u; mine = (j == x) ? c : mine; }
        if (sum == G) break;
        __builtin_amdgcn_s_sleep(1);
        if ((++sp & 255u) == 0u) { if (xb_ld(&bar[XB_TMO])) break; if (sp > XB_SPIN_CAP) { atomicAdd(&bar[XB_TMO], 1u); break; } }
    }
    nloc = mine > 0u ? mine : 1u; nx = cnt > 0u ? cnt : 1u;
}
__device__ __forceinline__ void xcd_barrier(const XcdBarrier& b) {
    asm volatile("s_waitcnt vmcnt(0)" ::: "memory");
    __syncthreads();
    if (threadIdx.x == 0) {
        unsigned* bar = b.bar;
        __builtin_amdgcn_s_waitcnt(0);
        unsigned nloc = b.st[0], nx = b.st[1];
        if (nloc == 0u) { xcd_barrier_complete(bar, b.x, nloc, nx); b.st[0] = nloc; b.st[1] = nx; }
        const unsigned old = xb_add(&bar[XB_XSUB(b.x)], 1u);
        const unsigned gen = old / nloc;
        if (old + 1u == (gen + 1u) * nloc) {
            __builtin_amdgcn_fence(__ATOMIC_RELEASE, "agent");
            asm volatile("s_waitcnt vmcnt(0)" ::: "memory");
            const unsigned og = xb_add(&bar[XB_TOP], 1u);
            const unsigned tg = og / nx;
            if (og + 1u == (tg + 1u) * nx) xb_add(&bar[XB_TOPGEN], 1u);
            else XB_SPIN(xb_ld(&bar[XB_TOPGEN]) == tg, bar);
            __builtin_amdgcn_fence(__ATOMIC_ACQUIRE, "agent");
            xb_add(&bar[XB_XGEN(b.x)], 1u);
            asm volatile("s_waitcnt vmcnt(0)" ::: "memory");
        } else {
            XB_SPIN(xb_ld(&bar[XB_XGEN(b.x)]) == gen, bar);
            __builtin_amdgcn_fence(__ATOMIC_ACQUIRE, "agent");
            asm volatile("s_waitcnt vmcnt(0)" ::: "memory");
        }
    }
    __syncthreads();
}
#endif

__device__ __forceinline__ void item_twiddle(const Frame& F, int it) {
    cplx* tw = (cplx*)(F.ws + WS_TW);
    const int k = it * NT + F.tid;
    if (k < TWN) { float s, c; const float a = -6.283185307179586f * (float)k / (float)TWN; s = sinf(a); c = cosf(a); tw[k].x = c; tw[k].y = s; }
}
__device__ __forceinline__ void item_mod(const Frame& F, int it) {
    const int layer = it / (NMOD / 64), n0 = (it % (NMOD / 64)) * 64;
    float* sc = (float*)F.smem;
    float* red = sc + 5 * D;
    for (int i = F.tid; i < 5 * D; i += NT) { const int m = i / D, k = i % D; const float v = m < NB ? F.in(I_C)[m * D + k] : F.in(I_CCTX)[k]; sc[i] = siluf(v); }
    __syncthreads();
    const int j = F.tid & 63, ks = F.tid >> 6;
    const float* w = F.in(I_WMOD) + (size_t)layer * D * NMOD + n0 + j;
    float a[5] = {0, 0, 0, 0, 0};
#pragma unroll 1
    for (int k0 = ks * 128; k0 < ks * 128 + 128; k0 += 32) {
        float wv[32];
#pragma unroll
        for (int q = 0; q < 32; ++q) wv[q] = w[(size_t)(k0 + q) * NMOD];
#pragma unroll
        for (int q = 0; q < 32; ++q)
#pragma unroll
            for (int m = 0; m < 5; ++m) a[m] += sc[m * D + k0 + q] * wv[q]; }
#pragma unroll
    for (int m = 0; m < 5; ++m) red[(ks * 5 + m) * 64 + j] = a[m];
    __syncthreads();
    if (F.tid < 5 * 64) { const int m = F.tid / 64, jj = F.tid % 64; float s = 0; for (int q = 0; q < 8; ++q) s += red[(q * 5 + m) * 64 + jj];
        ((float*)(F.ws + WS_MOD))[(size_t)(layer * 5 + m) * NMOD + n0 + jj] = s + F.in(I_BMOD)[layer * NMOD + n0 + jj]; }
    __syncthreads();
}
__device__ __forceinline__ void item_filter(const Frame& F, int layer, int isctx, int tb) {
    const int L = isctx ? CTXL : SEQ;
    float* feats = (float*)F.smem;
    float* h1 = feats + 32 * 33;
    float* h2 = h1 + 32 * 64;
    const int t0 = tb * 32;
    for (int i = F.tid; i < 32 * 33; i += NT) {
        const int tt = i / 33, f = i % 33; const float t = (float)(t0 + tt);
        float v;
        if (f == 0) v = t / (float)(L - 1 > 1 ? L - 1 : 1);
        else { const int bi = (f - 1) & 15; const float band = 1e-4f + (float)bi * ((15.0f - 1e-4f) / 15.0f);
               const float ang = (6.283185307179586f / (float)L) * t * band; v = (f <= 16) ? cosf(ang) : -sinf(ang); }
        feats[i] = v;
    }
    __syncthreads();
    const float* w1 = F.in(I_HW1) + layer * 33 * 64; const float* b1 = F.in(I_HB1) + layer * 64;
    const float* w2 = F.in(I_HW2) + layer * 64 * 64; const float* b2 = F.in(I_HB2) + layer * 64;
    const float* fr = F.in(I_HFREQ) + layer * 64;
    for (int i = F.tid; i < 32 * 64; i += NT) { const int tt = i >> 6, j = i & 63; float s = b1[j]; for (int k = 0; k < 33; ++k) s += feats[tt * 33 + k] * w1[k * 64 + j]; h1[i] = sinf(fr[j] * s); }
    __syncthreads();
    for (int i = F.tid; i < 32 * 64; i += NT) { const int tt = i >> 6, j = i & 63; float s = b2[j]; for (int k = 0; k < 64; ++k) s += h1[tt * 64 + k] * w2[k * 64 + j]; h2[i] = sinf(fr[j] * s); }
    __syncthreads();
    const float* w3 = F.in(I_HW3) + (size_t)layer * 64 * 1024;
    const int c0 = F.tid * 2;
    float* ft = (float*)(F.ws + WS_FT) + (isctx ? (size_t)2 * 256 * 4 * SEQ : (size_t)layer * 256 * 4 * SEQ);
    for (int hf = 0; hf < 2; ++hf) {
        float acc[16][2];
        for (int tt = 0; tt < 16; ++tt) { acc[tt][0] = 0.f; acc[tt][1] = 0.f; }
#pragma unroll 4
        for (int k = 0; k < 64; ++k) { const float wa = w3[k * 1024 + c0], wb = w3[k * 1024 + c0 + 1];
#pragma unroll
            for (int tt = 0; tt < 16; ++tt) { const float hv = h2[(hf * 16 + tt) * 64 + k]; acc[tt][0] += hv * wa; acc[tt][1] += hv * wb; } }
#pragma unroll
        for (int q = 0; q < 2; ++q) {
            const int col = c0 + q, dir = col >> 9, order = (col >> 8) & 1, c = col & 255;
            const float dec = fabsf(F.in(I_HDEC)[((layer * 2 + dir) * 2 + order) * 256 + c]);
            float* dst = ft + ((size_t)(c * 2 + order) * 2 + dir) * L + t0 + hf * 16;
#pragma unroll
            for (int tt = 0; tt < 16; ++tt) { const float tu = (float)(t0 + hf * 16 + tt) / (float)(L - 1 > 1 ? L - 1 : 1); dst[tt] = acc[tt][q] * expf(-tu * dec); }
        }
    }
    __syncthreads();
}
__device__ __forceinline__ int inproj_src_col(int j) { return j < 1024 ? j : (j < 3328 ? j + 12 : (j < 3340 ? j - 2304 : (j < NIN ? j : -1))); }
__device__ __forceinline__ void item_transpose(const Frame& F, const float* src, int ldn, int nvalid, half_t* dst, int K, int k0, int n0, int inmap = 0) {
    float* tile = (float*)F.smem;
    f32x4 v[8];
#pragma unroll
    for (int q = 0; q < 8; ++q) { const int i = F.tid + q * NT, r = i >> 6, c4 = (i & 63) * 4;
        if (inmap) { const int sc = inproj_src_col(n0 + c4); v[q] = sc >= 0 ? *(const f32x4*)(src + (size_t)(k0 + r) * ldn + sc) : (f32x4){0.f, 0.f, 0.f, 0.f}; }
        else if (n0 + c4 + 3 < nvalid) v[q] = *(const f32x4*)(src + (size_t)(k0 + r) * ldn + n0 + c4);
        else {
#pragma unroll
            for (int e = 0; e < 4; ++e) v[q][e] = (n0 + c4 + e < nvalid) ? src[(size_t)(k0 + r) * ldn + n0 + c4 + e] : 0.f; } }
#pragma unroll
    for (int q = 0; q < 8; ++q) { const int i = F.tid + q * NT, r = i >> 6, c4 = (i & 63) * 4; *(f32x4*)(tile + r * 260 + c4) = v[q]; }
    __syncthreads();
#pragma unroll
    for (int q = 0; q < 4; ++q) { const int i = F.tid + q * NT, n = i >> 3, kc = (i & 7) * 8; half8 h;
#pragma unroll
        for (int e = 0; e < 8; ++e) h[e] = (half_t)tile[(kc + e) * 260 + n];
        *(half8*)(dst + (size_t)(n0 + n) * K + k0 + kc) = h; }
    __syncthreads();
}
__device__ __forceinline__ void item_router_w(const Frame& F, int layer) {
    half_t* dst = (half_t*)(F.ws + WS_WR) + (size_t)layer * 2 * 48 * D;
#pragma unroll 4
    for (int i = F.tid; i < 32 * D; i += NT) {
        const int k = i >> 5, c = i & 31; const float w = F.in(I_ERW)[(size_t)layer * D * 32 + i];
        const half_t hi = (half_t)w; dst[(size_t)(4 + c) * D + k] = hi; dst[(size_t)(48 + 4 + c) * D + k] = (half_t)((w - (float)hi) * 2048.f); }
#pragma unroll 4
    for (int i = F.tid; i < 4 * D; i += NT) {
        const int k = i >> 2, c = i & 3; const float w = F.in(I_GRW)[(size_t)layer * D * 4 + i];
        const half_t hi = (half_t)w; dst[(size_t)c * D + k] = hi; dst[(size_t)(48 + c) * D + k] = (half_t)((w - (float)hi) * 2048.f); }
#pragma unroll 4
    for (int i = F.tid; i < 12 * D; i += NT) { dst[(size_t)36 * D + i] = (half_t)0.f; dst[(size_t)(48 + 36) * D + i] = (half_t)0.f; }
}
constexpr int IT_TW = (TWN + NT - 1) / NT;
constexpr int IT_MOD = 2 * (NMOD / 64);
constexpr int IT_FILT = 2 * (SEQ / 32) + (CTXL / 32);
constexpr int IT_TWIN = 2 * 16 * (NINP / 256);
constexpr int IT_TWOUT = 2 * 16 * 4;
constexpr int IT_TMOE = 32 * 48;
__device__ __forceinline__ void moe_transpose_item(const Frame& F, int layer, int it) {
    const int e = it / 48, r = it % 48, which = r / 16, t = r % 16;
    half_t* base = (half_t*)(F.ws + WS_WMOE) + (size_t)e * 3 * 262144;
    if (which < 2) {
        const float* src = F.in(which == 0 ? I_MG : I_MU) + ((size_t)layer * 32 + e) * 262144;
        item_transpose(F, src, 256, 256, base + which * 262144, 1024, t * 64, 0);
    } else {
        const float* src = F.in(I_MD) + ((size_t)layer * 32 + e) * 262144;
        item_transpose(F, src, 1024, 1024, base + 2 * 262144, 256, (t >> 2) * 64, (t & 3) * 256);
    }
}
__device__ __forceinline__ void phase_setup(const Frame& F) {
    const int G = gridDim.x; int rot = blockIdx.x;
    for (int i = rot; i < IT_MOD; i += G) item_mod(F, i);
    rot = (rot + G - (IT_MOD % G)) % G;
    for (int i = rot; i < IT_TWIN; i += G) { const int layer = i / (16 * (NINP / 256)), r = i % (16 * (NINP / 256));
        item_transpose(F, F.in(I_WIN) + (size_t)layer * D * NIN, NIN, NIN, (half_t*)(F.ws + WS_WIN) + (size_t)layer * NINP * D, D, (r / (NINP / 256)) * 64, (r % (NINP / 256)) * 256, 1); }
    rot = (rot + G - (IT_TWIN % G)) % G;
    for (int i = rot; i < IT_FILT; i += G) { if (i < 2 * (SEQ / 32)) item_filter(F, i / (SEQ / 32), 0, i % (SEQ / 32)); else item_filter(F, 0, 1, i - 2 * (SEQ / 32)); }
    rot = (rot + G - (IT_FILT % G)) % G;
    for (int i = rot; i < IT_TWOUT; i += G) { const int layer = i / 64, r = i % 64;
        item_transpose(F, F.in(I_WOUT) + (size_t)layer * D * D, D, D, (half_t*)(F.ws + WS_WOUT) + (size_t)layer * D * D, D, (r >> 2) * 64, (r & 3) * 256); }
    rot = (rot + G - (IT_TWOUT % G)) % G;
    for (int i = rot; i < IT_TW; i += G) item_twiddle(F, i);
    rot = (rot + G - (IT_TW % G)) % G;
    for (int i = rot; i < 2; i += G) item_router_w(F, i);
}

__device__ __forceinline__ void phase_norm1(const Frame& F, int layer) {
    half_t* xn = (half_t*)(F.ws + WS_XN);
    const int lane = F.lane, nwaves = gridDim.x * (NT / 64);
    const float* nw = F.in(I_N1W) + layer * D;
    int mc = -1; f32x4 g[4], s4[4];
    int row = blockIdx.x * (NT / 64) + F.wave;
    f32x4 v[4];
    if (row < TT) { const float* x = F.xrow_in(layer, row);
#pragma unroll
        for (int q = 0; q < 4; ++q) v[q] = *(const f32x4*)(x + q * 256 + lane * 4); }
    for (; row < TT; row += nwaves) {
        const int nrow = row + nwaves;
        f32x4 vn[4];
        if (nrow < TT) { const float* x = F.xrow_in(layer, nrow);
#pragma unroll
            for (int q = 0; q < 4; ++q) vn[q] = *(const f32x4*)(x + q * 256 + lane * 4); }
        if (layer > 0) {
            const half_t* xa = (const half_t*)(F.ws + WS_U16 + XAB_OFF) + (size_t)row * D; const half_t* xb = xa + (size_t)TT * D; float* xw = F.xrow(row);
            const float* g5 = modp(F, layer - 1, row_mod(row), 5);
#pragma unroll
            for (int q = 0; q < 4; ++q) { const int k = q * 256 + lane * 4; const half4 a4 = *(const half4*)(xa + k), b4 = *(const half4*)(xb + k); const f32x4 gv = *(const f32x4*)(g5 + k);
#pragma unroll
                for (int e = 0; e < 4; ++e) v[q][e] += gv[e] * ((float)a4[e] + (float)b4[e]);
                *(f32x4*)(xw + k) = v[q]; } }
        const int m = row_mod(row);
        if (m != mc) { mc = m; const float* sh = modp(F, layer, m, 0); const float* scl = modp(F, layer, m, 1);
#pragma unroll
            for (int q = 0; q < 4; ++q) { const int k = q * 256 + lane * 4; const f32x4 a = *(const f32x4*)(nw + k), b = *(const f32x4*)(scl + k); s4[q] = *(const f32x4*)(sh + k);
#pragma unroll
                for (int e = 0; e < 4; ++e) g[q][e] = a[e] * (1.0f + b[e]); } }
        float ss = 0.f;
#pragma unroll
        for (int q = 0; q < 4; ++q) ss += v[q][0] * v[q][0] + v[q][1] * v[q][1] + v[q][2] * v[q][2] + v[q][3] * v[q][3];
        ss = wave_sum(ss);
        const float rs = 1.0f / sqrtf(ss * (1.0f / D) + EPSF);
        int srow = row;
        if (layer == 1 && row < TL) { const int b = row / SEQ, l = row % SEQ; srow = b * SEQ + (l % GW) * GROWS + l / GW; }
#pragma unroll
        for (int q = 0; q < 4; ++q) { const int k = q * 256 + lane * 4; half4 h;
#pragma unroll
            for (int e = 0; e < 4; ++e) h[e] = (half_t)(v[q][e] * rs * g[q][e] + s4[q][e]);
            *(half4*)(xn + (size_t)srow * D + k) = h; }
#pragma unroll
        for (int q = 0; q < 4; ++q) v[q] = vn[q];
    }
}

#ifdef EMU
#define WAVE_SYNC() emu_wave_barrier()
#else
#define WAVE_SYNC() __builtin_amdgcn_wave_barrier()
#endif
constexpr int HYTR_OFF = g8::STAGE_BYTES + 2048;
struct EpiInproj {
    static constexpr bool PERM = true;
    half_t* u16; float* ug; half_t* hyt; half_t* halo; unsigned char* smem;
    __device__ __forceinline__ void operator()(const f32x4 (&acc)[2][2][4][2], const g8::Unit& u, int wr, int wc, int fr, int fq) const {
        const int rowb = u.pm * 256 + wr * 64 + fr;
        const bool edge = (fr == 0) || (fr == 15);
        const int lane = fq * 16 + fr;
        half_t* T = (half_t*)(smem + HYTR_OFF) + (wr * 4 + wc) * (32 * 24);
#pragma unroll
        for (int bj = 0; bj < 2; ++bj) {
            const int c8 = u.pn * 256 + bj * 128 + wc * 32 + 8 * fq;
            if (c8 < 1024 || (c8 >= 1792 && c8 < 3328)) {
                const int uc = c8 < 1024 ? c8 : c8 - 768; const bool hal = edge && uc >= 384 && uc < 1792;
#pragma unroll
                for (int ai = 0; ai < 2; ++ai)
#pragma unroll
                    for (int m = 0; m < 4; ++m) { const int row = rowb + ai * 128 + m * 16; const f32x4 a0 = acc[ai][bj][m][0], a1 = acc[ai][bj][m][1]; half8 h;
                        h[0] = (half_t)a0[0]; h[1] = (half_t)a0[1]; h[2] = (half_t)a0[2]; h[3] = (half_t)a0[3]; h[4] = (half_t)a1[0]; h[5] = (half_t)a1[1]; h[6] = (half_t)a1[2]; h[7] = (half_t)a1[3];
                        *(half8*)(u16 + (size_t)row * UW + uc) = h;
                        if (hal) *(half8*)(halo + ((size_t)(row >> 4) * 2 + (fr == 15)) * 1408 + (uc - 384)) = h; }
            } else if (c8 < 1792) {
                const int chb = (c8 - 8 * fq) - 1024;
#pragma unroll
                for (int ai = 0; ai < 2; ++ai)
#pragma unroll
                    for (int m = 0; m < 4; ++m) {
                        const f32x4 a0 = acc[ai][bj][m][0], a1 = acc[ai][bj][m][1];
                        WAVE_SYNC();
#pragma unroll
                        for (int j = 0; j < 4; ++j) { T[(8 * fq + j) * 24 + fr] = (half_t)a0[j]; T[(8 * fq + 4 + j) * 24 + fr] = (half_t)a1[j]; }
                        WAVE_SYNC();
                        const int ch = lane >> 1, th = lane & 1; const half8 hv = *(const half8*)(T + ch * 24 + th * 8);
                        const int row0 = rowb - fr + ai * 128 + m * 16;
                        half_t* dst = row0 < TL ? hyt + ((size_t)(row0 / SEQ) * 768 + chb + ch) * SEQ + row0 % SEQ : hyt + (size_t)NB * 768 * SEQ + ((size_t)((row0 - TL) / CTXL) * 768 + chb + ch) * CTXL + (row0 - TL) % CTXL;
                        *(half8*)(dst + th * 8) = hv; }
            } else {
#pragma unroll
                for (int n = 0; n < 2; ++n) { const int c0 = c8 + 4 * n;
                    if (c0 < NIN) { const int gc = c0 < 3340 ? c0 - 3328 : 12 + (c0 - 3340);
#pragma unroll
                        for (int ai = 0; ai < 2; ++ai)
#pragma unroll
                            for (int m = 0; m < 4; ++m) { const int row = rowb + ai * 128 + m * 16; *(f32x4*)(ug + (size_t)row * UGW + gc) = acc[ai][bj][m][n]; } } }
            }
        }
    }
};
__device__ __forceinline__ void phase_inproj(const Frame& F, int layer) {
    g8::DenseSched S; S.abase = (const char*)(F.ws + WS_XN); S.bbase = (const char*)((const half_t*)(F.ws + WS_WIN) + (size_t)layer * NINP * D); S.K = D; S.nM = TT / 256; S.nN = NINP / 256; S.G = gridDim.x; S.c = blockIdx.x;
    EpiInproj E{(half_t*)(F.ws + WS_U16), (float*)(F.ws + WS_UG), (half_t*)(F.ws + WS_HYT), (half_t*)(F.ws + WS_HALO), F.smem};
    g8::gemm_phase(F.smem, D, S, E);
}


__device__ __forceinline__ void phase_act(const Frame& F, int layer) {
    half_t* u16 = (half_t*)(F.ws + WS_U16); const half_t* halo = (const half_t*)(F.ws + WS_HALO);
    const int tid = F.tid, g = tid % 176, hf = tid / 176;
    const bool active = tid < 352;
    const bool isml = g >= 80; const int ch = isml ? (g - 80) * 8 : g * 8, C = isml ? 768 : 640;
    const float* cw = isml ? F.in(I_MCW) + layer * 3 * 768 : F.in(I_SCW) + layer * 3 * 640; const float* cb = isml ? F.in(I_MCB) + layer * 768 : F.in(I_SCB) + layer * 640;
    const float osc = (isml && ch >= 384) ? 0.125f : 1.0f;
    float w0[8], w1[8], w2[8], wb[8];
#pragma unroll
    for (int i = 0; i < 8; ++i) { const int cc = active ? ch + i : 0; w0[i] = cw[cc]; w1[i] = cw[C + cc]; w2[i] = cw[2 * C + cc]; wb[i] = cb[cc]; }
    for (int it = blockIdx.x; it < TT / 16; it += gridDim.x) {
        const int rb = it * 16, r0 = rb + hf * 8;
        const bool isl = rb < TL; const int L = isl ? SEQ : CTXL; const int pos0 = (isl ? rb : rb - TL) % L;
        half8 rr[10]; half8 zz;
#pragma unroll
        for (int i = 0; i < 8; ++i) zz[i] = (half_t)0.f;
        if (active) {
            const size_t col = 384 + g * 8;
#pragma unroll
            for (int k = 0; k < 8; ++k) rr[k + 1] = *(const half8*)(u16 + (size_t)(r0 + k) * UW + col);
            if (hf == 0) { rr[0] = pos0 > 0 ? *(const half8*)(halo + ((size_t)(it - 1) * 2 + 1) * 1408 + g * 8) : zz; rr[9] = *(const half8*)(u16 + (size_t)(rb + 8) * UW + col); }
            else { rr[0] = *(const half8*)(u16 + (size_t)(rb + 7) * UW + col); rr[9] = pos0 + 16 < L ? *(const half8*)(halo + ((size_t)(it + 1) * 2 + 0) * 1408 + g * 8) : zz; }
        }
        half8 o[8];
        if (active) {
#pragma unroll
            for (int k = 0; k < 8; ++k)
#pragma unroll
                for (int i = 0; i < 8; ++i) o[k][i] = (half_t)(osc * fsilu(w0[i] * (float)rr[k][i] + w1[i] * (float)rr[k + 1][i] + w2[i] * (float)rr[k + 2][i] + wb[i]));
        }
        __syncthreads();
        if (active) {
#pragma unroll
            for (int k = 0; k < 8; ++k) *(half8*)(u16 + (size_t)(r0 + k) * UW + 384 + g * 8) = o[k];
        }
    }
}

constexpr int SA = 72, SB = 136;

__device__ __forceinline__ void load_rows8(const half_t* u16, int rowbase, int Lseq, int dir, int jj0, int ucol, half8 (&rr)[8]) {
#pragma unroll
    for (int k = 0; k < 8; ++k) { const int jj = jj0 + k, pos = dir == 0 ? jj : Lseq - 1 - jj; rr[k] = *(const half8*)(u16 + (size_t)(rowbase + pos) * UW + ucol); }
}
__device__ __forceinline__ void transpose8(const half8 (&rr)[8], half8 (&t)[8]) {
#pragma unroll
    for (int i = 0; i < 8; ++i)
#pragma unroll
        for (int k = 0; k < 8; ++k) t[i][k] = rr[k][i];
}
__device__ __forceinline__ void ssd_block(const Frame& F, int layer, int b, int h, int dir) {
    half_t* Cs = (half_t*)F.smem;
    half_t* Bs = Cs + 128 * SA;
    half_t* BT = Bs + 128 * SA;
    half_t* XT = BT + 64 * SB;
    half_t* SC = XT + 64 * SB;
    half_t* ST = SC + 128 * SB;
    float* cum = (float*)(ST + 64 * SA);
    float* dtv = cum + 128;
    float* wes = dtv + 128;
    const half_t* u16 = (const half_t*)(F.ws + WS_U16); const float* ug = (const float*)(F.ws + WS_UG);
    half_t* yout = (half_t*)(F.ws + WS_YF) + (size_t)dir * TT * 384;
    const float* cw = F.in(I_SCW) + layer * 3 * 640; const float* cb = F.in(I_SCB) + layer * 640;
    const float dtb = F.in(I_DTB)[(layer * 2 + dir) * 6 + h];
    const float Aneg = -expf(F.in(I_ALOG)[(layer * 2 + dir) * 6 + h]);
    const float Dh = F.in(I_SD)[layer * 6 + h];
    const int g = h / 3, tid = F.tid, lane = F.lane, wave = F.wave;
    const int kind = tid >> 7, c8 = (tid & 7) * 8, j0 = ((tid >> 3) & 15) * 8;
    const int ch = kind == 0 ? h * 64 + c8 : (kind == 1 ? 384 + g * 64 + c8 : 512 + g * 64 + c8);
    f32x4 accS[1][2]; zero_acc(accS);
    for (int i = tid; i < 64 * SA; i += NT) ST[i] = (half_t)0.f;
    constexpr int NC0 = CTXL / 128, NCT = NC0 + SEQ / 128;
    half8 rr[8]; float ug0 = 0.f, ug1 = 0.f;
    if (kind < 3) load_rows8(u16, TL + b * CTXL, CTXL, dir, j0, 384 + ch, rr);
    if (wave == 7) { const int p0 = dir == 0 ? 2 * lane : CTXL - 1 - 2 * lane, p1 = dir == 0 ? p0 + 1 : p0 - 1;
        ug0 = ug[(size_t)(TL + b * CTXL + p0) * UGW + dir * 6 + h]; ug1 = ug[(size_t)(TL + b * CTXL + p1) * UGW + dir * 6 + h]; }
    __syncthreads();
    for (int cc = 0; cc < NCT; ++cc) {
        const int seg = cc >= NC0 ? 1 : 0, c = seg ? cc - NC0 : cc;
        const int Lseq = seg == 0 ? CTXL : SEQ, rowbase = seg == 0 ? TL + b * CTXL : b * SEQ;
        const bool want_y = (seg == 1) || (layer == 0);
        const int nseg = (cc + 1) >= NC0 ? 1 : 0, ncn = nseg ? cc + 1 - NC0 : cc + 1, nL = nseg == 0 ? CTXL : SEQ, nrb = nseg == 0 ? TL + b * CTXL : b * SEQ;
        if (wave == 7) {
            const float dt0 = fsoftplus(ug0 + dtb), dt1 = fsoftplus(ug1 + dtb);
            const float a0 = dt0 * Aneg, a1 = dt1 * Aneg;
            const float incl = wave_scan_sum(a0 + a1, lane);
            const float c1 = incl, c0 = incl - a1;
            const float cl = wave_last(incl);
            cum[2 * lane] = c0; cum[2 * lane + 1] = c1; dtv[2 * lane] = dt0; dtv[2 * lane + 1] = dt1;
            wes[2 * lane] = dt0 * fexp(cl - c0); wes[2 * lane + 1] = dt1 * fexp(cl - c1);
            if (cc + 1 < NCT) { const int pi = ncn * 128 + 2 * lane, p0 = dir == 0 ? pi : nL - 1 - pi, p1 = dir == 0 ? p0 + 1 : p0 - 1;
                ug0 = ug[(size_t)(nrb + p0) * UGW + dir * 6 + h]; ug1 = ug[(size_t)(nrb + p1) * UGW + dir * 6 + h]; }
        }
        if (kind < 3) {
            if (kind == 0) { half8 t[8]; transpose8(rr, t);
#pragma unroll
                for (int i = 0; i < 8; ++i) *(half8*)(XT + (c8 + i) * SB + j0) = t[i];
            } else if (kind == 1) { half8 t[8]; transpose8(rr, t);
#pragma unroll
                for (int k = 0; k < 8; ++k) *(half8*)(Bs + (j0 + k) * SA + c8) = rr[k];
#pragma unroll
                for (int i = 0; i < 8; ++i) *(half8*)(BT + (c8 + i) * SB + j0) = t[i];
            } else {
#pragma unroll
                for (int k = 0; k < 8; ++k) *(half8*)(Cs + (j0 + k) * SA + c8) = rr[k];
            }
            if (cc + 1 < NCT) load_rows8(u16, nrb, nL, dir, ncn * 128 + j0, 384 + ch, rr);
        }
        __syncthreads();
        const float cl = cum[127];
        if (want_y) {
            { const int ws_ = wave & 1, wl = wave >> 1;
              if (!(ws_ == 1 && wl < 2)) {
                f32x4 g_[4][2]; zero_acc(g_);
                mma_lds<4, 2>(g_, Bs + ws_ * 64 * SA, SA, Cs + wl * 32 * SA, SA, 2, lane);
#pragma unroll
                for (int a = 0; a < 4; ++a) {
                    const int s0 = ws_ * 64 + a * 16 + (lane >> 4) * 4;
                    const f32x4 cs4 = *(const f32x4*)(cum + s0), dt4 = *(const f32x4*)(dtv + s0);
#pragma unroll
                    for (int q = 0; q < 2; ++q) {
                        const int l = wl * 32 + q * 16 + (lane & 15); const float cl_ = cum[l]; half4 hv;
#pragma unroll
                        for (int i = 0; i < 4; ++i) hv[i] = (half_t)((s0 + i) <= l ? g_[a][q][i] * fexp(cl_ - cs4[i]) * dt4[i] : 0.f);
                        *(half4*)(SC + l * SB + s0) = hv;
                    } }
              } }
            f32x4 y1[4][1]; zero_acc(y1);
            mma_lds<4, 1>(y1, ST, SA, Cs + wave * 16 * SA, SA, 2, lane);
            __syncthreads();
            f32x4 y2[4][1]; zero_acc(y2);
            mma_lds<4, 1>(y2, XT, SB, SC + wave * 16 * SB, SB, wave / 2 + 1, lane);
            { const int l = wave * 16 + (lane & 15); const float el = fexp(cum[l]);
              const int pi = c * 128 + l, pos = dir == 0 ? pi : Lseq - 1 - pi;
#pragma unroll
              for (int a = 0; a < 4; ++a) { const int p0 = a * 16 + (lane >> 4) * 4; f32x4 y;
#pragma unroll
                  for (int i = 0; i < 4; ++i) y[i] = y1[a][0][i] * el + y2[a][0][i];
                  if (dir == 0) {
#pragma unroll
                      for (int i = 0; i < 4; ++i) y[i] += Dh * (float)XT[(p0 + i) * SB + l]; }
                  *(half4*)(yout + (size_t)(rowbase + pos) * 384 + h * 64 + p0) = to_half4(y); } }
        }
        { const float dec = fexp(cl);
#pragma unroll
          for (int q = 0; q < 2; ++q) accS[0][q] *= dec;
          const int r = lane & 15, kq = (lane >> 4) * 8;
#pragma unroll
          for (int ks = 0; ks < 4; ++ks) {
              const half8 a = *(const half8*)(BT + ((wave >> 1) * 16 + r) * SB + ks * 32 + kq);
              const f32x4 e0 = *(const f32x4*)(wes + ks * 32 + kq), e1 = *(const f32x4*)(wes + ks * 32 + kq + 4);
#pragma unroll
              for (int q = 0; q < 2; ++q) { half8 bb = *(const half8*)(XT + ((wave & 1) * 32 + q * 16 + r) * SB + ks * 32 + kq);
#pragma unroll
                  for (int i = 0; i < 4; ++i) { bb[i] = (half_t)((float)bb[i] * e0[i]); bb[4 + i] = (half_t)((float)bb[4 + i] * e1[i]); }
                  accS[0][q] = mfma16(a, bb, accS[0][q]); } } }
        __syncthreads();
#pragma unroll
        for (int q = 0; q < 2; ++q) { const int p = (wave & 1) * 32 + q * 16 + (lane & 15), n0 = (wave >> 1) * 16 + (lane >> 4) * 4; *(half4*)(ST + p * SA + n0) = to_half4(accS[0][q]); }
    }
    __syncthreads();
}

__device__ __forceinline__ void mlstm_block(const Frame& F, int layer, int b, int h, int dir) {
    half_t* Qs = (half_t*)F.smem;
    half_t* Ks = Qs + 128 * SA;
    half_t* KT = Ks + 128 * SA;
    half_t* VT = KT + 64 * SB;
    half_t* SC = VT + 64 * SB;
    half_t* CS = SC + 128 * SB;
    float* ig = (float*)(CS + 64 * SA);
    float* cumf = ig + 128; float* gsv = cumf + 128; float* mtv = gsv + 128; float* ee = mtv + 128; float* dn = ee + 128;
    float* nvec = dn + 128;
    float* scal = nvec + 64;
    const half_t* u16 = (const half_t*)(F.ws + WS_U16); const float* ug = (const float*)(F.ws + WS_UG);
    half_t* hout = (half_t*)(F.ws + WS_YF) + (size_t)(2 + dir) * TT * 384;
    const float* cw = F.in(I_MCW) + layer * 3 * 768; const float* cb = F.in(I_MCB) + layer * 768;
    const float bi = F.in(I_MGB)[((layer * 2 + dir) * 2 + 0) * 6 + h], bf = F.in(I_MGB)[((layer * 2 + dir) * 2 + 1) * 6 + h];
    const int tid = F.tid, lane = F.lane, wave = F.wave;
    const int kind = tid >> 7, c8 = (tid & 7) * 8, j0 = ((tid >> 3) & 15) * 8;
    const int ch = kind == 0 ? h * 64 + c8 : 384 + h * 64 + c8;
    f32x4 accC[1][2]; zero_acc(accC);
    float m_in = 0.f;
    for (int i = tid; i < 64 * SA; i += NT) CS[i] = (half_t)0.f;
    if (tid < 64) nvec[tid] = 0.f;
    constexpr int NC0 = CTXL / 128, NCT = NC0 + SEQ / 128;
    half8 rr[8]; float gi0 = 0.f, gi1 = 0.f, gf0 = 0.f, gf1 = 0.f;
    const int ucol = kind == 2 ? 1792 + h * 64 + c8 : 1024 + ch;
    if (kind < 3) load_rows8(u16, TL + b * CTXL, CTXL, dir, j0, ucol, rr);
    if (wave == 7) { const int p0 = dir == 0 ? 2 * lane : CTXL - 1 - 2 * lane, p1 = dir == 0 ? p0 + 1 : p0 - 1;
        const float* g0 = ug + (size_t)(TL + b * CTXL + p0) * UGW + 12 + dir * 12; const float* g1 = ug + (size_t)(TL + b * CTXL + p1) * UGW + 12 + dir * 12;
        gi0 = g0[h]; gf0 = g0[6 + h]; gi1 = g1[h]; gf1 = g1[6 + h]; }
    half8 ones;
#pragma unroll
    for (int i = 0; i < 8; ++i) ones[i] = (half_t)1.0f;
    __syncthreads();
    for (int cc = 0; cc < NCT; ++cc) {
        const int seg = cc >= NC0 ? 1 : 0, c = seg ? cc - NC0 : cc;
        const int Lseq = seg == 0 ? CTXL : SEQ, rowbase = seg == 0 ? TL + b * CTXL : b * SEQ;
        const bool want_y = (seg == 1) || (layer == 0);
        const int nseg = (cc + 1) >= NC0 ? 1 : 0, ncn = nseg ? cc + 1 - NC0 : cc + 1, nL = nseg == 0 ? CTXL : SEQ, nrb = nseg == 0 ? TL + b * CTXL : b * SEQ;
        if (wave == 7) {
            const float i0 = gi0 + bi, i1 = gi1 + bi, lf0 = flogsigmoid(gf0 + bf), lf1 = flogsigmoid(gf1 + bf);
            const float incl = wave_scan_sum(lf0 + lf1, lane);
            const float c1 = incl, c0 = incl - lf1;
            const float tot = wave_last(incl);
            const float r0 = i0 - c0, r1 = i1 - c1;
            const float pincl = wave_scan_max(fmaxf(r0, r1), lane);
            const float pexcl = wave_shr1(pincl, -3.0e38f, lane);
            const float pm0 = fmaxf(pexcl, r0), pm1 = pincl;
            const float pmlast = wave_last(pincl);
            const float m_new = fmaxf(tot + m_in, tot + pmlast);
            ig[2 * lane] = i0; ig[2 * lane + 1] = i1; cumf[2 * lane] = c0; cumf[2 * lane + 1] = c1; gsv[2 * lane] = r0; gsv[2 * lane + 1] = r1;
            mtv[2 * lane] = fmaxf(c0 + m_in, c0 + pm0); mtv[2 * lane + 1] = fmaxf(c1 + m_in, c1 + pm1);
            ee[2 * lane] = fexp(r0 + tot - m_new); ee[2 * lane + 1] = fexp(r1 + tot - m_new);
            if (lane == 0) { scal[0] = tot; scal[1] = m_new; }
            if (cc + 1 < NCT) { const int pi = ncn * 128 + 2 * lane, p0 = dir == 0 ? pi : nL - 1 - pi, p1 = dir == 0 ? p0 + 1 : p0 - 1;
                const float* g0 = ug + (size_t)(nrb + p0) * UGW + 12 + dir * 12; const float* g1 = ug + (size_t)(nrb + p1) * UGW + 12 + dir * 12;
                gi0 = g0[h]; gf0 = g0[6 + h]; gi1 = g1[h]; gf1 = g1[6 + h]; }
        }
        if (kind == 0) {
#pragma unroll
            for (int k = 0; k < 8; ++k) *(half8*)(Qs + (j0 + k) * SA + c8) = rr[k];
        } else if (kind == 1) { half8 t[8]; transpose8(rr, t);
#pragma unroll
            for (int k = 0; k < 8; ++k) *(half8*)(Ks + (j0 + k) * SA + c8) = rr[k];
#pragma unroll
            for (int i = 0; i < 8; ++i) *(half8*)(KT + (c8 + i) * SB + j0) = t[i];
        } else if (kind == 2) { half8 t[8]; transpose8(rr, t);
#pragma unroll
            for (int i = 0; i < 8; ++i) *(half8*)(VT + (c8 + i) * SB + j0) = t[i];
        }
        if (kind < 3 && cc + 1 < NCT) load_rows8(u16, nrb, nL, dir, ncn * 128 + j0, ucol, rr);
        __syncthreads();
        const float tot = scal[0], m_new = scal[1];
        if (want_y) {
            { const int ws_ = wave & 1, wl = wave >> 1;
              if (!(ws_ == 1 && wl < 2)) {
                f32x4 g_[4][2]; zero_acc(g_);
                mma_lds<4, 2>(g_, Ks + ws_ * 64 * SA, SA, Qs + wl * 32 * SA, SA, 2, lane);
#pragma unroll
                for (int a = 0; a < 4; ++a) {
                    const int s0 = ws_ * 64 + a * 16 + (lane >> 4) * 4; const f32x4 gs4 = *(const f32x4*)(gsv + s0);
#pragma unroll
                    for (int q = 0; q < 2; ++q) {
                        const int l = wl * 32 + q * 16 + (lane & 15); const float cm = cumf[l] - mtv[l]; half4 hv;
#pragma unroll
                        for (int i = 0; i < 4; ++i) hv[i] = (half_t)((s0 + i) <= l ? g_[a][q][i] * fexp(cm + gs4[i]) : 0.f);
                        *(half4*)(SC + l * SB + s0) = hv;
                    } }
              } }
            f32x4 h1[4][1]; zero_acc(h1);
            mma_lds<4, 1>(h1, CS, SA, Qs + wave * 16 * SA, SA, 2, lane);
            f32x4 dq = {0.f, 0.f, 0.f, 0.f};
            { const int r_ = lane & 15, kq_ = (lane >> 4) * 8;
#pragma unroll
              for (int ks = 0; ks < 2; ++ks) { half8 na; const f32x4 n0 = *(const f32x4*)(nvec + ks * 32 + kq_), n1 = *(const f32x4*)(nvec + ks * 32 + kq_ + 4);
#pragma unroll
                  for (int i = 0; i < 4; ++i) { na[i] = (half_t)n0[i]; na[4 + i] = (half_t)n1[i]; }
                  dq = mfma16(na, *(const half8*)(Qs + (wave * 16 + r_) * SA + ks * 32 + kq_), dq); } }
            __syncthreads();
            f32x4 h2[4]; f32x4 d1 = {0.f, 0.f, 0.f, 0.f};
#pragma unroll
            for (int a = 0; a < 4; ++a) h2[a] = (f32x4){0.f, 0.f, 0.f, 0.f};
            { const int r = lane & 15, kq = (lane >> 4) * 8;
              for (int ks = 0; ks < wave / 2 + 1; ++ks) {
                  const half8 bfr = *(const half8*)(SC + (wave * 16 + r) * SB + ks * 32 + kq);
#pragma unroll
                  for (int a = 0; a < 4; ++a) { const half8 afr = *(const half8*)(VT + (a * 16 + r) * SB + ks * 32 + kq); h2[a] = mfma16(afr, bfr, h2[a]); }
                  d1 = mfma16(ones, bfr, d1); } }
            { const int l = wave * 16 + (lane & 15); const float ai = fexp(cumf[l] + m_in - mtv[l]); const float rden = 1.0f / fmaxf(fabsf(dq[0] * ai + d1[0]), fexp(-mtv[l]));
              const int pi = c * 128 + l, pos = dir == 0 ? pi : Lseq - 1 - pi;
#pragma unroll
              for (int a = 0; a < 4; ++a) { const int v0 = a * 16 + (lane >> 4) * 4; f32x4 y;
#pragma unroll
                  for (int i = 0; i < 4; ++i) y[i] = (h1[a][0][i] * ai + h2[a][i]) * rden;
                  *(half4*)(hout + (size_t)(rowbase + pos) * 384 + h * 64 + v0) = to_half4(y); } }
        }
        { const float sc = fexp(tot + m_in - m_new);
#pragma unroll
          for (int q = 0; q < 2; ++q) accC[0][q] *= sc;
          { const int r = lane & 15, kq = (lane >> 4) * 8;
#pragma unroll
            for (int ks = 0; ks < 4; ++ks) {
              const half8 a = *(const half8*)(KT + ((wave >> 1) * 16 + r) * SB + ks * 32 + kq);
              const f32x4 e0 = *(const f32x4*)(ee + ks * 32 + kq), e1 = *(const f32x4*)(ee + ks * 32 + kq + 4);
#pragma unroll
              for (int q = 0; q < 2; ++q) { half8 bb = *(const half8*)(VT + ((wave & 1) * 32 + q * 16 + r) * SB + ks * 32 + kq);
#pragma unroll
                  for (int i = 0; i < 4; ++i) { bb[i] = (half_t)((float)bb[i] * e0[i]); bb[4 + i] = (half_t)((float)bb[4 + i] * e1[i]); }
                  accC[0][q] = mfma16(a, bb, accC[0][q]); } } }
          if ((wave & 1) == 0) { f32x4 an = {0.f, 0.f, 0.f, 0.f}; const int r_ = lane & 15, kq_ = (lane >> 4) * 8;
#pragma unroll
              for (int ks = 0; ks < 4; ++ks) { half8 eb; const f32x4 e0 = *(const f32x4*)(ee + ks * 32 + kq_), e1 = *(const f32x4*)(ee + ks * 32 + kq_ + 4);
#pragma unroll
                  for (int i = 0; i < 4; ++i) { eb[i] = (half_t)e0[i]; eb[4 + i] = (half_t)e1[i]; }
                  an = mfma16(*(const half8*)(KT + ((wave >> 1) * 16 + r_) * SB + ks * 32 + kq_), eb, an); }
              if ((lane & 15) == 0) {
#pragma unroll
                  for (int i = 0; i < 4; ++i) { const int d = (wave >> 1) * 16 + (lane >> 4) * 4 + i; nvec[d] = sc * nvec[d] + an[i]; } } } }
        m_in = m_new;
        __syncthreads();
#pragma unroll
        for (int q = 0; q < 2; ++q) { const int v = (wave & 1) * 32 + q * 16 + (lane & 15), d0 = (wave >> 1) * 16 + (lane >> 4) * 4; *(half4*)(CS + v * SA + d0) = to_half4(accC[0][q]); }
    }
    __syncthreads();
}

__device__ __forceinline__ cplx cmul(cplx a, cplx b) { return cplx{a.x * b.x - a.y * b.y, a.x * b.y + a.y * b.x}; }
__device__ __forceinline__ cplx cadd(cplx a, cplx b) { return cplx{a.x + b.x, a.y + b.y}; }
__device__ __forceinline__ cplx csub(cplx a, cplx b) { return cplx{a.x - b.x, a.y - b.y}; }
__device__ __forceinline__ void sincos_turns(float x, float& s, float& c) {
#ifdef EMU
    s = sinf(6.283185307179586f * x); c = cosf(6.283185307179586f * x);
#else
    s = __builtin_amdgcn_sinf(x); c = __builtin_amdgcn_cosf(x);
#endif
}
#define PADI(i) ((i) + ((i) >> 5))
template <bool INV> __device__ __forceinline__ void r4(cplx& a0, cplx& a1, cplx& a2, cplx& a3) {
    const cplx t0 = cadd(a0, a2), t1 = csub(a0, a2), t2 = cadd(a1, a3), t3 = csub(a1, a3);
    a0 = cadd(t0, t2); a2 = csub(t0, t2);
    if (!INV) { a1 = cplx{t1.x + t3.y, t1.y - t3.x}; a3 = cplx{t1.x - t3.y, t1.y + t3.x}; }
    else      { a1 = cplx{t1.x - t3.y, t1.y + t3.x}; a3 = cplx{t1.x + t3.y, t1.y - t3.x}; }
}
template <bool INV> __device__ __forceinline__ void fft16(cplx (&v)[16]) {
#pragma unroll
    for (int l0 = 0; l0 < 4; ++l0) r4<INV>(v[l0], v[l0 + 4], v[l0 + 8], v[l0 + 12]);
    const float C1 = 0.9238795325112867f, S1 = 0.3826834323650898f, C2 = 0.7071067811865476f;
    const float sg = INV ? 1.f : -1.f;
#define TWM(idx, cr, ci) v[idx] = cmul(v[idx], cplx{(cr), sg * (ci)})
    TWM(1 + 4 * 1, C1, S1); TWM(2 + 4 * 1, C2, C2); TWM(3 + 4 * 1, S1, C1);
    TWM(1 + 4 * 2, C2, C2); TWM(2 + 4 * 2, 0.f, 1.f); TWM(3 + 4 * 2, -C2, C2);
    TWM(1 + 4 * 3, S1, C1); TWM(2 + 4 * 3, -C2, C2); TWM(3 + 4 * 3, -C1, -S1);
#undef TWM
    cplx o[16];
#pragma unroll
    for (int m0 = 0; m0 < 4; ++m0) { cplx a0 = v[4 * m0], a1 = v[4 * m0 + 1], a2 = v[4 * m0 + 2], a3 = v[4 * m0 + 3]; r4<INV>(a0, a1, a2, a3);
        o[m0] = a0; o[m0 + 4] = a1; o[m0 + 8] = a2; o[m0 + 12] = a3; }
#pragma unroll
    for (int i = 0; i < 16; ++i) v[i] = o[i];
}
__device__ __forceinline__ void twpow(cplx w1, cplx (&w)[16]) {
    w[1] = w1; w[2] = cmul(w1, w1); w[3] = cmul(w[2], w1); w[4] = cmul(w[2], w[2]); w[5] = cmul(w[4], w1); w[6] = cmul(w[4], w[2]); w[7] = cmul(w[4], w[3]); w[8] = cmul(w[4], w[4]);
#pragma unroll
    for (int m = 9; m < 16; ++m) w[m] = cmul(w[8], w[m - 8]);
}
#ifdef EMU
#define OPAQUE_I(x)
#else
#define OPAQUE_I(x) asm volatile("" : "+v"(x))
#endif
template <int NS> __device__ __forceinline__ void fft_fwd16(cplx* buf0, cplx* buf1, int N, int tid, int TS = NT) {
#pragma unroll 1
    for (int n = N; n >= 32; n >>= 4) { const int q = n >> 4, qs = q + (q >> 5);
        for (int i = tid; i < N / 16; i += TS) {
            const int blk = i / q, j = i - blk * q; int pb = PADI(blk * n + j); OPAQUE_I(pb);
            float s, c; sincos_turns(-(float)j / (float)n, s, c);
            const cplx w1{c, s};
#pragma unroll
            for (int st = 0; st < NS; ++st) { cplx* buf = (st == 0 ? buf0 : buf1) + pb;
                cplx v[16];
#pragma unroll
                for (int l = 0; l < 16; ++l) v[l] = buf[l * qs];
                fft16<false>(v);
                buf[0] = v[0];
                cplx wm = w1;
#pragma unroll
                for (int m = 1; m < 16; ++m) { buf[m * qs] = cmul(v[m], wm); wm = cmul(wm, w1); }
                LOADER_FENCE(); }
        }
        __syncthreads(); }
}
template <int NS> __device__ __forceinline__ void fft_inv16(cplx* buf0, cplx* buf1, int N, int tid, int TS = NT) {
#pragma unroll 1
    for (int n = 32; n <= N; n <<= 4) { const int q = n >> 4, qs = q + (q >> 5);
        for (int i = tid; i < N / 16; i += TS) {
            const int blk = i / q, j = i - blk * q; int pb = PADI(blk * n + j); OPAQUE_I(pb);
            float s, c; sincos_turns((float)j / (float)n, s, c);
            const cplx w1{c, s};
#pragma unroll
            for (int st = 0; st < NS; ++st) { cplx* buf = (st == 0 ? buf0 : buf1) + pb;
                cplx v[16];
                v[0] = buf[0];
                cplx wm = w1;
#pragma unroll
                for (int m = 1; m < 16; ++m) { v[m] = cmul(buf[m * qs], wm); wm = cmul(wm, w1); }
                fft16<true>(v);
#pragma unroll
                for (int l = 0; l < 16; ++l) buf[l * qs] = v[l];
                LOADER_FENCE(); }
        }
        __syncthreads(); }
}
static_assert(2 * SEQ == 512 || 2 * SEQ == 8192, "FFT size must be 2*16^k");
static_assert(2 * CTXL == 512 || 2 * CTXL == 8192, "FFT size must be 2*16^k");
constexpr int HBUF = (2 * SEQ + (2 * SEQ) / 32 + 8);
constexpr int HPT = (SEQ + NT - 1) / NT;
__device__ __forceinline__ void hy_conv8(const half_t* p, int t0, int L, float w0, float w1, float w2, float bsv, float (&o)[8]) {
    const half8 m = *(const half8*)(p + t0);
    float e[10]; e[0] = t0 > 0 ? (float)p[t0 - 1] : 0.f; e[9] = t0 + 8 < L ? (float)p[t0 + 8] : 0.f;
#pragma unroll
    for (int i = 0; i < 8; ++i) e[i + 1] = (float)m[i];
#pragma unroll
    for (int i = 0; i < 8; ++i) o[i] = w0 * e[i] + w1 * e[i + 1] + w2 * e[i + 2] + bsv;
}
template <int TS> __device__ __forceinline__ float team_sum(float v, const Frame& F, float* red) {
    if constexpr (TS == NT) { v = wave_sum(v); if (F.lane == 0) red[F.wave] = v; __syncthreads(); float t = 0.f; for (int w = 0; w < NT / 64; ++w) t += red[w]; return t; }
    else { static_assert(TS == 32, "team size");
#pragma unroll
        for (int m = 16; m >= 1; m >>= 1) v += __shfl_xor(v, m);
        __syncthreads(); return v; }
}
template <int NS, int TS, int HP> __device__ __forceinline__ void hyena_seg_t(const Frame& F, int layer, int c0, const int seg) {
    const int HB = (seg == 0 ? 2 * SEQ : 2 * CTXL) + (seg == 0 ? 2 * SEQ : 2 * CTXL) / 32 + 8;
    const int tid = F.tid % TS, team = F.tid / TS, c = c0 + team;
    cplx* bufA = (cplx*)F.smem + (size_t)team * 2 * HB;
    cplx* bufB = bufA + HB;
    float* red = (float*)((cplx*)F.smem + (size_t)(NT / TS) * 2 * HB);
    const float* cwp = F.in(I_HCW) + layer * 3 * 768; const float* cbp = F.in(I_HCB) + layer * 768;
    {
        const int L = seg == 0 ? SEQ : CTXL, N = 2 * L;
        const half_t* hyt = (const half_t*)(F.ws + WS_HYT) + (seg == 0 ? 0 : (size_t)NB * 768 * SEQ);
        float* z1 = (float*)(F.ws + WS_XN) + (seg == 0 ? 0 : (size_t)NB * 256 * SEQ);
        float* yht = (float*)(F.ws + WS_YHT) + (seg == 0 ? 0 : (size_t)NB * 256 * SEQ);
        const float* ft = (const float*)(F.ws + WS_FT) + (seg == 0 ? (size_t)layer * 256 * 4 * SEQ : (size_t)2 * 256 * 4 * SEQ);
        for (int order = 0; order < 2; ++order) {
            const float* hfw = ft + ((size_t)(c * 2 + order) * 2 + 0) * L; const float* hbw = ft + ((size_t)(c * 2 + order) * 2 + 1) * L;
            float asum = 0.f;
            for (int i_ = tid; i_ < N; i_ += TS) { int i = i_; OPAQUE_I(i); const float v = i < L ? hfw[i] : (i == L ? 0.f : hbw[N - i]); bufA[PADI(i)] = cplx{v, 0.f}; asum += fabsf(v); }
            const float tot = team_sum<TS>(asum, F, red);
            fft_fwd16<1>(bufA, bufA, N, tid, TS);
            half4 Hh[HP];
            const float hs = 1.0f / tot, invN = 1.0f / (float)N;
#pragma unroll
            for (int k = 0; k < HP; ++k) { int i = tid + k * TS; OPAQUE_I(i); half4 hv;
                if (i < N / 2) { const cplx a = bufA[PADI(2 * i)], b_ = bufA[PADI(2 * i + 1)]; const cplx s = cadd(a, b_), d = csub(a, b_);
                    hv[0] = (half_t)(s.x * hs); hv[1] = (half_t)(s.y * hs); hv[2] = (half_t)(d.x * hs); hv[3] = (half_t)(d.y * hs); }
                else { hv[0] = hv[1] = hv[2] = hv[3] = (half_t)0.f; }
                Hh[k] = hv; LOADER_FENCE(); }
            __syncthreads();
            const int gch = 256 * (order + 1) + c;
            for (int pr = 0; pr < NB / 2; pr += NS) {
#pragma unroll
                for (int st = 0; st < NS; ++st) { cplx* buf = st == 0 ? bufA : bufB; const int b0 = 2 * (pr + st), b1 = b0 + 1;
                    const float vw0 = cwp[c], vw1 = cwp[768 + c], vw2 = cwp[1536 + c], vb = cbp[c];
                    const half_t* v0p = hyt + ((size_t)b0 * 768 + c) * L; const half_t* v1p = hyt + ((size_t)b1 * 768 + c) * L;
                    const float* z0q = z1 + ((size_t)b0 * 256 + c) * L; const float* z1q = z1 + ((size_t)b1 * 256 + c) * L;
                    for (int t0_ = tid * 8; t0_ < N; t0_ += TS * 8) { int t0 = t0_; OPAQUE_I(t0);
                        if (t0 < L) { float za[8], zb[8];
                            if (order == 0) { hy_conv8(v0p, t0, L, vw0, vw1, vw2, vb, za); hy_conv8(v1p, t0, L, vw0, vw1, vw2, vb, zb); }
                            else {
#pragma unroll
                                for (int i = 0; i < 8; ++i) { za[i] = z0q[t0 + i]; zb[i] = z1q[t0 + i]; } }
#pragma unroll
                            for (int i = 0; i < 8; ++i) buf[PADI(t0 + i)] = cplx{za[i], zb[i]}; }
                        else {
#pragma unroll
                            for (int i = 0; i < 8; ++i) buf[PADI(t0 + i)] = cplx{0.f, 0.f}; }
                        LOADER_FENCE();
                    } }
                __syncthreads();
                fft_fwd16<NS>(bufA, bufB, N, tid, TS);
#pragma unroll
                for (int st = 0; st < NS; ++st) { cplx* buf = st == 0 ? bufA : bufB;
#pragma unroll
                    for (int k = 0; k < HP; ++k) { int i = tid + k * TS; OPAQUE_I(i);
                        if (i < N / 2) { const cplx a = buf[PADI(2 * i)], b_ = buf[PADI(2 * i + 1)];
                            const cplx h0{(float)Hh[k][0] * invN, (float)Hh[k][1] * invN}, h1{(float)Hh[k][2] * invN, (float)Hh[k][3] * invN};
                            const cplx s = cmul(cadd(a, b_), h0), d = cmul(csub(a, b_), h1);
                            buf[PADI(2 * i)] = cadd(s, d); buf[PADI(2 * i + 1)] = csub(s, d); }
                        LOADER_FENCE(); } }
                __syncthreads();
                fft_inv16<NS>(bufA, bufB, N, tid, TS);
#pragma unroll
                for (int st = 0; st < NS; ++st) { cplx* buf = st == 0 ? bufA : bufB; const int b0 = 2 * (pr + st), b1 = b0 + 1;
                    const float gw0 = cwp[gch], gw1 = cwp[768 + gch], gw2 = cwp[1536 + gch], gb = cbp[gch];
                    const float vw0 = cwp[c], vw1 = cwp[768 + c], vw2 = cwp[1536 + c], vb = cbp[c];
                    const float skip = F.in(I_HSKIP)[(layer * 2 + order) * 256 + c];
                    const half_t* v0p = hyt + ((size_t)b0 * 768 + c) * L; const half_t* v1p = hyt + ((size_t)b1 * 768 + c) * L;
                    const float* z0q = z1 + ((size_t)b0 * 256 + c) * L; const float* z1q = z1 + ((size_t)b1 * 256 + c) * L;
                    const half_t* g0p = hyt + ((size_t)b0 * 768 + gch) * L; const half_t* g1p = hyt + ((size_t)b1 * 768 + gch) * L;
                    float* d0 = (order == 0 ? z1 : yht) + ((size_t)b0 * 256 + c) * L; float* d1 = (order == 0 ? z1 : yht) + ((size_t)b1 * 256 + c) * L;
                    for (int t0_ = tid * 8; t0_ < L; t0_ += TS * 8) { int t0 = t0_; OPAQUE_I(t0);
                        float za[8], zb[8], ga[8], gb_[8];
                        if (order == 0) { hy_conv8(v0p, t0, L, vw0, vw1, vw2, vb, za); hy_conv8(v1p, t0, L, vw0, vw1, vw2, vb, zb); }
                        else {
#pragma unroll
                            for (int i = 0; i < 8; ++i) { za[i] = z0q[t0 + i]; zb[i] = z1q[t0 + i]; } }
                        hy_conv8(g0p, t0, L, gw0, gw1, gw2, gb, ga); hy_conv8(g1p, t0, L, gw0, gw1, gw2, gb, gb_);
                        f32x4 oa[2], ob[2];
#pragma unroll
                        for (int i = 0; i < 8; ++i) { const cplx y = buf[PADI(t0 + i)]; oa[i >> 2][i & 3] = ga[i] * (y.x + skip * za[i]); ob[i >> 2][i & 3] = gb_[i] * (y.y + skip * zb[i]); }
                        *(f32x4*)(d0 + t0) = oa[0]; *(f32x4*)(d0 + t0 + 4) = oa[1]; *(f32x4*)(d1 + t0) = ob[0]; *(f32x4*)(d1 + t0 + 4) = ob[1];
                        LOADER_FENCE();
                    } }
                __syncthreads();
            }
        }
    }
}
constexpr int HP_L = (SEQ + NT - 1) / NT, HP_C = (CTXL + 31) / 32;
static_assert((size_t)(NT / 32) * 2 * (2 * CTXL + 2 * CTXL / 32 + 8) * 8 + 256 <= (size_t)LDS_BYTES - 64, "ctx team buffers must fit in LDS");
__device__ __forceinline__ void hyena_channel(const Frame& F, int layer, int c) {
    constexpr int NS = (NB % 4 == 0) ? 2 : 1;
    hyena_seg_t<NS, NT, HP_L>(F, layer, c, 0);
}
__device__ __forceinline__ void hyena_ctx_group(const Frame& F, int layer, int g) {
    constexpr int NS = (NB % 4 == 0) ? 2 : 1;
    hyena_seg_t<NS, 32, HP_C>(F, layer, g * (NT / 32), 1);
}
__device__ __forceinline__ int queue_pull(const Frame& F, unsigned* head) {
    int* slot = (int*)(F.smem + LDS_BYTES - 64);
    __syncthreads();
    if (F.tid == 0) *slot = (int)atomicAdd(head, 1u);
    __syncthreads();
    const int v = *slot;
    return v;
}
__device__ __forceinline__ void phase_mixers(const Frame& F, int layer) {
    const int bid = blockIdx.x;
    constexpr int NSCAN = 2 * NB * 6 * 2;
    unsigned* qhead = (unsigned*)(F.ws + WS_CTL) + CW_QUE + layer * 128;
    if (bid < NSCAN) {
        const int k = bid >> 1, kind = bid & 1, dir = k % 2, h = (k / 2) % 6, b = k / 12;
        if (kind == 0) ssd_block(F, layer, b, h, dir); else mlstm_block(F, layer, b, h, dir);
    }
    for (;;) { const int c = queue_pull(F, qhead); if (c >= 256) break; hyena_channel(F, layer, c); }
    if (layer == 0) for (;;) { const int g = queue_pull(F, qhead + 32); if (g >= 256 / (NT / 32)) break; hyena_ctx_group(F, layer, g); }
    for (;;) { const int it = queue_pull(F, qhead + 64); if (it >= IT_TMOE) break; moe_transpose_item(F, layer, it); }
}

__device__ __forceinline__ void phase_combine(const Frame& F, int layer) {
    const int nrows = layer == 0 ? TT : TL;
    const half_t* u16 = (const half_t*)(F.ws + WS_U16);
    const half_t* yf = (const half_t*)(F.ws + WS_YF); const half_t* yb = yf + (size_t)TT * 384; const half_t* hf = yb + (size_t)TT * 384; const half_t* hb = hf + (size_t)TT * 384;
    half_t* yl = (half_t*)(F.ws + WS_XN);
    const float* snw = F.in(I_SNW) + layer * 384; const float* mnw = F.in(I_MNW) + layer * 384;
    const int lane = F.lane, k8 = (lane < 48 ? lane : 0) * 8, nwaves = gridDim.x * (NT / 64);
    f32x4 sw[2], mw[2];
#pragma unroll
    for (int q = 0; q < 2; ++q) { sw[q] = *(const f32x4*)(snw + k8 + q * 4); mw[q] = *(const f32x4*)(mnw + k8 + q * 4); }
    int row = blockIdx.x * (NT / 64) + F.wave;
    half8 a[6];
#define COMB_LOAD(dst, r) { const size_t ro = (size_t)(r); dst[0] = *(const half8*)(yf + ro * 384 + k8); dst[1] = *(const half8*)(yb + ro * 384 + k8); dst[2] = *(const half8*)(u16 + ro * UW + k8); \
        dst[3] = *(const half8*)(hf + ro * 384 + k8); dst[4] = *(const half8*)(hb + ro * 384 + k8); dst[5] = *(const half8*)(u16 + ro * UW + 2176 + k8); }
    if (row < nrows) COMB_LOAD(a, row)
    for (; row < nrows; row += nwaves) {
        const int nrow = row + nwaves;
        half8 an[6];
        if (nrow < nrows) COMB_LOAD(an, nrow)
        const size_t ro = (size_t)row;
        float g[8], hv[8]; float ss = 0.f, hs = 0.f;
#pragma unroll
        for (int i = 0; i < 8; ++i) { g[i] = ((float)a[0][i] + (float)a[1][i]) * fsilu((float)a[2][i]); ss += g[i] * g[i]; hv[i] = (float)a[3][i] + (float)a[4][i]; hs += hv[i]; }
        if (lane >= 48) ss = 0.f;
        ss = wave_sum(ss);
        hs += __shfl_xor(hs, 1); hs += __shfl_xor(hs, 2); hs += __shfl_xor(hs, 4);
        const float mu = hs * (1.0f / 64.f);
        float vs = 0.f;
#pragma unroll
        for (int i = 0; i < 8; ++i) { hv[i] -= mu; vs += hv[i] * hv[i]; }
        vs += __shfl_xor(vs, 1); vs += __shfl_xor(vs, 2); vs += __shfl_xor(vs, 4);
        const float rs = 1.0f / sqrtf(ss * (1.0f / 384.f) + EPSF), rstd = 1.0f / sqrtf(vs * (1.0f / 64.f) + EPSF);
        if (lane < 48) { half8 o1, o2;
#pragma unroll
            for (int i = 0; i < 8; ++i) { o1[i] = (half_t)(g[i] * rs * sw[i >> 2][i & 3]); o2[i] = (half_t)(hv[i] * rstd * mw[i >> 2][i & 3] / (1.0f + fexp(-(float)a[5][i]))); }
            *(half8*)(yl + ro * D + k8) = o1; *(half8*)(yl + ro * D + 640 + k8) = o2; }
#pragma unroll
        for (int i = 0; i < 6; ++i) a[i] = an[i];
    }
#undef COMB_LOAD
    { const int ntile = nrows / 32, hbk = blockIdx.x * 2 + (F.tid >> 8), c = F.tid & 255;
      for (int tl = hbk; tl < ntile; tl += gridDim.x * 2) {
          const int row0 = tl * 32; const bool isl = row0 < TL; const int L = isl ? SEQ : CTXL; const int rc = isl ? row0 : row0 - TL; const int b = rc / L, t0 = rc % L;
          const float* src = (const float*)(F.ws + WS_YHT) + (isl ? 0 : (size_t)NB * 256 * SEQ) + ((size_t)b * 256 + c) * L + t0;
          f32x4 v[8];
#pragma unroll
          for (int q = 0; q < 8; ++q) v[q] = *(const f32x4*)(src + q * 4);
#pragma unroll
          for (int i = 0; i < 32; ++i) yl[(size_t)(row0 + i) * D + 384 + c] = (half_t)v[i >> 2][i & 3]; } }
}

struct EpiOutproj {
    static constexpr bool PERM = true;
    Frame F; int layer;
    __device__ __forceinline__ void operator()(const f32x4 (&acc)[2][2][4][2], const g8::Unit& u, int wr, int wc, int fr, int fq) const {
#pragma unroll
        for (int ai = 0; ai < 2; ++ai)
#pragma unroll
            for (int m = 0; m < 4; ++m) {
                const int srow = u.pm * 256 + ai * 128 + wr * 64 + m * 16 + fr;
                int row = srow;
                if (layer == 1 && srow < TL) { const int b = srow / SEQ, s = srow % SEQ; row = b * SEQ + (s % GROWS) * GW + s / GROWS; }
                const float* g1 = modp(F, layer, row_mod(row), 2);
                const float* xi = F.xrow_in(layer, row); float* xo = F.xrow(row);
#pragma unroll
                for (int bj = 0; bj < 2; ++bj) { const int c0 = u.pn * 256 + bj * 128 + wc * 32 + 8 * fq;
                    const f32x4 x0 = *(const f32x4*)(xi + c0), x1 = *(const f32x4*)(xi + c0 + 4), g0 = *(const f32x4*)(g1 + c0), g1v = *(const f32x4*)(g1 + c0 + 4);
                    *(f32x4*)(xo + c0) = x0 + g0 * acc[ai][bj][m][0]; *(f32x4*)(xo + c0 + 4) = x1 + g1v * acc[ai][bj][m][1]; }
            }
    }
};
__device__ __forceinline__ void outproj_ctx_tiles(const Frame& F, int layer) {
    const half_t* yl = (const half_t*)(F.ws + WS_XN) + (size_t)TL * D;
    const half_t* wt = (const half_t*)(F.ws + WS_WOUT) + (size_t)layer * D * D;
    const int lane = F.lane, wave = F.wave, r = lane & 15, kq = (lane >> 4) * 8;
    const int ntile = (TC / 64) * (D / 64);
    for (int t = blockIdx.x; t < ntile; t += gridDim.x) {
        const int m0 = (t / (D / 64)) * 64, n0 = (t % (D / 64)) * 64;
        const int mt = wave >> 1, nt0 = (wave & 1) * 2;
        const half_t* ap = yl + (size_t)(m0 + mt * 16 + r) * D + kq;
        const half_t* bp0 = wt + (size_t)(n0 + nt0 * 16 + r) * D + kq; const half_t* bp1 = bp0 + (size_t)16 * D;
        f32x4 c0 = {0.f, 0.f, 0.f, 0.f}, c1 = {0.f, 0.f, 0.f, 0.f};
#pragma unroll 1
        for (int kb = 0; kb < D; kb += 256) {
            half8 a[8], b0[8], b1[8];
#pragma unroll
            for (int q = 0; q < 8; ++q) { a[q] = *(const half8*)(ap + kb + q * 32); b0[q] = *(const half8*)(bp0 + kb + q * 32); b1[q] = *(const half8*)(bp1 + kb + q * 32); }
#pragma unroll
            for (int q = 0; q < 8; ++q) { c0 = mfma16(a[q], b0[q], c0); c1 = mfma16(a[q], b1[q], c1); }
        }
#pragma unroll
        for (int i = 0; i < 4; ++i) {
            const int row = TL + m0 + mt * 16 + (lane >> 4) * 4 + i;
            const float* g1 = modp(F, layer, NB, 2); const float* xi = F.xrow_in(layer, row); float* xo = F.xrow(row);
            const int ca = n0 + nt0 * 16 + r, cb = ca + 16;
            xo[ca] = xi[ca] + g1[ca] * c0[i]; xo[cb] = xi[cb] + g1[cb] * c1[i];
        }
    }
}
__device__ __forceinline__ void phase_outproj(const Frame& F, int layer) {
    if (layer == 0) outproj_ctx_tiles(F, layer);
    g8::DenseSched S; S.abase = (const char*)(F.ws + WS_XN); S.bbase = (const char*)((const half_t*)(F.ws + WS_WOUT) + (size_t)layer * D * D); S.K = D; S.nM = TL / 256; S.nN = D / 256; S.G = gridDim.x; S.c = blockIdx.x;
    EpiOutproj E{F, layer};
    g8::gemm_phase(F.smem, D, S, E);
}

constexpr int RLD = D + 8;
__device__ __forceinline__ void phase_router(const Frame& F, int layer, bool dry = false) {
    const int nrows = layer == 0 ? TT : TL, total = nrows / 16;
    half_t* Th = (half_t*)F.smem;
    half_t* Tl = Th + 16 * RLD;
    float* PART = (float*)(Tl + 16 * RLD);
    float* LG = PART + 8 * 16 * 48;
    half_t* tb = (half_t*)(F.ws + WS_XN);
    unsigned* cnt = (unsigned*)(F.ws + WS_CTL) + CW_CNT + layer * 64 * CSTR;
    int* list = (int*)(F.ws + WS_LIST); float* pw = (float*)(F.ws + WS_PW);
    const float* nw = F.in(I_N2W) + layer * D;
    const half_t* wr = (const half_t*)(F.ws + WS_WR) + (size_t)layer * 2 * 48 * D;
    const int lane = F.lane, wave = F.wave, r = lane & 15, kq = (lane >> 4) * 8, kb = wave * 128;
    half8 bh[3][4];
#pragma unroll
    for (int nt = 0; nt < 3; ++nt)
#pragma unroll
        for (int ks = 0; ks < 4; ++ks) { const size_t o = (size_t)(nt * 16 + r) * D + kb + ks * 32 + kq; bh[nt][ks] = *(const half8*)(wr + o); }
    int mc = -1; f32x4 g[4], s4[4];
    int it = blockIdx.x;
    f32x4 v[2][4];
    if (it < total) {
#pragma unroll
        for (int rr = 0; rr < 2; ++rr) { const float* x = F.xrow(it * 16 + wave * 2 + rr);
#pragma unroll
            for (int q = 0; q < 4; ++q) v[rr][q] = *(const f32x4*)(x + q * 256 + lane * 4); } }
    int p_row = -1, p_ea = 0, p_eb = 0; unsigned p_pa = 0, p_pb = 0; float p_w0 = 0.f, p_w1 = 0.f;
    for (; it < total; it += gridDim.x) {
        const int row0 = it * 16, nit = it + gridDim.x;
        f32x4 vn[2][4];
        if (nit < total) {
#pragma unroll
            for (int rr = 0; rr < 2; ++rr) { const float* x = F.xrow(nit * 16 + wave * 2 + rr);
#pragma unroll
                for (int q = 0; q < 4; ++q) vn[rr][q] = *(const f32x4*)(x + q * 256 + lane * 4); } }
        { const int m = row_mod(row0);
          if (m != mc) { mc = m; const float* sh = modp(F, layer, m, 3); const float* scl = modp(F, layer, m, 4);
#pragma unroll
              for (int q = 0; q < 4; ++q) { const int k = q * 256 + lane * 4; const f32x4 a = *(const f32x4*)(nw + k), b = *(const f32x4*)(scl + k); s4[q] = *(const f32x4*)(sh + k);
#pragma unroll
                  for (int e = 0; e < 4; ++e) g[q][e] = a[e] * (1.0f + b[e]); } } }
#pragma unroll
        for (int rr = 0; rr < 2; ++rr) {
            float ss = 0.f;
#pragma unroll
            for (int q = 0; q < 4; ++q) ss += v[rr][q][0] * v[rr][q][0] + v[rr][q][1] * v[rr][q][1] + v[rr][q][2] * v[rr][q][2] + v[rr][q][3] * v[rr][q][3];
            ss = wave_sum(ss);
            const float rs = 1.0f / sqrtf(ss * (1.0f / D) + EPSF);
            const int lr = wave * 2 + rr, row = row0 + lr;
#pragma unroll
            for (int q = 0; q < 4; ++q) { const int k = q * 256 + lane * 4; half4 h, l;
#pragma unroll
                for (int e = 0; e < 4; ++e) { const float tv = v[rr][q][e] * rs * g[q][e] + s4[q][e]; h[e] = (half_t)tv; l[e] = (half_t)((tv - (float)h[e]) * 2048.f); }
                *(half4*)(tb + (size_t)row * D + k) = h; *(half4*)(Th + lr * RLD + k) = h; *(half4*)(Tl + lr * RLD + k) = l; }
        }
        __syncthreads();
        { f32x4 ah[3], al[3]; half8 bl[3][4];
#pragma unroll
          for (int nt = 0; nt < 3; ++nt)
#pragma unroll
              for (int ks = 0; ks < 4; ++ks) bl[nt][ks] = *(const half8*)(wr + (size_t)48 * D + (size_t)(nt * 16 + r) * D + kb + ks * 32 + kq);
#pragma unroll
          for (int nt = 0; nt < 3; ++nt) { ah[nt] = (f32x4){0.f, 0.f, 0.f, 0.f}; al[nt] = (f32x4){0.f, 0.f, 0.f, 0.f}; }
#pragma unroll
          for (int ks = 0; ks < 4; ++ks) {
              const half8 a_h = *(const half8*)(Th + r * RLD + kb + ks * 32 + kq), a_l = *(const half8*)(Tl + r * RLD + kb + ks * 32 + kq);
#pragma unroll
              for (int nt = 0; nt < 3; ++nt) { ah[nt] = mfma16(a_h, bh[nt][ks], ah[nt]); al[nt] = mfma16(a_l, bh[nt][ks], al[nt]); al[nt] = mfma16(a_h, bl[nt][ks], al[nt]); }
          }
#pragma unroll
          for (int nt = 0; nt < 3; ++nt)
#pragma unroll
              for (int i = 0; i < 4; ++i) PART[(wave * 16 + (lane >> 4) * 4 + i) * 48 + nt * 16 + r] = ah[nt][i] + al[nt][i] * (1.0f / 2048.f); }
        __syncthreads();
        for (int o = F.tid; o < 16 * 48; o += NT) { const int col = o % 48; float sum = 0.f;
#pragma unroll
            for (int w = 0; w < 8; ++w) sum += PART[w * 16 * 48 + o];
            float bias = 0.f; if (col < 4) bias = F.in(I_GRB)[layer * 4 + col]; else if (col < 36) bias = F.in(I_ERB)[layer * 32 + col - 4];
            LG[o] = sum + bias; }
        __syncthreads();
        if (F.tid < 16) {
            if (p_row >= 0 && !dry) { list[(size_t)(p_ea * 2 + 0) * LCAP + p_pa] = p_row * 2 + 0; list[(size_t)(p_eb * 2 + 1) * LCAP + p_pb] = p_row * 2 + 1; pw[p_row * 2 + 0] = p_w0; pw[p_row * 2 + 1] = p_w1; }
            const int row = row0 + F.tid; const float* lg = LG + F.tid * 48;
            int gi = 0; float gm = lg[0];
            for (int q = 1; q < 4; ++q) if (lg[q] > gm) { gm = lg[q]; gi = q; }
            float gs = 0.f; for (int q = 0; q < 4; ++q) gs += expf(lg[q] - gm);
            const float grp_p = 1.0f / gs;
            const float* el = lg + 4 + gi * 8;
            int i0 = 0; float e0 = el[0];
            for (int q = 1; q < 8; ++q) if (el[q] > e0) { e0 = el[q]; i0 = q; }
            int i1 = -1; float e1 = -3.0e38f;
            for (int q = 0; q < 8; ++q) if (q != i0 && el[q] > e1) { e1 = el[q]; i1 = q; }
            const float p1 = expf(e1 - e0);
            p_w0 = grp_p * (1.0f / (1.0f + p1)); p_w1 = grp_p * (p1 / (1.0f + p1));
            p_ea = gi * 8 + i0; p_eb = gi * 8 + i1; p_row = row;
            if (!dry) { p_pa = atomicAdd(&cnt[(p_ea * 2 + 0) * CSTR], 1u); p_pb = atomicAdd(&cnt[(p_eb * 2 + 1) * CSTR], 1u); }
        }
#pragma unroll
        for (int rr = 0; rr < 2; ++rr)
#pragma unroll
            for (int q = 0; q < 4; ++q) v[rr][q] = vn[rr][q];
    }
    if (F.tid < 16 && p_row >= 0 && !dry) { list[(size_t)(p_ea * 2 + 0) * LCAP + p_pa] = p_row * 2 + 0; list[(size_t)(p_eb * 2 + 1) * LCAP + p_pb] = p_row * 2 + 1; pw[p_row * 2 + 0] = p_w0; pw[p_row * 2 + 1] = p_w1; }
    __syncthreads();
}

constexpr int MOE_PRE_OFF = g8::STAGE_BYTES;
struct MoeSchedA {
    const char* abase; const char* wbase; const int* pre; const unsigned* cnt; const int* list; int G, c;
    __device__ __forceinline__ int entry(const g8::Unit& u, int r) const { const int rc = r < u.n ? r : 0; return rc < u.c0 ? list[(size_t)(u.e * 2) * LCAP + rc] : list[(size_t)(u.e * 2 + 1) * LCAP + (rc - u.c0)]; }
    __device__ __forceinline__ bool next(int i, g8::Unit& u) const {
        const int L = i * G + c; if (L >= pre[32]) return false;
        int e = 0; while (L >= pre[e + 1]) ++e;
        const int loc = L - pre[e]; u.e = e; u.c0 = (int)cnt[(e * 2) * CSTR]; u.n = u.c0 + (int)cnt[(e * 2 + 1) * CSTR]; u.pm = loc >> 1; u.pn = loc & 1; return true;
    }
    __device__ __forceinline__ unsigned a_off(const g8::Unit& u, int r) const { return (unsigned)(entry(u, u.pm * 256 + r) >> 1) * (unsigned)(D * 2); }
    __device__ __forceinline__ const char* b_half(const g8::Unit& u, int h) const { return wbase + ((size_t)u.e * 3 * 262144 + (size_t)h * 262144 + (size_t)u.pn * 128 * D) * 2; }
};
struct EpiMoeA {
    static constexpr bool PERM = true;
    MoeSchedA S; const float* pw; half_t* hid;
    __device__ __forceinline__ void operator()(const f32x4 (&acc)[2][2][4][2], const g8::Unit& u, int wr, int wc, int fr, int fq) const {
        int pid[8]; float w[8];
#pragma unroll
        for (int g = 0; g < 8; ++g) pid[g] = S.entry(u, u.pm * 256 + (g >> 2) * 128 + wr * 64 + (g & 3) * 16 + fr);
#pragma unroll
        for (int g = 0; g < 8; ++g) w[g] = pw[pid[g]];
        const int f = u.pn * 128 + wc * 32 + 8 * fq;
#pragma unroll
        for (int ai = 0; ai < 2; ++ai)
#pragma unroll
            for (int m = 0; m < 4; ++m) {
                const int rr = u.pm * 256 + ai * 128 + wr * 64 + m * 16 + fr;
                if (rr < u.n) { half8 h;
#pragma unroll
                    for (int n = 0; n < 2; ++n) { const f32x4 g = acc[ai][0][m][n], up = acc[ai][1][m][n];
#pragma unroll
                        for (int i = 0; i < 4; ++i) h[n * 4 + i] = (half_t)(fsilu(g[i]) * up[i] * w[ai * 4 + m]); }
                    *(half8*)(hid + (size_t)pid[ai * 4 + m] * 256 + f) = h; }
            }
    }
};
__device__ __forceinline__ void phase_moe_a(const Frame& F, int layer) {
    int* pre = (int*)(F.smem + MOE_PRE_OFF);
    const unsigned* cnt = (const unsigned*)(F.ws + WS_CTL) + CW_CNT + layer * 64 * CSTR;
    if (F.tid == 0) { int s = 0; for (int e = 0; e < 32; ++e) { pre[e] = s; s += (((int)(cnt[(e * 2) * CSTR] + cnt[(e * 2 + 1) * CSTR]) + 255) / 256) * 2; } pre[32] = s; }
    __syncthreads();
    MoeSchedA S; S.abase = (const char*)(F.ws + WS_XN); S.wbase = (const char*)(F.ws + WS_WMOE); S.pre = pre; S.cnt = cnt; S.list = (const int*)(F.ws + WS_LIST); S.G = gridDim.x; S.c = blockIdx.x;
    EpiMoeA E{S, (const float*)(F.ws + WS_PW), (half_t*)(F.ws + WS_U16)};
    g8::gemm_phase(F.smem, D, S, E);
    __syncthreads();
}
struct MoeSchedB {
    const char* abase; const char* wbase; const int* pre; const unsigned* cnt; const int* list; int G, c;
    __device__ __forceinline__ bool next(int i, g8::Unit& u) const {
        const int L = i * G + c; if (L >= pre[64]) return false;
        int l = 0; while (L >= pre[l + 1]) ++l;
        const int loc = L - pre[l]; u.e = l >> 1; u.c0 = l & 1; u.n = (int)cnt[(l) * CSTR]; u.pm = loc >> 2; u.pn = loc & 3; return true;
    }
    __device__ __forceinline__ int entry(const g8::Unit& u, int rr) const { return list[(size_t)(u.e * 2 + u.c0) * LCAP + (rr < u.n ? rr : 0)]; }
    __device__ __forceinline__ unsigned a_off(const g8::Unit& u, int r) const { return (unsigned)entry(u, u.pm * 256 + r) * 512u; }
    __device__ __forceinline__ const char* b_half(const g8::Unit& u, int h) const { return wbase + ((size_t)u.e * 3 * 262144 + 2 * 262144 + (size_t)(u.pn * 256 + h * 128) * 256) * 2; }
};
struct EpiMoeB {
    static constexpr bool PERM = true;
    MoeSchedB S; Frame F; int layer;
    __device__ __forceinline__ void operator()(const f32x4 (&acc)[2][2][4][2], const g8::Unit& u, int wr, int wc, int fr, int fq) const {
        int row[8];
#pragma unroll
        for (int g = 0; g < 8; ++g) row[g] = S.entry(u, u.pm * 256 + (g >> 2) * 128 + wr * 64 + (g & 3) * 16 + fr) >> 1;
        half_t* xab = (half_t*)(F.ws + WS_U16 + XAB_OFF) + (size_t)u.c0 * TT * D;
#pragma unroll
        for (int ai = 0; ai < 2; ++ai)
#pragma unroll
            for (int m = 0; m < 4; ++m) {
                const int rr = u.pm * 256 + ai * 128 + wr * 64 + m * 16 + fr;
                if (rr < u.n) { const int rw = row[ai * 4 + m]; half_t* xo = xab + (size_t)rw * D;
#pragma unroll
                    for (int bj = 0; bj < 2; ++bj) { const int d = u.pn * 256 + bj * 128 + wc * 32 + 8 * fq;
                        const f32x4 a0 = acc[ai][bj][m][0], a1 = acc[ai][bj][m][1];
                        half8 h; h[0] = (half_t)a0[0]; h[1] = (half_t)a0[1]; h[2] = (half_t)a0[2]; h[3] = (half_t)a0[3]; h[4] = (half_t)a1[0]; h[5] = (half_t)a1[1]; h[6] = (half_t)a1[2]; h[7] = (half_t)a1[3];
                        *(half8*)(xo + d) = h; } }
            }
    }
};
__device__ __forceinline__ void phase_moe_b(const Frame& F, int layer) {
    int* pre = (int*)(F.smem + MOE_PRE_OFF);
    const unsigned* cnt = (const unsigned*)(F.ws + WS_CTL) + CW_CNT + layer * 64 * CSTR;
    if (F.tid == 0) { int s = 0; for (int l = 0; l < 64; ++l) { pre[l] = s; s += (((int)cnt[(l) * CSTR] + 255) / 256) * 4; } pre[64] = s; }
    __syncthreads();
    MoeSchedB S; S.abase = (const char*)(F.ws + WS_U16); S.wbase = (const char*)(F.ws + WS_WMOE); S.pre = pre; S.cnt = cnt; S.list = (const int*)(F.ws + WS_LIST); S.G = gridDim.x; S.c = blockIdx.x;
    EpiMoeB E{S, F, layer};
    g8::gemm_phase(F.smem, 256, S, E);
    __syncthreads();
}

__device__ __forceinline__ void phase_final(const Frame& F) {
    const float* fw = F.in(I_FNW);
    const int lane = F.lane, nwaves = gridDim.x * (NT / 64);
    f32x4 w4[4];
#pragma unroll
    for (int q = 0; q < 4; ++q) w4[q] = *(const f32x4*)(fw + q * 256 + lane * 4);
    int row = blockIdx.x * (NT / 64) + F.wave;
    f32x4 v[4];
    if (row < TL) {
#pragma unroll
        for (int q = 0; q < 4; ++q) v[q] = *(const f32x4*)(F.P->out + (size_t)row * D + q * 256 + lane * 4); }
    for (; row < TL; row += nwaves) {
        const int nrow = row + nwaves;
        f32x4 vn[4];
        if (nrow < TL) {
#pragma unroll
            for (int q = 0; q < 4; ++q) vn[q] = *(const f32x4*)(F.P->out + (size_t)nrow * D + q * 256 + lane * 4); }
        { const half_t* xa = (const half_t*)(F.ws + WS_U16 + XAB_OFF) + (size_t)row * D; const half_t* xb = xa + (size_t)TT * D;
          const float* g5 = modp(F, 1, row_mod(row), 5);
#pragma unroll
          for (int q = 0; q < 4; ++q) { const int k = q * 256 + lane * 4; const half4 a4 = *(const half4*)(xa + k), b4 = *(const half4*)(xb + k); const f32x4 gv = *(const f32x4*)(g5 + k);
#pragma unroll
              for (int e = 0; e < 4; ++e) v[q][e] += gv[e] * ((float)a4[e] + (float)b4[e]); } }
        float ss = 0.f;
#pragma unroll
        for (int q = 0; q < 4; ++q) ss += v[q][0] * v[q][0] + v[q][1] * v[q][1] + v[q][2] * v[q][2] + v[q][3] * v[q][3];
        ss = wave_sum(ss);
        const float rs = 1.0f / sqrtf(ss * (1.0f / D) + EPSF);
#pragma unroll
        for (int q = 0; q < 4; ++q) *(f32x4*)(F.P->out + (size_t)row * D + q * 256 + lane * 4) = v[q] * rs * w4[q];
#pragma unroll
        for (int q = 0; q < 4; ++q) v[q] = vn[q];
    }
}

constexpr int NPHASE = 1 + 2 * 9 + 1;
#ifndef ONLY
#define ONLY -1
#endif
#define EN(x) (ONLY < 0 || ONLY == (x))
__device__ __forceinline__ void run_phase(const Frame& F, int ph) {
    if (ph == 0) { if (EN(0)) phase_setup(F); return; }
    if (ph == NPHASE - 1) { if (EN(11)) phase_final(F); return; }
    const int layer = (ph - 1) / 9, k = (ph - 1) % 9;
    switch (k) {
        case 0: if (EN(1)) phase_norm1(F, layer); break;
        case 1: if (EN(2)) phase_inproj(F, layer); break;
        case 2: if (EN(10)) phase_act(F, layer); break;
        case 3: if (EN(3)) phase_mixers(F, layer); break;
        case 4: if (EN(4)) phase_combine(F, layer); break;
        case 5: if (EN(5)) phase_outproj(F, layer); break;
        case 6: if (EN(6)) phase_router(F, layer); break;
        case 7: if (EN(7)) phase_moe_a(F, layer); break;
        default: if (EN(8)) phase_moe_b(F, layer); break;
    }
}

#ifdef EMU
void mega(const Params* Pp) {
    Frame F; F.P = Pp; F.ws = Pp->ws; F.smem = emu_blk->smem; F.tid = threadIdx.x; F.lane = F.tid & 63; F.wave = F.tid >> 6;
    for (int ph = Pp->ph_lo; ph < Pp->ph_hi; ++ph) { run_phase(F, ph); __syncthreads(); }
}
#else
__global__ void __launch_bounds__(NT) mega(Params P) {
    extern __shared__ __attribute__((aligned(16))) unsigned char smem_dyn[];
    cg::grid_group grid = cg::this_grid();
    Frame F; F.P = (ParamsPtr)__builtin_amdgcn_kernarg_segment_ptr(); F.ws = P.ws; F.smem = smem_dyn; F.tid = threadIdx.x; F.lane = F.tid & 63; F.wave = F.tid >> 6;
    volatile LAS unsigned* bst = (volatile LAS unsigned*)(smem_dyn + LDS_BYTES - 16);
    if (F.tid < 4) bst[F.tid] = 0u;
    __syncthreads();
    XcdBarrier xb = xcd_barrier_post((unsigned*)(P.ws + WS_CTL) + CW_BAR, bst);
    if (P.ph_lo < 0) grid.sync();
#define DUP -1
#define AMP -1
#define PHASE_STEP(i) if (P.ph_lo <= (i) && (i) < P.ph_hi) { \
        unsigned long long t0_ = 0; if (AMP == (i)) t0_ = __builtin_amdgcn_s_memrealtime(); \
        run_phase(F, (i)); \
        if ((i) + 1 < P.ph_hi || AMP == (i)) xcd_barrier(xb); \
        if (AMP == (i)) { const unsigned long long t1_ = __builtin_amdgcn_s_memrealtime(); if (blockIdx.x == 0) { while (__builtin_amdgcn_s_memrealtime() - t1_ < t1_ - t0_) __builtin_amdgcn_s_sleep(8); } xcd_barrier(xb); } }
    PHASE_STEP(0) PHASE_STEP(1) PHASE_STEP(2) PHASE_STEP(3) PHASE_STEP(4) PHASE_STEP(5) PHASE_STEP(6) PHASE_STEP(7) PHASE_STEP(8) PHASE_STEP(9)
    PHASE_STEP(10) PHASE_STEP(11) PHASE_STEP(12) PHASE_STEP(13) PHASE_STEP(14) PHASE_STEP(15) PHASE_STEP(16) PHASE_STEP(17) PHASE_STEP(18) PHASE_STEP(19)
    static_assert(NPHASE == 20, "phase list");
}

extern "C" void kernel_launch(void* const* d_in, const int* in_sizes, int n_in, void* d_out, int out_size, void* d_ws, size_t ws_size, hipStream_t stream) {
    static int grid_blocks = 0;
    if (grid_blocks == 0) {
        if (n_in != 38 || out_size != TL * D || ws_size < WS_END) { fprintf(stderr, "kernel_launch: unexpected shapes (n_in %d out %d ws %zu need %zu)\n", n_in, out_size, ws_size, (size_t)WS_END); grid_blocks = -1; return; }
        int dev = 0, cus = 0, per_cu = 0;
        hipGetDevice(&dev);
        hipDeviceGetAttribute(&cus, hipDeviceAttributeMultiprocessorCount, dev);
        hipFuncSetAttribute((const void*)mega, hipFuncAttributeMaxDynamicSharedMemorySize, LDS_BYTES);
        hipOccupancyMaxActiveBlocksPerMultiprocessor(&per_cu, (const void*)mega, NT, LDS_BYTES);
        if (per_cu < 1) { fprintf(stderr, "kernel_launch: occupancy query says 0 blocks per CU\n"); grid_blocks = -1; return; }
        grid_blocks = cus;
    }
    if (grid_blocks < 0) return;
    if (hipMemsetAsync((char*)d_ws + WS_CTL, 0, CTL_BYTES, stream) != hipSuccess) { fprintf(stderr, "kernel_launch: memset failed\n"); return; }
    Params p{};
    for (int i = 0; i < 38; ++i) p.in[i] = (const float*)d_in[i];
    p.out = (float*)d_out; p.ws = (unsigned char*)d_ws; p.ph_lo = 0; p.ph_hi = NPHASE;
    void* args[] = {&p};
    hipError_t e = hipLaunchCooperativeKernel((const void*)mega, dim3(grid_blocks), dim3(NT), args, LDS_BYTES, stream);
    if (e != hipSuccess) fprintf(stderr, "cooperative launch failed: %s (grid %d)\n", hipGetErrorString(e), grid_blocks);
}
#endif
```

```cpp
#ifdef EMU
#include "gpuemu.h"
#else
#include <hip/hip_runtime.h>
#include <hip/hip_cooperative_groups.h>
#include <cstdio>
namespace cg = cooperative_groups;
#endif
#include <stdint.h>

#ifndef CFG_B
#define CFG_B 4
#endif
#ifndef CFG_SEQ
#define CFG_SEQ 4096
#endif
#ifndef CFG_CTX
#define CFG_CTX 256
#endif

typedef _Float16 half_t;
typedef _Float16 half8 __attribute__((ext_vector_type(8)));
typedef _Float16 half4 __attribute__((ext_vector_type(4)));
typedef float f32x4 __attribute__((ext_vector_type(4)));
struct cplx { float x, y; };

constexpr int D = 1024, NB = CFG_B, SEQ = CFG_SEQ, CTXL = CFG_CTX, GW = 64, GROWS = SEQ / GW;
constexpr int TL = NB * SEQ, TC = NB * CTXL, TT = TL + TC;
constexpr int NIN = 3364, NINP = 3584;
constexpr int UW = 2560;
constexpr int UGW = 36;
constexpr int NT = 512;
constexpr int TWN = 2 * SEQ > 2 * CTXL ? 2 * SEQ : 2 * CTXL;
constexpr int NMOD = 6 * D;
constexpr int LCAP = TT;
constexpr float EPSF = 1e-6f;

constexpr size_t al256(size_t x) { return (x + 255) / 256 * 256; }
constexpr size_t WS_CTL    = 0;
constexpr size_t WS_MOD    = 65536;
constexpr size_t WS_TW     = WS_MOD + al256(sizeof(float) * 2 * 5 * NMOD);
constexpr size_t WS_WIN    = WS_TW + al256(sizeof(cplx) * TWN);
constexpr size_t WS_WOUT   = WS_WIN + al256(2ull * 2 * NINP * D);
constexpr size_t WS_WMOE   = WS_WOUT + al256(2ull * 2 * D * D);
constexpr size_t WS_XC     = WS_WMOE + al256(2ull * 32 * 3 * 262144);
constexpr size_t WS_XN     = WS_XC + al256(4ull * TC * D);
constexpr size_t WS_U16    = WS_XN + al256(2ull * TT * D);
constexpr size_t WS_UG     = WS_U16 + al256(2ull * TT * UW);
constexpr size_t WS_HYT    = WS_UG + al256(4ull * TT * UGW);
constexpr size_t WS_YF     = WS_HYT + al256(2ull * NB * 768 * (SEQ + CTXL));
constexpr size_t WS_YHT    = WS_YF + al256(2ull * 4 * TT * 384);
constexpr size_t WS_FT     = WS_YHT + al256(4ull * NB * 256 * (SEQ + CTXL));
constexpr size_t WS_LIST   = WS_FT + al256(4ull * (2 * 256 * 4 * SEQ + 256 * 4 * CTXL));
constexpr size_t WS_PW     = WS_LIST + al256(4ull * 64 * LCAP);
constexpr size_t WS_WR     = WS_PW + al256(4ull * TT * 2);
constexpr size_t WS_HALO   = WS_WR + al256(2ull * 2 * 2 * 48 * D);
constexpr size_t WS_END    = WS_HALO + al256(2ull * (TT / 16) * 2 * 1408);
static_assert(4ull * NB * 256 * (SEQ + CTXL) <= 2ull * TT * D, "Z1 scratch must fit in the XN region");
static_assert(2ull * TT * 2 * 256 <= 2ull * TT * UW, "HID must fit in the U16 region");
constexpr size_t XAB_OFF = 2ull * TT * 2 * 256;
static_assert(XAB_OFF + 2ull * 2 * TT * D <= 2ull * TT * UW, "HID + XA + XB must fit in the U16 region");

constexpr int CW_CNT = 8192;
constexpr int CSTR = 64;
constexpr int CW_QUE = 256;
constexpr int CW_BAR = 1024;
constexpr size_t CTL_BYTES = 65536;

constexpr int LDS_BYTES = 156 * 1024;

struct Params {
    const float* in[38];
    float* out;
    unsigned char* ws;
    int ph_lo, ph_hi;
};

enum { I_X = 0, I_C, I_CTX, I_CCTX, I_WMOD, I_BMOD, I_N1W, I_N2W, I_WIN, I_WOUT, I_SCW, I_SCB, I_DTB, I_ALOG, I_SD, I_SNW,
       I_HCW, I_HCB, I_HW1, I_HB1, I_HW2, I_HB2, I_HW3, I_HFREQ, I_HDEC, I_HSKIP, I_MCW, I_MCB, I_MGB, I_MNW,
       I_GRW, I_GRB, I_ERW, I_ERB, I_MG, I_MU, I_MD, I_FNW };

__device__ __forceinline__ float siluf(float x) { return x / (1.0f + expf(-x)); }
__device__ __forceinline__ float sigmoidf_(float x) { return 1.0f / (1.0f + expf(-x)); }
__device__ __forceinline__ float softplusf_(float x) { return x > 20.f ? x : log1pf(expf(x)); }
__device__ __forceinline__ float logsigmoidf_(float x) { return fminf(x, 0.f) - log1pf(expf(-fabsf(x))); }

__device__ __forceinline__ float fsoftplus(float x) {
#ifdef EMU
    return x > 20.f ? x : log1pf(expf(x));
#else
    const float e = __expf(x);
    return x > 20.f ? x : (e < 1e-3f ? e * (1.0f - 0.5f * e) : __logf(1.0f + e));
#endif
}
__device__ __forceinline__ float flogsigmoid(float x) { return fminf(x, 0.f) - fsoftplus(-fabsf(x)); }
__device__ __forceinline__ float fexp(float x) {
#ifdef EMU
    return expf(x);
#else
    return __expf(x);
#endif
}
__device__ __forceinline__ float fsilu(float x) {
#ifdef EMU
    return x / (1.0f + expf(-x));
#else
    return __fdividef(x, 1.0f + __expf(-x));
#endif
}
__device__ __forceinline__ float wave_sum(float v) {
#pragma unroll
    for (int m = 32; m >= 1; m >>= 1) v += __shfl_xor(v, m);
    return v;
}
__device__ __forceinline__ float wave_max(float v) {
#pragma unroll
    for (int m = 32; m >= 1; m >>= 1) v = fmaxf(v, __shfl_xor(v, m));
    return v;
}
#ifndef EMU
#define DPP_F(oldv, v, ctrl, rmask) __builtin_bit_cast(float, __builtin_amdgcn_update_dpp(__builtin_bit_cast(int, (float)(oldv)), __builtin_bit_cast(int, (float)(v)), (ctrl), (rmask), 0xF, false))
#endif
__device__ __forceinline__ float wave_scan_sum(float v, int lane) {
#ifdef EMU
    for (int d = 1; d < 64; d <<= 1) { float o = __shfl_up(v, d); if (lane >= d) v += o; }
    return v;
#else
    v += DPP_F(0.f, v, 0x111, 0xF);
    v += DPP_F(0.f, v, 0x112, 0xF);
    v += DPP_F(0.f, v, 0x114, 0xF);
    v += DPP_F(0.f, v, 0x118, 0xF);
    v += DPP_F(0.f, v, 0x142, 0xA);
    v += DPP_F(0.f, v, 0x143, 0xC);
    return v;
#endif
}
__device__ __forceinline__ float wave_last(float v) {
#ifdef EMU
    return __shfl(v, 63);
#else
    return __builtin_bit_cast(float, __builtin_amdgcn_readlane(__builtin_bit_cast(int, v), 63));
#endif
}
__device__ __forceinline__ float wave_shr1(float v, float fill, int lane) {
#ifdef EMU
    float o = __shfl_up(v, 1); return lane == 0 ? fill : o;
#else
    return DPP_F(fill, v, 0x138, 0xF);
#endif
}
__device__ __forceinline__ float wave_scan_max(float v, int lane) {
#ifdef EMU
    for (int d = 1; d < 64; d <<= 1) { float o = __shfl_up(v, d); if (lane >= d) v = fmaxf(v, o); }
    return v;
#else
    const float NI = -3.0e38f;
    v = fmaxf(v, DPP_F(NI, v, 0x111, 0xF));
    v = fmaxf(v, DPP_F(NI, v, 0x112, 0xF));
    v = fmaxf(v, DPP_F(NI, v, 0x114, 0xF));
    v = fmaxf(v, DPP_F(NI, v, 0x118, 0xF));
    v = fmaxf(v, DPP_F(NI, v, 0x142, 0xA));
    v = fmaxf(v, DPP_F(NI, v, 0x143, 0xC));
    return v;
#endif
}

template <int MT, int NTL>
__device__ __forceinline__ void mma_lds(f32x4 (&acc)[MT][NTL], const half_t* A, int lda, const half_t* B, int ldb, int ksteps, int lane) {
#ifndef EMU
    const int r = lane & 15, kq = (lane >> 4) * 8;
    for (int ks = 0; ks < ksteps; ++ks) {
        half8 a[MT], b[NTL];
#pragma unroll
        for (int mt = 0; mt < MT; ++mt) a[mt] = *(const half8*)(A + (mt * 16 + r) * lda + ks * 32 + kq);
#pragma unroll
        for (int nt = 0; nt < NTL; ++nt) b[nt] = *(const half8*)(B + (nt * 16 + r) * ldb + ks * 32 + kq);
#pragma unroll
        for (int mt = 0; mt < MT; ++mt)
#pragma unroll
            for (int nt = 0; nt < NTL; ++nt) acc[mt][nt] = __builtin_amdgcn_mfma_f32_16x16x32_f16(a[mt], b[nt], acc[mt][nt], 0, 0, 0);
    }
#else
    for (int mt = 0; mt < MT; ++mt) for (int nt = 0; nt < NTL; ++nt) for (int i = 0; i < 4; ++i) {
        const int row = mt * 16 + (lane >> 4) * 4 + i, col = nt * 16 + (lane & 15);
        float s = acc[mt][nt][i];
        for (int k = 0; k < ksteps * 32; ++k) s += (float)A[row * lda + k] * (float)B[col * ldb + k];
        acc[mt][nt][i] = s;
    }
#endif
}

__device__ __forceinline__ f32x4 mfma16(half8 a, half8 b, f32x4 c) {
#ifdef EMU
    return emu_mfma16(a, b, c);
#else
    return __builtin_amdgcn_mfma_f32_16x16x32_f16(a, b, c, 0, 0, 0);
#endif
}
template <int MT, int NTL> __device__ __forceinline__ void zero_acc(f32x4 (&acc)[MT][NTL]) {
#pragma unroll
    for (int mt = 0; mt < MT; ++mt)
#pragma unroll
        for (int nt = 0; nt < NTL; ++nt) acc[mt][nt] = (f32x4){0.f, 0.f, 0.f, 0.f};
}

__device__ __forceinline__ void load_taps4(const float* cw, const float* cb, int C, int ch, int dir, f32x4& w0, f32x4& w1, f32x4& w2, f32x4& wb) {
    w0 = *(const f32x4*)(cw + (dir ? 2 : 0) * C + ch); w1 = *(const f32x4*)(cw + C + ch); w2 = *(const f32x4*)(cw + (dir ? 0 : 2) * C + ch); wb = *(const f32x4*)(cb + ch);
}
#ifdef EMU
#define LOADER_FENCE()
#else
#define LOADER_FENCE() asm volatile("" ::: "memory")
#endif
#define CONV4(k, i) (w0[i] * (float)rr[k][hh * 4 + i] + w1[i] * (float)rr[(k) + 1][hh * 4 + i] + w2[i] * (float)rr[(k) + 2][hh * 4 + i] + wb[i])
__device__ __forceinline__ half4 to_half4(const f32x4 v) { half4 h; h[0] = (half_t)v[0]; h[1] = (half_t)v[1]; h[2] = (half_t)v[2]; h[3] = (half_t)v[3]; return h; }
namespace g8 {
constexpr int BM = 256, BK = 64, HALF = 128, HTB = HALF * BK * 2, STAGE_BYTES = 8 * HTB;
__device__ __forceinline__ int lds_byte(int r, int c) { const int st = (r >> 4) * 2 + (c >> 5), rr = r & 15, cc = c & 31, ob = rr * 64 + cc * 2; return st * 1024 + (ob ^ (((ob >> 9) & 1) << 5)); }
__device__ __forceinline__ int perm32(int rho) { const int n = rho >> 4, i = rho & 15; return 8 * (i >> 2) + 4 * n + (i & 3); }
__device__ __forceinline__ void stage_rc(int b, int& R, int& C) { const int st = b / 1024, sb = b % 1024, swz = sb ^ (((sb >> 9) & 1) << 5); R = (st >> 1) * 16 + swz / 64; C = (st & 1) * 32 + (swz % 64) / 2; }
struct Unit { int pm, pn, e, n, c0; };

struct DenseSched {
    const char* abase; const char* bbase; int K, nM, nN, G, c;
    __device__ __forceinline__ bool next(int i, Unit& u) const {
        const int nwg = nM * nN; const long L = (long)i * G + c; if (L >= nwg) return false;
        int wgid = (int)L; { const int q = nwg / 8, r = nwg % 8, xcd = wgid % 8, off = wgid / 8; wgid = (xcd < r ? xcd * (q + 1) : r * (q + 1) + (xcd - r) * q) + off; }
        const int nig = 8 * nN, gid = wgid / nig, fm = gid * 8, gsz = (nM - fm) < 8 ? (nM - fm) : 8;
        u.pm = fm + ((wgid % nig) % gsz); u.pn = (wgid % nig) / gsz; u.e = 0; u.n = 0; u.c0 = 0; return true;
    }
    __device__ __forceinline__ unsigned a_off(const Unit& u, int r) const { return (unsigned)((size_t)(u.pm * 256 + r) * K * 2); }
    __device__ __forceinline__ const char* b_half(const Unit& u, int h) const { return bbase + (size_t)(u.pn * 256 + h * 128) * K * 2; }
};

template <class Epi, class Sched>
__device__ __forceinline__ void gemm_phase(unsigned char* smem, const int K, const Sched& S, const Epi& E) {
    const int tid = threadIdx.x, lane = tid & 63;
#ifdef EMU
    const int wid = tid >> 6, wr = wid >> 2, wc = wid & 3, fr = lane & 15, fq = lane >> 4;
    half_t* As = (half_t*)smem; half_t* Bs = As + 256 * 72;
    Unit cur;
    for (int ui = 0; S.next(ui, cur); ++ui) {
        f32x4 acc[2][2][4][2];
        for (int a = 0; a < 2; ++a) for (int b = 0; b < 2; ++b) for (int m = 0; m < 4; ++m) for (int n = 0; n < 2; ++n) acc[a][b][m][n] = (f32x4){0.f, 0.f, 0.f, 0.f};
        for (int kt = 0; kt < K / 64; ++kt) {
            { const int row = tid >> 1, c0 = (tid & 1) * 32;
              const half_t* sa = (const half_t*)(S.abase + S.a_off(cur, row)) + kt * 64 + c0;
              const half_t* sb = (const half_t*)(S.b_half(cur, row >> 7)) + (size_t)(row & 127) * K + kt * 64 + c0;
              for (int q = 0; q < 32; ++q) { As[row * 72 + c0 + q] = sa[q]; Bs[row * 72 + c0 + q] = sb[q]; } }
            __syncthreads();
            for (int a = 0; a < 2; ++a) for (int b = 0; b < 2; ++b) for (int m = 0; m < 4; ++m) for (int n = 0; n < 2; ++n) for (int i = 0; i < 4; ++i) {
                const int row = 128 * a + 64 * wr + 16 * m + fr, col = 128 * b + 32 * wc + (Epi::PERM ? 8 * fq + 4 * n + i : 16 * n + 4 * fq + i); float s = acc[a][b][m][n][i];
                for (int k = 0; k < 64; ++k) s += (float)As[row * 72 + k] * (float)Bs[col * 72 + k];
                acc[a][b][m][n][i] = s; }
            __syncthreads();
        }
        E(acc, cur, wr, wc, fr, fq);
    }
#else
    typedef __attribute__((address_space(3))) unsigned char* ldsp_t;
    const ldsp_t lds = (ldsp_t)smem;
    const int wid = __builtin_amdgcn_readfirstlane(tid >> 6), wr = wid >> 2, wc = wid & 3, fr = lane & 15, fq = lane >> 4;
    const int nt = K / BK;
    int Rr[2], Cc[2]; unsigned voffB[2];
#pragma unroll
    for (int i = 0; i < 2; ++i) { stage_rc(tid * 16 + i * 8192, Rr[i], Cc[i]); const int Rb = Epi::PERM ? ((Rr[i] & ~31) + perm32(Rr[i] & 31)) : Rr[i]; voffB[i] = (unsigned)(Rb * K + Cc[i]) * 2u; }
    const size_t kstep = (size_t)(BK * 2);
    const unsigned ldsw = (unsigned)wid * 1024u;
    const int aoffl = lds_byte(wr * 64 + fr, fq * 8), boffl = lds_byte(wc * 32 + fr, fq * 8);
#define G8_SA(b, h) (((b) * 2 + (h)) * HTB)
#define G8_SB(b, h) ((4 + (b) * 2 + (h)) * HTB)
#define G8_STAGE(bufoff, gbase, voff) do { _Pragma("unroll") for (int _i = 0; _i < 2; ++_i) \
        __builtin_amdgcn_global_load_lds((const unsigned*)((const char*)(gbase) + (voff)[_i]), (__attribute__((address_space(3))) unsigned*)(lds + (bufoff) + ldsw + _i * 8192), 16, 0, 0); } while (0)
#define G8_LDA(dst, b, h) do { _Pragma("unroll") for (int m = 0; m < 4; ++m) _Pragma("unroll") for (int k = 0; k < 2; ++k) dst[m][k] = *(const __attribute__((address_space(3))) half8*)(lds + G8_SA(b, h) + aoffl + m * 2048 + k * 1024); } while (0)
#define G8_LDB(dst, b, h) do { _Pragma("unroll") for (int n = 0; n < 2; ++n) _Pragma("unroll") for (int k = 0; k < 2; ++k) dst[n][k] = *(const __attribute__((address_space(3))) half8*)(lds + G8_SB(b, h) + boffl + n * 2048 + k * 1024); } while (0)
#define G8_MMA(ai, bj, At, Bt) do { __builtin_amdgcn_s_setprio(1); _Pragma("unroll") for (int m = 0; m < 4; ++m) _Pragma("unroll") for (int n = 0; n < 2; ++n) _Pragma("unroll") for (int k = 0; k < 2; ++k) \
        acc[ai][bj][m][n] = __builtin_amdgcn_mfma_f32_16x16x32_f16(Bt[n][k], At[m][k], acc[ai][bj][m][n], 0, 0, 0); __builtin_amdgcn_s_setprio(0); } while (0)
#define G8_WAIT_V(n) asm volatile("s_waitcnt vmcnt(" #n ")" ::: "memory")
#define G8_WAIT_L(n) asm volatile("s_waitcnt lgkmcnt(" #n ")" ::: "memory")
#define G8_BAR __builtin_amdgcn_s_barrier()
#define G8_SCHED __builtin_amdgcn_sched_barrier(0)
#define G8_AOFF(dst, u) do { _Pragma("unroll") for (int _h = 0; _h < 2; ++_h) _Pragma("unroll") for (int _i = 0; _i < 2; ++_i) dst[_h][_i] = S.a_off(u, _h * 128 + Rr[_i]) + (unsigned)Cc[_i] * 2u; } while (0)
    Unit cur, nxt; int ui = 0;
    if (!S.next(0, cur)) return;
    f32x4 acc[2][2][4][2];
#pragma unroll
    for (int a = 0; a < 2; ++a)
#pragma unroll
        for (int b = 0; b < 2; ++b)
#pragma unroll
            for (int m = 0; m < 4; ++m)
#pragma unroll
                for (int n = 0; n < 2; ++n) acc[a][b][m][n] = (f32x4){0.f, 0.f, 0.f, 0.f};
    half8 At[4][2], B0[2][2], B1[2][2];
    unsigned caoff[2][2], naoff[2][2];
    G8_AOFF(caoff, cur);
    const char* cA = S.abase; const char* cB0 = S.b_half(cur, 0); const char* cB1 = S.b_half(cur, 1);
    G8_STAGE(G8_SB(0, 0), cB0, voffB); G8_STAGE(G8_SA(0, 0), cA, caoff[0]); G8_STAGE(G8_SB(0, 1), cB1, voffB); G8_STAGE(G8_SA(0, 1), cA, caoff[1]);
    if (wr == 1) G8_BAR;
    G8_WAIT_V(4); G8_BAR;
    G8_STAGE(G8_SB(1, 0), cB0 + kstep, voffB); G8_STAGE(G8_SA(1, 0), cA + kstep, caoff[0]); G8_STAGE(G8_SB(1, 1), cB1 + kstep, voffB);
    G8_WAIT_V(6); G8_BAR;
    for (;;) {
        const bool has_next = S.next(ui + 1, nxt);
        if (!has_next) nxt = cur;
        G8_AOFF(naoff, nxt);
        const char* nB0 = S.b_half(nxt, 0); const char* nB1 = S.b_half(nxt, 1);
#pragma unroll 1
        for (int t = 0; t < nt; t += 2) {
            const bool last = (t == nt - 2);
            const char* a1 = cA + (size_t)(t + 1) * kstep;
            const char* a2 = last ? cA : cA + (size_t)(t + 2) * kstep;
            const char* b20 = last ? nB0 : cB0 + (size_t)(t + 2) * kstep; const char* b21 = last ? nB1 : cB1 + (size_t)(t + 2) * kstep;
            const char* a3 = a2 + kstep; const char* b30 = b20 + kstep; const char* b31 = b21 + kstep;
            unsigned xoff[2][2];
#pragma unroll
            for (int h = 0; h < 2; ++h)
#pragma unroll
                for (int i = 0; i < 2; ++i) xoff[h][i] = last ? naoff[h][i] : caoff[h][i];
            G8_LDB(B0, 0, 0); G8_SCHED; G8_LDA(At, 0, 0); G8_STAGE(G8_SA(1, 1), a1, caoff[1]);
            G8_WAIT_L(8); G8_BAR; G8_WAIT_L(0); G8_MMA(0, 0, At, B0); G8_BAR; G8_SCHED;
            G8_LDB(B1, 0, 1); G8_STAGE(G8_SB(0, 0), b20, voffB);
            G8_BAR; G8_WAIT_L(0); G8_MMA(0, 1, At, B1); G8_BAR;
            G8_LDA(At, 0, 1); G8_STAGE(G8_SA(0, 0), a2, xoff[0]);
            G8_BAR; G8_WAIT_L(0); G8_MMA(1, 0, At, B0); G8_BAR; G8_SCHED;
            G8_STAGE(G8_SB(0, 1), b21, voffB);
            G8_WAIT_V(6); G8_BAR; G8_MMA(1, 1, At, B1); G8_BAR;
            G8_LDB(B0, 1, 0); G8_SCHED; G8_LDA(At, 1, 0); G8_STAGE(G8_SA(0, 1), a2, xoff[1]);
            G8_WAIT_L(8); G8_BAR; G8_WAIT_L(0); G8_MMA(0, 0, At, B0); G8_BAR; G8_SCHED;
            G8_LDB(B1, 1, 1); G8_STAGE(G8_SB(1, 0), b30, voffB);
            G8_BAR; G8_WAIT_L(0); G8_MMA(0, 1, At, B1); G8_BAR;
            G8_LDA(At, 1, 1); G8_STAGE(G8_SA(1, 0), a3, xoff[0]);
            G8_BAR; G8_WAIT_L(0); G8_MMA(1, 0, At, B0); G8_BAR; G8_SCHED;
            G8_STAGE(G8_SB(1, 1), b31, voffB);
            G8_WAIT_V(6); G8_BAR; G8_MMA(1, 1, At, B1); G8_BAR;
        }
        E(acc, cur, wr, wc, fr, fq);
        if (!has_next) break;
#pragma unroll
        for (int a = 0; a < 2; ++a)
#pragma unroll
            for (int b = 0; b < 2; ++b)
#pragma unroll
                for (int m = 0; m < 4; ++m)
#pragma unroll
                    for (int n = 0; n < 2; ++n) acc[a][b][m][n] = (f32x4){0.f, 0.f, 0.f, 0.f};
        cur = nxt; cB0 = nB0; cB1 = nB1; ++ui;
#pragma unroll
        for (int h = 0; h < 2; ++h)
#pragma unroll
            for (int i = 0; i < 2; ++i) caoff[h][i] = naoff[h][i];
    }
    G8_WAIT_V(0);
    if (wr == 0) G8_BAR;
    G8_BAR;
#undef G8_SA
#undef G8_SB
#undef G8_STAGE
#undef G8_LDA
#undef G8_LDB
#undef G8_MMA
#undef G8_WAIT_V
#undef G8_WAIT_L
#undef G8_BAR
#undef G8_SCHED
#undef G8_AOFF
#endif
}
}

#ifdef EMU
typedef const Params* ParamsPtr;
#else
typedef const __attribute__((address_space(4))) Params* ParamsPtr;
#endif
struct Frame {
    ParamsPtr P; unsigned char* ws; unsigned char* smem; int tid, lane, wave;
    __device__ __forceinline__ const float* in(int i) const { return P->in[i]; }
    __device__ __forceinline__ float* xrow(int row) const { return row < TL ? P->out + (size_t)row * D : (float*)(ws + WS_XC) + (size_t)(row - TL) * D; }
    __device__ __forceinline__ const float* xrow_in(int layer, int row) const {
        if (layer == 0) return row < TL ? in(I_X) + (size_t)row * D : in(I_CTX) + (size_t)(row - TL) * D;
        return xrow(row);
    }
};
__device__ __forceinline__ int row_mod(int row) { return row < TL ? row / SEQ : NB; }
__device__ __forceinline__ const float* modp(const Frame& F, int layer, int m, int chunk) { return (const float*)(F.ws + WS_MOD) + ((size_t)(layer * 5 + m) * 6 + chunk) * D; }


#ifndef EMU
#define XB_TMO      128
#define XB_XCNT(j)  (256  + 64 * (j))
#define XB_XSUB(j)  (1280 + 64 * (j))
#define XB_XGEN(j)  (2304 + 64 * (j))
#define XB_TOP      3328
#define XB_TOPGEN   3392
#define XCD_BAR_WORDS 3456
#define XB_SPIN_CAP (1u << 26)
#define LAS __attribute__((address_space(3)))
static_assert((CW_BAR + XCD_BAR_WORDS) * 4 <= CTL_BYTES, "control region");
__device__ __forceinline__ unsigned xb_ld(unsigned* p)              { return __hip_atomic_load(p, __ATOMIC_RELAXED, __HIP_MEMORY_SCOPE_AGENT); }
__device__ __forceinline__ unsigned xb_add(unsigned* p, unsigned v) { return __hip_atomic_fetch_add(p, v, __ATOMIC_RELAXED, __HIP_MEMORY_SCOPE_AGENT); }
__device__ __forceinline__ unsigned xb_xcc_id() { return (unsigned)__builtin_amdgcn_s_getreg((3 << 11) | 20) & 0xFu; }
#define XB_SPIN(cond, bar) do { unsigned _sp = 0; while (cond) { __builtin_amdgcn_s_sleep(1); \
    if ((++_sp & 255u) == 0u) { if (xb_ld(&(bar)[XB_TMO])) break; if (_sp > XB_SPIN_CAP) { atomicAdd(&(bar)[XB_TMO], 1u); break; } } } } while (0)
struct XcdBarrier { unsigned* bar; unsigned x; volatile LAS unsigned* st; };
__device__ __forceinline__ XcdBarrier xcd_barrier_post(unsigned* bar, volatile LAS unsigned* st) {
    XcdBarrier b; b.bar = bar; b.x = xb_xcc_id(); b.st = st;
    if (threadIdx.x == 0) (void)xb_add(&bar[XB_XCNT(b.x)], 1u);
    return b;
}
__device__ __forceinline__ void xcd_barrier_complete(unsigned* bar, unsigned x, unsigned& nloc, unsigned& nx) {
    const unsigned G = gridDim.x * gridDim.y * gridDim.z;
    unsigned sum, cnt, mine, sp = 0u;
    for (;;) {
        sum = 0u; cnt = 0u; mine = 0u;
#pragma unroll
        for (unsigned j = 0; j < 16; ++j) { const unsigned c = xb_ld(&bar[XB_XCNT(j)]); sum += c; cnt += (c > 0u) ? 1u : 0u; mine = (j == x) ? c : mine; }
        if (sum == G) break;
        __builtin_amdgcn_s_sleep(1);
        if ((++sp & 255u) == 0u) { if (xb_ld(&bar[XB_TMO])) break; if (sp > XB_SPIN_CAP) { atomicAdd(&bar[XB_TMO], 1u); break; } }
    }
    nloc = mine > 0u ? mine : 1u; nx = cnt > 0u ? cnt : 1u;
}
__device__ __forceinline__ void xcd_barrier(const XcdBarrier& b) {
    asm volatile("s_waitcnt vmcnt(0)" ::: "memory");
    __syncthreads();
    if (threadIdx.x == 0) {
        unsigned* bar = b.bar;
        __builtin_amdgcn_s_waitcnt(0);
        unsigned nloc = b.st[0], nx = b.st[1];
        if (nloc == 0u) { xcd_barrier_complete(bar, b.x, nloc, nx); b.st[0] = nloc; b.st[1] = nx; }
        const unsigned old = xb_add(&bar[XB_XSUB(b.x)], 1u);
        const unsigned gen = old / nloc;
        if (old + 1u == (gen + 1u) * nloc) {
            __builtin_amdgcn_fence(__ATOMIC_RELEASE, "agent");
            asm volatile("s_waitcnt vmcnt(0)" ::: "memory");
            const unsigned og = xb_add(&bar[XB_TOP], 1u);
            const unsigned tg = og / nx;
            if (og + 1u == (tg + 1u) * nx) xb_add(&bar[XB_TOPGEN], 1u);
            else XB_SPIN(xb_ld(&bar[XB_TOPGEN]) == tg, bar);
            __builtin_amdgcn_fence(__ATOMIC_ACQUIRE, "agent");
            xb_add(&bar[XB_XGEN(b.x)], 1u);
            asm volatile("s_waitcnt vmcnt(0)" ::: "memory");
        } else {
            XB_SPIN(xb_ld(&bar[XB_XGEN(b.x)]) == gen, bar);
            __builtin_amdgcn_fence(__ATOMIC_ACQUIRE, "agent");
            asm volatile("s_waitcnt vmcnt(0)" ::: "memory");
        }
    }
    __syncthreads();
}
#endif

__device__ __forceinline__ void item_twiddle(const Frame& F, int it) {
    cplx* tw = (cplx*)(F.ws + WS_TW);
    const int k = it * NT + F.tid;
    if (k < TWN) { float s, c; const float a = -6.283185307179586f * (float)k / (float)TWN; s = sinf(a); c = cosf(a); tw[k].x = c; tw[k].y = s; }
}
__device__ __forceinline__ void item_mod(const Frame& F, int it) {
    const int layer = it / (NMOD / 64), n0 = (it % (NMOD / 64)) * 64;
    float* sc = (float*)F.smem;
    float* red = sc + 5 * D;
    for (int i = F.tid; i < 5 * D; i += NT) { const int m = i / D, k = i % D; const float v = m < NB ? F.in(I_C)[m * D + k] : F.in(I_CCTX)[k]; sc[i] = siluf(v); }
    __syncthreads();
    const int j = F.tid & 63, ks = F.tid >> 6;
    const float* w = F.in(I_WMOD) + (size_t)layer * D * NMOD + n0 + j;
    float a[5] = {0, 0, 0, 0, 0};
#pragma unroll 1
    for (int k0 = ks * 128; k0 < ks * 128 + 128; k0 += 32) {
        float wv[32];
#pragma unroll
        for (int q = 0; q < 32; ++q) wv[q] = w[(size_t)(k0 + q) * NMOD];
#pragma unroll
        for (int q = 0; q < 32; ++q)
#pragma unroll
            for (int m = 0; m < 5; ++m) a[m] += sc[m * D + k0 + q] * wv[q]; }
#pragma unroll
    for (int m = 0; m < 5; ++m) red[(ks * 5 + m) * 64 + j] = a[m];
    __syncthreads();
    if (F.tid < 5 * 64) { const int m = F.tid / 64, jj = F.tid % 64; float s = 0; for (int q = 0; q < 8; ++q) s += red[(q * 5 + m) * 64 + jj];
        ((float*)(F.ws + WS_MOD))[(size_t)(layer * 5 + m) * NMOD + n0 + jj] = s + F.in(I_BMOD)[layer * NMOD + n0 + jj]; }
    __syncthreads();
}
__device__ __forceinline__ void item_filter(const Frame& F, int layer, int isctx, int tb) {
    const int L = isctx ? CTXL : SEQ;
    float* feats = (float*)F.smem;
    float* h1 = feats + 32 * 33;
    float* h2 = h1 + 32 * 64;
    const int t0 = tb * 32;
    for (int i = F.tid; i < 32 * 33; i += NT) {
        const int tt = i / 33, f = i % 33; const float t = (float)(t0 + tt);
        float v;
        if (f == 0) v = t / (float)(L - 1 > 1 ? L - 1 : 1);
        else { const int bi = (f - 1) & 15; const float band = 1e-4f + (float)bi * ((15.0f - 1e-4f) / 15.0f);
               const float ang = (6.283185307179586f / (float)L) * t * band; v = (f <= 16) ? cosf(ang) : -sinf(ang); }
        feats[i] = v;
    }
    __syncthreads();
    const float* w1 = F.in(I_HW1) + layer * 33 * 64; const float* b1 = F.in(I_HB1) + layer * 64;
    const float* w2 = F.in(I_HW2) + layer * 64 * 64; const float* b2 = F.in(I_HB2) + layer * 64;
    const float* fr = F.in(I_HFREQ) + layer * 64;
    for (int i = F.tid; i < 32 * 64; i += NT) { const int tt = i >> 6, j = i & 63; float s = b1[j]; for (int k = 0; k < 33; ++k) s += feats[tt * 33 + k] * w1[k * 64 + j]; h1[i] = sinf(fr[j] * s); }
    __syncthreads();
    for (int i = F.tid; i < 32 * 64; i += NT) { const int tt = i >> 6, j = i & 63; float s = b2[j]; for (int k = 0; k < 64; ++k) s += h1[tt * 64 + k] * w2[k * 64 + j]; h2[i] = sinf(fr[j] * s); }
    __syncthreads();
    const float* w3 = F.in(I_HW3) + (size_t)layer * 64 * 1024;
    const int c0 = F.tid * 2;
    float* ft = (float*)(F.ws + WS_FT) + (isctx ? (size_t)2 * 256 * 4 * SEQ : (size_t)layer * 256 * 4 * SEQ);
    for (int hf = 0; hf < 2; ++hf) {
        float acc[16][2];
        for (int tt = 0; tt < 16; ++tt) { acc[tt][0] = 0.f; acc[tt][1] = 0.f; }
#pragma unroll 4
        for (int k = 0; k < 64; ++k) { const float wa = w3[k * 1024 + c0], wb = w3[k * 1024 + c0 + 1];
#pragma unroll
            for (int tt = 0; tt < 16; ++tt) { const float hv = h2[(hf * 16 + tt) * 64 + k]; acc[tt][0] += hv * wa; acc[tt][1] += hv * wb; } }
#pragma unroll
        for (int q = 0; q < 2; ++q) {
            const int col = c0 + q, dir = col >> 9, order = (col >> 8) & 1, c = col & 255;
            const float dec = fabsf(F.in(I_HDEC)[((layer * 2 + dir) * 2 + order) * 256 + c]);
            float* dst = ft + ((size_t)(c * 2 + order) * 2 + dir) * L + t0 + hf * 16;
#pragma unroll
            for (int tt = 0; tt < 16; ++tt) { const float tu = (float)(t0 + hf * 16 + tt) / (float)(L - 1 > 1 ? L - 1 : 1); dst[tt] = acc[tt][q] * expf(-tu * dec); }
        }
    }
    __syncthreads();
}
__device__ __forceinline__ int inproj_src_col(int j) { return j < 1024 ? j : (j < 3328 ? j + 12 : (j < 3340 ? j - 2304 : (j < NIN ? j : -1))); }
__device__ __forceinline__ void item_transpose(const Frame& F, const float* src, int ldn, int nvalid, half_t* dst, int K, int k0, int n0, int inmap = 0) {
    float* tile = (float*)F.smem;
    f32x4 v[8];
#pragma unroll
    for (int q = 0; q < 8; ++q) { const int i = F.tid + q * NT, r = i >> 6, c4 = (i & 63) * 4;
        if (inmap) { const int sc = inproj_src_col(n0 + c4); v[q] = sc >= 0 ? *(const f32x4*)(src + (size_t)(k0 + r) * ldn + sc) : (f32x4){0.f, 0.f, 0.f, 0.f}; }
        else if (n0 + c4 + 3 < nvalid) v[q] = *(const f32x4*)(src + (size_t)(k0 + r) * ldn + n0 + c4);
        else {
#pragma unroll
            for (int e = 0; e < 4; ++e) v[q][e] = (n0 + c4 + e < nvalid) ? src[(size_t)(k0 + r) * ldn + n0 + c4 + e] : 0.f; } }
#pragma unroll
    for (int q = 0; q < 8; ++q) { const int i = F.tid + q * NT, r = i >> 6, c4 = (i & 63) * 4; *(f32x4*)(tile + r * 260 + c4) = v[q]; }
    __syncthreads();
#pragma unroll
    for (int q = 0; q < 4; ++q) { const int i = F.tid + q * NT, n = i >> 3, kc = (i & 7) * 8; half8 h;
#pragma unroll
        for (int e = 0; e < 8; ++e) h[e] = (half_t)tile[(kc + e) * 260 + n];
        *(half8*)(dst + (size_t)(n0 + n) * K + k0 + kc) = h; }
    __syncthreads();
}
__device__ __forceinline__ void item_router_w(const Frame& F, int layer) {
    half_t* dst = (half_t*)(F.ws + WS_WR) + (size_t)layer * 2 * 48 * D;
#pragma unroll 4
    for (int i = F.tid; i < 32 * D; i += NT) {
        const int k = i >> 5, c = i & 31; const float w = F.in(I_ERW)[(size_t)layer * D * 32 + i];
        const half_t hi = (half_t)w; dst[(size_t)(4 + c) * D + k] = hi; dst[(size_t)(48 + 4 + c) * D + k] = (half_t)((w - (float)hi) * 2048.f); }
#pragma unroll 4
    for (int i = F.tid; i < 4 * D; i += NT) {
        const int k = i >> 2, c = i & 3; const float w = F.in(I_GRW)[(size_t)layer * D * 4 + i];
        const half_t hi = (half_t)w; dst[(size_t)c * D + k] = hi; dst[(size_t)(48 + c) * D + k] = (half_t)((w - (float)hi) * 2048.f); }
#pragma unroll 4
    for (int i = F.tid; i < 12 * D; i += NT) { dst[(size_t)36 * D + i] = (half_t)0.f; dst[(size_t)(48 + 36) * D + i] = (half_t)0.f; }
}
constexpr int IT_TW = (TWN + NT - 1) / NT;
constexpr int IT_MOD = 2 * (NMOD / 64);
constexpr int IT_FILT = 2 * (SEQ / 32) + (CTXL / 32);
constexpr int IT_TWIN = 2 * 16 * (NINP / 256);
constexpr int IT_TWOUT = 2 * 16 * 4;
constexpr int IT_TMOE = 32 * 48;
__device__ __forceinline__ void moe_transpose_item(const Frame& F, int layer, int it) {
    const int e = it / 48, r = it % 48, which = r / 16, t = r % 16;
    half_t* base = (half_t*)(F.ws + WS_WMOE) + (size_t)e * 3 * 262144;
    if (which < 2) {
        const float* src = F.in(which == 0 ? I_MG : I_MU) + ((size_t)layer * 32 + e) * 262144;
        item_transpose(F, src, 256, 256, base + which * 262144, 1024, t * 64, 0);
    } else {
        const float* src = F.in(I_MD) + ((size_t)layer * 32 + e) * 262144;
        item_transpose(F, src, 1024, 1024, base + 2 * 262144, 256, (t >> 2) * 64, (t & 3) * 256);
    }
}
__device__ __forceinline__ void phase_setup(const Frame& F) {
    const int G = gridDim.x; int rot = blockIdx.x;
    for (int i = rot; i < IT_MOD; i += G) item_mod(F, i);
    rot = (rot + G - (IT_MOD % G)) % G;
    for (int i = rot; i < IT_TWIN; i += G) { const int layer = i / (16 * (NINP / 256)), r = i % (16 * (NINP / 256));
        item_transpose(F, F.in(I_WIN) + (size_t)layer * D * NIN, NIN, NIN, (half_t*)(F.ws + WS_WIN) + (size_t)layer * NINP * D, D, (r / (NINP / 256)) * 64, (r % (NINP / 256)) * 256, 1); }
    rot = (rot + G - (IT_TWIN % G)) % G;
    for (int i = rot; i < IT_FILT; i += G) { if (i < 2 * (SEQ / 32)) item_filter(F, i / (SEQ / 32), 0, i % (SEQ / 32)); else item_filter(F, 0, 1, i - 2 * (SEQ / 32)); }
    rot = (rot + G - (IT_FILT % G)) % G;
    for (int i = rot; i < IT_TWOUT; i += G) { const int layer = i / 64, r = i % 64;
        item_transpose(F, F.in(I_WOUT) + (size_t)layer * D * D, D, D, (half_t*)(F.ws + WS_WOUT) + (size_t)layer * D * D, D, (r >> 2) * 64, (r & 3) * 256); }
    rot = (rot + G - (IT_TWOUT % G)) % G;
    for (int i = rot; i < IT_TW; i += G) item_twiddle(F, i);
    rot = (rot + G - (IT_TW % G)) % G;
    for (int i = rot; i < 2; i += G) item_router_w(F, i);
}

__device__ __forceinline__ void phase_norm1(const Frame& F, int layer) {
    half_t* xn = (half_t*)(F.ws + WS_XN);
    const int lane = F.lane, nwaves = gridDim.x * (NT / 64);
    const float* nw = F.in(I_N1W) + layer * D;
    int mc = -1; f32x4 g[4], s4[4];
    int row = blockIdx.x * (NT / 64) + F.wave;
    f32x4 v[4];
    if (row < TT) { const float* x = F.xrow_in(layer, row);
#pragma unroll
        for (int q = 0; q < 4; ++q) v[q] = *(const f32x4*)(x + q * 256 + lane * 4); }
    for (; row < TT; row += nwaves) {
        const int nrow = row + nwaves;
        f32x4 vn[4];
        if (nrow < TT) { const float* x = F.xrow_in(layer, nrow);
#pragma unroll
            for (int q = 0; q < 4; ++q) vn[q] = *(const f32x4*)(x + q * 256 + lane * 4); }
        if (layer > 0) {
            const half_t* xa = (const half_t*)(F.ws + WS_U16 + XAB_OFF) + (size_t)row * D; const half_t* xb = xa + (size_t)TT * D; float* xw = F.xrow(row);
            const float* g5 = modp(F, layer - 1, row_mod(row), 5);
#pragma unroll
            for (int q = 0; q < 4; ++q) { const int k = q * 256 + lane * 4; const half4 a4 = *(const half4*)(xa + k), b4 = *(const half4*)(xb + k); const f32x4 gv = *(const f32x4*)(g5 + k);
#pragma unroll
                for (int e = 0; e < 4; ++e) v[q][e] += gv[e] * ((float)a4[e] + (float)b4[e]);
                *(f32x4*)(xw + k) = v[q]; } }
        const int m = row_mod(row);
        if (m != mc) { mc = m; const float* sh = modp(F, layer, m, 0); const float* scl = modp(F, layer, m, 1);
#pragma unroll
            for (int q = 0; q < 4; ++q) { const int k = q * 256 + lane * 4; const f32x4 a = *(const f32x4*)(nw + k), b = *(const f32x4*)(scl + k); s4[q] = *(const f32x4*)(sh + k);
#pragma unroll
                for (int e = 0; e < 4; ++e) g[q][e] = a[e] * (1.0f + b[e]); } }
        float ss = 0.f;
#pragma unroll
        for (int q = 0; q < 4; ++q) ss += v[q][0] * v[q][0] + v[q][1] * v[q][1] + v[q][2] * v[q][2] + v[q][3] * v[q][3];
        ss = wave_sum(ss);
        const float rs = 1.0f / sqrtf(ss * (1.0f / D) + EPSF);
        int srow = row;
        if (layer == 1 && row < TL) { const int b = row / SEQ, l = row % SEQ; srow = b * SEQ + (l % GW) * GROWS + l / GW; }
#pragma unroll
        for (int q = 0; q < 4; ++q) { const int k = q * 256 + lane * 4; half4 h;
#pragma unroll
            for (int e = 0; e < 4; ++e) h[e] = (half_t)(v[q][e] * rs * g[q][e] + s4[q][e]);
            *(half4*)(xn + (size_t)srow * D + k) = h; }
#pragma unroll
        for (int q = 0; q < 4; ++q) v[q] = vn[q];
    }
}

#ifdef EMU
#define WAVE_SYNC() emu_wave_barrier()
#else
#define WAVE_SYNC() __builtin_amdgcn_wave_barrier()
#endif
constexpr int HYTR_OFF = g8::STAGE_BYTES + 2048;
struct EpiInproj {
    static constexpr bool PERM = true;
    half_t* u16; float* ug; half_t* hyt; half_t* halo; unsigned char* smem;
    __device__ __forceinline__ void operator()(const f32x4 (&acc)[2][2][4][2], const g8::Unit& u, int wr, int wc, int fr, int fq) const {
        const int rowb = u.pm * 256 + wr * 64 + fr;
        const bool edge = (fr == 0) || (fr == 15);
        const int lane = fq * 16 + fr;
        half_t* T = (half_t*)(smem + HYTR_OFF) + (wr * 4 + wc) * (32 * 24);
#pragma unroll
        for (int bj = 0; bj < 2; ++bj) {
            const int c8 = u.pn * 256 + bj * 128 + wc * 32 + 8 * fq;
            if (c8 < 1024 || (c8 >= 1792 && c8 < 3328)) {
                const int uc = c8 < 1024 ? c8 : c8 - 768; const bool hal = edge && uc >= 384 && uc < 1792;
#pragma unroll
                for (int ai = 0; ai < 2; ++ai)
#pragma unroll
                    for (int m = 0; m < 4; ++m) { const int row = rowb + ai * 128 + m * 16; const f32x4 a0 = acc[ai][bj][m][0], a1 = acc[ai][bj][m][1]; half8 h;
                        h[0] = (half_t)a0[0]; h[1] = (half_t)a0[1]; h[2] = (half_t)a0[2]; h[3] = (half_t)a0[3]; h[4] = (half_t)a1[0]; h[5] = (half_t)a1[1]; h[6] = (half_t)a1[2]; h[7] = (half_t)a1[3];
                        *(half8*)(u16 + (size_t)row * UW + uc) = h;
                        if (hal) *(half8*)(halo + ((size_t)(row >> 4) * 2 + (fr == 15)) * 1408 + (uc - 384)) = h; }
            } else if (c8 < 1792) {
                const int chb = (c8 - 8 * fq) - 1024;
#pragma unroll
                for (int ai = 0; ai < 2; ++ai)
#pragma unroll
                    for (int m = 0; m < 4; ++m) {
                        const f32x4 a0 = acc[ai][bj][m][0], a1 = acc[ai][bj][m][1];
                        WAVE_SYNC();
#pragma unroll
                        for (int j = 0; j < 4; ++j) { T[(8 * fq + j) * 24 + fr] = (half_t)a0[j]; T[(8 * fq + 4 + j) * 24 + fr] = (half_t)a1[j]; }
                        WAVE_SYNC();
                        const int ch = lane >> 1, th = lane & 1; const half8 hv = *(const half8*)(T + ch * 24 + th * 8);
                        const int row0 = rowb - fr + ai * 128 + m * 16;
                        half_t* dst = row0 < TL ? hyt + ((size_t)(row0 / SEQ) * 768 + chb + ch) * SEQ + row0 % SEQ : hyt + (size_t)NB * 768 * SEQ + ((size_t)((row0 - TL) / CTXL) * 768 + chb + ch) * CTXL + (row0 - TL) % CTXL;
                        *(half8*)(dst + th * 8) = hv; }
            } else {
#pragma unroll
                for (int n = 0; n < 2; ++n) { const int c0 = c8 + 4 * n;
                    if (c0 < NIN) { const int gc = c0 < 3340 ? c0 - 3328 : 12 + (c0 - 3340);
#pragma unroll
                        for (int ai = 0; ai < 2; ++ai)
#pragma unroll
                            for (int m = 0; m < 4; ++m) { const int row = rowb + ai * 128 + m * 16; *(f32x4*)(ug + (size_t)row * UGW + gc) = acc[ai][bj][m][n]; } } }
            }
        }
    }
};
__device__ __forceinline__ void phase_inproj(const Frame& F, int layer) {
    g8::DenseSched S; S.abase = (const char*)(F.ws + WS_XN); S.bbase = (const char*)((const half_t*)(F.ws + WS_WIN) + (size_t)layer * NINP * D); S.K = D; S.nM = TT / 256; S.nN = NINP / 256; S.G = gridDim.x; S.c = blockIdx.x;
    EpiInproj E{(half_t*)(F.ws + WS_U16), (float*)(F.ws + WS_UG), (half_t*)(F.ws + WS_HYT), (half_t*)(F.ws + WS_HALO), F.smem};
    g8::gemm_phase(F.smem, D, S, E);
}


__device__ __forceinline__ void phase_act(const Frame& F, int layer) {
    half_t* u16 = (half_t*)(F.ws + WS_U16); const half_t* halo = (const half_t*)(F.ws + WS_HALO);
    const int tid = F.tid, g = tid % 176, hf = tid / 176;
    const bool active = tid < 352;
    const bool isml = g >= 80; const int ch = isml ? (g - 80) * 8 : g * 8, C = isml ? 768 : 640;
    const float* cw = isml ? F.in(I_MCW) + layer * 3 * 768 : F.in(I_SCW) + layer * 3 * 640; const float* cb = isml ? F.in(I_MCB) + layer * 768 : F.in(I_SCB) + layer * 640;
    const float osc = (isml && ch >= 384) ? 0.125f : 1.0f;
    float w0[8], w1[8], w2[8], wb[8];
#pragma unroll
    for (int i = 0; i < 8; ++i) { const int cc = active ? ch + i : 0; w0[i] = cw[cc]; w1[i] = cw[C + cc]; w2[i] = cw[2 * C + cc]; wb[i] = cb[cc]; }
    for (int it = blockIdx.x; it < TT / 16; it += gridDim.x) {
        const int rb = it * 16, r0 = rb + hf * 8;
        const bool isl = rb < TL; const int L = isl ? SEQ : CTXL; const int pos0 = (isl ? rb : rb - TL) % L;
        half8 rr[10]; half8 zz;
#pragma unroll
        for (int i = 0; i < 8; ++i) zz[i] = (half_t)0.f;
        if (active) {
            const size_t col = 384 + g * 8;
#pragma unroll
            for (int k = 0; k < 8; ++k) rr[k + 1] = *(const half8*)(u16 + (size_t)(r0 + k) * UW + col);
            if (hf == 0) { rr[0] = pos0 > 0 ? *(const half8*)(halo + ((size_t)(it - 1) * 2 + 1) * 1408 + g * 8) : zz; rr[9] = *(const half8*)(u16 + (size_t)(rb + 8) * UW + col); }
            else { rr[0] = *(const half8*)(u16 + (size_t)(rb + 7) * UW + col); rr[9] = pos0 + 16 < L ? *(const half8*)(halo + ((size_t)(it + 1) * 2 + 0) * 1408 + g * 8) : zz; }
        }
        half8 o[8];
        if (active) {
#pragma unroll
            for (int k = 0; k < 8; ++k)
#pragma unroll
                for (int i = 0; i < 8; ++i) o[k][i] = (half_t)(osc * fsilu(w0[i] * (float)rr[k][i] + w1[i] * (float)rr[k + 1][i] + w2[i] * (float)rr[k + 2][i] + wb[i]));
        }
        __syncthreads();
        if (active) {
#pragma unroll
            for (int k = 0; k < 8; ++k) *(half8*)(u16 + (size_t)(r0 + k) * UW + 384 + g * 8) = o[k];
        }
    }
}

constexpr int SA = 72, SB = 136;

__device__ __forceinline__ void load_rows8(const half_t* u16, int rowbase, int Lseq, int dir, int jj0, int ucol, half8 (&rr)[8]) {
#pragma unroll
    for (int k = 0; k < 8; ++k) { const int jj = jj0 + k, pos = dir == 0 ? jj : Lseq - 1 - jj; rr[k] = *(const half8*)(u16 + (size_t)(rowbase + pos) * UW + ucol); }
}
__device__ __forceinline__ void transpose8(const half8 (&rr)[8], half8 (&t)[8]) {
#pragma unroll
    for (int i = 0; i < 8; ++i)
#pragma unroll
        for (int k = 0; k < 8; ++k) t[i][k] = rr[k][i];
}
__device__ __forceinline__ void ssd_block(const Frame& F, int layer, int b, int h, int dir) {
    half_t* Cs = (half_t*)F.smem;
    half_t* Bs = Cs + 128 * SA;
    half_t* BT = Bs + 128 * SA;
    half_t* XT = BT + 64 * SB;
    half_t* SC = XT + 64 * SB;
    half_t* ST = SC + 128 * SB;
    float* cum = (float*)(ST + 64 * SA);
    float* dtv = cum + 128;
    float* wes = dtv + 128;
    const half_t* u16 = (const half_t*)(F.ws + WS_U16); const float* ug = (const float*)(F.ws + WS_UG);
    half_t* yout = (half_t*)(F.ws + WS_YF) + (size_t)dir * TT * 384;
    const float* cw = F.in(I_SCW) + layer * 3 * 640; const float* cb = F.in(I_SCB) + layer * 640;
    const float dtb = F.in(I_DTB)[(layer * 2 + dir) * 6 + h];
    const float Aneg = -expf(F.in(I_ALOG)[(layer * 2 + dir) * 6 + h]);
    const float Dh = F.in(I_SD)[layer * 6 + h];
    const int g = h / 3, tid = F.tid, lane = F.lane, wave = F.wave;
    const int kind = tid >> 7, c8 = (tid & 7) * 8, j0 = ((tid >> 3) & 15) * 8;
    const int ch = kind == 0 ? h * 64 + c8 : (kind == 1 ? 384 + g * 64 + c8 : 512 + g * 64 + c8);
    f32x4 accS[1][2]; zero_acc(accS);
    for (int i = tid; i < 64 * SA; i += NT) ST[i] = (half_t)0.f;
    constexpr int NC0 = CTXL / 128, NCT = NC0 + SEQ / 128;
    half8 rr[8]; float ug0 = 0.f, ug1 = 0.f;
    if (kind < 3) load_rows8(u16, TL + b * CTXL, CTXL, dir, j0, 384 + ch, rr);
    if (wave == 7) { const int p0 = dir == 0 ? 2 * lane : CTXL - 1 - 2 * lane, p1 = dir == 0 ? p0 + 1 : p0 - 1;
        ug0 = ug[(size_t)(TL + b * CTXL + p0) * UGW + dir * 6 + h]; ug1 = ug[(size_t)(TL + b * CTXL + p1) * UGW + dir * 6 + h]; }
    __syncthreads();
    for (int cc = 0; cc < NCT; ++cc) {
        const int seg = cc >= NC0 ? 1 : 0, c = seg ? cc - NC0 : cc;
        const int Lseq = seg == 0 ? CTXL : SEQ, rowbase = seg == 0 ? TL + b * CTXL : b * SEQ;
        const bool want_y = (seg == 1) || (layer == 0);
        const int nseg = (cc + 1) >= NC0 ? 1 : 0, ncn = nseg ? cc + 1 - NC0 : cc + 1, nL = nseg == 0 ? CTXL : SEQ, nrb = nseg == 0 ? TL + b * CTXL : b * SEQ;
        if (wave == 7) {
            const float dt0 = fsoftplus(ug0 + dtb), dt1 = fsoftplus(ug1 + dtb);
            const float a0 = dt0 * Aneg, a1 = dt1 * Aneg;
            const float incl = wave_scan_sum(a0 + a1, lane);
            const float c1 = incl, c0 = incl - a1;
            const float cl = wave_last(incl);
            cum[2 * lane] = c0; cum[2 * lane + 1] = c1; dtv[2 * lane] = dt0; dtv[2 * lane + 1] = dt1;
            wes[2 * lane] = dt0 * fexp(cl - c0); wes[2 * lane + 1] = dt1 * fexp(cl - c1);
            if (cc + 1 < NCT) { const int pi = ncn * 128 + 2 * lane, p0 = dir == 0 ? pi : nL - 1 - pi, p1 = dir == 0 ? p0 + 1 : p0 - 1;
                ug0 = ug[(size_t)(nrb + p0) * UGW + dir * 6 + h]; ug1 = ug[(size_t)(nrb + p1) * UGW + dir * 6 + h]; }
        }
        if (kind < 3) {
            if (kind == 0) { half8 t[8]; transpose8(rr, t);
#pragma unroll
                for (int i = 0; i < 8; ++i) *(half8*)(XT + (c8 + i) * SB + j0) = t[i];
            } else if (kind == 1) { half8 t[8]; transpose8(rr, t);
#pragma unroll
                for (int k = 0; k < 8; ++k) *(half8*)(Bs + (j0 + k) * SA + c8) = rr[k];
#pragma unroll
                for (int i = 0; i < 8; ++i) *(half8*)(BT + (c8 + i) * SB + j0) = t[i];
            } else {
#pragma unroll
                for (int k = 0; k < 8; ++k) *(half8*)(Cs + (j0 + k) * SA + c8) = rr[k];
            }
            if (cc + 1 < NCT) load_rows8(u16, nrb, nL, dir, ncn * 128 + j0, 384 + ch, rr);
        }
        __syncthreads();
        const float cl = cum[127];
        if (want_y) {
            { const int ws_ = wave & 1, wl = wave >> 1;
              if (!(ws_ == 1 && wl < 2)) {
                f32x4 g_[4][2]; zero_acc(g_);
                mma_lds<4, 2>(g_, Bs + ws_ * 64 * SA, SA, Cs + wl * 32 * SA, SA, 2, lane);
#pragma unroll
                for (int a = 0; a < 4; ++a) {
                    const int s0 = ws_ * 64 + a * 16 + (lane >> 4) * 4;
                    const f32x4 cs4 = *(const f32x4*)(cum + s0), dt4 = *(const f32x4*)(dtv + s0);
#pragma unroll
                    for (int q = 0; q < 2; ++q) {
                        const int l = wl * 32 + q * 16 + (lane & 15); const float cl_ = cum[l]; half4 hv;
#pragma unroll
                        for (int i = 0; i < 4; ++i) hv[i] = (half_t)((s0 + i) <= l ? g_[a][q][i] * fexp(cl_ - cs4[i]) * dt4[i] : 0.f);
                        *(half4*)(SC + l * SB + s0) = hv;
                    } }
              } }
            f32x4 y1[4][1]; zero_acc(y1);
            mma_lds<4, 1>(y1, ST, SA, Cs + wave * 16 * SA, SA, 2, lane);
            __syncthreads();
            f32x4 y2[4][1]; zero_acc(y2);
            mma_lds<4, 1>(y2, XT, SB, SC + wave * 16 * SB, SB, wave / 2 + 1, lane);
            { const int l = wave * 16 + (lane & 15); const float el = fexp(cum[l]);
              const int pi = c * 128 + l, pos = dir == 0 ? pi : Lseq - 1 - pi;
#pragma unroll
              for (int a = 0; a < 4; ++a) { const int p0 = a * 16 + (lane >> 4) * 4; f32x4 y;
#pragma unroll
                  for (int i = 0; i < 4; ++i) y[i] = y1[a][0][i] * el + y2[a][0][i];
                  if (dir == 0) {
#pragma unroll
                      for (int i = 0; i < 4; ++i) y[i] += Dh * (float)XT[(p0 + i) * SB + l]; }
                  *(half4*)(yout + (size_t)(rowbase + pos) * 384 + h * 64 + p0) = to_half4(y); } }
        }
        { const float dec = fexp(cl);
#pragma unroll
          for (int q = 0; q < 2; ++q) accS[0][q] *= dec;
          const int r = lane & 15, kq = (lane >> 4) * 8;
#pragma unroll
          for (int ks = 0; ks < 4; ++ks) {
              const half8 a = *(const half8*)(BT + ((wave >> 1) * 16 + r) * SB + ks * 32 + kq);
              const f32x4 e0 = *(const f32x4*)(wes + ks * 32 + kq), e1 = *(const f32x4*)(wes + ks * 32 + kq + 4);
#pragma unroll
              for (int q = 0; q < 2; ++q) { half8 bb = *(const half8*)(XT + ((wave & 1) * 32 + q * 16 + r) * SB + ks * 32 + kq);
#pragma unroll
                  for (int i = 0; i < 4; ++i) { bb[i] = (half_t)((float)bb[i] * e0[i]); bb[4 + i] = (half_t)((float)bb[4 + i] * e1[i]); }
                  accS[0][q] = mfma16(a, bb, accS[0][q]); } } }
        __syncthreads();
#pragma unroll
        for (int q = 0; q < 2; ++q) { const int p = (wave & 1) * 32 + q * 16 + (lane & 15), n0 = (wave >> 1) * 16 + (lane >> 4) * 4; *(half4*)(ST + p * SA + n0) = to_half4(accS[0][q]); }
    }
    __syncthreads();
}

__device__ __forceinline__ void mlstm_block(const Frame& F, int layer, int b, int h, int dir) {
    half_t* Qs = (half_t*)F.smem;
    half_t* Ks = Qs + 128 * SA;
    half_t* KT = Ks + 128 * SA;
    half_t* VT = KT + 64 * SB;
    half_t* SC = VT + 64 * SB;
    half_t* CS = SC + 128 * SB;
    float* ig = (float*)(CS + 64 * SA);
    float* cumf = ig + 128; float* gsv = cumf + 128; float* mtv = gsv + 128; float* ee = mtv + 128; float* dn = ee + 128;
    float* nvec = dn + 128;
    float* scal = nvec + 64;
    const half_t* u16 = (const half_t*)(F.ws + WS_U16); const float* ug = (const float*)(F.ws + WS_UG);
    half_t* hout = (half_t*)(F.ws + WS_YF) + (size_t)(2 + dir) * TT * 384;
    const float* cw = F.in(I_MCW) + layer * 3 * 768; const float* cb = F.in(I_MCB) + layer * 768;
    const float bi = F.in(I_MGB)[((layer * 2 + dir) * 2 + 0) * 6 + h], bf = F.in(I_MGB)[((layer * 2 + dir) * 2 + 1) * 6 + h];
    const int tid = F.tid, lane = F.lane, wave = F.wave;
    const int kind = tid >> 7, c8 = (tid & 7) * 8, j0 = ((tid >> 3) & 15) * 8;
    const int ch = kind == 0 ? h * 64 + c8 : 384 + h * 64 + c8;
    f32x4 accC[1][2]; zero_acc(accC);
    float m_in = 0.f;
    for (int i = tid; i < 64 * SA; i += NT) CS[i] = (half_t)0.f;
    if (tid < 64) nvec[tid] = 0.f;
    constexpr int NC0 = CTXL / 128, NCT = NC0 + SEQ / 128;
    half8 rr[8]; float gi0 = 0.f, gi1 = 0.f, gf0 = 0.f, gf1 = 0.f;
    const int ucol = kind == 2 ? 1792 + h * 64 + c8 : 1024 + ch;
    if (kind < 3) load_rows8(u16, TL + b * CTXL, CTXL, dir, j0, ucol, rr);
    if (wave == 7) { const int p0 = dir == 0 ? 2 * lane : CTXL - 1 - 2 * lane, p1 = dir == 0 ? p0 + 1 : p0 - 1;
        const float* g0 = ug + (size_t)(TL + b * CTXL + p0) * UGW + 12 + dir * 12; const float* g1 = ug + (size_t)(TL + b * CTXL + p1) * UGW + 12 + dir * 12;
        gi0 = g0[h]; gf0 = g0[6 + h]; gi1 = g1[h]; gf1 = g1[6 + h]; }
    half8 ones;
#pragma unroll
    for (int i = 0; i < 8; ++i) ones[i] = (half_t)1.0f;
    __syncthreads();
    for (int cc = 0; cc < NCT; ++cc) {
        const int seg = cc >= NC0 ? 1 : 0, c = seg ? cc - NC0 : cc;
        const int Lseq = seg == 0 ? CTXL : SEQ, rowbase = seg == 0 ? TL + b * CTXL : b * SEQ;
        const bool want_y = (seg == 1) || (layer == 0);
        const int nseg = (cc + 1) >= NC0 ? 1 : 0, ncn = nseg ? cc + 1 - NC0 : cc + 1, nL = nseg == 0 ? CTXL : SEQ, nrb = nseg == 0 ? TL + b * CTXL : b * SEQ;
        if (wave == 7) {
            const float i0 = gi0 + bi, i1 = gi1 + bi, lf0 = flogsigmoid(gf0 + bf), lf1 = flogsigmoid(gf1 + bf);
            const float incl = wave_scan_sum(lf0 + lf1, lane);
            const float c1 = incl, c0 = incl - lf1;
            const float tot = wave_last(incl);
            const float r0 = i0 - c0, r1 = i1 - c1;
            const float pincl = wave_scan_max(fmaxf(r0, r1), lane);
            const float pexcl = wave_shr1(pincl, -3.0e38f, lane);
            const float pm0 = fmaxf(pexcl, r0), pm1 = pincl;
            const float pmlast = wave_last(pincl);
            const float m_new = fmaxf(tot + m_in, tot + pmlast);
            ig[2 * lane] = i0; ig[2 * lane + 1] = i1; cumf[2 * lane] = c0; cumf[2 * lane + 1] = c1; gsv[2 * lane] = r0; gsv[2 * lane + 1] = r1;
            mtv[2 * lane] = fmaxf(c0 + m_in, c0 + pm0); mtv[2 * lane + 1] = fmaxf(c1 + m_in, c1 + pm1);
            ee[2 * lane] = fexp(r0 + tot - m_new); ee[2 * lane + 1] = fexp(r1 + tot - m_new);
            if (lane == 0) { scal[0] = tot; scal[1] = m_new; }
            if (cc + 1 < NCT) { const int pi = ncn * 128 + 2 * lane, p0 = dir == 0 ? pi : nL - 1 - pi, p1 = dir == 0 ? p0 + 1 : p0 - 1;
                const float* g0 = ug + (size_t)(nrb + p0) * UGW + 12 + dir * 12; const float* g1 = ug + (size_t)(nrb + p1) * UGW + 12 + dir * 12;
                gi0 = g0[h]; gf0 = g0[6 + h]; gi1 = g1[h]; gf1 = g1[6 + h]; }
        }
        if (kind == 0) {
#pragma unroll
            for (int k = 0; k < 8; ++k) *(half8*)(Qs + (j0 + k) * SA + c8) = rr[k];
        } else if (kind == 1) { half8 t[8]; transpose8(rr, t);
#pragma unroll
            for (int k = 0; k < 8; ++k) *(half8*)(Ks + (j0 + k) * SA + c8) = rr[k];
#pragma unroll
            for (int i = 0; i < 8; ++i) *(half8*)(KT + (c8 + i) * SB + j0) = t[i];
        } else if (kind == 2) { half8 t[8]; transpose8(rr, t);
#pragma unroll
            for (int i = 0; i < 8; ++i) *(half8*)(VT + (c8 + i) * SB + j0) = t[i];
        }
        if (kind < 3 && cc + 1 < NCT) load_rows8(u16, nrb, nL, dir, ncn * 128 + j0, ucol, rr);
        __syncthreads();
        const float tot = scal[0], m_new = scal[1];
        if (want_y) {
            { const int ws_ = wave & 1, wl = wave >> 1;
              if (!(ws_ == 1 && wl < 2)) {
                f32x4 g_[4][2]; zero_acc(g_);
                mma_lds<4, 2>(g_, Ks + ws_ * 64 * SA, SA, Qs + wl * 32 * SA, SA, 2, lane);
#pragma unroll
                for (int a = 0; a < 4; ++a) {
                    const int s0 = ws_ * 64 + a * 16 + (lane >> 4) * 4; const f32x4 gs4 = *(const f32x4*)(gsv + s0);
#pragma unroll
                    for (int q = 0; q < 2; ++q) {
                        const int l = wl * 32 + q * 16 + (lane & 15); const float cm = cumf[l] - mtv[l]; half4 hv;
#pragma unroll
                        for (int i = 0; i < 4; ++i) hv[i] = (half_t)((s0 + i) <= l ? g_[a][q][i] * fexp(cm + gs4[i]) : 0.f);
                        *(half4*)(SC + l * SB + s0) = hv;
                    } }
              } }
            f32x4 h1[4][1]; zero_acc(h1);
            mma_lds<4, 1>(h1, CS, SA, Qs + wave * 16 * SA, SA, 2, lane);
            f32x4 dq = {0.f, 0.f, 0.f, 0.f};
            { const int r_ = lane & 15, kq_ = (lane >> 4) * 8;
#pragma unroll
              for (int ks = 0; ks < 2; ++ks) { half8 na; const f32x4 n0 = *(const f32x4*)(nvec + ks * 32 + kq_), n1 = *(const f32x4*)(nvec + ks * 32 + kq_ + 4);
#pragma unroll
                  for (int i = 0; i < 4; ++i) { na[i] = (half_t)n0[i]; na[4 + i] = (half_t)n1[i]; }
                  dq = mfma16(na, *(const half8*)(Qs + (wave * 16 + r_) * SA + ks * 32 + kq_), dq); } }
            __syncthreads();
            f32x4 h2[4]; f32x4 d1 = {0.f, 0.f, 0.f, 0.f};
#pragma unroll
            for (int a = 0; a < 4; ++a) h2[a] = (f32x4){0.f, 0.f, 0.f, 0.f};
            { const int r = lane & 15, kq = (lane >> 4) * 8;
              for (int ks = 0; ks < wave / 2 + 1; ++ks) {
                  const half8 bfr = *(const half8*)(SC + (wave * 16 + r) * SB + ks * 32 + kq);
#pragma unroll
                  for (int a = 0; a < 4; ++a) { const half8 afr = *(const half8*)(VT + (a * 16 + r) * SB + ks * 32 + kq); h2[a] = mfma16(afr, bfr, h2[a]); }
                  d1 = mfma16(ones, bfr, d1); } }
            { const int l = wave * 16 + (lane & 15); const float ai = fexp(cumf[l] + m_in - mtv[l]); const float rden = 1.0f / fmaxf(fabsf(dq[0] * ai + d1[0]), fexp(-mtv[l]));
              const int pi = c * 128 + l, pos = dir == 0 ? pi : Lseq - 1 - pi;
#pragma unroll
              for (int a = 0; a < 4; ++a) { const int v0 = a * 16 + (lane >> 4) * 4; f32x4 y;
#pragma unroll
                  for (int i = 0; i < 4; ++i) y[i] = (h1[a][0][i] * ai + h2[a][i]) * rden;
                  *(half4*)(hout + (size_t)(rowbase + pos) * 384 + h * 64 + v0) = to_half4(y); } }
        }
        { const float sc = fexp(tot + m_in - m_new);
#pragma unroll
          for (int q = 0; q < 2; ++q) accC[0][q] *= sc;
          { const int r = lane & 15, kq = (lane >> 4) * 8;
#pragma unroll
            for (int ks = 0; ks < 4; ++ks) {
              const half8 a = *(const half8*)(KT + ((wave >> 1) * 16 + r) * SB + ks * 32 + kq);
              const f32x4 e0 = *(const f32x4*)(ee + ks * 32 + kq), e1 = *(const f32x4*)(ee + ks * 32 + kq + 4);
#pragma unroll
              for (int q = 0; q < 2; ++q) { half8 bb = *(const half8*)(VT + ((wave & 1) * 32 + q * 16 + r) * SB + ks * 32 + kq);
#pragma unroll
                  for (int i = 0; i < 4; ++i) { bb[i] = (half_t)((float)bb[i] * e0[i]); bb[4 + i] = (half_t)((float)bb[4 + i] * e1[i]); }
                  accC[0][q] = mfma16(a, bb, accC[0][q]); } } }
          if ((wave & 1) == 0) { f32x4 an = {0.f, 0.f, 0.f, 0.f}; const int r_ = lane & 15, kq_ = (lane >> 4) * 8;
#pragma unroll
              for (int ks = 0; ks < 4; ++ks) { half8 eb; const f32x4 e0 = *(const f32x4*)(ee + ks * 32 + kq_), e1 = *(const f32x4*)(ee + ks * 32 + kq_ + 4);
#pragma unroll
                  for (int i = 0; i < 4; ++i) { eb[i] = (half_t)e0[i]; eb[4 + i] = (half_t)e1[i]; }
                  an = mfma16(*(const half8*)(KT + ((wave >> 1) * 16 + r_) * SB + ks * 32 + kq_), eb, an); }
              if ((lane & 15) == 0) {
#pragma unroll
                  for (int i = 0; i < 4; ++i) { const int d = (wave >> 1) * 16 + (lane >> 4) * 4 + i; nvec[d] = sc * nvec[d] + an[i]; } } } }
        m_in = m_new;
        __syncthreads();
#pragma unroll
        for (int q = 0; q < 2; ++q) { const int v = (wave & 1) * 32 + q * 16 + (lane & 15), d0 = (wave >> 1) * 16 + (lane >> 4) * 4; *(half4*)(CS + v * SA + d0) = to_half4(accC[0][q]); }
    }
    __syncthreads();
}

__device__ __forceinline__ cplx cmul(cplx a, cplx b) { return cplx{a.x * b.x - a.y * b.y, a.x * b.y + a.y * b.x}; }
__device__ __forceinline__ cplx cadd(cplx a, cplx b) { return cplx{a.x + b.x, a.y + b.y}; }
__device__ __forceinline__ cplx csub(cplx a, cplx b) { return cplx{a.x - b.x, a.y - b.y}; }
__device__ __forceinline__ void sincos_turns(float x, float& s, float& c) {
#ifdef EMU
    s = sinf(6.283185307179586f * x); c = cosf(6.283185307179586f * x);
#else
    s = __builtin_amdgcn_sinf(x); c = __builtin_amdgcn_cosf(x);
#endif
}
#define PADI(i) ((i) + ((i) >> 5))
template <bool INV> __device__ __forceinline__ void r4(cplx& a0, cplx& a1, cplx& a2, cplx& a3) {
    const cplx t0 = cadd(a0, a2), t1 = csub(a0, a2), t2 = cadd(a1, a3), t3 = csub(a1, a3);
    a0 = cadd(t0, t2); a2 = csub(t0, t2);
    if (!INV) { a1 = cplx{t1.x + t3.y, t1.y - t3.x}; a3 = cplx{t1.x - t3.y, t1.y + t3.x}; }
    else      { a1 = cplx{t1.x - t3.y, t1.y + t3.x}; a3 = cplx{t1.x + t3.y, t1.y - t3.x}; }
}
template <bool INV> __device__ __forceinline__ void fft16(cplx (&v)[16]) {
#pragma unroll
    for (int l0 = 0; l0 < 4; ++l0) r4<INV>(v[l0], v[l0 + 4], v[l0 + 8], v[l0 + 12]);
    const float C1 = 0.9238795325112867f, S1 = 0.3826834323650898f, C2 = 0.7071067811865476f;
    const float sg = INV ? 1.f : -1.f;
#define TWM(idx, cr, ci) v[idx] = cmul(v[idx], cplx{(cr), sg * (ci)})
    TWM(1 + 4 * 1, C1, S1); TWM(2 + 4 * 1, C2, C2); TWM(3 + 4 * 1, S1, C1);
    TWM(1 + 4 * 2, C2, C2); TWM(2 + 4 * 2, 0.f, 1.f); TWM(3 + 4 * 2, -C2, C2);
    TWM(1 + 4 * 3, S1, C1); TWM(2 + 4 * 3, -C2, C2); TWM(3 + 4 * 3, -C1, -S1);
#undef TWM
    cplx o[16];
#pragma unroll
    for (int m0 = 0; m0 < 4; ++m0) { cplx a0 = v[4 * m0], a1 = v[4 * m0 + 1], a2 = v[4 * m0 + 2], a3 = v[4 * m0 + 3]; r4<INV>(a0, a1, a2, a3);
        o[m0] = a0; o[m0 + 4] = a1; o[m0 + 8] = a2; o[m0 + 12] = a3; }
#pragma unroll
    for (int i = 0; i < 16; ++i) v[i] = o[i];
}
__device__ __forceinline__ void twpow(cplx w1, cplx (&w)[16]) {
    w[1] = w1; w[2] = cmul(w1, w1); w[3] = cmul(w[2], w1); w[4] = cmul(w[2], w[2]); w[5] = cmul(w[4], w1); w[6] = cmul(w[4], w[2]); w[7] = cmul(w[4], w[3]); w[8] = cmul(w[4], w[4]);
#pragma unroll
    for (int m = 9; m < 16; ++m) w[m] = cmul(w[8], w[m - 8]);
}
#ifdef EMU
#define OPAQUE_I(x)
#else
#define OPAQUE_I(x) asm volatile("" : "+v"(x))
#endif
template <int NS> __device__ __forceinline__ void fft_fwd16(cplx* buf0, cplx* buf1, int N, int tid, int TS = NT) {
#pragma unroll 1
    for (int n = N; n >= 32; n >>= 4) { const int q = n >> 4, qs = q + (q >> 5);
        for (int i = tid; i < N / 16; i += TS) {
            const int blk = i / q, j = i - blk * q; int pb = PADI(blk * n + j); OPAQUE_I(pb);
            float s, c; sincos_turns(-(float)j / (float)n, s, c);
            const cplx w1{c, s};
#pragma unroll
            for (int st = 0; st < NS; ++st) { cplx* buf = (st == 0 ? buf0 : buf1) + pb;
                cplx v[16];
#pragma unroll
                for (int l = 0; l < 16; ++l) v[l] = buf[l * qs];
                fft16<false>(v);
                buf[0] = v[0];
                cplx wm = w1;
#pragma unroll
                for (int m = 1; m < 16; ++m) { buf[m * qs] = cmul(v[m], wm); wm = cmul(wm, w1); }
                LOADER_FENCE(); }
        }
        __syncthreads(); }
}
template <int NS> __device__ __forceinline__ void fft_inv16(cplx* buf0, cplx* buf1, int N, int tid, int TS = NT) {
#pragma unroll 1
    for (int n = 32; n <= N; n <<= 4) { const int q = n >> 4, qs = q + (q >> 5);
        for (int i = tid; i < N / 16; i += TS) {
            const int blk = i / q, j = i - blk * q; int pb = PADI(blk * n + j); OPAQUE_I(pb);
            float s, c; sincos_turns((float)j / (float)n, s, c);
            const cplx w1{c, s};
#pragma unroll
            for (int st = 0; st < NS; ++st) { cplx* buf = (st == 0 ? buf0 : buf1) + pb;
                cplx v[16];
                v[0] = buf[0];
                cplx wm = w1;
#pragma unroll
                for (int m = 1; m < 16; ++m) { v[m] = cmul(buf[m * qs], wm); wm = cmul(wm, w1); }
                fft16<true>(v);
#pragma unroll
                for (int l = 0; l < 16; ++l) buf[l * qs] = v[l];
                LOADER_FENCE(); }
        }
        __syncthreads(); }
}
static_assert(2 * SEQ == 512 || 2 * SEQ == 8192, "FFT size must be 2*16^k");
static_assert(2 * CTXL == 512 || 2 * CTXL == 8192, "FFT size must be 2*16^k");
constexpr int HBUF = (2 * SEQ + (2 * SEQ) / 32 + 8);
constexpr int HPT = (SEQ + NT - 1) / NT;
__device__ __forceinline__ void hy_conv8(const half_t* p, int t0, int L, float w0, float w1, float w2, float bsv, float (&o)[8]) {
    const half8 m = *(const half8*)(p + t0);
    float e[10]; e[0] = t0 > 0 ? (float)p[t0 - 1] : 0.f; e[9] = t0 + 8 < L ? (float)p[t0 + 8] : 0.f;
#pragma unroll
    for (int i = 0; i < 8; ++i) e[i + 1] = (float)m[i];
#pragma unroll
    for (int i = 0; i < 8; ++i) o[i] = w0 * e[i] + w1 * e[i + 1] + w2 * e[i + 2] + bsv;
}
template <int TS> __device__ __forceinline__ float team_sum(float v, const Frame& F, float* red) {
    if constexpr (TS == NT) { v = wave_sum(v); if (F.lane == 0) red[F.wave] = v; __syncthreads(); float t = 0.f; for (int w = 0; w < NT / 64; ++w) t += red[w]; return t; }
    else { static_assert(TS == 32, "team size");
#pragma unroll
        for (int m = 16; m >= 1; m >>= 1) v += __shfl_xor(v, m);
        __syncthreads(); return v; }
}
template <int NS, int TS, int HP> __device__ __forceinline__ void hyena_seg_t(const Frame& F, int layer, int c0, const int seg) {
    const int HB = (seg == 0 ? 2 * SEQ : 2 * CTXL) + (seg == 0 ? 2 * SEQ : 2 * CTXL) / 32 + 8;
    const int tid = F.tid % TS, team = F.tid / TS, c = c0 + team;
    cplx* bufA = (cplx*)F.smem + (size_t)team * 2 * HB;
    cplx* bufB = bufA + HB;
    float* red = (float*)((cplx*)F.smem + (size_t)(NT / TS) * 2 * HB);
    const float* cwp = F.in(I_HCW) + layer * 3 * 768; const float* cbp = F.in(I_HCB) + layer * 768;
    {
        const int L = seg == 0 ? SEQ : CTXL, N = 2 * L;
        const half_t* hyt = (const half_t*)(F.ws + WS_HYT) + (seg == 0 ? 0 : (size_t)NB * 768 * SEQ);
        float* z1 = (float*)(F.ws + WS_XN) + (seg == 0 ? 0 : (size_t)NB * 256 * SEQ);
        float* yht = (float*)(F.ws + WS_YHT) + (seg == 0 ? 0 : (size_t)NB * 256 * SEQ);
        const float* ft = (const float*)(F.ws + WS_FT) + (seg == 0 ? (size_t)layer * 256 * 4 * SEQ : (size_t)2 * 256 * 4 * SEQ);
        for (int order = 0; order < 2; ++order) {
            const float* hfw = ft + ((size_t)(c * 2 + order) * 2 + 0) * L; const float* hbw = ft + ((size_t)(c * 2 + order) * 2 + 1) * L;
            float asum = 0.f;
            for (int i_ = tid; i_ < N; i_ += TS) { int i = i_; OPAQUE_I(i); const float v = i < L ? hfw[i] : (i == L ? 0.f : hbw[N - i]); bufA[PADI(i)] = cplx{v, 0.f}; asum += fabsf(v); }
            const float tot = team_sum<TS>(asum, F, red);
            fft_fwd16<1>(bufA, bufA, N, tid, TS);
            half4 Hh[HP];
            const float hs = 1.0f / tot, invN = 1.0f / (float)N;
#pragma unroll
            for (int k = 0; k < HP; ++k) { int i = tid + k * TS; OPAQUE_I(i); half4 hv;
                if (i < N / 2) { const cplx a = bufA[PADI(2 * i)], b_ = bufA[PADI(2 * i + 1)]; const cplx s = cadd(a, b_), d = csub(a, b_);
                    hv[0] = (half_t)(s.x * hs); hv[1] = (half_t)(s.y * hs); hv[2] = (half_t)(d.x * hs); hv[3] = (half_t)(d.y * hs); }
                else { hv[0] = hv[1] = hv[2] = hv[3] = (half_t)0.f; }
                Hh[k] = hv; LOADER_FENCE(); }
            __syncthreads();
            const int gch = 256 * (order + 1) + c;
            for (int pr = 0; pr < NB / 2; pr += NS) {
#pragma unroll
                for (int st = 0; st < NS; ++st) { cplx* buf = st == 0 ? bufA : bufB; const int b0 = 2 * (pr + st), b1 = b0 + 1;
                    const float vw0 = cwp[c], vw1 = cwp[768 + c], vw2 = cwp[1536 + c], vb = cbp[c];
                    const half_t* v0p = hyt + ((size_t)b0 * 768 + c) * L; const half_t* v1p = hyt + ((size_t)b1 * 768 + c) * L;
                    const float* z0q = z1 + ((size_t)b0 * 256 + c) * L; const float* z1q = z1 + ((size_t)b1 * 256 + c) * L;
                    for (int t0_ = tid * 8; t0_ < N; t0_ += TS * 8) { int t0 = t0_; OPAQUE_I(t0);
                        if (t0 < L) { float za[8], zb[8];
                            if (order == 0) { hy_conv8(v0p, t0, L, vw0, vw1, vw2, vb, za); hy_conv8(v1p, t0, L, vw0, vw1, vw2, vb, zb); }
                            else {
#pragma unroll
                                for (int i = 0; i < 8; ++i) { za[i] = z0q[t0 + i]; zb[i] = z1q[t0 + i]; } }
#pragma unroll
                            for (int i = 0; i < 8; ++i) buf[PADI(t0 + i)] = cplx{za[i], zb[i]}; }
                        else {
#pragma unroll
                            for (int i = 0; i < 8; ++i) buf[PADI(t0 + i)] = cplx{0.f, 0.f}; }
                        LOADER_FENCE();
                    } }
                __syncthreads();
                fft_fwd16<NS>(bufA, bufB, N, tid, TS);
#pragma unroll
                for (int st = 0; st < NS; ++st) { cplx* buf = st == 0 ? bufA : bufB;
#pragma unroll
                    for (int k = 0; k < HP; ++k) { int i = tid + k * TS; OPAQUE_I(i);
                        if (i < N / 2) { const cplx a = buf[PADI(2 * i)], b_ = buf[PADI(2 * i + 1)];
                            const cplx h0{(float)Hh[k][0] * invN, (float)Hh[k][1] * invN}, h1{(float)Hh[k][2] * invN, (float)Hh[k][3] * invN};
                            const cplx s = cmul(cadd(a, b_), h0), d = cmul(csub(a, b_), h1);
                            buf[PADI(2 * i)] = cadd(s, d); buf[PADI(2 * i + 1)] = csub(s, d); }
                        LOADER_FENCE(); } }
                __syncthreads();
                fft_inv16<NS>(bufA, bufB, N, tid, TS);
#pragma unroll
                for (int st = 0; st < NS; ++st) { cplx* buf = st == 0 ? bufA : bufB; const int b0 = 2 * (pr + st), b1 = b0 + 1;
                    const float gw0 = cwp[gch], gw1 = cwp[768 + gch], gw2 = cwp[1536 + gch], gb = cbp[gch];
                    const float vw0 = cwp[c], vw1 = cwp[768 + c], vw2 = cwp[1536 + c], vb = cbp[c];
                    const float skip = F.in(I_HSKIP)[(layer * 2 + order) * 256 + c];
                    const half_t* v0p = hyt + ((size_t)b0 * 768 + c) * L; const half_t* v1p = hyt + ((size_t)b1 * 768 + c) * L;
                    const float* z0q = z1 + ((size_t)b0 * 256 + c) * L; const float* z1q = z1 + ((size_t)b1 * 256 + c) * L;
                    const half_t* g0p = hyt + ((size_t)b0 * 768 + gch) * L; const half_t* g1p = hyt + ((size_t)b1 * 768 + gch) * L;
                    float* d0 = (order == 0 ? z1 : yht) + ((size_t)b0 * 256 + c) * L; float* d1 = (order == 0 ? z1 : yht) + ((size_t)b1 * 256 + c) * L;
                    for (int t0_ = tid * 8; t0_ < L; t0_ += TS * 8) { int t0 = t0_; OPAQUE_I(t0);
                        float za[8], zb[8], ga[8], gb_[8];
                        if (order == 0) { hy_conv8(v0p, t0, L, vw0, vw1, vw2, vb, za); hy_conv8(v1p, t0, L, vw0, vw1, vw2, vb, zb); }
                        else {
#pragma unroll
                            for (int i = 0; i < 8; ++i) { za[i] = z0q[t0 + i]; zb[i] = z1q[t0 + i]; } }
                        hy_conv8(g0p, t0, L, gw0, gw1, gw2, gb, ga); hy_conv8(g1p, t0, L, gw0, gw1, gw2, gb, gb_);
                        f32x4 oa[2], ob[2];
#pragma unroll
                        for (int i = 0; i < 8; ++i) { const cplx y = buf[PADI(t0 + i)]; oa[i >> 2][i & 3] = ga[i] * (y.x + skip * za[i]); ob[i >> 2][i & 3] = gb_[i] * (y.y + skip * zb[i]); }
                        *(f32x4*)(d0 + t0) = oa[0]; *(f32x4*)(d0 + t0 + 4) = oa[1]; *(f32x4*)(d1 + t0) = ob[0]; *(f32x4*)(d1 + t0 + 4) = ob[1];
                        LOADER_FENCE();
                    } }
                __syncthreads();
            }
        }
    }
}
constexpr int HP_L = (SEQ + NT - 1) / NT, HP_C = (CTXL + 31) / 32;
static_assert((size_t)(NT / 32) * 2 * (2 * CTXL + 2 * CTXL / 32 + 8) * 8 + 256 <= (size_t)LDS_BYTES - 64, "ctx team buffers must fit in LDS");
__device__ __forceinline__ void hyena_channel(const Frame& F, int layer, int c) {
    constexpr int NS = (NB % 4 == 0) ? 2 : 1;
    hyena_seg_t<NS, NT, HP_L>(F, layer, c, 0);
}
__device__ __forceinline__ void hyena_ctx_group(const Frame& F, int layer, int g) {
    constexpr int NS = (NB % 4 == 0) ? 2 : 1;
    hyena_seg_t<NS, 32, HP_C>(F, layer, g * (NT / 32), 1);
}
__device__ __forceinline__ int queue_pull(const Frame& F, unsigned* head) {
    int* slot = (int*)(F.smem + LDS_BYTES - 64);
    __syncthreads();
    if (F.tid == 0) *slot = (int)atomicAdd(head, 1u);
    __syncthreads();
    const int v = *slot;
    return v;
}
__device__ __forceinline__ void phase_mixers(const Frame& F, int layer) {
    const int bid = blockIdx.x;
    constexpr int NSCAN = 2 * NB * 6 * 2;
    unsigned* qhead = (unsigned*)(F.ws + WS_CTL) + CW_QUE + layer * 128;
    if (bid < NSCAN) {
        const int k = bid >> 1, kind = bid & 1, dir = k % 2, h = (k / 2) % 6, b = k / 12;
        if (kind == 0) ssd_block(F, layer, b, h, dir); else mlstm_block(F, layer, b, h, dir);
    }
    for (;;) { const int c = queue_pull(F, qhead); if (c >= 256) break; hyena_channel(F, layer, c); }
    if (layer == 0) for (;;) { const int g = queue_pull(F, qhead + 32); if (g >= 256 / (NT / 32)) break; hyena_ctx_group(F, layer, g); }
    for (;;) { const int it = queue_pull(F, qhead + 64); if (it >= IT_TMOE) break; moe_transpose_item(F, layer, it); }
}

__device__ __forceinline__ void phase_combine(const Frame& F, int layer) {
    const int nrows = layer == 0 ? TT : TL;
    const half_t* u16 = (const half_t*)(F.ws + WS_U16);
    const half_t* yf = (const half_t*)(F.ws + WS_YF); const half_t* yb = yf + (size_t)TT * 384; const half_t* hf = yb + (size_t)TT * 384; const half_t* hb = hf + (size_t)TT * 384;
    half_t* yl = (half_t*)(F.ws + WS_XN);
    const float* snw = F.in(I_SNW) + layer * 384; const float* mnw = F.in(I_MNW) + layer * 384;
    const int lane = F.lane, k8 = (lane < 48 ? lane : 0) * 8, nwaves = gridDim.x * (NT / 64);
    f32x4 sw[2], mw[2];
#pragma unroll
    for (int q = 0; q < 2; ++q) { sw[q] = *(const f32x4*)(snw + k8 + q * 4); mw[q] = *(const f32x4*)(mnw + k8 + q * 4); }
    int row = blockIdx.x * (NT / 64) + F.wave;
    half8 a[6];
#define COMB_LOAD(dst, r) { const size_t ro = (size_t)(r); dst[0] = *(const half8*)(yf + ro * 384 + k8); dst[1] = *(const half8*)(yb + ro * 384 + k8); dst[2] = *(const half8*)(u16 + ro * UW + k8); \
        dst[3] = *(const half8*)(hf + ro * 384 + k8); dst[4] = *(const half8*)(hb + ro * 384 + k8); dst[5] = *(const half8*)(u16 + ro * UW + 2176 + k8); }
    if (row < nrows) COMB_LOAD(a, row)
    for (; row < nrows; row += nwaves) {
        const int nrow = row + nwaves;
        half8 an[6];
        if (nrow < nrows) COMB_LOAD(an, nrow)
        const size_t ro = (size_t)row;
        float g[8], hv[8]; float ss = 0.f, hs = 0.f;
#pragma unroll
        for (int i = 0; i < 8; ++i) { g[i] = ((float)a[0][i] + (float)a[1][i]) * fsilu((float)a[2][i]); ss += g[i] * g[i]; hv[i] = (float)a[3][i] + (float)a[4][i]; hs += hv[i]; }
        if (lane >= 48) ss = 0.f;
        ss = wave_sum(ss);
        hs += __shfl_xor(hs, 1); hs += __shfl_xor(hs, 2); hs += __shfl_xor(hs, 4);
        const float mu = hs * (1.0f / 64.f);
        float vs = 0.f;
#pragma unroll
        for (int i = 0; i < 8; ++i) { hv[i] -= mu; vs += hv[i] * hv[i]; }
        vs += __shfl_xor(vs, 1); vs += __shfl_xor(vs, 2); vs += __shfl_xor(vs, 4);
        const float rs = 1.0f / sqrtf(ss * (1.0f / 384.f) + EPSF), rstd = 1.0f / sqrtf(vs * (1.0f / 64.f) + EPSF);
        if (lane < 48) { half8 o1, o2;
#pragma unroll
            for (int i = 0; i < 8; ++i) { o1[i] = (half_t)(g[i] * rs * sw[i >> 2][i & 3]); o2[i] = (half_t)(hv[i] * rstd * mw[i >> 2][i & 3] / (1.0f + fexp(-(float)a[5][i]))); }
            *(half8*)(yl + ro * D + k8) = o1; *(half8*)(yl + ro * D + 640 + k8) = o2; }
#pragma unroll
        for (int i = 0; i < 6; ++i) a[i] = an[i];
    }
#undef COMB_LOAD
    { const int ntile = nrows / 32, hbk = blockIdx.x * 2 + (F.tid >> 8), c = F.tid & 255;
      for (int tl = hbk; tl < ntile; tl += gridDim.x * 2) {
          const int row0 = tl * 32; const bool isl = row0 < TL; const int L = isl ? SEQ : CTXL; const int rc = isl ? row0 : row0 - TL; const int b = rc / L, t0 = rc % L;
          const float* src = (const float*)(F.ws + WS_YHT) + (isl ? 0 : (size_t)NB * 256 * SEQ) + ((size_t)b * 256 + c) * L + t0;
          f32x4 v[8];
#pragma unroll
          for (int q = 0; q < 8; ++q) v[q] = *(const f32x4*)(src + q * 4);
#pragma unroll
          for (int i = 0; i < 32; ++i) yl[(size_t)(row0 + i) * D + 384 + c] = (half_t)v[i >> 2][i & 3]; } }
}

struct EpiOutproj {
    static constexpr bool PERM = true;
    Frame F; int layer;
    __device__ __forceinline__ void operator()(const f32x4 (&acc)[2][2][4][2], const g8::Unit& u, int wr, int wc, int fr, int fq) const {
#pragma unroll
        for (int ai = 0; ai < 2; ++ai)
#pragma unroll
            for (int m = 0; m < 4; ++m) {
                const int srow = u.pm * 256 + ai * 128 + wr * 64 + m * 16 + fr;
                int row = srow;
                if (layer == 1 && srow < TL) { const int b = srow / SEQ, s = srow % SEQ; row = b * SEQ + (s % GROWS) * GW + s / GROWS; }
                const float* g1 = modp(F, layer, row_mod(row), 2);
                const float* xi = F.xrow_in(layer, row); float* xo = F.xrow(row);
#pragma unroll
                for (int bj = 0; bj < 2; ++bj) { const int c0 = u.pn * 256 + bj * 128 + wc * 32 + 8 * fq;
                    const f32x4 x0 = *(const f32x4*)(xi + c0), x1 = *(const f32x4*)(xi + c0 + 4), g0 = *(const f32x4*)(g1 + c0), g1v = *(const f32x4*)(g1 + c0 + 4);
                    *(f32x4*)(xo + c0) = x0 + g0 * acc[ai][bj][m][0]; *(f32x4*)(xo + c0 + 4) = x1 + g1v * acc[ai][bj][m][1]; }
            }
    }
};
__device__ __forceinline__ void outproj_ctx_tiles(const Frame& F, int layer) {
    const half_t* yl = (const half_t*)(F.ws + WS_XN) + (size_t)TL * D;
    const half_t* wt = (const half_t*)(F.ws + WS_WOUT) + (size_t)layer * D * D;
    constexpr int KC = 256, LDT = KC + 8;
    half_t* As = (half_t*)F.smem; half_t* Bs = As + 64 * LDT;
    const int lane = F.lane, wave = F.wave, tid = F.tid;
    const int ntile = (TC / 64) * (D / 64);
    for (int t = blockIdx.x; t < ntile; t += gridDim.x) {
        const int m0 = (t / (D / 64)) * 64, n0 = (t % (D / 64)) * 64;
        const int mt = wave >> 1, nt0 = (wave & 1) * 2;
        f32x4 c[1][2]; zero_acc(c);
        for (int kb = 0; kb < D; kb += KC) {
            half8 ra[4], rb[4];
#pragma unroll
            for (int q = 0; q < 4; ++q) { const int pc = tid + q * NT, row = pc >> 5, kc = (pc & 31) * 8; ra[q] = *(const half8*)(yl + (size_t)(m0 + row) * D + kb + kc); rb[q] = *(const half8*)(wt + (size_t)(n0 + row) * D + kb + kc); }
            __syncthreads();
#pragma unroll
            for (int q = 0; q < 4; ++q) { const int pc = tid + q * NT, row = pc >> 5, kc = (pc & 31) * 8; *(half8*)(As + row * LDT + kc) = ra[q]; *(half8*)(Bs + row * LDT + kc) = rb[q]; }
            __syncthreads();
            mma_lds<1, 2>(c, As + mt * 16 * LDT, LDT, Bs + nt0 * 16 * LDT, LDT, KC / 32, lane);
        }
        const int r = lane & 15;
#pragma unroll
        for (int i = 0; i < 4; ++i) {
            const int row = TL + m0 + mt * 16 + (lane >> 4) * 4 + i;
            const float* g1 = modp(F, layer, NB, 2); const float* xi = F.xrow_in(layer, row); float* xo = F.xrow(row);
            const int ca = n0 + nt0 * 16 + r, cb = ca + 16;
            xo[ca] = xi[ca] + g1[ca] * c[0][0][i]; xo[cb] = xi[cb] + g1[cb] * c[0][1][i];
        }
        __syncthreads();
    }
}
__device__ __forceinline__ void phase_outproj(const Frame& F, int layer) {
    if (layer == 0) outproj_ctx_tiles(F, layer);
    g8::DenseSched S; S.abase = (const char*)(F.ws + WS_XN); S.bbase = (const char*)((const half_t*)(F.ws + WS_WOUT) + (size_t)layer * D * D); S.K = D; S.nM = TL / 256; S.nN = D / 256; S.G = gridDim.x; S.c = blockIdx.x;
    EpiOutproj E{F, layer};
    g8::gemm_phase(F.smem, D, S, E);
}

constexpr int RLD = D + 8;
__device__ __forceinline__ void phase_router(const Frame& F, int layer, bool dry = false) {
    const int nrows = layer == 0 ? TT : TL, total = nrows / 16;
    half_t* Th = (half_t*)F.smem;
    half_t* Tl = Th + 16 * RLD;
    float* PART = (float*)(Tl + 16 * RLD);
    float* LG = PART + 8 * 16 * 48;
    half_t* tb = (half_t*)(F.ws + WS_XN);
    unsigned* cnt = (unsigned*)(F.ws + WS_CTL) + CW_CNT + layer * 64 * CSTR;
    int* list = (int*)(F.ws + WS_LIST); float* pw = (float*)(F.ws + WS_PW);
    const float* nw = F.in(I_N2W) + layer * D;
    const half_t* wr = (const half_t*)(F.ws + WS_WR) + (size_t)layer * 2 * 48 * D;
    const int lane = F.lane, wave = F.wave, r = lane & 15, kq = (lane >> 4) * 8, kb = wave * 128;
    half8 bh[3][4];
#pragma unroll
    for (int nt = 0; nt < 3; ++nt)
#pragma unroll
        for (int ks = 0; ks < 4; ++ks) { const size_t o = (size_t)(nt * 16 + r) * D + kb + ks * 32 + kq; bh[nt][ks] = *(const half8*)(wr + o); }
    int mc = -1; f32x4 g[4], s4[4];
    int it = blockIdx.x;
    f32x4 v[2][4];
    if (it < total) {
#pragma unroll
        for (int rr = 0; rr < 2; ++rr) { const float* x = F.xrow(it * 16 + wave * 2 + rr);
#pragma unroll
            for (int q = 0; q < 4; ++q) v[rr][q] = *(const f32x4*)(x + q * 256 + lane * 4); } }
    int p_row = -1, p_ea = 0, p_eb = 0; unsigned p_pa = 0, p_pb = 0; float p_w0 = 0.f, p_w1 = 0.f;
    for (; it < total; it += gridDim.x) {
        const int row0 = it * 16, nit = it + gridDim.x;
        f32x4 vn[2][4];
        if (nit < total) {
#pragma unroll
            for (int rr = 0; rr < 2; ++rr) { const float* x = F.xrow(nit * 16 + wave * 2 + rr);
#pragma unroll
                for (int q = 0; q < 4; ++q) vn[rr][q] = *(const f32x4*)(x + q * 256 + lane * 4); } }
        { const int m = row_mod(row0);
          if (m != mc) { mc = m; const float* sh = modp(F, layer, m, 3); const float* scl = modp(F, layer, m, 4);
#pragma unroll
              for (int q = 0; q < 4; ++q) { const int k = q * 256 + lane * 4; const f32x4 a = *(const f32x4*)(nw + k), b = *(const f32x4*)(scl + k); s4[q] = *(const f32x4*)(sh + k);
#pragma unroll
                  for (int e = 0; e < 4; ++e) g[q][e] = a[e] * (1.0f + b[e]); } } }
#pragma unroll
        for (int rr = 0; rr < 2; ++rr) {
            float ss = 0.f;
#pragma unroll
            for (int q = 0; q < 4; ++q) ss += v[rr][q][0] * v[rr][q][0] + v[rr][q][1] * v[rr][q][1] + v[rr][q][2] * v[rr][q][2] + v[rr][q][3] * v[rr][q][3];
            ss = wave_sum(ss);
            const float rs = 1.0f / sqrtf(ss * (1.0f / D) + EPSF);
            const int lr = wave * 2 + rr, row = row0 + lr;
#pragma unroll
            for (int q = 0; q < 4; ++q) { const int k = q * 256 + lane * 4; half4 h, l;
#pragma unroll
                for (int e = 0; e < 4; ++e) { const float tv = v[rr][q][e] * rs * g[q][e] + s4[q][e]; h[e] = (half_t)tv; l[e] = (half_t)((tv - (float)h[e]) * 2048.f); }
                *(half4*)(tb + (size_t)row * D + k) = h; *(half4*)(Th + lr * RLD + k) = h; *(half4*)(Tl + lr * RLD + k) = l; }
        }
        __syncthreads();
        { f32x4 ah[3], al[3]; half8 bl[3][4];
#pragma unroll
          for (int nt = 0; nt < 3; ++nt)
#pragma unroll
              for (int ks = 0; ks < 4; ++ks) bl[nt][ks] = *(const half8*)(wr + (size_t)48 * D + (size_t)(nt * 16 + r) * D + kb + ks * 32 + kq);
#pragma unroll
          for (int nt = 0; nt < 3; ++nt) { ah[nt] = (f32x4){0.f, 0.f, 0.f, 0.f}; al[nt] = (f32x4){0.f, 0.f, 0.f, 0.f}; }
#pragma unroll
          for (int ks = 0; ks < 4; ++ks) {
              const half8 a_h = *(const half8*)(Th + r * RLD + kb + ks * 32 + kq), a_l = *(const half8*)(Tl + r * RLD + kb + ks * 32 + kq);
#pragma unroll
              for (int nt = 0; nt < 3; ++nt) { ah[nt] = mfma16(a_h, bh[nt][ks], ah[nt]); al[nt] = mfma16(a_l, bh[nt][ks], al[nt]); al[nt] = mfma16(a_h, bl[nt][ks], al[nt]); }
          }
#pragma unroll
          for (int nt = 0; nt < 3; ++nt)
#pragma unroll
              for (int i = 0; i < 4; ++i) PART[(wave * 16 + (lane >> 4) * 4 + i) * 48 + nt * 16 + r] = ah[nt][i] + al[nt][i] * (1.0f / 2048.f); }
        __syncthreads();
        for (int o = F.tid; o < 16 * 48; o += NT) { const int col = o % 48; float sum = 0.f;
#pragma unroll
            for (int w = 0; w < 8; ++w) sum += PART[w * 16 * 48 + o];
            float bias = 0.f; if (col < 4) bias = F.in(I_GRB)[layer * 4 + col]; else if (col < 36) bias = F.in(I_ERB)[layer * 32 + col - 4];
            LG[o] = sum + bias; }
        __syncthreads();
        if (F.tid < 16) {
            if (p_row >= 0 && !dry) { list[(size_t)(p_ea * 2 + 0) * LCAP + p_pa] = p_row * 2 + 0; list[(size_t)(p_eb * 2 + 1) * LCAP + p_pb] = p_row * 2 + 1; pw[p_row * 2 + 0] = p_w0; pw[p_row * 2 + 1] = p_w1; }
            const int row = row0 + F.tid; const float* lg = LG + F.tid * 48;
            int gi = 0; float gm = lg[0];
            for (int q = 1; q < 4; ++q) if (lg[q] > gm) { gm = lg[q]; gi = q; }
            float gs = 0.f; for (int q = 0; q < 4; ++q) gs += expf(lg[q] - gm);
            const float grp_p = 1.0f / gs;
            const float* el = lg + 4 + gi * 8;
            int i0 = 0; float e0 = el[0];
            for (int q = 1; q < 8; ++q) if (el[q] > e0) { e0 = el[q]; i0 = q; }
            int i1 = -1; float e1 = -3.0e38f;
            for (int q = 0; q < 8; ++q) if (q != i0 && el[q] > e1) { e1 = el[q]; i1 = q; }
            const float p1 = expf(e1 - e0);
            p_w0 = grp_p * (1.0f / (1.0f + p1)); p_w1 = grp_p * (p1 / (1.0f + p1));
            p_ea = gi * 8 + i0; p_eb = gi * 8 + i1; p_row = row;
            if (!dry) { p_pa = atomicAdd(&cnt[(p_ea * 2 + 0) * CSTR], 1u); p_pb = atomicAdd(&cnt[(p_eb * 2 + 1) * CSTR], 1u); }
        }
#pragma unroll
        for (int rr = 0; rr < 2; ++rr)
#pragma unroll
            for (int q = 0; q < 4; ++q) v[rr][q] = vn[rr][q];
    }
    if (F.tid < 16 && p_row >= 0 && !dry) { list[(size_t)(p_ea * 2 + 0) * LCAP + p_pa] = p_row * 2 + 0; list[(size_t)(p_eb * 2 + 1) * LCAP + p_pb] = p_row * 2 + 1; pw[p_row * 2 + 0] = p_w0; pw[p_row * 2 + 1] = p_w1; }
    __syncthreads();
}

constexpr int MOE_PRE_OFF = g8::STAGE_BYTES;
struct MoeSchedA {
    const char* abase; const char* wbase; const int* pre; const unsigned* cnt; const int* list; int G, c;
    __device__ __forceinline__ int entry(const g8::Unit& u, int r) const { const int rc = r < u.n ? r : 0; return rc < u.c0 ? list[(size_t)(u.e * 2) * LCAP + rc] : list[(size_t)(u.e * 2 + 1) * LCAP + (rc - u.c0)]; }
    __device__ __forceinline__ bool next(int i, g8::Unit& u) const {
        const int L = i * G + c; if (L >= pre[32]) return false;
        int e = 0; while (L >= pre[e + 1]) ++e;
        const int loc = L - pre[e]; u.e = e; u.c0 = (int)cnt[(e * 2) * CSTR]; u.n = u.c0 + (int)cnt[(e * 2 + 1) * CSTR]; u.pm = loc >> 1; u.pn = loc & 1; return true;
    }
    __device__ __forceinline__ unsigned a_off(const g8::Unit& u, int r) const { return (unsigned)(entry(u, u.pm * 256 + r) >> 1) * (unsigned)(D * 2); }
    __device__ __forceinline__ const char* b_half(const g8::Unit& u, int h) const { return wbase + ((size_t)u.e * 3 * 262144 + (size_t)h * 262144 + (size_t)u.pn * 128 * D) * 2; }
};
struct EpiMoeA {
    static constexpr bool PERM = true;
    MoeSchedA S; const float* pw; half_t* hid;
    __device__ __forceinline__ void operator()(const f32x4 (&acc)[2][2][4][2], const g8::Unit& u, int wr, int wc, int fr, int fq) const {
        int pid[8]; float w[8];
#pragma unroll
        for (int g = 0; g < 8; ++g) pid[g] = S.entry(u, u.pm * 256 + (g >> 2) * 128 + wr * 64 + (g & 3) * 16 + fr);
#pragma unroll
        for (int g = 0; g < 8; ++g) w[g] = pw[pid[g]];
        const int f = u.pn * 128 + wc * 32 + 8 * fq;
#pragma unroll
        for (int ai = 0; ai < 2; ++ai)
#pragma unroll
            for (int m = 0; m < 4; ++m) {
                const int rr = u.pm * 256 + ai * 128 + wr * 64 + m * 16 + fr;
                if (rr < u.n) { half8 h;
#pragma unroll
                    for (int n = 0; n < 2; ++n) { const f32x4 g = acc[ai][0][m][n], up = acc[ai][1][m][n];
#pragma unroll
                        for (int i = 0; i < 4; ++i) h[n * 4 + i] = (half_t)(fsilu(g[i]) * up[i] * w[ai * 4 + m]); }
                    *(half8*)(hid + (size_t)pid[ai * 4 + m] * 256 + f) = h; }
            }
    }
};
__device__ __forceinline__ void phase_moe_a(const Frame& F, int layer) {
    int* pre = (int*)(F.smem + MOE_PRE_OFF);
    const unsigned* cnt = (const unsigned*)(F.ws + WS_CTL) + CW_CNT + layer * 64 * CSTR;
    if (F.tid == 0) { int s = 0; for (int e = 0; e < 32; ++e) { pre[e] = s; s += (((int)(cnt[(e * 2) * CSTR] + cnt[(e * 2 + 1) * CSTR]) + 255) / 256) * 2; } pre[32] = s; }
    __syncthreads();
    MoeSchedA S; S.abase = (const char*)(F.ws + WS_XN); S.wbase = (const char*)(F.ws + WS_WMOE); S.pre = pre; S.cnt = cnt; S.list = (const int*)(F.ws + WS_LIST); S.G = gridDim.x; S.c = blockIdx.x;
    EpiMoeA E{S, (const float*)(F.ws + WS_PW), (half_t*)(F.ws + WS_U16)};
    g8::gemm_phase(F.smem, D, S, E);
    __syncthreads();
}
struct MoeSchedB {
    const char* abase; const char* wbase; const int* pre; const unsigned* cnt; const int* list; int G, c;
    __device__ __forceinline__ bool next(int i, g8::Unit& u) const {
        const int L = i * G + c; if (L >= pre[64]) return false;
        int l = 0; while (L >= pre[l + 1]) ++l;
        const int loc = L - pre[l]; u.e = l >> 1; u.c0 = l & 1; u.n = (int)cnt[(l) * CSTR]; u.pm = loc >> 2; u.pn = loc & 3; return true;
    }
    __device__ __forceinline__ int entry(const g8::Unit& u, int rr) const { return list[(size_t)(u.e * 2 + u.c0) * LCAP + (rr < u.n ? rr : 0)]; }
    __device__ __forceinline__ unsigned a_off(const g8::Unit& u, int r) const { return (unsigned)entry(u, u.pm * 256 + r) * 512u; }
    __device__ __forceinline__ const char* b_half(const g8::Unit& u, int h) const { return wbase + ((size_t)u.e * 3 * 262144 + 2 * 262144 + (size_t)(u.pn * 256 + h * 128) * 256) * 2; }
};
struct EpiMoeB {
    static constexpr bool PERM = true;
    MoeSchedB S; Frame F; int layer;
    __device__ __forceinline__ void operator()(const f32x4 (&acc)[2][2][4][2], const g8::Unit& u, int wr, int wc, int fr, int fq) const {
        int row[8];
#pragma unroll
        for (int g = 0; g < 8; ++g) row[g] = S.entry(u, u.pm * 256 + (g >> 2) * 128 + wr * 64 + (g & 3) * 16 + fr) >> 1;
        half_t* xab = (half_t*)(F.ws + WS_U16 + XAB_OFF) + (size_t)u.c0 * TT * D;
#pragma unroll
        for (int ai = 0; ai < 2; ++ai)
#pragma unroll
            for (int m = 0; m < 4; ++m) {
                const int rr = u.pm * 256 + ai * 128 + wr * 64 + m * 16 + fr;
                if (rr < u.n) { const int rw = row[ai * 4 + m]; half_t* xo = xab + (size_t)rw * D;
#pragma unroll
                    for (int bj = 0; bj < 2; ++bj) { const int d = u.pn * 256 + bj * 128 + wc * 32 + 8 * fq;
                        const f32x4 a0 = acc[ai][bj][m][0], a1 = acc[ai][bj][m][1];
                        half8 h; h[0] = (half_t)a0[0]; h[1] = (half_t)a0[1]; h[2] = (half_t)a0[2]; h[3] = (half_t)a0[3]; h[4] = (half_t)a1[0]; h[5] = (half_t)a1[1]; h[6] = (half_t)a1[2]; h[7] = (half_t)a1[3];
                        *(half8*)(xo + d) = h; } }
            }
    }
};
__device__ __forceinline__ void phase_moe_b(const Frame& F, int layer) {
    int* pre = (int*)(F.smem + MOE_PRE_OFF);
    const unsigned* cnt = (const unsigned*)(F.ws + WS_CTL) + CW_CNT + layer * 64 * CSTR;
    if (F.tid == 0) { int s = 0; for (int l = 0; l < 64; ++l) { pre[l] = s; s += (((int)cnt[(l) * CSTR] + 255) / 256) * 4; } pre[64] = s; }
    __syncthreads();
    MoeSchedB S; S.abase = (const char*)(F.ws + WS_U16); S.wbase = (const char*)(F.ws + WS_WMOE); S.pre = pre; S.cnt = cnt; S.list = (const int*)(F.ws + WS_LIST); S.G = gridDim.x; S.c = blockIdx.x;
    EpiMoeB E{S, F, layer};
    g8::gemm_phase(F.smem, 256, S, E);
    __syncthreads();
}

__device__ __forceinline__ void phase_final(const Frame& F) {
    const float* fw = F.in(I_FNW);
    const int lane = F.lane, nwaves = gridDim.x * (NT / 64);
    f32x4 w4[4];
#pragma unroll
    for (int q = 0; q < 4; ++q) w4[q] = *(const f32x4*)(fw + q * 256 + lane * 4);
    int row = blockIdx.x * (NT / 64) + F.wave;
    f32x4 v[4];
    if (row < TL) {
#pragma unroll
        for (int q = 0; q < 4; ++q) v[q] = *(const f32x4*)(F.P->out + (size_t)row * D + q * 256 + lane * 4); }
    for (; row < TL; row += nwaves) {
        const int nrow = row + nwaves;
        f32x4 vn[4];
        if (nrow < TL) {
#pragma unroll
            for (int q = 0; q < 4; ++q) vn[q] = *(const f32x4*)(F.P->out + (size_t)nrow * D + q * 256 + lane * 4); }
        { const half_t* xa = (const half_t*)(F.ws + WS_U16 + XAB_OFF) + (size_t)row * D; const half_t* xb = xa + (size_t)TT * D;
          const float* g5 = modp(F, 1, row_mod(row), 5);
#pragma unroll
          for (int q = 0; q < 4; ++q) { const int k = q * 256 + lane * 4; const half4 a4 = *(const half4*)(xa + k), b4 = *(const half4*)(xb + k); const f32x4 gv = *(const f32x4*)(g5 + k);
#pragma unroll
              for (int e = 0; e < 4; ++e) v[q][e] += gv[e] * ((float)a4[e] + (float)b4[e]); } }
        float ss = 0.f;
#pragma unroll
        for (int q = 0; q < 4; ++q) ss += v[q][0] * v[q][0] + v[q][1] * v[q][1] + v[q][2] * v[q][2] + v[q][3] * v[q][3];
        ss = wave_sum(ss);
        const float rs = 1.0f / sqrtf(ss * (1.0f / D) + EPSF);
#pragma unroll
        for (int q = 0; q < 4; ++q) *(f32x4*)(F.P->out + (size_t)row * D + q * 256 + lane * 4) = v[q] * rs * w4[q];
#pragma unroll
        for (int q = 0; q < 4; ++q) v[q] = vn[q];
    }
}

constexpr int NPHASE = 1 + 2 * 9 + 1;
#ifndef ONLY
#define ONLY -1
#endif
#define EN(x) (ONLY < 0 || ONLY == (x))
__device__ __forceinline__ void run_phase(const Frame& F, int ph) {
    if (ph == 0) { if (EN(0)) phase_setup(F); return; }
    if (ph == NPHASE - 1) { if (EN(11)) phase_final(F); return; }
    const int layer = (ph - 1) / 9, k = (ph - 1) % 9;
    switch (k) {
        case 0: if (EN(1)) phase_norm1(F, layer); break;
        case 1: if (EN(2)) phase_inproj(F, layer); break;
        case 2: if (EN(10)) phase_act(F, layer); break;
        case 3: if (EN(3)) phase_mixers(F, layer); break;
        case 4: if (EN(4)) phase_combine(F, layer); break;
        case 5: if (EN(5)) phase_outproj(F, layer); break;
        case 6: if (EN(6)) phase_router(F, layer); break;
        case 7: if (EN(7)) phase_moe_a(F, layer); break;
        default: if (EN(8)) phase_moe_b(F, layer); break;
    }
}

#ifdef EMU
void mega(const Params* Pp) {
    Frame F; F.P = Pp; F.ws = Pp->ws; F.smem = emu_blk->smem; F.tid = threadIdx.x; F.lane = F.tid & 63; F.wave = F.tid >> 6;
    for (int ph = Pp->ph_lo; ph < Pp->ph_hi; ++ph) { run_phase(F, ph); __syncthreads(); }
}
#else
__global__ void __launch_bounds__(NT) mega(Params P) {
    extern __shared__ __attribute__((aligned(16))) unsigned char smem_dyn[];
    cg::grid_group grid = cg::this_grid();
    Frame F; F.P = (ParamsPtr)__builtin_amdgcn_kernarg_segment_ptr(); F.ws = P.ws; F.smem = smem_dyn; F.tid = threadIdx.x; F.lane = F.tid & 63; F.wave = F.tid >> 6;
    volatile LAS unsigned* bst = (volatile LAS unsigned*)(smem_dyn + LDS_BYTES - 16);
    if (F.tid < 4) bst[F.tid] = 0u;
    __syncthreads();
    XcdBarrier xb = xcd_barrier_post((unsigned*)(P.ws + WS_CTL) + CW_BAR, bst);
    if (P.ph_lo < 0) grid.sync();
#define DUP -1
#define AMP -1
#define PHASE_STEP(i) if (P.ph_lo <= (i) && (i) < P.ph_hi) { \
        unsigned long long t0_ = 0; if (AMP == (i)) t0_ = __builtin_amdgcn_s_memrealtime(); \
        run_phase(F, (i)); \
        if ((i) + 1 < P.ph_hi || AMP == (i)) xcd_barrier(xb); \
        if (AMP == (i)) { const unsigned long long t1_ = __builtin_amdgcn_s_memrealtime(); if (blockIdx.x == 0) { while (__builtin_amdgcn_s_memrealtime() - t1_ < t1_ - t0_) __builtin_amdgcn_s_sleep(8); } xcd_barrier(xb); } }
    PHASE_STEP(0) PHASE_STEP(1) PHASE_STEP(2) PHASE_STEP(3) PHASE_STEP(4) PHASE_STEP(5) PHASE_STEP(6) PHASE_STEP(7) PHASE_STEP(8) PHASE_STEP(9)
    PHASE_STEP(10) PHASE_STEP(11) PHASE_STEP(12) PHASE_STEP(13) PHASE_STEP(14) PHASE_STEP(15) PHASE_STEP(16) PHASE_STEP(17) PHASE_STEP(18) PHASE_STEP(19)
    static_assert(NPHASE == 20, "phase list");
}

extern "C" void kernel_launch(void* const* d_in, const int* in_sizes, int n_in, void* d_out, int out_size, void* d_ws, size_t ws_size, hipStream_t stream) {
    static int grid_blocks = 0;
    if (grid_blocks == 0) {
        if (n_in != 38 || out_size != TL * D || ws_size < WS_END) { fprintf(stderr, "kernel_launch: unexpected shapes (n_in %d out %d ws %zu need %zu)\n", n_in, out_size, ws_size, (size_t)WS_END); grid_blocks = -1; return; }
        int dev = 0, cus = 0, per_cu = 0;
        hipGetDevice(&dev);
        hipDeviceGetAttribute(&cus, hipDeviceAttributeMultiprocessorCount, dev);
        hipFuncSetAttribute((const void*)mega, hipFuncAttributeMaxDynamicSharedMemorySize, LDS_BYTES);
        hipOccupancyMaxActiveBlocksPerMultiprocessor(&per_cu, (const void*)mega, NT, LDS_BYTES);
        if (per_cu < 1) { fprintf(stderr, "kernel_launch: occupancy query says 0 blocks per CU\n"); grid_blocks = -1; return; }
        grid_blocks = cus;
    }
    if (grid_blocks < 0) return;
    if (hipMemsetAsync((char*)d_ws + WS_CTL, 0, CTL_BYTES, stream) != hipSuccess) { fprintf(stderr, "kernel_launch: memset failed\n"); return; }
    Params p{};
    for (int i = 0; i < 38; ++i) p.in[i] = (const float*)d_in[i];
    p.out = (float*)d_out; p.ws = (unsigned char*)d_ws; p.ph_lo = 0; p.ph_hi = NPHASE;
    void* args[] = {&p};
    hipError_t e = hipLaunchCooperativeKernel((const void*)mega, dim3(grid_blocks), dim3(NT), args, LDS_BYTES, stream);
    if (e != hipSuccess) fprintf(stderr, "cooperative launch failed: %s (grid %d)\n", hipGetErrorString(e), grid_blocks);
}
#endif
```

```cpp
#ifdef EMU
#include "gpuemu.h"
#else
#include <hip/hip_runtime.h>
#include <hip/hip_cooperative_groups.h>
#include <cstdio>
namespace cg = cooperative_groups;
#endif
#include <stdint.h>

#ifndef CFG_B
#define CFG_B 4
#endif
#ifndef CFG_SEQ
#define CFG_SEQ 4096
#endif
#ifndef CFG_CTX
#define CFG_CTX 256
#endif

typedef _Float16 half_t;
typedef _Float16 half8 __attribute__((ext_vector_type(8)));
typedef _Float16 half4 __attribute__((ext_vector_type(4)));
typedef float f32x4 __attribute__((ext_vector_type(4)));
struct cplx { float x, y; };

constexpr int D = 1024, NB = CFG_B, SEQ = CFG_SEQ, CTXL = CFG_CTX, GW = 64, GROWS = SEQ / GW;
constexpr int TL = NB * SEQ, TC = NB * CTXL, TT = TL + TC;
constexpr int NIN = 3364, NINP = 3584;
constexpr int UW = 2560;
constexpr int UGW = 36;
constexpr int NT = 512;
constexpr int TWN = 2 * SEQ > 2 * CTXL ? 2 * SEQ : 2 * CTXL;
constexpr int NMOD = 6 * D;
constexpr int LCAP = TT;
constexpr float EPSF = 1e-6f;

constexpr size_t al256(size_t x) { return (x + 255) / 256 * 256; }
constexpr size_t WS_CTL    = 0;
constexpr size_t WS_MOD    = 65536;
constexpr size_t WS_TW     = WS_MOD + al256(sizeof(float) * 2 * 5 * NMOD);
constexpr size_t WS_WIN    = WS_TW + al256(sizeof(cplx) * TWN);
constexpr size_t WS_WOUT   = WS_WIN + al256(2ull * 2 * NINP * D);
constexpr size_t WS_WMOE   = WS_WOUT + al256(2ull * 2 * D * D);
constexpr size_t WS_XC     = WS_WMOE + al256(2ull * 32 * 3 * 262144);
constexpr size_t WS_XN     = WS_XC + al256(4ull * TC * D);
constexpr size_t WS_U16    = WS_XN + al256(2ull * TT * D);
constexpr size_t WS_UG     = WS_U16 + al256(2ull * TT * UW);
constexpr size_t WS_HYT    = WS_UG + al256(4ull * TT * UGW);
constexpr size_t WS_YF     = WS_HYT + al256(2ull * NB * 768 * (SEQ + CTXL));
constexpr size_t WS_YHT    = WS_YF + al256(2ull * 4 * TT * 384);
constexpr size_t WS_FT     = WS_YHT + al256(4ull * NB * 256 * (SEQ + CTXL));
constexpr size_t WS_LIST   = WS_FT + al256(4ull * (2 * 256 * 4 * SEQ + 256 * 4 * CTXL));
constexpr size_t WS_PW     = WS_LIST + al256(4ull * 64 * LCAP);
constexpr size_t WS_WR     = WS_PW + al256(4ull * TT * 2);
constexpr size_t WS_HALO   = WS_WR + al256(2ull * 2 * 2 * 48 * D);
constexpr size_t WS_END    = WS_HALO + al256(2ull * (TT / 16) * 2 * 1408);
static_assert(4ull * NB * 256 * (SEQ + CTXL) <= 2ull * TT * D, "Z1 scratch must fit in the XN region");
static_assert(2ull * TT * 2 * 256 <= 2ull * TT * UW, "HID must fit in the U16 region");
constexpr size_t XAB_OFF = 2ull * TT * 2 * 256;
static_assert(XAB_OFF + 2ull * 2 * TT * D <= 2ull * TT * UW, "HID + XA + XB must fit in the U16 region");

constexpr int CW_CNT = 8192;
constexpr int CSTR = 64;
constexpr int CW_QUE = 256;
constexpr int CW_BAR = 1024;
constexpr size_t CTL_BYTES = 65536;

constexpr int LDS_BYTES = 156 * 1024;

struct Params {
    const float* in[38];
    float* out;
    unsigned char* ws;
    int ph_lo, ph_hi;
};

enum { I_X = 0, I_C, I_CTX, I_CCTX, I_WMOD, I_BMOD, I_N1W, I_N2W, I_WIN, I_WOUT, I_SCW, I_SCB, I_DTB, I_ALOG, I_SD, I_SNW,
       I_HCW, I_HCB, I_HW1, I_HB1, I_HW2, I_HB2, I_HW3, I_HFREQ, I_HDEC, I_HSKIP, I_MCW, I_MCB, I_MGB, I_MNW,
       I_GRW, I_GRB, I_ERW, I_ERB, I_MG, I_MU, I_MD, I_FNW };

__device__ __forceinline__ float siluf(float x) { return x / (1.0f + expf(-x)); }
__device__ __forceinline__ float sigmoidf_(float x) { return 1.0f / (1.0f + expf(-x)); }
__device__ __forceinline__ float softplusf_(float x) { return x > 20.f ? x : log1pf(expf(x)); }
__device__ __forceinline__ float logsigmoidf_(float x) { return fminf(x, 0.f) - log1pf(expf(-fabsf(x))); }

__device__ __forceinline__ float fsoftplus(float x) {
#ifdef EMU
    return x > 20.f ? x : log1pf(expf(x));
#else
    const float e = __expf(x);
    return x > 20.f ? x : (e < 1e-3f ? e * (1.0f - 0.5f * e) : __logf(1.0f + e));
#endif
}
__device__ __forceinline__ float flogsigmoid(float x) { return fminf(x, 0.f) - fsoftplus(-fabsf(x)); }
__device__ __forceinline__ float fexp(float x) {
#ifdef EMU
    return expf(x);
#else
    return __expf(x);
#endif
}
__device__ __forceinline__ float fsilu(float x) {
#ifdef EMU
    return x / (1.0f + expf(-x));
#else
    return __fdividef(x, 1.0f + __expf(-x));
#endif
}
__device__ __forceinline__ float wave_sum(float v) {
#pragma unroll
    for (int m = 32; m >= 1; m >>= 1) v += __shfl_xor(v, m);
    return v;
}
__device__ __forceinline__ float wave_max(float v) {
#pragma unroll
    for (int m = 32; m >= 1; m >>= 1) v = fmaxf(v, __shfl_xor(v, m));
    return v;
}
#ifndef EMU
#define DPP_F(oldv, v, ctrl, rmask) __builtin_bit_cast(float, __builtin_amdgcn_update_dpp(__builtin_bit_cast(int, (float)(oldv)), __builtin_bit_cast(int, (float)(v)), (ctrl), (rmask), 0xF, false))
#endif
__device__ __forceinline__ float wave_scan_sum(float v, int lane) {
#ifdef EMU
    for (int d = 1; d < 64; d <<= 1) { float o = __shfl_up(v, d); if (lane >= d) v += o; }
    return v;
#else
    v += DPP_F(0.f, v, 0x111, 0xF);
    v += DPP_F(0.f, v, 0x112, 0xF);
    v += DPP_F(0.f, v, 0x114, 0xF);
    v += DPP_F(0.f, v, 0x118, 0xF);
    v += DPP_F(0.f, v, 0x142, 0xA);
    v += DPP_F(0.f, v, 0x143, 0xC);
    return v;
#endif
}
__device__ __forceinline__ float wave_last(float v) {
#ifdef EMU
    return __shfl(v, 63);
#else
    return __builtin_bit_cast(float, __builtin_amdgcn_readlane(__builtin_bit_cast(int, v), 63));
#endif
}
__device__ __forceinline__ float wave_shr1(float v, float fill, int lane) {
#ifdef EMU
    float o = __shfl_up(v, 1); return lane == 0 ? fill : o;
#else
    return DPP_F(fill, v, 0x138, 0xF);
#endif
}
__device__ __forceinline__ float wave_scan_max(float v, int lane) {
#ifdef EMU
    for (int d = 1; d < 64; d <<= 1) { float o = __shfl_up(v, d); if (lane >= d) v = fmaxf(v, o); }
    return v;
#else
    const float NI = -3.0e38f;
    v = fmaxf(v, DPP_F(NI, v, 0x111, 0xF));
    v = fmaxf(v, DPP_F(NI, v, 0x112, 0xF));
    v = fmaxf(v, DPP_F(NI, v, 0x114, 0xF));
    v = fmaxf(v, DPP_F(NI, v, 0x118, 0xF));
    v = fmaxf(v, DPP_F(NI, v, 0x142, 0xA));
    v = fmaxf(v, DPP_F(NI, v, 0x143, 0xC));
    return v;
#endif
}

template <int MT, int NTL>
__device__ __forceinline__ void mma_lds(f32x4 (&acc)[MT][NTL], const half_t* A, int lda, const half_t* B, int ldb, int ksteps, int lane) {
#ifndef EMU
    const int r = lane & 15, kq = (lane >> 4) * 8;
    for (int ks = 0; ks < ksteps; ++ks) {
        half8 a[MT], b[NTL];
#pragma unroll
        for (int mt = 0; mt < MT; ++mt) a[mt] = *(const half8*)(A + (mt * 16 + r) * lda + ks * 32 + kq);
#pragma unroll
        for (int nt = 0; nt < NTL; ++nt) b[nt] = *(const half8*)(B + (nt * 16 + r) * ldb + ks * 32 + kq);
#pragma unroll
        for (int mt = 0; mt < MT; ++mt)
#pragma unroll
            for (int nt = 0; nt < NTL; ++nt) acc[mt][nt] = __builtin_amdgcn_mfma_f32_16x16x32_f16(a[mt], b[nt], acc[mt][nt], 0, 0, 0);
    }
#else
    for (int mt = 0; mt < MT; ++mt) for (int nt = 0; nt < NTL; ++nt) for (int i = 0; i < 4; ++i) {
        const int row = mt * 16 + (lane >> 4) * 4 + i, col = nt * 16 + (lane & 15);
        float s = acc[mt][nt][i];
        for (int k = 0; k < ksteps * 32; ++k) s += (float)A[row * lda + k] * (float)B[col * ldb + k];
        acc[mt][nt][i] = s;
    }
#endif
}

__device__ __forceinline__ f32x4 mfma16(half8 a, half8 b, f32x4 c) {
#ifdef EMU
    return emu_mfma16(a, b, c);
#else
    return __builtin_amdgcn_mfma_f32_16x16x32_f16(a, b, c, 0, 0, 0);
#endif
}
template <int MT, int NTL> __device__ __forceinline__ void zero_acc(f32x4 (&acc)[MT][NTL]) {
#pragma unroll
    for (int mt = 0; mt < MT; ++mt)
#pragma unroll
        for (int nt = 0; nt < NTL; ++nt) acc[mt][nt] = (f32x4){0.f, 0.f, 0.f, 0.f};
}

__device__ __forceinline__ void load_taps4(const float* cw, const float* cb, int C, int ch, int dir, f32x4& w0, f32x4& w1, f32x4& w2, f32x4& wb) {
    w0 = *(const f32x4*)(cw + (dir ? 2 : 0) * C + ch); w1 = *(const f32x4*)(cw + C + ch); w2 = *(const f32x4*)(cw + (dir ? 0 : 2) * C + ch); wb = *(const f32x4*)(cb + ch);
}
#ifdef EMU
#define LOADER_FENCE()
#else
#define LOADER_FENCE() asm volatile("" ::: "memory")
#endif
#define CONV4(k, i) (w0[i] * (float)rr[k][hh * 4 + i] + w1[i] * (float)rr[(k) + 1][hh * 4 + i] + w2[i] * (float)rr[(k) + 2][hh * 4 + i] + wb[i])
__device__ __forceinline__ half4 to_half4(const f32x4 v) { half4 h; h[0] = (half_t)v[0]; h[1] = (half_t)v[1]; h[2] = (half_t)v[2]; h[3] = (half_t)v[3]; return h; }
namespace g8 {
constexpr int BM = 256, BK = 64, HALF = 128, HTB = HALF * BK * 2, STAGE_BYTES = 8 * HTB;
__device__ __forceinline__ int lds_byte(int r, int c) { const int st = (r >> 4) * 2 + (c >> 5), rr = r & 15, cc = c & 31, ob = rr * 64 + cc * 2; return st * 1024 + (ob ^ (((ob >> 9) & 1) << 5)); }
__device__ __forceinline__ int perm32(int rho) { const int n = rho >> 4, i = rho & 15; return 8 * (i >> 2) + 4 * n + (i & 3); }
__device__ __forceinline__ void stage_rc(int b, int& R, int& C) { const int st = b / 1024, sb = b % 1024, swz = sb ^ (((sb >> 9) & 1) << 5); R = (st >> 1) * 16 + swz / 64; C = (st & 1) * 32 + (swz % 64) / 2; }
struct Unit { int pm, pn, e, n, c0; };

struct DenseSched {
    const char* abase; const char* bbase; int K, nM, nN, G, c;
    __device__ __forceinline__ bool next(int i, Unit& u) const {
        const int nwg = nM * nN; const long L = (long)i * G + c; if (L >= nwg) return false;
        int wgid = (int)L; { const int q = nwg / 8, r = nwg % 8, xcd = wgid % 8, off = wgid / 8; wgid = (xcd < r ? xcd * (q + 1) : r * (q + 1) + (xcd - r) * q) + off; }
        const int nig = 8 * nN, gid = wgid / nig, fm = gid * 8, gsz = (nM - fm) < 8 ? (nM - fm) : 8;
        u.pm = fm + ((wgid % nig) % gsz); u.pn = (wgid % nig) / gsz; u.e = 0; u.n = 0; u.c0 = 0; return true;
    }
    __device__ __forceinline__ unsigned a_off(const Unit& u, int r) const { return (unsigned)((size_t)(u.pm * 256 + r) * K * 2); }
    __device__ __forceinline__ const char* b_half(const Unit& u, int h) const { return bbase + (size_t)(u.pn * 256 + h * 128) * K * 2; }
};

template <class Epi, class Sched>
__device__ __forceinline__ void gemm_phase(unsigned char* smem, const int K, const Sched& S, const Epi& E) {
    const int tid = threadIdx.x, lane = tid & 63;
#ifdef EMU
    const int wid = tid >> 6, wr = wid >> 2, wc = wid & 3, fr = lane & 15, fq = lane >> 4;
    half_t* As = (half_t*)smem; half_t* Bs = As + 256 * 72;
    Unit cur;
    for (int ui = 0; S.next(ui, cur); ++ui) {
        f32x4 acc[2][2][4][2];
        for (int a = 0; a < 2; ++a) for (int b = 0; b < 2; ++b) for (int m = 0; m < 4; ++m) for (int n = 0; n < 2; ++n) acc[a][b][m][n] = (f32x4){0.f, 0.f, 0.f, 0.f};
        for (int kt = 0; kt < K / 64; ++kt) {
            { const int row = tid >> 1, c0 = (tid & 1) * 32;
              const half_t* sa = (const half_t*)(S.abase + S.a_off(cur, row)) + kt * 64 + c0;
              const half_t* sb = (const half_t*)(S.b_half(cur, row >> 7)) + (size_t)(row & 127) * K + kt * 64 + c0;
              for (int q = 0; q < 32; ++q) { As[row * 72 + c0 + q] = sa[q]; Bs[row * 72 + c0 + q] = sb[q]; } }
            __syncthreads();
            for (int a = 0; a < 2; ++a) for (int b = 0; b < 2; ++b) for (int m = 0; m < 4; ++m) for (int n = 0; n < 2; ++n) for (int i = 0; i < 4; ++i) {
                const int row = 128 * a + 64 * wr + 16 * m + fr, col = 128 * b + 32 * wc + (Epi::PERM ? 8 * fq + 4 * n + i : 16 * n + 4 * fq + i); float s = acc[a][b][m][n][i];
                for (int k = 0; k < 64; ++k) s += (float)As[row * 72 + k] * (float)Bs[col * 72 + k];
                acc[a][b][m][n][i] = s; }
            __syncthreads();
        }
        E(acc, cur, wr, wc, fr, fq);
    }
#else
    typedef __attribute__((address_space(3))) unsigned char* ldsp_t;
    const ldsp_t lds = (ldsp_t)smem;
    const int wid = __builtin_amdgcn_readfirstlane(tid >> 6), wr = wid >> 2, wc = wid & 3, fr = lane & 15, fq = lane >> 4;
    const int nt = K / BK;
    int Rr[2], Cc[2]; unsigned voffB[2];
#pragma unroll
    for (int i = 0; i < 2; ++i) { stage_rc(tid * 16 + i * 8192, Rr[i], Cc[i]); const int Rb = Epi::PERM ? ((Rr[i] & ~31) + perm32(Rr[i] & 31)) : Rr[i]; voffB[i] = (unsigned)(Rb * K + Cc[i]) * 2u; }
    const size_t kstep = (size_t)(BK * 2);
    const unsigned ldsw = (unsigned)wid * 1024u;
    const int aoffl = lds_byte(wr * 64 + fr, fq * 8), boffl = lds_byte(wc * 32 + fr, fq * 8);
#define G8_SA(b, h) (((b) * 2 + (h)) * HTB)
#define G8_SB(b, h) ((4 + (b) * 2 + (h)) * HTB)
#define G8_STAGE(bufoff, gbase, voff) do { _Pragma("unroll") for (int _i = 0; _i < 2; ++_i) \
        __builtin_amdgcn_global_load_lds((const unsigned*)((const char*)(gbase) + (voff)[_i]), (__attribute__((address_space(3))) unsigned*)(lds + (bufoff) + ldsw + _i * 8192), 16, 0, 0); } while (0)
#define G8_LDA(dst, b, h) do { _Pragma("unroll") for (int m = 0; m < 4; ++m) _Pragma("unroll") for (int k = 0; k < 2; ++k) dst[m][k] = *(const __attribute__((address_space(3))) half8*)(lds + G8_SA(b, h) + aoffl + m * 2048 + k * 1024); } while (0)
#define G8_LDB(dst, b, h) do { _Pragma("unroll") for (int n = 0; n < 2; ++n) _Pragma("unroll") for (int k = 0; k < 2; ++k) dst[n][k] = *(const __attribute__((address_space(3))) half8*)(lds + G8_SB(b, h) + boffl + n * 2048 + k * 1024); } while (0)
#define G8_MMA(ai, bj, At, Bt) do { __builtin_amdgcn_s_setprio(1); _Pragma("unroll") for (int m = 0; m < 4; ++m) _Pragma("unroll") for (int n = 0; n < 2; ++n) _Pragma("unroll") for (int k = 0; k < 2; ++k) \
        acc[ai][bj][m][n] = __builtin_amdgcn_mfma_f32_16x16x32_f16(Bt[n][k], At[m][k], acc[ai][bj][m][n], 0, 0, 0); __builtin_amdgcn_s_setprio(0); } while (0)
#define G8_WAIT_V(n) asm volatile("s_waitcnt vmcnt(" #n ")" ::: "memory")
#define G8_WAIT_L(n) asm volatile("s_waitcnt lgkmcnt(" #n ")" ::: "memory")
#define G8_BAR __builtin_amdgcn_s_barrier()
#define G8_SCHED __builtin_amdgcn_sched_barrier(0)
#define G8_AOFF(dst, u) do { _Pragma("unroll") for (int _h = 0; _h < 2; ++_h) _Pragma("unroll") for (int _i = 0; _i < 2; ++_i) dst[_h][_i] = S.a_off(u, _h * 128 + Rr[_i]) + (unsigned)Cc[_i] * 2u; } while (0)
    Unit cur, nxt; int ui = 0;
    if (!S.next(0, cur)) return;
    f32x4 acc[2][2][4][2];
#pragma unroll
    for (int a = 0; a < 2; ++a)
#pragma unroll
        for (int b = 0; b < 2; ++b)
#pragma unroll
            for (int m = 0; m < 4; ++m)
#pragma unroll
                for (int n = 0; n < 2; ++n) acc[a][b][m][n] = (f32x4){0.f, 0.f, 0.f, 0.f};
    half8 At[4][2], B0[2][2], B1[2][2];
    unsigned caoff[2][2], naoff[2][2];
    G8_AOFF(caoff, cur);
    const char* cA = S.abase; const char* cB0 = S.b_half(cur, 0); const char* cB1 = S.b_half(cur, 1);
    G8_STAGE(G8_SB(0, 0), cB0, voffB); G8_STAGE(G8_SA(0, 0), cA, caoff[0]); G8_STAGE(G8_SB(0, 1), cB1, voffB); G8_STAGE(G8_SA(0, 1), cA, caoff[1]);
    if (wr == 1) G8_BAR;
    G8_WAIT_V(4); G8_BAR;
    G8_STAGE(G8_SB(1, 0), cB0 + kstep, voffB); G8_STAGE(G8_SA(1, 0), cA + kstep, caoff[0]); G8_STAGE(G8_SB(1, 1), cB1 + kstep, voffB);
    G8_WAIT_V(6); G8_BAR;
    for (;;) {
        const bool has_next = S.next(ui + 1, nxt);
        if (!has_next) nxt = cur;
        G8_AOFF(naoff, nxt);
        const char* nB0 = S.b_half(nxt, 0); const char* nB1 = S.b_half(nxt, 1);
#pragma unroll 1
        for (int t = 0; t < nt; t += 2) {
            const bool last = (t == nt - 2);
            const char* a1 = cA + (size_t)(t + 1) * kstep;
            const char* a2 = last ? cA : cA + (size_t)(t + 2) * kstep;
            const char* b20 = last ? nB0 : cB0 + (size_t)(t + 2) * kstep; const char* b21 = last ? nB1 : cB1 + (size_t)(t + 2) * kstep;
            const char* a3 = a2 + kstep; const char* b30 = b20 + kstep; const char* b31 = b21 + kstep;
            unsigned xoff[2][2];
#pragma unroll
            for (int h = 0; h < 2; ++h)
#pragma unroll
                for (int i = 0; i < 2; ++i) xoff[h][i] = last ? naoff[h][i] : caoff[h][i];
            G8_LDB(B0, 0, 0); G8_SCHED; G8_LDA(At, 0, 0); G8_STAGE(G8_SA(1, 1), a1, caoff[1]);
            G8_WAIT_L(8); G8_BAR; G8_WAIT_L(0); G8_MMA(0, 0, At, B0); G8_BAR; G8_SCHED;
            G8_LDB(B1, 0, 1); G8_STAGE(G8_SB(0, 0), b20, voffB);
            G8_BAR; G8_WAIT_L(0); G8_MMA(0, 1, At, B1); G8_BAR;
            G8_LDA(At, 0, 1); G8_STAGE(G8_SA(0, 0), a2, xoff[0]);
            G8_BAR; G8_WAIT_L(0); G8_MMA(1, 0, At, B0); G8_BAR; G8_SCHED;
            G8_STAGE(G8_SB(0, 1), b21, voffB);
            G8_WAIT_V(6); G8_BAR; G8_MMA(1, 1, At, B1); G8_BAR;
            G8_LDB(B0, 1, 0); G8_SCHED; G8_LDA(At, 1, 0); G8_STAGE(G8_SA(0, 1), a2, xoff[1]);
            G8_WAIT_L(8); G8_BAR; G8_WAIT_L(0); G8_MMA(0, 0, At, B0); G8_BAR; G8_SCHED;
            G8_LDB(B1, 1, 1); G8_STAGE(G8_SB(1, 0), b30, voffB);
            G8_BAR; G8_WAIT_L(0); G8_MMA(0, 1, At, B1); G8_BAR;
            G8_LDA(At, 1, 1); G8_STAGE(G8_SA(1, 0), a3, xoff[0]);
            G8_BAR; G8_WAIT_L(0); G8_MMA(1, 0, At, B0); G8_BAR; G8_SCHED;
            G8_STAGE(G8_SB(1, 1), b31, voffB);
            G8_WAIT_V(6); G8_BAR; G8_MMA(1, 1, At, B1); G8_BAR;
        }
        E(acc, cur, wr, wc, fr, fq);
        if (!has_next) break;
#pragma unroll
        for (int a = 0; a < 2; ++a)
#pragma unroll
            for (int b = 0; b < 2; ++b)
#pragma unroll
                for (int m = 0; m < 4; ++m)
#pragma unroll
                    for (int n = 0; n < 2; ++n) acc[a][b][m][n] = (f32x4){0.f, 0.f, 0.f, 0.f};
        cur = nxt; cB0 = nB0; cB1 = nB1; ++ui;
#pragma unroll
        for (int h = 0; h < 2; ++h)
#pragma unroll
            for (int i = 0; i < 2; ++i) caoff[h][i] = naoff[h][i];
    }
    G8_WAIT_V(0);
    if (wr == 0) G8_BAR;
    G8_BAR;
#undef G8_SA
#undef G8_SB
#undef G8_STAGE
#undef G8_LDA
#undef G8_LDB
#undef G8_MMA
#undef G8_WAIT_V
#undef G8_WAIT_L
#undef G8_BAR
#undef G8_SCHED
#undef G8_AOFF
#endif
}
}

#ifdef EMU
typedef const Params* ParamsPtr;
#else
typedef const __attribute__((address_space(4))) Params* ParamsPtr;
#endif
struct Frame {
    ParamsPtr P; unsigned char* ws; unsigned char* smem; int tid, lane, wave;
    __device__ __forceinline__ const float* in(int i) const { return P->in[i]; }
    __device__ __forceinline__ float* xrow(int row) const { return row < TL ? P->out + (size_t)row * D : (float*)(ws + WS_XC) + (size_t)(row - TL) * D; }
    __device__ __forceinline__ const float* xrow_in(int layer, int row) const {
        if (layer == 0) return row < TL ? in(I_X) + (size_t)row * D : in(I_CTX) + (size_t)(row - TL) * D;
        return xrow(row);
    }
};
__device__ __forceinline__ int row_mod(int row) { return row < TL ? row / SEQ : NB; }
__device__ __forceinline__ const float* modp(const Frame& F, int layer, int m, int chunk) { return (const float*)(F.ws + WS_MOD) + ((size_t)(layer * 5 + m) * 6 + chunk) * D; }


#ifndef EMU
#define XB_TMO      128
#define XB_XCNT(j)  (256  + 64 * (j))
#define XB_XSUB(j)  (1280 + 64 * (j))
#define XB_XGEN(j)  (2304 + 64 * (j))
#define XB_TOP      3328
#define XB_TOPGEN   3392
#define XCD_BAR_WORDS 3456
#define XB_SPIN_CAP (1u << 26)
#define LAS __attribute__((address_space(3)))
static_assert((CW_BAR + XCD_BAR_WORDS) * 4 <= CTL_BYTES, "control region");
__device__ __forceinline__ unsigned xb_ld(unsigned* p)              { return __hip_atomic_load(p, __ATOMIC_RELAXED, __HIP_MEMORY_SCOPE_AGENT); }
__device__ __forceinline__ unsigned xb_add(unsigned* p, unsigned v) { return __hip_atomic_fetch_add(p, v, __ATOMIC_RELAXED, __HIP_MEMORY_SCOPE_AGENT); }
__device__ __forceinline__ unsigned xb_xcc_id() { return (unsigned)__builtin_amdgcn_s_getreg((3 << 11) | 20) & 0xFu; }
#define XB_SPIN(cond, bar) do { unsigned _sp = 0; while (cond) { __builtin_amdgcn_s_sleep(1); \
    if ((++_sp & 255u) == 0u) { if (xb_ld(&(bar)[XB_TMO])) break; if (_sp > XB_SPIN_CAP) { atomicAdd(&(bar)[XB_TMO], 1u); break; } } } } while (0)
struct XcdBarrier { unsigned* bar; unsigned x; volatile LAS unsigned* st; };
__device__ __forceinline__ XcdBarrier xcd_barrier_post(unsigned* bar, volatile LAS unsigned* st) {
    XcdBarrier b; b.bar = bar; b.x = xb_xcc_id(); b.st = st;
    if (threadIdx.x == 0) (void)xb_add(&bar[XB_XCNT(b.x)], 1u);
    return b;
}
__device__ __forceinline__ void xcd_barrier_complete(unsigned* bar, unsigned x, unsigned& nloc, unsigned& nx) {
    const unsigned G = gridDim.x * gridDim.y * gridDim.z;
    unsigned sum, cnt, mine, sp = 0u;
    for (;;) {
        sum = 0u; cnt = 0u; mine = 0u;
#pragma unroll
        for (unsigned j = 0; j < 16; ++j) { const unsigned c = xb_ld(&bar[XB_XCNT(j)]); sum += c; cnt += (c > 0u) ? 1u : 0u; mine = (j == x) ? c : mine; }
        if (sum == G) break;
        __builtin_amdgcn_s_sleep(1);
        if ((++sp & 255u) == 0u) { if (xb_ld(&bar[XB_TMO])) break; if (sp > XB_SPIN_CAP) { atomicAdd(&bar[XB_TMO], 1u); break; } }
    }
    nloc = mine > 0u ? mine : 1u; nx = cnt > 0u ? cnt : 1u;
}
__device__ __forceinline__ void xcd_barrier(const XcdBarrier& b) {
    asm volatile("s_waitcnt vmcnt(0)" ::: "memory");
    __syncthreads();
    if (threadIdx.x == 0) {
        unsigned* bar = b.bar;
        __builtin_amdgcn_s_waitcnt(0);
        unsigned nloc = b.st[0], nx = b.st[1];
        if (nloc == 0u) { xcd_barrier_complete(bar, b.x, nloc, nx); b.st[0] = nloc; b.st[1] = nx; }
        const unsigned old = xb_add(&bar[XB_XSUB(b.x)], 1u);
        const unsigned gen = old / nloc;
        if (old + 1u == (gen + 1u) * nloc) {
            __builtin_amdgcn_fence(__ATOMIC_RELEASE, "agent");
            asm volatile("s_waitcnt vmcnt(0)" ::: "memory");
            const unsigned og = xb_add(&bar[XB_TOP], 1u);
            const unsigned tg = og / nx;
            if (og + 1u == (tg + 1u) * nx) xb_add(&bar[XB_TOPGEN], 1u);
            else XB_SPIN(xb_ld(&bar[XB_TOPGEN]) == tg, bar);
            __builtin_amdgcn_fence(__ATOMIC_ACQUIRE, "agent");
            xb_add(&bar[XB_XGEN(b.x)], 1u);
            asm volatile("s_waitcnt vmcnt(0)" ::: "memory");
        } else {
            XB_SPIN(xb_ld(&bar[XB_XGEN(b.x)]) == gen, bar);
            __builtin_amdgcn_fence(__ATOMIC_ACQUIRE, "agent");
            asm volatile("s_waitcnt vmcnt(0)" ::: "memory");
        }
    }
    __syncthreads();
}
#endif

__device__ __forceinline__ void item_twiddle(const Frame& F, int it) {
    cplx* tw = (cplx*)(F.ws + WS_TW);
    const int k = it * NT + F.tid;
    if (k < TWN) { float s, c; const float a = -6.283185307179586f * (float)k / (float)TWN; s = sinf(a); c = cosf(a); tw[k].x = c; tw[k].y = s; }
}
__device__ __forceinline__ void item_mod(const Frame& F, int it) {
    const int layer = it / (NMOD / 64), n0 = (it % (NMOD / 64)) * 64;
    float* sc = (float*)F.smem;
    float* red = sc + 5 * D;
    for (int i = F.tid; i < 5 * D; i += NT) { const int m = i / D, k = i % D; const float v = m < NB ? F.in(I_C)[m * D + k] : F.in(I_CCTX)[k]; sc[i] = siluf(v); }
    __syncthreads();
    const int j = F.tid & 63, ks = F.tid >> 6;
    const float* w = F.in(I_WMOD) + (size_t)layer * D * NMOD + n0 + j;
    float a[5] = {0, 0, 0, 0, 0};
#pragma unroll 1
    for (int k0 = ks * 128; k0 < ks * 128 + 128; k0 += 32) {
        float wv[32];
#pragma unroll
        for (int q = 0; q < 32; ++q) wv[q] = w[(size_t)(k0 + q) * NMOD];
#pragma unroll
        for (int q = 0; q < 32; ++q)
#pragma unroll
            for (int m = 0; m < 5; ++m) a[m] += sc[m * D + k0 + q] * wv[q]; }
#pragma unroll
    for (int m = 0; m < 5; ++m) red[(ks * 5 + m) * 64 + j] = a[m];
    __syncthreads();
    if (F.tid < 5 * 64) { const int m = F.tid / 64, jj = F.tid % 64; float s = 0; for (int q = 0; q < 8; ++q) s += red[(q * 5 + m) * 64 + jj];
        ((float*)(F.ws + WS_MOD))[(size_t)(layer * 5 + m) * NMOD + n0 + jj] = s + F.in(I_BMOD)[layer * NMOD + n0 + jj]; }
    __syncthreads();
}
__device__ __forceinline__ void item_filter(const Frame& F, int layer, int isctx, int tb) {
    const int L = isctx ? CTXL : SEQ;
    float* feats = (float*)F.smem;
    float* h1 = feats + 32 * 33;
    float* h2 = h1 + 32 * 64;
    const int t0 = tb * 32;
    for (int i = F.tid; i < 32 * 33; i += NT) {
        const int tt = i / 33, f = i % 33; const float t = (float)(t0 + tt);
        float v;
        if (f == 0) v = t / (float)(L - 1 > 1 ? L - 1 : 1);
        else { const int bi = (f - 1) & 15; const float band = 1e-4f + (float)bi * ((15.0f - 1e-4f) / 15.0f);
               const float ang = (6.283185307179586f / (float)L) * t * band; v = (f <= 16) ? cosf(ang) : -sinf(ang); }
        feats[i] = v;
    }
    __syncthreads();
    const float* w1 = F.in(I_HW1) + layer * 33 * 64; const float* b1 = F.in(I_HB1) + layer * 64;
    const float* w2 = F.in(I_HW2) + layer * 64 * 64; const float* b2 = F.in(I_HB2) + layer * 64;
    const float* fr = F.in(I_HFREQ) + layer * 64;
    for (int i = F.tid; i < 32 * 64; i += NT) { const int tt = i >> 6, j = i & 63; float s = b1[j]; for (int k = 0; k < 33; ++k) s += feats[tt * 33 + k] * w1[k * 64 + j]; h1[i] = sinf(fr[j] * s); }
    __syncthreads();
    for (int i = F.tid; i < 32 * 64; i += NT) { const int tt = i >> 6, j = i & 63; float s = b2[j]; for (int k = 0; k < 64; ++k) s += h1[tt * 64 + k] * w2[k * 64 + j]; h2[i] = sinf(fr[j] * s); }
    __syncthreads();
    const float* w3 = F.in(I_HW3) + (size_t)layer * 64 * 1024;
    const int c0 = F.tid * 2;
    float* ft = (float*)(F.ws + WS_FT) + (isctx ? (size_t)2 * 256 * 4 * SEQ : (size_t)layer * 256 * 4 * SEQ);
    for (int hf = 0; hf < 2; ++hf) {
        float acc[16][2];
        for (int tt = 0; tt < 16; ++tt) { acc[tt][0] = 0.f; acc[tt][1] = 0.f; }
#pragma unroll 4
        for (int k = 0; k < 64; ++k) { const float wa = w3[k * 1024 + c0], wb = w3[k * 1024 + c0 + 1];
#pragma unroll
            for (int tt = 0; tt < 16; ++tt) { const float hv = h2[(hf * 16 + tt) * 64 + k]; acc[tt][0] += hv * wa; acc[tt][1] += hv * wb; } }
#pragma unroll
        for (int q = 0; q < 2; ++q) {
            const int col = c0 + q, dir = col >> 9, order = (col >> 8) & 1, c = col & 255;
            const float dec = fabsf(F.in(I_HDEC)[((layer * 2 + dir) * 2 + order) * 256 + c]);
            float* dst = ft + ((size_t)(c * 2 + order) * 2 + dir) * L + t0 + hf * 16;
#pragma unroll
            for (int tt = 0; tt < 16; ++tt) { const float tu = (float)(t0 + hf * 16 + tt) / (float)(L - 1 > 1 ? L - 1 : 1); dst[tt] = acc[tt][q] * expf(-tu * dec); }
        }
    }
    __syncthreads();
}
__device__ __forceinline__ int inproj_src_col(int j) { return j < 1024 ? j : (j < 3328 ? j + 12 : (j < 3340 ? j - 2304 : (j < NIN ? j : -1))); }
__device__ __forceinline__ void item_transpose(const Frame& F, const float* src, int ldn, int nvalid, half_t* dst, int K, int k0, int n0, int inmap = 0) {
    float* tile = (float*)F.smem;
    f32x4 v[8];
#pragma unroll
    for (int q = 0; q < 8; ++q) { const int i = F.tid + q * NT, r = i >> 6, c4 = (i & 63) * 4;
        if (inmap) { const int sc = inproj_src_col(n0 + c4); v[q] = sc >= 0 ? *(const f32x4*)(src + (size_t)(k0 + r) * ldn + sc) : (f32x4){0.f, 0.f, 0.f, 0.f}; }
        else if (n0 + c4 + 3 < nvalid) v[q] = *(const f32x4*)(src + (size_t)(k0 + r) * ldn + n0 + c4);
        else {
#pragma unroll
            for (int e = 0; e < 4; ++e) v[q][e] = (n0 + c4 + e < nvalid) ? src[(size_t)(k0 + r) * ldn + n0 + c4 + e] : 0.f; } }
#pragma unroll
    for (int q = 0; q < 8; ++q) { const int i = F.tid + q * NT, r = i >> 6, c4 = (i & 63) * 4; *(f32x4*)(tile + r * 260 + c4) = v[q]; }
    __syncthreads();
#pragma unroll
    for (int q = 0; q < 4; ++q) { const int i = F.tid + q * NT, n = i >> 3, kc = (i & 7) * 8; half8 h;
#pragma unroll
        for (int e = 0; e < 8; ++e) h[e] = (half_t)tile[(kc + e) * 260 + n];
        *(half8*)(dst + (size_t)(n0 + n) * K + k0 + kc) = h; }
    __syncthreads();
}
__device__ __forceinline__ void item_router_w(const Frame& F, int it) {
    const int layer = it >> 5, k0 = (it & 31) * 32;
    half_t* dst = (half_t*)(F.ws + WS_WR) + (size_t)layer * 2 * 48 * D;
#pragma unroll
    for (int q = 0; q < 2; ++q) {
        const int i = F.tid + q * NT, k = k0 + (i >> 5), c = i & 31; const float w = F.in(I_ERW)[(size_t)layer * D * 32 + (size_t)k0 * 32 + i];
        const half_t hi = (half_t)w; dst[(size_t)(4 + c) * D + k] = hi; dst[(size_t)(48 + 4 + c) * D + k] = (half_t)((w - (float)hi) * 2048.f); }
    if (F.tid < 128) {
        const int k = k0 + (F.tid >> 2), c = F.tid & 3; const float w = F.in(I_GRW)[(size_t)layer * D * 4 + (size_t)k0 * 4 + F.tid];
        const half_t hi = (half_t)w; dst[(size_t)c * D + k] = hi; dst[(size_t)(48 + c) * D + k] = (half_t)((w - (float)hi) * 2048.f); }
    if (F.tid < 12 * 32) { const int c = 36 + (F.tid >> 5), k = k0 + (F.tid & 31); dst[(size_t)c * D + k] = (half_t)0.f; dst[(size_t)(48 + c) * D + k] = (half_t)0.f; }
}
constexpr int IT_TW = (TWN + NT - 1) / NT;
constexpr int IT_MOD = 2 * (NMOD / 64);
constexpr int IT_FILT = 2 * (SEQ / 32) + (CTXL / 32);
constexpr int IT_TWIN = 2 * 16 * (NINP / 256);
constexpr int IT_TWOUT = 2 * 16 * 4;
constexpr int IT_TMOE = 32 * 48;
__device__ __forceinline__ void moe_transpose_item(const Frame& F, int layer, int it) {
    const int e = it / 48, r = it % 48, which = r / 16, t = r % 16;
    half_t* base = (half_t*)(F.ws + WS_WMOE) + (size_t)e * 3 * 262144;
    if (which < 2) {
        const float* src = F.in(which == 0 ? I_MG : I_MU) + ((size_t)layer * 32 + e) * 262144;
        item_transpose(F, src, 256, 256, base + which * 262144, 1024, t * 64, 0);
    } else {
        const float* src = F.in(I_MD) + ((size_t)layer * 32 + e) * 262144;
        item_transpose(F, src, 1024, 1024, base + 2 * 262144, 256, (t >> 2) * 64, (t & 3) * 256);
    }
}
__device__ __forceinline__ void phase_setup(const Frame& F) {
    const int G = gridDim.x; int rot = blockIdx.x;
    for (int i = rot; i < IT_MOD; i += G) item_mod(F, i);
    rot = (rot + G - (IT_MOD % G)) % G;
    for (int i = rot; i < IT_TWIN; i += G) { const int layer = i / (16 * (NINP / 256)), r = i % (16 * (NINP / 256));
        item_transpose(F, F.in(I_WIN) + (size_t)layer * D * NIN, NIN, NIN, (half_t*)(F.ws + WS_WIN) + (size_t)layer * NINP * D, D, (r / (NINP / 256)) * 64, (r % (NINP / 256)) * 256, 1); }
    rot = (rot + G - (IT_TWIN % G)) % G;
    for (int i = rot; i < IT_FILT; i += G) { if (i < 2 * (SEQ / 32)) item_filter(F, i / (SEQ / 32), 0, i % (SEQ / 32)); else item_filter(F, 0, 1, i - 2 * (SEQ / 32)); }
    rot = (rot + G - (IT_FILT % G)) % G;
    for (int i = rot; i < IT_TWOUT; i += G) { const int layer = i / 64, r = i % 64;
        item_transpose(F, F.in(I_WOUT) + (size_t)layer * D * D, D, D, (half_t*)(F.ws + WS_WOUT) + (size_t)layer * D * D, D, (r >> 2) * 64, (r & 3) * 256); }
    rot = (rot + G - (IT_TWOUT % G)) % G;
    for (int i = rot; i < IT_TW; i += G) item_twiddle(F, i);
    rot = (rot + G - (IT_TW % G)) % G;
    for (int i = rot; i < 64; i += G) item_router_w(F, i);
}

__device__ __forceinline__ void phase_norm1(const Frame& F, int layer) {
    half_t* xn = (half_t*)(F.ws + WS_XN);
    const int lane = F.lane, nwaves = gridDim.x * (NT / 64);
    const float* nw = F.in(I_N1W) + layer * D;
    int mc = -1; f32x4 g[4], s4[4];
    int row = blockIdx.x * (NT / 64) + F.wave;
    f32x4 v[4];
    if (row < TT) { const float* x = F.xrow_in(layer, row);
#pragma unroll
        for (int q = 0; q < 4; ++q) v[q] = *(const f32x4*)(x + q * 256 + lane * 4); }
    for (; row < TT; row += nwaves) {
        const int nrow = row + nwaves;
        f32x4 vn[4];
        if (nrow < TT) { const float* x = F.xrow_in(layer, nrow);
#pragma unroll
            for (int q = 0; q < 4; ++q) vn[q] = *(const f32x4*)(x + q * 256 + lane * 4); }
        if (layer > 0) {
            const half_t* xa = (const half_t*)(F.ws + WS_U16 + XAB_OFF) + (size_t)row * D; const half_t* xb = xa + (size_t)TT * D; float* xw = F.xrow(row);
            const float* g5 = modp(F, layer - 1, row_mod(row), 5);
#pragma unroll
            for (int q = 0; q < 4; ++q) { const int k = q * 256 + lane * 4; const half4 a4 = *(const half4*)(xa + k), b4 = *(const half4*)(xb + k); const f32x4 gv = *(const f32x4*)(g5 + k);
#pragma unroll
                for (int e = 0; e < 4; ++e) v[q][e] += gv[e] * ((float)a4[e] + (float)b4[e]);
                *(f32x4*)(xw + k) = v[q]; } }
        const int m = row_mod(row);
        if (m != mc) { mc = m; const float* sh = modp(F, layer, m, 0); const float* scl = modp(F, layer, m, 1);
#pragma unroll
            for (int q = 0; q < 4; ++q) { const int k = q * 256 + lane * 4; const f32x4 a = *(const f32x4*)(nw + k), b = *(const f32x4*)(scl + k); s4[q] = *(const f32x4*)(sh + k);
#pragma unroll
                for (int e = 0; e < 4; ++e) g[q][e] = a[e] * (1.0f + b[e]); } }
        float ss = 0.f;
#pragma unroll
        for (int q = 0; q < 4; ++q) ss += v[q][0] * v[q][0] + v[q][1] * v[q][1] + v[q][2] * v[q][2] + v[q][3] * v[q][3];
        ss = wave_sum(ss);
        const float rs = 1.0f / sqrtf(ss * (1.0f / D) + EPSF);
        int srow = row;
        if (layer == 1 && row < TL) { const int b = row / SEQ, l = row % SEQ; srow = b * SEQ + (l % GW) * GROWS + l / GW; }
#pragma unroll
        for (int q = 0; q < 4; ++q) { const int k = q * 256 + lane * 4; half4 h;
#pragma unroll
            for (int e = 0; e < 4; ++e) h[e] = (half_t)(v[q][e] * rs * g[q][e] + s4[q][e]);
            *(half4*)(xn + (size_t)srow * D + k) = h; }
#pragma unroll
        for (int q = 0; q < 4; ++q) v[q] = vn[q];
    }
}

#ifdef EMU
#define WAVE_SYNC() emu_wave_barrier()
#else
#define WAVE_SYNC() __builtin_amdgcn_wave_barrier()
#endif
constexpr int HYTR_OFF = g8::STAGE_BYTES + 2048;
struct EpiInproj {
    static constexpr bool PERM = true;
    half_t* u16; float* ug; half_t* hyt; half_t* halo; unsigned char* smem;
    __device__ __forceinline__ void operator()(const f32x4 (&acc)[2][2][4][2], const g8::Unit& u, int wr, int wc, int fr, int fq) const {
        const int rowb = u.pm * 256 + wr * 64 + fr;
        const bool edge = (fr == 0) || (fr == 15);
        const int lane = fq * 16 + fr;
        half_t* T = (half_t*)(smem + HYTR_OFF) + (wr * 4 + wc) * (32 * 24);
#pragma unroll
        for (int bj = 0; bj < 2; ++bj) {
            const int c8 = u.pn * 256 + bj * 128 + wc * 32 + 8 * fq;
            if (c8 < 1024 || (c8 >= 1792 && c8 < 3328)) {
                const int uc = c8 < 1024 ? c8 : c8 - 768; const bool hal = edge && uc >= 384 && uc < 1792;
#pragma unroll
                for (int ai = 0; ai < 2; ++ai)
#pragma unroll
                    for (int m = 0; m < 4; ++m) { const int row = rowb + ai * 128 + m * 16; const f32x4 a0 = acc[ai][bj][m][0], a1 = acc[ai][bj][m][1]; half8 h;
                        h[0] = (half_t)a0[0]; h[1] = (half_t)a0[1]; h[2] = (half_t)a0[2]; h[3] = (half_t)a0[3]; h[4] = (half_t)a1[0]; h[5] = (half_t)a1[1]; h[6] = (half_t)a1[2]; h[7] = (half_t)a1[3];
                        *(half8*)(u16 + (size_t)row * UW + uc) = h;
                        if (hal) *(half8*)(halo + ((size_t)(row >> 4) * 2 + (fr == 15)) * 1408 + (uc - 384)) = h; }
            } else if (c8 < 1792) {
                const int chb = (c8 - 8 * fq) - 1024;
#pragma unroll
                for (int ai = 0; ai < 2; ++ai)
#pragma unroll
                    for (int m = 0; m < 4; ++m) {
                        const f32x4 a0 = acc[ai][bj][m][0], a1 = acc[ai][bj][m][1];
                        WAVE_SYNC();
#pragma unroll
                        for (int j = 0; j < 4; ++j) { T[(8 * fq + j) * 24 + fr] = (half_t)a0[j]; T[(8 * fq + 4 + j) * 24 + fr] = (half_t)a1[j]; }
                        WAVE_SYNC();
                        const int ch = lane >> 1, th = lane & 1; const half8 hv = *(const half8*)(T + ch * 24 + th * 8);
                        const int row0 = rowb - fr + ai * 128 + m * 16;
                        half_t* dst = row0 < TL ? hyt + ((size_t)(row0 / SEQ) * 768 + chb + ch) * SEQ + row0 % SEQ : hyt + (size_t)NB * 768 * SEQ + ((size_t)((row0 - TL) / CTXL) * 768 + chb + ch) * CTXL + (row0 - TL) % CTXL;
                        *(half8*)(dst + th * 8) = hv; }
            } else {
#pragma unroll
                for (int n = 0; n < 2; ++n) { const int c0 = c8 + 4 * n;
                    if (c0 < NIN) { const int gc = c0 < 3340 ? c0 - 3328 : 12 + (c0 - 3340);
#pragma unroll
                        for (int ai = 0; ai < 2; ++ai)
#pragma unroll
                            for (int m = 0; m < 4; ++m) { const int row = rowb + ai * 128 + m * 16; *(f32x4*)(ug + (size_t)row * UGW + gc) = acc[ai][bj][m][n]; } } }
            }
        }
    }
};
__device__ __forceinline__ void phase_inproj(const Frame& F, int layer) {
    g8::DenseSched S; S.abase = (const char*)(F.ws + WS_XN); S.bbase = (const char*)((const half_t*)(F.ws + WS_WIN) + (size_t)layer * NINP * D); S.K = D; S.nM = TT / 256; S.nN = NINP / 256; S.G = gridDim.x; S.c = blockIdx.x;
    EpiInproj E{(half_t*)(F.ws + WS_U16), (float*)(F.ws + WS_UG), (half_t*)(F.ws + WS_HYT), (half_t*)(F.ws + WS_HALO), F.smem};
    g8::gemm_phase(F.smem, D, S, E);
}


__device__ __forceinline__ void phase_act(const Frame& F, int layer) {
    half_t* u16 = (half_t*)(F.ws + WS_U16); const half_t* halo = (const half_t*)(F.ws + WS_HALO);
    const int tid = F.tid, g = tid % 176, hf = tid / 176;
    const bool active = tid < 352;
    const bool isml = g >= 80; const int ch = isml ? (g - 80) * 8 : g * 8, C = isml ? 768 : 640;
    const float* cw = isml ? F.in(I_MCW) + layer * 3 * 768 : F.in(I_SCW) + layer * 3 * 640; const float* cb = isml ? F.in(I_MCB) + layer * 768 : F.in(I_SCB) + layer * 640;
    const float osc = (isml && ch >= 384) ? 0.125f : 1.0f;
    float w0[8], w1[8], w2[8], wb[8];
#pragma unroll
    for (int i = 0; i < 8; ++i) { const int cc = active ? ch + i : 0; w0[i] = cw[cc]; w1[i] = cw[C + cc]; w2[i] = cw[2 * C + cc]; wb[i] = cb[cc]; }
    for (int it = blockIdx.x; it < TT / 16; it += gridDim.x) {
        const int rb = it * 16, r0 = rb + hf * 8;
        const bool isl = rb < TL; const int L = isl ? SEQ : CTXL; const int pos0 = (isl ? rb : rb - TL) % L;
        half8 rr[10]; half8 zz;
#pragma unroll
        for (int i = 0; i < 8; ++i) zz[i] = (half_t)0.f;
        if (active) {
            const size_t col = 384 + g * 8;
#pragma unroll
            for (int k = 0; k < 8; ++k) rr[k + 1] = *(const half8*)(u16 + (size_t)(r0 + k) * UW + col);
            if (hf == 0) { rr[0] = pos0 > 0 ? *(const half8*)(halo + ((size_t)(it - 1) * 2 + 1) * 1408 + g * 8) : zz; rr[9] = *(const half8*)(u16 + (size_t)(rb + 8) * UW + col); }
            else { rr[0] = *(const half8*)(u16 + (size_t)(rb + 7) * UW + col); rr[9] = pos0 + 16 < L ? *(const half8*)(halo + ((size_t)(it + 1) * 2 + 0) * 1408 + g * 8) : zz; }
        }
        half8 o[8];
        if (active) {
#pragma unroll
            for (int k = 0; k < 8; ++k)
#pragma unroll
                for (int i = 0; i < 8; ++i) o[k][i] = (half_t)(osc * fsilu(w0[i] * (float)rr[k][i] + w1[i] * (float)rr[k + 1][i] + w2[i] * (float)rr[k + 2][i] + wb[i]));
        }
        __syncthreads();
        if (active) {
#pragma unroll
            for (int k = 0; k < 8; ++k) *(half8*)(u16 + (size_t)(r0 + k) * UW + 384 + g * 8) = o[k];
        }
    }
}

constexpr int SA = 72, SB = 136;

__device__ __forceinline__ void load_rows8(const half_t* u16, int rowbase, int Lseq, int dir, int jj0, int ucol, half8 (&rr)[8]) {
#pragma unroll
    for (int k = 0; k < 8; ++k) { const int jj = jj0 + k, pos = dir == 0 ? jj : Lseq - 1 - jj; rr[k] = *(const half8*)(u16 + (size_t)(rowbase + pos) * UW + ucol); }
}
__device__ __forceinline__ void transpose8(const half8 (&rr)[8], half8 (&t)[8]) {
#pragma unroll
    for (int i = 0; i < 8; ++i)
#pragma unroll
        for (int k = 0; k < 8; ++k) t[i][k] = rr[k][i];
}
__device__ __forceinline__ void ssd_block(const Frame& F, int layer, int b, int h, int dir) {
    half_t* Cs = (half_t*)F.smem;
    half_t* Bs = Cs + 128 * SA;
    half_t* BT = Bs + 128 * SA;
    half_t* XT = BT + 64 * SB;
    half_t* SC = XT + 64 * SB;
    half_t* ST = SC + 128 * SB;
    float* cum = (float*)(ST + 64 * SA);
    float* dtv = cum + 128;
    float* wes = dtv + 128;
    const half_t* u16 = (const half_t*)(F.ws + WS_U16); const float* ug = (const float*)(F.ws + WS_UG);
    half_t* yout = (half_t*)(F.ws + WS_YF) + (size_t)dir * TT * 384;
    const float* cw = F.in(I_SCW) + layer * 3 * 640; const float* cb = F.in(I_SCB) + layer * 640;
    const float dtb = F.in(I_DTB)[(layer * 2 + dir) * 6 + h];
    const float Aneg = -expf(F.in(I_ALOG)[(layer * 2 + dir) * 6 + h]);
    const float Dh = F.in(I_SD)[layer * 6 + h];
    const int g = h / 3, tid = F.tid, lane = F.lane, wave = F.wave;
    const int kind = tid >> 7, c8 = (tid & 7) * 8, j0 = ((tid >> 3) & 15) * 8;
    const int ch = kind == 0 ? h * 64 + c8 : (kind == 1 ? 384 + g * 64 + c8 : 512 + g * 64 + c8);
    f32x4 accS[1][2]; zero_acc(accS);
    for (int i = tid; i < 64 * SA; i += NT) ST[i] = (half_t)0.f;
    constexpr int NC0 = CTXL / 128, NCT = NC0 + SEQ / 128;
    half8 rr[8]; float ug0 = 0.f, ug1 = 0.f;
    if (kind < 3) load_rows8(u16, TL + b * CTXL, CTXL, dir, j0, 384 + ch, rr);
    if (wave == 7) { const int p0 = dir == 0 ? 2 * lane : CTXL - 1 - 2 * lane, p1 = dir == 0 ? p0 + 1 : p0 - 1;
        ug0 = ug[(size_t)(TL + b * CTXL + p0) * UGW + dir * 6 + h]; ug1 = ug[(size_t)(TL + b * CTXL + p1) * UGW + dir * 6 + h]; }
    __syncthreads();
    for (int cc = 0; cc < NCT; ++cc) {
        const int seg = cc >= NC0 ? 1 : 0, c = seg ? cc - NC0 : cc;
        const int Lseq = seg == 0 ? CTXL : SEQ, rowbase = seg == 0 ? TL + b * CTXL : b * SEQ;
        const bool want_y = (seg == 1) || (layer == 0);
        const int nseg = (cc + 1) >= NC0 ? 1 : 0, ncn = nseg ? cc + 1 - NC0 : cc + 1, nL = nseg == 0 ? CTXL : SEQ, nrb = nseg == 0 ? TL + b * CTXL : b * SEQ;
        if (wave == 7) {
            const float dt0 = fsoftplus(ug0 + dtb), dt1 = fsoftplus(ug1 + dtb);
            const float a0 = dt0 * Aneg, a1 = dt1 * Aneg;
            const float incl = wave_scan_sum(a0 + a1, lane);
            const float c1 = incl, c0 = incl - a1;
            const float cl = wave_last(incl);
            cum[2 * lane] = c0; cum[2 * lane + 1] = c1; dtv[2 * lane] = dt0; dtv[2 * lane + 1] = dt1;
            wes[2 * lane] = dt0 * fexp(cl - c0); wes[2 * lane + 1] = dt1 * fexp(cl - c1);
            if (cc + 1 < NCT) { const int pi = ncn * 128 + 2 * lane, p0 = dir == 0 ? pi : nL - 1 - pi, p1 = dir == 0 ? p0 + 1 : p0 - 1;
                ug0 = ug[(size_t)(nrb + p0) * UGW + dir * 6 + h]; ug1 = ug[(size_t)(nrb + p1) * UGW + dir * 6 + h]; }
        }
        if (kind < 3) {
            if (kind == 0) { half8 t[8]; transpose8(rr, t);
#pragma unroll
                for (int i = 0; i < 8; ++i) *(half8*)(XT + (c8 + i) * SB + j0) = t[i];
            } else if (kind == 1) { half8 t[8]; transpose8(rr, t);
#pragma unroll
                for (int k = 0; k < 8; ++k) *(half8*)(Bs + (j0 + k) * SA + c8) = rr[k];
#pragma unroll
                for (int i = 0; i < 8; ++i) *(half8*)(BT + (c8 + i) * SB + j0) = t[i];
            } else {
#pragma unroll
                for (int k = 0; k < 8; ++k) *(half8*)(Cs + (j0 + k) * SA + c8) = rr[k];
            }
            if (cc + 1 < NCT) load_rows8(u16, nrb, nL, dir, ncn * 128 + j0, 384 + ch, rr);
        }
        __syncthreads();
        const float cl = cum[127];
        if (want_y) {
            { const int ws_ = wave & 1, wl = wave >> 1;
              if (!(ws_ == 1 && wl < 2)) {
                f32x4 g_[4][2]; zero_acc(g_);
                mma_lds<4, 2>(g_, Bs + ws_ * 64 * SA, SA, Cs + wl * 32 * SA, SA, 2, lane);
#pragma unroll
                for (int a = 0; a < 4; ++a) {
                    const int s0 = ws_ * 64 + a * 16 + (lane >> 4) * 4;
                    const f32x4 cs4 = *(const f32x4*)(cum + s0), dt4 = *(const f32x4*)(dtv + s0);
#pragma unroll
                    for (int q = 0; q < 2; ++q) {
                        const int l = wl * 32 + q * 16 + (lane & 15); const float cl_ = cum[l]; half4 hv;
#pragma unroll
                        for (int i = 0; i < 4; ++i) hv[i] = (half_t)((s0 + i) <= l ? g_[a][q][i] * fexp(cl_ - cs4[i]) * dt4[i] : 0.f);
                        *(half4*)(SC + l * SB + s0) = hv;
                    } }
              } }
            f32x4 y1[4][1]; zero_acc(y1);
            mma_lds<4, 1>(y1, ST, SA, Cs + wave * 16 * SA, SA, 2, lane);
            __syncthreads();
            f32x4 y2[4][1]; zero_acc(y2);
            mma_lds<4, 1>(y2, XT, SB, SC + wave * 16 * SB, SB, wave / 2 + 1, lane);
            { const int l = wave * 16 + (lane & 15); const float el = fexp(cum[l]);
              const int pi = c * 128 + l, pos = dir == 0 ? pi : Lseq - 1 - pi;
#pragma unroll
              for (int a = 0; a < 4; ++a) { const int p0 = a * 16 + (lane >> 4) * 4; f32x4 y;
#pragma unroll
                  for (int i = 0; i < 4; ++i) y[i] = y1[a][0][i] * el + y2[a][0][i];
                  if (dir == 0) {
#pragma unroll
                      for (int i = 0; i < 4; ++i) y[i] += Dh * (float)XT[(p0 + i) * SB + l]; }
                  *(half4*)(yout + (size_t)(rowbase + pos) * 384 + h * 64 + p0) = to_half4(y); } }
        }
        { const float dec = fexp(cl);
#pragma unroll
          for (int q = 0; q < 2; ++q) accS[0][q] *= dec;
          const int r = lane & 15, kq = (lane >> 4) * 8;
#pragma unroll
          for (int ks = 0; ks < 4; ++ks) {
              const half8 a = *(const half8*)(BT + ((wave >> 1) * 16 + r) * SB + ks * 32 + kq);
              const f32x4 e0 = *(const f32x4*)(wes + ks * 32 + kq), e1 = *(const f32x4*)(wes + ks * 32 + kq + 4);
#pragma unroll
              for (int q = 0; q < 2; ++q) { half8 bb = *(const half8*)(XT + ((wave & 1) * 32 + q * 16 + r) * SB + ks * 32 + kq);
#pragma unroll
                  for (int i = 0; i < 4; ++i) { bb[i] = (half_t)((float)bb[i] * e0[i]); bb[4 + i] = (half_t)((float)bb[4 + i] * e1[i]); }
                  accS[0][q] = mfma16(a, bb, accS[0][q]); } } }
        __syncthreads();
#pragma unroll
        for (int q = 0; q < 2; ++q) { const int p = (wave & 1) * 32 + q * 16 + (lane & 15), n0 = (wave >> 1) * 16 + (lane >> 4) * 4; *(half4*)(ST + p * SA + n0) = to_half4(accS[0][q]); }
    }
    __syncthreads();
}

__device__ __forceinline__ void mlstm_block(const Frame& F, int layer, int b, int h, int dir) {
    half_t* Qs = (half_t*)F.smem;
    half_t* Ks = Qs + 128 * SA;
    half_t* KT = Ks + 128 * SA;
    half_t* VT = KT + 64 * SB;
    half_t* SC = VT + 64 * SB;
    half_t* CS = SC + 128 * SB;
    float* ig = (float*)(CS + 64 * SA);
    float* cumf = ig + 128; float* gsv = cumf + 128; float* mtv = gsv + 128; float* ee = mtv + 128; float* dn = ee + 128;
    float* nvec = dn + 128;
    float* scal = nvec + 64;
    const half_t* u16 = (const half_t*)(F.ws + WS_U16); const float* ug = (const float*)(F.ws + WS_UG);
    half_t* hout = (half_t*)(F.ws + WS_YF) + (size_t)(2 + dir) * TT * 384;
    const float* cw = F.in(I_MCW) + layer * 3 * 768; const float* cb = F.in(I_MCB) + layer * 768;
    const float bi = F.in(I_MGB)[((layer * 2 + dir) * 2 + 0) * 6 + h], bf = F.in(I_MGB)[((layer * 2 + dir) * 2 + 1) * 6 + h];
    const int tid = F.tid, lane = F.lane, wave = F.wave;
    const int kind = tid >> 7, c8 = (tid & 7) * 8, j0 = ((tid >> 3) & 15) * 8;
    const int ch = kind == 0 ? h * 64 + c8 : 384 + h * 64 + c8;
    f32x4 accC[1][2]; zero_acc(accC);
    float m_in = 0.f;
    for (int i = tid; i < 64 * SA; i += NT) CS[i] = (half_t)0.f;
    if (tid < 64) nvec[tid] = 0.f;
    constexpr int NC0 = CTXL / 128, NCT = NC0 + SEQ / 128;
    half8 rr[8]; float gi0 = 0.f, gi1 = 0.f, gf0 = 0.f, gf1 = 0.f;
    const int ucol = kind == 2 ? 1792 + h * 64 + c8 : 1024 + ch;
    if (kind < 3) load_rows8(u16, TL + b * CTXL, CTXL, dir, j0, ucol, rr);
    if (wave == 7) { const int p0 = dir == 0 ? 2 * lane : CTXL - 1 - 2 * lane, p1 = dir == 0 ? p0 + 1 : p0 - 1;
        const float* g0 = ug + (size_t)(TL + b * CTXL + p0) * UGW + 12 + dir * 12; const float* g1 = ug + (size_t)(TL + b * CTXL + p1) * UGW + 12 + dir * 12;
        gi0 = g0[h]; gf0 = g0[6 + h]; gi1 = g1[h]; gf1 = g1[6 + h]; }
    half8 ones;
#pragma unroll
    for (int i = 0; i < 8; ++i) ones[i] = (half_t)1.0f;
    __syncthreads();
    for (int cc = 0; cc < NCT; ++cc) {
        const int seg = cc >= NC0 ? 1 : 0, c = seg ? cc - NC0 : cc;
        const int Lseq = seg == 0 ? CTXL : SEQ, rowbase = seg == 0 ? TL + b * CTXL : b * SEQ;
        const bool want_y = (seg == 1) || (layer == 0);
        const int nseg = (cc + 1) >= NC0 ? 1 : 0, ncn = nseg ? cc + 1 - NC0 : cc + 1, nL = nseg == 0 ? CTXL : SEQ, nrb = nseg == 0 ? TL + b * CTXL : b * SEQ;
        if (wave == 7) {
            const float i0 = gi0 + bi, i1 = gi1 + bi, lf0 = flogsigmoid(gf0 + bf), lf1 = flogsigmoid(gf1 + bf);
            const float incl = wave_scan_sum(lf0 + lf1, lane);
            const float c1 = incl, c0 = incl - lf1;
            const float tot = wave_last(incl);
            const float r0 = i0 - c0, r1 = i1 - c1;
            const float pincl = wave_scan_max(fmaxf(r0, r1), lane);
            const float pexcl = wave_shr1(pincl, -3.0e38f, lane);
            const float pm0 = fmaxf(pexcl, r0), pm1 = pincl;
            const float pmlast = wave_last(pincl);
            const float m_new = fmaxf(tot + m_in, tot + pmlast);
            ig[2 * lane] = i0; ig[2 * lane + 1] = i1; cumf[2 * lane] = c0; cumf[2 * lane + 1] = c1; gsv[2 * lane] = r0; gsv[2 * lane + 1] = r1;
            mtv[2 * lane] = fmaxf(c0 + m_in, c0 + pm0); mtv[2 * lane + 1] = fmaxf(c1 + m_in, c1 + pm1);
            ee[2 * lane] = fexp(r0 + tot - m_new); ee[2 * lane + 1] = fexp(r1 + tot - m_new);
            if (lane == 0) { scal[0] = tot; scal[1] = m_new; }
            if (cc + 1 < NCT) { const int pi = ncn * 128 + 2 * lane, p0 = dir == 0 ? pi : nL - 1 - pi, p1 = dir == 0 ? p0 + 1 : p0 - 1;
                const float* g0 = ug + (size_t)(nrb + p0) * UGW + 12 + dir * 12; const float* g1 = ug + (size_t)(nrb + p1) * UGW + 12 + dir * 12;
                gi0 = g0[h]; gf0 = g0[6 + h]; gi1 = g1[h]; gf1 = g1[6 + h]; }
        }
        if (kind == 0) {
#pragma unroll
            for (int k = 0; k < 8; ++k) *(half8*)(Qs + (j0 + k) * SA + c8) = rr[k];
        } else if (kind == 1) { half8 t[8]; transpose8(rr, t);
#pragma unroll
            for (int k = 0; k < 8; ++k) *(half8*)(Ks + (j0 + k) * SA + c8) = rr[k];
#pragma unroll
            for (int i = 0; i < 8; ++i) *(half8*)(KT + (c8 + i) * SB + j0) = t[i];
        } else if (kind == 2) { half8 t[8]; transpose8(rr, t);
#pragma unroll
            for (int i = 0; i < 8; ++i) *(half8*)(VT + (c8 + i) * SB + j0) = t[i];
        }
        if (kind < 3 && cc + 1 < NCT) load_rows8(u16, nrb, nL, dir, ncn * 128 + j0, ucol, rr);
        __syncthreads();
        const float tot = scal[0], m_new = scal[1];
        if (want_y) {
            { const int ws_ = wave & 1, wl = wave >> 1;
              if (!(ws_ == 1 && wl < 2)) {
                f32x4 g_[4][2]; zero_acc(g_);
                mma_lds<4, 2>(g_, Ks + ws_ * 64 * SA, SA, Qs + wl * 32 * SA, SA, 2, lane);
#pragma unroll
                for (int a = 0; a < 4; ++a) {
                    const int s0 = ws_ * 64 + a * 16 + (lane >> 4) * 4; const f32x4 gs4 = *(const f32x4*)(gsv + s0);
#pragma unroll
                    for (int q = 0; q < 2; ++q) {
                        const int l = wl * 32 + q * 16 + (lane & 15); const float cm = cumf[l] - mtv[l]; half4 hv;
#pragma unroll
                        for (int i = 0; i < 4; ++i) hv[i] = (half_t)((s0 + i) <= l ? g_[a][q][i] * fexp(cm + gs4[i]) : 0.f);
                        *(half4*)(SC + l * SB + s0) = hv;
                    } }
              } }
            f32x4 h1[4][1]; zero_acc(h1);
            mma_lds<4, 1>(h1, CS, SA, Qs + wave * 16 * SA, SA, 2, lane);
            f32x4 dq = {0.f, 0.f, 0.f, 0.f};
            { const int r_ = lane & 15, kq_ = (lane >> 4) * 8;
#pragma unroll
              for (int ks = 0; ks < 2; ++ks) { half8 na; const f32x4 n0 = *(const f32x4*)(nvec + ks * 32 + kq_), n1 = *(const f32x4*)(nvec + ks * 32 + kq_ + 4);
#pragma unroll
                  for (int i = 0; i < 4; ++i) { na[i] = (half_t)n0[i]; na[4 + i] = (half_t)n1[i]; }
                  dq = mfma16(na, *(const half8*)(Qs + (wave * 16 + r_) * SA + ks * 32 + kq_), dq); } }
            __syncthreads();
            f32x4 h2[4]; f32x4 d1 = {0.f, 0.f, 0.f, 0.f};
#pragma unroll
            for (int a = 0; a < 4; ++a) h2[a] = (f32x4){0.f, 0.f, 0.f, 0.f};
            { const int r = lane & 15, kq = (lane >> 4) * 8;
              for (int ks = 0; ks < wave / 2 + 1; ++ks) {
                  const half8 bfr = *(const half8*)(SC + (wave * 16 + r) * SB + ks * 32 + kq);
#pragma unroll
                  for (int a = 0; a < 4; ++a) { const half8 afr = *(const half8*)(VT + (a * 16 + r) * SB + ks * 32 + kq); h2[a] = mfma16(afr, bfr, h2[a]); }
                  d1 = mfma16(ones, bfr, d1); } }
            { const int l = wave * 16 + (lane & 15); const float ai = fexp(cumf[l] + m_in - mtv[l]); const float rden = 1.0f / fmaxf(fabsf(dq[0] * ai + d1[0]), fexp(-mtv[l]));
              const int pi = c * 128 + l, pos = dir == 0 ? pi : Lseq - 1 - pi;
#pragma unroll
              for (int a = 0; a < 4; ++a) { const int v0 = a * 16 + (lane >> 4) * 4; f32x4 y;
#pragma unroll
                  for (int i = 0; i < 4; ++i) y[i] = (h1[a][0][i] * ai + h2[a][i]) * rden;
                  *(half4*)(hout + (size_t)(rowbase + pos) * 384 + h * 64 + v0) = to_half4(y); } }
        }
        { const float sc = fexp(tot + m_in - m_new);
#pragma unroll
          for (int q = 0; q < 2; ++q) accC[0][q] *= sc;
          { const int r = lane & 15, kq = (lane >> 4) * 8;
#pragma unroll
            for (int ks = 0; ks < 4; ++ks) {
              const half8 a = *(const half8*)(KT + ((wave >> 1) * 16 + r) * SB + ks * 32 + kq);
              const f32x4 e0 = *(const f32x4*)(ee + ks * 32 + kq), e1 = *(const f32x4*)(ee + ks * 32 + kq + 4);
#pragma unroll
              for (int q = 0; q < 2; ++q) { half8 bb = *(const half8*)(VT + ((wave & 1) * 32 + q * 16 + r) * SB + ks * 32 + kq);
#pragma unroll
                  for (int i = 0; i < 4; ++i) { bb[i] = (half_t)((float)bb[i] * e0[i]); bb[4 + i] = (half_t)((float)bb[4 + i] * e1[i]); }
                  accC[0][q] = mfma16(a, bb, accC[0][q]); } } }
          if ((wave & 1) == 0) { f32x4 an = {0.f, 0.f, 0.f, 0.f}; const int r_ = lane & 15, kq_ = (lane >> 4) * 8;
#pragma unroll
              for (int ks = 0; ks < 4; ++ks) { half8 eb; const f32x4 e0 = *(const f32x4*)(ee + ks * 32 + kq_), e1 = *(const f32x4*)(ee + ks * 32 + kq_ + 4);
#pragma unroll
                  for (int i = 0; i < 4; ++i) { eb[i] = (half_t)e0[i]; eb[4 + i] = (half_t)e1[i]; }
                  an = mfma16(*(const half8*)(KT + ((wave >> 1) * 16 + r_) * SB + ks * 32 + kq_), eb, an); }
              if ((lane & 15) == 0) {
#pragma unroll
                  for (int i = 0; i < 4; ++i) { const int d = (wave >> 1) * 16 + (lane >> 4) * 4 + i; nvec[d] = sc * nvec[d] + an[i]; } } } }
        m_in = m_new;
        __syncthreads();
#pragma unroll
        for (int q = 0; q < 2; ++q) { const int v = (wave & 1) * 32 + q * 16 + (lane & 15), d0 = (wave >> 1) * 16 + (lane >> 4) * 4; *(half4*)(CS + v * SA + d0) = to_half4(accC[0][q]); }
    }
    __syncthreads();
}

__device__ __forceinline__ cplx cmul(cplx a, cplx b) { return cplx{a.x * b.x - a.y * b.y, a.x * b.y + a.y * b.x}; }
__device__ __forceinline__ cplx cadd(cplx a, cplx b) { return cplx{a.x + b.x, a.y + b.y}; }
__device__ __forceinline__ cplx csub(cplx a, cplx b) { return cplx{a.x - b.x, a.y - b.y}; }
__device__ __forceinline__ void sincos_turns(float x, float& s, float& c) {
#ifdef EMU
    s = sinf(6.283185307179586f * x); c = cosf(6.283185307179586f * x);
#else
    s = __builtin_amdgcn_sinf(x); c = __builtin_amdgcn_cosf(x);
#endif
}
#define PADI(i) ((i) + ((i) >> 5))
template <bool INV> __device__ __forceinline__ void r4(cplx& a0, cplx& a1, cplx& a2, cplx& a3) {
    const cplx t0 = cadd(a0, a2), t1 = csub(a0, a2), t2 = cadd(a1, a3), t3 = csub(a1, a3);
    a0 = cadd(t0, t2); a2 = csub(t0, t2);
    if (!INV) { a1 = cplx{t1.x + t3.y, t1.y - t3.x}; a3 = cplx{t1.x - t3.y, t1.y + t3.x}; }
    else      { a1 = cplx{t1.x - t3.y, t1.y + t3.x}; a3 = cplx{t1.x + t3.y, t1.y - t3.x}; }
}
template <bool INV> __device__ __forceinline__ void fft16(cplx (&v)[16]) {
#pragma unroll
    for (int l0 = 0; l0 < 4; ++l0) r4<INV>(v[l0], v[l0 + 4], v[l0 + 8], v[l0 + 12]);
    const float C1 = 0.9238795325112867f, S1 = 0.3826834323650898f, C2 = 0.7071067811865476f;
    const float sg = INV ? 1.f : -1.f;
#define TWM(idx, cr, ci) v[idx] = cmul(v[idx], cplx{(cr), sg * (ci)})
    TWM(1 + 4 * 1, C1, S1); TWM(2 + 4 * 1, C2, C2); TWM(3 + 4 * 1, S1, C1);
    TWM(1 + 4 * 2, C2, C2); TWM(2 + 4 * 2, 0.f, 1.f); TWM(3 + 4 * 2, -C2, C2);
    TWM(1 + 4 * 3, S1, C1); TWM(2 + 4 * 3, -C2, C2); TWM(3 + 4 * 3, -C1, -S1);
#undef TWM
    cplx o[16];
#pragma unroll
    for (int m0 = 0; m0 < 4; ++m0) { cplx a0 = v[4 * m0], a1 = v[4 * m0 + 1], a2 = v[4 * m0 + 2], a3 = v[4 * m0 + 3]; r4<INV>(a0, a1, a2, a3);
        o[m0] = a0; o[m0 + 4] = a1; o[m0 + 8] = a2; o[m0 + 12] = a3; }
#pragma unroll
    for (int i = 0; i < 16; ++i) v[i] = o[i];
}
__device__ __forceinline__ void twpow(cplx w1, cplx (&w)[16]) {
    w[1] = w1; w[2] = cmul(w1, w1); w[3] = cmul(w[2], w1); w[4] = cmul(w[2], w[2]); w[5] = cmul(w[4], w1); w[6] = cmul(w[4], w[2]); w[7] = cmul(w[4], w[3]); w[8] = cmul(w[4], w[4]);
#pragma unroll
    for (int m = 9; m < 16; ++m) w[m] = cmul(w[8], w[m - 8]);
}
#ifdef EMU
#define OPAQUE_I(x)
#else
#define OPAQUE_I(x) asm volatile("" : "+v"(x))
#endif
template <int NS> __device__ __forceinline__ void fft_fwd16(cplx* buf0, cplx* buf1, int N, int tid, int TS = NT) {
#pragma unroll 1
    for (int n = N; n >= 32; n >>= 4) { const int q = n >> 4, qs = q + (q >> 5);
        for (int i = tid; i < N / 16; i += TS) {
            const int blk = i / q, j = i - blk * q; int pb = PADI(blk * n + j); OPAQUE_I(pb);
            float s, c; sincos_turns(-(float)j / (float)n, s, c);
            const cplx w1{c, s};
#pragma unroll
            for (int st = 0; st < NS; ++st) { cplx* buf = (st == 0 ? buf0 : buf1) + pb;
                cplx v[16];
#pragma unroll
                for (int l = 0; l < 16; ++l) v[l] = buf[l * qs];
                fft16<false>(v);
                buf[0] = v[0];
                cplx wm = w1;
#pragma unroll
                for (int m = 1; m < 16; ++m) { buf[m * qs] = cmul(v[m], wm); wm = cmul(wm, w1); }
                LOADER_FENCE(); }
        }
        __syncthreads(); }
}
template <int NS> __device__ __forceinline__ void fft_inv16(cplx* buf0, cplx* buf1, int N, int tid, int TS = NT) {
#pragma unroll 1
    for (int n = 32; n <= N; n <<= 4) { const int q = n >> 4, qs = q + (q >> 5);
        for (int i = tid; i < N / 16; i += TS) {
            const int blk = i / q, j = i - blk * q; int pb = PADI(blk * n + j); OPAQUE_I(pb);
            float s, c; sincos_turns((float)j / (float)n, s, c);
            const cplx w1{c, s};
#pragma unroll
            for (int st = 0; st < NS; ++st) { cplx* buf = (st == 0 ? buf0 : buf1) + pb;
                cplx v[16];
                v[0] = buf[0];
                cplx wm = w1;
#pragma unroll
                for (int m = 1; m < 16; ++m) { v[m] = cmul(buf[m * qs], wm); wm = cmul(wm, w1); }
                fft16<true>(v);
#pragma unroll
                for (int l = 0; l < 16; ++l) buf[l * qs] = v[l];
                LOADER_FENCE(); }
        }
        __syncthreads(); }
}
static_assert(2 * SEQ == 512 || 2 * SEQ == 8192, "FFT size must be 2*16^k");
static_assert(2 * CTXL == 512 || 2 * CTXL == 8192, "FFT size must be 2*16^k");
constexpr int HBUF = (2 * SEQ + (2 * SEQ) / 32 + 8);
constexpr int HPT = (SEQ + NT - 1) / NT;
__device__ __forceinline__ void hy_conv8(const half_t* p, int t0, int L, float w0, float w1, float w2, float bsv, float (&o)[8]) {
    const half8 m = *(const half8*)(p + t0);
    float e[10]; e[0] = t0 > 0 ? (float)p[t0 - 1] : 0.f; e[9] = t0 + 8 < L ? (float)p[t0 + 8] : 0.f;
#pragma unroll
    for (int i = 0; i < 8; ++i) e[i + 1] = (float)m[i];
#pragma unroll
    for (int i = 0; i < 8; ++i) o[i] = w0 * e[i] + w1 * e[i + 1] + w2 * e[i + 2] + bsv;
}
template <int TS> __device__ __forceinline__ float team_sum(float v, const Frame& F, float* red) {
    if constexpr (TS == NT) { v = wave_sum(v); if (F.lane == 0) red[F.wave] = v; __syncthreads(); float t = 0.f; for (int w = 0; w < NT / 64; ++w) t += red[w]; return t; }
    else { static_assert(TS == 32, "team size");
#pragma unroll
        for (int m = 16; m >= 1; m >>= 1) v += __shfl_xor(v, m);
        __syncthreads(); return v; }
}
template <int NS, int TS, int HP> __device__ __forceinline__ void hyena_seg_t(const Frame& F, int layer, int c0, const int seg) {
    const int HB = (seg == 0 ? 2 * SEQ : 2 * CTXL) + (seg == 0 ? 2 * SEQ : 2 * CTXL) / 32 + 8;
    const int tid = F.tid % TS, team = F.tid / TS, c = c0 + team;
    cplx* bufA = (cplx*)F.smem + (size_t)team * 2 * HB;
    cplx* bufB = bufA + HB;
    float* red = (float*)((cplx*)F.smem + (size_t)(NT / TS) * 2 * HB);
    const float* cwp = F.in(I_HCW) + layer * 3 * 768; const float* cbp = F.in(I_HCB) + layer * 768;
    {
        const int L = seg == 0 ? SEQ : CTXL, N = 2 * L;
        const half_t* hyt = (const half_t*)(F.ws + WS_HYT) + (seg == 0 ? 0 : (size_t)NB * 768 * SEQ);
        float* z1 = (float*)(F.ws + WS_XN) + (seg == 0 ? 0 : (size_t)NB * 256 * SEQ);
        float* yht = (float*)(F.ws + WS_YHT) + (seg == 0 ? 0 : (size_t)NB * 256 * SEQ);
        const float* ft = (const float*)(F.ws + WS_FT) + (seg == 0 ? (size_t)layer * 256 * 4 * SEQ : (size_t)2 * 256 * 4 * SEQ);
        for (int order = 0; order < 2; ++order) {
            const float* hfw = ft + ((size_t)(c * 2 + order) * 2 + 0) * L; const float* hbw = ft + ((size_t)(c * 2 + order) * 2 + 1) * L;
            float asum = 0.f;
            for (int i_ = tid; i_ < N; i_ += TS) { int i = i_; OPAQUE_I(i); const float v = i < L ? hfw[i] : (i == L ? 0.f : hbw[N - i]); bufA[PADI(i)] = cplx{v, 0.f}; asum += fabsf(v); }
            const float tot = team_sum<TS>(asum, F, red);
            fft_fwd16<1>(bufA, bufA, N, tid, TS);
            half4 Hh[HP];
            const float hs = 1.0f / tot, invN = 1.0f / (float)N;
#pragma unroll
            for (int k = 0; k < HP; ++k) { int i = tid + k * TS; OPAQUE_I(i); half4 hv;
                if (i < N / 2) { const cplx a = bufA[PADI(2 * i)], b_ = bufA[PADI(2 * i + 1)]; const cplx s = cadd(a, b_), d = csub(a, b_);
                    hv[0] = (half_t)(s.x * hs); hv[1] = (half_t)(s.y * hs); hv[2] = (half_t)(d.x * hs); hv[3] = (half_t)(d.y * hs); }
                else { hv[0] = hv[1] = hv[2] = hv[3] = (half_t)0.f; }
                Hh[k] = hv; LOADER_FENCE(); }
            __syncthreads();
            const int gch = 256 * (order + 1) + c;
            for (int pr = 0; pr < NB / 2; pr += NS) {
#pragma unroll
                for (int st = 0; st < NS; ++st) { cplx* buf = st == 0 ? bufA : bufB; const int b0 = 2 * (pr + st), b1 = b0 + 1;
                    const float vw0 = cwp[c], vw1 = cwp[768 + c], vw2 = cwp[1536 + c], vb = cbp[c];
                    const half_t* v0p = hyt + ((size_t)b0 * 768 + c) * L; const half_t* v1p = hyt + ((size_t)b1 * 768 + c) * L;
                    const float* z0q = z1 + ((size_t)b0 * 256 + c) * L; const float* z1q = z1 + ((size_t)b1 * 256 + c) * L;
                    for (int t0_ = tid * 8; t0_ < N; t0_ += TS * 8) { int t0 = t0_; OPAQUE_I(t0);
                        if (t0 < L) { float za[8], zb[8];
                            if (order == 0) { hy_conv8(v0p, t0, L, vw0, vw1, vw2, vb, za); hy_conv8(v1p, t0, L, vw0, vw1, vw2, vb, zb); }
                            else {
#pragma unroll
                                for (int i = 0; i < 8; ++i) { za[i] = z0q[t0 + i]; zb[i] = z1q[t0 + i]; } }
#pragma unroll
                            for (int i = 0; i < 8; ++i) buf[PADI(t0 + i)] = cplx{za[i], zb[i]}; }
                        else {
#pragma unroll
                            for (int i = 0; i < 8; ++i) buf[PADI(t0 + i)] = cplx{0.f, 0.f}; }
                        LOADER_FENCE();
                    } }
                __syncthreads();
                fft_fwd16<NS>(bufA, bufB, N, tid, TS);
#pragma unroll
                for (int st = 0; st < NS; ++st) { cplx* buf = st == 0 ? bufA : bufB;
#pragma unroll
                    for (int k = 0; k < HP; ++k) { int i = tid + k * TS; OPAQUE_I(i);
                        if (i < N / 2) { const cplx a = buf[PADI(2 * i)], b_ = buf[PADI(2 * i + 1)];
                            const cplx h0{(float)Hh[k][0] * invN, (float)Hh[k][1] * invN}, h1{(float)Hh[k][2] * invN, (float)Hh[k][3] * invN};
                            const cplx s = cmul(cadd(a, b_), h0), d = cmul(csub(a, b_), h1);
                            buf[PADI(2 * i)] = cadd(s, d); buf[PADI(2 * i + 1)] = csub(s, d); }
                        LOADER_FENCE(); } }
                __syncthreads();
                fft_inv16<NS>(bufA, bufB, N, tid, TS);
#pragma unroll
                for (int st = 0; st < NS; ++st) { cplx* buf = st == 0 ? bufA : bufB; const int b0 = 2 * (pr + st), b1 = b0 + 1;
                    const float gw0 = cwp[gch], gw1 = cwp[768 + gch], gw2 = cwp[1536 + gch], gb = cbp[gch];
                    const float vw0 = cwp[c], vw1 = cwp[768 + c], vw2 = cwp[1536 + c], vb = cbp[c];
                    const float skip = F.in(I_HSKIP)[(layer * 2 + order) * 256 + c];
                    const half_t* v0p = hyt + ((size_t)b0 * 768 + c) * L; const half_t* v1p = hyt + ((size_t)b1 * 768 + c) * L;
                    const float* z0q = z1 + ((size_t)b0 * 256 + c) * L; const float* z1q = z1 + ((size_t)b1 * 256 + c) * L;
                    const half_t* g0p = hyt + ((size_t)b0 * 768 + gch) * L; const half_t* g1p = hyt + ((size_t)b1 * 768 + gch) * L;
                    float* d0 = (order == 0 ? z1 : yht) + ((size_t)b0 * 256 + c) * L; float* d1 = (order == 0 ? z1 : yht) + ((size_t)b1 * 256 + c) * L;
                    for (int t0_ = tid * 8; t0_ < L; t0_ += TS * 8) { int t0 = t0_; OPAQUE_I(t0);
                        float za[8], zb[8], ga[8], gb_[8];
                        if (order == 0) { hy_conv8(v0p, t0, L, vw0, vw1, vw2, vb, za); hy_conv8(v1p, t0, L, vw0, vw1, vw2, vb, zb); }
                        else {
#pragma unroll
                            for (int i = 0; i < 8; ++i) { za[i] = z0q[t0 + i]; zb[i] = z1q[t0 + i]; } }
                        hy_conv8(g0p, t0, L, gw0, gw1, gw2, gb, ga); hy_conv8(g1p, t0, L, gw0, gw1, gw2, gb, gb_);
                        f32x4 oa[2], ob[2];
#pragma unroll
                        for (int i = 0; i < 8; ++i) { const cplx y = buf[PADI(t0 + i)]; oa[i >> 2][i & 3] = ga[i] * (y.x + skip * za[i]); ob[i >> 2][i & 3] = gb_[i] * (y.y + skip * zb[i]); }
                        *(f32x4*)(d0 + t0) = oa[0]; *(f32x4*)(d0 + t0 + 4) = oa[1]; *(f32x4*)(d1 + t0) = ob[0]; *(f32x4*)(d1 + t0 + 4) = ob[1];
                        LOADER_FENCE();
                    } }
                __syncthreads();
            }
        }
    }
}
constexpr int HP_L = (SEQ + NT - 1) / NT, HP_C = (CTXL + 31) / 32;
static_assert((size_t)(NT / 32) * 2 * (2 * CTXL + 2 * CTXL / 32 + 8) * 8 + 256 <= (size_t)LDS_BYTES - 64, "ctx team buffers must fit in LDS");
__device__ __forceinline__ void hyena_channel(const Frame& F, int layer, int c) {
    constexpr int NS = (NB % 4 == 0) ? 2 : 1;
    hyena_seg_t<NS, NT, HP_L>(F, layer, c, 0);
}
__device__ __forceinline__ void hyena_ctx_group(const Frame& F, int layer, int g) {
    constexpr int NS = (NB % 4 == 0) ? 2 : 1;
    hyena_seg_t<NS, 32, HP_C>(F, layer, g * (NT / 32), 1);
}
__device__ __forceinline__ int queue_pull(const Frame& F, unsigned* head) {
    int* slot = (int*)(F.smem + LDS_BYTES - 64);
    __syncthreads();
    if (F.tid == 0) *slot = (int)atomicAdd(head, 1u);
    __syncthreads();
    const int v = *slot;
    return v;
}
__device__ __forceinline__ void phase_mixers(const Frame& F, int layer) {
    const int bid = blockIdx.x;
    constexpr int NSCAN = 2 * NB * 6 * 2;
    unsigned* qhead = (unsigned*)(F.ws + WS_CTL) + CW_QUE + layer * 128;
    if (bid < NSCAN) {
        const int k = bid >> 1, kind = bid & 1, dir = k % 2, h = (k / 2) % 6, b = k / 12;
        if (kind == 0) ssd_block(F, layer, b, h, dir); else mlstm_block(F, layer, b, h, dir);
    }
    for (;;) { const int c = queue_pull(F, qhead); if (c >= 256) break; hyena_channel(F, layer, c); }
    if (layer == 0) for (;;) { const int g = queue_pull(F, qhead + 32); if (g >= 256 / (NT / 32)) break; hyena_ctx_group(F, layer, g); }
    for (;;) { const int it = queue_pull(F, qhead + 64); if (it >= IT_TMOE) break; moe_transpose_item(F, layer, it); }
}

__device__ __forceinline__ void phase_combine(const Frame& F, int layer) {
    const int nrows = layer == 0 ? TT : TL;
    const half_t* u16 = (const half_t*)(F.ws + WS_U16);
    const half_t* yf = (const half_t*)(F.ws + WS_YF); const half_t* yb = yf + (size_t)TT * 384; const half_t* hf = yb + (size_t)TT * 384; const half_t* hb = hf + (size_t)TT * 384;
    half_t* yl = (half_t*)(F.ws + WS_XN);
    const float* snw = F.in(I_SNW) + layer * 384; const float* mnw = F.in(I_MNW) + layer * 384;
    const int lane = F.lane, k8 = (lane < 48 ? lane : 0) * 8, nwaves = gridDim.x * (NT / 64);
    f32x4 sw[2], mw[2];
#pragma unroll
    for (int q = 0; q < 2; ++q) { sw[q] = *(const f32x4*)(snw + k8 + q * 4); mw[q] = *(const f32x4*)(mnw + k8 + q * 4); }
    int row = blockIdx.x * (NT / 64) + F.wave;
    half8 a[6];
#define COMB_LOAD(dst, r) { const size_t ro = (size_t)(r); dst[0] = *(const half8*)(yf + ro * 384 + k8); dst[1] = *(const half8*)(yb + ro * 384 + k8); dst[2] = *(const half8*)(u16 + ro * UW + k8); \
        dst[3] = *(const half8*)(hf + ro * 384 + k8); dst[4] = *(const half8*)(hb + ro * 384 + k8); dst[5] = *(const half8*)(u16 + ro * UW + 2176 + k8); }
    if (row < nrows) COMB_LOAD(a, row)
    for (; row < nrows; row += nwaves) {
        const int nrow = row + nwaves;
        half8 an[6];
        if (nrow < nrows) COMB_LOAD(an, nrow)
        const size_t ro = (size_t)row;
        float g[8], hv[8]; float ss = 0.f, hs = 0.f;
#pragma unroll
        for (int i = 0; i < 8; ++i) { g[i] = ((float)a[0][i] + (float)a[1][i]) * fsilu((float)a[2][i]); ss += g[i] * g[i]; hv[i] = (float)a[3][i] + (float)a[4][i]; hs += hv[i]; }
        if (lane >= 48) ss = 0.f;
        ss = wave_sum(ss);
        hs += __shfl_xor(hs, 1); hs += __shfl_xor(hs, 2); hs += __shfl_xor(hs, 4);
        const float mu = hs * (1.0f / 64.f);
        float vs = 0.f;
#pragma unroll
        for (int i = 0; i < 8; ++i) { hv[i] -= mu; vs += hv[i] * hv[i]; }
        vs += __shfl_xor(vs, 1); vs += __shfl_xor(vs, 2); vs += __shfl_xor(vs, 4);
        const float rs = 1.0f / sqrtf(ss * (1.0f / 384.f) + EPSF), rstd = 1.0f / sqrtf(vs * (1.0f / 64.f) + EPSF);
        if (lane < 48) { half8 o1, o2;
#pragma unroll
            for (int i = 0; i < 8; ++i) { o1[i] = (half_t)(g[i] * rs * sw[i >> 2][i & 3]); o2[i] = (half_t)(hv[i] * rstd * mw[i >> 2][i & 3] / (1.0f + fexp(-(float)a[5][i]))); }
            *(half8*)(yl + ro * D + k8) = o1; *(half8*)(yl + ro * D + 640 + k8) = o2; }
#pragma unroll
        for (int i = 0; i < 6; ++i) a[i] = an[i];
    }
#undef COMB_LOAD
    { const int ntile = nrows / 32, hbk = blockIdx.x * 2 + (F.tid >> 8), c = F.tid & 255;
      for (int tl = hbk; tl < ntile; tl += gridDim.x * 2) {
          const int row0 = tl * 32; const bool isl = row0 < TL; const int L = isl ? SEQ : CTXL; const int rc = isl ? row0 : row0 - TL; const int b = rc / L, t0 = rc % L;
          const float* src = (const float*)(F.ws + WS_YHT) + (isl ? 0 : (size_t)NB * 256 * SEQ) + ((size_t)b * 256 + c) * L + t0;
          f32x4 v[8];
#pragma unroll
          for (int q = 0; q < 8; ++q) v[q] = *(const f32x4*)(src + q * 4);
#pragma unroll
          for (int i = 0; i < 32; ++i) yl[(size_t)(row0 + i) * D + 384 + c] = (half_t)v[i >> 2][i & 3]; } }
}

struct EpiOutproj {
    static constexpr bool PERM = true;
    Frame F; int layer;
    __device__ __forceinline__ void operator()(const f32x4 (&acc)[2][2][4][2], const g8::Unit& u, int wr, int wc, int fr, int fq) const {
#pragma unroll
        for (int ai = 0; ai < 2; ++ai)
#pragma unroll
            for (int m = 0; m < 4; ++m) {
                const int srow = u.pm * 256 + ai * 128 + wr * 64 + m * 16 + fr;
                int row = srow;
                if (layer == 1 && srow < TL) { const int b = srow / SEQ, s = srow % SEQ; row = b * SEQ + (s % GROWS) * GW + s / GROWS; }
                const float* g1 = modp(F, layer, row_mod(row), 2);
                const float* xi = F.xrow_in(layer, row); float* xo = F.xrow(row);
#pragma unroll
                for (int bj = 0; bj < 2; ++bj) { const int c0 = u.pn * 256 + bj * 128 + wc * 32 + 8 * fq;
                    const f32x4 x0 = *(const f32x4*)(xi + c0), x1 = *(const f32x4*)(xi + c0 + 4), g0 = *(const f32x4*)(g1 + c0), g1v = *(const f32x4*)(g1 + c0 + 4);
                    *(f32x4*)(xo + c0) = x0 + g0 * acc[ai][bj][m][0]; *(f32x4*)(xo + c0 + 4) = x1 + g1v * acc[ai][bj][m][1]; }
            }
    }
};
__device__ __forceinline__ void outproj_ctx_tiles(const Frame& F, int layer) {
    const half_t* yl = (const half_t*)(F.ws + WS_XN) + (size_t)TL * D;
    const half_t* wt = (const half_t*)(F.ws + WS_WOUT) + (size_t)layer * D * D;
    constexpr int KC = 256, LDT = KC + 8;
    half_t* As = (half_t*)F.smem; half_t* Bs = As + 64 * LDT;
    const int lane = F.lane, wave = F.wave, tid = F.tid;
    const int ntile = (TC / 64) * (D / 64);
    for (int t = blockIdx.x; t < ntile; t += gridDim.x) {
        const int m0 = (t / (D / 64)) * 64, n0 = (t % (D / 64)) * 64;
        const int mt = wave >> 1, nt0 = (wave & 1) * 2;
        f32x4 c[1][2]; zero_acc(c);
        for (int kb = 0; kb < D; kb += KC) {
            half8 ra[4], rb[4];
#pragma unroll
            for (int q = 0; q < 4; ++q) { const int pc = tid + q * NT, row = pc >> 5, kc = (pc & 31) * 8; ra[q] = *(const half8*)(yl + (size_t)(m0 + row) * D + kb + kc); rb[q] = *(const half8*)(wt + (size_t)(n0 + row) * D + kb + kc); }
            __syncthreads();
#pragma unroll
            for (int q = 0; q < 4; ++q) { const int pc = tid + q * NT, row = pc >> 5, kc = (pc & 31) * 8; *(half8*)(As + row * LDT + kc) = ra[q]; *(half8*)(Bs + row * LDT + kc) = rb[q]; }
            __syncthreads();
            mma_lds<1, 2>(c, As + mt * 16 * LDT, LDT, Bs + nt0 * 16 * LDT, LDT, KC / 32, lane);
        }
        const int r = lane & 15;
#pragma unroll
        for (int i = 0; i < 4; ++i) {
            const int row = TL + m0 + mt * 16 + (lane >> 4) * 4 + i;
            const float* g1 = modp(F, layer, NB, 2); const float* xi = F.xrow_in(layer, row); float* xo = F.xrow(row);
            const int ca = n0 + nt0 * 16 + r, cb = ca + 16;
            xo[ca] = xi[ca] + g1[ca] * c[0][0][i]; xo[cb] = xi[cb] + g1[cb] * c[0][1][i];
        }
        __syncthreads();
    }
}
__device__ __forceinline__ void phase_outproj(const Frame& F, int layer) {
    if (layer == 0) outproj_ctx_tiles(F, layer);
    g8::DenseSched S; S.abase = (const char*)(F.ws + WS_XN); S.bbase = (const char*)((const half_t*)(F.ws + WS_WOUT) + (size_t)layer * D * D); S.K = D; S.nM = TL / 256; S.nN = D / 256; S.G = gridDim.x; S.c = blockIdx.x;
    EpiOutproj E{F, layer};
    g8::gemm_phase(F.smem, D, S, E);
}

constexpr int RLD = D + 8;
__device__ __forceinline__ void phase_router(const Frame& F, int layer, bool dry = false) {
    const int nrows = layer == 0 ? TT : TL, total = nrows / 16;
    half_t* Th = (half_t*)F.smem;
    half_t* Tl = Th + 16 * RLD;
    float* PART = (float*)(Tl + 16 * RLD);
    float* LG = PART + 8 * 16 * 48;
    half_t* tb = (half_t*)(F.ws + WS_XN);
    unsigned* cnt = (unsigned*)(F.ws + WS_CTL) + CW_CNT + layer * 64 * CSTR;
    int* list = (int*)(F.ws + WS_LIST); float* pw = (float*)(F.ws + WS_PW);
    const float* nw = F.in(I_N2W) + layer * D;
    const half_t* wr = (const half_t*)(F.ws + WS_WR) + (size_t)layer * 2 * 48 * D;
    const int lane = F.lane, wave = F.wave, r = lane & 15, kq = (lane >> 4) * 8, kb = wave * 128;
    half8 bh[3][4];
#pragma unroll
    for (int nt = 0; nt < 3; ++nt)
#pragma unroll
        for (int ks = 0; ks < 4; ++ks) { const size_t o = (size_t)(nt * 16 + r) * D + kb + ks * 32 + kq; bh[nt][ks] = *(const half8*)(wr + o); }
    int mc = -1; f32x4 g[4], s4[4];
    int it = blockIdx.x;
    f32x4 v[2][4];
    if (it < total) {
#pragma unroll
        for (int rr = 0; rr < 2; ++rr) { const float* x = F.xrow(it * 16 + wave * 2 + rr);
#pragma unroll
            for (int q = 0; q < 4; ++q) v[rr][q] = *(const f32x4*)(x + q * 256 + lane * 4); } }
    int p_row = -1, p_ea = 0, p_eb = 0; unsigned p_pa = 0, p_pb = 0; float p_w0 = 0.f, p_w1 = 0.f;
    for (; it < total; it += gridDim.x) {
        const int row0 = it * 16, nit = it + gridDim.x;
        f32x4 vn[2][4];
        if (nit < total) {
#pragma unroll
            for (int rr = 0; rr < 2; ++rr) { const float* x = F.xrow(nit * 16 + wave * 2 + rr);
#pragma unroll
                for (int q = 0; q < 4; ++q) vn[rr][q] = *(const f32x4*)(x + q * 256 + lane * 4); } }
        { const int m = row_mod(row0);
          if (m != mc) { mc = m; const float* sh = modp(F, layer, m, 3); const float* scl = modp(F, layer, m, 4);
#pragma unroll
              for (int q = 0; q < 4; ++q) { const int k = q * 256 + lane * 4; const f32x4 a = *(const f32x4*)(nw + k), b = *(const f32x4*)(scl + k); s4[q] = *(const f32x4*)(sh + k);
#pragma unroll
                  for (int e = 0; e < 4; ++e) g[q][e] = a[e] * (1.0f + b[e]); } } }
#pragma unroll
        for (int rr = 0; rr < 2; ++rr) {
            float ss = 0.f;
#pragma unroll
            for (int q = 0; q < 4; ++q) ss += v[rr][q][0] * v[rr][q][0] + v[rr][q][1] * v[rr][q][1] + v[rr][q][2] * v[rr][q][2] + v[rr][q][3] * v[rr][q][3];
            ss = wave_sum(ss);
            const float rs = 1.0f / sqrtf(ss * (1.0f / D) + EPSF);
            const int lr = wave * 2 + rr, row = row0 + lr;
#pragma unroll
            for (int q = 0; q < 4; ++q) { const int k = q * 256 + lane * 4; half4 h, l;
#pragma unroll
                for (int e = 0; e < 4; ++e) { const float tv = v[rr][q][e] * rs * g[q][e] + s4[q][e]; h[e] = (half_t)tv; l[e] = (half_t)((tv - (float)h[e]) * 2048.f); }
                *(half4*)(tb + (size_t)row * D + k) = h; *(half4*)(Th + lr * RLD + k) = h; *(half4*)(Tl + lr * RLD + k) = l; }
        }
        __syncthreads();
        { f32x4 ah[3], al[3]; half8 bl[3][4];
#pragma unroll
          for (int nt = 0; nt < 3; ++nt)
#pragma unroll
              for (int ks = 0; ks < 4; ++ks) bl[nt][ks] = *(const half8*)(wr + (size_t)48 * D + (size_t)(nt * 16 + r) * D + kb + ks * 32 + kq);
#pragma unroll
          for (int nt = 0; nt < 3; ++nt) { ah[nt] = (f32x4){0.f, 0.f, 0.f, 0.f}; al[nt] = (f32x4){0.f, 0.f, 0.f, 0.f}; }
#pragma unroll
          for (int ks = 0; ks < 4; ++ks) {
              const half8 a_h = *(const half8*)(Th + r * RLD + kb + ks * 32 + kq), a_l = *(const half8*)(Tl + r * RLD + kb + ks * 32 + kq);
#pragma unroll
              for (int nt = 0; nt < 3; ++nt) { ah[nt] = mfma16(a_h, bh[nt][ks], ah[nt]); al[nt] = mfma16(a_l, bh[nt][ks], al[nt]); al[nt] = mfma16(a_h, bl[nt][ks], al[nt]); }
          }
#pragma unroll
          for (int nt = 0; nt < 3; ++nt)
#pragma unroll
              for (int i = 0; i < 4; ++i) PART[(wave * 16 + (lane >> 4) * 4 + i) * 48 + nt * 16 + r] = ah[nt][i] + al[nt][i] * (1.0f / 2048.f); }
        __syncthreads();
        for (int o = F.tid; o < 16 * 48; o += NT) { const int col = o % 48; float sum = 0.f;
#pragma unroll
            for (int w = 0; w < 8; ++w) sum += PART[w * 16 * 48 + o];
            float bias = 0.f; if (col < 4) bias = F.in(I_GRB)[layer * 4 + col]; else if (col < 36) bias = F.in(I_ERB)[layer * 32 + col - 4];
            LG[o] = sum + bias; }
        __syncthreads();
        if (F.tid < 16) {
            if (p_row >= 0 && !dry) { list[(size_t)(p_ea * 2 + 0) * LCAP + p_pa] = p_row * 2 + 0; list[(size_t)(p_eb * 2 + 1) * LCAP + p_pb] = p_row * 2 + 1; pw[p_row * 2 + 0] = p_w0; pw[p_row * 2 + 1] = p_w1; }
            const int row = row0 + F.tid; const float* lg = LG + F.tid * 48;
            int gi = 0; float gm = lg[0];
            for (int q = 1; q < 4; ++q) if (lg[q] > gm) { gm = lg[q]; gi = q; }
            float gs = 0.f; for (int q = 0; q < 4; ++q) gs += expf(lg[q] - gm);
            const float grp_p = 1.0f / gs;
            const float* el = lg + 4 + gi * 8;
            int i0 = 0; float e0 = el[0];
            for (int q = 1; q < 8; ++q) if (el[q] > e0) { e0 = el[q]; i0 = q; }
            int i1 = -1; float e1 = -3.0e38f;
            for (int q = 0; q < 8; ++q) if (q != i0 && el[q] > e1) { e1 = el[q]; i1 = q; }
            const float p1 = expf(e1 - e0);
            p_w0 = grp_p * (1.0f / (1.0f + p1)); p_w1 = grp_p * (p1 / (1.0f + p1));
            p_ea = gi * 8 + i0; p_eb = gi * 8 + i1; p_row = row;
            if (!dry) { p_pa = atomicAdd(&cnt[(p_ea * 2 + 0) * CSTR], 1u); p_pb = atomicAdd(&cnt[(p_eb * 2 + 1) * CSTR], 1u); }
        }
#pragma unroll
        for (int rr = 0; rr < 2; ++rr)
#pragma unroll
            for (int q = 0; q < 4; ++q) v[rr][q] = vn[rr][q];
    }
    if (F.tid < 16 && p_row >= 0 && !dry) { list[(size_t)(p_ea * 2 + 0) * LCAP + p_pa] = p_row * 2 + 0; list[(size_t)(p_eb * 2 + 1) * LCAP + p_pb] = p_row * 2 + 1; pw[p_row * 2 + 0] = p_w0; pw[p_row * 2 + 1] = p_w1; }
    __syncthreads();
}

constexpr int MOE_PRE_OFF = g8::STAGE_BYTES;
struct MoeSchedA {
    const char* abase; const char* wbase; const int* pre; const unsigned* cnt; const int* list; int G, c;
    __device__ __forceinline__ int entry(const g8::Unit& u, int r) const { const int rc = r < u.n ? r : 0; return rc < u.c0 ? list[(size_t)(u.e * 2) * LCAP + rc] : list[(size_t)(u.e * 2 + 1) * LCAP + (rc - u.c0)]; }
    __device__ __forceinline__ bool next(int i, g8::Unit& u) const {
        const int L = i * G + c; if (L >= pre[32]) return false;
        int e = 0; while (L >= pre[e + 1]) ++e;
        const int loc = L - pre[e]; u.e = e; u.c0 = (int)cnt[(e * 2) * CSTR]; u.n = u.c0 + (int)cnt[(e * 2 + 1) * CSTR]; u.pm = loc >> 1; u.pn = loc & 1; return true;
    }
    __device__ __forceinline__ unsigned a_off(const g8::Unit& u, int r) const { return (unsigned)(entry(u, u.pm * 256 + r) >> 1) * (unsigned)(D * 2); }
    __device__ __forceinline__ const char* b_half(const g8::Unit& u, int h) const { return wbase + ((size_t)u.e * 3 * 262144 + (size_t)h * 262144 + (size_t)u.pn * 128 * D) * 2; }
};
struct EpiMoeA {
    static constexpr bool PERM = true;
    MoeSchedA S; const float* pw; half_t* hid;
    __device__ __forceinline__ void operator()(const f32x4 (&acc)[2][2][4][2], const g8::Unit& u, int wr, int wc, int fr, int fq) const {
        int pid[8]; float w[8];
#pragma unroll
        for (int g = 0; g < 8; ++g) pid[g] = S.entry(u, u.pm * 256 + (g >> 2) * 128 + wr * 64 + (g & 3) * 16 + fr);
#pragma unroll
        for (int g = 0; g < 8; ++g) w[g] = pw[pid[g]];
        const int f = u.pn * 128 + wc * 32 + 8 * fq;
#pragma unroll
        for (int ai = 0; ai < 2; ++ai)
#pragma unroll
            for (int m = 0; m < 4; ++m) {
                const int rr = u.pm * 256 + ai * 128 + wr * 64 + m * 16 + fr;
                if (rr < u.n) { half8 h;
#pragma unroll
                    for (int n = 0; n < 2; ++n) { const f32x4 g = acc[ai][0][m][n], up = acc[ai][1][m][n];
#pragma unroll
                        for (int i = 0; i < 4; ++i) h[n * 4 + i] = (half_t)(fsilu(g[i]) * up[i] * w[ai * 4 + m]); }
                    *(half8*)(hid + (size_t)pid[ai * 4 + m] * 256 + f) = h; }
            }
    }
};
__device__ __forceinline__ void phase_moe_a(const Frame& F, int layer) {
    int* pre = (int*)(F.smem + MOE_PRE_OFF);
    const unsigned* cnt = (const unsigned*)(F.ws + WS_CTL) + CW_CNT + layer * 64 * CSTR;
    if (F.tid == 0) { int s = 0; for (int e = 0; e < 32; ++e) { pre[e] = s; s += (((int)(cnt[(e * 2) * CSTR] + cnt[(e * 2 + 1) * CSTR]) + 255) / 256) * 2; } pre[32] = s; }
    __syncthreads();
    MoeSchedA S; S.abase = (const char*)(F.ws + WS_XN); S.wbase = (const char*)(F.ws + WS_WMOE); S.pre = pre; S.cnt = cnt; S.list = (const int*)(F.ws + WS_LIST); S.G = gridDim.x; S.c = blockIdx.x;
    EpiMoeA E{S, (const float*)(F.ws + WS_PW), (half_t*)(F.ws + WS_U16)};
    g8::gemm_phase(F.smem, D, S, E);
    __syncthreads();
}
struct MoeSchedB {
    const char* abase; const char* wbase; const int* pre; const unsigned* cnt; const int* list; int G, c;
    __device__ __forceinline__ bool next(int i, g8::Unit& u) const {
        const int L = i * G + c; if (L >= pre[64]) return false;
        int l = 0; while (L >= pre[l + 1]) ++l;
        const int loc = L - pre[l]; u.e = l >> 1; u.c0 = l & 1; u.n = (int)cnt[(l) * CSTR]; u.pm = loc >> 2; u.pn = loc & 3; return true;
    }
    __device__ __forceinline__ int entry(const g8::Unit& u, int rr) const { return list[(size_t)(u.e * 2 + u.c0) * LCAP + (rr < u.n ? rr : 0)]; }
    __device__ __forceinline__ unsigned a_off(const g8::Unit& u, int r) const { return (unsigned)entry(u, u.pm * 256 + r) * 512u; }
    __device__ __forceinline__ const char* b_half(const g8::Unit& u, int h) const { return wbase + ((size_t)u.e * 3 * 262144 + 2 * 262144 + (size_t)(u.pn * 256 + h * 128) * 256) * 2; }
};
struct EpiMoeB {
    static constexpr bool PERM = true;
    MoeSchedB S; Frame F; int layer;
    __device__ __forceinline__ void operator()(const f32x4 (&acc)[2][2][4][2], const g8::Unit& u, int wr, int wc, int fr, int fq) const {
        int row[8];
#pragma unroll
        for (int g = 0; g < 8; ++g) row[g] = S.entry(u, u.pm * 256 + (g >> 2) * 128 + wr * 64 + (g & 3) * 16 + fr) >> 1;
        half_t* xab = (half_t*)(F.ws + WS_U16 + XAB_OFF) + (size_t)u.c0 * TT * D;
#pragma unroll
        for (int ai = 0; ai < 2; ++ai)
#pragma unroll
            for (int m = 0; m < 4; ++m) {
                const int rr = u.pm * 256 + ai * 128 + wr * 64 + m * 16 + fr;
                if (rr < u.n) { const int rw = row[ai * 4 + m]; half_t* xo = xab + (size_t)rw * D;
#pragma unroll
                    for (int bj = 0; bj < 2; ++bj) { const int d = u.pn * 256 + bj * 128 + wc * 32 + 8 * fq;
                        const f32x4 a0 = acc[ai][bj][m][0], a1 = acc[ai][bj][m][1];
                        half8 h; h[0] = (half_t)a0[0]; h[1] = (half_t)a0[1]; h[2] = (half_t)a0[2]; h[3] = (half_t)a0[3]; h[4] = (half_t)a1[0]; h[5] = (half_t)a1[1]; h[6] = (half_t)a1[2]; h[7] = (half_t)a1[3];
                        *(half8*)(xo + d) = h; } }
            }
    }
};
__device__ __forceinline__ void phase_moe_b(const Frame& F, int layer) {
    int* pre = (int*)(F.smem + MOE_PRE_OFF);
    const unsigned* cnt = (const unsigned*)(F.ws + WS_CTL) + CW_CNT + layer * 64 * CSTR;
    if (F.tid == 0) { int s = 0; for (int l = 0; l < 64; ++l) { pre[l] = s; s += (((int)cnt[(l) * CSTR] + 255) / 256) * 4; } pre[64] = s; }
    __syncthreads();
    MoeSchedB S; S.abase = (const char*)(F.ws + WS_U16); S.wbase = (const char*)(F.ws + WS_WMOE); S.pre = pre; S.cnt = cnt; S.list = (const int*)(F.ws + WS_LIST); S.G = gridDim.x; S.c = blockIdx.x;
    EpiMoeB E{S, F, layer};
    g8::gemm_phase(F.smem, 256, S, E);
    __syncthreads();
}

__device__ __forceinline__ void phase_final(const Frame& F) {
    const float* fw = F.in(I_FNW);
    const int lane = F.lane, nwaves = gridDim.x * (NT / 64);
    f32x4 w4[4];
#pragma unroll
    for (int q = 0; q < 4; ++q) w4[q] = *(const f32x4*)(fw + q * 256 + lane * 4);
    int row = blockIdx.x * (NT / 64) + F.wave;
    f32x4 v[4];
    if (row < TL) {
#pragma unroll
        for (int q = 0; q < 4; ++q) v[q] = *(const f32x4*)(F.P->out + (size_t)row * D + q * 256 + lane * 4); }
    for (; row < TL; row += nwaves) {
        const int nrow = row + nwaves;
        f32x4 vn[4];
        if (nrow < TL) {
#pragma unroll
            for (int q = 0; q < 4; ++q) vn[q] = *(const f32x4*)(F.P->out + (size_t)nrow * D + q * 256 + lane * 4); }
        { const half_t* xa = (const half_t*)(F.ws + WS_U16 + XAB_OFF) + (size_t)row * D; const half_t* xb = xa + (size_t)TT * D;
          const float* g5 = modp(F, 1, row_mod(row), 5);
#pragma unroll
          for (int q = 0; q < 4; ++q) { const int k = q * 256 + lane * 4; const half4 a4 = *(const half4*)(xa + k), b4 = *(const half4*)(xb + k); const f32x4 gv = *(const f32x4*)(g5 + k);
#pragma unroll
              for (int e = 0; e < 4; ++e) v[q][e] += gv[e] * ((float)a4[e] + (float)b4[e]); } }
        float ss = 0.f;
#pragma unroll
        for (int q = 0; q < 4; ++q) ss += v[q][0] * v[q][0] + v[q][1] * v[q][1] + v[q][2] * v[q][2] + v[q][3] * v[q][3];
        ss = wave_sum(ss);
        const float rs = 1.0f / sqrtf(ss * (1.0f / D) + EPSF);
#pragma unroll
        for (int q = 0; q < 4; ++q) *(f32x4*)(F.P->out + (size_t)row * D + q * 256 + lane * 4) = v[q] * rs * w4[q];
#pragma unroll
        for (int q = 0; q < 4; ++q) v[q] = vn[q];
    }
}

constexpr int NPHASE = 1 + 2 * 9 + 1;
#ifndef ONLY
#define ONLY -1
#endif
#define EN(x) (ONLY < 0 || ONLY == (x))
__device__ __forceinline__ void run_phase(const Frame& F, int ph) {
    if (ph == 0) { if (EN(0)) phase_setup(F); return; }
    if (ph == NPHASE - 1) { if (EN(11)) phase_final(F); return; }
    const int layer = (ph - 1) / 9, k = (ph - 1) % 9;
    switch (k) {
        case 0: if (EN(1)) phase_norm1(F, layer); break;
        case 1: if (EN(2)) phase_inproj(F, layer); break;
        case 2: if (EN(10)) phase_act(F, layer); break;
        case 3: if (EN(3)) phase_mixers(F, layer); break;
        case 4: if (EN(4)) phase_combine(F, layer); break;
        case 5: if (EN(5)) phase_outproj(F, layer); break;
        case 6: if (EN(6)) phase_router(F, layer); break;
        case 7: if (EN(7)) phase_moe_a(F, layer); break;
        default: if (EN(8)) phase_moe_b(F, layer); break;
    }
}

#ifdef EMU
void mega(const Params* Pp) {
    Frame F; F.P = Pp; F.ws = Pp->ws; F.smem = emu_blk->smem; F.tid = threadIdx.x; F.lane = F.tid & 63; F.wave = F.tid >> 6;
    for (int ph = Pp->ph_lo; ph < Pp->ph_hi; ++ph) { run_phase(F, ph); __syncthreads(); }
}
#else
__global__ void __launch_bounds__(NT) mega(Params P) {
    extern __shared__ __attribute__((aligned(16))) unsigned char smem_dyn[];
    cg::grid_group grid = cg::this_grid();
    Frame F; F.P = (ParamsPtr)__builtin_amdgcn_kernarg_segment_ptr(); F.ws = P.ws; F.smem = smem_dyn; F.tid = threadIdx.x; F.lane = F.tid & 63; F.wave = F.tid >> 6;
    volatile LAS unsigned* bst = (volatile LAS unsigned*)(smem_dyn + LDS_BYTES - 16);
    if (F.tid < 4) bst[F.tid] = 0u;
    __syncthreads();
    XcdBarrier xb = xcd_barrier_post((unsigned*)(P.ws + WS_CTL) + CW_BAR, bst);
    if (P.ph_lo < 0) grid.sync();
#define DUP -1
#define AMP -1
#define PHASE_STEP(i) if (P.ph_lo <= (i) && (i) < P.ph_hi) { \
        unsigned long long t0_ = 0; if (AMP == (i)) t0_ = __builtin_amdgcn_s_memrealtime(); \
        run_phase(F, (i)); \
        if ((i) + 1 < P.ph_hi || AMP == (i)) xcd_barrier(xb); \
        if (AMP == (i)) { const unsigned long long t1_ = __builtin_amdgcn_s_memrealtime(); if (blockIdx.x == 0) { while (__builtin_amdgcn_s_memrealtime() - t1_ < t1_ - t0_) __builtin_amdgcn_s_sleep(8); } xcd_barrier(xb); } }
    PHASE_STEP(0) PHASE_STEP(1) PHASE_STEP(2) PHASE_STEP(3) PHASE_STEP(4) PHASE_STEP(5) PHASE_STEP(6) PHASE_STEP(7) PHASE_STEP(8) PHASE_STEP(9)
    PHASE_STEP(10) PHASE_STEP(11) PHASE_STEP(12) PHASE_STEP(13) PHASE_STEP(14) PHASE_STEP(15) PHASE_STEP(16) PHASE_STEP(17) PHASE_STEP(18) PHASE_STEP(19)
    static_assert(NPHASE == 20, "phase list");
}

extern "C" void kernel_launch(void* const* d_in, const int* in_sizes, int n_in, void* d_out, int out_size, void* d_ws, size_t ws_size, hipStream_t stream) {
    static int grid_blocks = 0;
    if (grid_blocks == 0) {
        if (n_in != 38 || out_size != TL * D || ws_size < WS_END) { fprintf(stderr, "kernel_launch: unexpected shapes (n_in %d out %d ws %zu need %zu)\n", n_in, out_size, ws_size, (size_t)WS_END); grid_blocks = -1; return; }
        int dev = 0, cus = 0, per_cu = 0;
        hipGetDevice(&dev);
        hipDeviceGetAttribute(&cus, hipDeviceAttributeMultiprocessorCount, dev);
        hipFuncSetAttribute((const void*)mega, hipFuncAttributeMaxDynamicSharedMemorySize, LDS_BYTES);
        hipOccupancyMaxActiveBlocksPerMultiprocessor(&per_cu, (const void*)mega, NT, LDS_BYTES);
        if (per_cu < 1) { fprintf(stderr, "kernel_launch: occupancy query says 0 blocks per CU\n"); grid_blocks = -1; return; }
        grid_blocks = cus;
    }
    if (grid_blocks < 0) return;
    if (hipMemsetAsync((char*)d_ws + WS_CTL, 0, CTL_BYTES, stream) != hipSuccess) { fprintf(stderr, "kernel_launch: memset failed\n"); return; }
    Params p{};
    for (int i = 0; i < 38; ++i) p.in[i] = (const float*)d_in[i];
    p.out = (float*)d_out; p.ws = (unsigned char*)d_ws; p.ph_lo = 0; p.ph_hi = NPHASE;
    void* args[] = {&p};
    hipError_t e = hipLaunchCooperativeKernel((const void*)mega, dim3(grid_blocks), dim3(NT), args, LDS_BYTES, stream);
    if (e != hipSuccess) fprintf(stderr, "cooperative launch failed: %s (grid %d)\n", hipGetErrorString(e), grid_blocks);
}
#endif
```

```cpp
#ifdef EMU
#include "gpuemu.h"
#else
#include <hip/hip_runtime.h>
#include <hip/hip_cooperative_groups.h>
#include <cstdio>
namespace cg = cooperative_groups;
#endif
#include <stdint.h>

#ifndef CFG_B
#define CFG_B 4
#endif
#ifndef CFG_SEQ
#define CFG_SEQ 4096
#endif
#ifndef CFG_CTX
#define CFG_CTX 256
#endif

#ifdef EMU
#define NT_LOAD(T, p) (*(const T*)(p))
#else
#define NT_LOAD(T, p) __builtin_nontemporal_load((const T*)(p))
#endif
typedef _Float16 half_t;
typedef _Float16 half8 __attribute__((ext_vector_type(8)));
typedef _Float16 half4 __attribute__((ext_vector_type(4)));
typedef float f32x4 __attribute__((ext_vector_type(4)));
struct cplx { float x, y; };

constexpr int D = 1024, NB = CFG_B, SEQ = CFG_SEQ, CTXL = CFG_CTX, GW = 64, GROWS = SEQ / GW;
constexpr int TL = NB * SEQ, TC = NB * CTXL, TT = TL + TC;
constexpr int NIN = 3364, NINP = 3584;
constexpr int UW = 2560;
constexpr int UGW = 36;
constexpr int NT = 512;
constexpr int TWN = 2 * SEQ > 2 * CTXL ? 2 * SEQ : 2 * CTXL;
constexpr int NMOD = 6 * D;
constexpr int LCAP = TT;
constexpr float EPSF = 1e-6f;

constexpr size_t al256(size_t x) { return (x + 255) / 256 * 256; }
constexpr size_t WS_CTL    = 0;
constexpr size_t WS_MOD    = 65536;
constexpr size_t WS_TW     = WS_MOD + al256(sizeof(float) * 2 * 5 * NMOD);
constexpr size_t WS_WIN    = WS_TW + al256(sizeof(cplx) * TWN);
constexpr size_t WS_WOUT   = WS_WIN + al256(2ull * 2 * NINP * D);
constexpr size_t WS_WMOE   = WS_WOUT + al256(2ull * 2 * D * D);
constexpr size_t WS_XC     = WS_WMOE + al256(2ull * 32 * 3 * 262144);
constexpr size_t WS_XN     = WS_XC + al256(4ull * TC * D);
constexpr size_t WS_U16    = WS_XN + al256(2ull * TT * D);
constexpr size_t WS_UG     = WS_U16 + al256(2ull * TT * UW);
constexpr size_t WS_HYT    = WS_UG + al256(4ull * TT * UGW);
constexpr size_t WS_YF     = WS_HYT + al256(2ull * NB * 768 * (SEQ + CTXL));
constexpr size_t WS_YHT    = WS_YF + al256(2ull * 4 * TT * 384);
constexpr size_t WS_FT     = WS_YHT + al256(4ull * NB * 256 * (SEQ + CTXL));
constexpr size_t WS_LIST   = WS_FT + al256(4ull * (2 * 256 * 4 * SEQ + 256 * 4 * CTXL));
constexpr size_t WS_PW     = WS_LIST + al256(4ull * 64 * LCAP);
constexpr size_t WS_WR     = WS_PW + al256(4ull * TT * 2);
constexpr size_t WS_HALO   = WS_WR + al256(2ull * 2 * 2 * 48 * D);
constexpr size_t WS_END    = WS_HALO + al256(2ull * (TT / 16) * 2 * 1408);
static_assert(4ull * NB * 256 * (SEQ + CTXL) <= 2ull * TT * D, "Z1 scratch must fit in the XN region");
static_assert(2ull * TT * 2 * 256 <= 2ull * TT * UW, "HID must fit in the U16 region");
constexpr size_t XAB_OFF = 2ull * TT * 2 * 256;
static_assert(XAB_OFF + 2ull * 2 * TT * D <= 2ull * TT * UW, "HID + XA + XB must fit in the U16 region");

constexpr int CW_CNT = 8192;
constexpr int CSTR = 64;
constexpr int CW_QUE = 256;
constexpr int CW_BAR = 1024;
constexpr size_t CTL_BYTES = 65536;

constexpr int LDS_BYTES = 156 * 1024;

struct Params {
    const float* in[38];
    float* out;
    unsigned char* ws;
    int ph_lo, ph_hi;
};

enum { I_X = 0, I_C, I_CTX, I_CCTX, I_WMOD, I_BMOD, I_N1W, I_N2W, I_WIN, I_WOUT, I_SCW, I_SCB, I_DTB, I_ALOG, I_SD, I_SNW,
       I_HCW, I_HCB, I_HW1, I_HB1, I_HW2, I_HB2, I_HW3, I_HFREQ, I_HDEC, I_HSKIP, I_MCW, I_MCB, I_MGB, I_MNW,
       I_GRW, I_GRB, I_ERW, I_ERB, I_MG, I_MU, I_MD, I_FNW };

__device__ __forceinline__ float siluf(float x) { return x / (1.0f + expf(-x)); }
__device__ __forceinline__ float sigmoidf_(float x) { return 1.0f / (1.0f + expf(-x)); }
__device__ __forceinline__ float softplusf_(float x) { return x > 20.f ? x : log1pf(expf(x)); }
__device__ __forceinline__ float logsigmoidf_(float x) { return fminf(x, 0.f) - log1pf(expf(-fabsf(x))); }

__device__ __forceinline__ float fsoftplus(float x) {
#ifdef EMU
    return x > 20.f ? x : log1pf(expf(x));
#else
    const float e = __expf(x);
    return x > 20.f ? x : (e < 1e-3f ? e * (1.0f - 0.5f * e) : __logf(1.0f + e));
#endif
}
__device__ __forceinline__ float flogsigmoid(float x) { return fminf(x, 0.f) - fsoftplus(-fabsf(x)); }
__device__ __forceinline__ float fexp(float x) {
#ifdef EMU
    return expf(x);
#else
    return __expf(x);
#endif
}
__device__ __forceinline__ float fsilu(float x) {
#ifdef EMU
    return x / (1.0f + expf(-x));
#else
    return __fdividef(x, 1.0f + __expf(-x));
#endif
}
__device__ __forceinline__ float wave_sum(float v) {
#pragma unroll
    for (int m = 32; m >= 1; m >>= 1) v += __shfl_xor(v, m);
    return v;
}
__device__ __forceinline__ float wave_max(float v) {
#pragma unroll
    for (int m = 32; m >= 1; m >>= 1) v = fmaxf(v, __shfl_xor(v, m));
    return v;
}
#ifndef EMU
#define DPP_F(oldv, v, ctrl, rmask) __builtin_bit_cast(float, __builtin_amdgcn_update_dpp(__builtin_bit_cast(int, (float)(oldv)), __builtin_bit_cast(int, (float)(v)), (ctrl), (rmask), 0xF, false))
#endif
__device__ __forceinline__ float wave_scan_sum(float v, int lane) {
#ifdef EMU
    for (int d = 1; d < 64; d <<= 1) { float o = __shfl_up(v, d); if (lane >= d) v += o; }
    return v;
#else
    v += DPP_F(0.f, v, 0x111, 0xF);
    v += DPP_F(0.f, v, 0x112, 0xF);
    v += DPP_F(0.f, v, 0x114, 0xF);
    v += DPP_F(0.f, v, 0x118, 0xF);
    v += DPP_F(0.f, v, 0x142, 0xA);
    v += DPP_F(0.f, v, 0x143, 0xC);
    return v;
#endif
}
__device__ __forceinline__ float wave_last(float v) {
#ifdef EMU
    return __shfl(v, 63);
#else
    return __builtin_bit_cast(float, __builtin_amdgcn_readlane(__builtin_bit_cast(int, v), 63));
#endif
}
__device__ __forceinline__ float wave_shr1(float v, float fill, int lane) {
#ifdef EMU
    float o = __shfl_up(v, 1); return lane == 0 ? fill : o;
#else
    return DPP_F(fill, v, 0x138, 0xF);
#endif
}
__device__ __forceinline__ float wave_scan_max(float v, int lane) {
#ifdef EMU
    for (int d = 1; d < 64; d <<= 1) { float o = __shfl_up(v, d); if (lane >= d) v = fmaxf(v, o); }
    return v;
#else
    const float NI = -3.0e38f;
    v = fmaxf(v, DPP_F(NI, v, 0x111, 0xF));
    v = fmaxf(v, DPP_F(NI, v, 0x112, 0xF));
    v = fmaxf(v, DPP_F(NI, v, 0x114, 0xF));
    v = fmaxf(v, DPP_F(NI, v, 0x118, 0xF));
    v = fmaxf(v, DPP_F(NI, v, 0x142, 0xA));
    v = fmaxf(v, DPP_F(NI, v, 0x143, 0xC));
    return v;
#endif
}

template <int MT, int NTL>
__device__ __forceinline__ void mma_lds(f32x4 (&acc)[MT][NTL], const half_t* A, int lda, const half_t* B, int ldb, int ksteps, int lane) {
#ifndef EMU
    const int r = lane & 15, kq = (lane >> 4) * 8;
    for (int ks = 0; ks < ksteps; ++ks) {
        half8 a[MT], b[NTL];
#pragma unroll
        for (int mt = 0; mt < MT; ++mt) a[mt] = *(const half8*)(A + (mt * 16 + r) * lda + ks * 32 + kq);
#pragma unroll
        for (int nt = 0; nt < NTL; ++nt) b[nt] = *(const half8*)(B + (nt * 16 + r) * ldb + ks * 32 + kq);
#pragma unroll
        for (int mt = 0; mt < MT; ++mt)
#pragma unroll
            for (int nt = 0; nt < NTL; ++nt) acc[mt][nt] = __builtin_amdgcn_mfma_f32_16x16x32_f16(a[mt], b[nt], acc[mt][nt], 0, 0, 0);
    }
#else
    for (int mt = 0; mt < MT; ++mt) for (int nt = 0; nt < NTL; ++nt) for (int i = 0; i < 4; ++i) {
        const int row = mt * 16 + (lane >> 4) * 4 + i, col = nt * 16 + (lane & 15);
        float s = acc[mt][nt][i];
        for (int k = 0; k < ksteps * 32; ++k) s += (float)A[row * lda + k] * (float)B[col * ldb + k];
        acc[mt][nt][i] = s;
    }
#endif
}

__device__ __forceinline__ f32x4 mfma16(half8 a, half8 b, f32x4 c) {
#ifdef EMU
    return emu_mfma16(a, b, c);
#else
    return __builtin_amdgcn_mfma_f32_16x16x32_f16(a, b, c, 0, 0, 0);
#endif
}
template <int MT, int NTL> __device__ __forceinline__ void zero_acc(f32x4 (&acc)[MT][NTL]) {
#pragma unroll
    for (int mt = 0; mt < MT; ++mt)
#pragma unroll
        for (int nt = 0; nt < NTL; ++nt) acc[mt][nt] = (f32x4){0.f, 0.f, 0.f, 0.f};
}

__device__ __forceinline__ void load_taps4(const float* cw, const float* cb, int C, int ch, int dir, f32x4& w0, f32x4& w1, f32x4& w2, f32x4& wb) {
    w0 = *(const f32x4*)(cw + (dir ? 2 : 0) * C + ch); w1 = *(const f32x4*)(cw + C + ch); w2 = *(const f32x4*)(cw + (dir ? 0 : 2) * C + ch); wb = *(const f32x4*)(cb + ch);
}
#ifdef EMU
#define LOADER_FENCE()
#else
#define LOADER_FENCE() asm volatile("" ::: "memory")
#endif
#define CONV4(k, i) (w0[i] * (float)rr[k][hh * 4 + i] + w1[i] * (float)rr[(k) + 1][hh * 4 + i] + w2[i] * (float)rr[(k) + 2][hh * 4 + i] + wb[i])
__device__ __forceinline__ half4 to_half4(const f32x4 v) { half4 h; h[0] = (half_t)v[0]; h[1] = (half_t)v[1]; h[2] = (half_t)v[2]; h[3] = (half_t)v[3]; return h; }
namespace g8 {
constexpr int BM = 256, BK = 64, HALF = 128, HTB = HALF * BK * 2, STAGE_BYTES = 8 * HTB;
__device__ __forceinline__ int lds_byte(int r, int c) { const int st = (r >> 4) * 2 + (c >> 5), rr = r & 15, cc = c & 31, ob = rr * 64 + cc * 2; return st * 1024 + (ob ^ (((ob >> 9) & 1) << 5)); }
__device__ __forceinline__ int perm32(int rho) { const int n = rho >> 4, i = rho & 15; return 8 * (i >> 2) + 4 * n + (i & 3); }
__device__ __forceinline__ void stage_rc(int b, int& R, int& C) { const int st = b / 1024, sb = b % 1024, swz = sb ^ (((sb >> 9) & 1) << 5); R = (st >> 1) * 16 + swz / 64; C = (st & 1) * 32 + (swz % 64) / 2; }
struct Unit { int pm, pn, e, n, c0; };

struct DenseSched {
    const char* abase; const char* bbase; int K, nM, nN, G, c;
    __device__ __forceinline__ bool next(int i, Unit& u) const {
        const int nwg = nM * nN; const long L = (long)i * G + c; if (L >= nwg) return false;
        int wgid = (int)L; { const int q = nwg / 8, r = nwg % 8, xcd = wgid % 8, off = wgid / 8; wgid = (xcd < r ? xcd * (q + 1) : r * (q + 1) + (xcd - r) * q) + off; }
        const int nig = 8 * nN, gid = wgid / nig, fm = gid * 8, gsz = (nM - fm) < 8 ? (nM - fm) : 8;
        u.pm = fm + ((wgid % nig) % gsz); u.pn = (wgid % nig) / gsz; u.e = 0; u.n = 0; u.c0 = 0; return true;
    }
    __device__ __forceinline__ unsigned a_off(const Unit& u, int r) const { return (unsigned)((size_t)(u.pm * 256 + r) * K * 2); }
    __device__ __forceinline__ const char* b_half(const Unit& u, int h) const { return bbase + (size_t)(u.pn * 256 + h * 128) * K * 2; }
};

template <class Epi, class Sched>
__device__ __forceinline__ void gemm_phase(unsigned char* smem, const int K, const Sched& S, const Epi& E) {
    const int tid = threadIdx.x, lane = tid & 63;
#ifdef EMU
    const int wid = tid >> 6, wr = wid >> 2, wc = wid & 3, fr = lane & 15, fq = lane >> 4;
    half_t* As = (half_t*)smem; half_t* Bs = As + 256 * 72;
    Unit cur;
    for (int ui = 0; S.next(ui, cur); ++ui) {
        f32x4 acc[2][2][4][2];
        for (int a = 0; a < 2; ++a) for (int b = 0; b < 2; ++b) for (int m = 0; m < 4; ++m) for (int n = 0; n < 2; ++n) acc[a][b][m][n] = (f32x4){0.f, 0.f, 0.f, 0.f};
        for (int kt = 0; kt < K / 64; ++kt) {
            { const int row = tid >> 1, c0 = (tid & 1) * 32;
              const half_t* sa = (const half_t*)(S.abase + S.a_off(cur, row)) + kt * 64 + c0;
              const half_t* sb = (const half_t*)(S.b_half(cur, row >> 7)) + (size_t)(row & 127) * K + kt * 64 + c0;
              for (int q = 0; q < 32; ++q) { As[row * 72 + c0 + q] = sa[q]; Bs[row * 72 + c0 + q] = sb[q]; } }
            __syncthreads();
            for (int a = 0; a < 2; ++a) for (int b = 0; b < 2; ++b) for (int m = 0; m < 4; ++m) for (int n = 0; n < 2; ++n) for (int i = 0; i < 4; ++i) {
                const int row = 128 * a + 64 * wr + 16 * m + fr, col = 128 * b + 32 * wc + (Epi::PERM ? 8 * fq + 4 * n + i : 16 * n + 4 * fq + i); float s = acc[a][b][m][n][i];
                for (int k = 0; k < 64; ++k) s += (float)As[row * 72 + k] * (float)Bs[col * 72 + k];
                acc[a][b][m][n][i] = s; }
            __syncthreads();
        }
        E(acc, cur, wr, wc, fr, fq);
    }
#else
    typedef __attribute__((address_space(3))) unsigned char* ldsp_t;
    const ldsp_t lds = (ldsp_t)smem;
    const int wid = __builtin_amdgcn_readfirstlane(tid >> 6), wr = wid >> 2, wc = wid & 3, fr = lane & 15, fq = lane >> 4;
    const int nt = K / BK;
    int Rr[2], Cc[2]; unsigned voffB[2];
#pragma unroll
    for (int i = 0; i < 2; ++i) { stage_rc(tid * 16 + i * 8192, Rr[i], Cc[i]); const int Rb = Epi::PERM ? ((Rr[i] & ~31) + perm32(Rr[i] & 31)) : Rr[i]; voffB[i] = (unsigned)(Rb * K + Cc[i]) * 2u; }
    const size_t kstep = (size_t)(BK * 2);
    const unsigned ldsw = (unsigned)wid * 1024u;
    const int aoffl = lds_byte(wr * 64 + fr, fq * 8), boffl = lds_byte(wc * 32 + fr, fq * 8);
#define G8_SA(b, h) (((b) * 2 + (h)) * HTB)
#define G8_SB(b, h) ((4 + (b) * 2 + (h)) * HTB)
#define G8_STAGE(bufoff, gbase, voff) do { _Pragma("unroll") for (int _i = 0; _i < 2; ++_i) \
        __builtin_amdgcn_global_load_lds((const unsigned*)((const char*)(gbase) + (voff)[_i]), (__attribute__((address_space(3))) unsigned*)(lds + (bufoff) + ldsw + _i * 8192), 16, 0, 0); } while (0)
#define G8_LDA(dst, b, h) do { _Pragma("unroll") for (int m = 0; m < 4; ++m) _Pragma("unroll") for (int k = 0; k < 2; ++k) dst[m][k] = *(const __attribute__((address_space(3))) half8*)(lds + G8_SA(b, h) + aoffl + m * 2048 + k * 1024); } while (0)
#define G8_LDB(dst, b, h) do { _Pragma("unroll") for (int n = 0; n < 2; ++n) _Pragma("unroll") for (int k = 0; k < 2; ++k) dst[n][k] = *(const __attribute__((address_space(3))) half8*)(lds + G8_SB(b, h) + boffl + n * 2048 + k * 1024); } while (0)
#define G8_MMA(ai, bj, At, Bt) do { __builtin_amdgcn_s_setprio(1); _Pragma("unroll") for (int m = 0; m < 4; ++m) _Pragma("unroll") for (int n = 0; n < 2; ++n) _Pragma("unroll") for (int k = 0; k < 2; ++k) \
        acc[ai][bj][m][n] = __builtin_amdgcn_mfma_f32_16x16x32_f16(Bt[n][k], At[m][k], acc[ai][bj][m][n], 0, 0, 0); __builtin_amdgcn_s_setprio(0); } while (0)
#define G8_WAIT_V(n) asm volatile("s_waitcnt vmcnt(" #n ")" ::: "memory")
#define G8_WAIT_L(n) asm volatile("s_waitcnt lgkmcnt(" #n ")" ::: "memory")
#define G8_BAR __builtin_amdgcn_s_barrier()
#define G8_SCHED __builtin_amdgcn_sched_barrier(0)
#define G8_AOFF(dst, u) do { _Pragma("unroll") for (int _h = 0; _h < 2; ++_h) _Pragma("unroll") for (int _i = 0; _i < 2; ++_i) dst[_h][_i] = S.a_off(u, _h * 128 + Rr[_i]) + (unsigned)Cc[_i] * 2u; } while (0)
    Unit cur, nxt; int ui = 0;
    if (!S.next(0, cur)) return;
    f32x4 acc[2][2][4][2];
#pragma unroll
    for (int a = 0; a < 2; ++a)
#pragma unroll
        for (int b = 0; b < 2; ++b)
#pragma unroll
            for (int m = 0; m < 4; ++m)
#pragma unroll
                for (int n = 0; n < 2; ++n) acc[a][b][m][n] = (f32x4){0.f, 0.f, 0.f, 0.f};
    half8 At[4][2], B0[2][2], B1[2][2];
    unsigned caoff[2][2], naoff[2][2];
    G8_AOFF(caoff, cur);
    const char* cA = S.abase; const char* cB0 = S.b_half(cur, 0); const char* cB1 = S.b_half(cur, 1);
    G8_STAGE(G8_SB(0, 0), cB0, voffB); G8_STAGE(G8_SA(0, 0), cA, caoff[0]); G8_STAGE(G8_SB(0, 1), cB1, voffB); G8_STAGE(G8_SA(0, 1), cA, caoff[1]);
    if (wr == 1) G8_BAR;
    G8_WAIT_V(4); G8_BAR;
    G8_STAGE(G8_SB(1, 0), cB0 + kstep, voffB); G8_STAGE(G8_SA(1, 0), cA + kstep, caoff[0]); G8_STAGE(G8_SB(1, 1), cB1 + kstep, voffB);
    G8_WAIT_V(6); G8_BAR;
    for (;;) {
        const bool has_next = S.next(ui + 1, nxt);
        if (!has_next) nxt = cur;
        G8_AOFF(naoff, nxt);
        const char* nB0 = S.b_half(nxt, 0); const char* nB1 = S.b_half(nxt, 1);
#pragma unroll 1
        for (int t = 0; t < nt; t += 2) {
            const bool last = (t == nt - 2);
            const char* a1 = cA + (size_t)(t + 1) * kstep;
            const char* a2 = last ? cA : cA + (size_t)(t + 2) * kstep;
            const char* b20 = last ? nB0 : cB0 + (size_t)(t + 2) * kstep; const char* b21 = last ? nB1 : cB1 + (size_t)(t + 2) * kstep;
            const char* a3 = a2 + kstep; const char* b30 = b20 + kstep; const char* b31 = b21 + kstep;
            unsigned xoff[2][2];
#pragma unroll
            for (int h = 0; h < 2; ++h)
#pragma unroll
                for (int i = 0; i < 2; ++i) xoff[h][i] = last ? naoff[h][i] : caoff[h][i];
            G8_LDB(B0, 0, 0); G8_SCHED; G8_LDA(At, 0, 0); G8_STAGE(G8_SA(1, 1), a1, caoff[1]);
            G8_WAIT_L(8); G8_BAR; G8_WAIT_L(0); G8_MMA(0, 0, At, B0); G8_BAR; G8_SCHED;
            G8_LDB(B1, 0, 1); G8_STAGE(G8_SB(0, 0), b20, voffB);
            G8_BAR; G8_WAIT_L(0); G8_MMA(0, 1, At, B1); G8_BAR;
            G8_LDA(At, 0, 1); G8_STAGE(G8_SA(0, 0), a2, xoff[0]);
            G8_BAR; G8_WAIT_L(0); G8_MMA(1, 0, At, B0); G8_BAR; G8_SCHED;
            G8_STAGE(G8_SB(0, 1), b21, voffB);
            G8_WAIT_V(6); G8_BAR; G8_MMA(1, 1, At, B1); G8_BAR;
            G8_LDB(B0, 1, 0); G8_SCHED; G8_LDA(At, 1, 0); G8_STAGE(G8_SA(0, 1), a2, xoff[1]);
            G8_WAIT_L(8); G8_BAR; G8_WAIT_L(0); G8_MMA(0, 0, At, B0); G8_BAR; G8_SCHED;
            G8_LDB(B1, 1, 1); G8_STAGE(G8_SB(1, 0), b30, voffB);
            G8_BAR; G8_WAIT_L(0); G8_MMA(0, 1, At, B1); G8_BAR;
            G8_LDA(At, 1, 1); G8_STAGE(G8_SA(1, 0), a3, xoff[0]);
            G8_BAR; G8_WAIT_L(0); G8_MMA(1, 0, At, B0); G8_BAR; G8_SCHED;
            G8_STAGE(G8_SB(1, 1), b31, voffB);
            G8_WAIT_V(6); G8_BAR; G8_MMA(1, 1, At, B1); G8_BAR;
        }
        E(acc, cur, wr, wc, fr, fq);
        if (!has_next) break;
#pragma unroll
        for (int a = 0; a < 2; ++a)
#pragma unroll
            for (int b = 0; b < 2; ++b)
#pragma unroll
                for (int m = 0; m < 4; ++m)
#pragma unroll
                    for (int n = 0; n < 2; ++n) acc[a][b][m][n] = (f32x4){0.f, 0.f, 0.f, 0.f};
        cur = nxt; cB0 = nB0; cB1 = nB1; ++ui;
#pragma unroll
        for (int h = 0; h < 2; ++h)
#pragma unroll
            for (int i = 0; i < 2; ++i) caoff[h][i] = naoff[h][i];
    }
    G8_WAIT_V(0);
    if (wr == 0) G8_BAR;
    G8_BAR;
#undef G8_SA
#undef G8_SB
#undef G8_STAGE
#undef G8_LDA
#undef G8_LDB
#undef G8_MMA
#undef G8_WAIT_V
#undef G8_WAIT_L
#undef G8_BAR
#undef G8_SCHED
#undef G8_AOFF
#endif
}
}

#ifdef EMU
typedef const Params* ParamsPtr;
#else
typedef const __attribute__((address_space(4))) Params* ParamsPtr;
#endif
struct Frame {
    ParamsPtr P; unsigned char* ws; unsigned char* smem; int tid, lane, wave;
    __device__ __forceinline__ const float* in(int i) const { return P->in[i]; }
    __device__ __forceinline__ float* xrow(int row) const { return row < TL ? P->out + (size_t)row * D : (float*)(ws + WS_XC) + (size_t)(row - TL) * D; }
    __device__ __forceinline__ const float* xrow_in(int layer, int row) const {
        if (layer == 0) return row < TL ? in(I_X) + (size_t)row * D : in(I_CTX) + (size_t)(row - TL) * D;
        return xrow(row);
    }
};
__device__ __forceinline__ int row_mod(int row) { return row < TL ? row / SEQ : NB; }
__device__ __forceinline__ const float* modp(const Frame& F, int layer, int m, int chunk) { return (const float*)(F.ws + WS_MOD) + ((size_t)(layer * 5 + m) * 6 + chunk) * D; }


#ifndef EMU
#define XB_TMO      128
#define XB_XCNT(j)  (256  + 64 * (j))
#define XB_XSUB(j)  (1280 + 64 * (j))
#define XB_XGEN(j)  (2304 + 64 * (j))
#define XB_TOP      3328
#define XB_TOPGEN   3392
#define XCD_BAR_WORDS 3456
#define XB_SPIN_CAP (1u << 26)
#define LAS __attribute__((address_space(3)))
static_assert((CW_BAR + XCD_BAR_WORDS) * 4 <= CTL_BYTES, "control region");
__device__ __forceinline__ unsigned xb_ld(unsigned* p)              { return __hip_atomic_load(p, __ATOMIC_RELAXED, __HIP_MEMORY_SCOPE_AGENT); }
__device__ __forceinline__ unsigned xb_add(unsigned* p, unsigned v) { return __hip_atomic_fetch_add(p, v, __ATOMIC_RELAXED, __HIP_MEMORY_SCOPE_AGENT); }
__device__ __forceinline__ unsigned xb_xcc_id() { return (unsigned)__builtin_amdgcn_s_getreg((3 << 11) | 20) & 0xFu; }
#define XB_SPIN(cond, bar) do { unsigned _sp = 0; while (cond) { \
    if ((++_sp & 255u) == 0u) { if (xb_ld(&(bar)[XB_TMO])) break; if (_sp > XB_SPIN_CAP) { atomicAdd(&(bar)[XB_TMO], 1u); break; } } } } while (0)
struct XcdBarrier { unsigned* bar; unsigned x; volatile LAS unsigned* st; };
__device__ __forceinline__ XcdBarrier xcd_barrier_post(unsigned* bar, volatile LAS unsigned* st) {
    XcdBarrier b; b.bar = bar; b.x = xb_xcc_id(); b.st = st;
    if (threadIdx.x == 0) (void)xb_add(&bar[XB_XCNT(b.x)], 1u);
    return b;
}
__device__ __forceinline__ void xcd_barrier_complete(unsigned* bar, unsigned x, unsigned& nloc, unsigned& nx) {
    const unsigned G = gridDim.x * gridDim.y * gridDim.z;
    unsigned sum, cnt, mine, sp = 0u;
    for (;;) {
        sum = 0u; cnt = 0u; mine = 0u;
#pragma unroll
        for (unsigned j = 0; j < 16; ++j) { const unsigned c = xb_ld(&bar[XB_XCNT(j)]); sum += c; cnt += (c > 0u) ? 1u : 0u; mine = (j == x) ? c : mine; }
        if (sum == G) break;
        __builtin_amdgcn_s_sleep(1);
        if ((++sp & 255u) == 0u) { if (xb_ld(&bar[XB_TMO])) break; if (sp > XB_SPIN_CAP) { atomicAdd(&bar[XB_TMO], 1u); break; } }
    }
    nloc = mine > 0u ? mine : 1u; nx = cnt > 0u ? cnt : 1u;
}
__device__ __forceinline__ void xcd_barrier(const XcdBarrier& b) {
    asm volatile("s_waitcnt vmcnt(0)" ::: "memory");
    __syncthreads();
    if (threadIdx.x == 0) {
        unsigned* bar = b.bar;
        __builtin_amdgcn_s_waitcnt(0);
        unsigned nloc = b.st[0], nx = b.st[1];
        if (nloc == 0u) { xcd_barrier_complete(bar, b.x, nloc, nx); b.st[0] = nloc; b.st[1] = nx; }
        const unsigned old = xb_add(&bar[XB_XSUB(b.x)], 1u);
        const unsigned gen = old / nloc;
        if (old + 1u == (gen + 1u) * nloc) {
            __builtin_amdgcn_fence(__ATOMIC_RELEASE, "agent");
            asm volatile("s_waitcnt vmcnt(0)" ::: "memory");
            const unsigned og = xb_add(&bar[XB_TOP], 1u);
            const unsigned tg = og / nx;
            if (og + 1u == (tg + 1u) * nx) {
#pragma unroll
                for (unsigned j = 0; j < 16; ++j) (void)xb_add(&bar[XB_XGEN(j)], 1u);
            }
        }
        XB_SPIN(xb_ld(&bar[XB_XGEN(b.x)]) == gen, bar);
        __builtin_amdgcn_fence(__ATOMIC_ACQUIRE, "agent");
        asm volatile("s_waitcnt vmcnt(0)" ::: "memory");
    }
    __syncthreads();
}
#endif

__device__ __forceinline__ void item_twiddle(const Frame& F, int it) {
    cplx* tw = (cplx*)(F.ws + WS_TW);
    const int k = it * NT + F.tid;
    if (k < TWN) { float s, c; const float a = -6.283185307179586f * (float)k / (float)TWN; s = sinf(a); c = cosf(a); tw[k].x = c; tw[k].y = s; }
}
__device__ __forceinline__ void item_mod(const Frame& F, int it) {
    const int layer = it / (NMOD / 64), n0 = (it % (NMOD / 64)) * 64;
    float* sc = (float*)F.smem;
    float* red = sc + 5 * D;
    for (int i = F.tid; i < 5 * D; i += NT) { const int m = i / D, k = i % D; const float v = m < NB ? F.in(I_C)[m * D + k] : F.in(I_CCTX)[k]; sc[i] = siluf(v); }
    __syncthreads();
    const int j = F.tid & 63, ks = F.tid >> 6;
    const float* w = F.in(I_WMOD) + (size_t)layer * D * NMOD + n0 + j;
    float a[5] = {0, 0, 0, 0, 0};
#pragma unroll 1
    for (int k0 = ks * 128; k0 < ks * 128 + 128; k0 += 64) {
        float wv[64];
#pragma unroll
        for (int q = 0; q < 64; ++q) wv[q] = NT_LOAD(float, w + (size_t)(k0 + q) * NMOD);
#pragma unroll
        for (int q = 0; q < 64; ++q)
#pragma unroll
            for (int m = 0; m < 5; ++m) a[m] += sc[m * D + k0 + q] * wv[q]; }
#pragma unroll
    for (int m = 0; m < 5; ++m) red[(ks * 5 + m) * 64 + j] = a[m];
    __syncthreads();
    if (F.tid < 5 * 64) { const int m = F.tid / 64, jj = F.tid % 64; float s = 0; for (int q = 0; q < 8; ++q) s += red[(q * 5 + m) * 64 + jj];
        ((float*)(F.ws + WS_MOD))[(size_t)(layer * 5 + m) * NMOD + n0 + jj] = s + F.in(I_BMOD)[layer * NMOD + n0 + jj]; }
    __syncthreads();
}
#ifdef EMU
#define SCHED_FENCE()
#else
#define SCHED_FENCE() __builtin_amdgcn_sched_barrier(0)
#endif
#ifdef EMU
#define OPAQUE_T(x)
#else
#define OPAQUE_T(x) asm volatile("" : "+v"(x))
#endif
template <int NP>
__device__ __forceinline__ void item_filter(const Frame& F, int layer, int isctx, int tb) {
    int tid = F.tid; OPAQUE_T(tid);
    const int L = isctx ? CTXL : SEQ;
    float* feats = (float*)F.smem;
    float* h1 = feats + 32 * 33;
    float* h2 = h1 + 32 * 64;
    const int t0 = tb * NP;
    for (int i = tid; i < NP * 33; i += NT) {
        const int tt = i / 33, f = i % 33; const float t = (float)(t0 + tt);
        float v;
        if (f == 0) v = t / (float)(L - 1 > 1 ? L - 1 : 1);
        else { const int bi = (f - 1) & 15; const float band = 1e-4f + (float)bi * ((15.0f - 1e-4f) / 15.0f);
               const float ang = (6.283185307179586f / (float)L) * t * band; v = (f <= 16) ? cosf(ang) : -sinf(ang); }
        feats[i] = v;
    }
    __syncthreads();
    const float* w1 = F.in(I_HW1) + layer * 33 * 64; const float* b1 = F.in(I_HB1) + layer * 64;
    const float* w2 = F.in(I_HW2) + layer * 64 * 64; const float* b2 = F.in(I_HB2) + layer * 64;
    const float* fr = F.in(I_HFREQ) + layer * 64;
    const int j = tid & 63, tq = tid >> 6;
    const float fj = fr[j];
    { float wc[33];
#pragma unroll
      for (int k = 0; k < 33; ++k) wc[k] = w1[k * 64 + j];
      const float bj = b1[j];
#pragma unroll 1
      for (int q = 0; q < NP / 8; ++q) { const int tt = tq + 8 * q; float s = bj;
#pragma unroll
          for (int k = 0; k < 33; ++k) s += feats[tt * 33 + k] * wc[k];
          h1[tt * 64 + j] = sinf(fj * s); } }
    __syncthreads();
    { float wc[64];
#pragma unroll
      for (int k = 0; k < 64; ++k) wc[k] = w2[k * 64 + j];
      const float bj = b2[j];
#pragma unroll 1
      for (int q = 0; q < NP / 8; ++q) { const int tt = tq + 8 * q; float s = bj;
#pragma unroll
          for (int k4 = 0; k4 < 16; ++k4) { const f32x4 hv = *(const f32x4*)(h1 + tt * 64 + k4 * 4);
#pragma unroll
              for (int e = 0; e < 4; ++e) s += hv[e] * wc[k4 * 4 + e]; }
          h2[j * NP + tt] = sinf(fj * s); } }
    __syncthreads();
    const float* w3 = F.in(I_HW3) + (size_t)layer * 64 * 1024;
    const int c0 = tid * 2;
    float* ft = (float*)(F.ws + WS_FT) + (isctx ? (size_t)2 * 256 * 4 * SEQ : (size_t)layer * 256 * 4 * SEQ);
    const float tinv = 1.0f / (float)(L - 1 > 1 ? L - 1 : 1);
#pragma unroll 1
    for (int hf = 0; hf < NP / 16; ++hf) {
        float acc[16][2];
#pragma unroll
        for (int tt = 0; tt < 16; ++tt) { acc[tt][0] = 0.f; acc[tt][1] = 0.f; }
#pragma unroll 1
        for (int kb = 0; kb < 64; kb += 16) {
            float wa[16], wb[16];
#pragma unroll
            for (int q = 0; q < 16; ++q) { wa[q] = w3[(kb + q) * 1024 + c0]; wb[q] = w3[(kb + q) * 1024 + c0 + 1]; }
#pragma unroll
            for (int q = 0; q < 16; ++q)
#pragma unroll
                for (int t4 = 0; t4 < 4; ++t4) { const f32x4 hv = *(const f32x4*)(h2 + (kb + q) * NP + hf * 16 + t4 * 4);
#pragma unroll
                    for (int e = 0; e < 4; ++e) { acc[t4 * 4 + e][0] += hv[e] * wa[q]; acc[t4 * 4 + e][1] += hv[e] * wb[q]; } }
        }
#pragma unroll
        for (int q = 0; q < 2; ++q) {
            const int col = c0 + q, dir = col >> 9, order = (col >> 8) & 1, c = col & 255;
            const float dec = fabsf(F.in(I_HDEC)[((layer * 2 + dir) * 2 + order) * 256 + c]);
            float* dst = ft + ((size_t)(c * 2 + order) * 2 + dir) * L + t0 + hf * 16;
#pragma unroll
            for (int t4 = 0; t4 < 4; ++t4) { f32x4 o;
#pragma unroll
                for (int e = 0; e < 4; ++e) { const float tu = (float)(t0 + hf * 16 + t4 * 4 + e) * tinv; o[e] = acc[t4 * 4 + e][q] * expf(-tu * dec); }
                *(f32x4*)(dst + t4 * 4) = o; }
        }
    }
    __syncthreads();
}
__device__ __forceinline__ int inproj_src_col(int j) { return j < 1024 ? j : (j < 3328 ? j + 12 : (j < 3340 ? j - 2304 : (j < NIN ? j : -1))); }
__device__ __forceinline__ void item_transpose(const Frame& F, const float* src, int ldn, int nvalid, half_t* dst, int K, int k0, int n0, int inmap = 0) {
    float* tile = (float*)F.smem;
    f32x4 v[8];
#pragma unroll
    for (int q = 0; q < 8; ++q) { const int i = F.tid + q * NT, r = i >> 6, c4 = (i & 63) * 4;
        if (inmap) { const int sc = inproj_src_col(n0 + c4); v[q] = sc >= 0 ? NT_LOAD(f32x4, src + (size_t)(k0 + r) * ldn + sc) : (f32x4){0.f, 0.f, 0.f, 0.f}; }
        else if (n0 + c4 + 3 < nvalid) v[q] = NT_LOAD(f32x4, src + (size_t)(k0 + r) * ldn + n0 + c4);
        else {
#pragma unroll
            for (int e = 0; e < 4; ++e) v[q][e] = (n0 + c4 + e < nvalid) ? src[(size_t)(k0 + r) * ldn + n0 + c4 + e] : 0.f; } }
#pragma unroll
    for (int q = 0; q < 8; ++q) { const int i = F.tid + q * NT, r = i >> 6, c4 = (i & 63) * 4; *(f32x4*)(tile + r * 260 + c4) = v[q]; }
    __syncthreads();
#pragma unroll
    for (int q = 0; q < 4; ++q) { const int i = F.tid + q * NT, n = i >> 3, kc = (i & 7) * 8; half8 h;
#pragma unroll
        for (int e = 0; e < 8; ++e) h[e] = (half_t)tile[(kc + e) * 260 + n];
        *(half8*)(dst + (size_t)(n0 + n) * K + k0 + kc) = h; }
    __syncthreads();
}
__device__ __forceinline__ void item_router_w(const Frame& F, int it) {
    const int layer = it >> 5, k0 = (it & 31) * 32;
    half_t* dst = (half_t*)(F.ws + WS_WR) + (size_t)layer * 2 * 48 * D;
#pragma unroll
    for (int q = 0; q < 2; ++q) {
        const int i = F.tid + q * NT, k = k0 + (i >> 5), c = i & 31; const float w = F.in(I_ERW)[(size_t)layer * D * 32 + (size_t)k0 * 32 + i];
        const half_t hi = (half_t)w; dst[(size_t)(4 + c) * D + k] = hi; dst[(size_t)(48 + 4 + c) * D + k] = (half_t)((w - (float)hi) * 2048.f); }
    if (F.tid < 128) {
        const int k = k0 + (F.tid >> 2), c = F.tid & 3; const float w = F.in(I_GRW)[(size_t)layer * D * 4 + (size_t)k0 * 4 + F.tid];
        const half_t hi = (half_t)w; dst[(size_t)c * D + k] = hi; dst[(size_t)(48 + c) * D + k] = (half_t)((w - (float)hi) * 2048.f); }
    if (F.tid < 12 * 32) { const int c = 36 + (F.tid >> 5), k = k0 + (F.tid & 31); dst[(size_t)c * D + k] = (half_t)0.f; dst[(size_t)(48 + c) * D + k] = (half_t)0.f; }
}
constexpr int IT_TW = (TWN + NT - 1) / NT;
constexpr int IT_MOD = 2 * (NMOD / 64);
constexpr int IT_FILT = 2 * (SEQ / 32) + (CTXL / 32);
constexpr int IT_TWIN = 2 * 16 * (NINP / 256);
constexpr int IT_TWOUT = 2 * 16 * 4;
constexpr int IT_TMOE = 32 * 48;
__device__ __forceinline__ void moe_transpose_item(const Frame& F, int layer, int it) {
    const int e = it / 48, r = it % 48, which = r / 16, t = r % 16;
    half_t* base = (half_t*)(F.ws + WS_WMOE) + (size_t)e * 3 * 262144;
    if (which < 2) {
        const float* src = F.in(which == 0 ? I_MG : I_MU) + ((size_t)layer * 32 + e) * 262144;
        item_transpose(F, src, 256, 256, base + which * 262144, 1024, t * 64, 0);
    } else {
        const float* src = F.in(I_MD) + ((size_t)layer * 32 + e) * 262144;
        item_transpose(F, src, 1024, 1024, base + 2 * 262144, 256, (t >> 2) * 64, (t & 3) * 256);
    }
}
__device__ __forceinline__ void item_twin(const Frame& F, int layer, int r) {
    item_transpose(F, F.in(I_WIN) + (size_t)layer * D * NIN, NIN, NIN, (half_t*)(F.ws + WS_WIN) + (size_t)layer * NINP * D, D, (r / (NINP / 256)) * 64, (r % (NINP / 256)) * 256, 1); }
__device__ __forceinline__ void item_twout(const Frame& F, int layer, int r) {
    item_transpose(F, F.in(I_WOUT) + (size_t)layer * D * D, D, D, (half_t*)(F.ws + WS_WOUT) + (size_t)layer * D * D, D, (r >> 2) * 64, (r & 3) * 256); }
constexpr int IT_TWIN1 = 16 * (NINP / 256), IT_TWOUT1 = 64, IT_FILT0 = SEQ / 16 + CTXL / 16;
__device__ __forceinline__ void phase_setup(const Frame& F) {
    const int G = gridDim.x, b = blockIdx.x;
    constexpr int IT_MOD0 = IT_MOD / 2;
    const int sB = (IT_MOD0 < G) ? IT_MOD0 : 0, nb = G - sB, rk = b - sB;
#define SETUP_FIRST(start) ((b + G - ((start) % G)) % G)
#define RANK_FIRST(start) ((rk + nb - ((start) % nb)) % nb)
    for (int i = b; i < IT_MOD0; i += G) item_mod(F, i);
    for (int i = SETUP_FIRST(sB); i < IT_FILT0; i += G) { if (i < SEQ / 16) item_filter<16>(F, 0, 0, i); else item_filter<16>(F, 0, 1, i - SEQ / 16); }
    if (rk >= 0) {
        for (int i = RANK_FIRST(16); i < IT_TWIN1; i += nb) item_twin(F, 0, i);
        for (int i = RANK_FIRST(80); i < IT_TWOUT1; i += nb) item_twout(F, 0, i);
        for (int i = RANK_FIRST(96); i < 64; i += nb) item_router_w(F, i);
        for (int i = RANK_FIRST(144); i < IT_TW; i += nb) item_twiddle(F, i);
    }
#undef SETUP_FIRST
#undef RANK_FIRST
}

__device__ __forceinline__ void phase_norm1(const Frame& F, int layer) {
    half_t* xn = (half_t*)(F.ws + WS_XN);
    const int lane = F.lane, nwaves = gridDim.x * (NT / 64);
    const float* nw = F.in(I_N1W) + layer * D;
    int mc = -1; f32x4 g[4], s4[4];
    int row = blockIdx.x * (NT / 64) + F.wave;
    f32x4 v[4];
    if (row < TT) { const float* x = F.xrow_in(layer, row);
#pragma unroll
        for (int q = 0; q < 4; ++q) v[q] = NT_LOAD(f32x4, x + q * 256 + lane * 4); }
    for (; row < TT; row += nwaves) {
        const int nrow = row + nwaves;
        f32x4 vn[4];
        if (nrow < TT) { const float* x = F.xrow_in(layer, nrow);
#pragma unroll
            for (int q = 0; q < 4; ++q) vn[q] = NT_LOAD(f32x4, x + q * 256 + lane * 4); }
        if (layer > 0) {
            const half_t* xa = (const half_t*)(F.ws + WS_U16 + XAB_OFF) + (size_t)row * D; const half_t* xb = xa + (size_t)TT * D; float* xw = F.xrow(row);
            const float* g5 = modp(F, layer - 1, row_mod(row), 5);
#pragma unroll
            for (int q = 0; q < 4; ++q) { const int k = q * 256 + lane * 4; const half4 a4 = *(const half4*)(xa + k), b4 = *(const half4*)(xb + k); const f32x4 gv = *(const f32x4*)(g5 + k);
#pragma unroll
                for (int e = 0; e < 4; ++e) v[q][e] += gv[e] * ((float)a4[e] + (float)b4[e]);
                *(f32x4*)(xw + k) = v[q]; } }
        const int m = row_mod(row);
        if (m != mc) { mc = m; const float* sh = modp(F, layer, m, 0); const float* scl = modp(F, layer, m, 1);
#pragma unroll
            for (int q = 0; q < 4; ++q) { const int k = q * 256 + lane * 4; const f32x4 a = *(const f32x4*)(nw + k), b = *(const f32x4*)(scl + k); s4[q] = *(const f32x4*)(sh + k);
#pragma unroll
                for (int e = 0; e < 4; ++e) g[q][e] = a[e] * (1.0f + b[e]); } }
        float ss = 0.f;
#pragma unroll
        for (int q = 0; q < 4; ++q) ss += v[q][0] * v[q][0] + v[q][1] * v[q][1] + v[q][2] * v[q][2] + v[q][3] * v[q][3];
        ss = wave_sum(ss);
        const float rs = 1.0f / sqrtf(ss * (1.0f / D) + EPSF);
        int srow = row;
        if (layer == 1 && row < TL) { const int b = row / SEQ, l = row % SEQ; srow = b * SEQ + (l % GW) * GROWS + l / GW; }
#pragma unroll
        for (int q = 0; q < 4; ++q) { const int k = q * 256 + lane * 4; half4 h;
#pragma unroll
            for (int e = 0; e < 4; ++e) h[e] = (half_t)(v[q][e] * rs * g[q][e] + s4[q][e]);
            *(half4*)(xn + (size_t)srow * D + k) = h; }
#pragma unroll
        for (int q = 0; q < 4; ++q) v[q] = vn[q];
    }
}

#ifdef EMU
#define WAVE_SYNC() emu_wave_barrier()
#else
#define WAVE_SYNC() __builtin_amdgcn_wave_barrier()
#endif
constexpr int HYTR_OFF = g8::STAGE_BYTES + 2048;
struct EpiInproj {
    static constexpr bool PERM = true;
    half_t* u16; float* ug; half_t* hyt; half_t* halo; unsigned char* smem;
    __device__ __forceinline__ void operator()(const f32x4 (&acc)[2][2][4][2], const g8::Unit& u, int wr, int wc, int fr, int fq) const {
        const int rowb = u.pm * 256 + wr * 64 + fr;
        const bool edge = (fr == 0) || (fr == 15);
        const int lane = fq * 16 + fr;
        half_t* T = (half_t*)(smem + HYTR_OFF) + (wr * 4 + wc) * (32 * 24);
#pragma unroll
        for (int bj = 0; bj < 2; ++bj) {
            const int c8 = u.pn * 256 + bj * 128 + wc * 32 + 8 * fq;
            if (c8 < 1024 || (c8 >= 1792 && c8 < 3328)) {
                const int uc = c8 < 1024 ? c8 : c8 - 768; const bool hal = edge && uc >= 384 && uc < 1792;
#pragma unroll
                for (int ai = 0; ai < 2; ++ai)
#pragma unroll
                    for (int m = 0; m < 4; ++m) { const int row = rowb + ai * 128 + m * 16; const f32x4 a0 = acc[ai][bj][m][0], a1 = acc[ai][bj][m][1]; half8 h;
                        h[0] = (half_t)a0[0]; h[1] = (half_t)a0[1]; h[2] = (half_t)a0[2]; h[3] = (half_t)a0[3]; h[4] = (half_t)a1[0]; h[5] = (half_t)a1[1]; h[6] = (half_t)a1[2]; h[7] = (half_t)a1[3];
                        *(half8*)(u16 + (size_t)row * UW + uc) = h;
                        if (hal) *(half8*)(halo + ((size_t)(row >> 4) * 2 + (fr == 15)) * 1408 + (uc - 384)) = h; }
            } else if (c8 < 1792) {
                const int chb = (c8 - 8 * fq) - 1024;
#pragma unroll
                for (int ai = 0; ai < 2; ++ai)
#pragma unroll
                    for (int m = 0; m < 4; ++m) {
                        const f32x4 a0 = acc[ai][bj][m][0], a1 = acc[ai][bj][m][1];
                        WAVE_SYNC();
#pragma unroll
                        for (int j = 0; j < 4; ++j) { T[(8 * fq + j) * 24 + fr] = (half_t)a0[j]; T[(8 * fq + 4 + j) * 24 + fr] = (half_t)a1[j]; }
                        WAVE_SYNC();
                        const int ch = lane >> 1, th = lane & 1; const half8 hv = *(const half8*)(T + ch * 24 + th * 8);
                        const int row0 = rowb - fr + ai * 128 + m * 16;
                        half_t* dst = row0 < TL ? hyt + ((size_t)(row0 / SEQ) * 768 + chb + ch) * SEQ + row0 % SEQ : hyt + (size_t)NB * 768 * SEQ + ((size_t)((row0 - TL) / CTXL) * 768 + chb + ch) * CTXL + (row0 - TL) % CTXL;
                        *(half8*)(dst + th * 8) = hv; }
            } else {
#pragma unroll
                for (int n = 0; n < 2; ++n) { const int c0 = c8 + 4 * n;
                    if (c0 < NIN) { const int gc = c0 < 3340 ? c0 - 3328 : 12 + (c0 - 3340);
#pragma unroll
                        for (int ai = 0; ai < 2; ++ai)
#pragma unroll
                            for (int m = 0; m < 4; ++m) { const int row = rowb + ai * 128 + m * 16; *(f32x4*)(ug + (size_t)row * UGW + gc) = acc[ai][bj][m][n]; } } }
            }
        }
    }
};
__device__ __forceinline__ int inproj_idle_blocks(int G) { const int nfull = ((TT / 256) * (NINP / 256)) % G; return nfull > 0 ? G - nfull : G; }
__device__ __forceinline__ void phase_inproj(const Frame& F, int layer) {
    g8::DenseSched S; S.abase = (const char*)(F.ws + WS_XN); S.bbase = (const char*)((const half_t*)(F.ws + WS_WIN) + (size_t)layer * NINP * D); S.K = D; S.nM = TT / 256; S.nN = NINP / 256; S.G = gridDim.x; S.c = blockIdx.x;
    EpiInproj E{(half_t*)(F.ws + WS_U16), (float*)(F.ws + WS_UG), (half_t*)(F.ws + WS_HYT), (half_t*)(F.ws + WS_HALO), F.smem};
    g8::gemm_phase(F.smem, D, S, E);
    const int G = gridDim.x, nfull = (S.nM * S.nN) % G;
    const int nidle = nfull > 0 ? G - nfull : G, me = nfull > 0 ? (int)blockIdx.x - nfull : (int)blockIdx.x;
    if (me >= 0) {
        __syncthreads();
        if (layer == 0) { for (int i = me; i < IT_TWIN1 + IT_TWOUT1; i += nidle) { if (i < IT_TWIN1) item_twin(F, 1, i); else item_twout(F, 1, i - IT_TWIN1); } }
        else if (me < SEQ / 32) item_filter<32>(F, 1, 0, me);
    }
}


__device__ __forceinline__ void phase_act(const Frame& F, int layer) {
    half_t* u16 = (half_t*)(F.ws + WS_U16); const half_t* halo = (const half_t*)(F.ws + WS_HALO);
    const int tid = F.tid, g = tid % 176, hf = tid / 176;
    const bool active = tid < 352;
    const bool isml = g >= 80; const int ch = isml ? (g - 80) * 8 : g * 8, C = isml ? 768 : 640;
    const float* cw = isml ? F.in(I_MCW) + layer * 3 * 768 : F.in(I_SCW) + layer * 3 * 640; const float* cb = isml ? F.in(I_MCB) + layer * 768 : F.in(I_SCB) + layer * 640;
    const float osc = (isml && ch >= 384) ? 0.125f : 1.0f;
    float w0[8], w1[8], w2[8], wb[8];
#pragma unroll
    for (int i = 0; i < 8; ++i) { const int cc = active ? ch + i : 0; w0[i] = cw[cc]; w1[i] = cw[C + cc]; w2[i] = cw[2 * C + cc]; wb[i] = cb[cc]; }
    half8 zz;
#pragma unroll
    for (int i = 0; i < 8; ++i) zz[i] = (half_t)0.f;
    const size_t col = 384 + g * 8;
    auto load_item = [&](int it, half8 (&rr)[10]) {
        const int rb = it * 16, r0 = rb + hf * 8;
        const bool isl = rb < TL; const int L = isl ? SEQ : CTXL; const int pos0 = (isl ? rb : rb - TL) % L;
#pragma unroll
        for (int k = 0; k < 8; ++k) rr[k + 1] = NT_LOAD(half8, u16 + (size_t)(r0 + k) * UW + col);
        if (hf == 0) { rr[0] = pos0 > 0 ? *(const half8*)(halo + ((size_t)(it - 1) * 2 + 1) * 1408 + g * 8) : zz; rr[9] = *(const half8*)(u16 + (size_t)(rb + 8) * UW + col); }
        else { rr[0] = *(const half8*)(u16 + (size_t)(rb + 7) * UW + col); rr[9] = pos0 + 16 < L ? *(const half8*)(halo + ((size_t)(it + 1) * 2 + 0) * 1408 + g * 8) : zz; }
    };
    int it = blockIdx.x;
    half8 rr[10];
    if (active && it < TT / 16) load_item(it, rr);
    for (; it < TT / 16; it += gridDim.x) {
        const int r0 = it * 16 + hf * 8, nit = it + gridDim.x;
        half8 rn[10];
        if (active && nit < TT / 16) load_item(nit, rn);
        half8 o[8];
        if (active) {
#pragma unroll
            for (int k = 0; k < 8; ++k)
#pragma unroll
                for (int i = 0; i < 8; ++i) o[k][i] = (half_t)(osc * fsilu(w0[i] * (float)rr[k][i] + w1[i] * (float)rr[k + 1][i] + w2[i] * (float)rr[k + 2][i] + wb[i]));
        }
        __syncthreads();
        if (active) {
#pragma unroll
            for (int k = 0; k < 8; ++k) *(half8*)(u16 + (size_t)(r0 + k) * UW + col) = o[k];
        }
#pragma unroll
        for (int k = 0; k < 10; ++k) rr[k] = rn[k];
    }
}

constexpr int SA = 72, SB = 136;

__device__ __forceinline__ void load_rows8(const half_t* u16, int rowbase, int Lseq, int dir, int jj0, int ucol, half8 (&rr)[8]) {
#pragma unroll
    for (int k = 0; k < 8; ++k) { const int jj = jj0 + k, pos = dir == 0 ? jj : Lseq - 1 - jj; rr[k] = *(const half8*)(u16 + (size_t)(rowbase + pos) * UW + ucol); }
}
__device__ __forceinline__ void transpose8(const half8 (&rr)[8], half8 (&t)[8]) {
#pragma unroll
    for (int i = 0; i < 8; ++i)
#pragma unroll
        for (int k = 0; k < 8; ++k) t[i][k] = rr[k][i];
}
#ifdef EMU
#define LDS_BARRIER() __syncthreads()
#else
#define LDS_BARRIER() do { asm volatile("s_waitcnt lgkmcnt(0)" ::: "memory"); __builtin_amdgcn_s_barrier(); asm volatile("" ::: "memory"); } while (0)
#endif
__device__ __forceinline__ void ssd_block(const Frame& F, int layer, int b, int h, int dir) {
    half_t* Cs = (half_t*)F.smem;
    half_t* Bs = Cs + 128 * SA;
    half_t* BT = Bs + 128 * SA;
    half_t* XT = BT + 64 * SB;
    half_t* SC = XT + 64 * SB;
    half_t* ST = SC + 128 * SB;
    float* cum = (float*)(ST + 64 * SA);
    float* dtv = cum + 128;
    float* wes = dtv + 128;
    const half_t* u16 = (const half_t*)(F.ws + WS_U16); const float* ug = (const float*)(F.ws + WS_UG);
    half_t* yout = (half_t*)(F.ws + WS_YF) + (size_t)dir * TT * 384;
    const float* cw = F.in(I_SCW) + layer * 3 * 640; const float* cb = F.in(I_SCB) + layer * 640;
    const float dtb = F.in(I_DTB)[(layer * 2 + dir) * 6 + h];
    const float Aneg = -expf(F.in(I_ALOG)[(layer * 2 + dir) * 6 + h]);
    const float Dh = F.in(I_SD)[layer * 6 + h];
    const int g = h / 3, tid = F.tid, lane = F.lane, wave = F.wave;
    const int kind = tid >> 7, c8 = (tid & 7) * 8, j0 = ((tid >> 3) & 15) * 8;
    const int ch = kind == 0 ? h * 64 + c8 : (kind == 1 ? 384 + g * 64 + c8 : 512 + g * 64 + c8);
    f32x4 accS[1][2]; zero_acc(accS);
    for (int i = tid; i < 64 * SA; i += NT) ST[i] = (half_t)0.f;
    constexpr int NC0 = CTXL / 128, NCT = NC0 + SEQ / 128;
    half8 rr[8]; float ug0 = 0.f, ug1 = 0.f;
    if (kind < 3) load_rows8(u16, TL + b * CTXL, CTXL, dir, j0, 384 + ch, rr);
    if (wave == 7) { const int p0 = dir == 0 ? 2 * lane : CTXL - 1 - 2 * lane, p1 = dir == 0 ? p0 + 1 : p0 - 1;
        ug0 = ug[(size_t)(TL + b * CTXL + p0) * UGW + dir * 6 + h]; ug1 = ug[(size_t)(TL + b * CTXL + p1) * UGW + dir * 6 + h]; }
    __syncthreads();
    for (int cc = 0; cc < NCT; ++cc) {
        const int seg = cc >= NC0 ? 1 : 0, c = seg ? cc - NC0 : cc;
        const int Lseq = seg == 0 ? CTXL : SEQ, rowbase = seg == 0 ? TL + b * CTXL : b * SEQ;
        const bool want_y = (seg == 1) || (layer == 0);
        const int nseg = (cc + 1) >= NC0 ? 1 : 0, ncn = nseg ? cc + 1 - NC0 : cc + 1, nL = nseg == 0 ? CTXL : SEQ, nrb = nseg == 0 ? TL + b * CTXL : b * SEQ;
        if (wave == 7) {
            const float dt0 = fsoftplus(ug0 + dtb), dt1 = fsoftplus(ug1 + dtb);
            const float a0 = dt0 * Aneg, a1 = dt1 * Aneg;
            const float incl = wave_scan_sum(a0 + a1, lane);
            const float c1 = incl, c0 = incl - a1;
            const float cl = wave_last(incl);
            cum[2 * lane] = c0; cum[2 * lane + 1] = c1; dtv[2 * lane] = dt0; dtv[2 * lane + 1] = dt1;
            wes[2 * lane] = dt0 * fexp(cl - c0); wes[2 * lane + 1] = dt1 * fexp(cl - c1);
            if (cc + 1 < NCT) { const int pi = ncn * 128 + 2 * lane, p0 = dir == 0 ? pi : nL - 1 - pi, p1 = dir == 0 ? p0 + 1 : p0 - 1;
                ug0 = ug[(size_t)(nrb + p0) * UGW + dir * 6 + h]; ug1 = ug[(size_t)(nrb + p1) * UGW + dir * 6 + h]; }
        }
        if (kind < 3) {
            if (kind == 0) { half8 t[8]; transpose8(rr, t);
#pragma unroll
                for (int i = 0; i < 8; ++i) *(half8*)(XT + (c8 + i) * SB + j0) = t[i];
            } else if (kind == 1) { half8 t[8]; transpose8(rr, t);
#pragma unroll
                for (int k = 0; k < 8; ++k) *(half8*)(Bs + (j0 + k) * SA + c8) = rr[k];
#pragma unroll
                for (int i = 0; i < 8; ++i) *(half8*)(BT + (c8 + i) * SB + j0) = t[i];
            } else {
#pragma unroll
                for (int k = 0; k < 8; ++k) *(half8*)(Cs + (j0 + k) * SA + c8) = rr[k];
            }
            if (cc + 1 < NCT) load_rows8(u16, nrb, nL, dir, ncn * 128 + j0, 384 + ch, rr);
        }
        LDS_BARRIER();
        const float cl = cum[127];
        if (want_y) {
            { const int ws_ = wave & 1, wl = wave >> 1;
              if (!(ws_ == 1 && wl < 2)) {
                f32x4 g_[4][2]; zero_acc(g_);
                mma_lds<4, 2>(g_, Bs + ws_ * 64 * SA, SA, Cs + wl * 32 * SA, SA, 2, lane);
#pragma unroll
                for (int a = 0; a < 4; ++a) {
                    const int s0 = ws_ * 64 + a * 16 + (lane >> 4) * 4;
                    const f32x4 cs4 = *(const f32x4*)(cum + s0), dt4 = *(const f32x4*)(dtv + s0);
#pragma unroll
                    for (int q = 0; q < 2; ++q) {
                        const int l = wl * 32 + q * 16 + (lane & 15); const float cl_ = cum[l]; half4 hv;
#pragma unroll
                        for (int i = 0; i < 4; ++i) hv[i] = (half_t)((s0 + i) <= l ? g_[a][q][i] * fexp(cl_ - cs4[i]) * dt4[i] : 0.f);
                        *(half4*)(SC + l * SB + s0) = hv;
                    } }
              } }
            f32x4 y1[4][1]; zero_acc(y1);
            mma_lds<4, 1>(y1, ST, SA, Cs + wave * 16 * SA, SA, 2, lane);
            LDS_BARRIER();
            f32x4 y2[4][1]; zero_acc(y2);
            mma_lds<4, 1>(y2, XT, SB, SC + wave * 16 * SB, SB, wave / 2 + 1, lane);
            { const int l = wave * 16 + (lane & 15); const float el = fexp(cum[l]);
              const int pi = c * 128 + l, pos = dir == 0 ? pi : Lseq - 1 - pi;
#pragma unroll
              for (int a = 0; a < 4; ++a) { const int p0 = a * 16 + (lane >> 4) * 4; f32x4 y;
#pragma unroll
                  for (int i = 0; i < 4; ++i) y[i] = y1[a][0][i] * el + y2[a][0][i];
                  if (dir == 0) {
#pragma unroll
                      for (int i = 0; i < 4; ++i) y[i] += Dh * (float)XT[(p0 + i) * SB + l]; }
                  *(half4*)(yout + (size_t)(rowbase + pos) * 384 + h * 64 + p0) = to_half4(y); } }
        }
        { const float dec = fexp(cl);
#pragma unroll
          for (int q = 0; q < 2; ++q) accS[0][q] *= dec;
          const int r = lane & 15, kq = (lane >> 4) * 8;
#pragma unroll
          for (int ks = 0; ks < 4; ++ks) {
              const half8 a = *(const half8*)(BT + ((wave >> 1) * 16 + r) * SB + ks * 32 + kq);
              const f32x4 e0 = *(const f32x4*)(wes + ks * 32 + kq), e1 = *(const f32x4*)(wes + ks * 32 + kq + 4);
#pragma unroll
              for (int q = 0; q < 2; ++q) { half8 bb = *(const half8*)(XT + ((wave & 1) * 32 + q * 16 + r) * SB + ks * 32 + kq);
#pragma unroll
                  for (int i = 0; i < 4; ++i) { bb[i] = (half_t)((float)bb[i] * e0[i]); bb[4 + i] = (half_t)((float)bb[4 + i] * e1[i]); }
                  accS[0][q] = mfma16(a, bb, accS[0][q]); } } }
        LDS_BARRIER();
#pragma unroll
        for (int q = 0; q < 2; ++q) { const int p = (wave & 1) * 32 + q * 16 + (lane & 15), n0 = (wave >> 1) * 16 + (lane >> 4) * 4; *(half4*)(ST + p * SA + n0) = to_half4(accS[0][q]); }
    }
    __syncthreads();
}

__device__ __forceinline__ void mlstm_block(const Frame& F, int layer, int b, int h, int dir) {
    half_t* Qs = (half_t*)F.smem;
    half_t* Ks = Qs + 128 * SA;
    half_t* KT = Ks + 128 * SA;
    half_t* VT = KT + 64 * SB;
    half_t* SC = VT + 64 * SB;
    half_t* CS = SC + 128 * SB;
    float* ig = (float*)(CS + 64 * SA);
    float* cumf = ig + 128; float* gsv = cumf + 128; float* mtv = gsv + 128; float* ee = mtv + 128; float* dn = ee + 128;
    float* nvec = dn + 128;
    float* scal = nvec + 64;
    const half_t* u16 = (const half_t*)(F.ws + WS_U16); const float* ug = (const float*)(F.ws + WS_UG);
    half_t* hout = (half_t*)(F.ws + WS_YF) + (size_t)(2 + dir) * TT * 384;
    const float* cw = F.in(I_MCW) + layer * 3 * 768; const float* cb = F.in(I_MCB) + layer * 768;
    const float bi = F.in(I_MGB)[((layer * 2 + dir) * 2 + 0) * 6 + h], bf = F.in(I_MGB)[((layer * 2 + dir) * 2 + 1) * 6 + h];
    const int tid = F.tid, lane = F.lane, wave = F.wave;
    const int kind = tid >> 7, c8 = (tid & 7) * 8, j0 = ((tid >> 3) & 15) * 8;
    const int ch = kind == 0 ? h * 64 + c8 : 384 + h * 64 + c8;
    f32x4 accC[1][2]; zero_acc(accC);
    float m_in = 0.f;
    for (int i = tid; i < 64 * SA; i += NT) CS[i] = (half_t)0.f;
    if (tid < 64) nvec[tid] = 0.f;
    constexpr int NC0 = CTXL / 128, NCT = NC0 + SEQ / 128;
    half8 rr[8]; float gi0 = 0.f, gi1 = 0.f, gf0 = 0.f, gf1 = 0.f;
    const int ucol = kind == 2 ? 1792 + h * 64 + c8 : 1024 + ch;
    if (kind < 3) load_rows8(u16, TL + b * CTXL, CTXL, dir, j0, ucol, rr);
    if (wave == 7) { const int p0 = dir == 0 ? 2 * lane : CTXL - 1 - 2 * lane, p1 = dir == 0 ? p0 + 1 : p0 - 1;
        const float* g0 = ug + (size_t)(TL + b * CTXL + p0) * UGW + 12 + dir * 12; const float* g1 = ug + (size_t)(TL + b * CTXL + p1) * UGW + 12 + dir * 12;
        gi0 = g0[h]; gf0 = g0[6 + h]; gi1 = g1[h]; gf1 = g1[6 + h]; }
    half8 ones;
#pragma unroll
    for (int i = 0; i < 8; ++i) ones[i] = (half_t)1.0f;
    __syncthreads();
    for (int cc = 0; cc < NCT; ++cc) {
        const int seg = cc >= NC0 ? 1 : 0, c = seg ? cc - NC0 : cc;
        const int Lseq = seg == 0 ? CTXL : SEQ, rowbase = seg == 0 ? TL + b * CTXL : b * SEQ;
        const bool want_y = (seg == 1) || (layer == 0);
        const int nseg = (cc + 1) >= NC0 ? 1 : 0, ncn = nseg ? cc + 1 - NC0 : cc + 1, nL = nseg == 0 ? CTXL : SEQ, nrb = nseg == 0 ? TL + b * CTXL : b * SEQ;
        if (wave == 7) {
            const float i0 = gi0 + bi, i1 = gi1 + bi, lf0 = flogsigmoid(gf0 + bf), lf1 = flogsigmoid(gf1 + bf);
            const float incl = wave_scan_sum(lf0 + lf1, lane);
            const float c1 = incl, c0 = incl - lf1;
            const float tot = wave_last(incl);
            const float r0 = i0 - c0, r1 = i1 - c1;
            const float pincl = wave_scan_max(fmaxf(r0, r1), lane);
            const float pexcl = wave_shr1(pincl, -3.0e38f, lane);
            const float pm0 = fmaxf(pexcl, r0), pm1 = pincl;
            const float pmlast = wave_last(pincl);
            const float m_new = fmaxf(tot + m_in, tot + pmlast);
            ig[2 * lane] = i0; ig[2 * lane + 1] = i1; cumf[2 * lane] = c0; cumf[2 * lane + 1] = c1; gsv[2 * lane] = r0; gsv[2 * lane + 1] = r1;
            mtv[2 * lane] = fmaxf(c0 + m_in, c0 + pm0); mtv[2 * lane + 1] = fmaxf(c1 + m_in, c1 + pm1);
            ee[2 * lane] = fexp(r0 + tot - m_new); ee[2 * lane + 1] = fexp(r1 + tot - m_new);
            if (lane == 0) { scal[0] = tot; scal[1] = m_new; }
            if (cc + 1 < NCT) { const int pi = ncn * 128 + 2 * lane, p0 = dir == 0 ? pi : nL - 1 - pi, p1 = dir == 0 ? p0 + 1 : p0 - 1;
                const float* g0 = ug + (size_t)(nrb + p0) * UGW + 12 + dir * 12; const float* g1 = ug + (size_t)(nrb + p1) * UGW + 12 + dir * 12;
                gi0 = g0[h]; gf0 = g0[6 + h]; gi1 = g1[h]; gf1 = g1[6 + h]; }
        }
        if (kind == 0) {
#pragma unroll
            for (int k = 0; k < 8; ++k) *(half8*)(Qs + (j0 + k) * SA + c8) = rr[k];
        } else if (kind == 1) { half8 t[8]; transpose8(rr, t);
#pragma unroll
            for (int k = 0; k < 8; ++k) *(half8*)(Ks + (j0 + k) * SA + c8) = rr[k];
#pragma unroll
            for (int i = 0; i < 8; ++i) *(half8*)(KT + (c8 + i) * SB + j0) = t[i];
        } else if (kind == 2) { half8 t[8]; transpose8(rr, t);
#pragma unroll
            for (int i = 0; i < 8; ++i) *(half8*)(VT + (c8 + i) * SB + j0) = t[i];
        }
        if (kind < 3 && cc + 1 < NCT) load_rows8(u16, nrb, nL, dir, ncn * 128 + j0, ucol, rr);
        LDS_BARRIER();
        const float tot = scal[0], m_new = scal[1];
        if (want_y) {
            { const int ws_ = wave & 1, wl = wave >> 1;
              if (!(ws_ == 1 && wl < 2)) {
                f32x4 g_[4][2]; zero_acc(g_);
                mma_lds<4, 2>(g_, Ks + ws_ * 64 * SA, SA, Qs + wl * 32 * SA, SA, 2, lane);
#pragma unroll
                for (int a = 0; a < 4; ++a) {
                    const int s0 = ws_ * 64 + a * 16 + (lane >> 4) * 4; const f32x4 gs4 = *(const f32x4*)(gsv + s0);
#pragma unroll
                    for (int q = 0; q < 2; ++q) {
                        const int l = wl * 32 + q * 16 + (lane & 15); const float cm = cumf[l] - mtv[l]; half4 hv;
#pragma unroll
                        for (int i = 0; i < 4; ++i) hv[i] = (half_t)((s0 + i) <= l ? g_[a][q][i] * fexp(cm + gs4[i]) : 0.f);
                        *(half4*)(SC + l * SB + s0) = hv;
                    } }
              } }
            f32x4 h1[4][1]; zero_acc(h1);
            mma_lds<4, 1>(h1, CS, SA, Qs + wave * 16 * SA, SA, 2, lane);
            f32x4 dq = {0.f, 0.f, 0.f, 0.f};
            { const int r_ = lane & 15, kq_ = (lane >> 4) * 8;
#pragma unroll
              for (int ks = 0; ks < 2; ++ks) { half8 na; const f32x4 n0 = *(const f32x4*)(nvec + ks * 32 + kq_), n1 = *(const f32x4*)(nvec + ks * 32 + kq_ + 4);
#pragma unroll
                  for (int i = 0; i < 4; ++i) { na[i] = (half_t)n0[i]; na[4 + i] = (half_t)n1[i]; }
                  dq = mfma16(na, *(const half8*)(Qs + (wave * 16 + r_) * SA + ks * 32 + kq_), dq); } }
            LDS_BARRIER();
            f32x4 h2[4]; f32x4 d1 = {0.f, 0.f, 0.f, 0.f};
#pragma unroll
            for (int a = 0; a < 4; ++a) h2[a] = (f32x4){0.f, 0.f, 0.f, 0.f};
            { const int r = lane & 15, kq = (lane >> 4) * 8;
              for (int ks = 0; ks < wave / 2 + 1; ++ks) {
                  const half8 bfr = *(const half8*)(SC + (wave * 16 + r) * SB + ks * 32 + kq);
#pragma unroll
                  for (int a = 0; a < 4; ++a) { const half8 afr = *(const half8*)(VT + (a * 16 + r) * SB + ks * 32 + kq); h2[a] = mfma16(afr, bfr, h2[a]); }
                  d1 = mfma16(ones, bfr, d1); } }
            { const int l = wave * 16 + (lane & 15); const float ai = fexp(cumf[l] + m_in - mtv[l]); const float rden = 1.0f / fmaxf(fabsf(dq[0] * ai + d1[0]), fexp(-mtv[l]));
              const int pi = c * 128 + l, pos = dir == 0 ? pi : Lseq - 1 - pi;
#pragma unroll
              for (int a = 0; a < 4; ++a) { const int v0 = a * 16 + (lane >> 4) * 4; f32x4 y;
#pragma unroll
                  for (int i = 0; i < 4; ++i) y[i] = (h1[a][0][i] * ai + h2[a][i]) * rden;
                  *(half4*)(hout + (size_t)(rowbase + pos) * 384 + h * 64 + v0) = to_half4(y); } }
        }
        { const float sc = fexp(tot + m_in - m_new);
#pragma unroll
          for (int q = 0; q < 2; ++q) accC[0][q] *= sc;
          { const int r = lane & 15, kq = (lane >> 4) * 8;
#pragma unroll
            for (int ks = 0; ks < 4; ++ks) {
              const half8 a = *(const half8*)(KT + ((wave >> 1) * 16 + r) * SB + ks * 32 + kq);
              const f32x4 e0 = *(const f32x4*)(ee + ks * 32 + kq), e1 = *(const f32x4*)(ee + ks * 32 + kq + 4);
#pragma unroll
              for (int q = 0; q < 2; ++q) { half8 bb = *(const half8*)(VT + ((wave & 1) * 32 + q * 16 + r) * SB + ks * 32 + kq);
#pragma unroll
                  for (int i = 0; i < 4; ++i) { bb[i] = (half_t)((float)bb[i] * e0[i]); bb[4 + i] = (half_t)((float)bb[4 + i] * e1[i]); }
                  accC[0][q] = mfma16(a, bb, accC[0][q]); } } }
          if ((wave & 1) == 0) { f32x4 an = {0.f, 0.f, 0.f, 0.f}; const int r_ = lane & 15, kq_ = (lane >> 4) * 8;
#pragma unroll
              for (int ks = 0; ks < 4; ++ks) { half8 eb; const f32x4 e0 = *(const f32x4*)(ee + ks * 32 + kq_), e1 = *(const f32x4*)(ee + ks * 32 + kq_ + 4);
#pragma unroll
                  for (int i = 0; i < 4; ++i) { eb[i] = (half_t)e0[i]; eb[4 + i] = (half_t)e1[i]; }
                  an = mfma16(*(const half8*)(KT + ((wave >> 1) * 16 + r_) * SB + ks * 32 + kq_), eb, an); }
              if ((lane & 15) == 0) {
#pragma unroll
                  for (int i = 0; i < 4; ++i) { const int d = (wave >> 1) * 16 + (lane >> 4) * 4 + i; nvec[d] = sc * nvec[d] + an[i]; } } } }
        m_in = m_new;
        LDS_BARRIER();
#pragma unroll
        for (int q = 0; q < 2; ++q) { const int v = (wave & 1) * 32 + q * 16 + (lane & 15), d0 = (wave >> 1) * 16 + (lane >> 4) * 4; *(half4*)(CS + v * SA + d0) = to_half4(accC[0][q]); }
    }
    __syncthreads();
}

__device__ __forceinline__ cplx cmul(cplx a, cplx b) { return cplx{a.x * b.x - a.y * b.y, a.x * b.y + a.y * b.x}; }
__device__ __forceinline__ cplx cadd(cplx a, cplx b) { return cplx{a.x + b.x, a.y + b.y}; }
__device__ __forceinline__ cplx csub(cplx a, cplx b) { return cplx{a.x - b.x, a.y - b.y}; }
__device__ __forceinline__ void sincos_turns(float x, float& s, float& c) {
#ifdef EMU
    s = sinf(6.283185307179586f * x); c = cosf(6.283185307179586f * x);
#else
    s = __builtin_amdgcn_sinf(x); c = __builtin_amdgcn_cosf(x);
#endif
}
#define PADI(i) ((i) + ((i) >> 5))
template <bool INV> __device__ __forceinline__ void r4(cplx& a0, cplx& a1, cplx& a2, cplx& a3) {
    const cplx t0 = cadd(a0, a2), t1 = csub(a0, a2), t2 = cadd(a1, a3), t3 = csub(a1, a3);
    a0 = cadd(t0, t2); a2 = csub(t0, t2);
    if (!INV) { a1 = cplx{t1.x + t3.y, t1.y - t3.x}; a3 = cplx{t1.x - t3.y, t1.y + t3.x}; }
    else      { a1 = cplx{t1.x - t3.y, t1.y + t3.x}; a3 = cplx{t1.x + t3.y, t1.y - t3.x}; }
}
template <bool INV> __device__ __forceinline__ void fft16(cplx (&v)[16]) {
#pragma unroll
    for (int l0 = 0; l0 < 4; ++l0) r4<INV>(v[l0], v[l0 + 4], v[l0 + 8], v[l0 + 12]);
    const float C1 = 0.9238795325112867f, S1 = 0.3826834323650898f, C2 = 0.7071067811865476f;
    const float sg = INV ? 1.f : -1.f;
#define TWM(idx, cr, ci) v[idx] = cmul(v[idx], cplx{(cr), sg * (ci)})
    TWM(1 + 4 * 1, C1, S1); TWM(2 + 4 * 1, C2, C2); TWM(3 + 4 * 1, S1, C1);
    TWM(1 + 4 * 2, C2, C2); TWM(2 + 4 * 2, 0.f, 1.f); TWM(3 + 4 * 2, -C2, C2);
    TWM(1 + 4 * 3, S1, C1); TWM(2 + 4 * 3, -C2, C2); TWM(3 + 4 * 3, -C1, -S1);
#undef TWM
    cplx o[16];
#pragma unroll
    for (int m0 = 0; m0 < 4; ++m0) { cplx a0 = v[4 * m0], a1 = v[4 * m0 + 1], a2 = v[4 * m0 + 2], a3 = v[4 * m0 + 3]; r4<INV>(a0, a1, a2, a3);
        o[m0] = a0; o[m0 + 4] = a1; o[m0 + 8] = a2; o[m0 + 12] = a3; }
#pragma unroll
    for (int i = 0; i < 16; ++i) v[i] = o[i];
}
__device__ __forceinline__ void twpow(cplx w1, cplx (&w)[16]) {
    w[1] = w1; w[2] = cmul(w1, w1); w[3] = cmul(w[2], w1); w[4] = cmul(w[2], w[2]); w[5] = cmul(w[4], w1); w[6] = cmul(w[4], w[2]); w[7] = cmul(w[4], w[3]); w[8] = cmul(w[4], w[4]);
#pragma unroll
    for (int m = 9; m < 16; ++m) w[m] = cmul(w[8], w[m - 8]);
}
#ifdef EMU
#define OPAQUE_I(x)
#else
#define OPAQUE_I(x) asm volatile("" : "+v"(x))
#endif
template <int NS> __device__ __forceinline__ void fft_fwd16(cplx* buf0, cplx* buf1, int N, int tid, int TS = NT) {
#pragma unroll 1
    for (int n = N; n >= 32; n >>= 4) { const int q = n >> 4, qs = q + (q >> 5);
        for (int i = tid; i < N / 16; i += TS) {
            const int blk = i / q, j = i - blk * q; int pb = PADI(blk * n + j); OPAQUE_I(pb);
            float s, c; sincos_turns(-(float)j / (float)n, s, c);
            const cplx w1{c, s};
#pragma unroll
            for (int st = 0; st < NS; ++st) { cplx* buf = (st == 0 ? buf0 : buf1) + pb;
                cplx v[16];
#pragma unroll
                for (int l = 0; l < 16; ++l) v[l] = buf[l * qs];
                fft16<false>(v);
                buf[0] = v[0];
                cplx wm = w1;
#pragma unroll
                for (int m = 1; m < 16; ++m) { buf[m * qs] = cmul(v[m], wm); wm = cmul(wm, w1); }
                LOADER_FENCE(); }
        }
        __syncthreads(); }
}
template <int NS> __device__ __forceinline__ void fft_inv16(cplx* buf0, cplx* buf1, int N, int tid, int TS = NT) {
#pragma unroll 1
    for (int n = 32; n <= N; n <<= 4) { const int q = n >> 4, qs = q + (q >> 5);
        for (int i = tid; i < N / 16; i += TS) {
            const int blk = i / q, j = i - blk * q; int pb = PADI(blk * n + j); OPAQUE_I(pb);
            float s, c; sincos_turns((float)j / (float)n, s, c);
            const cplx w1{c, s};
#pragma unroll
            for (int st = 0; st < NS; ++st) { cplx* buf = (st == 0 ? buf0 : buf1) + pb;
                cplx v[16];
                v[0] = buf[0];
                cplx wm = w1;
#pragma unroll
                for (int m = 1; m < 16; ++m) { v[m] = cmul(buf[m * qs], wm); wm = cmul(wm, w1); }
                fft16<true>(v);
#pragma unroll
                for (int l = 0; l < 16; ++l) buf[l * qs] = v[l];
                LOADER_FENCE(); }
        }
        __syncthreads(); }
}
static_assert(2 * SEQ == 512 || 2 * SEQ == 8192, "FFT size must be 2*16^k");
static_assert(2 * CTXL == 512 || 2 * CTXL == 8192, "FFT size must be 2*16^k");
constexpr int HBUF = (2 * SEQ + (2 * SEQ) / 32 + 8);
constexpr int HPT = (SEQ + NT - 1) / NT;
__device__ __forceinline__ void hy_conv8(const half_t* p, int t0, int L, float w0, float w1, float w2, float bsv, float (&o)[8]) {
    const half8 m = *(const half8*)(p + t0);
    float e[10]; e[0] = t0 > 0 ? (float)p[t0 - 1] : 0.f; e[9] = t0 + 8 < L ? (float)p[t0 + 8] : 0.f;
#pragma unroll
    for (int i = 0; i < 8; ++i) e[i + 1] = (float)m[i];
#pragma unroll
    for (int i = 0; i < 8; ++i) o[i] = w0 * e[i] + w1 * e[i + 1] + w2 * e[i + 2] + bsv;
}
template <int TS> __device__ __forceinline__ float team_sum(float v, const Frame& F, float* red) {
    if constexpr (TS == NT) { v = wave_sum(v); if (F.lane == 0) red[F.wave] = v; __syncthreads(); float t = 0.f; for (int w = 0; w < NT / 64; ++w) t += red[w]; return t; }
    else { static_assert(TS == 32, "team size");
#pragma unroll
        for (int m = 16; m >= 1; m >>= 1) v += __shfl_xor(v, m);
        __syncthreads(); return v; }
}
template <int NS, int TS, int HP> __device__ __forceinline__ void hyena_seg_t(const Frame& F, int layer, int c0, const int seg) {
    const int HB = (seg == 0 ? 2 * SEQ : 2 * CTXL) + (seg == 0 ? 2 * SEQ : 2 * CTXL) / 32 + 8;
    const int tid = F.tid % TS, team = F.tid / TS, c = c0 + team;
    cplx* bufA = (cplx*)F.smem + (size_t)team * 2 * HB;
    cplx* bufB = bufA + HB;
    float* red = (float*)((cplx*)F.smem + (size_t)(NT / TS) * 2 * HB);
    const float* cwp = F.in(I_HCW) + layer * 3 * 768; const float* cbp = F.in(I_HCB) + layer * 768;
    {
        const int L = seg == 0 ? SEQ : CTXL, N = 2 * L;
        const half_t* hyt = (const half_t*)(F.ws + WS_HYT) + (seg == 0 ? 0 : (size_t)NB * 768 * SEQ);
        float* z1 = (float*)(F.ws + WS_XN) + (seg == 0 ? 0 : (size_t)NB * 256 * SEQ);
        float* yht = (float*)(F.ws + WS_YHT) + (seg == 0 ? 0 : (size_t)NB * 256 * SEQ);
        const float* ft = (const float*)(F.ws + WS_FT) + (seg == 0 ? (size_t)layer * 256 * 4 * SEQ : (size_t)2 * 256 * 4 * SEQ);
        half4 Hh0[HP], Hh1[HP];
        const float invN = 1.0f / (float)N;
        {
            float as0 = 0.f, as1 = 0.f;
            const float* hf0 = ft + ((size_t)(c * 2 + 0) * 2 + 0) * L; const float* hb0 = ft + ((size_t)(c * 2 + 0) * 2 + 1) * L;
            const float* hf1 = ft + ((size_t)(c * 2 + 1) * 2 + 0) * L; const float* hb1 = ft + ((size_t)(c * 2 + 1) * 2 + 1) * L;
            for (int i_ = tid; i_ < N; i_ += TS) { int i = i_; OPAQUE_I(i);
                const float v0 = i < L ? hf0[i] : (i == L ? 0.f : hb0[N - i]), v1 = i < L ? hf1[i] : (i == L ? 0.f : hb1[N - i]);
                bufA[PADI(i)] = cplx{v0, 0.f}; bufB[PADI(i)] = cplx{v1, 0.f}; as0 += fabsf(v0); as1 += fabsf(v1); }
            const float tot0 = team_sum<TS>(as0, F, red);
            const float tot1 = team_sum<TS>(as1, F, red + 8);
            fft_fwd16<2>(bufA, bufB, N, tid, TS);
            const float hs0 = 1.0f / tot0, hs1 = 1.0f / tot1;
#pragma unroll
            for (int k = 0; k < HP; ++k) { int i = tid + k * TS; OPAQUE_I(i); half4 hv, hw;
                if (i < N / 2) { const cplx a = bufA[PADI(2 * i)], b_ = bufA[PADI(2 * i + 1)]; const cplx s = cadd(a, b_), d = csub(a, b_);
                    hv[0] = (half_t)(s.x * hs0); hv[1] = (half_t)(s.y * hs0); hv[2] = (half_t)(d.x * hs0); hv[3] = (half_t)(d.y * hs0);
                    const cplx a1 = bufB[PADI(2 * i)], b1_ = bufB[PADI(2 * i + 1)]; const cplx s1 = cadd(a1, b1_), d1 = csub(a1, b1_);
                    hw[0] = (half_t)(s1.x * hs1); hw[1] = (half_t)(s1.y * hs1); hw[2] = (half_t)(d1.x * hs1); hw[3] = (half_t)(d1.y * hs1); }
                else { hv[0] = hv[1] = hv[2] = hv[3] = (half_t)0.f; hw = hv; }
                Hh0[k] = hv; Hh1[k] = hw; LOADER_FENCE(); }
            __syncthreads();
        }
        for (int order = 0; order < 2; ++order) {
            const int gch = 256 * (order + 1) + c;
            for (int pr = 0; pr < NB / 2; pr += NS) {
#pragma unroll
                for (int st = 0; st < NS; ++st) { cplx* buf = st == 0 ? bufA : bufB; const int b0 = 2 * (pr + st), b1 = b0 + 1;
                    const float vw0 = cwp[c], vw1 = cwp[768 + c], vw2 = cwp[1536 + c], vb = cbp[c];
                    const half_t* v0p = hyt + ((size_t)b0 * 768 + c) * L; const half_t* v1p = hyt + ((size_t)b1 * 768 + c) * L;
                    const float* z0q = z1 + ((size_t)b0 * 256 + c) * L; const float* z1q = z1 + ((size_t)b1 * 256 + c) * L;
                    for (int t0_ = tid * 8; t0_ < N; t0_ += TS * 8) { int t0 = t0_; OPAQUE_I(t0);
                        if (t0 < L) { float za[8], zb[8];
                            if (order == 0) { hy_conv8(v0p, t0, L, vw0, vw1, vw2, vb, za); hy_conv8(v1p, t0, L, vw0, vw1, vw2, vb, zb); }
                            else {
#pragma unroll
                                for (int i = 0; i < 8; ++i) { za[i] = z0q[t0 + i]; zb[i] = z1q[t0 + i]; } }
#pragma unroll
                            for (int i = 0; i < 8; ++i) buf[PADI(t0 + i)] = cplx{za[i], zb[i]}; }
                        else {
#pragma unroll
                            for (int i = 0; i < 8; ++i) buf[PADI(t0 + i)] = cplx{0.f, 0.f}; }
                        LOADER_FENCE();
                    } }
                __syncthreads();
                fft_fwd16<NS>(bufA, bufB, N, tid, TS);
#pragma unroll
                for (int st = 0; st < NS; ++st) { cplx* buf = st == 0 ? bufA : bufB;
#pragma unroll
                    for (int k = 0; k < HP; ++k) { int i = tid + k * TS; OPAQUE_I(i);
                        if (i < N / 2) { const cplx a = buf[PADI(2 * i)], b_ = buf[PADI(2 * i + 1)];
                            const half4 hq = order == 0 ? Hh0[k] : Hh1[k];
                            const cplx h0{(float)hq[0] * invN, (float)hq[1] * invN}, h1{(float)hq[2] * invN, (float)hq[3] * invN};
                            const cplx s = cmul(cadd(a, b_), h0), d = cmul(csub(a, b_), h1);
                            buf[PADI(2 * i)] = cadd(s, d); buf[PADI(2 * i + 1)] = csub(s, d); }
                        LOADER_FENCE(); } }
                __syncthreads();
                fft_inv16<NS>(bufA, bufB, N, tid, TS);
#pragma unroll
                for (int st = 0; st < NS; ++st) { cplx* buf = st == 0 ? bufA : bufB; const int b0 = 2 * (pr + st), b1 = b0 + 1;
                    const float gw0 = cwp[gch], gw1 = cwp[768 + gch], gw2 = cwp[1536 + gch], gb = cbp[gch];
                    const float vw0 = cwp[c], vw1 = cwp[768 + c], vw2 = cwp[1536 + c], vb = cbp[c];
                    const float skip = F.in(I_HSKIP)[(layer * 2 + order) * 256 + c];
                    const half_t* v0p = hyt + ((size_t)b0 * 768 + c) * L; const half_t* v1p = hyt + ((size_t)b1 * 768 + c) * L;
                    const float* z0q = z1 + ((size_t)b0 * 256 + c) * L; const float* z1q = z1 + ((size_t)b1 * 256 + c) * L;
                    const half_t* g0p = hyt + ((size_t)b0 * 768 + gch) * L; const half_t* g1p = hyt + ((size_t)b1 * 768 + gch) * L;
                    float* d0 = (order == 0 ? z1 : yht) + ((size_t)b0 * 256 + c) * L; float* d1 = (order == 0 ? z1 : yht) + ((size_t)b1 * 256 + c) * L;
                    for (int t0_ = tid * 8; t0_ < L; t0_ += TS * 8) { int t0 = t0_; OPAQUE_I(t0);
                        float za[8], zb[8], ga[8], gb_[8];
                        if (order == 0) { hy_conv8(v0p, t0, L, vw0, vw1, vw2, vb, za); hy_conv8(v1p, t0, L, vw0, vw1, vw2, vb, zb); }
                        else {
#pragma unroll
                            for (int i = 0; i < 8; ++i) { za[i] = z0q[t0 + i]; zb[i] = z1q[t0 + i]; } }
                        hy_conv8(g0p, t0, L, gw0, gw1, gw2, gb, ga); hy_conv8(g1p, t0, L, gw0, gw1, gw2, gb, gb_);
                        f32x4 oa[2], ob[2];
#pragma unroll
                        for (int i = 0; i < 8; ++i) { const cplx y = buf[PADI(t0 + i)]; oa[i >> 2][i & 3] = ga[i] * (y.x + skip * za[i]); ob[i >> 2][i & 3] = gb_[i] * (y.y + skip * zb[i]); }
                        *(f32x4*)(d0 + t0) = oa[0]; *(f32x4*)(d0 + t0 + 4) = oa[1]; *(f32x4*)(d1 + t0) = ob[0]; *(f32x4*)(d1 + t0 + 4) = ob[1];
                        LOADER_FENCE();
                    } }
                __syncthreads();
            }
        }
    }
}
constexpr int HP_L = (SEQ + NT - 1) / NT, HP_C = (CTXL + 31) / 32;
static_assert((size_t)(NT / 32) * 2 * (2 * CTXL + 2 * CTXL / 32 + 8) * 8 + 256 <= (size_t)LDS_BYTES - 64, "ctx team buffers must fit in LDS");
__device__ __forceinline__ void hyena_channel(const Frame& F, int layer, int c) {
    constexpr int NS = (NB % 4 == 0) ? 2 : 1;
    hyena_seg_t<NS, NT, HP_L>(F, layer, c, 0);
}
__device__ __forceinline__ void hyena_ctx_group(const Frame& F, int layer, int g) {
    constexpr int NS = (NB % 4 == 0) ? 2 : 1;
    hyena_seg_t<NS, 32, HP_C>(F, layer, g * (NT / 32), 1);
}
__device__ __forceinline__ int queue_pull(const Frame& F, unsigned* head) {
    int* slot = (int*)(F.smem + LDS_BYTES - 64);
    __syncthreads();
    if (F.tid == 0) *slot = (int)atomicAdd(head, 1u);
    __syncthreads();
    const int v = *slot;
    return v;
}
__device__ __forceinline__ void phase_mixers(const Frame& F, int layer) {
    const int bid = blockIdx.x;
    constexpr int NSCAN = 2 * NB * 6 * 2;
    unsigned* qhead = (unsigned*)(F.ws + WS_CTL) + CW_QUE + layer * 128;
    if (bid < NSCAN) {
        const int k = bid >> 1, kind = bid & 1, dir = k % 2, h = (k / 2) % 6, b = k / 12;
        if (kind == 0) ssd_block(F, layer, b, h, dir); else mlstm_block(F, layer, b, h, dir);
    }
    { const int G = gridDim.x, nfree = G - NSCAN;
      if (nfree > 0) { if (bid >= NSCAN) for (int c = bid - NSCAN; c < 256; c += nfree) hyena_channel(F, layer, c); }
      else for (int c = bid; c < 256; c += G) hyena_channel(F, layer, c); }
    if (layer == 0) for (;;) { const int g = queue_pull(F, qhead + 32); if (g >= 256 / (NT / 32)) break; hyena_ctx_group(F, layer, g); }
    for (;;) { const int it = queue_pull(F, qhead + 64); if (it >= IT_TMOE) break; moe_transpose_item(F, layer, it); }
}

__device__ __forceinline__ void phase_combine(const Frame& F, int layer) {
    const int nrows = layer == 0 ? TT : TL;
    const half_t* u16 = (const half_t*)(F.ws + WS_U16);
    const half_t* yf = (const half_t*)(F.ws + WS_YF); const half_t* yb = yf + (size_t)TT * 384; const half_t* hf = yb + (size_t)TT * 384; const half_t* hb = hf + (size_t)TT * 384;
    half_t* yl = (half_t*)(F.ws + WS_XN);
    const float* snw = F.in(I_SNW) + layer * 384; const float* mnw = F.in(I_MNW) + layer * 384;
    const int lane = F.lane, k8 = (lane < 48 ? lane : 0) * 8, nwaves = gridDim.x * (NT / 64);
    f32x4 sw[2], mw[2];
#pragma unroll
    for (int q = 0; q < 2; ++q) { sw[q] = *(const f32x4*)(snw + k8 + q * 4); mw[q] = *(const f32x4*)(mnw + k8 + q * 4); }
    int row = blockIdx.x * (NT / 64) + F.wave;
    half8 a[6];
#define COMB_LOAD(dst, r) { const size_t ro = (size_t)(r); dst[0] = NT_LOAD(half8, yf + ro * 384 + k8); dst[1] = NT_LOAD(half8, yb + ro * 384 + k8); dst[2] = NT_LOAD(half8, u16 + ro * UW + k8); \
        dst[3] = NT_LOAD(half8, hf + ro * 384 + k8); dst[4] = NT_LOAD(half8, hb + ro * 384 + k8); dst[5] = NT_LOAD(half8, u16 + ro * UW + 2176 + k8); }
    if (row < nrows) COMB_LOAD(a, row)
    for (; row < nrows; row += nwaves) {
        const int nrow = row + nwaves;
        half8 an[6];
        if (nrow < nrows) COMB_LOAD(an, nrow)
        const size_t ro = (size_t)row;
        float g[8], hv[8]; float ss = 0.f, hs = 0.f;
#pragma unroll
        for (int i = 0; i < 8; ++i) { g[i] = ((float)a[0][i] + (float)a[1][i]) * fsilu((float)a[2][i]); ss += g[i] * g[i]; hv[i] = (float)a[3][i] + (float)a[4][i]; hs += hv[i]; }
        if (lane >= 48) ss = 0.f;
        ss = wave_sum(ss);
        hs += __shfl_xor(hs, 1); hs += __shfl_xor(hs, 2); hs += __shfl_xor(hs, 4);
        const float mu = hs * (1.0f / 64.f);
        float vs = 0.f;
#pragma unroll
        for (int i = 0; i < 8; ++i) { hv[i] -= mu; vs += hv[i] * hv[i]; }
        vs += __shfl_xor(vs, 1); vs += __shfl_xor(vs, 2); vs += __shfl_xor(vs, 4);
        const float rs = 1.0f / sqrtf(ss * (1.0f / 384.f) + EPSF), rstd = 1.0f / sqrtf(vs * (1.0f / 64.f) + EPSF);
        if (lane < 48) { half8 o1, o2;
#pragma unroll
            for (int i = 0; i < 8; ++i) { o1[i] = (half_t)(g[i] * rs * sw[i >> 2][i & 3]); o2[i] = (half_t)(hv[i] * rstd * mw[i >> 2][i & 3] / (1.0f + fexp(-(float)a[5][i]))); }
            *(half8*)(yl + ro * D + k8) = o1; *(half8*)(yl + ro * D + 640 + k8) = o2; }
#pragma unroll
        for (int i = 0; i < 6; ++i) a[i] = an[i];
    }
#undef COMB_LOAD
    { const int ntile = nrows / 32, hb = F.tid >> 8, ht = F.tid & 255, G2 = gridDim.x * 2;
      constexpr int TLD = 264;
      half_t* T = (half_t*)F.smem + hb * (32 * TLD);
      const int niter = (ntile + G2 - 1) / G2;
      for (int k = 0; k < niter; ++k) {
          const int tl = blockIdx.x * 2 + hb + k * G2; const bool has = tl < ntile;
          const int row0 = (has ? tl : 0) * 32; const bool isl = row0 < TL; const int L = isl ? SEQ : CTXL; const int rc = isl ? row0 : row0 - TL; const int b = rc / L, t0 = rc % L;
          const float* base = (const float*)(F.ws + WS_YHT) + (isl ? 0 : (size_t)NB * 256 * SEQ) + (size_t)b * 256 * L + t0;
          f32x4 v[8];
#pragma unroll
          for (int q = 0; q < 8; ++q) { const int p = ht + q * 256, ch = p >> 3, tq = p & 7; v[q] = *(const f32x4*)(base + (size_t)ch * L + tq * 4); }
#pragma unroll
          for (int q = 0; q < 8; ++q) { const int p = ht + q * 256, ch = p >> 3, tq = p & 7;
#pragma unroll
              for (int e2 = 0; e2 < 4; ++e2) T[(tq * 4 + e2) * TLD + ch] = (half_t)v[q][e2]; }
          __syncthreads();
#pragma unroll
          for (int q = 0; q < 4; ++q) { const int pc = ht + q * 256, t = pc >> 5, g = pc & 31; const half8 h8 = *(const half8*)(T + t * TLD + g * 8);
              if (has) *(half8*)(yl + (size_t)(row0 + t) * D + 384 + g * 8) = h8; }
          __syncthreads();
      } }
}

struct EpiOutproj {
    static constexpr bool PERM = true;
    Frame F; int layer;
    __device__ __forceinline__ void operator()(const f32x4 (&acc)[2][2][4][2], const g8::Unit& u, int wr, int wc, int fr, int fq) const {
#pragma unroll
        for (int ai = 0; ai < 2; ++ai)
#pragma unroll
            for (int m = 0; m < 4; ++m) {
                const int srow = u.pm * 256 + ai * 128 + wr * 64 + m * 16 + fr;
                int row = srow;
                if (layer == 1 && srow < TL) { const int b = srow / SEQ, s = srow % SEQ; row = b * SEQ + (s % GROWS) * GW + s / GROWS; }
                const float* g1 = modp(F, layer, row_mod(row), 2);
                const float* xi = F.xrow_in(layer, row); float* xo = F.xrow(row);
#pragma unroll
                for (int bj = 0; bj < 2; ++bj) { const int c0 = u.pn * 256 + bj * 128 + wc * 32 + 8 * fq;
                    const f32x4 x0 = *(const f32x4*)(xi + c0), x1 = *(const f32x4*)(xi + c0 + 4), g0 = *(const f32x4*)(g1 + c0), g1v = *(const f32x4*)(g1 + c0 + 4);
                    *(f32x4*)(xo + c0) = x0 + g0 * acc[ai][bj][m][0]; *(f32x4*)(xo + c0 + 4) = x1 + g1v * acc[ai][bj][m][1]; }
            }
    }
};
__device__ __forceinline__ void outproj_ctx_tiles(const Frame& F, int layer) {
    const half_t* yl = (const half_t*)(F.ws + WS_XN) + (size_t)TL * D;
    const half_t* wt = (const half_t*)(F.ws + WS_WOUT) + (size_t)layer * D * D;
    constexpr int KC = 256, LDT = KC + 8;
    half_t* As = (half_t*)F.smem; half_t* Bs = As + 64 * LDT;
    const int lane = F.lane, wave = F.wave, tid = F.tid;
    const int ntile = (TC / 64) * (D / 64);
    for (int t = blockIdx.x; t < ntile; t += gridDim.x) {
        const int m0 = (t / (D / 64)) * 64, n0 = (t % (D / 64)) * 64;
        const int mt = wave >> 1, nt0 = (wave & 1) * 2;
        f32x4 c[1][2]; zero_acc(c);
        half8 ra[4], rb[4];
#pragma unroll
        for (int q = 0; q < 4; ++q) { const int pc = tid + q * NT, row = pc >> 5, kc = (pc & 31) * 8; ra[q] = *(const half8*)(yl + (size_t)(m0 + row) * D + kc); rb[q] = *(const half8*)(wt + (size_t)(n0 + row) * D + kc); }
#pragma unroll 1
        for (int kb = 0; kb < D; kb += KC) {
            __syncthreads();
#pragma unroll
            for (int q = 0; q < 4; ++q) { const int pc = tid + q * NT, row = pc >> 5, kc = (pc & 31) * 8; *(half8*)(As + row * LDT + kc) = ra[q]; *(half8*)(Bs + row * LDT + kc) = rb[q]; }
            __syncthreads();
            if (kb + KC < D) {
#pragma unroll
                for (int q = 0; q < 4; ++q) { const int pc = tid + q * NT, row = pc >> 5, kc = (pc & 31) * 8; ra[q] = *(const half8*)(yl + (size_t)(m0 + row) * D + kb + KC + kc); rb[q] = *(const half8*)(wt + (size_t)(n0 + row) * D + kb + KC + kc); } }
            mma_lds<1, 2>(c, As + mt * 16 * LDT, LDT, Bs + nt0 * 16 * LDT, LDT, KC / 32, lane);
        }
        const int r = lane & 15;
#pragma unroll
        for (int i = 0; i < 4; ++i) {
            const int row = TL + m0 + mt * 16 + (lane >> 4) * 4 + i;
            const float* g1 = modp(F, layer, NB, 2); const float* xi = F.xrow_in(layer, row); float* xo = F.xrow(row);
            const int ca = n0 + nt0 * 16 + r, cb = ca + 16;
            xo[ca] = xi[ca] + g1[ca] * c[0][0][i]; xo[cb] = xi[cb] + g1[cb] * c[0][1][i];
        }
        __syncthreads();
    }
}
__device__ __forceinline__ void phase_outproj(const Frame& F, int layer) {
    if (layer == 0) outproj_ctx_tiles(F, layer);
    g8::DenseSched S; S.abase = (const char*)(F.ws + WS_XN); S.bbase = (const char*)((const half_t*)(F.ws + WS_WOUT) + (size_t)layer * D * D); S.K = D; S.nM = TL / 256; S.nN = D / 256; S.G = gridDim.x; S.c = blockIdx.x;
    EpiOutproj E{F, layer};
    g8::gemm_phase(F.smem, D, S, E);
}

constexpr int RLD = D + 8;
__device__ __forceinline__ void phase_router(const Frame& F, int layer, bool dry = false) {
    const int nrows = layer == 0 ? TT : TL, total = nrows / 16;
    half_t* Th = (half_t*)F.smem;
    half_t* Tl = Th + 16 * RLD;
    float* PART = (float*)(Tl + 16 * RLD);
    float* LG = PART + 8 * 16 * 48;
    half_t* tb = (half_t*)(F.ws + WS_XN);
    unsigned* cnt = (unsigned*)(F.ws + WS_CTL) + CW_CNT + layer * 64 * CSTR;
    int* list = (int*)(F.ws + WS_LIST); float* pw = (float*)(F.ws + WS_PW);
    const float* nw = F.in(I_N2W) + layer * D;
    const half_t* wr = (const half_t*)(F.ws + WS_WR) + (size_t)layer * 2 * 48 * D;
    const int lane = F.lane, wave = F.wave, r = lane & 15, kq = (lane >> 4) * 8, kb = wave * 128;
    half8 bh[3][4];
#pragma unroll
    for (int nt = 0; nt < 3; ++nt)
#pragma unroll
        for (int ks = 0; ks < 4; ++ks) { const size_t o = (size_t)(nt * 16 + r) * D + kb + ks * 32 + kq; bh[nt][ks] = *(const half8*)(wr + o); }
    int mc = -1; f32x4 g[4], s4[4];
    int it = blockIdx.x;
    f32x4 v[2][4];
    if (it < total) {
#pragma unroll
        for (int rr = 0; rr < 2; ++rr) { const float* x = F.xrow(it * 16 + wave * 2 + rr);
#pragma unroll
            for (int q = 0; q < 4; ++q) v[rr][q] = *(const f32x4*)(x + q * 256 + lane * 4); } }
    int p_row = -1, p_ea = 0, p_eb = 0; unsigned p_pa = 0, p_pb = 0; float p_w0 = 0.f, p_w1 = 0.f;
    for (; it < total; it += gridDim.x) {
        const int row0 = it * 16, nit = it + gridDim.x;
        f32x4 vn[2][4];
        if (nit < total) {
#pragma unroll
            for (int rr = 0; rr < 2; ++rr) { const float* x = F.xrow(nit * 16 + wave * 2 + rr);
#pragma unroll
                for (int q = 0; q < 4; ++q) vn[rr][q] = *(const f32x4*)(x + q * 256 + lane * 4); } }
        { const int m = row_mod(row0);
          if (m != mc) { mc = m; const float* sh = modp(F, layer, m, 3); const float* scl = modp(F, layer, m, 4);
#pragma unroll
              for (int q = 0; q < 4; ++q) { const int k = q * 256 + lane * 4; const f32x4 a = *(const f32x4*)(nw + k), b = *(const f32x4*)(scl + k); s4[q] = *(const f32x4*)(sh + k);
#pragma unroll
                  for (int e = 0; e < 4; ++e) g[q][e] = a[e] * (1.0f + b[e]); } } }
#pragma unroll
        for (int rr = 0; rr < 2; ++rr) {
            float ss = 0.f;
#pragma unroll
            for (int q = 0; q < 4; ++q) ss += v[rr][q][0] * v[rr][q][0] + v[rr][q][1] * v[rr][q][1] + v[rr][q][2] * v[rr][q][2] + v[rr][q][3] * v[rr][q][3];
            ss = wave_sum(ss);
            const float rs = 1.0f / sqrtf(ss * (1.0f / D) + EPSF);
            const int lr = wave * 2 + rr, row = row0 + lr;
#pragma unroll
            for (int q = 0; q < 4; ++q) { const int k = q * 256 + lane * 4; half4 h, l;
#pragma unroll
                for (int e = 0; e < 4; ++e) { const float tv = v[rr][q][e] * rs * g[q][e] + s4[q][e]; h[e] = (half_t)tv; l[e] = (half_t)((tv - (float)h[e]) * 2048.f); }
                *(half4*)(tb + (size_t)row * D + k) = h; *(half4*)(Th + lr * RLD + k) = h; *(half4*)(Tl + lr * RLD + k) = l; }
        }
        __syncthreads();
        { f32x4 ah[3], al[3]; half8 bl[3][4];
#pragma unroll
          for (int nt = 0; nt < 3; ++nt)
#pragma unroll
              for (int ks = 0; ks < 4; ++ks) bl[nt][ks] = *(const half8*)(wr + (size_t)48 * D + (size_t)(nt * 16 + r) * D + kb + ks * 32 + kq);
#pragma unroll
          for (int nt = 0; nt < 3; ++nt) { ah[nt] = (f32x4){0.f, 0.f, 0.f, 0.f}; al[nt] = (f32x4){0.f, 0.f, 0.f, 0.f}; }
#pragma unroll
          for (int ks = 0; ks < 4; ++ks) {
              const half8 a_h = *(const half8*)(Th + r * RLD + kb + ks * 32 + kq), a_l = *(const half8*)(Tl + r * RLD + kb + ks * 32 + kq);
#pragma unroll
              for (int nt = 0; nt < 3; ++nt) { ah[nt] = mfma16(a_h, bh[nt][ks], ah[nt]); al[nt] = mfma16(a_l, bh[nt][ks], al[nt]); al[nt] = mfma16(a_h, bl[nt][ks], al[nt]); }
          }
#pragma unroll
          for (int nt = 0; nt < 3; ++nt)
#pragma unroll
              for (int i = 0; i < 4; ++i) PART[(wave * 16 + (lane >> 4) * 4 + i) * 48 + nt * 16 + r] = ah[nt][i] + al[nt][i] * (1.0f / 2048.f); }
        __syncthreads();
        for (int o = F.tid; o < 16 * 48; o += NT) { const int col = o % 48; float sum = 0.f;
#pragma unroll
            for (int w = 0; w < 8; ++w) sum += PART[w * 16 * 48 + o];
            float bias = 0.f; if (col < 4) bias = F.in(I_GRB)[layer * 4 + col]; else if (col < 36) bias = F.in(I_ERB)[layer * 32 + col - 4];
            LG[o] = sum + bias; }
        __syncthreads();
        if (F.tid < 16) {
            if (p_row >= 0 && !dry) { list[(size_t)(p_ea * 2 + 0) * LCAP + p_pa] = p_row * 2 + 0; list[(size_t)(p_eb * 2 + 1) * LCAP + p_pb] = p_row * 2 + 1; pw[p_row * 2 + 0] = p_w0; pw[p_row * 2 + 1] = p_w1; }
            const int row = row0 + F.tid; const float* lg = LG + F.tid * 48;
            int gi = 0; float gm = lg[0];
            for (int q = 1; q < 4; ++q) if (lg[q] > gm) { gm = lg[q]; gi = q; }
            float gs = 0.f; for (int q = 0; q < 4; ++q) gs += expf(lg[q] - gm);
            const float grp_p = 1.0f / gs;
            const float* el = lg + 4 + gi * 8;
            int i0 = 0; float e0 = el[0];
            for (int q = 1; q < 8; ++q) if (el[q] > e0) { e0 = el[q]; i0 = q; }
            int i1 = -1; float e1 = -3.0e38f;
            for (int q = 0; q < 8; ++q) if (q != i0 && el[q] > e1) { e1 = el[q]; i1 = q; }
            const float p1 = expf(e1 - e0);
            p_w0 = grp_p * (1.0f / (1.0f + p1)); p_w1 = grp_p * (p1 / (1.0f + p1));
            p_ea = gi * 8 + i0; p_eb = gi * 8 + i1; p_row = row;
            if (!dry) { p_pa = atomicAdd(&cnt[(p_ea * 2 + 0) * CSTR], 1u); p_pb = atomicAdd(&cnt[(p_eb * 2 + 1) * CSTR], 1u); }
        }
#pragma unroll
        for (int rr = 0; rr < 2; ++rr)
#pragma unroll
            for (int q = 0; q < 4; ++q) v[rr][q] = vn[rr][q];
    }
    if (F.tid < 16 && p_row >= 0 && !dry) { list[(size_t)(p_ea * 2 + 0) * LCAP + p_pa] = p_row * 2 + 0; list[(size_t)(p_eb * 2 + 1) * LCAP + p_pb] = p_row * 2 + 1; pw[p_row * 2 + 0] = p_w0; pw[p_row * 2 + 1] = p_w1; }
    __syncthreads();
}

constexpr int MOE_PRE_OFF = g8::STAGE_BYTES;
struct MoeSchedA {
    const char* abase; const char* wbase; const int* pre; const unsigned* cnt; const int* list; int G, c;
    __device__ __forceinline__ int entry(const g8::Unit& u, int r) const { const int rc = r < u.n ? r : 0; return rc < u.c0 ? list[(size_t)(u.e * 2) * LCAP + rc] : list[(size_t)(u.e * 2 + 1) * LCAP + (rc - u.c0)]; }
    __device__ __forceinline__ bool next(int i, g8::Unit& u) const {
        const int nwg = pre[32]; int L = i * G + c; if (L >= nwg) return false;
        { const int q = nwg / 8, r = nwg % 8, xcd = L % 8, off = L / 8; L = (xcd < r ? xcd * (q + 1) : r * (q + 1) + (xcd - r) * q) + off; }
        int e = 0;
#pragma unroll
        for (int st = 16; st >= 1; st >>= 1) if (pre[e + st] <= L) e += st;
        const int loc = L - pre[e]; u.e = e; u.c0 = (int)cnt[(e * 2) * CSTR]; u.n = u.c0 + (int)cnt[(e * 2 + 1) * CSTR]; u.pm = loc >> 1; u.pn = loc & 1; return true;
    }
    __device__ __forceinline__ unsigned a_off(const g8::Unit& u, int r) const { return (unsigned)(entry(u, u.pm * 256 + r) >> 1) * (unsigned)(D * 2); }
    __device__ __forceinline__ const char* b_half(const g8::Unit& u, int h) const { return wbase + ((size_t)u.e * 3 * 262144 + (size_t)h * 262144 + (size_t)u.pn * 128 * D) * 2; }
};
struct EpiMoeA {
    static constexpr bool PERM = true;
    MoeSchedA S; const float* pw; half_t* hid;
    __device__ __forceinline__ void operator()(const f32x4 (&acc)[2][2][4][2], const g8::Unit& u, int wr, int wc, int fr, int fq) const {
        int pid[8]; float w[8];
#pragma unroll
        for (int g = 0; g < 8; ++g) pid[g] = S.entry(u, u.pm * 256 + (g >> 2) * 128 + wr * 64 + (g & 3) * 16 + fr);
#pragma unroll
        for (int g = 0; g < 8; ++g) w[g] = pw[pid[g]];
        const int f = u.pn * 128 + wc * 32 + 8 * fq;
#pragma unroll
        for (int ai = 0; ai < 2; ++ai)
#pragma unroll
            for (int m = 0; m < 4; ++m) {
                const int rr = u.pm * 256 + ai * 128 + wr * 64 + m * 16 + fr;
                if (rr < u.n) { half8 h;
#pragma unroll
                    for (int n = 0; n < 2; ++n) { const f32x4 g = acc[ai][0][m][n], up = acc[ai][1][m][n];
#pragma unroll
                        for (int i = 0; i < 4; ++i) h[n * 4 + i] = (half_t)(fsilu(g[i]) * up[i] * w[ai * 4 + m]); }
                    *(half8*)(hid + (size_t)pid[ai * 4 + m] * 256 + f) = h; }
            }
    }
};
__device__ __forceinline__ void phase_moe_a(const Frame& F, int layer) {
    int* pre = (int*)(F.smem + MOE_PRE_OFF);
    const unsigned* cnt = (const unsigned*)(F.ws + WS_CTL) + CW_CNT + layer * 64 * CSTR;
    int t_ = threadIdx.x; OPAQUE_T(t_);
    if (t_ < 64) {
        const int l = t_; int u = 0;
        if (l < 32) u = (((int)(cnt[(l * 2) * CSTR] + cnt[(l * 2 + 1) * CSTR]) + 255) / 256) * 2;
        int inc = u;
#pragma unroll
        for (int d = 1; d < 64; d <<= 1) { const int t = __shfl_up(inc, d); if (l >= d) inc += t; }
        if (l <= 32) pre[l] = inc - u;
    }
    __syncthreads();
    MoeSchedA S; S.abase = (const char*)(F.ws + WS_XN); S.wbase = (const char*)(F.ws + WS_WMOE); S.pre = pre; S.cnt = cnt; S.list = (const int*)(F.ws + WS_LIST); S.G = gridDim.x; S.c = blockIdx.x;
    EpiMoeA E{S, (const float*)(F.ws + WS_PW), (half_t*)(F.ws + WS_U16)};
    g8::gemm_phase(F.smem, D, S, E);
    __syncthreads();
    if (layer == 0) {
        const int G = gridDim.x, U = pre[32], nmax = (U + G - 1) / G, first = U - (nmax - 1) * G;
        const int nidle = (nmax > 0 && first < G) ? G - first : G, me = (nmax > 0 && first < G) ? (int)blockIdx.x - first : (int)blockIdx.x;
        const int f0 = inproj_idle_blocks(G);
        __syncthreads();
        if (me >= 0) {
            for (int i = f0 + me; i < SEQ / 32; i += nidle) item_filter<32>(F, 1, 0, i);
            const int nF = SEQ / 32 > f0 ? SEQ / 32 - f0 : 0;
            for (int i = (me + nidle - nF % nidle) % nidle; i < IT_MOD / 2; i += nidle) item_mod(F, IT_MOD / 2 + i);
        }
    }
}
struct MoeSchedB {
    const char* abase; const char* wbase; const int* pre; const unsigned* cnt; const int* list; int G, c;
    __device__ __forceinline__ bool next(int i, g8::Unit& u) const {
        const int nwg = pre[64]; int L = i * G + c; if (L >= nwg) return false;
        { const int q = nwg / 8, r = nwg % 8, xcd = L % 8, off = L / 8; L = (xcd < r ? xcd * (q + 1) : r * (q + 1) + (xcd - r) * q) + off; }
        int l = 0;
#pragma unroll
        for (int st = 32; st >= 1; st >>= 1) if (pre[l + st] <= L) l += st;
        const int loc = L - pre[l]; u.e = l >> 1; u.c0 = l & 1; u.n = (int)cnt[(l) * CSTR]; u.pm = loc >> 2; u.pn = loc & 3; return true;
    }
    __device__ __forceinline__ int entry(const g8::Unit& u, int rr) const { return list[(size_t)(u.e * 2 + u.c0) * LCAP + (rr < u.n ? rr : 0)]; }
    __device__ __forceinline__ unsigned a_off(const g8::Unit& u, int r) const { return (unsigned)entry(u, u.pm * 256 + r) * 512u; }
    __device__ __forceinline__ const char* b_half(const g8::Unit& u, int h) const { return wbase + ((size_t)u.e * 3 * 262144 + 2 * 262144 + (size_t)(u.pn * 256 + h * 128) * 256) * 2; }
};
struct EpiMoeB {
    static constexpr bool PERM = true;
    MoeSchedB S; Frame F; int layer;
    __device__ __forceinline__ void operator()(const f32x4 (&acc)[2][2][4][2], const g8::Unit& u, int wr, int wc, int fr, int fq) const {
        int row[8];
#pragma unroll
        for (int g = 0; g < 8; ++g) row[g] = S.entry(u, u.pm * 256 + (g >> 2) * 128 + wr * 64 + (g & 3) * 16 + fr) >> 1;
        half_t* xab = (half_t*)(F.ws + WS_U16 + XAB_OFF) + (size_t)u.c0 * TT * D;
#pragma unroll
        for (int ai = 0; ai < 2; ++ai)
#pragma unroll
            for (int m = 0; m < 4; ++m) {
                const int rr = u.pm * 256 + ai * 128 + wr * 64 + m * 16 + fr;
                if (rr < u.n) { const int rw = row[ai * 4 + m]; half_t* xo = xab + (size_t)rw * D;
#pragma unroll
                    for (int bj = 0; bj < 2; ++bj) { const int d = u.pn * 256 + bj * 128 + wc * 32 + 8 * fq;
                        const f32x4 a0 = acc[ai][bj][m][0], a1 = acc[ai][bj][m][1];
                        half8 h; h[0] = (half_t)a0[0]; h[1] = (half_t)a0[1]; h[2] = (half_t)a0[2]; h[3] = (half_t)a0[3]; h[4] = (half_t)a1[0]; h[5] = (half_t)a1[1]; h[6] = (half_t)a1[2]; h[7] = (half_t)a1[3];
                        *(half8*)(xo + d) = h; } }
            }
    }
};
__device__ __forceinline__ void phase_moe_b(const Frame& F, int layer) {
    int* pre = (int*)(F.smem + MOE_PRE_OFF);
    const unsigned* cnt = (const unsigned*)(F.ws + WS_CTL) + CW_CNT + layer * 64 * CSTR;
    int t_ = threadIdx.x; OPAQUE_T(t_);
    if (t_ < 64) {
        const int l = t_; const int u = (((int)cnt[l * CSTR] + 255) / 256) * 4;
        int inc = u;
#pragma unroll
        for (int d = 1; d < 64; d <<= 1) { const int t = __shfl_up(inc, d); if (l >= d) inc += t; }
        pre[l] = inc - u; if (l == 63) pre[64] = inc;
    }
    __syncthreads();
    MoeSchedB S; S.abase = (const char*)(F.ws + WS_U16); S.wbase = (const char*)(F.ws + WS_WMOE); S.pre = pre; S.cnt = cnt; S.list = (const int*)(F.ws + WS_LIST); S.G = gridDim.x; S.c = blockIdx.x;
    EpiMoeB E{S, F, layer};
    g8::gemm_phase(F.smem, 256, S, E);
    __syncthreads();
}

__device__ __forceinline__ void phase_final(const Frame& F) {
    const float* fw = F.in(I_FNW);
    int t_ = threadIdx.x; OPAQUE_T(t_);
    const int lane = t_ & 63, nwaves = gridDim.x * (NT / 64);
    f32x4 w4[4];
#pragma unroll
    for (int q = 0; q < 4; ++q) w4[q] = *(const f32x4*)(fw + q * 256 + lane * 4);
    int row = blockIdx.x * (NT / 64) + F.wave;
    f32x4 v[4];
    if (row < TL) {
#pragma unroll
        for (int q = 0; q < 4; ++q) v[q] = NT_LOAD(f32x4, F.P->out + (size_t)row * D + q * 256 + lane * 4); }
    for (; row < TL; row += nwaves) {
        const int nrow = row + nwaves;
        f32x4 vn[4];
        if (nrow < TL) {
#pragma unroll
            for (int q = 0; q < 4; ++q) vn[q] = NT_LOAD(f32x4, F.P->out + (size_t)nrow * D + q * 256 + lane * 4); }
        { const half_t* xa = (const half_t*)(F.ws + WS_U16 + XAB_OFF) + (size_t)row * D; const half_t* xb = xa + (size_t)TT * D;
          const float* g5 = modp(F, 1, row_mod(row), 5);
#pragma unroll
          for (int q = 0; q < 4; ++q) { const int k = q * 256 + lane * 4; const half4 a4 = *(const half4*)(xa + k), b4 = *(const half4*)(xb + k); const f32x4 gv = *(const f32x4*)(g5 + k);
#pragma unroll
              for (int e = 0; e < 4; ++e) v[q][e] += gv[e] * ((float)a4[e] + (float)b4[e]); } }
        float ss = 0.f;
#pragma unroll
        for (int q = 0; q < 4; ++q) ss += v[q][0] * v[q][0] + v[q][1] * v[q][1] + v[q][2] * v[q][2] + v[q][3] * v[q][3];
        ss = wave_sum(ss);
        const float rs = 1.0f / sqrtf(ss * (1.0f / D) + EPSF);
#pragma unroll
        for (int q = 0; q < 4; ++q) *(f32x4*)(F.P->out + (size_t)row * D + q * 256 + lane * 4) = v[q] * rs * w4[q];
#pragma unroll
        for (int q = 0; q < 4; ++q) v[q] = vn[q];
    }
}

constexpr int NPHASE = 1 + 2 * 9 + 1;
#ifndef ONLY
#define ONLY -1
#endif
#define EN(x) (ONLY < 0 || ONLY == (x))
__device__ __forceinline__ void run_phase(const Frame& F0, int ph) {
    Frame F = F0; { int t_ = F0.tid; OPAQUE_T(t_); F.tid = t_; F.lane = t_ & 63;
#ifdef EMU
      F.wave = t_ >> 6; }
#else
      F.wave = __builtin_amdgcn_readfirstlane(t_ >> 6); }
#endif
    if (ph == 0) { if (EN(0)) phase_setup(F); return; }
    if (ph == NPHASE - 1) { if (EN(11)) phase_final(F); return; }
    const int layer = (ph - 1) / 9, k = (ph - 1) % 9;
    switch (k) {
        case 0: if (EN(1)) phase_norm1(F, layer); break;
        case 1: if (EN(2)) phase_inproj(F, layer); break;
        case 2: if (EN(10)) phase_act(F, layer); break;
        case 3: if (EN(3)) phase_mixers(F, layer); break;
        case 4: if (EN(4)) phase_combine(F, layer); break;
        case 5: if (EN(5)) phase_outproj(F, layer); break;
        case 6: if (EN(6)) phase_router(F, layer); break;
        case 7: if (EN(7)) phase_moe_a(F, layer); break;
        default: if (EN(8)) phase_moe_b(F, layer); break;
    }
}

#ifdef EMU
void mega(const Params* Pp) {
    Frame F; F.P = Pp; F.ws = Pp->ws; F.smem = emu_blk->smem; F.tid = threadIdx.x; F.lane = F.tid & 63; F.wave = F.tid >> 6;
    for (int ph = Pp->ph_lo; ph < Pp->ph_hi; ++ph) { run_phase(F, ph); __syncthreads(); }
}
#else
__global__ void __launch_bounds__(NT) mega(Params P) {
    extern __shared__ __attribute__((aligned(16))) unsigned char smem_dyn[];
    cg::grid_group grid = cg::this_grid();
    Frame F; F.P = (ParamsPtr)__builtin_amdgcn_kernarg_segment_ptr(); F.ws = P.ws; F.smem = smem_dyn; F.tid = threadIdx.x; F.lane = F.tid & 63; F.wave = F.tid >> 6;
    volatile LAS unsigned* bst = (volatile LAS unsigned*)(smem_dyn + LDS_BYTES - 16);
    if (F.tid < 4) bst[F.tid] = 0u;
    __syncthreads();
    XcdBarrier xb = xcd_barrier_post((unsigned*)(P.ws + WS_CTL) + CW_BAR, bst);
    if (P.ph_lo < 0) grid.sync();
#define DUP -1
#define AMP -1
#define PHASE_STEP(i) if (P.ph_lo <= (i) && (i) < P.ph_hi) { \
        unsigned long long t0_ = 0; if (AMP == (i)) t0_ = __builtin_amdgcn_s_memrealtime(); \
        run_phase(F, (i)); \
        if (DUP == (i)) { xcd_barrier(xb); run_phase(F, (i)); } \
        if ((i) + 1 < P.ph_hi || AMP == (i)) xcd_barrier(xb); \
        if (AMP == (i)) { const unsigned long long t1_ = __builtin_amdgcn_s_memrealtime(); if (blockIdx.x == 0) { while (__builtin_amdgcn_s_memrealtime() - t1_ < t1_ - t0_) __builtin_amdgcn_s_sleep(8); } xcd_barrier(xb); } }
    PHASE_STEP(0) PHASE_STEP(1) PHASE_STEP(2) PHASE_STEP(3) PHASE_STEP(4) PHASE_STEP(5) PHASE_STEP(6) PHASE_STEP(7) PHASE_STEP(8) PHASE_STEP(9)
    PHASE_STEP(10) PHASE_STEP(11) PHASE_STEP(12) PHASE_STEP(13) PHASE_STEP(14) PHASE_STEP(15) PHASE_STEP(16) PHASE_STEP(17) PHASE_STEP(18) PHASE_STEP(19)
    static_assert(NPHASE == 20, "phase list");
}

extern "C" void kernel_launch(void* const* d_in, const int* in_sizes, int n_in, void* d_out, int out_size, void* d_ws, size_t ws_size, hipStream_t stream) {
    static int grid_blocks = 0;
    if (grid_blocks == 0) {
        if (n_in != 38 || out_size != TL * D || ws_size < WS_END) { fprintf(stderr, "kernel_launch: unexpected shapes (n_in %d out %d ws %zu need %zu)\n", n_in, out_size, ws_size, (size_t)WS_END); grid_blocks = -1; return; }
        int dev = 0, cus = 0, per_cu = 0;
        hipGetDevice(&dev);
        hipDeviceGetAttribute(&cus, hipDeviceAttributeMultiprocessorCount, dev);
        hipFuncSetAttribute((const void*)mega, hipFuncAttributeMaxDynamicSharedMemorySize, LDS_BYTES);
        hipOccupancyMaxActiveBlocksPerMultiprocessor(&per_cu, (const void*)mega, NT, LDS_BYTES);
        if (per_cu < 1) { fprintf(stderr, "kernel_launch: occupancy query says 0 blocks per CU\n"); grid_blocks = -1; return; }
        grid_blocks = cus;
    }
    if (grid_blocks < 0) return;
    if (hipMemsetAsync((char*)d_ws + WS_CTL, 0, CTL_BYTES, stream) != hipSuccess) { fprintf(stderr, "kernel_launch: memset failed\n"); return; }
    Params p{};
    for (int i = 0; i < 38; ++i) p.in[i] = (const float*)d_in[i];
    p.out = (float*)d_out; p.ws = (unsigned char*)d_ws; p.ph_lo = 0; p.ph_hi = NPHASE;
    void* args[] = {&p};
    hipError_t e = hipLaunchCooperativeKernel((const void*)mega, dim3(grid_blocks), dim3(NT), args, LDS_BYTES, stream);
    if (e != hipSuccess) fprintf(stderr, "cooperative launch failed: %s (grid %d)\n", hipGetErrorString(e), grid_blocks);
}
#endif
```
